# Optimizing an MI355X kernel written in HIP

```python
import jax
import jax.numpy as jnp
from jax import lax
import numpy as np

D_MODEL = 1024
BATCH = 2
SEQ = 16384
DEPTH = 2

BRANCH_WIDTH = D_MODEL // 2
N_BRANCH = 3
ATTN_HEADS = 8
ATTN_HEAD_DIM = BRANCH_WIDTH // ATTN_HEADS
ATTN_WIDTH = ATTN_HEADS * ATTN_HEAD_DIM
MOBA_BLOCK = 256
MOBA_TOPK = 3
QUERY_CHUNK = 128
RWKV_HEAD_DIM = 64
RWKV_HEADS = BRANCH_WIDTH // RWKV_HEAD_DIM
RWKV_WIDTH = RWKV_HEADS * RWKV_HEAD_DIM
DECAY_LORA = 64
ICLR_LORA = 64
GATE_LORA = 128
VMIX_LORA = 32
LNX_EPS = 64e-5
POOL_WINDOWS = (2, 4, 8, 16)
POOL_GROUPS = 4
POOL_GROUP_DIM = BRANCH_WIDTH // POOL_GROUPS
POOL_WIDTH = POOL_GROUPS * POOL_GROUP_DIM
N_GROUPS = 4
EXPERTS_PER_GROUP = 8
N_EXPERTS = N_GROUPS * EXPERTS_PER_GROUP
EXPERT_TOPK = 2
EXPERT_HIDDEN = 512
EXPERT_ROW_BLOCK = 128
RMS_EPS = 1e-6
ATTN_OFF = 0
ATTN_COLS = 3 * ATTN_WIDTH
GATE_OFF = ATTN_OFF + ATTN_COLS
GATE_COLS = N_BRANCH * D_MODEL
POOL_OFF = GATE_OFF + GATE_COLS
RWKV_OFF = POOL_OFF + POOL_WIDTH
RWKV_COLS = 3 * RWKV_WIDTH + DECAY_LORA + ICLR_LORA + GATE_LORA
IN_COLS = RWKV_OFF + RWKV_COLS

kernel_name = 'hybrid_moba_rwkv7_pool_hiermoe'


def rmsnorm(x, g):
    xf = x.astype(jnp.float32)
    y = xf * lax.rsqrt(jnp.mean(xf * xf, axis=-1, keepdims=True) + RMS_EPS)
    return (y * g.astype(jnp.float32)).astype(x.dtype)


def alibi_slopes(n_heads):
    return jnp.asarray([2.0 ** (-8.0 * (i + 1) / n_heads) for i in range(n_heads)], dtype=jnp.float32)


def token_shift(z, mu):
    prev = jnp.pad(z[:, :-1], ((0, 0), (1, 0), (0, 0)))
    return z + (prev - z) * mu


def moba_attention(q, k, v, slopes):
    B, H, S, Dh = q.shape
    L = MOBA_BLOCK
    nb = -(-S // L)
    n_cand = max(nb, MOBA_TOPK)
    pad = nb * L - S
    kp = jnp.pad(k, ((0, 0), (0, 0), (0, pad), (0, 0)))
    vp = jnp.pad(v, ((0, 0), (0, 0), (0, pad), (0, 0)))
    kb = kp.reshape(B, H, nb, L, Dh)
    vb = vp.reshape(B, H, nb, L, Dh)
    kmean = jnp.mean(kb.astype(jnp.float32), axis=3)
    kmean = jnp.pad(kmean, ((0, 0), (0, 0), (0, n_cand - nb), (0, 0)))
    scale = Dh ** -0.5
    bi = jnp.arange(B)[:, None, None, None]
    hi = jnp.arange(H)[None, :, None, None]
    cand = jnp.arange(n_cand)
    offs = jnp.arange(L)
    slope5 = slopes[None, :, None, None, None]
    slope4 = slopes[None, :, None, None]

    def one_chunk(c):
        q0 = c * QUERY_CHUNK
        own = q0 // L
        qc = lax.dynamic_slice_in_dim(q, q0, QUERY_CHUNK, axis=2).astype(jnp.float32)
        tq = q0 + jnp.arange(QUERY_CHUNK)
        gate = jnp.einsum('bhqd,bhnd->bhqn', qc, kmean)
        gate = jnp.where(cand < own, gate, -jnp.inf)
        _, sel = lax.top_k(gate, MOBA_TOPK)
        valid = sel < own
        sel = jnp.minimum(sel, nb - 1)
        k_sel = kb[bi, hi, sel].astype(jnp.float32)
        dist = (tq[:, None, None] - (sel[..., None] * L + offs)).astype(jnp.float32)
        s_sel = jnp.einsum('bhqd,bhqjld->bhqjl', qc, k_sel) * scale - slope5 * dist
        s_sel = jnp.where(valid[..., None], s_sel, -jnp.inf)
        s_sel = s_sel.reshape(B, H, QUERY_CHUNK, MOBA_TOPK * L)
        k_own = lax.dynamic_slice_in_dim(kp, own * L, L, axis=2).astype(jnp.float32)
        v_own = lax.dynamic_slice_in_dim(vp, own * L, L, axis=2).astype(jnp.float32)
        dist_own = tq[:, None] - (own * L + offs)[None, :]
        s_own = jnp.einsum('bhqd,bhld->bhql', qc, k_own) * scale - slope4 * dist_own.astype(jnp.float32)
        s_own = jnp.where(dist_own >= 0, s_own, -jnp.inf)
        p = jax.nn.softmax(jnp.concatenate([s_sel, s_own], axis=-1), axis=-1)
        p_sel = p[..., :MOBA_TOPK * L].reshape(B, H, QUERY_CHUNK, MOBA_TOPK, L)
        v_sel = vb[bi, hi, sel].astype(jnp.float32)
        o = (jnp.einsum('bhqjl,bhqjld->bhqd', p_sel, v_sel)
             + jnp.einsum('bhql,bhld->bhqd', p[..., MOBA_TOPK * L:], v_own))
        return o.astype(q.dtype)

    out = lax.map(one_chunk, jnp.arange(S // QUERY_CHUNK))
    return jnp.moveaxis(out, 0, 2).reshape(B, H, S, Dh)


def wkv7_scan(r, w, k, v, a, b):
    B, S, H, N = r.shape

    def step(state, inp):
        r_t, w_t, k_t, v_t, a_t, b_t = inp
        sa = jnp.einsum('bhvk,bhk->bhv', state, a_t)
        state = (state * w_t[:, :, None, :] + sa[..., None] * b_t[:, :, None, :]
                 + v_t[..., None] * k_t[:, :, None, :])
        return state, jnp.einsum('bhvk,bhk->bhv', state, r_t)

    xs = (jnp.swapaxes(r, 0, 1), jnp.swapaxes(w, 0, 1), jnp.swapaxes(k, 0, 1),
          jnp.swapaxes(v, 0, 1), jnp.swapaxes(a, 0, 1), jnp.swapaxes(b, 0, 1))
    _, y = lax.scan(step, jnp.zeros((B, H, N, N), jnp.float32), xs)
    return jnp.swapaxes(y, 0, 1)


def rwkv7_time_mix(cols, v_first, w0, w_decay_up, a0, w_iclr_up, w_gate_up, k_k, k_a, r_k,
                   lnx_g, lnx_b, vmix):
    B, S, _ = cols.shape
    W = RWKV_WIDTH
    c = cols.astype(jnp.float32)
    o1 = 3 * W
    o2 = o1 + DECAY_LORA
    o3 = o2 + ICLR_LORA
    o4 = o3 + GATE_LORA
    r, k, v = c[..., :W], c[..., W:2 * W], c[..., 2 * W:o1]
    w_lo, a_lo, g_lo = c[..., o1:o2], c[..., o2:o3], c[..., o3:o4]

    def heads(t):
        return t.reshape(B, S, RWKV_HEADS, RWKV_HEAD_DIM)

    w_log = -jax.nn.softplus(-(w0 + jnp.tanh(w_lo) @ w_decay_up)) - 0.5
    decay = jnp.exp(-jnp.exp(w_log))
    if vmix is None:
        v_first = v
    else:
        vm_lo, v0, w_vmix_up = vmix
        v = v + (v_first - v) * jax.nn.sigmoid(v0 + vm_lo.astype(jnp.float32) @ w_vmix_up)
    a = jax.nn.sigmoid(a0 + a_lo @ w_iclr_up)
    g = jax.nn.sigmoid(g_lo) @ w_gate_up
    kk = heads(k * k_k)
    kk = kk / jnp.maximum(jnp.sqrt(jnp.sum(kk * kk, axis=-1, keepdims=True)), 1e-12)
    k = k * (1.0 + (a - 1.0) * k_a)
    r_h, k_h, v_h, a_h = heads(r), heads(k), heads(v), heads(a)
    y = wkv7_scan(r_h, heads(decay), k_h, v_h, -kk, kk * a_h)
    mu = jnp.mean(y, axis=-1, keepdims=True)
    var = jnp.mean(jnp.square(y - mu), axis=-1, keepdims=True)
    y = ((y - mu) * lax.rsqrt(var + LNX_EPS)).reshape(B, S, W) * lnx_g + lnx_b
    bonus = jnp.sum(r_h * k_h * r_k, axis=-1, keepdims=True) * v_h
    y = (y + bonus.reshape(B, S, W)) * g
    return y.astype(cols.dtype), v_first


def multiscale_pool(z, pool_w, pool_scale):
    B, S, _ = z.shape
    zf = z.astype(jnp.float32).reshape(B, S, POOL_GROUPS, POOL_GROUP_DIM)
    cum = jnp.cumsum(zf, axis=1)
    t1 = jnp.arange(1, S + 1, dtype=jnp.float32)[None, :, None]
    outs = []
    for gi, win in enumerate(POOL_WINDOWS):
        cg = cum[:, :, gi]
        lagged = jnp.pad(cg, ((0, 0), (win, 0), (0, 0)))[:, :S]
        outs.append((cg - lagged) / jnp.minimum(t1, float(win)) - zf[:, :, gi])
    p = jnp.stack(outs, axis=2)
    y = jnp.einsum('bsgc,gcd->bsgd', p, pool_w.astype(jnp.float32)).reshape(B, S, POOL_WIDTH)
    return (y * pool_scale).astype(z.dtype)


def hier_moe(h, rg_w, rg_b, re_w, re_b, w1, w3, w2):
    B, S, D = h.shape
    T = B * S
    hf = h.reshape(T, D)
    glog = (hf @ rg_w).astype(jnp.float32) + rg_b
    gprob = jax.nn.softmax(glog, axis=-1)
    grp = jnp.argmax(glog, axis=-1)
    elog = ((hf @ re_w).astype(jnp.float32) + re_b).reshape(T, N_GROUPS, EXPERTS_PER_GROUP)
    elog_g = jnp.take_along_axis(elog, grp[:, None, None], axis=1)[:, 0]
    top_v, top_i = lax.top_k(elog_g, EXPERT_TOPK)
    wts = jax.nn.softmax(top_v, axis=-1) * jnp.take_along_axis(gprob, grp[:, None], axis=1)
    eid = (grp[:, None] * EXPERTS_PER_GROUP + top_i).reshape(-1)
    tok = jnp.repeat(jnp.arange(T), EXPERT_TOPK)
    wts = wts.reshape(-1)
    A = T * EXPERT_TOPK
    blk = EXPERT_ROW_BLOCK
    order = jnp.argsort(eid)
    e_s, tok_s, w_s = eid[order], tok[order], wts[order]
    counts = jnp.bincount(eid, length=N_EXPERTS)
    starts = jnp.cumsum(counts) - counts
    padded = (counts + blk - 1) // blk * blk
    pends = jnp.cumsum(padded)
    pstarts = pends - padded
    dest = pstarts[e_s] + (jnp.arange(A) - starts[e_s])
    R = -(-(A + N_EXPERTS * (blk - 1)) // blk) * blk
    nblk = R // blk
    buf = jnp.zeros((R, D), h.dtype).at[dest].set(hf[tok_s])
    blk_e = jnp.minimum(jnp.searchsorted(pends, jnp.arange(nblk) * blk, side='right'), N_EXPERTS - 1)

    def expert_block(args):
        xb, e = args
        return (jax.nn.silu(xb @ w1[e]) * (xb @ w3[e])) @ w2[e]

    yb = lax.map(expert_block, (buf.reshape(nblk, blk, D), blk_e)).reshape(R, D)
    y = yb[dest] * w_s[:, None].astype(yb.dtype)
    out = jax.ops.segment_sum(y, tok_s, num_segments=T)
    return out.reshape(B, S, D).astype(h.dtype)


def setup_inputs(seed: int = 0) -> dict:
    key = jax.random.key(seed)
    ks = jax.random.split(key, 32)
    f32 = jnp.float32
    L = DEPTH
    Lr = DEPTH - 1

    def nrm(k, shape, scale):
        return jax.random.normal(k, shape, f32) * scale

    def near_one(k, shape):
        return 1.0 + 0.1 * jax.random.normal(k, shape, f32)

    return {
        'x': nrm(ks[0], (BATCH, SEQ, D_MODEL), 1.0),
        'norm1_g': near_one(ks[1], (L, D_MODEL)),
        'w_in': nrm(ks[2], (L, D_MODEL, IN_COLS), D_MODEL ** -0.5),
        'w_vmix': nrm(ks[3], (Lr, D_MODEL, VMIX_LORA), D_MODEL ** -0.5),
        'rwkv_mu': jax.random.uniform(ks[4], (L, RWKV_COLS), f32),
        'vmix_mu': jax.random.uniform(ks[5], (Lr, VMIX_LORA), f32),
        'w0': jax.random.uniform(ks[6], (L, RWKV_WIDTH), f32, minval=-3.0, maxval=1.0),
        'w_decay_up': nrm(ks[7], (L, DECAY_LORA, RWKV_WIDTH), 0.1),
        'a0': nrm(ks[8], (L, RWKV_WIDTH), 0.5),
        'w_iclr_up': nrm(ks[9], (L, ICLR_LORA, RWKV_WIDTH), ICLR_LORA ** -0.5),
        'w_gate_up': nrm(ks[10], (L, GATE_LORA, RWKV_WIDTH), GATE_LORA ** -0.5),
        'k_k': 0.85 + 0.1 * jax.random.normal(ks[11], (L, RWKV_WIDTH), f32),
        'k_a': near_one(ks[12], (L, RWKV_WIDTH)),
        'r_k': nrm(ks[13], (L, RWKV_HEADS, RWKV_HEAD_DIM), 0.1),
        'lnx_g': near_one(ks[14], (L, RWKV_WIDTH)),
        'lnx_b': nrm(ks[15], (L, RWKV_WIDTH), 0.01),
        'v0': nrm(ks[16], (Lr, RWKV_WIDTH), 0.5),
        'w_vmix_up': nrm(ks[17], (Lr, VMIX_LORA, RWKV_WIDTH), VMIX_LORA ** -0.5),
        'pool_w': nrm(ks[18], (L, POOL_GROUPS, POOL_GROUP_DIM, POOL_GROUP_DIM), POOL_GROUP_DIM ** -0.5),
        'pool_scale': near_one(ks[19], (L, POOL_WIDTH)),
        'w_branch': nrm(ks[20], (L, N_BRANCH, BRANCH_WIDTH, D_MODEL), BRANCH_WIDTH ** -0.5),
        'w_out': nrm(ks[21], (L, D_MODEL, D_MODEL), D_MODEL ** -0.5),
        'norm2_g': near_one(ks[22], (L, D_MODEL)),
        'router_grp_w': nrm(ks[23], (L, D_MODEL, N_GROUPS), D_MODEL ** -0.5),
        'router_grp_b': nrm(ks[24], (L, N_GROUPS), 0.01),
        'router_exp_w': nrm(ks[25], (L, D_MODEL, N_EXPERTS), D_MODEL ** -0.5),
        'router_exp_b': nrm(ks[26], (L, N_EXPERTS), 0.01),
        'exp_w1': nrm(ks[27], (L, N_EXPERTS, D_MODEL, EXPERT_HIDDEN), D_MODEL ** -0.5),
        'exp_w3': nrm(ks[28], (L, N_EXPERTS, D_MODEL, EXPERT_HIDDEN), D_MODEL ** -0.5),
        'exp_w2': nrm(ks[29], (L, N_EXPERTS, EXPERT_HIDDEN, D_MODEL), EXPERT_HIDDEN ** -0.5),
        'final_norm_g': near_one(ks[30], (D_MODEL,)),
    }


def reference(x, norm1_g, w_in, w_vmix, rwkv_mu, vmix_mu, w0, w_decay_up, a0, w_iclr_up,
              w_gate_up, k_k, k_a, r_k, lnx_g, lnx_b, v0, w_vmix_up, pool_w, pool_scale,
              w_branch, w_out, norm2_g, router_grp_w, router_grp_b, router_exp_w, router_exp_b,
              exp_w1, exp_w3, exp_w2, final_norm_g):
    B, S, D = x.shape
    slopes = alibi_slopes(ATTN_HEADS)
    v_first = None

    def attn_heads(t):
        return t.reshape(B, S, ATTN_HEADS, ATTN_HEAD_DIM).transpose(0, 2, 1, 3)

    for l in range(DEPTH):
        h = rmsnorm(x, norm1_g[l])
        if l == 0:
            w_cols, mu = w_in[l], rwkv_mu[l]
        else:
            w_cols = jnp.concatenate([w_in[l], w_vmix[l - 1]], axis=1)
            mu = jnp.concatenate([rwkv_mu[l], vmix_mu[l - 1]], axis=0)
        z = h @ w_cols
        q = attn_heads(z[..., ATTN_OFF:ATTN_OFF + ATTN_WIDTH])
        k = attn_heads(z[..., ATTN_OFF + ATTN_WIDTH:ATTN_OFF + 2 * ATTN_WIDTH])
        v = attn_heads(z[..., ATTN_OFF + 2 * ATTN_WIDTH:ATTN_OFF + 3 * ATTN_WIDTH])
        y_attn = moba_attention(q, k, v, slopes).transpose(0, 2, 1, 3).reshape(B, S, ATTN_WIDTH)
        rw = token_shift(z[..., RWKV_OFF:], mu)
        vmix = None if l == 0 else (rw[..., RWKV_COLS:], v0[l - 1], w_vmix_up[l - 1])
        y_rwkv, v_first = rwkv7_time_mix(rw[..., :RWKV_COLS], v_first, w0[l], w_decay_up[l], a0[l],
                                         w_iclr_up[l], w_gate_up[l], k_k[l], k_a[l], r_k[l],
                                         lnx_g[l], lnx_b[l], vmix)
        y_pool = multiscale_pool(z[..., POOL_OFF:POOL_OFF + POOL_WIDTH], pool_w[l], pool_scale[l])
        gates = jax.nn.sigmoid(z[..., GATE_OFF:GATE_OFF + GATE_COLS].astype(jnp.float32))
        gates = gates.reshape(B, S, N_BRANCH, D)
        ys = jnp.stack([y_attn.astype(x.dtype), y_rwkv.astype(x.dtype), y_pool.astype(x.dtype)], axis=2)
        proj = jnp.einsum('bsiw,iwd->bsid', ys, w_branch[l])
        merged = jnp.sum(gates * proj, axis=2).astype(x.dtype)
        x = x + merged @ w_out[l]
        h2 = rmsnorm(x, norm2_g[l])
        x = x + hier_moe(h2, router_grp_w[l], router_grp_b[l], router_exp_w[l], router_exp_b[l],
                         exp_w1[l], exp_w3[l], exp_w2[l])
    return rmsnorm(x, final_norm_g)
```

```cpp
#include <hip/hip_runtime.h>
#include <hip/hip_cooperative_groups.h>
#include <cstdio>
#include <cstdint>
#include <cmath>
namespace pg8 {
#define PG8_LAS __attribute__((address_space(3)))
typedef unsigned short bf16_t;
typedef short bf16x8 __attribute__((ext_vector_type(8)));
typedef float f32x4 __attribute__((ext_vector_type(4)));
typedef unsigned u32x4 __attribute__((ext_vector_type(4)));
constexpr int BM = 256, BK = 64, HALF = 128, HTB = HALF * BK * 2  , STAGE_BYTES = 8 * HTB, NXCD = 8, WGM = 8;

__host__ __device__ __forceinline__ int lds_byte(int r, int c) { const int st = (r >> 4) * 2 + (c >> 5), rr = r & 15, cc = c & 31, ob = rr * 64 + cc * 2; return st * 1024 + (ob ^ (((ob >> 9) & 1) << 5)); }
__host__ __device__ __forceinline__ void stage_rc(int b, int& R, int& C) { const int st = b / 1024, sb = b % 1024, swz = sb ^ (((sb >> 9) & 1) << 5); R = (st >> 1) * 16 + swz / 64; C = (st & 1) * 32 + (swz % 64) / 2; }
__host__ __device__ __forceinline__ int perm32(int rho) { const int n = rho >> 4, i = rho & 15; return 8 * (i >> 2) + 4 * n + (i & 3); }

struct Unit { int pm, pn; };
struct Gemm { const bf16_t* A; const bf16_t* Bt; int M, N, K; };

struct StaticOrder {
    int nM, nN, nwg, G, c;
    __host__ __device__ void init(int M, int N, int G_, int c_) { nM = M / BM; nN = N / BM; nwg = nM * nN; G = G_; c = c_; }
    __host__ __device__ bool next(int i, Unit& u) const {
        const long L = (long)i * G + c; if (L >= nwg) return false;
        int wgid = (int)L; { const int q = nwg / NXCD, r = nwg % NXCD, xcd = wgid % NXCD, off = wgid / NXCD; wgid = (xcd < r ? xcd * (q + 1) : r * (q + 1) + (xcd - r) * q) + off; }
        const int nig = WGM * nN, gid = wgid / nig, fm = gid * WGM, gsz = (nM - fm) < WGM ? (nM - fm) : WGM;
        u.pm = fm + ((wgid % nig) % gsz); u.pn = (wgid % nig) / gsz; return true;
    }
    __device__ __forceinline__ void a_ready(const Unit&) const {}
    __device__ __forceinline__ void done(const Unit&) const {}
};

typedef float f32x2c_t __attribute__((ext_vector_type(2))); typedef __bf16 bf16x2c_t __attribute__((ext_vector_type(2)));
__device__ __forceinline__ unsigned cvt_pk_bf16(float lo, float hi) { const f32x2c_t v = {lo, hi}; const bf16x2c_t b = __builtin_convertvector(v, bf16x2c_t); return __builtin_bit_cast(unsigned, b); }
typedef float f32x2 __attribute__((ext_vector_type(2)));
__device__ __forceinline__ float fast_sigmoid(float x) { return __builtin_amdgcn_rcpf(1.0f + __builtin_amdgcn_exp2f(-1.4426950408889634f * x)); }
struct EpiZ {
    static constexpr bool PERM = true, AFTER_DRAIN = false;
    bf16_t *q, *k, *v, *poolz, *rwkvz; float qscale;
    __device__ __forceinline__ void operator()(const f32x4 (&acc)[2][2][4][2], const Unit& u, int wr, int wc, int fr, int fq) const {
        const int pn = u.pn; bf16_t* base; int ldc, colt, climit; float sc = 1.f;
        if (pn < 2) { base = q; ldc = 512; colt = pn * 256; climit = 512; sc = qscale; }
        else if (pn < 4) { base = k; ldc = 512; colt = (pn - 2) * 256; climit = 512; }
        else if (pn < 6) { base = v; ldc = 512; colt = (pn - 4) * 256; climit = 512; }
        else if (pn < 8) { base = poolz; ldc = 512; colt = (pn - 6) * 256; climit = 512; }
        else { base = rwkvz; ldc = 1824; colt = (pn - 8) * 256; climit = 1824; }
        const int row0 = u.pm * BM + wr * 64 + fr, col0 = colt + wc * 32 + 8 * fq;
#pragma unroll
        for (int ai = 0; ai < 2; ++ai)
#pragma unroll
            for (int m = 0; m < 4; ++m) { bf16_t* rowp = base + (size_t)(row0 + ai * HALF + m * 16) * ldc + col0;
#pragma unroll
                for (int bj = 0; bj < 2; ++bj) { if (col0 + bj * HALF < climit) { const f32x4 v0 = acc[ai][bj][m][0] * sc, v1 = acc[ai][bj][m][1] * sc;
                    u32x4 w; w.x = cvt_pk_bf16(v0[0], v0[1]); w.y = cvt_pk_bf16(v0[2], v0[3]); w.z = cvt_pk_bf16(v1[0], v1[1]); w.w = cvt_pk_bf16(v1[2], v1[3]);
                    *(u32x4*)(rowp + bj * HALF) = w; } } }
    }
};
struct EpiGate {
    static constexpr bool PERM = true, AFTER_DRAIN = false;
    bf16_t* O; int ldc;
    __device__ __forceinline__ void operator()(const f32x4 (&acc)[2][2][4][2], const Unit& u, int wr, int wc, int fr, int fq) const {
        const int row0 = u.pm * BM + wr * 64 + fr, col0 = u.pn * BM + wc * 32 + 8 * fq;
#pragma unroll
        for (int ai = 0; ai < 2; ++ai)
#pragma unroll
            for (int m = 0; m < 4; ++m) { bf16_t* rowp = O + (size_t)(row0 + ai * HALF + m * 16) * ldc + col0;
#pragma unroll
                for (int bj = 0; bj < 2; ++bj) { const f32x4 v0 = acc[ai][bj][m][0], v1 = acc[ai][bj][m][1];
                    u32x4 w; w.x = cvt_pk_bf16(fast_sigmoid(v0[0]), fast_sigmoid(v0[1])); w.y = cvt_pk_bf16(fast_sigmoid(v0[2]), fast_sigmoid(v0[3]));
                    w.z = cvt_pk_bf16(fast_sigmoid(v1[0]), fast_sigmoid(v1[1])); w.w = cvt_pk_bf16(fast_sigmoid(v1[2]), fast_sigmoid(v1[3]));
                    *(u32x4*)(rowp + bj * HALF) = w; } }
    }
};
__device__ __forceinline__ float bflo(unsigned w) { return __uint_as_float(w << 16); }
__device__ __forceinline__ float bfhi(unsigned w) { return __uint_as_float(w & 0xffff0000u); }
template <bool FIRST> struct EpiMerge {
    static constexpr bool PERM = true, AFTER_DRAIN = false;
    bf16_t* O; int ldc; const bf16_t* gate; int ldg, goff;
    __device__ __forceinline__ void operator()(const f32x4 (&acc)[2][2][4][2], const Unit& u, int wr, int wc, int fr, int fq) const {
        const int row0 = u.pm * BM + wr * 64 + fr, col0 = u.pn * BM + wc * 32 + 8 * fq;
#pragma unroll
        for (int ai = 0; ai < 2; ++ai)
#pragma unroll
            for (int m = 0; m < 4; ++m) { const size_t r = (size_t)(row0 + ai * HALF + m * 16); bf16_t* rowp = O + r * ldc + col0; const bf16_t* gp = gate + r * ldg + goff + col0;
#pragma unroll
                for (int bj = 0; bj < 2; ++bj) { const f32x4 v0 = acc[ai][bj][m][0], v1 = acc[ai][bj][m][1];
                    const u32x4 g = *(const u32x4*)(gp + bj * HALF);
                    float o[8] = {v0[0] * bflo(g.x), v0[1] * bfhi(g.x), v0[2] * bflo(g.y), v0[3] * bfhi(g.y), v1[0] * bflo(g.z), v1[1] * bfhi(g.z), v1[2] * bflo(g.w), v1[3] * bfhi(g.w)};
                    if (!FIRST) { const u32x4 p = *(const u32x4*)(rowp + bj * HALF);
                        o[0] += bflo(p.x); o[1] += bfhi(p.x); o[2] += bflo(p.y); o[3] += bfhi(p.y); o[4] += bflo(p.z); o[5] += bfhi(p.z); o[6] += bflo(p.w); o[7] += bfhi(p.w); }
                    u32x4 w; w.x = cvt_pk_bf16(o[0], o[1]); w.y = cvt_pk_bf16(o[2], o[3]); w.z = cvt_pk_bf16(o[4], o[5]); w.w = cvt_pk_bf16(o[6], o[7]);
                    *(u32x4*)(rowp + bj * HALF) = w; } }
    }
};
struct EpiResF32 {
    static constexpr bool PERM = false, AFTER_DRAIN = false;
    const float* base; float* out; int ldc;
    __device__ __forceinline__ void operator()(const f32x4 (&acc)[2][2][4][2], const Unit& u, int wr, int wc, int fr, int fq) const {
        const int row0 = u.pm * BM + wr * 64 + fr, col0 = u.pn * BM + wc * 32 + 4 * fq;
#pragma unroll
        for (int ai = 0; ai < 2; ++ai)
#pragma unroll
            for (int m = 0; m < 4; ++m) { const size_t off = (size_t)(row0 + ai * HALF + m * 16) * ldc + col0;
#pragma unroll
                for (int bj = 0; bj < 2; ++bj)
#pragma unroll
                    for (int n = 0; n < 2; ++n) { const f32x4 bs = *(const f32x4*)(base + off + bj * HALF + n * 16); *(f32x4*)(out + off + bj * HALF + n * 16) = bs + acc[ai][bj][m][n]; } }
    }
};
struct EpiSwiGLU {
    static constexpr bool PERM = true, AFTER_DRAIN = false;
    bf16_t* O;
    __device__ __forceinline__ void operator()(const f32x4 (&acc)[2][2][4][2], const Unit& u, int wr, int wc, int fr, int fq) const {
        const int row0 = u.pm * BM + wr * 64 + fr, col0 = (u.pn & 3) * 128 + wc * 32 + 8 * fq;
#pragma unroll
        for (int ai = 0; ai < 2; ++ai)
#pragma unroll
            for (int m = 0; m < 4; ++m) { bf16_t* rowp = O + (size_t)(row0 + ai * HALF + m * 16) * 512 + col0;
                float o[8];
#pragma unroll
                for (int n = 0; n < 2; ++n)
#pragma unroll
                    for (int e = 0; e < 4; ++e) { const float a1 = acc[ai][0][m][n][e], a3 = acc[ai][1][m][n][e]; o[n * 4 + e] = a1 * fast_sigmoid(a1) * a3; }
                u32x4 w; w.x = cvt_pk_bf16(o[0], o[1]); w.y = cvt_pk_bf16(o[2], o[3]); w.z = cvt_pk_bf16(o[4], o[5]); w.w = cvt_pk_bf16(o[6], o[7]);
                *(u32x4*)rowp = w; }
    }
};
struct EpiY {
    static constexpr bool PERM = true, AFTER_DRAIN = false;
    bf16_t* O;
    __device__ __forceinline__ void operator()(const f32x4 (&acc)[2][2][4][2], const Unit& u, int wr, int wc, int fr, int fq) const {
        const int row0 = u.pm * BM + wr * 64 + fr, col0 = (u.pn & 3) * BM + wc * 32 + 8 * fq;
#pragma unroll
        for (int ai = 0; ai < 2; ++ai)
#pragma unroll
            for (int m = 0; m < 4; ++m) { bf16_t* rowp = O + (size_t)(row0 + ai * HALF + m * 16) * 1024 + col0;
#pragma unroll
                for (int bj = 0; bj < 2; ++bj) { const f32x4 v0 = acc[ai][bj][m][0], v1 = acc[ai][bj][m][1];
                    u32x4 w; w.x = cvt_pk_bf16(v0[0], v0[1]); w.y = cvt_pk_bf16(v0[2], v0[3]); w.z = cvt_pk_bf16(v1[0], v1[1]); w.w = cvt_pk_bf16(v1[2], v1[3]);
                    *(u32x4*)(rowp + bj * HALF) = w; } }
    }
};
struct MoeOrder {
    const PG8_LAS unsigned char* tile_e; int nunits, G, c;
    __device__ __forceinline__ bool next(int i, Unit& u) const {
        const int L = i * G + c; if (L >= nunits) return false;
        const int pm = L >> 2; u.pm = pm; u.pn = __builtin_amdgcn_readfirstlane((int)tile_e[pm]) * 4 + (L & 3); return true;
    }
    __device__ __forceinline__ void a_ready(const Unit&) const {}
    __device__ __forceinline__ void done(const Unit&) const {}
};
template <class Epi, class Sched, bool ALIGN_EPI = false, bool SP2 = false>
__device__ __forceinline__ void gemm_phase(PG8_LAS unsigned char* lds, const Gemm g, const Sched& S, const Epi& E) {
    int tid = threadIdx.x; asm volatile("" : "+v"(tid));
    const int wid = __builtin_amdgcn_readfirstlane(tid >> 6), lane = tid & 63, wr = wid >> 2, wc = wid & 3, fr = lane & 15, fq = lane >> 4;
    const int K = g.K, nt = K / BK;
    unsigned voffA[2], voffB[2];
#pragma unroll
    for (int i = 0; i < 2; ++i) { int R, C; stage_rc(tid * 16 + i * 8192, R, C); const int Rb = Epi::PERM ? ((R & ~31) + perm32(R & 31)) : R;
        voffA[i] = (unsigned)(R * K + C) * 2u; voffB[i] = (unsigned)(Rb * K + C) * 2u; }
    const size_t kstep = (size_t)(BK * 2);
    const size_t hstep = (size_t)HALF * K * 2;
    const size_t tstep = 2 * hstep;
    const unsigned ldsw = (unsigned)wid * 1024u;
    const int aoff = lds_byte(wr * 64 + fr, fq * 8), boff = lds_byte(wc * 32 + fr, fq * 8);
#define PG8_SA(b, h) (((b) * 2 + (h)) * HTB)
#define PG8_SB(b, h) ((4 + (b) * 2 + (h)) * HTB)
#define PG8_STAGE(bufoff, gbase, voff) do { _Pragma("unroll") for (int _i = 0; _i < 2; ++_i) \
        __builtin_amdgcn_global_load_lds((const unsigned*)((const char*)(gbase) + (voff)[_i]), (PG8_LAS unsigned*)(lds + (bufoff) + ldsw + _i * 8192), 16, 0, 0); } while (0)
#define PG8_LDA(dst, b, h) do { _Pragma("unroll") for (int m = 0; m < 4; ++m) _Pragma("unroll") for (int k = 0; k < 2; ++k) dst[m][k] = *(const PG8_LAS bf16x8*)(lds + PG8_SA(b, h) + aoff + m * 2048 + k * 1024); } while (0)
#define PG8_LDB(dst, b, h) do { _Pragma("unroll") for (int n = 0; n < 2; ++n) _Pragma("unroll") for (int k = 0; k < 2; ++k) dst[n][k] = *(const PG8_LAS bf16x8*)(lds + PG8_SB(b, h) + boff + n * 2048 + k * 1024); } while (0)
#define PG8_MMA(ai, bj, At, Bt) do { __builtin_amdgcn_s_setprio(1); _Pragma("unroll") for (int m = 0; m < 4; ++m) _Pragma("unroll") for (int n = 0; n < 2; ++n) _Pragma("unroll") for (int k = 0; k < 2; ++k) \
        acc[ai][bj][m][n] = __builtin_amdgcn_mfma_f32_16x16x32_bf16(Bt[n][k], At[m][k], acc[ai][bj][m][n], 0, 0, 0); __builtin_amdgcn_s_setprio(0); } while (0)
#define PG8_WAIT_V(n) asm volatile("s_waitcnt vmcnt(" #n ")" ::: "memory")
#define PG8_WAIT_L(n) asm volatile("s_waitcnt lgkmcnt(" #n ")" ::: "memory")
#define PG8_BAR __builtin_amdgcn_s_barrier()
#define PG8_SCHED __builtin_amdgcn_sched_barrier(0)
    Unit cur, nxt; int ui = 0;
    if (!S.next(0, cur)) return;
    f32x4 acc[2][2][4][2];
#pragma unroll
    for (int a = 0; a < 2; ++a)
#pragma unroll
        for (int b = 0; b < 2; ++b)
#pragma unroll
            for (int m = 0; m < 4; ++m)
#pragma unroll
                for (int n = 0; n < 2; ++n) acc[a][b][m][n] = (f32x4){0.f, 0.f, 0.f, 0.f};
    bf16x8 At[4][2], B0[2][2], B1[2][2];
    const char* cA = (const char*)g.A + (size_t)cur.pm * tstep; const char* cB = (const char*)g.Bt + (size_t)cur.pn * tstep;
    S.a_ready(cur);
    if constexpr (SP2) {
        PG8_STAGE(PG8_SB(0, 0), cB, voffB); PG8_STAGE(PG8_SB(0, 1), cB + hstep, voffB); PG8_STAGE(PG8_SA(0, 0), cA, voffA); PG8_STAGE(PG8_SA(0, 1), cA + hstep, voffA);
        if (wr == 1) PG8_BAR;
        PG8_WAIT_V(2); PG8_BAR;
        PG8_STAGE(PG8_SB(1, 0), cB + kstep, voffB); PG8_STAGE(PG8_SA(1, 0), cA + kstep, voffA); PG8_STAGE(PG8_SB(1, 1), cB + hstep + kstep, voffB);
        PG8_WAIT_V(6); PG8_BAR;
    } else {
        PG8_STAGE(PG8_SB(0, 0), cB, voffB); PG8_STAGE(PG8_SA(0, 0), cA, voffA); PG8_STAGE(PG8_SB(0, 1), cB + hstep, voffB); PG8_STAGE(PG8_SA(0, 1), cA + hstep, voffA);
        if (wr == 1) PG8_BAR;
        PG8_WAIT_V(4); PG8_BAR;
        PG8_STAGE(PG8_SB(1, 0), cB + kstep, voffB); PG8_STAGE(PG8_SA(1, 0), cA + kstep, voffA); PG8_STAGE(PG8_SB(1, 1), cB + hstep + kstep, voffB);
        PG8_WAIT_V(6); PG8_BAR;
    }
    for (;;) {
        const bool has_next = S.next(ui + 1, nxt);
        const char* nA = has_next ? (const char*)g.A + (size_t)nxt.pm * tstep : cA; const char* nB = has_next ? (const char*)g.Bt + (size_t)nxt.pn * tstep : cB;
        for (int t = 0; t < nt; t += 2) {
            const bool last = (t == nt - 2);
            const char* a1 = cA + (size_t)(t + 1) * kstep;
            const char* a2 = last ? nA : cA + (size_t)(t + 2) * kstep; const char* b2 = last ? nB : cB + (size_t)(t + 2) * kstep;
            const char* a3 = a2 + kstep; const char* b3 = b2 + kstep;
            if (last && has_next) S.a_ready(nxt);
            if constexpr (SP2) {
            PG8_LDB(B0, 0, 0); PG8_LDB(B1, 0, 1); PG8_SCHED; PG8_LDA(At, 0, 0); PG8_STAGE(PG8_SA(1, 1), a1 + hstep, voffA);
            PG8_WAIT_V(8); PG8_WAIT_L(0); PG8_BAR; PG8_MMA(0, 0, At, B0); PG8_MMA(0, 1, At, B1); PG8_BAR; PG8_SCHED;
            PG8_LDA(At, 0, 1); PG8_STAGE(PG8_SB(0, 0), b2, voffB); PG8_STAGE(PG8_SB(0, 1), b2 + hstep, voffB); PG8_STAGE(PG8_SA(0, 0), a2, voffA);
            PG8_WAIT_V(8); PG8_WAIT_L(0); PG8_BAR; PG8_MMA(1, 0, At, B0); PG8_MMA(1, 1, At, B1); PG8_BAR; PG8_SCHED;
            PG8_LDB(B0, 1, 0); PG8_LDB(B1, 1, 1); PG8_SCHED; PG8_LDA(At, 1, 0); PG8_STAGE(PG8_SA(0, 1), a2 + hstep, voffA);
            PG8_WAIT_V(8); PG8_WAIT_L(0); PG8_BAR; PG8_MMA(0, 0, At, B0); PG8_MMA(0, 1, At, B1); PG8_BAR; PG8_SCHED;
            PG8_LDA(At, 1, 1); PG8_STAGE(PG8_SB(1, 0), b3, voffB); PG8_STAGE(PG8_SB(1, 1), b3 + hstep, voffB); PG8_STAGE(PG8_SA(1, 0), a3, voffA);
            PG8_WAIT_V(8); PG8_WAIT_L(0); PG8_BAR; PG8_MMA(1, 0, At, B0); PG8_MMA(1, 1, At, B1); PG8_BAR; PG8_SCHED;
            } else {
            PG8_LDB(B0, 0, 0); PG8_SCHED; PG8_LDA(At, 0, 0); PG8_STAGE(PG8_SA(1, 1), a1 + hstep, voffA);
            PG8_WAIT_L(8); PG8_BAR; PG8_WAIT_L(0); PG8_MMA(0, 0, At, B0); PG8_BAR; PG8_SCHED;
            PG8_LDB(B1, 0, 1); PG8_STAGE(PG8_SB(0, 0), b2, voffB);
            PG8_BAR; PG8_WAIT_L(0); PG8_MMA(0, 1, At, B1); PG8_BAR;
            PG8_LDA(At, 0, 1); PG8_STAGE(PG8_SA(0, 0), a2, voffA);
            PG8_BAR; PG8_WAIT_L(0); PG8_MMA(1, 0, At, B0); PG8_BAR; PG8_SCHED;
            PG8_STAGE(PG8_SB(0, 1), b2 + hstep, voffB);
            PG8_WAIT_V(6); PG8_BAR; PG8_MMA(1, 1, At, B1); PG8_BAR;
            PG8_LDB(B0, 1, 0); PG8_SCHED; PG8_LDA(At, 1, 0); PG8_STAGE(PG8_SA(0, 1), a2 + hstep, voffA);
            PG8_WAIT_L(8); PG8_BAR; PG8_WAIT_L(0); PG8_MMA(0, 0, At, B0); PG8_BAR; PG8_SCHED;
            PG8_LDB(B1, 1, 1); PG8_STAGE(PG8_SB(1, 0), b3, voffB);
            PG8_BAR; PG8_WAIT_L(0); PG8_MMA(0, 1, At, B1); PG8_BAR;
            PG8_LDA(At, 1, 1); PG8_STAGE(PG8_SA(1, 0), a3, voffA);
            PG8_BAR; PG8_WAIT_L(0); PG8_MMA(1, 0, At, B0); PG8_BAR; PG8_SCHED;
            PG8_STAGE(PG8_SB(1, 1), b3 + hstep, voffB);
            PG8_WAIT_V(6); PG8_BAR; PG8_MMA(1, 1, At, B1); PG8_BAR;
            }
        }
        if constexpr (ALIGN_EPI) { if (wr == 0) PG8_BAR; }
        if constexpr (!Epi::AFTER_DRAIN) { E(acc, cur, wr, wc, fr, fq); S.done(cur); }
        if (!has_next) break;
#pragma unroll
        for (int a = 0; a < 2; ++a)
#pragma unroll
            for (int b = 0; b < 2; ++b)
#pragma unroll
                for (int m = 0; m < 4; ++m)
#pragma unroll
                    for (int n = 0; n < 2; ++n) acc[a][b][m][n] = (f32x4){0.f, 0.f, 0.f, 0.f};
        cur = nxt; cA = nA; cB = nB; ++ui;
        if constexpr (ALIGN_EPI) { if (wr == 1) PG8_BAR; }
    }
    PG8_WAIT_V(0);
    if constexpr (!ALIGN_EPI) { if (wr == 0) PG8_BAR; }
    PG8_BAR;
    if constexpr (Epi::AFTER_DRAIN) { E.fused(acc, cur, wr, wc, fr, fq, lds, wid, lane); S.done(cur); }
#undef PG8_SA
#undef PG8_SB
#undef PG8_STAGE
#undef PG8_LDA
#undef PG8_LDB
#undef PG8_MMA
#undef PG8_WAIT_V
#undef PG8_WAIT_L
#undef PG8_BAR
#undef PG8_SCHED
}
}
namespace cg = cooperative_groups;
#define DI __device__ __forceinline__
#define LAS __attribute__((address_space(3)))
typedef unsigned short bf16;
typedef float f32x4 __attribute__((ext_vector_type(4)));
typedef unsigned u32x4 __attribute__((ext_vector_type(4)));
typedef unsigned u32x2 __attribute__((ext_vector_type(2)));

constexpr int BATCH = 2, SEQ = 16384, DM = 1024, T = BATCH * SEQ, DEPTH = 2;
constexpr int NEXP = 32, RZP = 1824;
constexpr int RMAX = 73728;
constexpr float C2 = 0.125f * 1.4426950408889634f;
constexpr float LOG2E = 1.4426950408889634f;
constexpr size_t MiB = 1u << 20;
constexpr size_t WS_CTL = 0, CTL_BYTES = 1 * MiB;
constexpr size_t WS_WIN = 1 * MiB, WS_WG = 9 * MiB, WS_WBR = 15 * MiB, WS_WOUT = 18 * MiB;
constexpr size_t WS_KMEAN = 20 * MiB, WS_RWG = 20 * MiB + 512 * 1024, WS_ROUTE = 21 * MiB, WS_RWT = 22 * MiB, WS_DEST = 22 * MiB + 512 * 1024, WS_BONUS = 23 * MiB;
constexpr size_t WS_XB = 32 * MiB, WS_VFIRST = 96 * MiB, WS_YPOOL = 128 * MiB, WS_YATTN = 160 * MiB;
constexpr size_t WS_BIG = 192 * MiB;
constexpr size_t WS_Q = WS_BIG, WS_K = WS_BIG + 32 * MiB, WS_V = WS_BIG + 64 * MiB, WS_POOLZ = WS_BIG + 232 * MiB, WS_RWKVZ = WS_BIG + 264 * MiB;
constexpr size_t WS_AR = WS_BIG;
constexpr size_t WS_GATES = WS_BIG + 32 * MiB;
constexpr size_t WS_XPERM = WS_BIG, WS_HACT = WS_BIG + 144 * MiB, WS_W13 = WS_BIG + 216 * MiB, WS_W2 = WS_BIG + 280 * MiB, WS_YMOE = WS_BIG;
constexpr size_t WS_END = WS_BIG + 378 * MiB;
static_assert(WS_RWKVZ + (size_t)T * RZP * 2 <= WS_END, "ws map");
static_assert(WS_W2 + (size_t)32 * 1024 * 512 * 2 <= WS_END, "ws map");
constexpr int CW_CNT = 64, CW_BAR = 4096;
constexpr int LDS_BYTES = 147456, MISC_OFF = 131072;

DI float bf2f(unsigned short u) { return __uint_as_float((unsigned)u << 16); }
DI unsigned f2bf(float f) { unsigned u = __float_as_uint(f); return (u + 0x7fffu + ((u >> 16) & 1u)) >> 16; }
DI unsigned pk2(float lo, float hi) { return f2bf(lo) | (f2bf(hi) << 16); }
DI float blo(unsigned w) { return __uint_as_float(w << 16); }
DI float bhi(unsigned w) { return __uint_as_float(w & 0xffff0000u); }
DI float wave_sum(float v) {
#pragma unroll
    for (int o = 1; o < 64; o <<= 1) v += __shfl_xor(v, o);
    return v;
}
DI float wave_max(float v) {
#pragma unroll
    for (int o = 1; o < 64; o <<= 1) v = fmaxf(v, __shfl_xor(v, o));
    return v;
}
DI float sigmoidf_(float x) { return 1.0f / (1.0f + __expf(-x)); }
#define LDS_WAIT() asm volatile("s_waitcnt lgkmcnt(0)" ::: "memory")

#define XB_TMO      128
#define XB_XCNT(j)  (256  + 64 * (j))
#define XB_XSUB(j)  (1280 + 64 * (j))
#define XB_XGEN(j)  (2304 + 64 * (j))
#define XB_TOP      3328
#define XB_TOPGEN   3392
#define XCD_BAR_WORDS 3456
#define XB_SPIN_CAP (1u << 27)

__device__ __forceinline__ unsigned xb_ld(unsigned* p)              { return __hip_atomic_load(p, __ATOMIC_RELAXED, __HIP_MEMORY_SCOPE_AGENT); }
__device__ __forceinline__ unsigned xb_add(unsigned* p, unsigned v) { return __hip_atomic_fetch_add(p, v, __ATOMIC_RELAXED, __HIP_MEMORY_SCOPE_AGENT); }
__device__ __forceinline__ unsigned xb_xcc_id() { return (unsigned)__builtin_amdgcn_s_getreg((3 << 11) | 20) & 0xFu; }
#define XB_SPIN(cond, bar) do { unsigned _sp = 0; while (cond) { __builtin_amdgcn_s_sleep(1); \
    if ((++_sp & 255u) == 0u) { if (xb_ld(&(bar)[XB_TMO])) break; if (_sp > XB_SPIN_CAP) { atomicAdd(&(bar)[XB_TMO], 1u); break; } } } } while (0)

struct XcdBarrier {
    unsigned* bar; unsigned x;
    volatile LAS unsigned* st;
};

__device__ __forceinline__ XcdBarrier xcd_barrier_post(unsigned* bar, volatile LAS unsigned* st) {
    XcdBarrier b; b.bar = bar; b.x = xb_xcc_id(); b.st = st;
    if (threadIdx.x == 0) (void)xb_add(&bar[XB_XCNT(b.x)], 1u);
    return b;
}
__device__ __forceinline__ void xcd_barrier_complete(unsigned* bar, unsigned x, unsigned& nloc, unsigned& nx) {
    const unsigned G = gridDim.x * gridDim.y * gridDim.z;
    unsigned sum, cnt, mine, sp = 0u;
    for (;;) {
        sum = 0u; cnt = 0u; mine = 0u;
#pragma unroll
        for (unsigned j = 0; j < 16; ++j) { const unsigned c = xb_ld(&bar[XB_XCNT(j)]); sum += c; cnt += (c > 0u) ? 1u : 0u; mine = (j == x) ? c : mine; }
        if (sum == G) break;
        __builtin_amdgcn_s_sleep(1);
        if ((++sp & 255u) == 0u) { if (xb_ld(&bar[XB_TMO])) break; if (sp > XB_SPIN_CAP) { atomicAdd(&bar[XB_TMO], 1u); break; } }
    }
    nloc = mine > 0u ? mine : 1u; nx = cnt > 0u ? cnt : 1u;
}

__device__ __forceinline__ void xcd_barrier(const XcdBarrier& b) {
    asm volatile("s_waitcnt vmcnt(0)" ::: "memory");
    __syncthreads();
    if (threadIdx.x == 0) {
        unsigned* bar = b.bar;
        __builtin_amdgcn_s_waitcnt(0);
        unsigned nloc = b.st[0], nx = b.st[1];
        if (nloc == 0u) { xcd_barrier_complete(bar, b.x, nloc, nx); b.st[0] = nloc; b.st[1] = nx; }
        const unsigned old = xb_add(&bar[XB_XSUB(b.x)], 1u);
        const unsigned gen = old / nloc;
        if (old + 1u == (gen + 1u) * nloc) {
            __builtin_amdgcn_fence(__ATOMIC_RELEASE, "agent");
            asm volatile("s_waitcnt vmcnt(0)" ::: "memory");
            const unsigned og = xb_add(&bar[XB_TOP], 1u);
            const unsigned tg = og / nx;
            if (og + 1u == (tg + 1u) * nx) xb_add(&bar[XB_TOPGEN], 1u);
            else XB_SPIN(xb_ld(&bar[XB_TOPGEN]) == tg, bar);
            __builtin_amdgcn_fence(__ATOMIC_ACQUIRE, "agent");
            xb_add(&bar[XB_XGEN(b.x)], 1u);
            asm volatile("s_waitcnt vmcnt(0)" ::: "memory");
        } else {
            XB_SPIN(xb_ld(&bar[XB_XGEN(b.x)]) == gen, bar);
            __builtin_amdgcn_fence(__ATOMIC_ACQUIRE, "agent");
            asm volatile("s_waitcnt vmcnt(0)" ::: "memory");
        }
    }
    __syncthreads();
}

struct Args { const float* in[31]; float* out; unsigned char* ws; };

typedef const __attribute__((address_space(4))) unsigned long long* kargp_t;
struct Frame {
    LAS unsigned char* lds; int tid, lane, wave, G, bid;
    kargp_t kp;
};
DI const float* INP(const Frame& F, int i) { return (const float*)F.kp[i]; }
DI float* OUTP(const Frame& F) { return (float*)F.kp[31]; }
DI unsigned char* WSP(const Frame& F) { return (unsigned char*)F.kp[32]; }
DI void fence_frame(Frame& F) {
    asm volatile("" : "+s"(F.kp) :: "memory"); asm volatile("" : "+s"(F.G)); asm volatile("" : "+s"(F.bid));
    asm volatile("" : "+v"(F.tid)); F.lane = F.tid & 63; F.wave = __builtin_amdgcn_readfirstlane(F.tid >> 6); }

DI void transpose_item(const float* W, int ldw, int ncols, bf16* WT, int ldt, const float* scale, LAS float* scr, int item, int lane) {
    const int nblk = ncols / 32, kb = item / nblk, nb = item % nblk, k0 = 64 * kb, n0 = 32 * nb;
#pragma unroll 8
    for (int i = 0; i < 32; ++i) { const int kk = 2 * i + (lane >> 5); float v = W[(size_t)(k0 + kk) * ldw + n0 + (lane & 31)]; if (scale) v *= scale[k0 + kk]; scr[kk * 33 + (lane & 31)] = v; }
    LDS_WAIT(); asm volatile("" ::: "memory");
    const int c = lane & 7;
#pragma unroll
    for (int j = 0; j < 4; ++j) { const int n = (lane >> 3) + 8 * j; const LAS float* s = scr + (8 * c) * 33 + n;
        u32x4 o; o.x = pk2(s[0 * 33], s[1 * 33]); o.y = pk2(s[2 * 33], s[3 * 33]); o.z = pk2(s[4 * 33], s[5 * 33]); o.w = pk2(s[6 * 33], s[7 * 33]);
        *(u32x4*)(WT + (size_t)(n0 + n) * ldt + k0 + 8 * c) = o; }
    LDS_WAIT(); asm volatile("" ::: "memory");
}
DI void prep_mixer_weights(Frame& F, int l) {
    LAS float* scr = (LAS float*)(F.lds + F.wave * 16384);
    const int gw = F.bid * 8 + F.wave, NGW = F.G * 8;
    const float* w_in = INP(F, 2) + (size_t)l * 1024 * 6912; const float* g1 = INP(F, 1) + l * 1024;
    bf16* WIN = (bf16*)(WSP(F) + WS_WIN); bf16* WG = (bf16*)(WSP(F) + WS_WG); bf16* WBR = (bf16*)(WSP(F) + WS_WBR); bf16* WOUT = (bf16*)(WSP(F) + WS_WOUT);
    constexpr int I1 = 16 * (1536 / 32), I2 = 16 * (2304 / 32), I3 = 16 * 1, I4 = 16 * (3072 / 32), I5 = 8 * (1024 / 32), I6 = 16 * (1024 / 32);
    const int n3 = l > 0 ? I3 : 0;
    const int total = I1 + I2 + n3 + I4 + 3 * I5 + I6;
    for (int it = gw; it < total; it += NGW) {
        int r = it;
        if (r < I1) { transpose_item(w_in, 6912, 1536, WIN, 1024, g1, scr, r, F.lane); continue; } r -= I1;
        if (r < I2) { transpose_item(w_in + 4608, 6912, 2304, WIN + (size_t)1536 * 1024, 1024, g1, scr, r, F.lane); continue; } r -= I2;
        if (r < n3) { transpose_item(INP(F, 3) + (size_t)(l - 1) * 1024 * 32, 32, 32, WIN + (size_t)3840 * 1024, 1024, g1, scr, r, F.lane); continue; } r -= n3;
        if (r < I4) { transpose_item(w_in + 1536, 6912, 3072, WG, 1024, g1, scr, r, F.lane); continue; } r -= I4;
        if (r < 3 * I5) { const int i = r / I5; transpose_item(INP(F, 20) + (size_t)(l * 3 + i) * 512 * 1024, 1024, 1024, WBR + (size_t)i * 1024 * 512, 512, i == 2 ? INP(F, 19) + l * 512 : nullptr, scr, r % I5, F.lane); continue; } r -= 3 * I5;
        transpose_item(INP(F, 21) + (size_t)l * 1024 * 1024, 1024, 1024, WOUT, 1024, nullptr, scr, r, F.lane);
    }
    if (l > 0) {
        u32x4* z = (u32x4*)(WIN + (size_t)3872 * 1024); const int n16 = 224 * 1024 * 2 / 16;
        for (int i = F.bid * 512 + F.tid; i < n16; i += F.G * 512) z[i] = (u32x4){0u, 0u, 0u, 0u};
    }
    { float* rwg = (float*)(WSP(F) + WS_RWG); const float* g2 = INP(F, 22) + l * 1024; const float* rgw = INP(F, 23) + (size_t)l * 1024 * 4; const float* rew = INP(F, 25) + (size_t)l * 1024 * 32;
      for (int i = F.bid * 512 + F.tid; i < 36 * 1024; i += F.G * 512) { const int j = i >> 10, k = i & 1023; rwg[i] = g2[k] * (j < 4 ? rgw[k * 4 + j] : rew[k * 32 + (j - 4)]); } }
}
DI void prep_expert_weights(Frame& F, int l) {
    LAS float* scr = (LAS float*)(F.lds + F.wave * 16384);
    const int gw = F.bid * 8 + F.wave, NGW = F.G * 8;
    const float* g2 = INP(F, 22) + l * 1024;
    bf16* W13 = (bf16*)(WSP(F) + WS_W13); bf16* W2 = (bf16*)(WSP(F) + WS_W2);
    constexpr int J13 = 64, N13 = NEXP * 2 * 4 * J13, J2 = 8 * 32, N2 = NEXP * J2;
    for (int it = gw; it < N13 + N2; it += NGW) {
        if (it < N13) { const int job = it / J13, item = it % J13, e = job >> 3, which = (job >> 2) & 1, grp = job & 3;
            const float* src = (which ? INP(F, 28) : INP(F, 27)) + ((size_t)(l * NEXP + e) * 1024) * 512 + grp * 128;
            transpose_item(src, 512, 128, W13 + ((size_t)e * 1024 + grp * 256 + which * 128) * 1024, 1024, g2, scr, item, F.lane);
        } else { const int r = it - N13, e = r / J2, item = r % J2;
            transpose_item(INP(F, 29) + (size_t)(l * NEXP + e) * 512 * 1024, 1024, 1024, W2 + (size_t)e * 1024 * 512, 512, nullptr, scr, item, F.lane); }
    }
}
DI void rms_rows_to_bf16(Frame& F, const float* x, bf16* xb) {
    const int gw = F.bid * 8 + F.wave, NGW = F.G * 8;
    for (int t = gw; t < T; t += NGW) {
        const f32x4* xr = (const f32x4*)(x + (size_t)t * DM) + F.lane; f32x4 v[4]; float s = 0.f;
#pragma unroll
        for (int j = 0; j < 4; ++j) { v[j] = xr[64 * j]; s += (v[j].x * v[j].x + v[j].y * v[j].y) + (v[j].z * v[j].z + v[j].w * v[j].w); }
        const float rs = rsqrtf(wave_sum(s) * (1.f / DM) + 1e-6f);
        u32x2* o = (u32x2*)(xb + (size_t)t * DM) + F.lane;
#pragma unroll
        for (int j = 0; j < 4; ++j) o[64 * j] = (u32x2){pk2(v[j].x * rs, v[j].y * rs), pk2(v[j].z * rs, v[j].w * rs)};
    }
}

DI void kmean_phase(Frame& F) {
    const bf16* K = (const bf16*)(WSP(F) + WS_K); float* kmean = (float*)(WSP(F) + WS_KMEAN);
    LAS float* red = (LAS float*)F.lds;
    for (int it = F.bid; it < BATCH * 8 * 64; it += F.G) {
        const int b = it >> 9, h = (it >> 6) & 7, n = it & 63, d = F.lane, part = F.wave;
        const bf16* kp = K + ((size_t)b * SEQ + n * 256 + part * 32) * 512 + h * 64 + d; float s = 0.f;
#pragma unroll 8
        for (int i = 0; i < 32; ++i) s += bf2f(kp[(size_t)i * 512]);
        red[part * 64 + d] = s;
        __syncthreads();
        if (F.tid < 64) { float a = 0.f;
#pragma unroll
            for (int p = 0; p < 8; ++p) a += red[p * 64 + F.tid];
            kmean[(size_t)it * 64 + F.tid] = a * (1.f / 256.f); }
        __syncthreads();
    }
}
DI void attn_naive_phase(Frame& F) {
    const bf16* Q = (const bf16*)(WSP(F) + WS_Q); const bf16* K = (const bf16*)(WSP(F) + WS_K); const bf16* V = (const bf16*)(WSP(F) + WS_V);
    const float* kmean = (const float*)(WSP(F) + WS_KMEAN); bf16* Y = (bf16*)(WSP(F) + WS_YATTN);
    LAS float* pbuf = (LAS float*)(F.lds + F.wave * 8192); LAS float* qbuf = pbuf + 1024;
    const int gw = F.bid * 8 + F.wave, NGW = F.G * 8, lane = F.lane;
    const float NEG = -INFINITY;
    for (int it = gw; it < T * 8; it += NGW) {
        const int t = it >> 3, h = it & 7, b = t / SEQ, tl = t % SEQ, own = tl >> 8;
        const float slope2 = exp2f(-(float)(h + 1)) * LOG2E;
        qbuf[lane] = bf2f(Q[(size_t)t * 512 + h * 64 + lane]);
        LDS_WAIT(); asm volatile("" ::: "memory");
        float q[64];
#pragma unroll
        for (int i = 0; i < 16; ++i) { const f32x4 v = ((const LAS f32x4*)qbuf)[i]; q[4 * i] = v.x; q[4 * i + 1] = v.y; q[4 * i + 2] = v.z; q[4 * i + 3] = v.w; }
        float g = NEG;
        if (lane < own) { const f32x4* km = (const f32x4*)(kmean + ((size_t)(b * 8 + h) * 64 + lane) * 64); float s = 0.f;
#pragma unroll
            for (int i = 0; i < 16; ++i) { const f32x4 v = km[i]; s += q[4 * i] * v.x + q[4 * i + 1] * v.y + q[4 * i + 2] * v.z + q[4 * i + 3] * v.w; }
            g = s; }
        int sel[4];
#pragma unroll
        for (int j = 0; j < 3; ++j) { const float m = wave_max(g); const unsigned long long bal = __ballot(g == m); const int idx = __ffsll((long long)bal) - 1;
            sel[j] = (m > NEG) ? idx : -1; if (lane == idx) g = NEG; }
        sel[3] = own;
        float sc[4][4]; float mx = NEG;
#pragma unroll
        for (int jb = 0; jb < 4; ++jb) { const int n = sel[jb];
#pragma unroll
            for (int i = 0; i < 4; ++i) { float s = NEG;
                if (n >= 0) { const int key = n * 256 + i * 64 + lane; const u32x4* kr = (const u32x4*)(K + ((size_t)b * SEQ + key) * 512 + h * 64); float d = 0.f;
#pragma unroll
                    for (int c = 0; c < 8; ++c) { const u32x4 w = kr[c]; d += q[8 * c] * blo(w.x) + q[8 * c + 1] * bhi(w.x) + q[8 * c + 2] * blo(w.y) + q[8 * c + 3] * bhi(w.y) + q[8 * c + 4] * blo(w.z) + q[8 * c + 5] * bhi(w.z) + q[8 * c + 6] * blo(w.w) + q[8 * c + 7] * bhi(w.w); }
                    s = d - slope2 * (float)(tl - key); if (key > tl) s = NEG; }
                sc[jb][i] = s; mx = fmaxf(mx, s); } }
        mx = wave_max(mx);
        float lsum = 0.f;
#pragma unroll
        for (int jb = 0; jb < 4; ++jb)
#pragma unroll
            for (int i = 0; i < 4; ++i) { const float p = (sc[jb][i] == NEG) ? 0.f : exp2f(sc[jb][i] - mx); lsum += p; pbuf[jb * 256 + i * 64 + lane] = p; }
        lsum = wave_sum(lsum);
        LDS_WAIT(); asm volatile("" ::: "memory");
        const int dg = lane & 15, kq = lane >> 4; float o0 = 0.f, o1 = 0.f, o2 = 0.f, o3 = 0.f;
#pragma unroll
        for (int jb = 0; jb < 4; ++jb) { const int n = sel[jb]; if (n < 0) continue;
            const bf16* vb = V + ((size_t)b * SEQ + n * 256) * 512 + h * 64 + dg * 4; const int nk = (jb == 3) ? (tl - own * 256 + 1) : 256;
            for (int kk = kq; kk < nk; kk += 4) { const float p = pbuf[jb * 256 + kk]; const u32x2 w = *(const u32x2*)(vb + (size_t)kk * 512);
                o0 += p * blo(w.x); o1 += p * bhi(w.x); o2 += p * blo(w.y); o3 += p * bhi(w.y); } }
        o0 += __shfl_xor(o0, 16); o1 += __shfl_xor(o1, 16); o2 += __shfl_xor(o2, 16); o3 += __shfl_xor(o3, 16);
        o0 += __shfl_xor(o0, 32); o1 += __shfl_xor(o1, 32); o2 += __shfl_xor(o2, 32); o3 += __shfl_xor(o3, 32);
        const float inv = 1.0f / lsum;
        if (kq == 0) *(u32x2*)(Y + (size_t)t * 512 + h * 64 + dg * 4) = (u32x2){pk2(o0 * inv, o1 * inv), pk2(o2 * inv, o3 * inv)};
        LDS_WAIT(); asm volatile("" ::: "memory");
    }
}
DI void pool_phase(Frame& F, int l) {
    const bf16* Z = (const bf16*)(WSP(F) + WS_POOLZ); bf16* Y = (bf16*)(WSP(F) + WS_YPOOL);
    LAS float* Wl = (LAS float*)F.lds;
    LAS float* Pl = (LAS float*)(F.lds + 65536);
    for (int g = 0; g < 4; ++g) {
        const int win = 2 << g; const float* pw = INP(F, 18) + ((size_t)(l * 4 + g) * 128) * 128;
        __syncthreads();
        for (int i = F.tid; i < 128 * 128 / 4; i += 512) ((LAS f32x4*)Wl)[i] = ((const f32x4*)pw)[i];
        for (int tile = F.bid; tile < T / 64; tile += F.G) {
            __syncthreads();
            for (int i = F.tid; i < 64 * 16; i += 512) { const int tt = i >> 4, cc = (i & 15) * 8, t = tile * 64 + tt, tl = t % SEQ; const int cnt = (tl + 1 < win) ? tl + 1 : win;
                float s[8] = {0.f, 0.f, 0.f, 0.f, 0.f, 0.f, 0.f, 0.f}, z0[8];
                for (int j = 0; j < cnt; ++j) { const u32x4 w = *(const u32x4*)(Z + (size_t)(t - j) * 512 + g * 128 + cc);
                    const float f[8] = {blo(w.x), bhi(w.x), blo(w.y), bhi(w.y), blo(w.z), bhi(w.z), blo(w.w), bhi(w.w)};
#pragma unroll
                    for (int e = 0; e < 8; ++e) { s[e] += f[e]; if (j == 0) z0[e] = f[e]; } }
                const float inv = 1.0f / (float)cnt;
#pragma unroll
                for (int e = 0; e < 8; ++e) Pl[tt * 129 + cc + e] = s[e] * inv - z0[e]; }
            __syncthreads();
            const int tt = F.tid >> 3, d0 = (F.tid & 7) * 16; float acc[16];
#pragma unroll
            for (int e = 0; e < 16; ++e) acc[e] = 0.f;
            for (int c = 0; c < 128; ++c) { const float p = Pl[tt * 129 + c]; const LAS f32x4* wr = (const LAS f32x4*)(Wl + c * 128 + d0);
#pragma unroll
                for (int e4 = 0; e4 < 4; ++e4) { const f32x4 w = wr[e4]; acc[4 * e4] += p * w.x; acc[4 * e4 + 1] += p * w.y; acc[4 * e4 + 2] += p * w.z; acc[4 * e4 + 3] += p * w.w; } }
            u32x4* o = (u32x4*)(Y + (size_t)(tile * 64 + tt) * 512 + g * 128 + d0);
            o[0] = (u32x4){pk2(acc[0], acc[1]), pk2(acc[2], acc[3]), pk2(acc[4], acc[5]), pk2(acc[6], acc[7])};
            o[1] = (u32x4){pk2(acc[8], acc[9]), pk2(acc[10], acc[11]), pk2(acc[12], acc[13]), pk2(acc[14], acc[15])};
        }
    }
    __syncthreads();
}
DI void rwkv_prep_phase(Frame& F, int l) {
    const bf16* RZ = (const bf16*)(WSP(F) + WS_RWKVZ); bf16* VF = (bf16*)(WSP(F) + WS_VFIRST);
    bf16* AR = (bf16*)(WSP(F) + WS_AR); const size_t AS = (size_t)T * 512;
    float* bonus = (float*)(WSP(F) + WS_BONUS);
    LAS float* A = (LAS float*)F.lds;
    const int ch = F.tid, h = F.wave, lane = F.lane;
    const float* mu = INP(F, 4) + l * 1792; const float* vmu = INP(F, 5) + (l > 0 ? (l - 1) * 32 : 0);
    const float* Wdu = INP(F, 7) + (size_t)l * 64 * 512; const float* Wiu = INP(F, 9) + (size_t)l * 64 * 512; const float* Wgu = INP(F, 10) + (size_t)l * 128 * 512;
    const float* Wvu = INP(F, 17) + (size_t)(l > 0 ? l - 1 : 0) * 32 * 512;
    const float w0 = INP(F, 6)[l * 512 + ch], a0 = INP(F, 8)[l * 512 + ch], kkc = INP(F, 11)[l * 512 + ch], kac = INP(F, 12)[l * 512 + ch], rkc = INP(F, 13)[l * 512 + ch];
    const float v0 = l > 0 ? INP(F, 16)[(l - 1) * 512 + ch] : 0.f;
    const float mur = mu[ch], muk = mu[512 + ch], muv = mu[1024 + ch];
    const int nk = l > 0 ? 288 : 256;
    for (int item = F.bid; item < T / 8; item += F.G) {
        const int t0 = item * 8, tl0 = t0 % SEQ;
        __syncthreads();
        for (int i = F.tid; i < 8 * nk; i += 512) { const int tok = i / nk, k = i % nk, col = 1536 + k; const size_t t = (size_t)(t0 + tok);
            const float zc = bf2f(RZ[t * RZP + col]); const float zp = (tl0 + tok == 0) ? 0.f : bf2f(RZ[(t - 1) * RZP + col]);
            const float m = col < 1792 ? mu[col] : vmu[col - 1792]; const float zs = zc + (zp - zc) * m;
            float f; if (k < 64) f = tanhf(zs); else if (k < 128) f = zs; else if (k < 256) f = sigmoidf_(zs); else f = zs;
            A[k * 8 + tok] = f; }
        __syncthreads();
        float aw[8], aa[8], ag[8], av[8];
#pragma unroll
        for (int e = 0; e < 8; ++e) { aw[e] = 0.f; aa[e] = 0.f; ag[e] = 0.f; av[e] = 0.f; }
#define LORA_ACC(ACC, WP, K0, NK) _Pragma("unroll 4") for (int k = 0; k < (NK); ++k) { const float w = (WP)[(size_t)k * 512 + ch]; const LAS f32x4* ap = (const LAS f32x4*)(A + ((K0) + k) * 8); \
            _Pragma("unroll") for (int e4 = 0; e4 < 2; ++e4) { const f32x4 a = ap[e4]; ACC[4 * e4] += a.x * w; ACC[4 * e4 + 1] += a.y * w; ACC[4 * e4 + 2] += a.z * w; ACC[4 * e4 + 3] += a.w * w; } }
        LORA_ACC(aw, Wdu, 0, 64)
        LORA_ACC(aa, Wiu, 64, 64)
        LORA_ACC(ag, Wgu, 128, 128)
        if (l > 0) { LORA_ACC(av, Wvu, 256, 32) }
#undef LORA_ACC
        float pr, pk, pv;
        if (tl0 == 0) { pr = 0.f; pk = 0.f; pv = 0.f; } else { const bf16* zp = RZ + (size_t)(t0 - 1) * RZP; pr = bf2f(zp[ch]); pk = bf2f(zp[512 + ch]); pv = bf2f(zp[1024 + ch]); }
#pragma unroll
        for (int e = 0; e < 8; ++e) { const size_t t = (size_t)(t0 + e); const bf16* zc = RZ + t * RZP;
            const float cr = bf2f(zc[ch]), ck = bf2f(zc[512 + ch]), cv = bf2f(zc[1024 + ch]);
            const float r = cr + (pr - cr) * mur, k = ck + (pk - ck) * muk; float v = cv + (pv - cv) * muv; pr = cr; pk = ck; pv = cv;
            const float xw = -(w0 + aw[e]);
            const float sp = xw > 20.f ? xw : log1pf(__expf(xw));
            const float lw = -__expf(-sp - 0.5f);
            const float asig = sigmoidf_(a0 + aa[e]);
            const size_t idx = t * 512 + ch;
            if (l == 0) VF[idx] = (bf16)f2bf(v); else { const float vf = bf2f(VF[idx]); v = v + (vf - v) * sigmoidf_(v0 + av[e]); }
            float kk = k * kkc; const float nrm = fmaxf(sqrtf(wave_sum(kk * kk)), 1e-12f); kk = kk / nrm;
            const float kp = k * (1.0f + (asig - 1.0f) * kac);
            const float bon = wave_sum(r * kp * rkc);
            AR[idx] = (bf16)f2bf(r); AR[AS + idx] = (bf16)f2bf(lw); AR[2 * AS + idx] = (bf16)f2bf(kp); AR[3 * AS + idx] = (bf16)f2bf(v);
            AR[4 * AS + idx] = (bf16)f2bf(kk); AR[5 * AS + idx] = (bf16)f2bf(kk * asig); AR[6 * AS + idx] = (bf16)f2bf(ag[e]);
            if (lane == 0) bonus[t * 8 + h] = bon; asm volatile("" ::: "memory"); }
    }
    __syncthreads();
}
DI void rwkv_scan_phase(Frame& F, int l) {
    if (F.wave != 0 || F.bid >= BATCH * 8) return;
    const int b = F.bid >> 3, h = F.bid & 7, lane = F.lane;
    bf16* AR = (bf16*)(WSP(F) + WS_AR); const size_t AS = (size_t)T * 512; const float* bonus = (const float*)(WSP(F) + WS_BONUS);
    LAS float* sb = (LAS float*)F.lds;
    float S[64];
#pragma unroll
    for (int i = 0; i < 64; ++i) S[i] = 0.f;
    const float lg = INP(F, 14)[l * 512 + h * 64 + lane], lb = INP(F, 15)[l * 512 + h * 64 + lane];
    const size_t base = (size_t)b * SEQ * 512 + h * 64 + lane;
    for (int t0 = 0; t0 < SEQ; t0 += 8) {
#pragma unroll
        for (int s = 0; s < 8; ++s) { const size_t idx = base + (size_t)(t0 + s) * 512;
            sb[(s * 8 + 0) * 64 + lane] = -bf2f(AR[4 * AS + idx]);
            sb[(s * 8 + 1) * 64 + lane] = bf2f(AR[5 * AS + idx]);
            sb[(s * 8 + 2) * 64 + lane] = bf2f(AR[2 * AS + idx]);
            sb[(s * 8 + 3) * 64 + lane] = __expf(bf2f(AR[AS + idx]));
            sb[(s * 8 + 4) * 64 + lane] = bf2f(AR[idx]);
            sb[(s * 8 + 5) * 64 + lane] = bf2f(AR[3 * AS + idx]);
            sb[(s * 8 + 6) * 64 + lane] = bf2f(AR[6 * AS + idx]);
            sb[(s * 8 + 7) * 64 + lane] = bonus[((size_t)b * SEQ + t0 + s) * 8 + h]; }
        LDS_WAIT(); asm volatile("" ::: "memory");
#pragma unroll 1
        for (int s = 0; s < 8; ++s) {
            const LAS f32x4* pa = (const LAS f32x4*)(sb + (s * 8 + 0) * 64); const LAS f32x4* pb = (const LAS f32x4*)(sb + (s * 8 + 1) * 64);
            const LAS f32x4* pk = (const LAS f32x4*)(sb + (s * 8 + 2) * 64); const LAS f32x4* pw = (const LAS f32x4*)(sb + (s * 8 + 3) * 64);
            const LAS f32x4* pr = (const LAS f32x4*)(sb + (s * 8 + 4) * 64);
            const float v = sb[(s * 8 + 5) * 64 + lane], gt = sb[(s * 8 + 6) * 64 + lane], bon = sb[(s * 8 + 7) * 64 + lane];
            float s0 = 0.f, s1 = 0.f, s2 = 0.f, s3 = 0.f;
#pragma unroll
            for (int i = 0; i < 16; ++i) { const f32x4 a = pa[i]; s0 += S[4 * i] * a.x; s1 += S[4 * i + 1] * a.y; s2 += S[4 * i + 2] * a.z; s3 += S[4 * i + 3] * a.w; if ((i & 7) == 7) asm volatile("" ::: "memory"); }
            const float sa = (s0 + s1) + (s2 + s3);
            float y0 = 0.f, y1 = 0.f, y2 = 0.f, y3 = 0.f;
#pragma unroll
            for (int i = 0; i < 16; ++i) { const f32x4 bb = pb[i], kk = pk[i], ww = pw[i], rr = pr[i];
                S[4 * i] = S[4 * i] * ww.x + (sa * bb.x + v * kk.x); y0 += S[4 * i] * rr.x;
                S[4 * i + 1] = S[4 * i + 1] * ww.y + (sa * bb.y + v * kk.y); y1 += S[4 * i + 1] * rr.y;
                S[4 * i + 2] = S[4 * i + 2] * ww.z + (sa * bb.z + v * kk.z); y2 += S[4 * i + 2] * rr.z;
                S[4 * i + 3] = S[4 * i + 3] * ww.w + (sa * bb.w + v * kk.w); y3 += S[4 * i + 3] * rr.w;
                if ((i & 3) == 3) asm volatile("" ::: "memory"); }
            const float y = (y0 + y1) + (y2 + y3);
            const float mean = wave_sum(y) * (1.f / 64.f), d = y - mean, var = wave_sum(d * d) * (1.f / 64.f);
            const float yn = d * rsqrtf(var + 64e-5f) * lg + lb;
            AR[base + (size_t)(t0 + s) * 512] = (bf16)f2bf((yn + bon * v) * gt);
        }
        LDS_WAIT(); asm volatile("" ::: "memory");
    }
}
DI void route_phase(Frame& F, int l) {
    const float* x = OUTP(F); bf16* h2 = (bf16*)(WSP(F) + WS_XB); const float* rwg = (const float*)(WSP(F) + WS_RWG);
    int* route = (int*)(WSP(F) + WS_ROUTE); float* rwt = (float*)(WSP(F) + WS_RWT); unsigned* cnt = (unsigned*)(WSP(F) + WS_CTL) + CW_CNT + 32 * l;
    const float* rgb = INP(F, 24) + l * 4; const float* reb = INP(F, 26) + l * 32;
    const int gw = F.bid * 8 + F.wave, NGW = F.G * 8, lane = F.lane;
    for (int t = gw; t < T; t += NGW) {
        const f32x4* xr = (const f32x4*)(x + (size_t)t * DM) + lane; f32x4 v[4]; float s = 0.f;
#pragma unroll
        for (int j = 0; j < 4; ++j) { v[j] = xr[64 * j]; s += (v[j].x * v[j].x + v[j].y * v[j].y) + (v[j].z * v[j].z + v[j].w * v[j].w); }
        const float rs = rsqrtf(wave_sum(s) * (1.f / DM) + 1e-6f);
        LAS float* lbuf = (LAS float*)(F.lds + MISC_OFF + 2048 + F.wave * 256);
#pragma unroll 1
        for (int j = 0; j < 36; ++j) { const f32x4* wr = (const f32x4*)(rwg + (size_t)j * 1024) + lane; float a = 0.f;
#pragma unroll
            for (int jj = 0; jj < 4; ++jj) { const f32x4 w = wr[64 * jj]; a += (v[jj].x * w.x + v[jj].y * w.y) + (v[jj].z * w.z + v[jj].w * w.w); }
            a = wave_sum(a) * rs + (j < 4 ? rgb[j] : reb[j - 4]); if (lane == 0) lbuf[j] = a; }
        LDS_WAIT(); asm volatile("" ::: "memory");
        float lg[36];
#pragma unroll
        for (int j = 0; j < 9; ++j) { const f32x4 q4 = ((const LAS f32x4*)lbuf)[j]; lg[4 * j] = q4.x; lg[4 * j + 1] = q4.y; lg[4 * j + 2] = q4.z; lg[4 * j + 3] = q4.w; }
        LDS_WAIT(); asm volatile("" ::: "memory");
        int grp = 0; float gm = lg[0];
#pragma unroll
        for (int j = 1; j < 4; ++j) if (lg[j] > gm) { gm = lg[j]; grp = j; }
        float gs = 0.f;
#pragma unroll
        for (int j = 0; j < 4; ++j) gs += __expf(lg[j] - gm);
        const float gprob = 1.0f / gs;
        float eg[8];
#pragma unroll
        for (int i = 0; i < 8; ++i) eg[i] = grp == 0 ? lg[4 + i] : grp == 1 ? lg[12 + i] : grp == 2 ? lg[20 + i] : lg[28 + i];
        int i0 = 0; float m0 = eg[0];
#pragma unroll
        for (int i = 1; i < 8; ++i) if (eg[i] > m0) { m0 = eg[i]; i0 = i; }
        int i1 = -1; float m1 = -INFINITY;
#pragma unroll
        for (int i = 0; i < 8; ++i) if (i != i0 && eg[i] > m1) { m1 = eg[i]; i1 = i; }
        const float e10 = __expf(m1 - m0), wa = gprob / (1.0f + e10), wb = gprob * e10 / (1.0f + e10);
        const int e0 = grp * 8 + i0, e1 = grp * 8 + i1;
        if (lane == 0) { const unsigned r0 = atomicAdd(cnt + e0, 1u), r1 = atomicAdd(cnt + e1, 1u);
            ((int4*)route)[t] = make_int4(e0, (int)r0, e1, (int)r1); ((float2*)rwt)[t] = make_float2(wa, wb); }
        u32x2* o = (u32x2*)(h2 + (size_t)t * DM) + lane;
#pragma unroll
        for (int j = 0; j < 4; ++j) o[64 * j] = (u32x2){pk2(v[j].x * rs, v[j].y * rs), pk2(v[j].z * rs, v[j].w * rs)};
    }
}
DI int moe_tables(Frame& F, int l) {
    LAS int* ps = (LAS int*)(F.lds + MISC_OFF); LAS unsigned char* te = (LAS unsigned char*)(F.lds + MISC_OFF + 256);
    const unsigned* cnt = (const unsigned*)(WSP(F) + WS_CTL) + CW_CNT + 32 * l;
    __syncthreads();
    if (F.tid == 0) { int acc = 0;
_Pragma("unroll 1")
        for (int e = 0; e < NEXP; ++e) { ps[e] = acc; const int c = (int)__hip_atomic_load(cnt + e, __ATOMIC_RELAXED, __HIP_MEMORY_SCOPE_AGENT); const int nt = (c + 255) >> 8;
_Pragma("unroll 1")
            for (int i = 0; i < nt; ++i) te[(acc >> 8) + i] = (unsigned char)e; acc += nt << 8; } ps[NEXP] = acc; }
    __syncthreads();
    return __builtin_amdgcn_readfirstlane(ps[NEXP] >> 8);
}
DI void permute_phase(Frame& F, int l) {
    moe_tables(F, l);
    const LAS int* ps = (const LAS int*)(F.lds + MISC_OFF);
    const bf16* h2 = (const bf16*)(WSP(F) + WS_XB); bf16* xp = (bf16*)(WSP(F) + WS_XPERM); const int* route = (const int*)(WSP(F) + WS_ROUTE); int* dest = (int*)(WSP(F) + WS_DEST);
    const int gw = F.bid * 8 + F.wave, NGW = F.G * 8, lane = F.lane;
    for (int t = gw; t < T; t += NGW) {
        const int4 r = ((const int4*)route)[t]; const int d0 = ps[r.x] + r.y, d1 = ps[r.z] + r.w;
        const u32x4* src = (const u32x4*)(h2 + (size_t)t * DM) + lane; u32x4* o0 = (u32x4*)(xp + (size_t)d0 * DM) + lane; u32x4* o1 = (u32x4*)(xp + (size_t)d1 * DM) + lane;
        const u32x4 a = src[0], b = src[64]; o0[0] = a; o0[64] = b; o1[0] = a; o1[64] = b;
        if (lane == 0) ((int2*)dest)[t] = make_int2(d0, d1);
    }
}
DI void combine_phase(Frame& F, int l) {
    float* x = OUTP(F); const bf16* Y = (const bf16*)(WSP(F) + WS_YMOE); const int* dest = (const int*)(WSP(F) + WS_DEST); const float* rwt = (const float*)(WSP(F) + WS_RWT);
    bf16* xb = (bf16*)(WSP(F) + WS_XB); const float* fg = INP(F, 30);
    const int gw = F.bid * 8 + F.wave, NGW = F.G * 8, lane = F.lane; const bool last = (l == DEPTH - 1);
    for (int t = gw; t < T; t += NGW) {
        const int2 d = ((const int2*)dest)[t]; const float2 w = ((const float2*)rwt)[t];
        f32x4* xr = (f32x4*)(x + (size_t)t * DM) + lane; const u32x2* y0 = (const u32x2*)(Y + (size_t)d.x * DM) + lane; const u32x2* y1 = (const u32x2*)(Y + (size_t)d.y * DM) + lane;
        f32x4 v[4]; float s = 0.f;
#pragma unroll
        for (int j = 0; j < 4; ++j) { v[j] = xr[64 * j]; const u32x2 a = y0[64 * j], b = y1[64 * j];
            v[j].x += w.x * blo(a.x) + w.y * blo(b.x); v[j].y += w.x * bhi(a.x) + w.y * bhi(b.x); v[j].z += w.x * blo(a.y) + w.y * blo(b.y); v[j].w += w.x * bhi(a.y) + w.y * bhi(b.y);
            s += (v[j].x * v[j].x + v[j].y * v[j].y) + (v[j].z * v[j].z + v[j].w * v[j].w); }
        const float rs = rsqrtf(wave_sum(s) * (1.f / DM) + 1e-6f);
        if (last) {
#pragma unroll
            for (int j = 0; j < 4; ++j) { const f32x4 g = ((const f32x4*)fg)[lane + 64 * j]; xr[64 * j] = v[j] * rs * g; }
        } else {
            u32x2* o = (u32x2*)(xb + (size_t)t * DM) + lane;
#pragma unroll
            for (int j = 0; j < 4; ++j) { xr[64 * j] = v[j]; o[64 * j] = (u32x2){pk2(v[j].x * rs, v[j].y * rs), pk2(v[j].z * rs, v[j].w * rs)}; }
        }
    }
}

DI void dump_bf16(Frame& F, const bf16* src, int pitch, int ncols, int c0) {
    float* out = OUTP(F);
    for (size_t i = (size_t)F.bid * 512 + F.tid; i < (size_t)T * ncols; i += (size_t)F.G * 512) { const size_t t = i / ncols; const int c = (int)(i % ncols); out[t * DM + c0 + c] = bf2f(src[t * pitch + c]); }
}
__global__ void __launch_bounds__(512, 2) mk_fwd(Args args) {
    extern __shared__ __attribute__((aligned(16))) unsigned char lds_raw[];
    cg::grid_group grid = cg::this_grid();
    Frame F; F.lds = (LAS unsigned char*)lds_raw; F.tid = threadIdx.x; F.lane = F.tid & 63; F.wave = __builtin_amdgcn_readfirstlane(F.tid >> 6); F.G = gridDim.x; F.bid = (int)__builtin_amdgcn_workgroup_id_x();
    F.kp = (kargp_t)__builtin_amdgcn_kernarg_segment_ptr();
    for (int u = F.tid; u < 64; u += 512) ((LAS unsigned*)(F.lds + MISC_OFF + 4096))[u] = 0u;
    __syncthreads();
    XcdBarrier bar = xcd_barrier_post((unsigned*)(WSP(F) + WS_CTL) + CW_BAR, (volatile LAS unsigned*)(F.lds + MISC_OFF + 4096));
    grid.sync();
#define GRID_BAR() do { xcd_barrier(bar); fence_frame(F); } while (0)
#define ws WSP(F)
    prep_mixer_weights(F, 0);
    rms_rows_to_bf16(F, INP(F, 0), (bf16*)(ws + WS_XB));
    GRID_BAR();
#if defined(DBG_STOP) && DBG_STOP == 10
    { pg8::Gemm g{(const bf16*)(ws + WS_XB), (const bf16*)(ws + WS_WG), T, 3072, DM}; pg8::StaticOrder S; S.init(T, 3072, F.G, (int)F.bid);
      pg8::EpiGate E{(bf16*)(ws + WS_GATES), 3072};
      pg8::gemm_phase<pg8::EpiGate, pg8::StaticOrder, true, true>(F.lds, g, S, E); }
    GRID_BAR();
    dump_bf16(F, (const bf16*)(ws + WS_GATES) + 1024, 3072, 1024, 0); return;
#endif
#pragma unroll 1
    for (int l = 0; l < DEPTH; ++l) {
        { pg8::Gemm g{(const bf16*)(ws + WS_XB), (const bf16*)(ws + WS_WIN), T, l == 0 ? 3840 : 4096, DM}; pg8::StaticOrder S; S.init(T, g.N, F.G, (int)F.bid);
          pg8::EpiZ E{(bf16*)(ws + WS_Q), (bf16*)(ws + WS_K), (bf16*)(ws + WS_V), (bf16*)(ws + WS_POOLZ), (bf16*)(ws + WS_RWKVZ), C2};
          pg8::gemm_phase<pg8::EpiZ, pg8::StaticOrder, true, true>(F.lds, g, S, E); }
        GRID_BAR();
        kmean_phase(F);
        pool_phase(F, l);
        GRID_BAR();
        attn_naive_phase(F);
        GRID_BAR();
#if defined(DBG_STOP) && DBG_STOP == 3
        dump_bf16(F, (const bf16*)(ws + WS_YATTN), 512, 512, 0); dump_bf16(F, (const bf16*)(ws + WS_YPOOL), 512, 512, 512); return;
#endif
        rwkv_prep_phase(F, l);
        GRID_BAR();
#if defined(DBG_STOP) && DBG_STOP == 4
        dump_bf16(F, (const bf16*)(ws + WS_AR) + (size_t)T * 512, 512, 512, 0); dump_bf16(F, (const bf16*)(ws + WS_AR) + (size_t)5 * T * 512, 512, 512, 512); return;
#endif
        rwkv_scan_phase(F, l);
        GRID_BAR();
#if defined(DBG_STOP) && DBG_STOP == 5
        dump_bf16(F, (const bf16*)(ws + WS_AR), 512, 512, 0); dump_bf16(F, (const bf16*)(ws + WS_YPOOL), 512, 512, 512); return;
#endif
        { pg8::Gemm g{(const bf16*)(ws + WS_XB), (const bf16*)(ws + WS_WG), T, 3072, DM}; pg8::StaticOrder S; S.init(T, 3072, F.G, (int)F.bid);
          pg8::EpiGate E{(bf16*)(ws + WS_GATES), 3072};
          pg8::gemm_phase<pg8::EpiGate, pg8::StaticOrder, true, true>(F.lds, g, S, E); }
        GRID_BAR();
#if defined(DBG_SCRUB)
        { const f32x4* xs = (const f32x4*)INP(F, 0) + (size_t)F.bid * 32768; f32x4 a = {0.f, 0.f, 0.f, 0.f};
          for (int i = F.tid; i < 32768; i += 512) a += xs[i];
          if (a.x + a.y + a.z + a.w == 12345.678f) ((float*)(ws + WS_BONUS))[F.tid] = a.x; }
        GRID_BAR();
#endif
        { pg8::StaticOrder S; S.init(T, DM, F.G, (int)F.bid);
          { pg8::Gemm g{(const bf16*)(ws + WS_YATTN), (const bf16*)(ws + WS_WBR), T, DM, 512};
            pg8::EpiMerge<true> E{(bf16*)(ws + WS_XB), DM, (const bf16*)(ws + WS_GATES), 3072, 0};
            pg8::gemm_phase<pg8::EpiMerge<true>, pg8::StaticOrder, true, true>(F.lds, g, S, E); }
          { pg8::Gemm g{(const bf16*)(ws + WS_AR), (const bf16*)(ws + WS_WBR) + (size_t)1024 * 512, T, DM, 512};
            pg8::EpiMerge<false> E{(bf16*)(ws + WS_XB), DM, (const bf16*)(ws + WS_GATES), 3072, 1024};
            pg8::gemm_phase<pg8::EpiMerge<false>, pg8::StaticOrder, true, true>(F.lds, g, S, E); }
          { pg8::Gemm g{(const bf16*)(ws + WS_YPOOL), (const bf16*)(ws + WS_WBR) + (size_t)2 * 1024 * 512, T, DM, 512};
            pg8::EpiMerge<false> E{(bf16*)(ws + WS_XB), DM, (const bf16*)(ws + WS_GATES), 3072, 2048};
            pg8::gemm_phase<pg8::EpiMerge<false>, pg8::StaticOrder, true, true>(F.lds, g, S, E); } }
        GRID_BAR();
#if defined(DBG_STOP) && DBG_STOP == 7
        dump_bf16(F, (const bf16*)(ws + WS_XB), 1024, 1024, 0); return;
#endif
#if defined(DBG_STOP) && DBG_STOP == 6
        dump_bf16(F, (const bf16*)(ws + WS_GATES) + 1024, 3072, 1024, 0); return;
#endif
        { pg8::Gemm g{(const bf16*)(ws + WS_XB), (const bf16*)(ws + WS_WOUT), T, DM, DM}; pg8::StaticOrder S; S.init(T, DM, F.G, (int)F.bid);
          pg8::EpiResF32 E{l == 0 ? INP(F, 0) : OUTP(F), OUTP(F), DM};
          pg8::gemm_phase<pg8::EpiResF32, pg8::StaticOrder, true, true>(F.lds, g, S, E); }
        GRID_BAR();
#if defined(DBG_STOP) && DBG_STOP == 1
        return;
#endif
        route_phase(F, l);
        prep_expert_weights(F, l);
        GRID_BAR();
        permute_phase(F, l);
        GRID_BAR();
        { const int ntile = moe_tables(F, l);
          const LAS unsigned char* te = (const LAS unsigned char*)(F.lds + MISC_OFF + 256);
          { pg8::Gemm g{(const bf16*)(ws + WS_XPERM), (const bf16*)(ws + WS_W13), RMAX, NEXP * 1024, DM}; pg8::MoeOrder S{te, ntile * 4, F.G, (int)F.bid};
            pg8::EpiSwiGLU E{(bf16*)(ws + WS_HACT)};
            pg8::gemm_phase<pg8::EpiSwiGLU, pg8::MoeOrder, true, true>(F.lds, g, S, E); }
          GRID_BAR();
          { pg8::Gemm g{(const bf16*)(ws + WS_HACT), (const bf16*)(ws + WS_W2), RMAX, NEXP * 1024, 512}; pg8::MoeOrder S{te, ntile * 4, F.G, (int)F.bid};
            pg8::EpiY E{(bf16*)(ws + WS_YMOE)};
            pg8::gemm_phase<pg8::EpiY, pg8::MoeOrder, true, true>(F.lds, g, S, E); } }
        GRID_BAR();
        combine_phase(F, l);
        if (l + 1 < DEPTH) prep_mixer_weights(F, l + 1);
        GRID_BAR();
#if defined(DBG_STOP) && DBG_STOP == 2
        return;
#endif
    }
#undef ws
}

extern "C" void kernel_launch(void* const* d_in, const int* in_sizes, int n_in, void* d_out, int out_size, void* d_ws, size_t ws_size, hipStream_t stream) {
    static int grid = 0;
    if (grid == 0) {
        if (n_in != 31 || out_size != T * DM || ws_size < WS_END) { fprintf(stderr, "kernel_launch: unexpected shapes (n_in %d out %d ws %zu, need %zu)\n", n_in, out_size, ws_size, (size_t)WS_END); grid = -1; return; }
        int dev = 0, cus = 0, per_cu = 0;
        (void)hipGetDevice(&dev); (void)hipDeviceGetAttribute(&cus, hipDeviceAttributeMultiprocessorCount, dev);
        (void)hipFuncSetAttribute((const void*)mk_fwd, hipFuncAttributeMaxDynamicSharedMemorySize, LDS_BYTES);
        (void)hipOccupancyMaxActiveBlocksPerMultiprocessor(&per_cu, (const void*)mk_fwd, 512, LDS_BYTES);
        (void)hipGetLastError();
        fprintf(stderr, "kernel_launch: cus %d per_cu %d ws %zu\n", cus, per_cu, ws_size);
        grid = cus;
    }
    if (grid < 0) return;
    (void)hipMemsetAsync((char*)d_ws + WS_CTL, 0, CTL_BYTES, stream);
    Args a{};
    for (int i = 0; i < 31; ++i) a.in[i] = (const float*)d_in[i];
    a.out = (float*)d_out; a.ws = (unsigned char*)d_ws;
    void* kargs[] = {&a};
    hipError_t e = hipLaunchCooperativeKernel((const void*)mk_fwd, dim3(grid), dim3(512), kargs, LDS_BYTES, stream);
    if (e != hipSuccess) fprintf(stderr, "cooperative launch failed: %s (grid %d)\n", hipGetErrorString(e), grid);
}
```

```cpp
#include <hip/hip_runtime.h>
#include <hip/hip_cooperative_groups.h>
#include <cstdio>
#include <cstdint>
#include <cmath>
namespace pg8 {
#define PG8_LAS __attribute__((address_space(3)))
typedef unsigned short bf16_t;
typedef short bf16x8 __attribute__((ext_vector_type(8)));
typedef float f32x4 __attribute__((ext_vector_type(4)));
typedef unsigned u32x4 __attribute__((ext_vector_type(4)));
constexpr int BM = 256, BK = 64, HALF = 128, HTB = HALF * BK * 2  , STAGE_BYTES = 8 * HTB, NXCD = 8, WGM = 8;

__host__ __device__ __forceinline__ int lds_byte(int r, int c) { const int st = (r >> 4) * 2 + (c >> 5), rr = r & 15, cc = c & 31, ob = rr * 64 + cc * 2; return st * 1024 + (ob ^ (((ob >> 9) & 1) << 5)); }
__host__ __device__ __forceinline__ void stage_rc(int b, int& R, int& C) { const int st = b / 1024, sb = b % 1024, swz = sb ^ (((sb >> 9) & 1) << 5); R = (st >> 1) * 16 + swz / 64; C = (st & 1) * 32 + (swz % 64) / 2; }
__host__ __device__ __forceinline__ int perm32(int rho) { const int n = rho >> 4, i = rho & 15; return 8 * (i >> 2) + 4 * n + (i & 3); }

struct Unit { int pm, pn; };
struct Gemm { const bf16_t* A; const bf16_t* Bt; int M, N, K; };

struct StaticOrder {
    int nM, nN, nwg, G, c;
    __host__ __device__ void init(int M, int N, int G_, int c_) { nM = M / BM; nN = N / BM; nwg = nM * nN; G = G_; c = c_; }
    __host__ __device__ bool next(int i, Unit& u) const {
        const long L = (long)i * G + c; if (L >= nwg) return false;
        int wgid = (int)L; { const int q = nwg / NXCD, r = nwg % NXCD, xcd = wgid % NXCD, off = wgid / NXCD; wgid = (xcd < r ? xcd * (q + 1) : r * (q + 1) + (xcd - r) * q) + off; }
        const int nig = WGM * nN, gid = wgid / nig, fm = gid * WGM, gsz = (nM - fm) < WGM ? (nM - fm) : WGM;
        u.pm = fm + ((wgid % nig) % gsz); u.pn = (wgid % nig) / gsz; return true;
    }
    __device__ __forceinline__ void a_ready(const Unit&) const {}
    __device__ __forceinline__ void done(const Unit&) const {}
};

typedef float f32x2c_t __attribute__((ext_vector_type(2))); typedef __bf16 bf16x2c_t __attribute__((ext_vector_type(2)));
__device__ __forceinline__ unsigned cvt_pk_bf16(float lo, float hi) { const f32x2c_t v = {lo, hi}; const bf16x2c_t b = __builtin_convertvector(v, bf16x2c_t); return __builtin_bit_cast(unsigned, b); }
typedef float f32x2 __attribute__((ext_vector_type(2)));
__device__ __forceinline__ float fast_sigmoid(float x) { return __builtin_amdgcn_rcpf(1.0f + __builtin_amdgcn_exp2f(-1.4426950408889634f * x)); }
struct EpiZ {
    static constexpr bool PERM = true, AFTER_DRAIN = false;
    bf16_t *q, *k, *v, *poolz, *rwkvz; float qscale;
    __device__ __forceinline__ void operator()(const f32x4 (&acc)[2][2][4][2], const Unit& u, int wr, int wc, int fr, int fq) const {
        const int pn = u.pn; bf16_t* base; int ldc, colt, climit; float sc = 1.f;
        if (pn < 2) { base = q; ldc = 512; colt = pn * 256; climit = 512; sc = qscale; }
        else if (pn < 4) { base = k; ldc = 512; colt = (pn - 2) * 256; climit = 512; }
        else if (pn < 6) { base = v; ldc = 512; colt = (pn - 4) * 256; climit = 512; }
        else if (pn < 8) { base = poolz; ldc = 512; colt = (pn - 6) * 256; climit = 512; }
        else { base = rwkvz; ldc = 1824; colt = (pn - 8) * 256; climit = 1824; }
        const int row0 = u.pm * BM + wr * 64 + fr, col0 = colt + wc * 32 + 8 * fq;
#pragma unroll
        for (int ai = 0; ai < 2; ++ai)
#pragma unroll
            for (int m = 0; m < 4; ++m) { bf16_t* rowp = base + (size_t)(row0 + ai * HALF + m * 16) * ldc + col0;
#pragma unroll
                for (int bj = 0; bj < 2; ++bj) { if (col0 + bj * HALF < climit) { const f32x4 v0 = acc[ai][bj][m][0] * sc, v1 = acc[ai][bj][m][1] * sc;
                    u32x4 w; w.x = cvt_pk_bf16(v0[0], v0[1]); w.y = cvt_pk_bf16(v0[2], v0[3]); w.z = cvt_pk_bf16(v1[0], v1[1]); w.w = cvt_pk_bf16(v1[2], v1[3]);
                    *(u32x4*)(rowp + bj * HALF) = w; } } }
    }
};
struct EpiGate {
    static constexpr bool PERM = true, AFTER_DRAIN = false;
    bf16_t* O; int ldc;
    __device__ __forceinline__ void operator()(const f32x4 (&acc)[2][2][4][2], const Unit& u, int wr, int wc, int fr, int fq) const {
        const int row0 = u.pm * BM + wr * 64 + fr, col0 = u.pn * BM + wc * 32 + 8 * fq;
#pragma unroll
        for (int ai = 0; ai < 2; ++ai)
#pragma unroll
            for (int m = 0; m < 4; ++m) { bf16_t* rowp = O + (size_t)(row0 + ai * HALF + m * 16) * ldc + col0;
#pragma unroll
                for (int bj = 0; bj < 2; ++bj) { const f32x4 v0 = acc[ai][bj][m][0], v1 = acc[ai][bj][m][1];
                    u32x4 w; w.x = cvt_pk_bf16(fast_sigmoid(v0[0]), fast_sigmoid(v0[1])); w.y = cvt_pk_bf16(fast_sigmoid(v0[2]), fast_sigmoid(v0[3]));
                    w.z = cvt_pk_bf16(fast_sigmoid(v1[0]), fast_sigmoid(v1[1])); w.w = cvt_pk_bf16(fast_sigmoid(v1[2]), fast_sigmoid(v1[3]));
                    *(u32x4*)(rowp + bj * HALF) = w; } }
    }
};
__device__ __forceinline__ float bflo(unsigned w) { return __uint_as_float(w << 16); }
__device__ __forceinline__ float bfhi(unsigned w) { return __uint_as_float(w & 0xffff0000u); }
template <bool FIRST> struct EpiMerge {
    static constexpr bool PERM = true, AFTER_DRAIN = false;
    bf16_t* O; int ldc; const bf16_t* gate; int ldg, goff;
    __device__ __forceinline__ void operator()(const f32x4 (&acc)[2][2][4][2], const Unit& u, int wr, int wc, int fr, int fq) const {
        const int row0 = u.pm * BM + wr * 64 + fr, col0 = u.pn * BM + wc * 32 + 8 * fq;
#pragma unroll
        for (int ai = 0; ai < 2; ++ai)
#pragma unroll
            for (int m = 0; m < 4; ++m) { const size_t r = (size_t)(row0 + ai * HALF + m * 16); bf16_t* rowp = O + r * ldc + col0; const bf16_t* gp = gate + r * ldg + goff + col0;
#pragma unroll
                for (int bj = 0; bj < 2; ++bj) { const f32x4 v0 = acc[ai][bj][m][0], v1 = acc[ai][bj][m][1];
                    const u32x4 g = *(const u32x4*)(gp + bj * HALF);
                    float o[8] = {v0[0] * bflo(g.x), v0[1] * bfhi(g.x), v0[2] * bflo(g.y), v0[3] * bfhi(g.y), v1[0] * bflo(g.z), v1[1] * bfhi(g.z), v1[2] * bflo(g.w), v1[3] * bfhi(g.w)};
                    if (!FIRST) { const u32x4 p = *(const u32x4*)(rowp + bj * HALF);
                        o[0] += bflo(p.x); o[1] += bfhi(p.x); o[2] += bflo(p.y); o[3] += bfhi(p.y); o[4] += bflo(p.z); o[5] += bfhi(p.z); o[6] += bflo(p.w); o[7] += bfhi(p.w); }
                    u32x4 w; w.x = cvt_pk_bf16(o[0], o[1]); w.y = cvt_pk_bf16(o[2], o[3]); w.z = cvt_pk_bf16(o[4], o[5]); w.w = cvt_pk_bf16(o[6], o[7]);
                    *(u32x4*)(rowp + bj * HALF) = w; } }
    }
};
struct EpiResF32 {
    static constexpr bool PERM = false, AFTER_DRAIN = false;
    const float* base; float* out; int ldc;
    __device__ __forceinline__ void operator()(const f32x4 (&acc)[2][2][4][2], const Unit& u, int wr, int wc, int fr, int fq) const {
        const int row0 = u.pm * BM + wr * 64 + fr, col0 = u.pn * BM + wc * 32 + 4 * fq;
#pragma unroll
        for (int ai = 0; ai < 2; ++ai)
#pragma unroll
            for (int m = 0; m < 4; ++m) { const size_t off = (size_t)(row0 + ai * HALF + m * 16) * ldc + col0;
#pragma unroll
                for (int bj = 0; bj < 2; ++bj)
#pragma unroll
                    for (int n = 0; n < 2; ++n) { const f32x4 bs = *(const f32x4*)(base + off + bj * HALF + n * 16); *(f32x4*)(out + off + bj * HALF + n * 16) = bs + acc[ai][bj][m][n]; } }
    }
};
struct EpiSwiGLU {
    static constexpr bool PERM = true, AFTER_DRAIN = false;
    bf16_t* O;
    __device__ __forceinline__ void operator()(const f32x4 (&acc)[2][2][4][2], const Unit& u, int wr, int wc, int fr, int fq) const {
        const int row0 = u.pm * BM + wr * 64 + fr, col0 = (u.pn & 3) * 128 + wc * 32 + 8 * fq;
#pragma unroll
        for (int ai = 0; ai < 2; ++ai)
#pragma unroll
            for (int m = 0; m < 4; ++m) { bf16_t* rowp = O + (size_t)(row0 + ai * HALF + m * 16) * 512 + col0;
                float o[8];
#pragma unroll
                for (int n = 0; n < 2; ++n)
#pragma unroll
                    for (int e = 0; e < 4; ++e) { const float a1 = acc[ai][0][m][n][e], a3 = acc[ai][1][m][n][e]; o[n * 4 + e] = a1 * fast_sigmoid(a1) * a3; }
                u32x4 w; w.x = cvt_pk_bf16(o[0], o[1]); w.y = cvt_pk_bf16(o[2], o[3]); w.z = cvt_pk_bf16(o[4], o[5]); w.w = cvt_pk_bf16(o[6], o[7]);
                *(u32x4*)rowp = w; }
    }
};
struct EpiY {
    static constexpr bool PERM = true, AFTER_DRAIN = false;
    bf16_t* O;
    __device__ __forceinline__ void operator()(const f32x4 (&acc)[2][2][4][2], const Unit& u, int wr, int wc, int fr, int fq) const {
        const int row0 = u.pm * BM + wr * 64 + fr, col0 = (u.pn & 3) * BM + wc * 32 + 8 * fq;
#pragma unroll
        for (int ai = 0; ai < 2; ++ai)
#pragma unroll
            for (int m = 0; m < 4; ++m) { bf16_t* rowp = O + (size_t)(row0 + ai * HALF + m * 16) * 1024 + col0;
#pragma unroll
                for (int bj = 0; bj < 2; ++bj) { const f32x4 v0 = acc[ai][bj][m][0], v1 = acc[ai][bj][m][1];
                    u32x4 w; w.x = cvt_pk_bf16(v0[0], v0[1]); w.y = cvt_pk_bf16(v0[2], v0[3]); w.z = cvt_pk_bf16(v1[0], v1[1]); w.w = cvt_pk_bf16(v1[2], v1[3]);
                    *(u32x4*)(rowp + bj * HALF) = w; } }
    }
};
struct MoeOrder {
    const PG8_LAS unsigned char* tile_e; int nunits, G, c;
    __device__ __forceinline__ bool next(int i, Unit& u) const {
        const int L = i * G + c; if (L >= nunits) return false;
        const int pm = L >> 2; u.pm = pm; u.pn = __builtin_amdgcn_readfirstlane((int)tile_e[pm]) * 4 + (L & 3); return true;
    }
    __device__ __forceinline__ void a_ready(const Unit&) const {}
    __device__ __forceinline__ void done(const Unit&) const {}
};
template <class Epi, class Sched, bool ALIGN_EPI = false, bool SP2 = false>
__device__ __forceinline__ void gemm_phase(PG8_LAS unsigned char* lds, const Gemm g, const Sched& S, const Epi& E) {
    int tid = threadIdx.x; asm volatile("" : "+v"(tid));
    const int wid = __builtin_amdgcn_readfirstlane(tid >> 6), lane = tid & 63, wr = wid >> 2, wc = wid & 3, fr = lane & 15, fq = lane >> 4;
    const int K = g.K, nt = K / BK;
    unsigned voffA[2], voffB[2];
#pragma unroll
    for (int i = 0; i < 2; ++i) { int R, C; stage_rc(tid * 16 + i * 8192, R, C); const int Rb = Epi::PERM ? ((R & ~31) + perm32(R & 31)) : R;
        voffA[i] = (unsigned)(R * K + C) * 2u; voffB[i] = (unsigned)(Rb * K + C) * 2u; }
    const size_t kstep = (size_t)(BK * 2);
    const size_t hstep = (size_t)HALF * K * 2;
    const size_t tstep = 2 * hstep;
    const unsigned ldsw = (unsigned)wid * 1024u;
    const int aoff = lds_byte(wr * 64 + fr, fq * 8), boff = lds_byte(wc * 32 + fr, fq * 8);
#define PG8_SA(b, h) (((b) * 2 + (h)) * HTB)
#define PG8_SB(b, h) ((4 + (b) * 2 + (h)) * HTB)
#define PG8_STAGE(bufoff, gbase, voff) do { _Pragma("unroll") for (int _i = 0; _i < 2; ++_i) \
        __builtin_amdgcn_global_load_lds((const unsigned*)((const char*)(gbase) + (voff)[_i]), (PG8_LAS unsigned*)(lds + (bufoff) + ldsw + _i * 8192), 16, 0, 0); } while (0)
#define PG8_LDA(dst, b, h) do { _Pragma("unroll") for (int m = 0; m < 4; ++m) _Pragma("unroll") for (int k = 0; k < 2; ++k) dst[m][k] = *(const PG8_LAS bf16x8*)(lds + PG8_SA(b, h) + aoff + m * 2048 + k * 1024); } while (0)
#define PG8_LDB(dst, b, h) do { _Pragma("unroll") for (int n = 0; n < 2; ++n) _Pragma("unroll") for (int k = 0; k < 2; ++k) dst[n][k] = *(const PG8_LAS bf16x8*)(lds + PG8_SB(b, h) + boff + n * 2048 + k * 1024); } while (0)
#define PG8_MMA(ai, bj, At, Bt) do { __builtin_amdgcn_s_setprio(1); _Pragma("unroll") for (int m = 0; m < 4; ++m) _Pragma("unroll") for (int n = 0; n < 2; ++n) _Pragma("unroll") for (int k = 0; k < 2; ++k) \
        acc[ai][bj][m][n] = __builtin_amdgcn_mfma_f32_16x16x32_bf16(Bt[n][k], At[m][k], acc[ai][bj][m][n], 0, 0, 0); __builtin_amdgcn_s_setprio(0); } while (0)
#define PG8_WAIT_V(n) asm volatile("s_waitcnt vmcnt(" #n ")" ::: "memory")
#define PG8_WAIT_L(n) asm volatile("s_waitcnt lgkmcnt(" #n ")" ::: "memory")
#define PG8_BAR __builtin_amdgcn_s_barrier()
#define PG8_SCHED __builtin_amdgcn_sched_barrier(0)
    Unit cur, nxt; int ui = 0;
    if (!S.next(0, cur)) return;
    f32x4 acc[2][2][4][2];
#pragma unroll
    for (int a = 0; a < 2; ++a)
#pragma unroll
        for (int b = 0; b < 2; ++b)
#pragma unroll
            for (int m = 0; m < 4; ++m)
#pragma unroll
                for (int n = 0; n < 2; ++n) acc[a][b][m][n] = (f32x4){0.f, 0.f, 0.f, 0.f};
    bf16x8 At[4][2], B0[2][2], B1[2][2];
    const char* cA = (const char*)g.A + (size_t)cur.pm * tstep; const char* cB = (const char*)g.Bt + (size_t)cur.pn * tstep;
    S.a_ready(cur);
    if constexpr (SP2) {
        PG8_STAGE(PG8_SB(0, 0), cB, voffB); PG8_STAGE(PG8_SB(0, 1), cB + hstep, voffB); PG8_STAGE(PG8_SA(0, 0), cA, voffA); PG8_STAGE(PG8_SA(0, 1), cA + hstep, voffA);
        if (wr == 1) PG8_BAR;
        PG8_WAIT_V(2); PG8_BAR;
        PG8_STAGE(PG8_SB(1, 0), cB + kstep, voffB); PG8_STAGE(PG8_SA(1, 0), cA + kstep, voffA); PG8_STAGE(PG8_SB(1, 1), cB + hstep + kstep, voffB);
        PG8_WAIT_V(6); PG8_BAR;
    } else {
        PG8_STAGE(PG8_SB(0, 0), cB, voffB); PG8_STAGE(PG8_SA(0, 0), cA, voffA); PG8_STAGE(PG8_SB(0, 1), cB + hstep, voffB); PG8_STAGE(PG8_SA(0, 1), cA + hstep, voffA);
        if (wr == 1) PG8_BAR;
        PG8_WAIT_V(4); PG8_BAR;
        PG8_STAGE(PG8_SB(1, 0), cB + kstep, voffB); PG8_STAGE(PG8_SA(1, 0), cA + kstep, voffA); PG8_STAGE(PG8_SB(1, 1), cB + hstep + kstep, voffB);
        PG8_WAIT_V(6); PG8_BAR;
    }
    for (;;) {
        const bool has_next = S.next(ui + 1, nxt);
        const char* nA = has_next ? (const char*)g.A + (size_t)nxt.pm * tstep : cA; const char* nB = has_next ? (const char*)g.Bt + (size_t)nxt.pn * tstep : cB;
        for (int t = 0; t < nt; t += 2) {
            const bool last = (t == nt - 2);
            const char* a1 = cA + (size_t)(t + 1) * kstep;
            const char* a2 = last ? nA : cA + (size_t)(t + 2) * kstep; const char* b2 = last ? nB : cB + (size_t)(t + 2) * kstep;
            const char* a3 = a2 + kstep; const char* b3 = b2 + kstep;
            if (last && has_next) S.a_ready(nxt);
            if constexpr (SP2) {
            PG8_LDB(B0, 0, 0); PG8_LDB(B1, 0, 1); PG8_SCHED; PG8_LDA(At, 0, 0); PG8_STAGE(PG8_SA(1, 1), a1 + hstep, voffA);
            PG8_WAIT_V(8); PG8_WAIT_L(0); PG8_BAR; PG8_MMA(0, 0, At, B0); PG8_MMA(0, 1, At, B1); PG8_BAR; PG8_SCHED;
            PG8_LDA(At, 0, 1); PG8_STAGE(PG8_SB(0, 0), b2, voffB); PG8_STAGE(PG8_SB(0, 1), b2 + hstep, voffB); PG8_STAGE(PG8_SA(0, 0), a2, voffA);
            PG8_WAIT_V(8); PG8_WAIT_L(0); PG8_BAR; PG8_MMA(1, 0, At, B0); PG8_MMA(1, 1, At, B1); PG8_BAR; PG8_SCHED;
            PG8_LDB(B0, 1, 0); PG8_LDB(B1, 1, 1); PG8_SCHED; PG8_LDA(At, 1, 0); PG8_STAGE(PG8_SA(0, 1), a2 + hstep, voffA);
            PG8_WAIT_V(8); PG8_WAIT_L(0); PG8_BAR; PG8_MMA(0, 0, At, B0); PG8_MMA(0, 1, At, B1); PG8_BAR; PG8_SCHED;
            PG8_LDA(At, 1, 1); PG8_STAGE(PG8_SB(1, 0), b3, voffB); PG8_STAGE(PG8_SB(1, 1), b3 + hstep, voffB); PG8_STAGE(PG8_SA(1, 0), a3, voffA);
            PG8_WAIT_V(8); PG8_WAIT_L(0); PG8_BAR; PG8_MMA(1, 0, At, B0); PG8_MMA(1, 1, At, B1); PG8_BAR; PG8_SCHED;
            } else {
            PG8_LDB(B0, 0, 0); PG8_SCHED; PG8_LDA(At, 0, 0); PG8_STAGE(PG8_SA(1, 1), a1 + hstep, voffA);
            PG8_WAIT_L(8); PG8_BAR; PG8_WAIT_L(0); PG8_MMA(0, 0, At, B0); PG8_BAR; PG8_SCHED;
            PG8_LDB(B1, 0, 1); PG8_STAGE(PG8_SB(0, 0), b2, voffB);
            PG8_BAR; PG8_WAIT_L(0); PG8_MMA(0, 1, At, B1); PG8_BAR;
            PG8_LDA(At, 0, 1); PG8_STAGE(PG8_SA(0, 0), a2, voffA);
            PG8_BAR; PG8_WAIT_L(0); PG8_MMA(1, 0, At, B0); PG8_BAR; PG8_SCHED;
            PG8_STAGE(PG8_SB(0, 1), b2 + hstep, voffB);
            PG8_WAIT_V(6); PG8_BAR; PG8_MMA(1, 1, At, B1); PG8_BAR;
            PG8_LDB(B0, 1, 0); PG8_SCHED; PG8_LDA(At, 1, 0); PG8_STAGE(PG8_SA(0, 1), a2 + hstep, voffA);
            PG8_WAIT_L(8); PG8_BAR; PG8_WAIT_L(0); PG8_MMA(0, 0, At, B0); PG8_BAR; PG8_SCHED;
            PG8_LDB(B1, 1, 1); PG8_STAGE(PG8_SB(1, 0), b3, voffB);
            PG8_BAR; PG8_WAIT_L(0); PG8_MMA(0, 1, At, B1); PG8_BAR;
            PG8_LDA(At, 1, 1); PG8_STAGE(PG8_SA(1, 0), a3, voffA);
            PG8_BAR; PG8_WAIT_L(0); PG8_MMA(1, 0, At, B0); PG8_BAR; PG8_SCHED;
            PG8_STAGE(PG8_SB(1, 1), b3 + hstep, voffB);
            PG8_WAIT_V(6); PG8_BAR; PG8_MMA(1, 1, At, B1); PG8_BAR;
            }
        }
        if constexpr (ALIGN_EPI) { if (wr == 0) PG8_BAR; }
        if constexpr (!Epi::AFTER_DRAIN) { E(acc, cur, wr, wc, fr, fq); S.done(cur); }
        if (!has_next) break;
#pragma unroll
        for (int a = 0; a < 2; ++a)
#pragma unroll
            for (int b = 0; b < 2; ++b)
#pragma unroll
                for (int m = 0; m < 4; ++m)
#pragma unroll
                    for (int n = 0; n < 2; ++n) acc[a][b][m][n] = (f32x4){0.f, 0.f, 0.f, 0.f};
        cur = nxt; cA = nA; cB = nB; ++ui;
        if constexpr (ALIGN_EPI) { if (wr == 1) PG8_BAR; }
    }
    PG8_WAIT_V(0);
    if constexpr (!ALIGN_EPI) { if (wr == 0) PG8_BAR; }
    PG8_BAR;
    if constexpr (Epi::AFTER_DRAIN) { E.fused(acc, cur, wr, wc, fr, fq, lds, wid, lane); S.done(cur); }
#undef PG8_SA
#undef PG8_SB
#undef PG8_STAGE
#undef PG8_LDA
#undef PG8_LDB
#undef PG8_MMA
#undef PG8_WAIT_V
#undef PG8_WAIT_L
#undef PG8_BAR
#undef PG8_SCHED
}
}
namespace cg = cooperative_groups;
#define DI __device__ __forceinline__
#define LAS __attribute__((address_space(3)))
typedef unsigned short bf16;
typedef float f32x4 __attribute__((ext_vector_type(4)));
typedef unsigned u32x4 __attribute__((ext_vector_type(4)));
typedef unsigned u32x2 __attribute__((ext_vector_type(2)));
typedef short bf16x8_t __attribute__((ext_vector_type(8)));

constexpr int BATCH = 2, SEQ = 16384, DM = 1024, T = BATCH * SEQ, DEPTH = 2;
constexpr int NEXP = 32, RZP = 1824;
constexpr int RMAX = 73728;
constexpr float C2 = 0.125f * 1.4426950408889634f;
constexpr float LOG2E = 1.4426950408889634f;
constexpr size_t MiB = 1u << 20;
constexpr size_t WS_CTL = 0, CTL_BYTES = 1 * MiB;
constexpr size_t WS_WIN = 1 * MiB, WS_WG = 9 * MiB, WS_WBR = 15 * MiB, WS_WOUT = 18 * MiB;
constexpr size_t WS_KMEAN = 20 * MiB, WS_RWG = 20 * MiB + 512 * 1024, WS_ROUTE = 21 * MiB, WS_RWT = 22 * MiB, WS_DEST = 22 * MiB + 512 * 1024, WS_BONUS = 23 * MiB, WS_WLT = 24 * MiB, WS_WPT = 24 * MiB + 512 * 1024, WS_WGBASE = 24 * MiB + 768 * 1024;
constexpr size_t WS_XB = 32 * MiB, WS_VFIRST = 96 * MiB, WS_YPOOL = 128 * MiB, WS_YATTN = 160 * MiB;
constexpr size_t WS_BIG = 192 * MiB;
constexpr size_t WS_Q = WS_BIG, WS_K = WS_BIG + 32 * MiB, WS_V = WS_BIG + 64 * MiB, WS_POOLZ = WS_BIG + 232 * MiB, WS_RWKVZ = WS_BIG + 264 * MiB;
constexpr size_t WS_AR = WS_BIG;
constexpr size_t WS_GATES = WS_BIG + 32 * MiB;
constexpr size_t WS_XPERM = WS_BIG, WS_HACT = WS_BIG + 144 * MiB, WS_W13 = WS_BIG + 216 * MiB, WS_W2 = WS_BIG + 280 * MiB, WS_YMOE = WS_BIG;
constexpr size_t WS_VT = WS_YATTN;
constexpr size_t WS_PARTO = WS_BIG + 96 * MiB, WS_PARTML = WS_BIG + 224 * MiB;
constexpr size_t WS_LIST = WS_BIG + 378 * MiB;
constexpr size_t WS_PCT = WS_BIG + 224 * MiB, WS_LC = WS_BIG + 256 * MiB, WS_RM = WS_BIG + 288 * MiB, WS_Y0 = WS_BIG + 320 * MiB, WS_S0 = WS_BIG + 352 * MiB;
constexpr int LSTRIDE = 516096;
constexpr size_t WS_END = WS_BIG + 394 * MiB;
static_assert(WS_LIST + (size_t)16 * LSTRIDE * 2 <= WS_END, "ws map");
static_assert(WS_RWKVZ + (size_t)T * RZP * 2 <= WS_END, "ws map");
static_assert(WS_W2 + (size_t)32 * 1024 * 512 * 2 <= WS_END, "ws map");
constexpr int CW_CNT = 64, CW_LCNT = 1024, CW_BAR = 4096;
constexpr int LDS_BYTES = 147456, MISC_OFF = 131072;

DI float bf2f(unsigned short u) { return __uint_as_float((unsigned)u << 16); }
DI unsigned f2bf(float f) { unsigned u = __float_as_uint(f); return (u + 0x7fffu + ((u >> 16) & 1u)) >> 16; }
DI unsigned pk2(float lo, float hi) { return f2bf(lo) | (f2bf(hi) << 16); }
DI float blo(unsigned w) { return __uint_as_float(w << 16); }
DI float bhi(unsigned w) { return __uint_as_float(w & 0xffff0000u); }
DI float wave_sum(float v) {
#pragma unroll
    for (int o = 1; o < 64; o <<= 1) v += __shfl_xor(v, o);
    return v;
}
DI float wave_max(float v) {
#pragma unroll
    for (int o = 1; o < 64; o <<= 1) v = fmaxf(v, __shfl_xor(v, o));
    return v;
}
DI float sigmoidf_(float x) { return 1.0f / (1.0f + __expf(-x)); }
#define LDS_WAIT() asm volatile("s_waitcnt lgkmcnt(0)" ::: "memory")

#define XB_TMO      128
#define XB_XCNT(j)  (256  + 64 * (j))
#define XB_XSUB(j)  (1280 + 64 * (j))
#define XB_XGEN(j)  (2304 + 64 * (j))
#define XB_TOP      3328
#define XB_TOPGEN   3392
#define XCD_BAR_WORDS 3456
#define XB_SPIN_CAP (1u << 27)

__device__ __forceinline__ unsigned xb_ld(unsigned* p)              { return __hip_atomic_load(p, __ATOMIC_RELAXED, __HIP_MEMORY_SCOPE_AGENT); }
__device__ __forceinline__ unsigned xb_add(unsigned* p, unsigned v) { return __hip_atomic_fetch_add(p, v, __ATOMIC_RELAXED, __HIP_MEMORY_SCOPE_AGENT); }
__device__ __forceinline__ unsigned xb_xcc_id() { return (unsigned)__builtin_amdgcn_s_getreg((3 << 11) | 20) & 0xFu; }
#define XB_SPIN(cond, bar) do { unsigned _sp = 0; while (cond) { __builtin_amdgcn_s_sleep(1); \
    if ((++_sp & 255u) == 0u) { if (xb_ld(&(bar)[XB_TMO])) break; if (_sp > XB_SPIN_CAP) { atomicAdd(&(bar)[XB_TMO], 1u); break; } } } } while (0)

struct XcdBarrier {
    unsigned* bar; unsigned x;
    volatile LAS unsigned* st;
};

__device__ __forceinline__ XcdBarrier xcd_barrier_post(unsigned* bar, volatile LAS unsigned* st) {
    XcdBarrier b; b.bar = bar; b.x = xb_xcc_id(); b.st = st;
    if (threadIdx.x == 0) (void)xb_add(&bar[XB_XCNT(b.x)], 1u);
    return b;
}
__device__ __forceinline__ void xcd_barrier_complete(unsigned* bar, unsigned x, unsigned& nloc, unsigned& nx) {
    const unsigned G = gridDim.x * gridDim.y * gridDim.z;
    unsigned sum, cnt, mine, sp = 0u;
    for (;;) {
        sum = 0u; cnt = 0u; mine = 0u;
#pragma unroll
        for (unsigned j = 0; j < 16; ++j) { const unsigned c = xb_ld(&bar[XB_XCNT(j)]); sum += c; cnt += (c > 0u) ? 1u : 0u; mine = (j == x) ? c : mine; }
        if (sum == G) break;
        __builtin_amdgcn_s_sleep(1);
        if ((++sp & 255u) == 0u) { if (xb_ld(&bar[XB_TMO])) break; if (sp > XB_SPIN_CAP) { atomicAdd(&bar[XB_TMO], 1u); break; } }
    }
    nloc = mine > 0u ? mine : 1u; nx = cnt > 0u ? cnt : 1u;
}

__device__ __forceinline__ void xcd_barrier(const XcdBarrier& b) {
    asm volatile("s_waitcnt vmcnt(0)" ::: "memory");
    __syncthreads();
    if (threadIdx.x == 0) {
        unsigned* bar = b.bar;
        __builtin_amdgcn_s_waitcnt(0);
        unsigned nloc = b.st[0], nx = b.st[1];
        if (nloc == 0u) { xcd_barrier_complete(bar, b.x, nloc, nx); b.st[0] = nloc; b.st[1] = nx; }
        const unsigned old = xb_add(&bar[XB_XSUB(b.x)], 1u);
        const unsigned gen = old / nloc;
        if (old + 1u == (gen + 1u) * nloc) {
            __builtin_amdgcn_fence(__ATOMIC_RELEASE, "agent");
            asm volatile("s_waitcnt vmcnt(0)" ::: "memory");
            const unsigned og = xb_add(&bar[XB_TOP], 1u);
            const unsigned tg = og / nx;
            if (og + 1u == (tg + 1u) * nx) xb_add(&bar[XB_TOPGEN], 1u);
            else XB_SPIN(xb_ld(&bar[XB_TOPGEN]) == tg, bar);
            __builtin_amdgcn_fence(__ATOMIC_ACQUIRE, "agent");
            xb_add(&bar[XB_XGEN(b.x)], 1u);
            asm volatile("s_waitcnt vmcnt(0)" ::: "memory");
        } else {
            XB_SPIN(xb_ld(&bar[XB_XGEN(b.x)]) == gen, bar);
            __builtin_amdgcn_fence(__ATOMIC_ACQUIRE, "agent");
            asm volatile("s_waitcnt vmcnt(0)" ::: "memory");
        }
    }
    __syncthreads();
}

struct Args { const float* in[31]; float* out; unsigned char* ws; };

typedef const __attribute__((address_space(4))) unsigned long long* kargp_t;
struct Frame {
    LAS unsigned char* lds; int tid, lane, wave, G, bid;
    kargp_t kp;
};
#define GASQ __attribute__((address_space(1)))
DI const float* INP(const Frame& F, int i) { return (const float*)(const GASQ float*)F.kp[i]; }
DI float* OUTP(const Frame& F) { return (float*)(GASQ float*)F.kp[31]; }
DI unsigned char* WSP(const Frame& F) { return (unsigned char*)(GASQ unsigned char*)F.kp[32]; }
DI void fence_frame(Frame& F) {
    asm volatile("" : "+s"(F.kp) :: "memory"); asm volatile("" : "+s"(F.G)); asm volatile("" : "+s"(F.bid));
    F.tid = threadIdx.x; asm volatile("" : "+v"(F.tid)); F.lane = F.tid & 63; F.wave = __builtin_amdgcn_readfirstlane(F.tid >> 6); }

DI void transpose_item(const float* W, int ldw, int ncols, bf16* WT, int ldt, const float* scale, LAS float* scr, int item, int lane) {
    const int nblk = ncols / 32, kb = item / nblk, nb = item % nblk, k0 = 64 * kb, n0 = 32 * nb;
#pragma unroll
    for (int i = 0; i < 32; ++i) { const int kk = 2 * i + (lane >> 5); float v = W[(size_t)(k0 + kk) * ldw + n0 + (lane & 31)]; if (scale) v *= scale[k0 + kk]; scr[kk * 33 + (lane & 31)] = v; }
    LDS_WAIT(); asm volatile("" ::: "memory");
    const int c = lane & 7;
#pragma unroll
    for (int j = 0; j < 4; ++j) { const int n = (lane >> 3) + 8 * j; const LAS float* s = scr + (8 * c) * 33 + n;
        u32x4 o; o.x = pk2(s[0 * 33], s[1 * 33]); o.y = pk2(s[2 * 33], s[3 * 33]); o.z = pk2(s[4 * 33], s[5 * 33]); o.w = pk2(s[6 * 33], s[7 * 33]);
        *(u32x4*)(WT + (size_t)(n0 + n) * ldt + k0 + 8 * c) = o; }
    LDS_WAIT(); asm volatile("" ::: "memory");
}
DI void prep_mixer_weights(Frame& F, int l) {
    LAS float* scr = (LAS float*)(F.lds + F.wave * 16384);
    const int gw = F.bid * 8 + F.wave, NGW = F.G * 8;
    const float* w_in = INP(F, 2) + (size_t)l * 1024 * 6912; const float* g1 = INP(F, 1) + l * 1024;
    bf16* WIN = (bf16*)(WSP(F) + WS_WIN); bf16* WG = (bf16*)(WSP(F) + WS_WG); bf16* WBR = (bf16*)(WSP(F) + WS_WBR); bf16* WOUT = (bf16*)(WSP(F) + WS_WOUT);
    constexpr int I1 = 16 * (1536 / 32), I2 = 16 * (2304 / 32), I3 = 16 * 1, I4 = 16 * (3072 / 32), I5 = 8 * (1024 / 32), I6 = 16 * (1024 / 32);
    const int n3 = l > 0 ? I3 : 0;
    const int total = I1 + I2 + n3 + I4 + 3 * I5 + I6;
    for (int it = gw; it < total; it += NGW) {
        int r = it;
        if (r < I1) { transpose_item(w_in, 6912, 1536, WIN, 1024, g1, scr, r, F.lane); continue; } r -= I1;
        if (r < I2) { transpose_item(w_in + 4608, 6912, 2304, WIN + (size_t)1536 * 1024, 1024, g1, scr, r, F.lane); continue; } r -= I2;
        if (r < n3) { transpose_item(INP(F, 3) + (size_t)(l - 1) * 1024 * 32, 32, 32, WIN + (size_t)3840 * 1024, 1024, g1, scr, r, F.lane); continue; } r -= n3;
        if (r < I4) { transpose_item(w_in + 1536, 6912, 3072, WG, 1024, g1, scr, r, F.lane); continue; } r -= I4;
        if (r < 3 * I5) { const int i = r / I5; transpose_item(INP(F, 20) + (size_t)(l * 3 + i) * 512 * 1024, 1024, 1024, WBR + (size_t)i * 1024 * 512, 512, i == 2 ? INP(F, 19) + l * 512 : nullptr, scr, r % I5, F.lane); continue; } r -= 3 * I5;
        transpose_item(INP(F, 21) + (size_t)l * 1024 * 1024, 1024, 1024, WOUT, 1024, nullptr, scr, r, F.lane);
    }
    if (l > 0) {
        u32x4* z = (u32x4*)(WIN + (size_t)3872 * 1024); const int n16 = 224 * 1024 * 2 / 16;
        for (int i = F.bid * 512 + F.tid; i < n16; i += F.G * 512) z[i] = (u32x4){0u, 0u, 0u, 0u};
    }
    { bf16* WPT = (bf16*)(WSP(F) + WS_WPT);
      for (int it = gw; it < 32; it += NGW) transpose_item(INP(F, 18) + (size_t)(l * 4 + (it >> 3)) * 128 * 128, 128, 128, WPT + (size_t)(it >> 3) * 128 * 128, 128, nullptr, scr, it & 7, F.lane); }
    { bf16* WLT = (bf16*)(WSP(F) + WS_WLT);
      constexpr int L1 = 1 * 16, L2 = 1 * 16, L3 = 2 * 16;
      for (int it = gw; it < L1 + L2 + L3; it += NGW) {
          if (it < L1) transpose_item(INP(F, 7) + (size_t)l * 64 * 512, 512, 512, WLT, 288, nullptr, scr, it, F.lane);
          else if (it < L1 + L2) transpose_item(INP(F, 9) + (size_t)l * 64 * 512, 512, 512, WLT + 64, 288, nullptr, scr, it - L1, F.lane);
          else transpose_item(INP(F, 10) + (size_t)l * 128 * 512, 512, 512, WLT + 128, 288, nullptr, scr, it - L1 - L2, F.lane); }
      const float* wv = INP(F, 17) + (size_t)(l > 0 ? l - 1 : 0) * 32 * 512;
      for (int i = F.bid * 512 + F.tid; i < 32 * 512; i += F.G * 512) { const int k = i >> 9, ch = i & 511; WLT[(size_t)ch * 288 + 256 + k] = (bf16)f2bf(l > 0 ? wv[k * 512 + ch] : 0.f); } }
    { bf16* RWH = (bf16*)(WSP(F) + WS_RWG); bf16* RWL = RWH + 48 * 1024; const float* g2 = INP(F, 22) + l * 1024; const float* rgw = INP(F, 23) + (size_t)l * 1024 * 4; const float* rew = INP(F, 25) + (size_t)l * 1024 * 32;
      for (int i = F.bid * 512 + F.tid; i < 48 * 1024; i += F.G * 512) { const int r = i >> 10, k = i & 1023;
          const float w = r < 16 ? rgw[k * 4 + (r & 3)] : r < 32 ? rew[k * 32 + 8 * ((r - 16) >> 2) + ((r - 16) & 3)] : rew[k * 32 + 8 * ((r - 32) >> 2) + 4 + ((r - 32) & 3)];
          const float v = g2[k] * w; const unsigned hb = f2bf(v); const float hf = __uint_as_float(hb << 16); RWH[i] = (bf16)hb; RWL[i] = (bf16)f2bf(v - hf); } }
}
DI void prep_expert_weights(Frame& F, int l) {
    LAS float* scr = (LAS float*)(F.lds + F.wave * 16384);
    const int gw = F.bid * 8 + F.wave, NGW = F.G * 8;
    const float* g2 = INP(F, 22) + l * 1024;
    bf16* W13 = (bf16*)(WSP(F) + WS_W13); bf16* W2 = (bf16*)(WSP(F) + WS_W2);
    constexpr int J13 = 64, N13 = NEXP * 2 * 4 * J13, J2 = 8 * 32, N2 = NEXP * J2;
    for (int it = gw; it < N13 + N2; it += NGW) {
        if (it < N13) { const int job = it / J13, item = it % J13, e = job >> 3, which = (job >> 2) & 1, grp = job & 3;
            const float* src = (which ? INP(F, 28) : INP(F, 27)) + ((size_t)(l * NEXP + e) * 1024) * 512 + grp * 128;
            transpose_item(src, 512, 128, W13 + ((size_t)e * 1024 + grp * 256 + which * 128) * 1024, 1024, g2, scr, item, F.lane);
        } else { const int r = it - N13, e = r / J2, item = r % J2;
            transpose_item(INP(F, 29) + (size_t)(l * NEXP + e) * 512 * 1024, 1024, 1024, W2 + (size_t)e * 1024 * 512, 512, nullptr, scr, item, F.lane); }
    }
}
DI void rms_rows_to_bf16(Frame& F, const float* x, bf16* xb) {
    const int gw = F.bid * 8 + F.wave, NGW = F.G * 8;
    for (int t = gw; t < T; t += NGW) {
        const f32x4* xr = (const f32x4*)(x + (size_t)t * DM) + F.lane; f32x4 v[4]; float s = 0.f;
#pragma unroll
        for (int j = 0; j < 4; ++j) { v[j] = xr[64 * j]; s += (v[j].x * v[j].x + v[j].y * v[j].y) + (v[j].z * v[j].z + v[j].w * v[j].w); }
        const float rs = rsqrtf(wave_sum(s) * (1.f / DM) + 1e-6f);
        u32x2* o = (u32x2*)(xb + (size_t)t * DM) + F.lane;
#pragma unroll
        for (int j = 0; j < 4; ++j) o[64 * j] = (u32x2){pk2(v[j].x * rs, v[j].y * rs), pk2(v[j].z * rs, v[j].w * rs)};
    }
}

DI void kmean_phase(Frame& F) {
    const bf16* K = (const bf16*)(WSP(F) + WS_K); float* kmean = (float*)(WSP(F) + WS_KMEAN);
    LAS float* red = (LAS float*)F.lds;
    for (int it = F.bid; it < BATCH * 8 * 64; it += F.G) {
        const int b = it >> 9, h = (it >> 6) & 7, n = it & 63, d = F.lane, part = F.wave;
        const bf16* kp = K + ((size_t)b * SEQ + n * 256 + part * 32) * 512 + h * 64 + d; float s = 0.f;
#pragma unroll
        for (int i = 0; i < 32; ++i) s += bf2f(kp[(size_t)i * 512]);
        red[part * 64 + d] = s;
        __syncthreads();
        if (F.tid < 64) { float a = 0.f;
#pragma unroll
            for (int p = 0; p < 8; ++p) a += red[p * 64 + F.tid];
            kmean[(size_t)it * 64 + F.tid] = a * (1.f / 256.f); }
        __syncthreads();
    }
}
DI void vt_phase(Frame& F) {
    const bf16* V = (const bf16*)(WSP(F) + WS_V); bf16* VT = (bf16*)(WSP(F) + WS_VT);
    LAS bf16* tl = (LAS bf16*)(F.lds + 4096 + F.wave * 9216);
    const int gw = F.bid * 8 + F.wave, NGW = F.G * 8, lane = F.lane;
    for (int it = gw; it < BATCH * 8 * (SEQ / 64); it += NGW) {
        const int bh = it / (SEQ / 64), tt = it % (SEQ / 64), b = bh >> 3, h = bh & 7, t0 = tt * 64;
#pragma unroll
        for (int i = 0; i < 8; ++i) { const int r = i * 8 + (lane >> 3), c = lane & 7;
            const u32x4 w = *(const u32x4*)(V + ((size_t)b * SEQ + t0 + r) * 512 + h * 64 + c * 8); *(LAS u32x4*)(tl + r * 72 + c * 8) = w; }
        LDS_WAIT(); asm volatile("" ::: "memory");
#pragma unroll
        for (int i = 0; i < 8; ++i) { const int d = i * 8 + (lane >> 3), c = lane & 7; unsigned short e[8];
#pragma unroll
            for (int k = 0; k < 8; ++k) e[k] = tl[(8 * c + k) * 72 + d];
            u32x4 w; w.x = e[0] | ((unsigned)e[1] << 16); w.y = e[2] | ((unsigned)e[3] << 16); w.z = e[4] | ((unsigned)e[5] << 16); w.w = e[6] | ((unsigned)e[7] << 16);
            *(u32x4*)(VT + ((size_t)bh * 64 + d) * SEQ + t0 + c * 8) = w; }
        LDS_WAIT(); asm volatile("" ::: "memory");
    }
}
DI int list_off(int n) { return n * SEQ - 128 * n * (n + 1); }
DI void sel_phase(Frame& F, int l) {
    const bf16* Q = (const bf16*)(WSP(F) + WS_Q); const float* kmean = (const float*)(WSP(F) + WS_KMEAN);
    unsigned short* list = (unsigned short*)(WSP(F) + WS_LIST); unsigned* lcnt = (unsigned*)(WSP(F) + WS_CTL) + CW_LCNT + 1024 * l;
    LAS float* km = (LAS float*)F.lds;
    for (int it = F.bid; it < BATCH * 8 * (SEQ / 512); it += F.G) {
        const int bh = it / (SEQ / 512), g = it % (SEQ / 512), b = bh >> 3, h = bh & 7;
        __syncthreads();
        for (int i = F.tid; i < 1024; i += 512) ((LAS f32x4*)km)[i] = ((const f32x4*)(kmean + (size_t)bh * 4096))[i];
        __syncthreads();
        const int tl = g * 512 + F.tid, own = __builtin_amdgcn_readfirstlane(tl >> 8);
        float q[64];
        { const u32x4* qp = (const u32x4*)(Q + ((size_t)b * SEQ + tl) * 512 + h * 64);
#pragma unroll
          for (int c = 0; c < 8; ++c) { const u32x4 w = qp[c]; q[8 * c] = blo(w.x); q[8 * c + 1] = bhi(w.x); q[8 * c + 2] = blo(w.y); q[8 * c + 3] = bhi(w.y); q[8 * c + 4] = blo(w.z); q[8 * c + 5] = bhi(w.z); q[8 * c + 6] = blo(w.w); q[8 * c + 7] = bhi(w.w); } }
        float v0 = -INFINITY, v1 = -INFINITY, v2 = -INFINITY; int i0 = -1, i1 = -1, i2 = -1;
        for (int n = 0; n < own; ++n) { const LAS f32x4* kp = (const LAS f32x4*)(km + n * 64); float s0 = 0.f, s1 = 0.f;
#pragma unroll
            for (int i = 0; i < 16; i += 2) { const f32x4 a = kp[i], c = kp[i + 1];
                s0 += q[4 * i] * a.x + q[4 * i + 1] * a.y + q[4 * i + 2] * a.z + q[4 * i + 3] * a.w; s1 += q[4 * i + 4] * c.x + q[4 * i + 5] * c.y + q[4 * i + 6] * c.z + q[4 * i + 7] * c.w; }
            const float gte = s0 + s1; const bool c0 = gte > v0, c1 = gte > v1, c2 = gte > v2;
            v2 = c1 ? v1 : (c2 ? gte : v2); i2 = c1 ? i1 : (c2 ? n : i2);
            v1 = c0 ? v0 : (c1 ? gte : v1); i1 = c0 ? i0 : (c1 ? n : i1);
            v0 = c0 ? gte : v0; i0 = c0 ? n : i0; }
        LAS unsigned* lc = (LAS unsigned*)(F.lds + MISC_OFF + 8192); LAS unsigned* lbase = lc + 64;
        if (F.tid < 64) lc[F.tid] = 0u;
        __syncthreads();
        unsigned r0 = 0u, r1 = 0u, r2 = 0u;
        if (i0 >= 0) r0 = atomicAdd((unsigned*)(lc + i0), 1u);
        if (i1 >= 0) r1 = atomicAdd((unsigned*)(lc + i1), 1u);
        if (i2 >= 0) r2 = atomicAdd((unsigned*)(lc + i2), 1u);
        __syncthreads();
        if (F.tid < 64) { const unsigned c = lc[F.tid]; lbase[F.tid] = c ? atomicAdd(lcnt + bh * 64 + F.tid, c) : 0u; }
        __syncthreads();
        unsigned short* lb = list + (size_t)bh * LSTRIDE;
        if (i0 >= 0) lb[list_off(i0) + lbase[i0] + r0] = (unsigned short)(tl | (0 << 14));
        if (i1 >= 0) lb[list_off(i1) + lbase[i1] + r1] = (unsigned short)(tl | (1 << 14));
        if (i2 >= 0) lb[list_off(i2) + lbase[i2] + r2] = (unsigned short)(tl | (2 << 14));
    }
    __syncthreads();
}
DI void att_phase(Frame& F, int l) {
    const bf16* Q = (const bf16*)(WSP(F) + WS_Q); const bf16* K = (const bf16*)(WSP(F) + WS_K); const bf16* VT = (const bf16*)(WSP(F) + WS_VT);
    const unsigned short* list = (const unsigned short*)(WSP(F) + WS_LIST); const unsigned* lcnt = (const unsigned*)(WSP(F) + WS_CTL) + CW_LCNT + 1024 * l;
    bf16* PO = (bf16*)(WSP(F) + WS_PARTO); float* PML = (float*)(WSP(F) + WS_PARTML);
    LAS unsigned char* Kl = F.lds;
    LAS unsigned char* Vl = F.lds + 36864;
    LAS int* pre = (LAS int*)(F.lds + MISC_OFF + 8192);
    const int lane = F.lane, wave = F.wave, qi = lane & 15, quad = lane >> 4;
    __syncthreads();
    if (F.tid == 0) { int acc = 0;
_Pragma("unroll 1")
        for (int i = 0; i < 1024; ++i) { pre[i] = acc; acc += ((int)__hip_atomic_load(lcnt + i, __ATOMIC_RELAXED, __HIP_MEMORY_SCOPE_AGENT) + 127) >> 7; } pre[1024] = acc; }
    __syncthreads();
    const int NL = __builtin_amdgcn_readfirstlane(pre[1024]), total = NL + BATCH * 8 * 64 * 2, per = (total + F.G - 1) / F.G;
    const int it0 = F.bid * per, it1 = (it0 + per < total) ? it0 + per : total;
    int cur = 0, loaded = -1;
    for (int it = it0; it < it1; ++it) {
        int i, tile, own_item;
        if (it < NL) { while (pre[cur + 1] <= it) ++cur; i = cur; tile = it - pre[cur]; own_item = 0; }
        else { const int o = it - NL; i = o >> 1; tile = o & 1; own_item = 1; }
        i = __builtin_amdgcn_readfirstlane(i); tile = __builtin_amdgcn_readfirstlane(tile);
        const int bh = i >> 6, n = i & 63, b = bh >> 3, h = bh & 7;
        if (i != loaded) {
            __syncthreads();
#pragma unroll
            for (int r = 0; r < 4; ++r) { const int c = F.tid + r * 512, row = c >> 3, ch = c & 7;
                const u32x4 w = *(const u32x4*)(K + ((size_t)b * SEQ + n * 256 + row) * 512 + h * 64 + ch * 8); *(LAS u32x4*)(Kl + row * 144 + ch * 16) = w; }
#pragma unroll
            for (int r = 0; r < 4; ++r) { const int c = F.tid + r * 512, row = c >> 5, ch = c & 31;
                const u32x4 w = *(const u32x4*)(VT + ((size_t)bh * 64 + row) * SEQ + n * 256 + ch * 8); *(LAS u32x4*)(Vl + row * 528 + ch * 16) = w; }
            __syncthreads();
            loaded = i;
        }
        int tl, j; bool valid;
        if (own_item) { tl = n * 256 + tile * 128 + wave * 16 + qi; j = 3; valid = true; }
        else { const int e = tile * 128 + wave * 16 + qi; const int cnt = (int)lcnt[i]; valid = e < cnt;
            const unsigned short ent = valid ? list[(size_t)bh * LSTRIDE + list_off(n) + e] : (unsigned short)0; tl = ent & 0x3fff; j = ent >> 14; }
        const size_t t = (size_t)b * SEQ + tl;
        const float slope2 = exp2f(-(float)(h + 1)) * LOG2E;
        bf16x8_t qf[2];
#pragma unroll
        for (int ks = 0; ks < 2; ++ks) qf[ks] = *(const bf16x8_t*)(Q + t * 512 + h * 64 + ks * 32 + quad * 8);
        f32x4 sc[16];
#pragma unroll
        for (int kt = 0; kt < 16; ++kt) { f32x4 a = {0.f, 0.f, 0.f, 0.f};
#pragma unroll
            for (int ks = 0; ks < 2; ++ks) { const bf16x8_t kf = *(const LAS bf16x8_t*)(Kl + (kt * 16 + qi) * 144 + ks * 64 + quad * 16); a = __builtin_amdgcn_mfma_f32_16x16x32_bf16(kf, qf[ks], a, 0, 0, 0); }
            sc[kt] = a; if ((kt & 3) == 3) asm volatile("" ::: "memory"); }
        const int tloc = tl - n * 256;
        float mx = -INFINITY; const float sbase = slope2 * (float)(quad * 4); const int tq4 = tloc - quad * 4;
#pragma unroll
        for (int kt = 0; kt < 16; ++kt)
#pragma unroll
            for (int e = 0; e < 4; ++e) { float s = fmaf(slope2, (float)(kt * 16 + e), sc[kt][e] + sbase); if (own_item && (kt * 16 + e) > tq4) s = -INFINITY; sc[kt][e] = s; mx = fmaxf(mx, s); }
        mx = fmaxf(mx, __shfl_xor(mx, 16)); mx = fmaxf(mx, __shfl_xor(mx, 32));
        float ls = 0.f;
#pragma unroll
        for (int kt = 0; kt < 16; ++kt)
#pragma unroll
            for (int e = 0; e < 4; ++e) { const float p = __builtin_amdgcn_exp2f(sc[kt][e] - mx); sc[kt][e] = p; ls += p; }
        ls += __shfl_xor(ls, 16); ls += __shfl_xor(ls, 32);
        f32x4 o[4];
#pragma unroll
        for (int dt = 0; dt < 4; ++dt) o[dt] = (f32x4){0.f, 0.f, 0.f, 0.f};
#pragma unroll
        for (int k2 = 0; k2 < 8; ++k2) {
            u32x4 pw; pw.x = pg8::cvt_pk_bf16(sc[2 * k2][0], sc[2 * k2][1]); pw.y = pg8::cvt_pk_bf16(sc[2 * k2][2], sc[2 * k2][3]);
            pw.z = pg8::cvt_pk_bf16(sc[2 * k2 + 1][0], sc[2 * k2 + 1][1]); pw.w = pg8::cvt_pk_bf16(sc[2 * k2 + 1][2], sc[2 * k2 + 1][3]);
            const bf16x8_t pf = __builtin_bit_cast(bf16x8_t, pw);
#pragma unroll
            for (int dt = 0; dt < 4; ++dt) { const LAS unsigned char* vp = Vl + (dt * 16 + qi) * 528 + (k2 * 32 + quad * 4) * 2;
                const u32x2 lo = *(const LAS u32x2*)vp, hi = *(const LAS u32x2*)(vp + 32);
                const u32x4 vw = {lo.x, lo.y, hi.x, hi.y};
                o[dt] = __builtin_amdgcn_mfma_f32_16x16x32_bf16(__builtin_bit_cast(bf16x8_t, vw), pf, o[dt], 0, 0, 0); }
            if (k2 & 1) asm volatile("" ::: "memory"); }
        if (valid) { const float inv = 1.0f / ls; const size_t pidx = (t * 8 + h) * 4 + j; bf16* op = PO + pidx * 64 + quad * 4;
#pragma unroll
            for (int dt = 0; dt < 4; ++dt) *(u32x2*)(op + dt * 16) = (u32x2){pg8::cvt_pk_bf16(o[dt][0] * inv, o[dt][1] * inv), pg8::cvt_pk_bf16(o[dt][2] * inv, o[dt][3] * inv)};
            if (quad == 0) ((float2*)PML)[pidx] = make_float2(mx - slope2 * (float)tloc, ls); }
    }
    __syncthreads();
}
DI void comb_phase(Frame& F) {
    const bf16* PO = (const bf16*)(WSP(F) + WS_PARTO); const float* PML = (const float*)(WSP(F) + WS_PARTML); bf16* Y = (bf16*)(WSP(F) + WS_YATTN);
    const int gw = F.bid * 8 + F.wave, NGW = F.G * 8, lane = F.lane, h = lane >> 3, dc = lane & 7;
    for (int t = gw; t < T; t += NGW) {
        const int own = (t % SEQ) >> 8, nsel = own < 3 ? own : 3; const size_t pb = ((size_t)t * 8 + h) * 4;
        float m[4], lw[4]; float M = -INFINITY;
#pragma unroll
        for (int j = 0; j < 4; ++j) { const bool ok = (j == 3) || (j < nsel); const float2 ml = ok ? ((const float2*)PML)[pb + j] : make_float2(-INFINITY, 0.f); m[j] = ml.x; lw[j] = ml.y; M = fmaxf(M, ml.x); }
        float acc[8] = {0.f, 0.f, 0.f, 0.f, 0.f, 0.f, 0.f, 0.f}; float wsum = 0.f;
#pragma unroll
        for (int j = 0; j < 4; ++j) { const bool ok = (j == 3) || (j < nsel); if (!ok) continue;
            const float w = __builtin_amdgcn_exp2f(m[j] - M) * lw[j]; wsum += w; const u32x4 ow = *(const u32x4*)(PO + (pb + j) * 64 + dc * 8);
            acc[0] += w * blo(ow.x); acc[1] += w * bhi(ow.x); acc[2] += w * blo(ow.y); acc[3] += w * bhi(ow.y); acc[4] += w * blo(ow.z); acc[5] += w * bhi(ow.z); acc[6] += w * blo(ow.w); acc[7] += w * bhi(ow.w); }
        const float inv = 1.0f / wsum;
        *(u32x4*)(Y + (size_t)t * 512 + h * 64 + dc * 8) = (u32x4){pk2(acc[0] * inv, acc[1] * inv), pk2(acc[2] * inv, acc[3] * inv), pk2(acc[4] * inv, acc[5] * inv), pk2(acc[6] * inv, acc[7] * inv)};
    }
}
DI void pool_phase(Frame& F, int l) {
    const bf16* Z = (const bf16*)(WSP(F) + WS_POOLZ); bf16* Y = (bf16*)(WSP(F) + WS_YPOOL); const bf16* WPT = (const bf16*)(WSP(F) + WS_WPT);
    LAS unsigned char* Pl = F.lds;
    const int lane = F.lane, li = lane & 15, quad = lane >> 4, g = F.wave >> 1, dt0 = (F.wave & 1) * 4;
    bf16x8_t wf[4][4];
#pragma unroll
    for (int dt = 0; dt < 4; ++dt)
#pragma unroll
        for (int ks = 0; ks < 4; ++ks) wf[dt][ks] = *(const bf16x8_t*)(WPT + ((size_t)g * 128 + 16 * (dt0 + dt) + li) * 128 + 32 * ks + 8 * quad);
    for (int tile = F.bid; tile < T / 64; tile += F.G) {
        __syncthreads();
#pragma unroll 1
        for (int i = F.tid; i < 64 * 64; i += 512) { const int tt = i >> 6, ch = i & 63, gg = ch >> 4, win = 2 << gg, t = tile * 64 + tt, tl = t % SEQ; const int cnt = (tl + 1 < win) ? tl + 1 : win;
            u32x4 w[16];
#pragma unroll
            for (int j = 0; j < 16; ++j) { w[j] = (u32x4){0u, 0u, 0u, 0u}; if (j < cnt) w[j] = *(const u32x4*)(Z + (size_t)(t - j) * 512 + ch * 8); }
            float s[8] = {0.f, 0.f, 0.f, 0.f, 0.f, 0.f, 0.f, 0.f};
#pragma unroll
            for (int j = 0; j < 16; ++j) { s[0] += blo(w[j].x); s[1] += bhi(w[j].x); s[2] += blo(w[j].y); s[3] += bhi(w[j].y); s[4] += blo(w[j].z); s[5] += bhi(w[j].z); s[6] += blo(w[j].w); s[7] += bhi(w[j].w); }
            const float inv = 1.0f / (float)cnt;
            *(LAS u32x4*)(Pl + tt * 1040 + ch * 16) = (u32x4){pk2(s[0] * inv - blo(w[0].x), s[1] * inv - bhi(w[0].x)), pk2(s[2] * inv - blo(w[0].y), s[3] * inv - bhi(w[0].y)),
                                                                 pk2(s[4] * inv - blo(w[0].z), s[5] * inv - bhi(w[0].z)), pk2(s[6] * inv - blo(w[0].w), s[7] * inv - bhi(w[0].w))}; }
        __syncthreads();
#pragma unroll
        for (int tt = 0; tt < 4; ++tt) {
            bf16x8_t pf[4];
#pragma unroll
            for (int ks = 0; ks < 4; ++ks) pf[ks] = *(const LAS bf16x8_t*)(Pl + (16 * tt + li) * 1040 + (g * 128 + 32 * ks + 8 * quad) * 2);
#pragma unroll
            for (int dt = 0; dt < 4; ++dt) { f32x4 acc = {0.f, 0.f, 0.f, 0.f};
#pragma unroll
                for (int ks = 0; ks < 4; ++ks) acc = __builtin_amdgcn_mfma_f32_16x16x32_bf16(wf[dt][ks], pf[ks], acc, 0, 0, 0);
                *(u32x2*)(Y + (size_t)(tile * 64 + 16 * tt + li) * 512 + g * 128 + 16 * (dt0 + dt) + 4 * quad) = (u32x2){pk2(acc[0], acc[1]), pk2(acc[2], acc[3])}; } }
    }
    __syncthreads();
}
DI void rwkv_prep_phase(Frame& F, int l) {
    const bf16* RZ = (const bf16*)(WSP(F) + WS_RWKVZ); bf16* VF = (bf16*)(WSP(F) + WS_VFIRST);
    bf16* AR = (bf16*)(WSP(F) + WS_AR); const size_t AS = (size_t)T * 512;
    float* bonus = (float*)(WSP(F) + WS_BONUS); const bf16* WLT = (const bf16*)(WSP(F) + WS_WLT);
    LAS unsigned char* Al = F.lds;
    const int h = F.wave;
    const float* mu = INP(F, 4) + l * 1792; const float* vmu = INP(F, 5) + (l > 0 ? (l - 1) * 32 : 0);
    const float* w0p = INP(F, 6) + l * 512 + h * 64; const float* a0p = INP(F, 8) + l * 512 + h * 64; const float* kkp = INP(F, 11) + l * 512 + h * 64;
    const float* kap = INP(F, 12) + l * 512 + h * 64; const float* rkp = INP(F, 13) + l * 512 + h * 64; const float* v0p = INP(F, 16) + (l > 0 ? l - 1 : 0) * 512 + h * 64;
    const int nch = l > 0 ? 36 : 32;
    for (int item = F.bid; item < T / 64; item += F.G) {
        int lane = F.lane; asm volatile("" : "+v"(lane));
        const int li = lane & 15, quad = lane >> 4;
        const int t0 = item * 64, tl0 = t0 % SEQ;
        __syncthreads();
        for (int i = F.tid; i < 64 * nch; i += 512) { const int tok = i / nch, c = i % nch, col = 1536 + 8 * c; const size_t t = (size_t)(t0 + tok);
            const u32x4 zc = *(const u32x4*)(RZ + t * RZP + col); u32x4 zp = {0u, 0u, 0u, 0u}; if (tl0 + tok != 0) zp = *(const u32x4*)(RZ + (t - 1) * RZP + col);
            const float* mp = col < 1792 ? mu + col : vmu + (col - 1792); const f32x4 m0 = *(const f32x4*)mp, m1 = *(const f32x4*)(mp + 4);
            const float cv[8] = {blo(zc.x), bhi(zc.x), blo(zc.y), bhi(zc.y), blo(zc.z), bhi(zc.z), blo(zc.w), bhi(zc.w)}, pv[8] = {blo(zp.x), bhi(zp.x), blo(zp.y), bhi(zp.y), blo(zp.z), bhi(zp.z), blo(zp.w), bhi(zp.w)};
            const float mm[8] = {m0.x, m0.y, m0.z, m0.w, m1.x, m1.y, m1.z, m1.w}; float f[8];
#pragma unroll
            for (int e = 0; e < 8; ++e) { const float zs = cv[e] + (pv[e] - cv[e]) * mm[e]; f[e] = c < 8 ? tanhf(zs) : (c >= 16 && c < 32) ? sigmoidf_(zs) : zs; }
            *(LAS u32x4*)(Al + tok * 592 + c * 16) = (u32x4){pk2(f[0], f[1]), pk2(f[2], f[3]), pk2(f[4], f[5]), pk2(f[6], f[7])}; }
        __syncthreads();
#pragma unroll 1
        for (int rt = 0; rt < 4; ++rt) {
            const int tok = 16 * rt + li; const size_t t = (size_t)(t0 + tok);
            f32x4 aw[4], aa[4], ag[4], av[4];
#pragma unroll
            for (int ct = 0; ct < 4; ++ct) { aw[ct] = (f32x4){0.f, 0.f, 0.f, 0.f}; aa[ct] = aw[ct]; ag[ct] = aw[ct]; av[ct] = aw[ct]; }
#pragma unroll
            for (int ks = 0; ks < 9; ++ks) { if (ks == 8 && l == 0) break;
                const bf16x8_t bfr = *(const LAS bf16x8_t*)(Al + tok * 592 + ks * 64 + quad * 16);
#pragma unroll
                for (int ct = 0; ct < 4; ++ct) { const bf16x8_t afr = *(const bf16x8_t*)(WLT + (size_t)(h * 64 + 16 * ct + li) * 288 + 32 * ks + 8 * quad);
                    if (ks < 2) aw[ct] = __builtin_amdgcn_mfma_f32_16x16x32_bf16(afr, bfr, aw[ct], 0, 0, 0);
                    else if (ks < 4) aa[ct] = __builtin_amdgcn_mfma_f32_16x16x32_bf16(afr, bfr, aa[ct], 0, 0, 0);
                    else if (ks < 8) ag[ct] = __builtin_amdgcn_mfma_f32_16x16x32_bf16(afr, bfr, ag[ct], 0, 0, 0);
                    else av[ct] = __builtin_amdgcn_mfma_f32_16x16x32_bf16(afr, bfr, av[ct], 0, 0, 0); }
                if (ks & 1) asm volatile("" ::: "memory"); }
            const bool first = (tl0 + tok == 0);
            float kk[4][4], as_[4][4]; float ss = 0.f, bs = 0.f;
#pragma unroll
            for (int ct = 0; ct < 4; ++ct) { const int cb = 16 * ct + 4 * quad; const size_t zi = t * RZP + h * 64 + cb;
                const u32x2 cr = *(const u32x2*)(RZ + zi), ck = *(const u32x2*)(RZ + zi + 512), cvv = *(const u32x2*)(RZ + zi + 1024);
                u32x2 pr = {0u, 0u}, pk_ = {0u, 0u}, pvv = {0u, 0u};
                if (!first) { pr = *(const u32x2*)(RZ + zi - RZP); pk_ = *(const u32x2*)(RZ + zi - RZP + 512); pvv = *(const u32x2*)(RZ + zi - RZP + 1024); }
                const f32x4 mr = *(const f32x4*)(mu + h * 64 + cb), mk = *(const f32x4*)(mu + 512 + h * 64 + cb), mv = *(const f32x4*)(mu + 1024 + h * 64 + cb);
                const f32x4 w0 = *(const f32x4*)(w0p + cb), a0 = *(const f32x4*)(a0p + cb), kkc = *(const f32x4*)(kkp + cb), kac = *(const f32x4*)(kap + cb), rkc = *(const f32x4*)(rkp + cb);
                const float crf[4] = {blo(cr.x), bhi(cr.x), blo(cr.y), bhi(cr.y)}, ckf[4] = {blo(ck.x), bhi(ck.x), blo(ck.y), bhi(ck.y)}, cvf[4] = {blo(cvv.x), bhi(cvv.x), blo(cvv.y), bhi(cvv.y)};
                const float prf[4] = {blo(pr.x), bhi(pr.x), blo(pr.y), bhi(pr.y)}, pkf[4] = {blo(pk_.x), bhi(pk_.x), blo(pk_.y), bhi(pk_.y)}, pvf[4] = {blo(pvv.x), bhi(pvv.x), blo(pvv.y), bhi(pvv.y)};
                float vo[4], lwo[4], ro[4], kpo[4];
                const size_t idx = t * 512 + h * 64 + cb;
                u32x2 vfw = {0u, 0u}; f32x4 v0 = {0.f, 0.f, 0.f, 0.f}; if (l > 0) { vfw = *(const u32x2*)(VF + idx); v0 = *(const f32x4*)(v0p + cb); }
                const float vff[4] = {blo(vfw.x), bhi(vfw.x), blo(vfw.y), bhi(vfw.y)};
#pragma unroll
                for (int e = 0; e < 4; ++e) { const float r = crf[e] + (prf[e] - crf[e]) * mr[e], k = ckf[e] + (pkf[e] - ckf[e]) * mk[e]; float v = cvf[e] + (pvf[e] - cvf[e]) * mv[e];
                    const float xw = -(w0[e] + aw[ct][e]); const float sp = xw > 20.f ? xw : log1pf(__expf(xw)); lwo[e] = -__expf(-sp - 0.5f);
                    const float asig = sigmoidf_(a0[e] + aa[ct][e]);
                    if (l > 0) v = v + (vff[e] - v) * sigmoidf_(v0[e] + av[ct][e]);
                    vo[e] = v; ro[e] = r; as_[ct][e] = asig; const float kr = k * kkc[e]; kk[ct][e] = kr; ss += kr * kr;
                    const float kpe = k * (1.0f + (asig - 1.0f) * kac[e]); kpo[e] = kpe; bs += r * kpe * rkc[e]; }
                if (l == 0) *(u32x2*)(VF + idx) = (u32x2){pk2(vo[0], vo[1]), pk2(vo[2], vo[3])};
                *(u32x2*)(AR + idx) = (u32x2){pk2(ro[0], ro[1]), pk2(ro[2], ro[3])};
                *(u32x2*)(AR + 2 * AS + idx) = (u32x2){pk2(kpo[0], kpo[1]), pk2(kpo[2], kpo[3])};
                *(u32x2*)(AR + AS + idx) = (u32x2){pk2(lwo[0], lwo[1]), pk2(lwo[2], lwo[3])};
                *(u32x2*)(AR + 3 * AS + idx) = (u32x2){pk2(vo[0], vo[1]), pk2(vo[2], vo[3])};
                *(u32x2*)(AR + 6 * AS + idx) = (u32x2){pk2(ag[ct][0], ag[ct][1]), pk2(ag[ct][2], ag[ct][3])}; asm volatile("" ::: "memory"); }
            ss += __shfl_xor(ss, 16); ss += __shfl_xor(ss, 32); bs += __shfl_xor(bs, 16); bs += __shfl_xor(bs, 32);
            const float inv = 1.0f / fmaxf(sqrtf(ss), 1e-12f);
#pragma unroll
            for (int ct = 0; ct < 4; ++ct) { const size_t idx = t * 512 + h * 64 + 16 * ct + 4 * quad; float kn[4], bb[4];
#pragma unroll
                for (int e = 0; e < 4; ++e) { kn[e] = kk[ct][e] * inv; bb[e] = kn[e] * as_[ct][e]; }
                *(u32x2*)(AR + 4 * AS + idx) = (u32x2){pk2(kn[0], kn[1]), pk2(kn[2], kn[3])};
                *(u32x2*)(AR + 5 * AS + idx) = (u32x2){pk2(bb[0], bb[1]), pk2(bb[2], bb[3])}; }
            if (quad == 0) bonus[t * 8 + h] = bs;
        }
    }
    __syncthreads();
}
DI void rwkv_chunk_phase(Frame& F) {
    const bf16* AR = (const bf16*)(WSP(F) + WS_AR); const size_t AS = (size_t)T * 512;
    bf16* PCT = (bf16*)(WSP(F) + WS_PCT); bf16* LC = (bf16*)(WSP(F) + WS_LC); bf16* RM = (bf16*)(WSP(F) + WS_RM); bf16* Y0 = (bf16*)(WSP(F) + WS_Y0);
    LAS float* sb = (LAS float*)(F.lds + F.wave * 12288);
    const int gw = F.bid * 8 + F.wave, NGW = F.G * 8;
    for (int it = gw; it < BATCH * 8 * (SEQ / 64); it += NGW) {
        int lane = F.lane; asm volatile("" : "+v"(lane));
        const int bh = it >> 8, ck = it & 255, b = bh >> 3, h = bh & 7;
        float S1[64], S2[64];
#pragma unroll
        for (int i = 0; i < 64; ++i) { S1[i] = (i == lane) ? 1.f : 0.f; S2[i] = 0.f; }
        const size_t ubase = ((size_t)b * SEQ + ck * 64) * 512 + h * 64;
        bf16* rm = RM + (size_t)it * 4096; bf16* y0 = Y0 + (size_t)it * 4096;
        for (int t0 = 0; t0 < 64; t0 += 8) {
#pragma unroll
            for (int s = 0; s < 8; ++s) { const bf16* ap = AR + ubase + (size_t)(t0 + s) * 512;
                sb[(s * 6 + 0) * 64 + lane] = -bf2f((ap + 4 * AS)[lane]);
                sb[(s * 6 + 1) * 64 + lane] = bf2f((ap + 5 * AS)[lane]);
                sb[(s * 6 + 2) * 64 + lane] = bf2f((ap + 2 * AS)[lane]);
                sb[(s * 6 + 3) * 64 + lane] = __expf(bf2f((ap + AS)[lane]));
                sb[(s * 6 + 4) * 64 + lane] = bf2f(ap[lane]);
                sb[(s * 6 + 5) * 64 + lane] = bf2f((ap + 3 * AS)[lane]); if (s & 1) asm volatile("" ::: "memory"); }
            LDS_WAIT(); asm volatile("" ::: "memory");
#pragma unroll 1
            for (int s = 0; s < 8; ++s) {
                const LAS f32x4* pa = (const LAS f32x4*)(sb + (s * 6 + 0) * 64); const LAS f32x4* pb = (const LAS f32x4*)(sb + (s * 6 + 1) * 64);
                const LAS f32x4* pk = (const LAS f32x4*)(sb + (s * 6 + 2) * 64); const LAS f32x4* pw = (const LAS f32x4*)(sb + (s * 6 + 3) * 64);
                const LAS f32x4* pr = (const LAS f32x4*)(sb + (s * 6 + 4) * 64);
                const float v = sb[(s * 6 + 5) * 64 + lane];
                float a0 = 0.f, a1 = 0.f, c0 = 0.f, c1 = 0.f;
#pragma unroll
                for (int i = 0; i < 16; ++i) { const f32x4 a = pa[i];
                    a0 += S1[4 * i] * a.x + S1[4 * i + 2] * a.z; a1 += S1[4 * i + 1] * a.y + S1[4 * i + 3] * a.w;
                    c0 += S2[4 * i] * a.x + S2[4 * i + 2] * a.z; c1 += S2[4 * i + 1] * a.y + S2[4 * i + 3] * a.w;
                    if ((i & 7) == 7) asm volatile("" ::: "memory"); }
                const float sa1 = a0 + a1, sa2 = c0 + c1;
                float y1a = 0.f, y1b = 0.f, y2a = 0.f, y2b = 0.f;
#pragma unroll
                for (int i = 0; i < 16; ++i) { const f32x4 bb = pb[i], kk = pk[i], ww = pw[i], rr = pr[i];
                    S1[4 * i] = S1[4 * i] * ww.x + sa1 * bb.x; S1[4 * i + 1] = S1[4 * i + 1] * ww.y + sa1 * bb.y; S1[4 * i + 2] = S1[4 * i + 2] * ww.z + sa1 * bb.z; S1[4 * i + 3] = S1[4 * i + 3] * ww.w + sa1 * bb.w;
                    S2[4 * i] = S2[4 * i] * ww.x + (sa2 * bb.x + v * kk.x); S2[4 * i + 1] = S2[4 * i + 1] * ww.y + (sa2 * bb.y + v * kk.y);
                    S2[4 * i + 2] = S2[4 * i + 2] * ww.z + (sa2 * bb.z + v * kk.z); S2[4 * i + 3] = S2[4 * i + 3] * ww.w + (sa2 * bb.w + v * kk.w);
                    y1a += S1[4 * i] * rr.x + S1[4 * i + 2] * rr.z; y1b += S1[4 * i + 1] * rr.y + S1[4 * i + 3] * rr.w;
                    y2a += S2[4 * i] * rr.x + S2[4 * i + 2] * rr.z; y2b += S2[4 * i + 1] * rr.y + S2[4 * i + 3] * rr.w;
                    if ((i & 3) == 3) asm volatile("" ::: "memory"); }
                (rm + (t0 + s) * 64)[lane] = (bf16)f2bf(y1a + y1b); (y0 + (t0 + s) * 64)[lane] = (bf16)f2bf(y2a + y2b);
            }
            LDS_WAIT(); asm volatile("" ::: "memory");
        }
        { u32x4* lp = (u32x4*)(LC + (size_t)it * 4096 + lane * 64);
#pragma unroll
          for (int i = 0; i < 8; ++i) lp[i] = (u32x4){pk2(S2[8 * i], S2[8 * i + 1]), pk2(S2[8 * i + 2], S2[8 * i + 3]), pk2(S2[8 * i + 4], S2[8 * i + 5]), pk2(S2[8 * i + 6], S2[8 * i + 7])};
          bf16* pp = PCT + (size_t)it * 4096;
#pragma unroll
          for (int k = 0; k < 64; ++k) (pp + k * 64)[lane] = (bf16)f2bf(S1[k]); }
    }
}
DI void rwkv_state_phase(Frame& F) {
    if (F.bid >= BATCH * 8) return;
    constexpr int SLOT = 18432, NSL = 6;
    const int bh = F.bid, wave = F.wave, lane = F.lane;
    const bf16* PCT = (const bf16*)(WSP(F) + WS_PCT) + (size_t)bh * 256 * 4096; const bf16* LC = (const bf16*)(WSP(F) + WS_LC) + (size_t)bh * 256 * 4096;
    bf16* S0 = (bf16*)(WSP(F) + WS_S0) + (size_t)bh * 256 * 4096;
    LAS unsigned char* ring = F.lds;
#define RBAR() do { asm volatile("s_waitcnt lgkmcnt(0)" ::: "memory"); __builtin_amdgcn_s_barrier(); asm volatile("" ::: "memory"); } while (0)
    if (wave >= 4) {
        const int lw = wave - 4; u32x4 rg[3][4];
        unsigned loff[4];
#pragma unroll
        for (int i = 0; i < 4; ++i) { const int p = i * 256 + lw * 64 + lane, pp = p & 511; loff[i] = (unsigned)((p >> 9) * 9216 + (pp >> 3) * 144 + (pp & 7) * 16); }
#define RLOAD(q, x) do { const u32x4* s0_ = (const u32x4*)(PCT + (size_t)(x) * 4096) + lw * 64 + lane; const u32x4* s1_ = (const u32x4*)(LC + (size_t)(x) * 4096) + lw * 64 + lane; \
            rg[q][0] = s0_[0]; rg[q][1] = s0_[256]; rg[q][2] = s1_[0]; rg[q][3] = s1_[256]; } while (0)
#define RWRITE(q, x) do { LAS unsigned char* d_ = ring + ((x) % NSL) * SLOT; _Pragma("unroll") for (int i = 0; i < 4; ++i) *(LAS u32x4*)(d_ + loff[i]) = rg[q][i]; } while (0)
        RLOAD(0, 0); RLOAD(1, 1); RLOAD(2, 2);
        RWRITE(0, 0); RWRITE(1, 1); RWRITE(2, 2);
        RLOAD(0, 3); RLOAD(1, 4); RLOAD(2, 5);
        RBAR();
#pragma unroll 1
        for (int c0 = 0; c0 < 256; c0 += 3) {
#pragma unroll
            for (int j = 0; j < 3; ++j) { const int c = c0 + j; if (c < 256) { const int x = c + 3;
                if (x < 256) { RWRITE(j, x); if (x + 3 < 256) RLOAD(j, x + 3); }
                RBAR(); } }
        }
#undef RLOAD
#undef RWRITE
    } else {
        const int vb = wave, vl = lane & 15, quad = lane >> 4;
        f32x4 st[4];
#pragma unroll
        for (int kt = 0; kt < 4; ++kt) st[kt] = (f32x4){0.f, 0.f, 0.f, 0.f};
        const unsigned aoff = (unsigned)(vl * 144 + quad * 8), loffc = (unsigned)(9216 + (16 * vb + vl) * 144 + quad * 8);
        RBAR();
#pragma unroll 1
        for (int c = 0; c < 256; ++c) {
            const LAS unsigned char* sl = ring + (c % NSL) * SLOT;
            u32x2 af[4][2][2], lf[4];
#pragma unroll
            for (int kt = 0; kt < 4; ++kt) {
#pragma unroll
                for (int s2 = 0; s2 < 2; ++s2) { af[kt][s2][0] = *(const LAS u32x2*)(sl + aoff + kt * 16 * 144 + s2 * 64); af[kt][s2][1] = *(const LAS u32x2*)(sl + aoff + kt * 16 * 144 + s2 * 64 + 32); }
                lf[kt] = *(const LAS u32x2*)(sl + loffc + kt * 32); }
            bf16x8_t bfr[2];
            { u32x2 pk[4];
#pragma unroll
              for (int kt = 0; kt < 4; ++kt) { pk[kt] = (u32x2){pg8::cvt_pk_bf16(st[kt][0], st[kt][1]), pg8::cvt_pk_bf16(st[kt][2], st[kt][3])};
                  *(u32x2*)(S0 + (size_t)c * 4096 + (16 * vb + vl) * 64 + 16 * kt + 4 * quad) = pk[kt]; }
              bfr[0] = __builtin_bit_cast(bf16x8_t, (u32x4){pk[0].x, pk[0].y, pk[1].x, pk[1].y}); bfr[1] = __builtin_bit_cast(bf16x8_t, (u32x4){pk[2].x, pk[2].y, pk[3].x, pk[3].y}); }
#pragma unroll
            for (int kt = 0; kt < 4; ++kt) { f32x4 acc = (f32x4){blo(lf[kt].x), bhi(lf[kt].x), blo(lf[kt].y), bhi(lf[kt].y)};
                acc = __builtin_amdgcn_mfma_f32_16x16x32_bf16(__builtin_bit_cast(bf16x8_t, (u32x4){af[kt][0][0].x, af[kt][0][0].y, af[kt][0][1].x, af[kt][0][1].y}), bfr[0], acc, 0, 0, 0);
                acc = __builtin_amdgcn_mfma_f32_16x16x32_bf16(__builtin_bit_cast(bf16x8_t, (u32x4){af[kt][1][0].x, af[kt][1][0].y, af[kt][1][1].x, af[kt][1][1].y}), bfr[1], acc, 0, 0, 0);
                st[kt] = acc; }
            RBAR();
        }
    }
#undef RBAR
}
DI void rwkv_out_phase(Frame& F, int l) {
    bf16* AR = (bf16*)(WSP(F) + WS_AR); const size_t AS = (size_t)T * 512; const float* bonus = (const float*)(WSP(F) + WS_BONUS);
    const bf16* RM = (const bf16*)(WSP(F) + WS_RM); const bf16* Y0 = (const bf16*)(WSP(F) + WS_Y0); const bf16* S0 = (const bf16*)(WSP(F) + WS_S0);
    const int gw = F.bid * 8 + F.wave, NGW = F.G * 8, lane = F.lane, li = lane & 15, quad = lane >> 4;
    for (int it = gw; it < BATCH * 8 * (SEQ / 64); it += NGW) {
        const int bh = it >> 8, ck = it & 255, b = bh >> 3, h = bh & 7;
        const bf16* s0 = S0 + (size_t)it * 4096; const bf16* rm = RM + (size_t)it * 4096; const bf16* y0 = Y0 + (size_t)it * 4096;
        bf16x8_t sa[4][2];
#pragma unroll
        for (int vt = 0; vt < 4; ++vt)
#pragma unroll
            for (int s2 = 0; s2 < 2; ++s2) sa[vt][s2] = *(const bf16x8_t*)(s0 + (16 * vt + li) * 64 + 32 * s2 + 8 * quad);
        float lg[4][4], lb[4][4];
#pragma unroll
        for (int vt = 0; vt < 4; ++vt) { const f32x4 g4 = *(const f32x4*)(INP(F, 14) + l * 512 + h * 64 + 16 * vt + 4 * quad), b4 = *(const f32x4*)(INP(F, 15) + l * 512 + h * 64 + 16 * vt + 4 * quad);
            lg[vt][0] = g4.x; lg[vt][1] = g4.y; lg[vt][2] = g4.z; lg[vt][3] = g4.w; lb[vt][0] = b4.x; lb[vt][1] = b4.y; lb[vt][2] = b4.z; lb[vt][3] = b4.w; }
#pragma unroll 1
        for (int tt = 0; tt < 4; ++tt) {
            const int tch = 16 * tt + li; const size_t t = (size_t)b * SEQ + ck * 64 + tch;
            bf16x8_t rb[2];
#pragma unroll
            for (int s2 = 0; s2 < 2; ++s2) rb[s2] = *(const bf16x8_t*)(rm + tch * 64 + 32 * s2 + 8 * quad);
            f32x4 acc[4];
#pragma unroll
            for (int vt = 0; vt < 4; ++vt) { const u32x2 yw = *(const u32x2*)(y0 + tch * 64 + 16 * vt + 4 * quad); acc[vt] = (f32x4){blo(yw.x), bhi(yw.x), blo(yw.y), bhi(yw.y)};
                acc[vt] = __builtin_amdgcn_mfma_f32_16x16x32_bf16(sa[vt][0], rb[0], acc[vt], 0, 0, 0); acc[vt] = __builtin_amdgcn_mfma_f32_16x16x32_bf16(sa[vt][1], rb[1], acc[vt], 0, 0, 0); }
            float sm = 0.f;
#pragma unroll
            for (int vt = 0; vt < 4; ++vt) sm += (acc[vt][0] + acc[vt][1]) + (acc[vt][2] + acc[vt][3]);
            sm += __shfl_xor(sm, 16); sm += __shfl_xor(sm, 32);
            const float mean = sm * (1.f / 64.f); float sq = 0.f;
#pragma unroll
            for (int vt = 0; vt < 4; ++vt)
#pragma unroll
                for (int e = 0; e < 4; ++e) { const float d = acc[vt][e] - mean; acc[vt][e] = d; sq += d * d; }
            sq += __shfl_xor(sq, 16); sq += __shfl_xor(sq, 32);
            const float rstd = rsqrtf(sq * (1.f / 64.f) + 64e-5f), bon = bonus[t * 8 + h];
            const size_t idx = t * 512 + h * 64 + 4 * quad;
#pragma unroll
            for (int vt = 0; vt < 4; ++vt) { const u32x2 vw = *(const u32x2*)(AR + 3 * AS + idx + 16 * vt), gw2 = *(const u32x2*)(AR + 6 * AS + idx + 16 * vt);
                const float vv[4] = {blo(vw.x), bhi(vw.x), blo(vw.y), bhi(vw.y)}, gg[4] = {blo(gw2.x), bhi(gw2.x), blo(gw2.y), bhi(gw2.y)}; float o[4];
#pragma unroll
                for (int e = 0; e < 4; ++e) o[e] = (acc[vt][e] * rstd * lg[vt][e] + lb[vt][e] + bon * vv[e]) * gg[e];
                *(u32x2*)(AR + idx + 16 * vt) = (u32x2){pk2(o[0], o[1]), pk2(o[2], o[3])}; }
        }
    }
}
DI void route_phase(Frame& F, int l) {
    const float* x = OUTP(F); bf16* h2 = (bf16*)(WSP(F) + WS_XB); const bf16* RWH = (const bf16*)(WSP(F) + WS_RWG); const bf16* RWL = RWH + 48 * 1024;
    int* route = (int*)(WSP(F) + WS_ROUTE); float* rwt = (float*)(WSP(F) + WS_RWT); unsigned* cnt = (unsigned*)(WSP(F) + WS_CTL) + CW_CNT + 32 * l;
    const float* rgb = INP(F, 24) + l * 4; const float* reb = INP(F, 26) + l * 32;
    LAS unsigned* lc = (LAS unsigned*)(F.lds + MISC_OFF + 8192); unsigned* wgbase = (unsigned*)(WSP(F) + WS_WGBASE);
    for (int wit = F.bid; wit < T / 128; wit += F.G) {
        int lane = F.lane; asm volatile("" : "+v"(lane));
        __syncthreads();
        if (F.tid < 32) lc[F.tid] = 0u;
        __syncthreads();
        const int it = wit * 8 + F.wave;
        const int li = lane & 15, quad = lane >> 4; const size_t t = (size_t)it * 16 + li;
        const float* xr = x + t * DM + 8 * quad;
        f32x4 acc[3];
#pragma unroll
        for (int jt = 0; jt < 3; ++jt) acc[jt] = (f32x4){0.f, 0.f, 0.f, 0.f};
        float ss = 0.f;
#pragma unroll 2
        for (int ks = 0; ks < 32; ++ks) {
            const f32x4 x0 = *(const f32x4*)(xr + 32 * ks), x1 = *(const f32x4*)(xr + 32 * ks + 4);
            ss += (x0.x * x0.x + x0.y * x0.y) + (x0.z * x0.z + x0.w * x0.w) + (x1.x * x1.x + x1.y * x1.y) + (x1.z * x1.z + x1.w * x1.w);
            const float xf[8] = {x0.x, x0.y, x0.z, x0.w, x1.x, x1.y, x1.z, x1.w}; unsigned hb[8]; float lo[8];
#pragma unroll
            for (int e = 0; e < 8; ++e) { hb[e] = f2bf(xf[e]); lo[e] = xf[e] - __uint_as_float(hb[e] << 16); }
            const bf16x8_t bh = __builtin_bit_cast(bf16x8_t, (u32x4){hb[0] | (hb[1] << 16), hb[2] | (hb[3] << 16), hb[4] | (hb[5] << 16), hb[6] | (hb[7] << 16)});
            const bf16x8_t bl = __builtin_bit_cast(bf16x8_t, (u32x4){pk2(lo[0], lo[1]), pk2(lo[2], lo[3]), pk2(lo[4], lo[5]), pk2(lo[6], lo[7])});
#pragma unroll
            for (int jt = 0; jt < 3; ++jt) { const size_t wo = (size_t)(16 * jt + li) * 1024 + 32 * ks + 8 * quad;
                const bf16x8_t wh = *(const bf16x8_t*)(RWH + wo), wl = *(const bf16x8_t*)(RWL + wo);
                acc[jt] = __builtin_amdgcn_mfma_f32_16x16x32_bf16(wh, bh, acc[jt], 0, 0, 0);
                acc[jt] = __builtin_amdgcn_mfma_f32_16x16x32_bf16(wl, bh, acc[jt], 0, 0, 0);
                acc[jt] = __builtin_amdgcn_mfma_f32_16x16x32_bf16(wh, bl, acc[jt], 0, 0, 0); }
        }
        ss += __shfl_xor(ss, 16); ss += __shfl_xor(ss, 32);
        const float rs = rsqrtf(ss * (1.f / DM) + 1e-6f);
#pragma unroll 4
        for (int ks = 0; ks < 32; ++ks) { const f32x4 x0 = *(const f32x4*)(xr + 32 * ks), x1 = *(const f32x4*)(xr + 32 * ks + 4);
            *(u32x4*)(h2 + t * DM + 32 * ks + 8 * quad) = (u32x4){pk2(x0.x * rs, x0.y * rs), pk2(x0.z * rs, x0.w * rs), pk2(x1.x * rs, x1.y * rs), pk2(x1.z * rs, x1.w * rs)}; }
        float gl[4]; int grp = 0;
#pragma unroll
        for (int j = 0; j < 4; ++j) gl[j] = acc[0][j] * rs + rgb[j];
        float gm = gl[0];
#pragma unroll
        for (int j = 1; j < 4; ++j) if (gl[j] > gm) { gm = gl[j]; grp = j; }
        if (quad == grp) {
            float gs = 0.f;
#pragma unroll
            for (int j = 0; j < 4; ++j) gs += __expf(gl[j] - gm);
            const float gprob = 1.0f / gs;
            float eg[8];
#pragma unroll
            for (int i = 0; i < 4; ++i) { eg[i] = acc[1][i] * rs + reb[8 * quad + i]; eg[4 + i] = acc[2][i] * rs + reb[8 * quad + 4 + i]; }
            int i0 = 0; float m0 = eg[0];
#pragma unroll
            for (int i = 1; i < 8; ++i) if (eg[i] > m0) { m0 = eg[i]; i0 = i; }
            int i1 = -1; float m1 = -INFINITY;
#pragma unroll
            for (int i = 0; i < 8; ++i) if (i != i0 && eg[i] > m1) { m1 = eg[i]; i1 = i; }
            const float e10 = __expf(m1 - m0), wa = gprob / (1.0f + e10), wb = gprob * e10 / (1.0f + e10);
            const int e0 = grp * 8 + i0, e1 = grp * 8 + i1;
            const unsigned r0 = atomicAdd((unsigned*)(lc + e0), 1u), r1 = atomicAdd((unsigned*)(lc + e1), 1u);
            ((int4*)route)[t] = make_int4(e0, (int)r0, e1, (int)r1); ((float2*)rwt)[t] = make_float2(wa, wb);
        }
        __syncthreads();
        if (F.tid < 32) { const unsigned c = lc[F.tid]; wgbase[wit * 32 + F.tid] = c ? atomicAdd(cnt + F.tid, c) : 0u; }
    }
    __syncthreads();
}
DI int moe_tables(Frame& F, int l) {
    LAS int* ps = (LAS int*)(F.lds + MISC_OFF); LAS unsigned char* te = (LAS unsigned char*)(F.lds + MISC_OFF + 256);
    const unsigned* cnt = (const unsigned*)(WSP(F) + WS_CTL) + CW_CNT + 32 * l;
    __syncthreads();
    if (F.tid == 0) { int acc = 0;
_Pragma("unroll 1")
        for (int e = 0; e < NEXP; ++e) { ps[e] = acc; const int c = (int)__hip_atomic_load(cnt + e, __ATOMIC_RELAXED, __HIP_MEMORY_SCOPE_AGENT); const int nt = (c + 255) >> 8;
_Pragma("unroll 1")
            for (int i = 0; i < nt; ++i) te[(acc >> 8) + i] = (unsigned char)e; acc += nt << 8; } ps[NEXP] = acc; }
    __syncthreads();
    return __builtin_amdgcn_readfirstlane(ps[NEXP] >> 8);
}
DI void permute_phase(Frame& F, int l) {
    moe_tables(F, l);
    const LAS int* ps = (const LAS int*)(F.lds + MISC_OFF);
    const bf16* h2 = (const bf16*)(WSP(F) + WS_XB); bf16* xp = (bf16*)(WSP(F) + WS_XPERM); const int* route = (const int*)(WSP(F) + WS_ROUTE); int* dest = (int*)(WSP(F) + WS_DEST);
    const int gw = F.bid * 8 + F.wave, NGW = F.G * 8, lane = F.lane;
    for (int t = gw; t < T; t += NGW) {
        const int4 r = ((const int4*)route)[t]; const unsigned* wb_ = (const unsigned*)(WSP(F) + WS_WGBASE) + (t >> 7) * 32; const int d0 = ps[r.x] + (int)wb_[r.x] + r.y, d1 = ps[r.z] + (int)wb_[r.z] + r.w;
        const u32x4* src = (const u32x4*)(h2 + (size_t)t * DM) + lane; u32x4* o0 = (u32x4*)(xp + (size_t)d0 * DM) + lane; u32x4* o1 = (u32x4*)(xp + (size_t)d1 * DM) + lane;
        const u32x4 a = src[0], b = src[64]; o0[0] = a; o0[64] = b; o1[0] = a; o1[64] = b;
        if (lane == 0) ((int2*)dest)[t] = make_int2(d0, d1);
    }
}
DI void combine_phase(Frame& F, int l) {
    float* x = OUTP(F); const bf16* Y = (const bf16*)(WSP(F) + WS_YMOE); const int* dest = (const int*)(WSP(F) + WS_DEST); const float* rwt = (const float*)(WSP(F) + WS_RWT);
    bf16* xb = (bf16*)(WSP(F) + WS_XB); const float* fg = INP(F, 30);
    const int gw = F.bid * 8 + F.wave, NGW = F.G * 8, lane = F.lane; const bool last = (l == DEPTH - 1);
    for (int t = gw; t < T; t += NGW) {
        const int2 d = ((const int2*)dest)[t]; const float2 w = ((const float2*)rwt)[t];
        f32x4* xr = (f32x4*)(x + (size_t)t * DM) + lane; const u32x2* y0 = (const u32x2*)(Y + (size_t)d.x * DM) + lane; const u32x2* y1 = (const u32x2*)(Y + (size_t)d.y * DM) + lane;
        f32x4 v[4]; float s = 0.f;
#pragma unroll
        for (int j = 0; j < 4; ++j) { v[j] = xr[64 * j]; const u32x2 a = y0[64 * j], b = y1[64 * j];
            v[j].x += w.x * blo(a.x) + w.y * blo(b.x); v[j].y += w.x * bhi(a.x) + w.y * bhi(b.x); v[j].z += w.x * blo(a.y) + w.y * blo(b.y); v[j].w += w.x * bhi(a.y) + w.y * bhi(b.y);
            s += (v[j].x * v[j].x + v[j].y * v[j].y) + (v[j].z * v[j].z + v[j].w * v[j].w); }
        const float rs = rsqrtf(wave_sum(s) * (1.f / DM) + 1e-6f);
        if (last) {
#pragma unroll
            for (int j = 0; j < 4; ++j) { const f32x4 g = ((const f32x4*)fg)[lane + 64 * j]; xr[64 * j] = v[j] * rs * g; }
        } else {
            u32x2* o = (u32x2*)(xb + (size_t)t * DM) + lane;
#pragma unroll
            for (int j = 0; j < 4; ++j) { xr[64 * j] = v[j]; o[64 * j] = (u32x2){pk2(v[j].x * rs, v[j].y * rs), pk2(v[j].z * rs, v[j].w * rs)}; }
        }
    }
}

DI void dump_bf16(Frame& F, const bf16* src, int pitch, int ncols, int c0) {
    float* out = OUTP(F);
    for (size_t i = (size_t)F.bid * 512 + F.tid; i < (size_t)T * ncols; i += (size_t)F.G * 512) { const size_t t = i / ncols; const int c = (int)(i % ncols); out[t * DM + c0 + c] = bf2f(src[t * pitch + c]); }
}
__global__ void __launch_bounds__(512, 2) mk_fwd(Args args) {
    extern __shared__ __attribute__((aligned(16))) unsigned char lds_raw[];
    cg::grid_group grid = cg::this_grid();
    Frame F; F.lds = (LAS unsigned char*)lds_raw; F.tid = threadIdx.x; F.lane = F.tid & 63; F.wave = __builtin_amdgcn_readfirstlane(F.tid >> 6); F.G = gridDim.x; F.bid = (int)__builtin_amdgcn_workgroup_id_x();
    F.kp = (kargp_t)__builtin_amdgcn_kernarg_segment_ptr();
    for (int u = F.tid; u < 64; u += 512) ((LAS unsigned*)(F.lds + MISC_OFF + 4096))[u] = 0u;
    __syncthreads();
    (void)xcd_barrier_post((unsigned*)(WSP(F) + WS_CTL) + CW_BAR, (volatile LAS unsigned*)(F.lds + MISC_OFF + 4096));
    grid.sync();
#define GRID_BAR() do { XcdBarrier bb_; bb_.bar = (unsigned*)(WSP(F) + WS_CTL) + CW_BAR; bb_.x = xb_xcc_id(); bb_.st = (volatile LAS unsigned*)(F.lds + MISC_OFF + 4096); xcd_barrier(bb_); fence_frame(F); } while (0)
#define ws WSP(F)
#if defined(DBG_TMASK)
#define PT0() const unsigned long long pt0_ = __builtin_amdgcn_s_memrealtime()
#define PT1(k) do { if ((DBG_TMASK >> (k)) & 1) { const unsigned long long n_ = __builtin_amdgcn_s_memrealtime(); const unsigned long long e_ = n_ + (unsigned long long)DBG_AMP * (n_ - pt0_); while (__builtin_amdgcn_s_memrealtime() < e_) __builtin_amdgcn_s_sleep(16); } } while (0)
#else
#define PT0() do {} while (0)
#define PT1(k) do {} while (0)
#endif
    { PT0(); prep_mixer_weights(F, 0);
    rms_rows_to_bf16(F, INP(F, 0), (bf16*)(ws + WS_XB));
    GRID_BAR(); PT1(0); }
#if defined(DBG_STOP) && DBG_STOP == 10
    { PT0(); { pg8::Gemm g{(const bf16*)(ws + WS_XB), (const bf16*)(ws + WS_WG), T, 3072, DM}; pg8::StaticOrder S; S.init(T, 3072, F.G, (int)F.bid);
      pg8::EpiGate E{(bf16*)(ws + WS_GATES), 3072};
      pg8::gemm_phase<pg8::EpiGate, pg8::StaticOrder, true, true>(F.lds, g, S, E); }
    GRID_BAR(); PT1(10); }
    dump_bf16(F, (const bf16*)(ws + WS_GATES) + 1024, 3072, 1024, 0); return;
#endif
#pragma unroll 1
    for (int l = 0; l < DEPTH; ++l) {
        { PT0(); { pg8::Gemm g{(const bf16*)(ws + WS_XB), (const bf16*)(ws + WS_WIN), T, l == 0 ? 3840 : 4096, DM}; pg8::StaticOrder S; S.init(T, g.N, F.G, (int)F.bid);
          pg8::EpiZ E{(bf16*)(ws + WS_Q), (bf16*)(ws + WS_K), (bf16*)(ws + WS_V), (bf16*)(ws + WS_POOLZ), (bf16*)(ws + WS_RWKVZ), C2};
          pg8::gemm_phase<pg8::EpiZ, pg8::StaticOrder, true, true>(F.lds, g, S, E); }
        GRID_BAR(); PT1(1); }
        { PT0(); kmean_phase(F);
        vt_phase(F);
        pool_phase(F, l);
        GRID_BAR(); PT1(2); }
        { PT0(); sel_phase(F, l);
        GRID_BAR(); PT1(3); }
        { PT0(); att_phase(F, l);
        GRID_BAR(); PT1(4); }
        { PT0(); comb_phase(F);
        GRID_BAR(); PT1(5); }
#if defined(DBG_STOP) && DBG_STOP == 3
        dump_bf16(F, (const bf16*)(ws + WS_YATTN), 512, 512, 0); dump_bf16(F, (const bf16*)(ws + WS_YPOOL), 512, 512, 512); return;
#endif
        { PT0(); rwkv_prep_phase(F, l);
        GRID_BAR(); PT1(6); }
        { PT0(); rwkv_chunk_phase(F);
        GRID_BAR(); PT1(7); }
        { PT0(); rwkv_state_phase(F);
        GRID_BAR(); PT1(8); }
        { PT0(); rwkv_out_phase(F, l);
        GRID_BAR(); PT1(9); }
        { pg8::Gemm g{(const bf16*)(ws + WS_XB), (const bf16*)(ws + WS_WG), T, 3072, DM}; pg8::StaticOrder S; S.init(T, 3072, F.G, (int)F.bid);
          pg8::EpiGate E{(bf16*)(ws + WS_GATES), 3072};
          pg8::gemm_phase<pg8::EpiGate, pg8::StaticOrder, true, true>(F.lds, g, S, E); }
        GRID_BAR();
#if defined(DBG_SCRUB)
        { const f32x4* xs = (const f32x4*)INP(F, 0) + (size_t)F.bid * 32768; f32x4 a = {0.f, 0.f, 0.f, 0.f};
          for (int i = F.tid; i < 32768; i += 512) a += xs[i];
          if (a.x + a.y + a.z + a.w == 12345.678f) ((float*)(ws + WS_BONUS))[F.tid] = a.x; }
        GRID_BAR();
#endif
        { PT0(); { pg8::StaticOrder S; S.init(T, DM, F.G, (int)F.bid);
          { pg8::Gemm g{(const bf16*)(ws + WS_YATTN), (const bf16*)(ws + WS_WBR), T, DM, 512};
            pg8::EpiMerge<true> E{(bf16*)(ws + WS_XB), DM, (const bf16*)(ws + WS_GATES), 3072, 0};
            pg8::gemm_phase<pg8::EpiMerge<true>, pg8::StaticOrder, true, true>(F.lds, g, S, E); }
          { pg8::Gemm g{(const bf16*)(ws + WS_AR), (const bf16*)(ws + WS_WBR) + (size_t)1024 * 512, T, DM, 512};
            pg8::EpiMerge<false> E{(bf16*)(ws + WS_XB), DM, (const bf16*)(ws + WS_GATES), 3072, 1024};
            pg8::gemm_phase<pg8::EpiMerge<false>, pg8::StaticOrder, true, true>(F.lds, g, S, E); }
          { pg8::Gemm g{(const bf16*)(ws + WS_YPOOL), (const bf16*)(ws + WS_WBR) + (size_t)2 * 1024 * 512, T, DM, 512};
            pg8::EpiMerge<false> E{(bf16*)(ws + WS_XB), DM, (const bf16*)(ws + WS_GATES), 3072, 2048};
            pg8::gemm_phase<pg8::EpiMerge<false>, pg8::StaticOrder, true, true>(F.lds, g, S, E); } }
        GRID_BAR(); PT1(11); }
#if defined(DBG_STOP) && DBG_STOP == 7
        dump_bf16(F, (const bf16*)(ws + WS_XB), 1024, 1024, 0); return;
#endif
#if defined(DBG_STOP) && DBG_STOP == 6
        dump_bf16(F, (const bf16*)(ws + WS_GATES) + 1024, 3072, 1024, 0); return;
#endif
        { PT0(); { pg8::Gemm g{(const bf16*)(ws + WS_XB), (const bf16*)(ws + WS_WOUT), T, DM, DM}; pg8::StaticOrder S; S.init(T, DM, F.G, (int)F.bid);
          pg8::EpiResF32 E{l == 0 ? INP(F, 0) : OUTP(F), OUTP(F), DM};
          pg8::gemm_phase<pg8::EpiResF32, pg8::StaticOrder, true, true>(F.lds, g, S, E); }
        GRID_BAR(); PT1(12); }
#if defined(DBG_STOP) && DBG_STOP == 1
        return;
#endif
        { PT0(); route_phase(F, l);
#if defined(DBG_TMASK)
        GRID_BAR(); PT1(13); } { PT0();
#endif
        prep_expert_weights(F, l);
        GRID_BAR(); PT1(18); }
        { PT0(); permute_phase(F, l);
        GRID_BAR(); PT1(14); }
        { const int ntile = moe_tables(F, l);
          const LAS unsigned char* te = (const LAS unsigned char*)(F.lds + MISC_OFF + 256);
          { PT0(); { pg8::Gemm g{(const bf16*)(ws + WS_XPERM), (const bf16*)(ws + WS_W13), RMAX, NEXP * 1024, DM}; pg8::MoeOrder S{te, ntile * 4, F.G, (int)F.bid};
            pg8::EpiSwiGLU E{(bf16*)(ws + WS_HACT)};
            pg8::gemm_phase<pg8::EpiSwiGLU, pg8::MoeOrder, true, true>(F.lds, g, S, E); }
          GRID_BAR(); PT1(15); }
          { PT0(); { pg8::Gemm g{(const bf16*)(ws + WS_HACT), (const bf16*)(ws + WS_W2), RMAX, NEXP * 1024, 512}; pg8::MoeOrder S{te, ntile * 4, F.G, (int)F.bid};
            pg8::EpiY E{(bf16*)(ws + WS_YMOE)};
            pg8::gemm_phase<pg8::EpiY, pg8::MoeOrder, true, true>(F.lds, g, S, E); }
        GRID_BAR(); PT1(16); } }
        { PT0(); combine_phase(F, l);
        if (l + 1 < DEPTH) prep_mixer_weights(F, l + 1);
        GRID_BAR(); PT1(17); }
#if defined(DBG_STOP) && DBG_STOP == 2
        return;
#endif
    }
#undef ws
}

extern "C" void kernel_launch(void* const* d_in, const int* in_sizes, int n_in, void* d_out, int out_size, void* d_ws, size_t ws_size, hipStream_t stream) {
    static int grid = 0;
    if (grid == 0) {
        if (n_in != 31 || out_size != T * DM || ws_size < WS_END) { fprintf(stderr, "kernel_launch: unexpected shapes (n_in %d out %d ws %zu, need %zu)\n", n_in, out_size, ws_size, (size_t)WS_END); grid = -1; return; }
        int dev = 0, cus = 0, per_cu = 0;
        (void)hipGetDevice(&dev); (void)hipDeviceGetAttribute(&cus, hipDeviceAttributeMultiprocessorCount, dev);
        (void)hipFuncSetAttribute((const void*)mk_fwd, hipFuncAttributeMaxDynamicSharedMemorySize, LDS_BYTES);
        (void)hipOccupancyMaxActiveBlocksPerMultiprocessor(&per_cu, (const void*)mk_fwd, 512, LDS_BYTES);
        (void)hipGetLastError();
        fprintf(stderr, "kernel_launch: cus %d per_cu %d ws %zu\n", cus, per_cu, ws_size);
        grid = cus;
    }
    if (grid < 0) return;
    (void)hipMemsetAsync((char*)d_ws + WS_CTL, 0, CTL_BYTES, stream);
    Args a{};
    for (int i = 0; i < 31; ++i) a.in[i] = (const float*)d_in[i];
    a.out = (float*)d_out; a.ws = (unsigned char*)d_ws;
    void* kargs[] = {&a};
    hipError_t e = hipLaunchCooperativeKernel((const void*)mk_fwd, dim3(grid), dim3(512), kargs, LDS_BYTES, stream);
    if (e != hipSuccess) fprintf(stderr, "cooperative launch failed: %s (grid %d)\n", hipGetErrorString(e), grid);
}
```

```cpp
#include <hip/hip_runtime.h>
#include <hip/hip_cooperative_groups.h>
#include <cstdio>
#include <cstdint>
#include <cmath>
namespace pg8 {
#define PG8_LAS __attribute__((address_space(3)))
typedef unsigned short bf16_t;
typedef short bf16x8 __attribute__((ext_vector_type(8)));
typedef float f32x4 __attribute__((ext_vector_type(4)));
typedef unsigned u32x4 __attribute__((ext_vector_type(4)));
constexpr int BM = 256, BK = 64, HALF = 128, HTB = HALF * BK * 2  , STAGE_BYTES = 8 * HTB, NXCD = 8, WGM = 8;

__host__ __device__ __forceinline__ int lds_byte(int r, int c) { const int st = (r >> 4) * 2 + (c >> 5), rr = r & 15, cc = c & 31, ob = rr * 64 + cc * 2; return st * 1024 + (ob ^ (((ob >> 9) & 1) << 5)); }
__host__ __device__ __forceinline__ void stage_rc(int b, int& R, int& C) { const int st = b / 1024, sb = b % 1024, swz = sb ^ (((sb >> 9) & 1) << 5); R = (st >> 1) * 16 + swz / 64; C = (st & 1) * 32 + (swz % 64) / 2; }
__host__ __device__ __forceinline__ int perm32(int rho) { const int n = rho >> 4, i = rho & 15; return 8 * (i >> 2) + 4 * n + (i & 3); }

struct Unit { int pm, pn; };
struct Gemm { const bf16_t* A; const bf16_t* Bt; int M, N, K; };

struct StaticOrder {
    int nM, nN, nwg, G, c;
    __host__ __device__ void init(int M, int N, int G_, int c_) { nM = M / BM; nN = N / BM; nwg = nM * nN; G = G_; c = c_; }
    __host__ __device__ bool next(int i, Unit& u) const {
        const long L = (long)i * G + c; if (L >= nwg) return false;
        int wgid = (int)L; { const int q = nwg / NXCD, r = nwg % NXCD, xcd = wgid % NXCD, off = wgid / NXCD; wgid = (xcd < r ? xcd * (q + 1) : r * (q + 1) + (xcd - r) * q) + off; }
        const int nig = WGM * nN, gid = wgid / nig, fm = gid * WGM, gsz = (nM - fm) < WGM ? (nM - fm) : WGM;
        u.pm = fm + ((wgid % nig) % gsz); u.pn = (wgid % nig) / gsz; return true;
    }
    __device__ __forceinline__ void a_ready(const Unit&) const {}
    __device__ __forceinline__ void done(const Unit&) const {}
};

typedef float f32x2c_t __attribute__((ext_vector_type(2))); typedef __bf16 bf16x2c_t __attribute__((ext_vector_type(2)));
__device__ __forceinline__ unsigned cvt_pk_bf16(float lo, float hi) { const f32x2c_t v = {lo, hi}; const bf16x2c_t b = __builtin_convertvector(v, bf16x2c_t); return __builtin_bit_cast(unsigned, b); }
typedef float f32x2 __attribute__((ext_vector_type(2)));
__device__ __forceinline__ float fast_sigmoid(float x) { return __builtin_amdgcn_rcpf(1.0f + __builtin_amdgcn_exp2f(-1.4426950408889634f * x)); }
struct EpiZ {
    static constexpr bool PERM = true, AFTER_DRAIN = false;
    bf16_t *q, *k, *v, *poolz, *rwkvz; float qscale;
    __device__ __forceinline__ void operator()(const f32x4 (&acc)[2][2][4][2], const Unit& u, int wr, int wc, int fr, int fq) const {
        const int pn = u.pn; bf16_t* base; int ldc, colt, climit; float sc = 1.f;
        if (pn < 2) { base = q; ldc = 512; colt = pn * 256; climit = 512; sc = qscale; }
        else if (pn < 4) { base = k; ldc = 512; colt = (pn - 2) * 256; climit = 512; }
        else if (pn < 6) { base = v; ldc = 512; colt = (pn - 4) * 256; climit = 512; }
        else if (pn < 8) { base = poolz; ldc = 512; colt = (pn - 6) * 256; climit = 512; }
        else { base = rwkvz; ldc = 1824; colt = (pn - 8) * 256; climit = 1824; }
        const int row0 = u.pm * BM + wr * 64 + fr, col0 = colt + wc * 32 + 8 * fq;
#pragma unroll
        for (int ai = 0; ai < 2; ++ai)
#pragma unroll
            for (int m = 0; m < 4; ++m) { bf16_t* rowp = base + (size_t)(row0 + ai * HALF + m * 16) * ldc + col0;
#pragma unroll
                for (int bj = 0; bj < 2; ++bj) { if (col0 + bj * HALF < climit) { const f32x4 v0 = acc[ai][bj][m][0] * sc, v1 = acc[ai][bj][m][1] * sc;
                    u32x4 w; w.x = cvt_pk_bf16(v0[0], v0[1]); w.y = cvt_pk_bf16(v0[2], v0[3]); w.z = cvt_pk_bf16(v1[0], v1[1]); w.w = cvt_pk_bf16(v1[2], v1[3]);
                    *(u32x4*)(rowp + bj * HALF) = w; } } }
    }
};
struct EpiGate {
    static constexpr bool PERM = true, AFTER_DRAIN = false;
    bf16_t* O; int ldc;
    __device__ __forceinline__ void operator()(const f32x4 (&acc)[2][2][4][2], const Unit& u, int wr, int wc, int fr, int fq) const {
        const int row0 = u.pm * BM + wr * 64 + fr, col0 = u.pn * BM + wc * 32 + 8 * fq;
#pragma unroll
        for (int ai = 0; ai < 2; ++ai)
#pragma unroll
            for (int m = 0; m < 4; ++m) { bf16_t* rowp = O + (size_t)(row0 + ai * HALF + m * 16) * ldc + col0;
#pragma unroll
                for (int bj = 0; bj < 2; ++bj) { const f32x4 v0 = acc[ai][bj][m][0], v1 = acc[ai][bj][m][1];
                    u32x4 w; w.x = cvt_pk_bf16(fast_sigmoid(v0[0]), fast_sigmoid(v0[1])); w.y = cvt_pk_bf16(fast_sigmoid(v0[2]), fast_sigmoid(v0[3]));
                    w.z = cvt_pk_bf16(fast_sigmoid(v1[0]), fast_sigmoid(v1[1])); w.w = cvt_pk_bf16(fast_sigmoid(v1[2]), fast_sigmoid(v1[3]));
                    *(u32x4*)(rowp + bj * HALF) = w; } }
    }
};
__device__ __forceinline__ float bflo(unsigned w) { return __uint_as_float(w << 16); }
__device__ __forceinline__ float bfhi(unsigned w) { return __uint_as_float(w & 0xffff0000u); }
template <bool FIRST> struct EpiMerge {
    static constexpr bool PERM = true, AFTER_DRAIN = false;
    bf16_t* O; int ldc; const bf16_t* gate; int ldg, goff;
    __device__ __forceinline__ void operator()(const f32x4 (&acc)[2][2][4][2], const Unit& u, int wr, int wc, int fr, int fq) const {
        const int row0 = u.pm * BM + wr * 64 + fr, col0 = u.pn * BM + wc * 32 + 8 * fq;
#pragma unroll
        for (int ai = 0; ai < 2; ++ai)
#pragma unroll
            for (int m = 0; m < 4; ++m) { const size_t r = (size_t)(row0 + ai * HALF + m * 16); bf16_t* rowp = O + r * ldc + col0; const bf16_t* gp = gate + r * ldg + goff + col0;
#pragma unroll
                for (int bj = 0; bj < 2; ++bj) { const f32x4 v0 = acc[ai][bj][m][0], v1 = acc[ai][bj][m][1];
                    const u32x4 g = *(const u32x4*)(gp + bj * HALF);
                    float o[8] = {v0[0] * bflo(g.x), v0[1] * bfhi(g.x), v0[2] * bflo(g.y), v0[3] * bfhi(g.y), v1[0] * bflo(g.z), v1[1] * bfhi(g.z), v1[2] * bflo(g.w), v1[3] * bfhi(g.w)};
                    if (!FIRST) { const u32x4 p = *(const u32x4*)(rowp + bj * HALF);
                        o[0] += bflo(p.x); o[1] += bfhi(p.x); o[2] += bflo(p.y); o[3] += bfhi(p.y); o[4] += bflo(p.z); o[5] += bfhi(p.z); o[6] += bflo(p.w); o[7] += bfhi(p.w); }
                    u32x4 w; w.x = cvt_pk_bf16(o[0], o[1]); w.y = cvt_pk_bf16(o[2], o[3]); w.z = cvt_pk_bf16(o[4], o[5]); w.w = cvt_pk_bf16(o[6], o[7]);
                    *(u32x4*)(rowp + bj * HALF) = w; } }
    }
};
struct EpiResF32 {
    static constexpr bool PERM = false, AFTER_DRAIN = false;
    const float* base; float* out; int ldc;
    __device__ __forceinline__ void operator()(const f32x4 (&acc)[2][2][4][2], const Unit& u, int wr, int wc, int fr, int fq) const {
        const int row0 = u.pm * BM + wr * 64 + fr, col0 = u.pn * BM + wc * 32 + 4 * fq;
#pragma unroll
        for (int ai = 0; ai < 2; ++ai)
#pragma unroll
            for (int m = 0; m < 4; ++m) { const size_t off = (size_t)(row0 + ai * HALF + m * 16) * ldc + col0;
#pragma unroll
                for (int bj = 0; bj < 2; ++bj)
#pragma unroll
                    for (int n = 0; n < 2; ++n) { const f32x4 bs = *(const f32x4*)(base + off + bj * HALF + n * 16); *(f32x4*)(out + off + bj * HALF + n * 16) = bs + acc[ai][bj][m][n]; } }
    }
};
struct EpiSwiGLU {
    static constexpr bool PERM = true, AFTER_DRAIN = false;
    bf16_t* O;
    __device__ __forceinline__ void operator()(const f32x4 (&acc)[2][2][4][2], const Unit& u, int wr, int wc, int fr, int fq) const {
        const int row0 = u.pm * BM + wr * 64 + fr, col0 = (u.pn & 3) * 128 + wc * 32 + 8 * fq;
#pragma unroll
        for (int ai = 0; ai < 2; ++ai)
#pragma unroll
            for (int m = 0; m < 4; ++m) { bf16_t* rowp = O + (size_t)(row0 + ai * HALF + m * 16) * 512 + col0;
                float o[8];
#pragma unroll
                for (int n = 0; n < 2; ++n)
#pragma unroll
                    for (int e = 0; e < 4; ++e) { const float a1 = acc[ai][0][m][n][e], a3 = acc[ai][1][m][n][e]; o[n * 4 + e] = a1 * fast_sigmoid(a1) * a3; }
                u32x4 w; w.x = cvt_pk_bf16(o[0], o[1]); w.y = cvt_pk_bf16(o[2], o[3]); w.z = cvt_pk_bf16(o[4], o[5]); w.w = cvt_pk_bf16(o[6], o[7]);
                *(u32x4*)rowp = w; }
    }
};
struct EpiY {
    static constexpr bool PERM = true, AFTER_DRAIN = false;
    bf16_t* O;
    __device__ __forceinline__ void operator()(const f32x4 (&acc)[2][2][4][2], const Unit& u, int wr, int wc, int fr, int fq) const {
        const int row0 = u.pm * BM + wr * 64 + fr, col0 = (u.pn & 3) * BM + wc * 32 + 8 * fq;
#pragma unroll
        for (int ai = 0; ai < 2; ++ai)
#pragma unroll
            for (int m = 0; m < 4; ++m) { bf16_t* rowp = O + (size_t)(row0 + ai * HALF + m * 16) * 1024 + col0;
#pragma unroll
                for (int bj = 0; bj < 2; ++bj) { const f32x4 v0 = acc[ai][bj][m][0], v1 = acc[ai][bj][m][1];
                    u32x4 w; w.x = cvt_pk_bf16(v0[0], v0[1]); w.y = cvt_pk_bf16(v0[2], v0[3]); w.z = cvt_pk_bf16(v1[0], v1[1]); w.w = cvt_pk_bf16(v1[2], v1[3]);
                    *(u32x4*)(rowp + bj * HALF) = w; } }
    }
};
struct MoeOrder {
    const PG8_LAS unsigned char* tile_e; int nunits, G, c;
    __device__ __forceinline__ bool next(int i, Unit& u) const {
        const int L = i * G + c; if (L >= nunits) return false;
        const int pm = L >> 2; u.pm = pm; u.pn = __builtin_amdgcn_readfirstlane((int)tile_e[pm]) * 4 + (L & 3); return true;
    }
    __device__ __forceinline__ void a_ready(const Unit&) const {}
    __device__ __forceinline__ void done(const Unit&) const {}
};
template <class Epi, class Sched, bool ALIGN_EPI = false, bool SP2 = false>
__device__ __forceinline__ void gemm_phase(PG8_LAS unsigned char* lds, const Gemm g, const Sched& S, const Epi& E) {
    int tid = threadIdx.x; asm volatile("" : "+v"(tid));
    const int wid = __builtin_amdgcn_readfirstlane(tid >> 6), lane = tid & 63, wr = wid >> 2, wc = wid & 3, fr = lane & 15, fq = lane >> 4;
    const int K = g.K, nt = K / BK;
    unsigned voffA[2], voffB[2];
#pragma unroll
    for (int i = 0; i < 2; ++i) { int R, C; stage_rc(tid * 16 + i * 8192, R, C); const int Rb = Epi::PERM ? ((R & ~31) + perm32(R & 31)) : R;
        voffA[i] = (unsigned)(R * K + C) * 2u; voffB[i] = (unsigned)(Rb * K + C) * 2u; }
    const size_t kstep = (size_t)(BK * 2);
    const size_t hstep = (size_t)HALF * K * 2;
    const size_t tstep = 2 * hstep;
    const unsigned ldsw = (unsigned)wid * 1024u;
    const int aoff = lds_byte(wr * 64 + fr, fq * 8), boff = lds_byte(wc * 32 + fr, fq * 8);
#define PG8_SA(b, h) (((b) * 2 + (h)) * HTB)
#define PG8_SB(b, h) ((4 + (b) * 2 + (h)) * HTB)
#define PG8_STAGE(bufoff, gbase, voff) do { _Pragma("unroll") for (int _i = 0; _i < 2; ++_i) \
        __builtin_amdgcn_global_load_lds((const unsigned*)((const char*)(gbase) + (voff)[_i]), (PG8_LAS unsigned*)(lds + (bufoff) + ldsw + _i * 8192), 16, 0, 0); } while (0)
#define PG8_LDA(dst, b, h) do { _Pragma("unroll") for (int m = 0; m < 4; ++m) _Pragma("unroll") for (int k = 0; k < 2; ++k) dst[m][k] = *(const PG8_LAS bf16x8*)(lds + PG8_SA(b, h) + aoff + m * 2048 + k * 1024); } while (0)
#define PG8_LDB(dst, b, h) do { _Pragma("unroll") for (int n = 0; n < 2; ++n) _Pragma("unroll") for (int k = 0; k < 2; ++k) dst[n][k] = *(const PG8_LAS bf16x8*)(lds + PG8_SB(b, h) + boff + n * 2048 + k * 1024); } while (0)
#define PG8_MMA(ai, bj, At, Bt) do { __builtin_amdgcn_s_setprio(1); _Pragma("unroll") for (int m = 0; m < 4; ++m) _Pragma("unroll") for (int n = 0; n < 2; ++n) _Pragma("unroll") for (int k = 0; k < 2; ++k) \
        acc[ai][bj][m][n] = __builtin_amdgcn_mfma_f32_16x16x32_bf16(Bt[n][k], At[m][k], acc[ai][bj][m][n], 0, 0, 0); __builtin_amdgcn_s_setprio(0); } while (0)
#define PG8_WAIT_V(n) asm volatile("s_waitcnt vmcnt(" #n ")" ::: "memory")
#define PG8_WAIT_L(n) asm volatile("s_waitcnt lgkmcnt(" #n ")" ::: "memory")
#define PG8_BAR __builtin_amdgcn_s_barrier()
#define PG8_SCHED __builtin_amdgcn_sched_barrier(0)
    Unit cur, nxt; int ui = 0;
    if (!S.next(0, cur)) return;
    f32x4 acc[2][2][4][2];
#pragma unroll
    for (int a = 0; a < 2; ++a)
#pragma unroll
        for (int b = 0; b < 2; ++b)
#pragma unroll
            for (int m = 0; m < 4; ++m)
#pragma unroll
                for (int n = 0; n < 2; ++n) acc[a][b][m][n] = (f32x4){0.f, 0.f, 0.f, 0.f};
    bf16x8 At[4][2], B0[2][2], B1[2][2];
    const char* cA = (const char*)g.A + (size_t)cur.pm * tstep; const char* cB = (const char*)g.Bt + (size_t)cur.pn * tstep;
    S.a_ready(cur);
    if constexpr (SP2) {
        PG8_STAGE(PG8_SB(0, 0), cB, voffB); PG8_STAGE(PG8_SB(0, 1), cB + hstep, voffB); PG8_STAGE(PG8_SA(0, 0), cA, voffA); PG8_STAGE(PG8_SA(0, 1), cA + hstep, voffA);
        if (wr == 1) PG8_BAR;
        PG8_WAIT_V(2); PG8_BAR;
        PG8_STAGE(PG8_SB(1, 0), cB + kstep, voffB); PG8_STAGE(PG8_SA(1, 0), cA + kstep, voffA); PG8_STAGE(PG8_SB(1, 1), cB + hstep + kstep, voffB);
        PG8_WAIT_V(6); PG8_BAR;
    } else {
        PG8_STAGE(PG8_SB(0, 0), cB, voffB); PG8_STAGE(PG8_SA(0, 0), cA, voffA); PG8_STAGE(PG8_SB(0, 1), cB + hstep, voffB); PG8_STAGE(PG8_SA(0, 1), cA + hstep, voffA);
        if (wr == 1) PG8_BAR;
        PG8_WAIT_V(4); PG8_BAR;
        PG8_STAGE(PG8_SB(1, 0), cB + kstep, voffB); PG8_STAGE(PG8_SA(1, 0), cA + kstep, voffA); PG8_STAGE(PG8_SB(1, 1), cB + hstep + kstep, voffB);
        PG8_WAIT_V(6); PG8_BAR;
    }
    for (;;) {
        const bool has_next = S.next(ui + 1, nxt);
        const char* nA = has_next ? (const char*)g.A + (size_t)nxt.pm * tstep : cA; const char* nB = has_next ? (const char*)g.Bt + (size_t)nxt.pn * tstep : cB;
        for (int t = 0; t < nt; t += 2) {
            const bool last = (t == nt - 2);
            const char* a1 = cA + (size_t)(t + 1) * kstep;
            const char* a2 = last ? nA : cA + (size_t)(t + 2) * kstep; const char* b2 = last ? nB : cB + (size_t)(t + 2) * kstep;
            const char* a3 = a2 + kstep; const char* b3 = b2 + kstep;
            if (last && has_next) S.a_ready(nxt);
            if constexpr (SP2) {
            PG8_LDB(B0, 0, 0); PG8_LDB(B1, 0, 1); PG8_SCHED; PG8_LDA(At, 0, 0); PG8_STAGE(PG8_SA(1, 1), a1 + hstep, voffA);
            PG8_WAIT_V(8); PG8_WAIT_L(0); PG8_BAR; PG8_MMA(0, 0, At, B0); PG8_MMA(0, 1, At, B1); PG8_BAR; PG8_SCHED;
            PG8_LDA(At, 0, 1); PG8_STAGE(PG8_SB(0, 0), b2, voffB); PG8_STAGE(PG8_SB(0, 1), b2 + hstep, voffB); PG8_STAGE(PG8_SA(0, 0), a2, voffA);
            PG8_WAIT_V(8); PG8_WAIT_L(0); PG8_BAR; PG8_MMA(1, 0, At, B0); PG8_MMA(1, 1, At, B1); PG8_BAR; PG8_SCHED;
            PG8_LDB(B0, 1, 0); PG8_LDB(B1, 1, 1); PG8_SCHED; PG8_LDA(At, 1, 0); PG8_STAGE(PG8_SA(0, 1), a2 + hstep, voffA);
            PG8_WAIT_V(8); PG8_WAIT_L(0); PG8_BAR; PG8_MMA(0, 0, At, B0); PG8_MMA(0, 1, At, B1); PG8_BAR; PG8_SCHED;
            PG8_LDA(At, 1, 1); PG8_STAGE(PG8_SB(1, 0), b3, voffB); PG8_STAGE(PG8_SB(1, 1), b3 + hstep, voffB); PG8_STAGE(PG8_SA(1, 0), a3, voffA);
            PG8_WAIT_V(8); PG8_WAIT_L(0); PG8_BAR; PG8_MMA(1, 0, At, B0); PG8_MMA(1, 1, At, B1); PG8_BAR; PG8_SCHED;
            } else {
            PG8_LDB(B0, 0, 0); PG8_SCHED; PG8_LDA(At, 0, 0); PG8_STAGE(PG8_SA(1, 1), a1 + hstep, voffA);
            PG8_WAIT_L(8); PG8_BAR; PG8_WAIT_L(0); PG8_MMA(0, 0, At, B0); PG8_BAR; PG8_SCHED;
            PG8_LDB(B1, 0, 1); PG8_STAGE(PG8_SB(0, 0), b2, voffB);
            PG8_BAR; PG8_WAIT_L(0); PG8_MMA(0, 1, At, B1); PG8_BAR;
            PG8_LDA(At, 0, 1); PG8_STAGE(PG8_SA(0, 0), a2, voffA);
            PG8_BAR; PG8_WAIT_L(0); PG8_MMA(1, 0, At, B0); PG8_BAR; PG8_SCHED;
            PG8_STAGE(PG8_SB(0, 1), b2 + hstep, voffB);
            PG8_WAIT_V(6); PG8_BAR; PG8_MMA(1, 1, At, B1); PG8_BAR;
            PG8_LDB(B0, 1, 0); PG8_SCHED; PG8_LDA(At, 1, 0); PG8_STAGE(PG8_SA(0, 1), a2 + hstep, voffA);
            PG8_WAIT_L(8); PG8_BAR; PG8_WAIT_L(0); PG8_MMA(0, 0, At, B0); PG8_BAR; PG8_SCHED;
            PG8_LDB(B1, 1, 1); PG8_STAGE(PG8_SB(1, 0), b3, voffB);
            PG8_BAR; PG8_WAIT_L(0); PG8_MMA(0, 1, At, B1); PG8_BAR;
            PG8_LDA(At, 1, 1); PG8_STAGE(PG8_SA(1, 0), a3, voffA);
            PG8_BAR; PG8_WAIT_L(0); PG8_MMA(1, 0, At, B0); PG8_BAR; PG8_SCHED;
            PG8_STAGE(PG8_SB(1, 1), b3 + hstep, voffB);
            PG8_WAIT_V(6); PG8_BAR; PG8_MMA(1, 1, At, B1); PG8_BAR;
            }
        }
        if constexpr (ALIGN_EPI) { if (wr == 0) PG8_BAR; }
        if constexpr (!Epi::AFTER_DRAIN) { E(acc, cur, wr, wc, fr, fq); S.done(cur); }
        if (!has_next) break;
#pragma unroll
        for (int a = 0; a < 2; ++a)
#pragma unroll
            for (int b = 0; b < 2; ++b)
#pragma unroll
                for (int m = 0; m < 4; ++m)
#pragma unroll
                    for (int n = 0; n < 2; ++n) acc[a][b][m][n] = (f32x4){0.f, 0.f, 0.f, 0.f};
        cur = nxt; cA = nA; cB = nB; ++ui;
        if constexpr (ALIGN_EPI) { if (wr == 1) PG8_BAR; }
    }
    PG8_WAIT_V(0);
    if constexpr (!ALIGN_EPI) { if (wr == 0) PG8_BAR; }
    PG8_BAR;
    if constexpr (Epi::AFTER_DRAIN) { E.fused(acc, cur, wr, wc, fr, fq, lds, wid, lane); S.done(cur); }
#undef PG8_SA
#undef PG8_SB
#undef PG8_STAGE
#undef PG8_LDA
#undef PG8_LDB
#undef PG8_MMA
#undef PG8_WAIT_V
#undef PG8_WAIT_L
#undef PG8_BAR
#undef PG8_SCHED
}
}
namespace cg = cooperative_groups;
#define DI __device__ __forceinline__
#define LAS __attribute__((address_space(3)))
typedef unsigned short bf16;
typedef float f32x4 __attribute__((ext_vector_type(4)));
typedef unsigned u32x4 __attribute__((ext_vector_type(4)));
typedef unsigned u32x2 __attribute__((ext_vector_type(2)));
typedef short bf16x8_t __attribute__((ext_vector_type(8)));

constexpr int BATCH = 2, SEQ = 16384, DM = 1024, T = BATCH * SEQ, DEPTH = 2;
constexpr int NEXP = 32, RZP = 1824;
constexpr int RMAX = 73728;
constexpr float C2 = 0.125f * 1.4426950408889634f;
constexpr float LOG2E = 1.4426950408889634f;
constexpr size_t MiB = 1u << 20;
constexpr size_t WS_CTL = 0, CTL_BYTES = 1 * MiB;
constexpr size_t WS_WIN = 1 * MiB, WS_WG = 9 * MiB, WS_WBR = 15 * MiB, WS_WOUT = 18 * MiB;
constexpr size_t WS_KMEAN = 20 * MiB, WS_RWG = 20 * MiB + 512 * 1024, WS_ROUTE = 21 * MiB, WS_RWT = 22 * MiB, WS_DEST = 22 * MiB + 512 * 1024, WS_BONUS = 23 * MiB, WS_WLT = 24 * MiB, WS_WPT = 24 * MiB + 512 * 1024, WS_WGBASE = 24 * MiB + 768 * 1024;
constexpr size_t WS_XB = 32 * MiB, WS_VFIRST = 96 * MiB, WS_YPOOL = 128 * MiB, WS_YATTN = 160 * MiB;
constexpr size_t WS_BIG = 192 * MiB;
constexpr size_t WS_Q = WS_BIG, WS_K = WS_BIG + 32 * MiB, WS_V = WS_BIG + 64 * MiB, WS_POOLZ = WS_BIG + 232 * MiB, WS_RWKVZ = WS_BIG + 264 * MiB;
constexpr size_t WS_AR = WS_BIG;
constexpr size_t WS_GATES = WS_BIG + 32 * MiB;
constexpr size_t WS_XPERM = WS_BIG, WS_HACT = WS_BIG + 144 * MiB, WS_W13 = WS_BIG + 216 * MiB, WS_W2 = WS_BIG + 280 * MiB, WS_YMOE = WS_BIG;
constexpr size_t WS_VT = WS_YATTN;
constexpr size_t WS_PARTO = WS_BIG + 96 * MiB, WS_PARTML = WS_BIG + 224 * MiB;
constexpr size_t WS_LIST = WS_BIG + 378 * MiB;
constexpr size_t WS_PCT = WS_BIG + 224 * MiB, WS_LC = WS_BIG + 256 * MiB, WS_RM = WS_BIG + 288 * MiB, WS_Y0 = WS_BIG + 320 * MiB, WS_S0 = WS_BIG + 352 * MiB;
constexpr int LSTRIDE = 516096;
constexpr size_t WS_END = WS_BIG + 394 * MiB;
static_assert(WS_LIST + (size_t)16 * LSTRIDE * 2 <= WS_END, "ws map");
static_assert(WS_RWKVZ + (size_t)T * RZP * 2 <= WS_END, "ws map");
static_assert(WS_W2 + (size_t)32 * 1024 * 512 * 2 <= WS_END, "ws map");
constexpr int CW_CNT = 64, CW_LCNT = 1024, CW_BAR = 4096;
constexpr int LDS_BYTES = 147456, MISC_OFF = 131072;

DI float bf2f(unsigned short u) { return __uint_as_float((unsigned)u << 16); }
DI unsigned f2bf(float f) { unsigned u = __float_as_uint(f); return (u + 0x7fffu + ((u >> 16) & 1u)) >> 16; }
DI unsigned pk2(float lo, float hi) { return f2bf(lo) | (f2bf(hi) << 16); }
DI float blo(unsigned w) { return __uint_as_float(w << 16); }
DI float bhi(unsigned w) { return __uint_as_float(w & 0xffff0000u); }
DI float wave_sum(float v) {
#pragma unroll
    for (int o = 1; o < 64; o <<= 1) v += __shfl_xor(v, o);
    return v;
}
DI float wave_max(float v) {
#pragma unroll
    for (int o = 1; o < 64; o <<= 1) v = fmaxf(v, __shfl_xor(v, o));
    return v;
}
DI float sigmoidf_(float x) { return 1.0f / (1.0f + __expf(-x)); }
#define LDS_WAIT() asm volatile("s_waitcnt lgkmcnt(0)" ::: "memory")

#define XB_TMO      128
#define XB_XCNT(j)  (256  + 64 * (j))
#define XB_XSUB(j)  (1280 + 64 * (j))
#define XB_XGEN(j)  (2304 + 64 * (j))
#define XB_TOP      3328
#define XB_TOPGEN   3392
#define XCD_BAR_WORDS 3456
#define XB_SPIN_CAP (1u << 27)

__device__ __forceinline__ unsigned xb_ld(unsigned* p)              { return __hip_atomic_load(p, __ATOMIC_RELAXED, __HIP_MEMORY_SCOPE_AGENT); }
__device__ __forceinline__ unsigned xb_add(unsigned* p, unsigned v) { return __hip_atomic_fetch_add(p, v, __ATOMIC_RELAXED, __HIP_MEMORY_SCOPE_AGENT); }
__device__ __forceinline__ unsigned xb_xcc_id() { return (unsigned)__builtin_amdgcn_s_getreg((3 << 11) | 20) & 0xFu; }
#define XB_SPIN(cond, bar) do { unsigned _sp = 0; while (cond) { __builtin_amdgcn_s_sleep(1); \
    if ((++_sp & 255u) == 0u) { if (xb_ld(&(bar)[XB_TMO])) break; if (_sp > XB_SPIN_CAP) { atomicAdd(&(bar)[XB_TMO], 1u); break; } } } } while (0)

struct XcdBarrier {
    unsigned* bar; unsigned x;
    volatile LAS unsigned* st;
};

__device__ __forceinline__ XcdBarrier xcd_barrier_post(unsigned* bar, volatile LAS unsigned* st) {
    XcdBarrier b; b.bar = bar; b.x = xb_xcc_id(); b.st = st;
    if (threadIdx.x == 0) (void)xb_add(&bar[XB_XCNT(b.x)], 1u);
    return b;
}
__device__ __forceinline__ void xcd_barrier_complete(unsigned* bar, unsigned x, unsigned& nloc, unsigned& nx) {
    const unsigned G = gridDim.x * gridDim.y * gridDim.z;
    unsigned sum, cnt, mine, sp = 0u;
    for (;;) {
        sum = 0u; cnt = 0u; mine = 0u;
#pragma unroll
        for (unsigned j = 0; j < 16; ++j) { const unsigned c = xb_ld(&bar[XB_XCNT(j)]); sum += c; cnt += (c > 0u) ? 1u : 0u; mine = (j == x) ? c : mine; }
        if (sum == G) break;
        __builtin_amdgcn_s_sleep(1);
        if ((++sp & 255u) == 0u) { if (xb_ld(&bar[XB_TMO])) break; if (sp > XB_SPIN_CAP) { atomicAdd(&bar[XB_TMO], 1u); break; } }
    }
    nloc = mine > 0u ? mine : 1u; nx = cnt > 0u ? cnt : 1u;
}

__device__ __forceinline__ void xcd_barrier(const XcdBarrier& b) {
    asm volatile("s_waitcnt vmcnt(0)" ::: "memory");
    __syncthreads();
    if (threadIdx.x == 0) {
        unsigned* bar = b.bar;
        __builtin_amdgcn_s_waitcnt(0);
        unsigned nloc = b.st[0], nx = b.st[1];
        if (nloc == 0u) { xcd_barrier_complete(bar, b.x, nloc, nx); b.st[0] = nloc; b.st[1] = nx; }
        const unsigned old = xb_add(&bar[XB_XSUB(b.x)], 1u);
        const unsigned gen = old / nloc;
        if (old + 1u == (gen + 1u) * nloc) {
            __builtin_amdgcn_fence(__ATOMIC_RELEASE, "agent");
            asm volatile("s_waitcnt vmcnt(0)" ::: "memory");
            const unsigned og = xb_add(&bar[XB_TOP], 1u);
            const unsigned tg = og / nx;
            if (og + 1u == (tg + 1u) * nx) xb_add(&bar[XB_TOPGEN], 1u);
            else XB_SPIN(xb_ld(&bar[XB_TOPGEN]) == tg, bar);
            __builtin_amdgcn_fence(__ATOMIC_ACQUIRE, "agent");
            xb_add(&bar[XB_XGEN(b.x)], 1u);
            asm volatile("s_waitcnt vmcnt(0)" ::: "memory");
        } else {
            XB_SPIN(xb_ld(&bar[XB_XGEN(b.x)]) == gen, bar);
            __builtin_amdgcn_fence(__ATOMIC_ACQUIRE, "agent");
            asm volatile("s_waitcnt vmcnt(0)" ::: "memory");
        }
    }
    __syncthreads();
}

struct Args { const float* in[31]; float* out; unsigned char* ws; };

typedef const __attribute__((address_space(4))) unsigned long long* kargp_t;
struct Frame {
    LAS unsigned char* lds; int tid, lane, wave, G, bid;
    kargp_t kp;
};
#define GASQ __attribute__((address_space(1)))
DI const float* INP(const Frame& F, int i) { return (const float*)(const GASQ float*)F.kp[i]; }
DI float* OUTP(const Frame& F) { return (float*)(GASQ float*)F.kp[31]; }
DI unsigned char* WSP(const Frame& F) { return (unsigned char*)(GASQ unsigned char*)F.kp[32]; }
DI void fence_frame(Frame& F) {
    asm volatile("" : "+s"(F.kp) :: "memory"); asm volatile("" : "+s"(F.G)); asm volatile("" : "+s"(F.bid));
    F.tid = threadIdx.x; asm volatile("" : "+v"(F.tid)); F.lane = F.tid & 63; F.wave = __builtin_amdgcn_readfirstlane(F.tid >> 6); }

DI void transpose_item(const float* W, int ldw, int ncols, bf16* WT, int ldt, const float* scale, LAS float* scr, int item, int lane) {
    const int nblk = ncols / 32, kb = item / nblk, nb = item % nblk, k0 = 64 * kb, n0 = 32 * nb;
#pragma unroll
    for (int i = 0; i < 32; ++i) { const int kk = 2 * i + (lane >> 5); float v = W[(size_t)(k0 + kk) * ldw + n0 + (lane & 31)]; if (scale) v *= scale[k0 + kk]; scr[kk * 33 + (lane & 31)] = v; }
    LDS_WAIT(); asm volatile("" ::: "memory");
    const int c = lane & 7;
#pragma unroll
    for (int j = 0; j < 4; ++j) { const int n = (lane >> 3) + 8 * j; const LAS float* s = scr + (8 * c) * 33 + n;
        u32x4 o; o.x = pk2(s[0 * 33], s[1 * 33]); o.y = pk2(s[2 * 33], s[3 * 33]); o.z = pk2(s[4 * 33], s[5 * 33]); o.w = pk2(s[6 * 33], s[7 * 33]);
        *(u32x4*)(WT + (size_t)(n0 + n) * ldt + k0 + 8 * c) = o; }
    LDS_WAIT(); asm volatile("" ::: "memory");
}
DI void prep_mixer_weights(Frame& F, int l) {
    LAS float* scr = (LAS float*)(F.lds + F.wave * 16384);
    const int gw = F.bid * 8 + F.wave, NGW = F.G * 8;
    const float* w_in = INP(F, 2) + (size_t)l * 1024 * 6912; const float* g1 = INP(F, 1) + l * 1024;
    bf16* WIN = (bf16*)(WSP(F) + WS_WIN); bf16* WG = (bf16*)(WSP(F) + WS_WG); bf16* WBR = (bf16*)(WSP(F) + WS_WBR); bf16* WOUT = (bf16*)(WSP(F) + WS_WOUT);
    constexpr int I1 = 16 * (1536 / 32), I2 = 16 * (2304 / 32), I3 = 16 * 1, I4 = 16 * (3072 / 32), I5 = 8 * (1024 / 32), I6 = 16 * (1024 / 32);
    const int n3 = l > 0 ? I3 : 0;
    const int total = I1 + I2 + n3 + I4 + 3 * I5 + I6;
    for (int it = gw; it < total; it += NGW) {
        int r = it;
        if (r < I1) { transpose_item(w_in, 6912, 1536, WIN, 1024, g1, scr, r, F.lane); continue; } r -= I1;
        if (r < I2) { transpose_item(w_in + 4608, 6912, 2304, WIN + (size_t)1536 * 1024, 1024, g1, scr, r, F.lane); continue; } r -= I2;
        if (r < n3) { transpose_item(INP(F, 3) + (size_t)(l - 1) * 1024 * 32, 32, 32, WIN + (size_t)3840 * 1024, 1024, g1, scr, r, F.lane); continue; } r -= n3;
        if (r < I4) { transpose_item(w_in + 1536, 6912, 3072, WG, 1024, g1, scr, r, F.lane); continue; } r -= I4;
        if (r < 3 * I5) { const int i = r / I5; transpose_item(INP(F, 20) + (size_t)(l * 3 + i) * 512 * 1024, 1024, 1024, WBR + (size_t)i * 1024 * 512, 512, i == 2 ? INP(F, 19) + l * 512 : nullptr, scr, r % I5, F.lane); continue; } r -= 3 * I5;
        transpose_item(INP(F, 21) + (size_t)l * 1024 * 1024, 1024, 1024, WOUT, 1024, nullptr, scr, r, F.lane);
    }
    if (l > 0) {
        u32x4* z = (u32x4*)(WIN + (size_t)3872 * 1024); const int n16 = 224 * 1024 * 2 / 16;
        for (int i = F.bid * 512 + F.tid; i < n16; i += F.G * 512) z[i] = (u32x4){0u, 0u, 0u, 0u};
    }
    { bf16* WPT = (bf16*)(WSP(F) + WS_WPT);
      for (int it = gw; it < 32; it += NGW) transpose_item(INP(F, 18) + (size_t)(l * 4 + (it >> 3)) * 128 * 128, 128, 128, WPT + (size_t)(it >> 3) * 128 * 128, 128, nullptr, scr, it & 7, F.lane); }
    { bf16* WLT = (bf16*)(WSP(F) + WS_WLT);
      constexpr int L1 = 1 * 16, L2 = 1 * 16, L3 = 2 * 16;
      for (int it = gw; it < L1 + L2 + L3; it += NGW) {
          if (it < L1) transpose_item(INP(F, 7) + (size_t)l * 64 * 512, 512, 512, WLT, 288, nullptr, scr, it, F.lane);
          else if (it < L1 + L2) transpose_item(INP(F, 9) + (size_t)l * 64 * 512, 512, 512, WLT + 64, 288, nullptr, scr, it - L1, F.lane);
          else transpose_item(INP(F, 10) + (size_t)l * 128 * 512, 512, 512, WLT + 128, 288, nullptr, scr, it - L1 - L2, F.lane); }
      const float* wv = INP(F, 17) + (size_t)(l > 0 ? l - 1 : 0) * 32 * 512;
      for (int i = F.bid * 512 + F.tid; i < 32 * 512; i += F.G * 512) { const int k = i >> 9, ch = i & 511; WLT[(size_t)ch * 288 + 256 + k] = (bf16)f2bf(l > 0 ? wv[k * 512 + ch] : 0.f); } }
    { bf16* RWH = (bf16*)(WSP(F) + WS_RWG); bf16* RWL = RWH + 48 * 1024; const float* g2 = INP(F, 22) + l * 1024; const float* rgw = INP(F, 23) + (size_t)l * 1024 * 4; const float* rew = INP(F, 25) + (size_t)l * 1024 * 32;
      for (int i = F.bid * 512 + F.tid; i < 48 * 1024; i += F.G * 512) { const int r = i >> 10, k = i & 1023;
          const float w = r < 16 ? rgw[k * 4 + (r & 3)] : r < 32 ? rew[k * 32 + 8 * ((r - 16) >> 2) + ((r - 16) & 3)] : rew[k * 32 + 8 * ((r - 32) >> 2) + 4 + ((r - 32) & 3)];
          const float v = g2[k] * w; const unsigned hb = f2bf(v); const float hf = __uint_as_float(hb << 16); RWH[i] = (bf16)hb; RWL[i] = (bf16)f2bf(v - hf); } }
}
DI void prep_expert_weights(Frame& F, int l) {
    LAS float* scr = (LAS float*)(F.lds + F.wave * 16384);
    const int gw = F.bid * 8 + F.wave, NGW = F.G * 8;
    const float* g2 = INP(F, 22) + l * 1024;
    bf16* W13 = (bf16*)(WSP(F) + WS_W13); bf16* W2 = (bf16*)(WSP(F) + WS_W2);
    constexpr int J13 = 64, N13 = NEXP * 2 * 4 * J13, J2 = 8 * 32, N2 = NEXP * J2;
    for (int it = gw; it < N13 + N2; it += NGW) {
        if (it < N13) { const int job = it / J13, item = it % J13, e = job >> 3, which = (job >> 2) & 1, grp = job & 3;
            const float* src = (which ? INP(F, 28) : INP(F, 27)) + ((size_t)(l * NEXP + e) * 1024) * 512 + grp * 128;
            transpose_item(src, 512, 128, W13 + ((size_t)e * 1024 + grp * 256 + which * 128) * 1024, 1024, g2, scr, item, F.lane);
        } else { const int r = it - N13, e = r / J2, item = r % J2;
            transpose_item(INP(F, 29) + (size_t)(l * NEXP + e) * 512 * 1024, 1024, 1024, W2 + (size_t)e * 1024 * 512, 512, nullptr, scr, item, F.lane); }
    }
}
DI void rms_rows_to_bf16(Frame& F, const float* x, bf16* xb) {
    const int gw = F.bid * 8 + F.wave, NGW = F.G * 8;
    for (int t = gw; t < T; t += NGW) {
        const f32x4* xr = (const f32x4*)(x + (size_t)t * DM) + F.lane; f32x4 v[4]; float s = 0.f;
#pragma unroll
        for (int j = 0; j < 4; ++j) { v[j] = xr[64 * j]; s += (v[j].x * v[j].x + v[j].y * v[j].y) + (v[j].z * v[j].z + v[j].w * v[j].w); }
        const float rs = rsqrtf(wave_sum(s) * (1.f / DM) + 1e-6f);
        u32x2* o = (u32x2*)(xb + (size_t)t * DM) + F.lane;
#pragma unroll
        for (int j = 0; j < 4; ++j) o[64 * j] = (u32x2){pk2(v[j].x * rs, v[j].y * rs), pk2(v[j].z * rs, v[j].w * rs)};
    }
}

DI void kmean_phase(Frame& F) {
    const bf16* K = (const bf16*)(WSP(F) + WS_K); float* kmean = (float*)(WSP(F) + WS_KMEAN);
    LAS float* red = (LAS float*)F.lds;
    for (int it = F.bid; it < BATCH * 8 * 64; it += F.G) {
        const int b = it >> 9, h = (it >> 6) & 7, n = it & 63, d = F.lane, part = F.wave;
        const bf16* kp = K + ((size_t)b * SEQ + n * 256 + part * 32) * 512 + h * 64 + d; float s = 0.f;
#pragma unroll
        for (int i = 0; i < 32; ++i) s += bf2f(kp[(size_t)i * 512]);
        red[part * 64 + d] = s;
        __syncthreads();
        if (F.tid < 64) { float a = 0.f;
#pragma unroll
            for (int p = 0; p < 8; ++p) a += red[p * 64 + F.tid];
            kmean[(size_t)it * 64 + F.tid] = a * (1.f / 256.f); }
        __syncthreads();
    }
}
DI void vt_phase(Frame& F) {
    const bf16* V = (const bf16*)(WSP(F) + WS_V); bf16* VT = (bf16*)(WSP(F) + WS_VT);
    LAS bf16* tl = (LAS bf16*)(F.lds + 4096 + F.wave * 9216);
    const int gw = F.bid * 8 + F.wave, NGW = F.G * 8, lane = F.lane;
    for (int it = gw; it < BATCH * 8 * (SEQ / 64); it += NGW) {
        const int bh = it / (SEQ / 64), tt = it % (SEQ / 64), b = bh >> 3, h = bh & 7, t0 = tt * 64;
#pragma unroll
        for (int i = 0; i < 8; ++i) { const int r = i * 8 + (lane >> 3), c = lane & 7;
            const u32x4 w = *(const u32x4*)(V + ((size_t)b * SEQ + t0 + r) * 512 + h * 64 + c * 8); *(LAS u32x4*)(tl + r * 72 + c * 8) = w; }
        LDS_WAIT(); asm volatile("" ::: "memory");
#pragma unroll
        for (int i = 0; i < 8; ++i) { const int d = i * 8 + (lane >> 3), c = lane & 7; unsigned short e[8];
#pragma unroll
            for (int k = 0; k < 8; ++k) e[k] = tl[(8 * c + k) * 72 + d];
            u32x4 w; w.x = e[0] | ((unsigned)e[1] << 16); w.y = e[2] | ((unsigned)e[3] << 16); w.z = e[4] | ((unsigned)e[5] << 16); w.w = e[6] | ((unsigned)e[7] << 16);
            *(u32x4*)(VT + ((size_t)bh * 64 + d) * SEQ + t0 + c * 8) = w; }
        LDS_WAIT(); asm volatile("" ::: "memory");
    }
}
DI int list_off(int n) { return n * SEQ - 128 * n * (n + 1); }
DI void sel_phase(Frame& F, int l) {
    const bf16* Q = (const bf16*)(WSP(F) + WS_Q); const float* kmean = (const float*)(WSP(F) + WS_KMEAN);
    unsigned short* list = (unsigned short*)(WSP(F) + WS_LIST); unsigned* lcnt = (unsigned*)(WSP(F) + WS_CTL) + CW_LCNT + 1024 * l;
    LAS float* km = (LAS float*)F.lds;
    for (int it = F.bid; it < BATCH * 8 * (SEQ / 512); it += F.G) {
        const int bh = it / (SEQ / 512), g = it % (SEQ / 512), b = bh >> 3, h = bh & 7;
        __syncthreads();
        for (int i = F.tid; i < 1024; i += 512) ((LAS f32x4*)km)[i] = ((const f32x4*)(kmean + (size_t)bh * 4096))[i];
        __syncthreads();
        const int tl = g * 512 + F.tid, own = __builtin_amdgcn_readfirstlane(tl >> 8);
        float q[64];
        { const u32x4* qp = (const u32x4*)(Q + ((size_t)b * SEQ + tl) * 512 + h * 64);
#pragma unroll
          for (int c = 0; c < 8; ++c) { const u32x4 w = qp[c]; q[8 * c] = blo(w.x); q[8 * c + 1] = bhi(w.x); q[8 * c + 2] = blo(w.y); q[8 * c + 3] = bhi(w.y); q[8 * c + 4] = blo(w.z); q[8 * c + 5] = bhi(w.z); q[8 * c + 6] = blo(w.w); q[8 * c + 7] = bhi(w.w); } }
        float v0 = -INFINITY, v1 = -INFINITY, v2 = -INFINITY; int i0 = -1, i1 = -1, i2 = -1;
        for (int n = 0; n < own; ++n) { const LAS f32x4* kp = (const LAS f32x4*)(km + n * 64); float s0 = 0.f, s1 = 0.f;
#pragma unroll
            for (int i = 0; i < 16; i += 2) { const f32x4 a = kp[i], c = kp[i + 1];
                s0 += q[4 * i] * a.x + q[4 * i + 1] * a.y + q[4 * i + 2] * a.z + q[4 * i + 3] * a.w; s1 += q[4 * i + 4] * c.x + q[4 * i + 5] * c.y + q[4 * i + 6] * c.z + q[4 * i + 7] * c.w; }
            const float gte = s0 + s1; const bool c0 = gte > v0, c1 = gte > v1, c2 = gte > v2;
            v2 = c1 ? v1 : (c2 ? gte : v2); i2 = c1 ? i1 : (c2 ? n : i2);
            v1 = c0 ? v0 : (c1 ? gte : v1); i1 = c0 ? i0 : (c1 ? n : i1);
            v0 = c0 ? gte : v0; i0 = c0 ? n : i0; }
        LAS unsigned* lc = (LAS unsigned*)(F.lds + MISC_OFF + 8192); LAS unsigned* lbase = lc + 64;
        if (F.tid < 64) lc[F.tid] = 0u;
        __syncthreads();
        unsigned r0 = 0u, r1 = 0u, r2 = 0u;
        if (i0 >= 0) r0 = atomicAdd((unsigned*)(lc + i0), 1u);
        if (i1 >= 0) r1 = atomicAdd((unsigned*)(lc + i1), 1u);
        if (i2 >= 0) r2 = atomicAdd((unsigned*)(lc + i2), 1u);
        __syncthreads();
        if (F.tid < 64) { const unsigned c = lc[F.tid]; lbase[F.tid] = c ? atomicAdd(lcnt + bh * 64 + F.tid, c) : 0u; }
        __syncthreads();
        unsigned short* lb = list + (size_t)bh * LSTRIDE;
        if (i0 >= 0) lb[list_off(i0) + lbase[i0] + r0] = (unsigned short)(tl | (0 << 14));
        if (i1 >= 0) lb[list_off(i1) + lbase[i1] + r1] = (unsigned short)(tl | (1 << 14));
        if (i2 >= 0) lb[list_off(i2) + lbase[i2] + r2] = (unsigned short)(tl | (2 << 14));
    }
    __syncthreads();
}
DI void att_phase(Frame& F, int l) {
    const bf16* Q = (const bf16*)(WSP(F) + WS_Q); const bf16* K = (const bf16*)(WSP(F) + WS_K); const bf16* VT = (const bf16*)(WSP(F) + WS_VT);
    const unsigned short* list = (const unsigned short*)(WSP(F) + WS_LIST); const unsigned* lcnt = (const unsigned*)(WSP(F) + WS_CTL) + CW_LCNT + 1024 * l;
    bf16* PO = (bf16*)(WSP(F) + WS_PARTO); float* PML = (float*)(WSP(F) + WS_PARTML);
    LAS unsigned char* Kl = F.lds;
    LAS unsigned char* Vl = F.lds + 36864;
    LAS int* pre = (LAS int*)(F.lds + MISC_OFF + 8192);
    LAS int* cl = (LAS int*)(F.lds + MISC_OFF + 12288); LAS int* ws8 = (LAS int*)(F.lds + MISC_OFF + 4352);
    const int lane = F.lane, wave = F.wave, qi = lane & 15, quad = lane >> 4;
    __syncthreads();
    { const int c0 = (int)__hip_atomic_load(lcnt + 2 * F.tid, __ATOMIC_RELAXED, __HIP_MEMORY_SCOPE_AGENT), c1 = (int)__hip_atomic_load(lcnt + 2 * F.tid + 1, __ATOMIC_RELAXED, __HIP_MEMORY_SCOPE_AGENT);
      cl[2 * F.tid] = c0; cl[2 * F.tid + 1] = c1; const int t0 = (c0 + 127) >> 7, t1 = (c1 + 127) >> 7; int inc = t0 + t1;
#pragma unroll
      for (int o = 1; o < 64; o <<= 1) { const int u = __shfl_up(inc, o); if (lane >= o) inc += u; }
      if (lane == 63) ws8[wave] = inc;
      __syncthreads();
      int off = 0;
#pragma unroll
      for (int w = 0; w < 8; ++w) { const int x = ws8[w]; if (w < wave) off += x; }
      const int ex = off + inc - (t0 + t1); pre[2 * F.tid] = ex; pre[2 * F.tid + 1] = ex + t0;
      __syncthreads();
      if (F.tid == 511) ws8[8] = off + inc; }
    __syncthreads();
    const int NL = __builtin_amdgcn_readfirstlane(ws8[8]), total = NL + BATCH * 8 * 64 * 2, per = (total + F.G - 1) / F.G;
    const int it0 = F.bid * per, it1 = (it0 + per < total) ? it0 + per : total;
    int cur = 0, loaded = -1;
    if (it0 < NL) { int lo = 0, hi = 1023;
        while (lo < hi) { const int mid = (lo + hi + 1) >> 1; if (pre[mid] <= it0) lo = mid; else hi = mid - 1; }
        cur = lo; }
    struct QA { int i, tile, own_item; bool valid; unsigned short ent; };
    struct QB { int i, own_item, tl, j; bool valid; bf16x8_t qf[2]; };
#define DEC_A(itx, R) do { int i_, tile_, own_; \
        if ((itx) < NL) { while (cur < 1023 && pre[cur + 1] <= (itx)) ++cur; i_ = cur; tile_ = (itx) - pre[cur]; own_ = 0; } \
        else { const int o_ = (itx) - NL; i_ = o_ >> 1; tile_ = o_ & 1; own_ = 1; } \
        i_ = __builtin_amdgcn_readfirstlane(i_); tile_ = __builtin_amdgcn_readfirstlane(tile_); \
        R.i = i_; R.tile = tile_; R.own_item = own_; R.ent = 0; R.valid = true; \
        if (!own_) { const int e_ = tile_ * 128 + wave * 16 + qi; R.valid = e_ < cl[i_]; if (R.valid) R.ent = list[(size_t)(i_ >> 6) * LSTRIDE + list_off(i_ & 63) + e_]; } } while (0)
#define DEC_B(A, R) do { const int bh_ = A.i >> 6, n_ = A.i & 63; R.i = A.i; R.own_item = A.own_item; R.valid = A.valid; \
        if (A.own_item) { R.tl = n_ * 256 + A.tile * 128 + wave * 16 + qi; R.j = 3; } else { R.tl = A.ent & 0x3fff; R.j = A.ent >> 14; } \
        { const size_t t_ = (size_t)(bh_ >> 3) * SEQ + R.tl; \
          R.qf[0] = *(const bf16x8_t*)(Q + t_ * 512 + (bh_ & 7) * 64 + quad * 8); R.qf[1] = *(const bf16x8_t*)(Q + t_ * 512 + (bh_ & 7) * 64 + 32 + quad * 8); } } while (0)
    QA na; na.i = 0; na.tile = 0; na.own_item = 1; na.valid = false; na.ent = 0;
    QB nx; nx.i = -1; nx.own_item = 0; nx.tl = 0; nx.j = 0; nx.valid = false; nx.qf[0] = (bf16x8_t){0, 0, 0, 0, 0, 0, 0, 0}; nx.qf[1] = nx.qf[0];
    if (it0 < it1) { DEC_A(it0, na); DEC_B(na, nx); if (it0 + 1 < it1) DEC_A(it0 + 1, na); }
    for (int it = it0; it < it1; ++it) {
        const int i = nx.i, own_item = nx.own_item, tl = nx.tl, j = nx.j; const bool valid = nx.valid; bf16x8_t qf[2] = {nx.qf[0], nx.qf[1]};
        const int bh = i >> 6, n = i & 63, b = bh >> 3, h = bh & 7;
        if (i != loaded) {
            __syncthreads();
#pragma unroll
            for (int r = 0; r < 4; ++r) { const int c = F.tid + r * 512, row = c >> 3, ch = c & 7;
                const u32x4 w = *(const u32x4*)(K + ((size_t)b * SEQ + n * 256 + row) * 512 + h * 64 + ch * 8); *(LAS u32x4*)(Kl + row * 144 + ch * 16) = w; }
#pragma unroll
            for (int r = 0; r < 4; ++r) { const int c = F.tid + r * 512, row = c >> 5, ch = c & 31;
                const u32x4 w = *(const u32x4*)(VT + ((size_t)bh * 64 + row) * SEQ + n * 256 + ch * 8); *(LAS u32x4*)(Vl + row * 528 + ch * 16) = w; }
            __syncthreads();
            loaded = i;
        }
        if (it + 1 < it1) { DEC_B(na, nx); if (it + 2 < it1) DEC_A(it + 2, na); }
        const size_t t = (size_t)b * SEQ + tl;
        const float slope2 = __builtin_amdgcn_exp2f(-(float)(h + 1)) * LOG2E;
        f32x4 sc[16];
#pragma unroll
        for (int kt = 0; kt < 16; ++kt) { f32x4 a = {0.f, 0.f, 0.f, 0.f};
#pragma unroll
            for (int ks = 0; ks < 2; ++ks) { const bf16x8_t kf = *(const LAS bf16x8_t*)(Kl + (kt * 16 + qi) * 144 + ks * 64 + quad * 16); a = __builtin_amdgcn_mfma_f32_16x16x32_bf16(kf, qf[ks], a, 0, 0, 0); }
            sc[kt] = a; if ((kt & 3) == 3) asm volatile("" ::: "memory"); }
        const int tloc = tl - n * 256;
        float mx = -INFINITY; const float sbase = slope2 * (float)(quad * 4); const int tq4 = tloc - quad * 4;
#pragma unroll
        for (int kt = 0; kt < 16; ++kt)
#pragma unroll
            for (int e = 0; e < 4; ++e) { float s = fmaf(slope2, (float)(kt * 16 + e), sc[kt][e] + sbase); if (own_item && (kt * 16 + e) > tq4) s = -INFINITY; sc[kt][e] = s; mx = fmaxf(mx, s); }
        mx = fmaxf(mx, __shfl_xor(mx, 16)); mx = fmaxf(mx, __shfl_xor(mx, 32));
        float ls = 0.f;
#pragma unroll
        for (int kt = 0; kt < 16; ++kt)
#pragma unroll
            for (int e = 0; e < 4; ++e) { const float p = __builtin_amdgcn_exp2f(sc[kt][e] - mx); sc[kt][e] = p; ls += p; }
        ls += __shfl_xor(ls, 16); ls += __shfl_xor(ls, 32);
        f32x4 o[4];
#pragma unroll
        for (int dt = 0; dt < 4; ++dt) o[dt] = (f32x4){0.f, 0.f, 0.f, 0.f};
#pragma unroll
        for (int k2 = 0; k2 < 8; ++k2) {
            u32x4 pw; pw.x = pg8::cvt_pk_bf16(sc[2 * k2][0], sc[2 * k2][1]); pw.y = pg8::cvt_pk_bf16(sc[2 * k2][2], sc[2 * k2][3]);
            pw.z = pg8::cvt_pk_bf16(sc[2 * k2 + 1][0], sc[2 * k2 + 1][1]); pw.w = pg8::cvt_pk_bf16(sc[2 * k2 + 1][2], sc[2 * k2 + 1][3]);
            const bf16x8_t pf = __builtin_bit_cast(bf16x8_t, pw);
#pragma unroll
            for (int dt = 0; dt < 4; ++dt) { const LAS unsigned char* vp = Vl + (dt * 16 + qi) * 528 + (k2 * 32 + quad * 4) * 2;
                const u32x2 lo = *(const LAS u32x2*)vp, hi = *(const LAS u32x2*)(vp + 32);
                const u32x4 vw = {lo.x, lo.y, hi.x, hi.y};
                o[dt] = __builtin_amdgcn_mfma_f32_16x16x32_bf16(__builtin_bit_cast(bf16x8_t, vw), pf, o[dt], 0, 0, 0); }
            if (k2 & 1) asm volatile("" ::: "memory"); }
        if (valid) { const float inv = 1.0f / ls; const size_t pidx = (t * 8 + h) * 4 + j; bf16* op = PO + pidx * 64 + quad * 4;
#pragma unroll
            for (int dt = 0; dt < 4; ++dt) *(u32x2*)(op + dt * 16) = (u32x2){pg8::cvt_pk_bf16(o[dt][0] * inv, o[dt][1] * inv), pg8::cvt_pk_bf16(o[dt][2] * inv, o[dt][3] * inv)};
            if (quad == 0) ((float2*)PML)[pidx] = make_float2(mx - slope2 * (float)tloc, ls); }
    }
#undef DEC_A
#undef DEC_B
    __syncthreads();
}
DI void comb_phase(Frame& F) {
    const bf16* PO = (const bf16*)(WSP(F) + WS_PARTO); const float* PML = (const float*)(WSP(F) + WS_PARTML); bf16* Y = (bf16*)(WSP(F) + WS_YATTN);
    const int gw = F.bid * 8 + F.wave, NGW = F.G * 8, lane = F.lane, h = lane >> 3, dc = lane & 7;
    for (int t = gw; t < T; t += NGW) {
        const int own = (t % SEQ) >> 8, nsel = own < 3 ? own : 3; const size_t pb = ((size_t)t * 8 + h) * 4;
        float m[4], lw[4]; float M = -INFINITY;
#pragma unroll
        for (int j = 0; j < 4; ++j) { const bool ok = (j == 3) || (j < nsel); const float2 ml = ok ? ((const float2*)PML)[pb + j] : make_float2(-INFINITY, 0.f); m[j] = ml.x; lw[j] = ml.y; M = fmaxf(M, ml.x); }
        float acc[8] = {0.f, 0.f, 0.f, 0.f, 0.f, 0.f, 0.f, 0.f}; float wsum = 0.f;
#pragma unroll
        for (int j = 0; j < 4; ++j) { const bool ok = (j == 3) || (j < nsel); if (!ok) continue;
            const float w = __builtin_amdgcn_exp2f(m[j] - M) * lw[j]; wsum += w; const u32x4 ow = *(const u32x4*)(PO + (pb + j) * 64 + dc * 8);
            acc[0] += w * blo(ow.x); acc[1] += w * bhi(ow.x); acc[2] += w * blo(ow.y); acc[3] += w * bhi(ow.y); acc[4] += w * blo(ow.z); acc[5] += w * bhi(ow.z); acc[6] += w * blo(ow.w); acc[7] += w * bhi(ow.w); }
        const float inv = 1.0f / wsum;
        *(u32x4*)(Y + (size_t)t * 512 + h * 64 + dc * 8) = (u32x4){pk2(acc[0] * inv, acc[1] * inv), pk2(acc[2] * inv, acc[3] * inv), pk2(acc[4] * inv, acc[5] * inv), pk2(acc[6] * inv, acc[7] * inv)};
    }
}
DI void pool_phase(Frame& F, int l) {
    const bf16* Z = (const bf16*)(WSP(F) + WS_POOLZ); bf16* Y = (bf16*)(WSP(F) + WS_YPOOL); const bf16* WPT = (const bf16*)(WSP(F) + WS_WPT);
    LAS unsigned char* Pl = F.lds;
    const int lane = F.lane, li = lane & 15, quad = lane >> 4, g = F.wave >> 1, dt0 = (F.wave & 1) * 4;
    bf16x8_t wf[4][4];
#pragma unroll
    for (int dt = 0; dt < 4; ++dt)
#pragma unroll
        for (int ks = 0; ks < 4; ++ks) wf[dt][ks] = *(const bf16x8_t*)(WPT + ((size_t)g * 128 + 16 * (dt0 + dt) + li) * 128 + 32 * ks + 8 * quad);
    for (int tile = F.bid; tile < T / 64; tile += F.G) {
        __syncthreads();
#pragma unroll 1
        for (int i = F.tid; i < 64 * 64; i += 512) { const int tt = i >> 6, ch = i & 63, gg = ch >> 4, win = 2 << gg, t = tile * 64 + tt, tl = t % SEQ; const int cnt = (tl + 1 < win) ? tl + 1 : win;
            u32x4 w[16];
#pragma unroll
            for (int j = 0; j < 16; ++j) { w[j] = (u32x4){0u, 0u, 0u, 0u}; if (j < cnt) w[j] = *(const u32x4*)(Z + (size_t)(t - j) * 512 + ch * 8); }
            float s[8] = {0.f, 0.f, 0.f, 0.f, 0.f, 0.f, 0.f, 0.f};
#pragma unroll
            for (int j = 0; j < 16; ++j) { s[0] += blo(w[j].x); s[1] += bhi(w[j].x); s[2] += blo(w[j].y); s[3] += bhi(w[j].y); s[4] += blo(w[j].z); s[5] += bhi(w[j].z); s[6] += blo(w[j].w); s[7] += bhi(w[j].w); }
            const float inv = 1.0f / (float)cnt;
            *(LAS u32x4*)(Pl + tt * 1040 + ch * 16) = (u32x4){pk2(s[0] * inv - blo(w[0].x), s[1] * inv - bhi(w[0].x)), pk2(s[2] * inv - blo(w[0].y), s[3] * inv - bhi(w[0].y)),
                                                                 pk2(s[4] * inv - blo(w[0].z), s[5] * inv - bhi(w[0].z)), pk2(s[6] * inv - blo(w[0].w), s[7] * inv - bhi(w[0].w))}; }
        __syncthreads();
#pragma unroll
        for (int tt = 0; tt < 4; ++tt) {
            bf16x8_t pf[4];
#pragma unroll
            for (int ks = 0; ks < 4; ++ks) pf[ks] = *(const LAS bf16x8_t*)(Pl + (16 * tt + li) * 1040 + (g * 128 + 32 * ks + 8 * quad) * 2);
#pragma unroll
            for (int dt = 0; dt < 4; ++dt) { f32x4 acc = {0.f, 0.f, 0.f, 0.f};
#pragma unroll
                for (int ks = 0; ks < 4; ++ks) acc = __builtin_amdgcn_mfma_f32_16x16x32_bf16(wf[dt][ks], pf[ks], acc, 0, 0, 0);
                *(u32x2*)(Y + (size_t)(tile * 64 + 16 * tt + li) * 512 + g * 128 + 16 * (dt0 + dt) + 4 * quad) = (u32x2){pk2(acc[0], acc[1]), pk2(acc[2], acc[3])}; } }
    }
    __syncthreads();
}
DI void rwkv_prep_phase(Frame& F, int l) {
    const bf16* RZ = (const bf16*)(WSP(F) + WS_RWKVZ); bf16* VF = (bf16*)(WSP(F) + WS_VFIRST);
    bf16* AR = (bf16*)(WSP(F) + WS_AR); const size_t AS = (size_t)T * 512;
    float* bonus = (float*)(WSP(F) + WS_BONUS); const bf16* WLT = (const bf16*)(WSP(F) + WS_WLT);
    LAS unsigned char* Al = F.lds;
    const int h = F.wave;
    const float* mu = INP(F, 4) + l * 1792; const float* vmu = INP(F, 5) + (l > 0 ? (l - 1) * 32 : 0);
    const float* w0p = INP(F, 6) + l * 512 + h * 64; const float* a0p = INP(F, 8) + l * 512 + h * 64; const float* kkp = INP(F, 11) + l * 512 + h * 64;
    const float* kap = INP(F, 12) + l * 512 + h * 64; const float* rkp = INP(F, 13) + l * 512 + h * 64; const float* v0p = INP(F, 16) + (l > 0 ? l - 1 : 0) * 512 + h * 64;
    const int nch = l > 0 ? 36 : 32;
    for (int item = F.bid; item < T / 64; item += F.G) {
        int lane = F.lane; asm volatile("" : "+v"(lane));
        const int li = lane & 15, quad = lane >> 4;
        const int t0 = item * 64, tl0 = t0 % SEQ;
        __syncthreads();
        for (int i = F.tid; i < 64 * nch; i += 512) { const int tok = i / nch, c = i % nch, col = 1536 + 8 * c; const size_t t = (size_t)(t0 + tok);
            const u32x4 zc = *(const u32x4*)(RZ + t * RZP + col); u32x4 zp = {0u, 0u, 0u, 0u}; if (tl0 + tok != 0) zp = *(const u32x4*)(RZ + (t - 1) * RZP + col);
            const float* mp = col < 1792 ? mu + col : vmu + (col - 1792); const f32x4 m0 = *(const f32x4*)mp, m1 = *(const f32x4*)(mp + 4);
            const float cv[8] = {blo(zc.x), bhi(zc.x), blo(zc.y), bhi(zc.y), blo(zc.z), bhi(zc.z), blo(zc.w), bhi(zc.w)}, pv[8] = {blo(zp.x), bhi(zp.x), blo(zp.y), bhi(zp.y), blo(zp.z), bhi(zp.z), blo(zp.w), bhi(zp.w)};
            const float mm[8] = {m0.x, m0.y, m0.z, m0.w, m1.x, m1.y, m1.z, m1.w}; float f[8];
#pragma unroll
            for (int e = 0; e < 8; ++e) { const float zs = cv[e] + (pv[e] - cv[e]) * mm[e]; f[e] = c < 8 ? tanhf(zs) : (c >= 16 && c < 32) ? sigmoidf_(zs) : zs; }
            *(LAS u32x4*)(Al + tok * 592 + c * 16) = (u32x4){pk2(f[0], f[1]), pk2(f[2], f[3]), pk2(f[4], f[5]), pk2(f[6], f[7])}; }
        __syncthreads();
#pragma unroll 1
        for (int rt = 0; rt < 4; ++rt) {
            const int tok = 16 * rt + li; const size_t t = (size_t)(t0 + tok);
            f32x4 aw[4], aa[4], ag[4], av[4];
#pragma unroll
            for (int ct = 0; ct < 4; ++ct) { aw[ct] = (f32x4){0.f, 0.f, 0.f, 0.f}; aa[ct] = aw[ct]; ag[ct] = aw[ct]; av[ct] = aw[ct]; }
#pragma unroll
            for (int ks = 0; ks < 9; ++ks) { if (ks == 8 && l == 0) break;
                const bf16x8_t bfr = *(const LAS bf16x8_t*)(Al + tok * 592 + ks * 64 + quad * 16);
#pragma unroll
                for (int ct = 0; ct < 4; ++ct) { const bf16x8_t afr = *(const bf16x8_t*)(WLT + (size_t)(h * 64 + 16 * ct + li) * 288 + 32 * ks + 8 * quad);
                    if (ks < 2) aw[ct] = __builtin_amdgcn_mfma_f32_16x16x32_bf16(afr, bfr, aw[ct], 0, 0, 0);
                    else if (ks < 4) aa[ct] = __builtin_amdgcn_mfma_f32_16x16x32_bf16(afr, bfr, aa[ct], 0, 0, 0);
                    else if (ks < 8) ag[ct] = __builtin_amdgcn_mfma_f32_16x16x32_bf16(afr, bfr, ag[ct], 0, 0, 0);
                    else av[ct] = __builtin_amdgcn_mfma_f32_16x16x32_bf16(afr, bfr, av[ct], 0, 0, 0); }
                if (ks & 1) asm volatile("" ::: "memory"); }
            const bool first = (tl0 + tok == 0);
            float kk[4][4], as_[4][4]; float ss = 0.f, bs = 0.f;
#pragma unroll
            for (int ct = 0; ct < 4; ++ct) { const int cb = 16 * ct + 4 * quad; const size_t zi = t * RZP + h * 64 + cb;
                const u32x2 cr = *(const u32x2*)(RZ + zi), ck = *(const u32x2*)(RZ + zi + 512), cvv = *(const u32x2*)(RZ + zi + 1024);
                u32x2 pr = {0u, 0u}, pk_ = {0u, 0u}, pvv = {0u, 0u};
                if (!first) { pr = *(const u32x2*)(RZ + zi - RZP); pk_ = *(const u32x2*)(RZ + zi - RZP + 512); pvv = *(const u32x2*)(RZ + zi - RZP + 1024); }
                const f32x4 mr = *(const f32x4*)(mu + h * 64 + cb), mk = *(const f32x4*)(mu + 512 + h * 64 + cb), mv = *(const f32x4*)(mu + 1024 + h * 64 + cb);
                const f32x4 w0 = *(const f32x4*)(w0p + cb), a0 = *(const f32x4*)(a0p + cb), kkc = *(const f32x4*)(kkp + cb), kac = *(const f32x4*)(kap + cb), rkc = *(const f32x4*)(rkp + cb);
                const float crf[4] = {blo(cr.x), bhi(cr.x), blo(cr.y), bhi(cr.y)}, ckf[4] = {blo(ck.x), bhi(ck.x), blo(ck.y), bhi(ck.y)}, cvf[4] = {blo(cvv.x), bhi(cvv.x), blo(cvv.y), bhi(cvv.y)};
                const float prf[4] = {blo(pr.x), bhi(pr.x), blo(pr.y), bhi(pr.y)}, pkf[4] = {blo(pk_.x), bhi(pk_.x), blo(pk_.y), bhi(pk_.y)}, pvf[4] = {blo(pvv.x), bhi(pvv.x), blo(pvv.y), bhi(pvv.y)};
                float vo[4], lwo[4], ro[4], kpo[4];
                const size_t idx = t * 512 + h * 64 + cb;
                u32x2 vfw = {0u, 0u}; f32x4 v0 = {0.f, 0.f, 0.f, 0.f}; if (l > 0) { vfw = *(const u32x2*)(VF + idx); v0 = *(const f32x4*)(v0p + cb); }
                const float vff[4] = {blo(vfw.x), bhi(vfw.x), blo(vfw.y), bhi(vfw.y)};
#pragma unroll
                for (int e = 0; e < 4; ++e) { const float r = crf[e] + (prf[e] - crf[e]) * mr[e], k = ckf[e] + (pkf[e] - ckf[e]) * mk[e]; float v = cvf[e] + (pvf[e] - cvf[e]) * mv[e];
                    const float xw = -(w0[e] + aw[ct][e]); const float sp = xw > 20.f ? xw : log1pf(__expf(xw)); lwo[e] = -__expf(-sp - 0.5f);
                    const float asig = sigmoidf_(a0[e] + aa[ct][e]);
                    if (l > 0) v = v + (vff[e] - v) * sigmoidf_(v0[e] + av[ct][e]);
                    vo[e] = v; ro[e] = r; as_[ct][e] = asig; const float kr = k * kkc[e]; kk[ct][e] = kr; ss += kr * kr;
                    const float kpe = k * (1.0f + (asig - 1.0f) * kac[e]); kpo[e] = kpe; bs += r * kpe * rkc[e]; }
                if (l == 0) *(u32x2*)(VF + idx) = (u32x2){pk2(vo[0], vo[1]), pk2(vo[2], vo[3])};
                *(u32x2*)(AR + idx) = (u32x2){pk2(ro[0], ro[1]), pk2(ro[2], ro[3])};
                *(u32x2*)(AR + 2 * AS + idx) = (u32x2){pk2(kpo[0], kpo[1]), pk2(kpo[2], kpo[3])};
                *(u32x2*)(AR + AS + idx) = (u32x2){pk2(lwo[0], lwo[1]), pk2(lwo[2], lwo[3])};
                *(u32x2*)(AR + 3 * AS + idx) = (u32x2){pk2(vo[0], vo[1]), pk2(vo[2], vo[3])};
                *(u32x2*)(AR + 6 * AS + idx) = (u32x2){pk2(ag[ct][0], ag[ct][1]), pk2(ag[ct][2], ag[ct][3])}; asm volatile("" ::: "memory"); }
            ss += __shfl_xor(ss, 16); ss += __shfl_xor(ss, 32); bs += __shfl_xor(bs, 16); bs += __shfl_xor(bs, 32);
            const float inv = 1.0f / fmaxf(sqrtf(ss), 1e-12f);
#pragma unroll
            for (int ct = 0; ct < 4; ++ct) { const size_t idx = t * 512 + h * 64 + 16 * ct + 4 * quad; float kn[4], bb[4];
#pragma unroll
                for (int e = 0; e < 4; ++e) { kn[e] = kk[ct][e] * inv; bb[e] = kn[e] * as_[ct][e]; }
                *(u32x2*)(AR + 4 * AS + idx) = (u32x2){pk2(kn[0], kn[1]), pk2(kn[2], kn[3])};
                *(u32x2*)(AR + 5 * AS + idx) = (u32x2){pk2(bb[0], bb[1]), pk2(bb[2], bb[3])}; }
            if (quad == 0) bonus[t * 8 + h] = bs;
        }
    }
    __syncthreads();
}
typedef float f32x2 __attribute__((ext_vector_type(2)));
DI void rwkv_chunk_phase(Frame& F) {
    const bf16* AR = (const bf16*)(WSP(F) + WS_AR); const size_t AS = (size_t)T * 512;
    bf16* PCT = (bf16*)(WSP(F) + WS_PCT); bf16* LC = (bf16*)(WSP(F) + WS_LC); bf16* RM = (bf16*)(WSP(F) + WS_RM); bf16* Y0 = (bf16*)(WSP(F) + WS_Y0);
    LAS float* sb = (LAS float*)(F.lds + F.wave * 12288);
    const int gw = F.bid * 8 + F.wave, NGW = F.G * 8;
    for (int it = gw; it < BATCH * 8 * (SEQ / 64); it += NGW) {
        int lane = F.lane; asm volatile("" : "+v"(lane));
        const int bh = it >> 8, ck = it & 255, b = bh >> 3, h = bh & 7;
        f32x2 S1[32], S2[32];
#pragma unroll
        for (int i = 0; i < 32; ++i) { S1[i] = (f32x2){(2 * i == lane) ? 1.f : 0.f, (2 * i + 1 == lane) ? 1.f : 0.f}; S2[i] = (f32x2){0.f, 0.f}; }
        const size_t ubase = ((size_t)b * SEQ + ck * 64) * 512 + h * 64;
        bf16* rm = RM + (size_t)it * 4096; bf16* y0 = Y0 + (size_t)it * 4096;
        for (int t0 = 0; t0 < 64; t0 += 8) {
#pragma unroll
            for (int s = 0; s < 8; ++s) { const bf16* ap = AR + ubase + (size_t)(t0 + s) * 512;
                sb[(s * 6 + 0) * 64 + lane] = -bf2f((ap + 4 * AS)[lane]);
                sb[(s * 6 + 1) * 64 + lane] = bf2f((ap + 5 * AS)[lane]);
                sb[(s * 6 + 2) * 64 + lane] = bf2f((ap + 2 * AS)[lane]);
                sb[(s * 6 + 3) * 64 + lane] = __expf(bf2f((ap + AS)[lane]));
                sb[(s * 6 + 4) * 64 + lane] = bf2f(ap[lane]);
                sb[(s * 6 + 5) * 64 + lane] = bf2f((ap + 3 * AS)[lane]); }
            LDS_WAIT(); asm volatile("" ::: "memory");
#pragma unroll 1
            for (int s = 0; s < 8; ++s) {
                const LAS f32x4* pa = (const LAS f32x4*)(sb + (s * 6 + 0) * 64); const LAS f32x4* pb = (const LAS f32x4*)(sb + (s * 6 + 1) * 64);
                const LAS f32x4* pk = (const LAS f32x4*)(sb + (s * 6 + 2) * 64); const LAS f32x4* pw = (const LAS f32x4*)(sb + (s * 6 + 3) * 64);
                const LAS f32x4* pr = (const LAS f32x4*)(sb + (s * 6 + 4) * 64);
                const float v = sb[(s * 6 + 5) * 64 + lane];
                f32x2 a1 = {0.f, 0.f}, a2 = {0.f, 0.f};
#pragma unroll
                for (int i = 0; i < 16; ++i) { const f32x4 a = pa[i]; const f32x2 alo = {a.x, a.y}, ahi = {a.z, a.w};
                    a1 = S1[2 * i] * alo + a1; a1 = S1[2 * i + 1] * ahi + a1; a2 = S2[2 * i] * alo + a2; a2 = S2[2 * i + 1] * ahi + a2;
                    if ((i & 7) == 7) asm volatile("" ::: "memory"); }
                const float sa1 = a1.x + a1.y, sa2 = a2.x + a2.y; const f32x2 sa1v = {sa1, sa1}, sa2v = {sa2, sa2}, vv = {v, v};
                f32x2 y1 = {0.f, 0.f}, y2 = {0.f, 0.f};
#pragma unroll
                for (int i = 0; i < 16; ++i) { const f32x4 bb = pb[i], kk = pk[i], ww = pw[i], rr = pr[i];
                    const f32x2 blo_ = {bb.x, bb.y}, bhi_ = {bb.z, bb.w}, klo = {kk.x, kk.y}, khi = {kk.z, kk.w}, wlo = {ww.x, ww.y}, whi = {ww.z, ww.w}, rlo = {rr.x, rr.y}, rhi = {rr.z, rr.w};
                    S1[2 * i] = S1[2 * i] * wlo + sa1v * blo_; S1[2 * i + 1] = S1[2 * i + 1] * whi + sa1v * bhi_;
                    S2[2 * i] = S2[2 * i] * wlo + (sa2v * blo_ + vv * klo); S2[2 * i + 1] = S2[2 * i + 1] * whi + (sa2v * bhi_ + vv * khi);
                    y1 = S1[2 * i] * rlo + y1; y1 = S1[2 * i + 1] * rhi + y1; y2 = S2[2 * i] * rlo + y2; y2 = S2[2 * i + 1] * rhi + y2;
                    if ((i & 3) == 3) asm volatile("" ::: "memory"); }
                (rm + (t0 + s) * 64)[lane] = (bf16)f2bf(y1.x + y1.y); (y0 + (t0 + s) * 64)[lane] = (bf16)f2bf(y2.x + y2.y);
            }
            LDS_WAIT(); asm volatile("" ::: "memory");
        }
        { u32x4* lp = (u32x4*)(LC + (size_t)it * 4096 + lane * 64);
#pragma unroll
          for (int i = 0; i < 8; ++i) lp[i] = (u32x4){pk2(S2[4 * i].x, S2[4 * i].y), pk2(S2[4 * i + 1].x, S2[4 * i + 1].y), pk2(S2[4 * i + 2].x, S2[4 * i + 2].y), pk2(S2[4 * i + 3].x, S2[4 * i + 3].y)};
          bf16* pp = PCT + (size_t)it * 4096;
#pragma unroll
          for (int k = 0; k < 32; ++k) { (pp + (2 * k) * 64)[lane] = (bf16)f2bf(S1[k].x); (pp + (2 * k + 1) * 64)[lane] = (bf16)f2bf(S1[k].y); } }
    }
}
DI void rwkv_state_phase(Frame& F) {
    if (F.bid >= BATCH * 8) return;
    constexpr int SLOT = 18432, NSL = 6;
    const int bh = F.bid, wave = F.wave, lane = F.lane;
    const bf16* PCT = (const bf16*)(WSP(F) + WS_PCT) + (size_t)bh * 256 * 4096; const bf16* LC = (const bf16*)(WSP(F) + WS_LC) + (size_t)bh * 256 * 4096;
    bf16* S0 = (bf16*)(WSP(F) + WS_S0) + (size_t)bh * 256 * 4096;
    LAS unsigned char* ring = F.lds;
#define RBAR() do { asm volatile("s_waitcnt lgkmcnt(0)" ::: "memory"); __builtin_amdgcn_s_barrier(); asm volatile("" ::: "memory"); } while (0)
    if (wave >= 4) {
        const int lw = wave - 4; u32x4 rg[3][4];
        unsigned loff[4];
#pragma unroll
        for (int i = 0; i < 4; ++i) { const int p = i * 256 + lw * 64 + lane, pp = p & 511; loff[i] = (unsigned)((p >> 9) * 9216 + (pp >> 3) * 144 + (pp & 7) * 16); }
#define RLOAD(q, x) do { const u32x4* s0_ = (const u32x4*)(PCT + (size_t)(x) * 4096) + lw * 64 + lane; const u32x4* s1_ = (const u32x4*)(LC + (size_t)(x) * 4096) + lw * 64 + lane; \
            rg[q][0] = s0_[0]; rg[q][1] = s0_[256]; rg[q][2] = s1_[0]; rg[q][3] = s1_[256]; } while (0)
#define RWRITE(q, x) do { LAS unsigned char* d_ = ring + ((x) % NSL) * SLOT; _Pragma("unroll") for (int i = 0; i < 4; ++i) *(LAS u32x4*)(d_ + loff[i]) = rg[q][i]; } while (0)
        RLOAD(0, 0); RLOAD(1, 1); RLOAD(2, 2);
        RWRITE(0, 0); RWRITE(1, 1); RWRITE(2, 2);
        RLOAD(0, 3); RLOAD(1, 4); RLOAD(2, 5);
        RBAR();
#pragma unroll 1
        for (int c0 = 0; c0 < 256; c0 += 3) {
#pragma unroll
            for (int j = 0; j < 3; ++j) { const int c = c0 + j; if (c < 256) { const int x = c + 3;
                if (x < 256) { RWRITE(j, x); if (x + 3 < 256) RLOAD(j, x + 3); }
                RBAR(); } }
        }
#undef RLOAD
#undef RWRITE
    } else {
        const int vb = wave, vl = lane & 15, quad = lane >> 4;
        f32x4 st[4];
#pragma unroll
        for (int kt = 0; kt < 4; ++kt) st[kt] = (f32x4){0.f, 0.f, 0.f, 0.f};
        const unsigned aoff = (unsigned)(vl * 144 + quad * 8), loffc = (unsigned)(9216 + (16 * vb + vl) * 144 + quad * 8);
        RBAR();
#pragma unroll 1
        for (int c = 0; c < 256; ++c) {
            const LAS unsigned char* sl = ring + (c % NSL) * SLOT;
            u32x2 af[4][2][2], lf[4];
#pragma unroll
            for (int kt = 0; kt < 4; ++kt) {
#pragma unroll
                for (int s2 = 0; s2 < 2; ++s2) { af[kt][s2][0] = *(const LAS u32x2*)(sl + aoff + kt * 16 * 144 + s2 * 64); af[kt][s2][1] = *(const LAS u32x2*)(sl + aoff + kt * 16 * 144 + s2 * 64 + 32); }
                lf[kt] = *(const LAS u32x2*)(sl + loffc + kt * 32); }
            bf16x8_t bfr[2];
            { u32x2 pk[4];
#pragma unroll
              for (int kt = 0; kt < 4; ++kt) { pk[kt] = (u32x2){pg8::cvt_pk_bf16(st[kt][0], st[kt][1]), pg8::cvt_pk_bf16(st[kt][2], st[kt][3])};
                  *(u32x2*)(S0 + (size_t)c * 4096 + (16 * vb + vl) * 64 + 16 * kt + 4 * quad) = pk[kt]; }
              bfr[0] = __builtin_bit_cast(bf16x8_t, (u32x4){pk[0].x, pk[0].y, pk[1].x, pk[1].y}); bfr[1] = __builtin_bit_cast(bf16x8_t, (u32x4){pk[2].x, pk[2].y, pk[3].x, pk[3].y}); }
#pragma unroll
            for (int kt = 0; kt < 4; ++kt) { f32x4 acc = (f32x4){blo(lf[kt].x), bhi(lf[kt].x), blo(lf[kt].y), bhi(lf[kt].y)};
                acc = __builtin_amdgcn_mfma_f32_16x16x32_bf16(__builtin_bit_cast(bf16x8_t, (u32x4){af[kt][0][0].x, af[kt][0][0].y, af[kt][0][1].x, af[kt][0][1].y}), bfr[0], acc, 0, 0, 0);
                acc = __builtin_amdgcn_mfma_f32_16x16x32_bf16(__builtin_bit_cast(bf16x8_t, (u32x4){af[kt][1][0].x, af[kt][1][0].y, af[kt][1][1].x, af[kt][1][1].y}), bfr[1], acc, 0, 0, 0);
                st[kt] = acc; }
            RBAR();
        }
    }
#undef RBAR
}
DI void rwkv_out_phase(Frame& F, int l) {
    bf16* AR = (bf16*)(WSP(F) + WS_AR); const size_t AS = (size_t)T * 512; const float* bonus = (const float*)(WSP(F) + WS_BONUS);
    const bf16* RM = (const bf16*)(WSP(F) + WS_RM); const bf16* Y0 = (const bf16*)(WSP(F) + WS_Y0); const bf16* S0 = (const bf16*)(WSP(F) + WS_S0);
    const int gw = F.bid * 8 + F.wave, NGW = F.G * 8, lane = F.lane, li = lane & 15, quad = lane >> 4;
    for (int it = gw; it < BATCH * 8 * (SEQ / 64); it += NGW) {
        const int bh = it >> 8, ck = it & 255, b = bh >> 3, h = bh & 7;
        const bf16* s0 = S0 + (size_t)it * 4096; const bf16* rm = RM + (size_t)it * 4096; const bf16* y0 = Y0 + (size_t)it * 4096;
        bf16x8_t sa[4][2];
#pragma unroll
        for (int vt = 0; vt < 4; ++vt)
#pragma unroll
            for (int s2 = 0; s2 < 2; ++s2) sa[vt][s2] = *(const bf16x8_t*)(s0 + (16 * vt + li) * 64 + 32 * s2 + 8 * quad);
        float lg[4][4], lb[4][4];
#pragma unroll
        for (int vt = 0; vt < 4; ++vt) { const f32x4 g4 = *(const f32x4*)(INP(F, 14) + l * 512 + h * 64 + 16 * vt + 4 * quad), b4 = *(const f32x4*)(INP(F, 15) + l * 512 + h * 64 + 16 * vt + 4 * quad);
            lg[vt][0] = g4.x; lg[vt][1] = g4.y; lg[vt][2] = g4.z; lg[vt][3] = g4.w; lb[vt][0] = b4.x; lb[vt][1] = b4.y; lb[vt][2] = b4.z; lb[vt][3] = b4.w; }
#pragma unroll 1
        for (int tt = 0; tt < 4; ++tt) {
            const int tch = 16 * tt + li; const size_t t = (size_t)b * SEQ + ck * 64 + tch;
            bf16x8_t rb[2];
#pragma unroll
            for (int s2 = 0; s2 < 2; ++s2) rb[s2] = *(const bf16x8_t*)(rm + tch * 64 + 32 * s2 + 8 * quad);
            f32x4 acc[4];
#pragma unroll
            for (int vt = 0; vt < 4; ++vt) { const u32x2 yw = *(const u32x2*)(y0 + tch * 64 + 16 * vt + 4 * quad); acc[vt] = (f32x4){blo(yw.x), bhi(yw.x), blo(yw.y), bhi(yw.y)};
                acc[vt] = __builtin_amdgcn_mfma_f32_16x16x32_bf16(sa[vt][0], rb[0], acc[vt], 0, 0, 0); acc[vt] = __builtin_amdgcn_mfma_f32_16x16x32_bf16(sa[vt][1], rb[1], acc[vt], 0, 0, 0); }
            float sm = 0.f;
#pragma unroll
            for (int vt = 0; vt < 4; ++vt) sm += (acc[vt][0] + acc[vt][1]) + (acc[vt][2] + acc[vt][3]);
            sm += __shfl_xor(sm, 16); sm += __shfl_xor(sm, 32);
            const float mean = sm * (1.f / 64.f); float sq = 0.f;
#pragma unroll
            for (int vt = 0; vt < 4; ++vt)
#pragma unroll
                for (int e = 0; e < 4; ++e) { const float d = acc[vt][e] - mean; acc[vt][e] = d; sq += d * d; }
            sq += __shfl_xor(sq, 16); sq += __shfl_xor(sq, 32);
            const float rstd = rsqrtf(sq * (1.f / 64.f) + 64e-5f), bon = bonus[t * 8 + h];
            const size_t idx = t * 512 + h * 64 + 4 * quad;
#pragma unroll
            for (int vt = 0; vt < 4; ++vt) { const u32x2 vw = *(const u32x2*)(AR + 3 * AS + idx + 16 * vt), gw2 = *(const u32x2*)(AR + 6 * AS + idx + 16 * vt);
                const float vv[4] = {blo(vw.x), bhi(vw.x), blo(vw.y), bhi(vw.y)}, gg[4] = {blo(gw2.x), bhi(gw2.x), blo(gw2.y), bhi(gw2.y)}; float o[4];
#pragma unroll
                for (int e = 0; e < 4; ++e) o[e] = (acc[vt][e] * rstd * lg[vt][e] + lb[vt][e] + bon * vv[e]) * gg[e];
                *(u32x2*)(AR + idx + 16 * vt) = (u32x2){pk2(o[0], o[1]), pk2(o[2], o[3])}; }
        }
    }
}
DI void route_phase(Frame& F, int l) {
    const float* x = OUTP(F); bf16* h2 = (bf16*)(WSP(F) + WS_XB); const bf16* RWH = (const bf16*)(WSP(F) + WS_RWG); const bf16* RWL = RWH + 48 * 1024;
    int* route = (int*)(WSP(F) + WS_ROUTE); float* rwt = (float*)(WSP(F) + WS_RWT); unsigned* cnt = (unsigned*)(WSP(F) + WS_CTL) + CW_CNT + 32 * l;
    const float* rgb = INP(F, 24) + l * 4; const float* reb = INP(F, 26) + l * 32;
    LAS unsigned* lc = (LAS unsigned*)(F.lds + MISC_OFF + 8192); unsigned* wgbase = (unsigned*)(WSP(F) + WS_WGBASE);
    for (int wit = F.bid; wit < T / 128; wit += F.G) {
        int lane = F.lane; asm volatile("" : "+v"(lane));
        __syncthreads();
        if (F.tid < 32) lc[F.tid] = 0u;
        __syncthreads();
        const int it = wit * 8 + F.wave;
        const int li = lane & 15, quad = lane >> 4; const size_t t = (size_t)it * 16 + li;
        const float* xr = x + t * DM + 8 * quad;
        f32x4 acc[3];
#pragma unroll
        for (int jt = 0; jt < 3; ++jt) acc[jt] = (f32x4){0.f, 0.f, 0.f, 0.f};
        float ss = 0.f;
#pragma unroll 2
        for (int ks = 0; ks < 32; ++ks) {
            const f32x4 x0 = *(const f32x4*)(xr + 32 * ks), x1 = *(const f32x4*)(xr + 32 * ks + 4);
            ss += (x0.x * x0.x + x0.y * x0.y) + (x0.z * x0.z + x0.w * x0.w) + (x1.x * x1.x + x1.y * x1.y) + (x1.z * x1.z + x1.w * x1.w);
            const float xf[8] = {x0.x, x0.y, x0.z, x0.w, x1.x, x1.y, x1.z, x1.w}; unsigned hb[8]; float lo[8];
#pragma unroll
            for (int e = 0; e < 8; ++e) { hb[e] = f2bf(xf[e]); lo[e] = xf[e] - __uint_as_float(hb[e] << 16); }
            const bf16x8_t bh = __builtin_bit_cast(bf16x8_t, (u32x4){hb[0] | (hb[1] << 16), hb[2] | (hb[3] << 16), hb[4] | (hb[5] << 16), hb[6] | (hb[7] << 16)});
            const bf16x8_t bl = __builtin_bit_cast(bf16x8_t, (u32x4){pk2(lo[0], lo[1]), pk2(lo[2], lo[3]), pk2(lo[4], lo[5]), pk2(lo[6], lo[7])});
#pragma unroll
            for (int jt = 0; jt < 3; ++jt) { const size_t wo = (size_t)(16 * jt + li) * 1024 + 32 * ks + 8 * quad;
                const bf16x8_t wh = *(const bf16x8_t*)(RWH + wo), wl = *(const bf16x8_t*)(RWL + wo);
                acc[jt] = __builtin_amdgcn_mfma_f32_16x16x32_bf16(wh, bh, acc[jt], 0, 0, 0);
                acc[jt] = __builtin_amdgcn_mfma_f32_16x16x32_bf16(wl, bh, acc[jt], 0, 0, 0);
                acc[jt] = __builtin_amdgcn_mfma_f32_16x16x32_bf16(wh, bl, acc[jt], 0, 0, 0); }
        }
        ss += __shfl_xor(ss, 16); ss += __shfl_xor(ss, 32);
        const float rs = rsqrtf(ss * (1.f / DM) + 1e-6f);
#pragma unroll 4
        for (int ks = 0; ks < 32; ++ks) { const f32x4 x0 = *(const f32x4*)(xr + 32 * ks), x1 = *(const f32x4*)(xr + 32 * ks + 4);
            *(u32x4*)(h2 + t * DM + 32 * ks + 8 * quad) = (u32x4){pk2(x0.x * rs, x0.y * rs), pk2(x0.z * rs, x0.w * rs), pk2(x1.x * rs, x1.y * rs), pk2(x1.z * rs, x1.w * rs)}; }
        float gl[4]; int grp = 0;
#pragma unroll
        for (int j = 0; j < 4; ++j) gl[j] = acc[0][j] * rs + rgb[j];
        float gm = gl[0];
#pragma unroll
        for (int j = 1; j < 4; ++j) if (gl[j] > gm) { gm = gl[j]; grp = j; }
        if (quad == grp) {
            float gs = 0.f;
#pragma unroll
            for (int j = 0; j < 4; ++j) gs += __expf(gl[j] - gm);
            const float gprob = 1.0f / gs;
            float eg[8];
#pragma unroll
            for (int i = 0; i < 4; ++i) { eg[i] = acc[1][i] * rs + reb[8 * quad + i]; eg[4 + i] = acc[2][i] * rs + reb[8 * quad + 4 + i]; }
            int i0 = 0; float m0 = eg[0];
#pragma unroll
            for (int i = 1; i < 8; ++i) if (eg[i] > m0) { m0 = eg[i]; i0 = i; }
            int i1 = -1; float m1 = -INFINITY;
#pragma unroll
            for (int i = 0; i < 8; ++i) if (i != i0 && eg[i] > m1) { m1 = eg[i]; i1 = i; }
            const float e10 = __expf(m1 - m0), wa = gprob / (1.0f + e10), wb = gprob * e10 / (1.0f + e10);
            const int e0 = grp * 8 + i0, e1 = grp * 8 + i1;
            const unsigned r0 = atomicAdd((unsigned*)(lc + e0), 1u), r1 = atomicAdd((unsigned*)(lc + e1), 1u);
            ((int4*)route)[t] = make_int4(e0, (int)r0, e1, (int)r1); ((float2*)rwt)[t] = make_float2(wa, wb);
        }
        __syncthreads();
        if (F.tid < 32) { const unsigned c = lc[F.tid]; wgbase[wit * 32 + F.tid] = c ? atomicAdd(cnt + F.tid, c) : 0u; }
    }
    __syncthreads();
}
DI int moe_tables(Frame& F, int l) {
    LAS int* ps = (LAS int*)(F.lds + MISC_OFF); LAS unsigned char* te = (LAS unsigned char*)(F.lds + MISC_OFF + 256);
    const unsigned* cnt = (const unsigned*)(WSP(F) + WS_CTL) + CW_CNT + 32 * l;
    __syncthreads();
    if (F.tid == 0) { int acc = 0;
_Pragma("unroll 1")
        for (int e = 0; e < NEXP; ++e) { ps[e] = acc; const int c = (int)__hip_atomic_load(cnt + e, __ATOMIC_RELAXED, __HIP_MEMORY_SCOPE_AGENT); const int nt = (c + 255) >> 8;
_Pragma("unroll 1")
            for (int i = 0; i < nt; ++i) te[(acc >> 8) + i] = (unsigned char)e; acc += nt << 8; } ps[NEXP] = acc; }
    __syncthreads();
    return __builtin_amdgcn_readfirstlane(ps[NEXP] >> 8);
}
DI void permute_phase(Frame& F, int l) {
    moe_tables(F, l);
    const LAS int* ps = (const LAS int*)(F.lds + MISC_OFF);
    const bf16* h2 = (const bf16*)(WSP(F) + WS_XB); bf16* xp = (bf16*)(WSP(F) + WS_XPERM); const int* route = (const int*)(WSP(F) + WS_ROUTE); int* dest = (int*)(WSP(F) + WS_DEST);
    const int gw = F.bid * 8 + F.wave, NGW = F.G * 8, lane = F.lane;
    for (int t = gw; t < T; t += NGW) {
        const int4 r = ((const int4*)route)[t]; const unsigned* wb_ = (const unsigned*)(WSP(F) + WS_WGBASE) + (t >> 7) * 32; const int d0 = ps[r.x] + (int)wb_[r.x] + r.y, d1 = ps[r.z] + (int)wb_[r.z] + r.w;
        const u32x4* src = (const u32x4*)(h2 + (size_t)t * DM) + lane; u32x4* o0 = (u32x4*)(xp + (size_t)d0 * DM) + lane; u32x4* o1 = (u32x4*)(xp + (size_t)d1 * DM) + lane;
        const u32x4 a = src[0], b = src[64]; o0[0] = a; o0[64] = b; o1[0] = a; o1[64] = b;
        if (lane == 0) ((int2*)dest)[t] = make_int2(d0, d1);
    }
}
DI void combine_phase(Frame& F, int l) {
    float* x = OUTP(F); const bf16* Y = (const bf16*)(WSP(F) + WS_YMOE); const int* dest = (const int*)(WSP(F) + WS_DEST); const float* rwt = (const float*)(WSP(F) + WS_RWT);
    bf16* xb = (bf16*)(WSP(F) + WS_XB); const float* fg = INP(F, 30);
    const int gw = F.bid * 8 + F.wave, NGW = F.G * 8, lane = F.lane; const bool last = (l == DEPTH - 1);
    for (int t = gw; t < T; t += NGW) {
        const int2 d = ((const int2*)dest)[t]; const float2 w = ((const float2*)rwt)[t];
        f32x4* xr = (f32x4*)(x + (size_t)t * DM) + lane; const u32x2* y0 = (const u32x2*)(Y + (size_t)d.x * DM) + lane; const u32x2* y1 = (const u32x2*)(Y + (size_t)d.y * DM) + lane;
        f32x4 v[4]; float s = 0.f;
#pragma unroll
        for (int j = 0; j < 4; ++j) { v[j] = xr[64 * j]; const u32x2 a = y0[64 * j], b = y1[64 * j];
            v[j].x += w.x * blo(a.x) + w.y * blo(b.x); v[j].y += w.x * bhi(a.x) + w.y * bhi(b.x); v[j].z += w.x * blo(a.y) + w.y * blo(b.y); v[j].w += w.x * bhi(a.y) + w.y * bhi(b.y);
            s += (v[j].x * v[j].x + v[j].y * v[j].y) + (v[j].z * v[j].z + v[j].w * v[j].w); }
        const float rs = rsqrtf(wave_sum(s) * (1.f / DM) + 1e-6f);
        if (last) {
#pragma unroll
            for (int j = 0; j < 4; ++j) { const f32x4 g = ((const f32x4*)fg)[lane + 64 * j]; xr[64 * j] = v[j] * rs * g; }
        } else {
            u32x2* o = (u32x2*)(xb + (size_t)t * DM) + lane;
#pragma unroll
            for (int j = 0; j < 4; ++j) { xr[64 * j] = v[j]; o[64 * j] = (u32x2){pk2(v[j].x * rs, v[j].y * rs), pk2(v[j].z * rs, v[j].w * rs)}; }
        }
    }
}

DI void dump_bf16(Frame& F, const bf16* src, int pitch, int ncols, int c0) {
    float* out = OUTP(F);
    for (size_t i = (size_t)F.bid * 512 + F.tid; i < (size_t)T * ncols; i += (size_t)F.G * 512) { const size_t t = i / ncols; const int c = (int)(i % ncols); out[t * DM + c0 + c] = bf2f(src[t * pitch + c]); }
}
__global__ void __launch_bounds__(512, 2) mk_fwd(Args args) {
    extern __shared__ __attribute__((aligned(16))) unsigned char lds_raw[];
    cg::grid_group grid = cg::this_grid();
    Frame F; F.lds = (LAS unsigned char*)lds_raw; F.tid = threadIdx.x; F.lane = F.tid & 63; F.wave = __builtin_amdgcn_readfirstlane(F.tid >> 6); F.G = gridDim.x; F.bid = (int)__builtin_amdgcn_workgroup_id_x();
    F.kp = (kargp_t)__builtin_amdgcn_kernarg_segment_ptr();
    for (int u = F.tid; u < 64; u += 512) ((LAS unsigned*)(F.lds + MISC_OFF + 4096))[u] = 0u;
    __syncthreads();
    (void)xcd_barrier_post((unsigned*)(WSP(F) + WS_CTL) + CW_BAR, (volatile LAS unsigned*)(F.lds + MISC_OFF + 4096));
    grid.sync();
#define GRID_BAR() do { XcdBarrier bb_; bb_.bar = (unsigned*)(WSP(F) + WS_CTL) + CW_BAR; bb_.x = xb_xcc_id(); bb_.st = (volatile LAS unsigned*)(F.lds + MISC_OFF + 4096); xcd_barrier(bb_); fence_frame(F); } while (0)
#define ws WSP(F)
#if defined(DBG_TMASK)
#define PT0() const unsigned long long pt0_ = __builtin_amdgcn_s_memrealtime()
#define PT1(k) do { if ((DBG_TMASK >> (k)) & 1) { const unsigned long long n_ = __builtin_amdgcn_s_memrealtime(); const unsigned long long e_ = n_ + (unsigned long long)DBG_AMP * (n_ - pt0_); while (__builtin_amdgcn_s_memrealtime() < e_) __builtin_amdgcn_s_sleep(16); } } while (0)
#else
#define PT0() do {} while (0)
#define PT1(k) do {} while (0)
#endif
    { PT0(); prep_mixer_weights(F, 0);
    rms_rows_to_bf16(F, INP(F, 0), (bf16*)(ws + WS_XB));
    GRID_BAR(); PT1(0); }
#if defined(DBG_STOP) && DBG_STOP == 10
    { PT0(); { pg8::Gemm g{(const bf16*)(ws + WS_XB), (const bf16*)(ws + WS_WG), T, 3072, DM}; pg8::StaticOrder S; S.init(T, 3072, F.G, (int)F.bid);
      pg8::EpiGate E{(bf16*)(ws + WS_GATES), 3072};
      pg8::gemm_phase<pg8::EpiGate, pg8::StaticOrder, true, true>(F.lds, g, S, E); }
    GRID_BAR(); PT1(10); }
    dump_bf16(F, (const bf16*)(ws + WS_GATES) + 1024, 3072, 1024, 0); return;
#endif
#pragma unroll 1
    for (int l = 0; l < DEPTH; ++l) {
        { PT0(); { pg8::Gemm g{(const bf16*)(ws + WS_XB), (const bf16*)(ws + WS_WIN), T, l == 0 ? 3840 : 4096, DM}; pg8::StaticOrder S; S.init(T, g.N, F.G, (int)F.bid);
          pg8::EpiZ E{(bf16*)(ws + WS_Q), (bf16*)(ws + WS_K), (bf16*)(ws + WS_V), (bf16*)(ws + WS_POOLZ), (bf16*)(ws + WS_RWKVZ), C2};
          pg8::gemm_phase<pg8::EpiZ, pg8::StaticOrder, true, true>(F.lds, g, S, E); }
        GRID_BAR(); PT1(1); }
        { PT0(); kmean_phase(F);
        vt_phase(F);
        pool_phase(F, l);
        GRID_BAR(); PT1(2); }
        { PT0(); sel_phase(F, l);
        GRID_BAR(); PT1(3); }
        { PT0(); att_phase(F, l);
        GRID_BAR(); PT1(4); }
        { PT0(); comb_phase(F);
        GRID_BAR(); PT1(5); }
#if defined(DBG_STOP) && DBG_STOP == 3
        dump_bf16(F, (const bf16*)(ws + WS_YATTN), 512, 512, 0); dump_bf16(F, (const bf16*)(ws + WS_YPOOL), 512, 512, 512); return;
#endif
        { PT0(); rwkv_prep_phase(F, l);
        GRID_BAR(); PT1(6); }
        { PT0(); rwkv_chunk_phase(F);
        GRID_BAR(); PT1(7); }
        { PT0(); rwkv_state_phase(F);
        GRID_BAR(); PT1(8); }
        { PT0(); rwkv_out_phase(F, l);
        GRID_BAR(); PT1(9); }
        { pg8::Gemm g{(const bf16*)(ws + WS_XB), (const bf16*)(ws + WS_WG), T, 3072, DM}; pg8::StaticOrder S; S.init(T, 3072, F.G, (int)F.bid);
          pg8::EpiGate E{(bf16*)(ws + WS_GATES), 3072};
          pg8::gemm_phase<pg8::EpiGate, pg8::StaticOrder, true, true>(F.lds, g, S, E); }
        GRID_BAR();
#if defined(DBG_SCRUB)
        { const f32x4* xs = (const f32x4*)INP(F, 0) + (size_t)F.bid * 32768; f32x4 a = {0.f, 0.f, 0.f, 0.f};
          for (int i = F.tid; i < 32768; i += 512) a += xs[i];
          if (a.x + a.y + a.z + a.w == 12345.678f) ((float*)(ws + WS_BONUS))[F.tid] = a.x; }
        GRID_BAR();
#endif
        { PT0(); { pg8::StaticOrder S; S.init(T, DM, F.G, (int)F.bid);
          { pg8::Gemm g{(const bf16*)(ws + WS_YATTN), (const bf16*)(ws + WS_WBR), T, DM, 512};
            pg8::EpiMerge<true> E{(bf16*)(ws + WS_XB), DM, (const bf16*)(ws + WS_GATES), 3072, 0};
            pg8::gemm_phase<pg8::EpiMerge<true>, pg8::StaticOrder, true, true>(F.lds, g, S, E); }
          { pg8::Gemm g{(const bf16*)(ws + WS_AR), (const bf16*)(ws + WS_WBR) + (size_t)1024 * 512, T, DM, 512};
            pg8::EpiMerge<false> E{(bf16*)(ws + WS_XB), DM, (const bf16*)(ws + WS_GATES), 3072, 1024};
            pg8::gemm_phase<pg8::EpiMerge<false>, pg8::StaticOrder, true, true>(F.lds, g, S, E); }
          { pg8::Gemm g{(const bf16*)(ws + WS_YPOOL), (const bf16*)(ws + WS_WBR) + (size_t)2 * 1024 * 512, T, DM, 512};
            pg8::EpiMerge<false> E{(bf16*)(ws + WS_XB), DM, (const bf16*)(ws + WS_GATES), 3072, 2048};
            pg8::gemm_phase<pg8::EpiMerge<false>, pg8::StaticOrder, true, true>(F.lds, g, S, E); } }
        GRID_BAR(); PT1(11); }
#if defined(DBG_STOP) && DBG_STOP == 7
        dump_bf16(F, (const bf16*)(ws + WS_XB), 1024, 1024, 0); return;
#endif
#if defined(DBG_STOP) && DBG_STOP == 6
        dump_bf16(F, (const bf16*)(ws + WS_GATES) + 1024, 3072, 1024, 0); return;
#endif
        { PT0(); { pg8::Gemm g{(const bf16*)(ws + WS_XB), (const bf16*)(ws + WS_WOUT), T, DM, DM}; pg8::StaticOrder S; S.init(T, DM, F.G, (int)F.bid);
          pg8::EpiResF32 E{l == 0 ? INP(F, 0) : OUTP(F), OUTP(F), DM};
          pg8::gemm_phase<pg8::EpiResF32, pg8::StaticOrder, true, true>(F.lds, g, S, E); }
        GRID_BAR(); PT1(12); }
#if defined(DBG_STOP) && DBG_STOP == 1
        return;
#endif
        { PT0(); route_phase(F, l);
#if defined(DBG_TMASK)
        GRID_BAR(); PT1(13); } { PT0();
#endif
        prep_expert_weights(F, l);
        GRID_BAR(); PT1(18); }
        { PT0(); permute_phase(F, l);
        GRID_BAR(); PT1(14); }
        { const int ntile = moe_tables(F, l);
          const LAS unsigned char* te = (const LAS unsigned char*)(F.lds + MISC_OFF + 256);
          { PT0(); { pg8::Gemm g{(const bf16*)(ws + WS_XPERM), (const bf16*)(ws + WS_W13), RMAX, NEXP * 1024, DM}; pg8::MoeOrder S{te, ntile * 4, F.G, (int)F.bid};
            pg8::EpiSwiGLU E{(bf16*)(ws + WS_HACT)};
            pg8::gemm_phase<pg8::EpiSwiGLU, pg8::MoeOrder, true, true>(F.lds, g, S, E); }
          GRID_BAR(); PT1(15); }
          { PT0(); { pg8::Gemm g{(const bf16*)(ws + WS_HACT), (const bf16*)(ws + WS_W2), RMAX, NEXP * 1024, 512}; pg8::MoeOrder S{te, ntile * 4, F.G, (int)F.bid};
            pg8::EpiY E{(bf16*)(ws + WS_YMOE)};
            pg8::gemm_phase<pg8::EpiY, pg8::MoeOrder, true, true>(F.lds, g, S, E); }
        GRID_BAR(); PT1(16); } }
        { PT0(); combine_phase(F, l);
        if (l + 1 < DEPTH) prep_mixer_weights(F, l + 1);
        GRID_BAR(); PT1(17); }
#if defined(DBG_STOP) && DBG_STOP == 2
        return;
#endif
    }
#undef ws
}

extern "C" void kernel_launch(void* const* d_in, const int* in_sizes, int n_in, void* d_out, int out_size, void* d_ws, size_t ws_size, hipStream_t stream) {
    static int grid = 0;
    if (grid == 0) {
        if (n_in != 31 || out_size != T * DM || ws_size < WS_END) { fprintf(stderr, "kernel_launch: unexpected shapes (n_in %d out %d ws %zu, need %zu)\n", n_in, out_size, ws_size, (size_t)WS_END); grid = -1; return; }
        int dev = 0, cus = 0, per_cu = 0;
        (void)hipGetDevice(&dev); (void)hipDeviceGetAttribute(&cus, hipDeviceAttributeMultiprocessorCount, dev);
        (void)hipFuncSetAttribute((const void*)mk_fwd, hipFuncAttributeMaxDynamicSharedMemorySize, LDS_BYTES);
        (void)hipOccupancyMaxActiveBlocksPerMultiprocessor(&per_cu, (const void*)mk_fwd, 512, LDS_BYTES);
        (void)hipGetLastError();
        fprintf(stderr, "kernel_launch: cus %d per_cu %d ws %zu\n", cus, per_cu, ws_size);
        grid = cus;
    }
    if (grid < 0) return;
    (void)hipMemsetAsync((char*)d_ws + WS_CTL, 0, CTL_BYTES, stream);
    Args a{};
    for (int i = 0; i < 31; ++i) a.in[i] = (const float*)d_in[i];
    a.out = (float*)d_out; a.ws = (unsigned char*)d_ws;
    void* kargs[] = {&a};
    hipError_t e = hipLaunchCooperativeKernel((const void*)mk_fwd, dim3(grid), dim3(512), kargs, LDS_BYTES, stream);
    if (e != hipSuccess) fprintf(stderr, "cooperative launch failed: %s (grid %d)\n", hipGetErrorString(e), grid);
}
```

```cpp
#include <hip/hip_runtime.h>
#include <hip/hip_cooperative_groups.h>
#include <cstdio>
#include <cstdint>
#include <cmath>
namespace pg8 {
#define PG8_LAS __attribute__((address_space(3)))
typedef unsigned short bf16_t;
typedef short bf16x8 __attribute__((ext_vector_type(8)));
typedef float f32x4 __attribute__((ext_vector_type(4)));
typedef unsigned u32x4 __attribute__((ext_vector_type(4)));
constexpr int BM = 256, BK = 64, HALF = 128, HTB = HALF * BK * 2  , STAGE_BYTES = 8 * HTB, NXCD = 8, WGM = 8;

__host__ __device__ __forceinline__ int lds_byte(int r, int c) { const int st = (r >> 4) * 2 + (c >> 5), rr = r & 15, cc = c & 31, ob = rr * 64 + cc * 2; return st * 1024 + (ob ^ (((ob >> 9) & 1) << 5)); }
__host__ __device__ __forceinline__ void stage_rc(int b, int& R, int& C) { const int st = b / 1024, sb = b % 1024, swz = sb ^ (((sb >> 9) & 1) << 5); R = (st >> 1) * 16 + swz / 64; C = (st & 1) * 32 + (swz % 64) / 2; }
__host__ __device__ __forceinline__ int perm32(int rho) { const int n = rho >> 4, i = rho & 15; return 8 * (i >> 2) + 4 * n + (i & 3); }

struct Unit { int pm, pn; };
struct Gemm { const bf16_t* A; const bf16_t* Bt; int M, N, K; };

struct StaticOrder {
    int nM, nN, nwg, G, c;
    __host__ __device__ void init(int M, int N, int G_, int c_) { nM = M / BM; nN = N / BM; nwg = nM * nN; G = G_; c = c_; }
    __host__ __device__ bool next(int i, Unit& u) const {
        const long L = (long)i * G + c; if (L >= nwg) return false;
        int wgid = (int)L; { const int q = nwg / NXCD, r = nwg % NXCD, xcd = wgid % NXCD, off = wgid / NXCD; wgid = (xcd < r ? xcd * (q + 1) : r * (q + 1) + (xcd - r) * q) + off; }
        const int nig = WGM * nN, gid = wgid / nig, fm = gid * WGM, gsz = (nM - fm) < WGM ? (nM - fm) : WGM;
        u.pm = fm + ((wgid % nig) % gsz); u.pn = (wgid % nig) / gsz; return true;
    }
    __device__ __forceinline__ void a_ready(const Unit&) const {}
    __device__ __forceinline__ void done(const Unit&) const {}
};

typedef float f32x2c_t __attribute__((ext_vector_type(2))); typedef __bf16 bf16x2c_t __attribute__((ext_vector_type(2)));
__device__ __forceinline__ unsigned cvt_pk_bf16(float lo, float hi) { const f32x2c_t v = {lo, hi}; const bf16x2c_t b = __builtin_convertvector(v, bf16x2c_t); return __builtin_bit_cast(unsigned, b); }
typedef float f32x2 __attribute__((ext_vector_type(2)));
__device__ __forceinline__ float fast_sigmoid(float x) { return __builtin_amdgcn_rcpf(1.0f + __builtin_amdgcn_exp2f(-1.4426950408889634f * x)); }
struct EpiZ {
    static constexpr bool PERM = true, AFTER_DRAIN = false;
    bf16_t *q, *k, *v, *poolz, *rwkvz; float qscale;
    __device__ __forceinline__ void operator()(const f32x4 (&acc)[2][2][4][2], const Unit& u, int wr, int wc, int fr, int fq) const {
        const int pn = u.pn; bf16_t* base; int ldc, colt, climit; float sc = 1.f;
        if (pn < 2) { base = q; ldc = 512; colt = pn * 256; climit = 512; sc = qscale; }
        else if (pn < 4) { base = k; ldc = 512; colt = (pn - 2) * 256; climit = 512; }
        else if (pn < 6) { base = v; ldc = 512; colt = (pn - 4) * 256; climit = 512; }
        else if (pn < 8) { base = poolz; ldc = 512; colt = (pn - 6) * 256; climit = 512; }
        else { base = rwkvz; ldc = 1824; colt = (pn - 8) * 256; climit = 1824; }
        const int row0 = u.pm * BM + wr * 64 + fr, col0 = colt + wc * 32 + 8 * fq;
#pragma unroll
        for (int ai = 0; ai < 2; ++ai)
#pragma unroll
            for (int m = 0; m < 4; ++m) { bf16_t* rowp = base + (size_t)(row0 + ai * HALF + m * 16) * ldc + col0;
#pragma unroll
                for (int bj = 0; bj < 2; ++bj) { if (col0 + bj * HALF < climit) { const f32x4 v0 = acc[ai][bj][m][0] * sc, v1 = acc[ai][bj][m][1] * sc;
                    u32x4 w; w.x = cvt_pk_bf16(v0[0], v0[1]); w.y = cvt_pk_bf16(v0[2], v0[3]); w.z = cvt_pk_bf16(v1[0], v1[1]); w.w = cvt_pk_bf16(v1[2], v1[3]);
                    *(u32x4*)(rowp + bj * HALF) = w; } } }
    }
};
typedef unsigned u32x2e __attribute__((ext_vector_type(2)));
struct EpiGate {
    static constexpr bool PERM = true, AFTER_DRAIN = false;
    unsigned char* O; int ldc;
    __device__ __forceinline__ void operator()(const f32x4 (&acc)[2][2][4][2], const Unit& u, int wr, int wc, int fr, int fq) const {
        const int row0 = u.pm * BM + wr * 64 + fr, col0 = u.pn * BM + wc * 32 + 8 * fq;
#pragma unroll
        for (int ai = 0; ai < 2; ++ai)
#pragma unroll
            for (int m = 0; m < 4; ++m) { unsigned char* rowp = O + (size_t)(row0 + ai * HALF + m * 16) * ldc + col0;
#pragma unroll
                for (int bj = 0; bj < 2; ++bj) { const f32x4 v0 = acc[ai][bj][m][0], v1 = acc[ai][bj][m][1]; unsigned q[8];
#pragma unroll
                    for (int e = 0; e < 4; ++e) { q[e] = (unsigned)(fast_sigmoid(v0[e]) * 255.0f + 0.5f); q[4 + e] = (unsigned)(fast_sigmoid(v1[e]) * 255.0f + 0.5f); }
                    *(u32x2e*)(rowp + bj * HALF) = (u32x2e){q[0] | (q[1] << 8) | (q[2] << 16) | (q[3] << 24), q[4] | (q[5] << 8) | (q[6] << 16) | (q[7] << 24)}; } }
    }
};
__device__ __forceinline__ float bflo(unsigned w) { return __uint_as_float(w << 16); }
__device__ __forceinline__ float bfhi(unsigned w) { return __uint_as_float(w & 0xffff0000u); }
template <bool FIRST> struct EpiMerge {
    static constexpr bool PERM = true, AFTER_DRAIN = false;
    bf16_t* O; int ldc; const unsigned char* gate; int ldg, goff;
    __device__ __forceinline__ void operator()(const f32x4 (&acc)[2][2][4][2], const Unit& u, int wr, int wc, int fr, int fq) const {
        const int row0 = u.pm * BM + wr * 64 + fr, col0 = u.pn * BM + wc * 32 + 8 * fq;
#pragma unroll
        for (int ai = 0; ai < 2; ++ai)
#pragma unroll
            for (int m = 0; m < 4; ++m) { const size_t r = (size_t)(row0 + ai * HALF + m * 16); bf16_t* rowp = O + r * ldc + col0; const unsigned char* gp = gate + r * ldg + goff + col0;
#pragma unroll
                for (int bj = 0; bj < 2; ++bj) { const f32x4 v0 = acc[ai][bj][m][0], v1 = acc[ai][bj][m][1];
                    const u32x2e g = *(const u32x2e*)(gp + bj * HALF); const float s = 1.0f / 255.0f;
                    float o[8] = {v0[0] * (float)(g.x & 255u) * s, v0[1] * (float)((g.x >> 8) & 255u) * s, v0[2] * (float)((g.x >> 16) & 255u) * s, v0[3] * (float)(g.x >> 24) * s,
                                  v1[0] * (float)(g.y & 255u) * s, v1[1] * (float)((g.y >> 8) & 255u) * s, v1[2] * (float)((g.y >> 16) & 255u) * s, v1[3] * (float)(g.y >> 24) * s};
                    if (!FIRST) { const u32x4 p = *(const u32x4*)(rowp + bj * HALF);
                        o[0] += bflo(p.x); o[1] += bfhi(p.x); o[2] += bflo(p.y); o[3] += bfhi(p.y); o[4] += bflo(p.z); o[5] += bfhi(p.z); o[6] += bflo(p.w); o[7] += bfhi(p.w); }
                    u32x4 w; w.x = cvt_pk_bf16(o[0], o[1]); w.y = cvt_pk_bf16(o[2], o[3]); w.z = cvt_pk_bf16(o[4], o[5]); w.w = cvt_pk_bf16(o[6], o[7]);
                    *(u32x4*)(rowp + bj * HALF) = w; } }
    }
};
struct EpiResF32 {
    static constexpr bool PERM = false, AFTER_DRAIN = false;
    const float* base; float* out; int ldc;
    __device__ __forceinline__ void operator()(const f32x4 (&acc)[2][2][4][2], const Unit& u, int wr, int wc, int fr, int fq) const {
        const int row0 = u.pm * BM + wr * 64 + fr, col0 = u.pn * BM + wc * 32 + 4 * fq;
#pragma unroll
        for (int ai = 0; ai < 2; ++ai)
#pragma unroll
            for (int m = 0; m < 4; ++m) { const size_t off = (size_t)(row0 + ai * HALF + m * 16) * ldc + col0;
#pragma unroll
                for (int bj = 0; bj < 2; ++bj)
#pragma unroll
                    for (int n = 0; n < 2; ++n) { const f32x4 bs = *(const f32x4*)(base + off + bj * HALF + n * 16); *(f32x4*)(out + off + bj * HALF + n * 16) = bs + acc[ai][bj][m][n]; } }
    }
};
struct EpiSwiGLU {
    static constexpr bool PERM = true, AFTER_DRAIN = false;
    bf16_t* O;
    __device__ __forceinline__ void operator()(const f32x4 (&acc)[2][2][4][2], const Unit& u, int wr, int wc, int fr, int fq) const {
        const int row0 = u.pm * BM + wr * 64 + fr, col0 = (u.pn & 3) * 128 + wc * 32 + 8 * fq;
#pragma unroll
        for (int ai = 0; ai < 2; ++ai)
#pragma unroll
            for (int m = 0; m < 4; ++m) { bf16_t* rowp = O + (size_t)(row0 + ai * HALF + m * 16) * 512 + col0;
                float o[8];
#pragma unroll
                for (int n = 0; n < 2; ++n)
#pragma unroll
                    for (int e = 0; e < 4; ++e) { const float a1 = acc[ai][0][m][n][e], a3 = acc[ai][1][m][n][e]; o[n * 4 + e] = a1 * fast_sigmoid(a1) * a3; }
                u32x4 w; w.x = cvt_pk_bf16(o[0], o[1]); w.y = cvt_pk_bf16(o[2], o[3]); w.z = cvt_pk_bf16(o[4], o[5]); w.w = cvt_pk_bf16(o[6], o[7]);
                *(u32x4*)rowp = w; }
    }
};
struct EpiY {
    static constexpr bool PERM = true, AFTER_DRAIN = false;
    bf16_t* O;
    __device__ __forceinline__ void operator()(const f32x4 (&acc)[2][2][4][2], const Unit& u, int wr, int wc, int fr, int fq) const {
        const int row0 = u.pm * BM + wr * 64 + fr, col0 = (u.pn & 3) * BM + wc * 32 + 8 * fq;
#pragma unroll
        for (int ai = 0; ai < 2; ++ai)
#pragma unroll
            for (int m = 0; m < 4; ++m) { bf16_t* rowp = O + (size_t)(row0 + ai * HALF + m * 16) * 1024 + col0;
#pragma unroll
                for (int bj = 0; bj < 2; ++bj) { const f32x4 v0 = acc[ai][bj][m][0], v1 = acc[ai][bj][m][1];
                    u32x4 w; w.x = cvt_pk_bf16(v0[0], v0[1]); w.y = cvt_pk_bf16(v0[2], v0[3]); w.z = cvt_pk_bf16(v1[0], v1[1]); w.w = cvt_pk_bf16(v1[2], v1[3]);
                    *(u32x4*)(rowp + bj * HALF) = w; } }
    }
};
struct MoeOrder {
    const PG8_LAS unsigned char* tile_e; int nunits, G, c;
    __device__ __forceinline__ bool next(int i, Unit& u) const {
        const int L = i * G + c; if (L >= nunits) return false;
        const int pm = L >> 2; u.pm = pm; u.pn = __builtin_amdgcn_readfirstlane((int)tile_e[pm]) * 4 + (L & 3); return true;
    }
    __device__ __forceinline__ void a_ready(const Unit&) const {}
    __device__ __forceinline__ void done(const Unit&) const {}
};
template <class Epi, class Sched, bool ALIGN_EPI = false, bool SP2 = false>
__device__ __forceinline__ void gemm_phase(PG8_LAS unsigned char* lds, const Gemm g, const Sched& S, const Epi& E) {
    int tid = threadIdx.x; asm volatile("" : "+v"(tid));
    const int wid = __builtin_amdgcn_readfirstlane(tid >> 6), lane = tid & 63, wr = wid >> 2, wc = wid & 3, fr = lane & 15, fq = lane >> 4;
    const int K = g.K, nt = K / BK;
    unsigned voffA[2], voffB[2];
#pragma unroll
    for (int i = 0; i < 2; ++i) { int R, C; stage_rc(tid * 16 + i * 8192, R, C); const int Rb = Epi::PERM ? ((R & ~31) + perm32(R & 31)) : R;
        voffA[i] = (unsigned)(R * K + C) * 2u; voffB[i] = (unsigned)(Rb * K + C) * 2u; }
    const size_t kstep = (size_t)(BK * 2);
    const size_t hstep = (size_t)HALF * K * 2;
    const size_t tstep = 2 * hstep;
    const unsigned ldsw = (unsigned)wid * 1024u;
    const int aoff = lds_byte(wr * 64 + fr, fq * 8), boff = lds_byte(wc * 32 + fr, fq * 8);
#define PG8_SA(b, h) (((b) * 2 + (h)) * HTB)
#define PG8_SB(b, h) ((4 + (b) * 2 + (h)) * HTB)
#define PG8_STAGE(bufoff, gbase, voff) do { _Pragma("unroll") for (int _i = 0; _i < 2; ++_i) \
        __builtin_amdgcn_global_load_lds((const unsigned*)((const char*)(gbase) + (voff)[_i]), (PG8_LAS unsigned*)(lds + (bufoff) + ldsw + _i * 8192), 16, 0, 0); } while (0)
#define PG8_LDA(dst, b, h) do { _Pragma("unroll") for (int m = 0; m < 4; ++m) _Pragma("unroll") for (int k = 0; k < 2; ++k) dst[m][k] = *(const PG8_LAS bf16x8*)(lds + PG8_SA(b, h) + aoff + m * 2048 + k * 1024); } while (0)
#define PG8_LDB(dst, b, h) do { _Pragma("unroll") for (int n = 0; n < 2; ++n) _Pragma("unroll") for (int k = 0; k < 2; ++k) dst[n][k] = *(const PG8_LAS bf16x8*)(lds + PG8_SB(b, h) + boff + n * 2048 + k * 1024); } while (0)
#define PG8_MMA(ai, bj, At, Bt) do { __builtin_amdgcn_s_setprio(1); _Pragma("unroll") for (int m = 0; m < 4; ++m) _Pragma("unroll") for (int n = 0; n < 2; ++n) _Pragma("unroll") for (int k = 0; k < 2; ++k) \
        acc[ai][bj][m][n] = __builtin_amdgcn_mfma_f32_16x16x32_bf16(Bt[n][k], At[m][k], acc[ai][bj][m][n], 0, 0, 0); __builtin_amdgcn_s_setprio(0); } while (0)
#define PG8_WAIT_V(n) asm volatile("s_waitcnt vmcnt(" #n ")" ::: "memory")
#define PG8_WAIT_L(n) asm volatile("s_waitcnt lgkmcnt(" #n ")" ::: "memory")
#define PG8_BAR __builtin_amdgcn_s_barrier()
#define PG8_SCHED __builtin_amdgcn_sched_barrier(0)
    Unit cur, nxt; int ui = 0;
    if (!S.next(0, cur)) return;
    f32x4 acc[2][2][4][2];
#pragma unroll
    for (int a = 0; a < 2; ++a)
#pragma unroll
        for (int b = 0; b < 2; ++b)
#pragma unroll
            for (int m = 0; m < 4; ++m)
#pragma unroll
                for (int n = 0; n < 2; ++n) acc[a][b][m][n] = (f32x4){0.f, 0.f, 0.f, 0.f};
    bf16x8 At[4][2], B0[2][2], B1[2][2];
    const char* cA = (const char*)g.A + (size_t)cur.pm * tstep; const char* cB = (const char*)g.Bt + (size_t)cur.pn * tstep;
    S.a_ready(cur);
    if constexpr (SP2) {
        PG8_STAGE(PG8_SB(0, 0), cB, voffB); PG8_STAGE(PG8_SB(0, 1), cB + hstep, voffB); PG8_STAGE(PG8_SA(0, 0), cA, voffA); PG8_STAGE(PG8_SA(0, 1), cA + hstep, voffA);
        if (wr == 1) PG8_BAR;
        PG8_WAIT_V(2); PG8_BAR;
        PG8_STAGE(PG8_SB(1, 0), cB + kstep, voffB); PG8_STAGE(PG8_SA(1, 0), cA + kstep, voffA); PG8_STAGE(PG8_SB(1, 1), cB + hstep + kstep, voffB);
        PG8_WAIT_V(6); PG8_BAR;
    } else {
        PG8_STAGE(PG8_SB(0, 0), cB, voffB); PG8_STAGE(PG8_SA(0, 0), cA, voffA); PG8_STAGE(PG8_SB(0, 1), cB + hstep, voffB); PG8_STAGE(PG8_SA(0, 1), cA + hstep, voffA);
        if (wr == 1) PG8_BAR;
        PG8_WAIT_V(4); PG8_BAR;
        PG8_STAGE(PG8_SB(1, 0), cB + kstep, voffB); PG8_STAGE(PG8_SA(1, 0), cA + kstep, voffA); PG8_STAGE(PG8_SB(1, 1), cB + hstep + kstep, voffB);
        PG8_WAIT_V(6); PG8_BAR;
    }
    for (;;) {
        const bool has_next = S.next(ui + 1, nxt);
        const char* nA = has_next ? (const char*)g.A + (size_t)nxt.pm * tstep : cA; const char* nB = has_next ? (const char*)g.Bt + (size_t)nxt.pn * tstep : cB;
        for (int t = 0; t < nt; t += 2) {
            const bool last = (t == nt - 2);
            const char* a1 = cA + (size_t)(t + 1) * kstep;
            const char* a2 = last ? nA : cA + (size_t)(t + 2) * kstep; const char* b2 = last ? nB : cB + (size_t)(t + 2) * kstep;
            const char* a3 = a2 + kstep; const char* b3 = b2 + kstep;
            if (last && has_next) S.a_ready(nxt);
            if constexpr (SP2) {
            PG8_LDB(B0, 0, 0); PG8_LDB(B1, 0, 1); PG8_SCHED; PG8_LDA(At, 0, 0); PG8_STAGE(PG8_SA(1, 1), a1 + hstep, voffA);
            PG8_WAIT_V(8); PG8_WAIT_L(0); PG8_BAR; PG8_MMA(0, 0, At, B0); PG8_MMA(0, 1, At, B1); PG8_BAR; PG8_SCHED;
            PG8_LDA(At, 0, 1); PG8_STAGE(PG8_SB(0, 0), b2, voffB); PG8_STAGE(PG8_SB(0, 1), b2 + hstep, voffB); PG8_STAGE(PG8_SA(0, 0), a2, voffA);
            PG8_WAIT_V(8); PG8_WAIT_L(0); PG8_BAR; PG8_MMA(1, 0, At, B0); PG8_MMA(1, 1, At, B1); PG8_BAR; PG8_SCHED;
            PG8_LDB(B0, 1, 0); PG8_LDB(B1, 1, 1); PG8_SCHED; PG8_LDA(At, 1, 0); PG8_STAGE(PG8_SA(0, 1), a2 + hstep, voffA);
            PG8_WAIT_V(8); PG8_WAIT_L(0); PG8_BAR; PG8_MMA(0, 0, At, B0); PG8_MMA(0, 1, At, B1); PG8_BAR; PG8_SCHED;
            PG8_LDA(At, 1, 1); PG8_STAGE(PG8_SB(1, 0), b3, voffB); PG8_STAGE(PG8_SB(1, 1), b3 + hstep, voffB); PG8_STAGE(PG8_SA(1, 0), a3, voffA);
            PG8_WAIT_V(8); PG8_WAIT_L(0); PG8_BAR; PG8_MMA(1, 0, At, B0); PG8_MMA(1, 1, At, B1); PG8_BAR; PG8_SCHED;
            } else {
            PG8_LDB(B0, 0, 0); PG8_SCHED; PG8_LDA(At, 0, 0); PG8_STAGE(PG8_SA(1, 1), a1 + hstep, voffA);
            PG8_WAIT_L(8); PG8_BAR; PG8_WAIT_L(0); PG8_MMA(0, 0, At, B0); PG8_BAR; PG8_SCHED;
            PG8_LDB(B1, 0, 1); PG8_STAGE(PG8_SB(0, 0), b2, voffB);
            PG8_BAR; PG8_WAIT_L(0); PG8_MMA(0, 1, At, B1); PG8_BAR;
            PG8_LDA(At, 0, 1); PG8_STAGE(PG8_SA(0, 0), a2, voffA);
            PG8_BAR; PG8_WAIT_L(0); PG8_MMA(1, 0, At, B0); PG8_BAR; PG8_SCHED;
            PG8_STAGE(PG8_SB(0, 1), b2 + hstep, voffB);
            PG8_WAIT_V(6); PG8_BAR; PG8_MMA(1, 1, At, B1); PG8_BAR;
            PG8_LDB(B0, 1, 0); PG8_SCHED; PG8_LDA(At, 1, 0); PG8_STAGE(PG8_SA(0, 1), a2 + hstep, voffA);
            PG8_WAIT_L(8); PG8_BAR; PG8_WAIT_L(0); PG8_MMA(0, 0, At, B0); PG8_BAR; PG8_SCHED;
            PG8_LDB(B1, 1, 1); PG8_STAGE(PG8_SB(1, 0), b3, voffB);
            PG8_BAR; PG8_WAIT_L(0); PG8_MMA(0, 1, At, B1); PG8_BAR;
            PG8_LDA(At, 1, 1); PG8_STAGE(PG8_SA(1, 0), a3, voffA);
            PG8_BAR; PG8_WAIT_L(0); PG8_MMA(1, 0, At, B0); PG8_BAR; PG8_SCHED;
            PG8_STAGE(PG8_SB(1, 1), b3 + hstep, voffB);
            PG8_WAIT_V(6); PG8_BAR; PG8_MMA(1, 1, At, B1); PG8_BAR;
            }
        }
        if constexpr (ALIGN_EPI) { if (wr == 0) PG8_BAR; }
        if constexpr (!Epi::AFTER_DRAIN) { E(acc, cur, wr, wc, fr, fq); S.done(cur); }
        if (!has_next) break;
#pragma unroll
        for (int a = 0; a < 2; ++a)
#pragma unroll
            for (int b = 0; b < 2; ++b)
#pragma unroll
                for (int m = 0; m < 4; ++m)
#pragma unroll
                    for (int n = 0; n < 2; ++n) acc[a][b][m][n] = (f32x4){0.f, 0.f, 0.f, 0.f};
        cur = nxt; cA = nA; cB = nB; ++ui;
        if constexpr (ALIGN_EPI) { if (wr == 1) PG8_BAR; }
    }
    PG8_WAIT_V(0);
    if constexpr (!ALIGN_EPI) { if (wr == 0) PG8_BAR; }
    PG8_BAR;
    if constexpr (Epi::AFTER_DRAIN) { E.fused(acc, cur, wr, wc, fr, fq, lds, wid, lane); S.done(cur); }
#undef PG8_SA
#undef PG8_SB
#undef PG8_STAGE
#undef PG8_LDA
#undef PG8_LDB
#undef PG8_MMA
#undef PG8_WAIT_V
#undef PG8_WAIT_L
#undef PG8_BAR
#undef PG8_SCHED
}
}
namespace cg = cooperative_groups;
#define DI __device__ __forceinline__
#define LAS __attribute__((address_space(3)))
typedef unsigned short bf16;
typedef float f32x4 __attribute__((ext_vector_type(4)));
typedef unsigned u32x4 __attribute__((ext_vector_type(4)));
typedef unsigned u32x2 __attribute__((ext_vector_type(2)));
typedef short bf16x8_t __attribute__((ext_vector_type(8)));

constexpr int BATCH = 2, SEQ = 16384, DM = 1024, T = BATCH * SEQ, DEPTH = 2;
constexpr int NEXP = 32, RZP = 1824;
constexpr int RMAX = 73728;
constexpr float C2 = 0.125f * 1.4426950408889634f;
constexpr float LOG2E = 1.4426950408889634f;
constexpr size_t MiB = 1u << 20;
constexpr size_t WS_CTL = 0, CTL_BYTES = 1 * MiB;
constexpr size_t WS_WIN = 1 * MiB, WS_WG = 9 * MiB, WS_WBR = 15 * MiB, WS_WOUT = 18 * MiB;
constexpr size_t WS_KMEAN = 20 * MiB, WS_RWG = 20 * MiB + 512 * 1024, WS_ROUTE = 21 * MiB, WS_RWT = 22 * MiB, WS_DEST = 22 * MiB + 512 * 1024, WS_BONUS = 23 * MiB, WS_WLT = 24 * MiB, WS_WPT = 24 * MiB + 512 * 1024, WS_WGBASE = 24 * MiB + 768 * 1024, WS_KINV = 25 * MiB, WS_PGT = 26 * MiB, WS_LG = 28 * MiB, WS_SG = 30 * MiB;
constexpr size_t WS_XB = 32 * MiB, WS_VFIRST = 96 * MiB, WS_YPOOL = 128 * MiB, WS_YATTN = 160 * MiB;
constexpr size_t WS_BIG = 192 * MiB;
constexpr size_t WS_Q = WS_BIG, WS_K = WS_BIG + 32 * MiB, WS_V = WS_BIG + 64 * MiB, WS_POOLZ = WS_BIG + 232 * MiB, WS_RWKVZ = WS_BIG + 264 * MiB;
constexpr size_t WS_AR = WS_BIG;
constexpr size_t WS_GATES = WS_BIG + 32 * MiB;
constexpr size_t WS_XPERM = WS_BIG, WS_HACT = WS_BIG + 144 * MiB, WS_W13 = WS_BIG + 216 * MiB, WS_W2 = WS_BIG + 280 * MiB, WS_YMOE = WS_BIG;
constexpr size_t WS_VT = WS_YATTN;
constexpr size_t WS_PARTO = WS_BIG + 96 * MiB, WS_PARTML = WS_BIG + 224 * MiB;
constexpr size_t WS_LIST = WS_BIG + 378 * MiB;
constexpr size_t WS_PCT = WS_BIG + 224 * MiB, WS_LC = WS_BIG + 256 * MiB, WS_RM = WS_BIG + 288 * MiB, WS_Y0 = WS_BIG + 320 * MiB, WS_S0 = WS_BIG + 352 * MiB;
constexpr int LSTRIDE = 516096;
constexpr size_t WS_END = WS_BIG + 394 * MiB;
static_assert(WS_LIST + (size_t)16 * LSTRIDE * 2 <= WS_END, "ws map");
static_assert(WS_RWKVZ + (size_t)T * RZP * 2 <= WS_END, "ws map");
static_assert(WS_W2 + (size_t)32 * 1024 * 512 * 2 <= WS_END, "ws map");
constexpr int CW_CNT = 64, CW_LCNT = 1024, CW_BAR = 4096;
constexpr int LDS_BYTES = 147456, MISC_OFF = 131072;

DI float bf2f(unsigned short u) { return __uint_as_float((unsigned)u << 16); }
DI unsigned f2bf(float f) { unsigned u = __float_as_uint(f); return (u + 0x7fffu + ((u >> 16) & 1u)) >> 16; }
DI unsigned pk2(float lo, float hi) { return f2bf(lo) | (f2bf(hi) << 16); }
DI float blo(unsigned w) { return __uint_as_float(w << 16); }
DI float bhi(unsigned w) { return __uint_as_float(w & 0xffff0000u); }
DI float wave_sum(float v) {
#pragma unroll
    for (int o = 1; o < 64; o <<= 1) v += __shfl_xor(v, o);
    return v;
}
DI float wave_max(float v) {
#pragma unroll
    for (int o = 1; o < 64; o <<= 1) v = fmaxf(v, __shfl_xor(v, o));
    return v;
}
DI float sigmoidf_(float x) { return 1.0f / (1.0f + __expf(-x)); }
#define LDS_WAIT() asm volatile("s_waitcnt lgkmcnt(0)" ::: "memory")

#define XB_TMO      128
#define XB_XCNT(j)  (256  + 64 * (j))
#define XB_XSUB(j)  (1280 + 64 * (j))
#define XB_XGEN(j)  (2304 + 64 * (j))
#define XB_TOP      3328
#define XB_TOPGEN   3392
#define XCD_BAR_WORDS 3456
#define XB_SPIN_CAP (1u << 27)

__device__ __forceinline__ unsigned xb_ld(unsigned* p)              { return __hip_atomic_load(p, __ATOMIC_RELAXED, __HIP_MEMORY_SCOPE_AGENT); }
__device__ __forceinline__ unsigned xb_add(unsigned* p, unsigned v) { return __hip_atomic_fetch_add(p, v, __ATOMIC_RELAXED, __HIP_MEMORY_SCOPE_AGENT); }
__device__ __forceinline__ unsigned xb_xcc_id() { return (unsigned)__builtin_amdgcn_s_getreg((3 << 11) | 20) & 0xFu; }
#define XB_SPIN(cond, bar) do { unsigned _sp = 0; while (cond) { __builtin_amdgcn_s_sleep(1); \
    if ((++_sp & 255u) == 0u) { if (xb_ld(&(bar)[XB_TMO])) break; if (_sp > XB_SPIN_CAP) { atomicAdd(&(bar)[XB_TMO], 1u); break; } } } } while (0)

struct XcdBarrier {
    unsigned* bar; unsigned x;
    volatile LAS unsigned* st;
};

__device__ __forceinline__ XcdBarrier xcd_barrier_post(unsigned* bar, volatile LAS unsigned* st) {
    XcdBarrier b; b.bar = bar; b.x = xb_xcc_id(); b.st = st;
    if (threadIdx.x == 0) (void)xb_add(&bar[XB_XCNT(b.x)], 1u);
    return b;
}
__device__ __forceinline__ void xcd_barrier_complete(unsigned* bar, unsigned x, unsigned& nloc, unsigned& nx) {
    const unsigned G = gridDim.x * gridDim.y * gridDim.z;
    unsigned sum, cnt, mine, sp = 0u;
    for (;;) {
        sum = 0u; cnt = 0u; mine = 0u;
#pragma unroll
        for (unsigned j = 0; j < 16; ++j) { const unsigned c = xb_ld(&bar[XB_XCNT(j)]); sum += c; cnt += (c > 0u) ? 1u : 0u; mine = (j == x) ? c : mine; }
        if (sum == G) break;
        __builtin_amdgcn_s_sleep(1);
        if ((++sp & 255u) == 0u) { if (xb_ld(&bar[XB_TMO])) break; if (sp > XB_SPIN_CAP) { atomicAdd(&bar[XB_TMO], 1u); break; } }
    }
    nloc = mine > 0u ? mine : 1u; nx = cnt > 0u ? cnt : 1u;
}

__device__ __forceinline__ void xcd_barrier(const XcdBarrier& b) {
    asm volatile("s_waitcnt vmcnt(0)" ::: "memory");
    __syncthreads();
    if (threadIdx.x == 0) {
        unsigned* bar = b.bar;
        __builtin_amdgcn_s_waitcnt(0);
        unsigned nloc = b.st[0], nx = b.st[1];
        if (nloc == 0u) { xcd_barrier_complete(bar, b.x, nloc, nx); b.st[0] = nloc; b.st[1] = nx; }
        const unsigned old = xb_add(&bar[XB_XSUB(b.x)], 1u);
        const unsigned gen = old / nloc;
        if (old + 1u == (gen + 1u) * nloc) {
            __builtin_amdgcn_fence(__ATOMIC_RELEASE, "agent");
            asm volatile("s_waitcnt vmcnt(0)" ::: "memory");
            const unsigned og = xb_add(&bar[XB_TOP], 1u);
            const unsigned tg = og / nx;
            if (og + 1u == (tg + 1u) * nx) xb_add(&bar[XB_TOPGEN], 1u);
            else XB_SPIN(xb_ld(&bar[XB_TOPGEN]) == tg, bar);
            __builtin_amdgcn_fence(__ATOMIC_ACQUIRE, "agent");
            xb_add(&bar[XB_XGEN(b.x)], 1u);
            asm volatile("s_waitcnt vmcnt(0)" ::: "memory");
        } else {
            XB_SPIN(xb_ld(&bar[XB_XGEN(b.x)]) == gen, bar);
            __builtin_amdgcn_fence(__ATOMIC_ACQUIRE, "agent");
            asm volatile("s_waitcnt vmcnt(0)" ::: "memory");
        }
    }
    __syncthreads();
}

struct Args { const float* in[31]; float* out; unsigned char* ws; };

typedef const __attribute__((address_space(4))) unsigned long long* kargp_t;
struct Frame {
    LAS unsigned char* lds; int tid, lane, wave, G, bid;
    kargp_t kp;
};
#define GASQ __attribute__((address_space(1)))
DI const float* INP(const Frame& F, int i) { return (const float*)(const GASQ float*)F.kp[i]; }
DI float* OUTP(const Frame& F) { return (float*)(GASQ float*)F.kp[31]; }
DI unsigned char* WSP(const Frame& F) { return (unsigned char*)(GASQ unsigned char*)F.kp[32]; }
DI void fence_frame(Frame& F) {
    asm volatile("" : "+s"(F.kp) :: "memory"); asm volatile("" : "+s"(F.G)); asm volatile("" : "+s"(F.bid));
    F.tid = threadIdx.x; asm volatile("" : "+v"(F.tid)); F.lane = F.tid & 63; F.wave = __builtin_amdgcn_readfirstlane(F.tid >> 6); }

DI void transpose_item(const float* W, int ldw, int ncols, bf16* WT, int ldt, const float* scale, LAS float* scr, int item, int lane) {
    const int nblk = ncols / 32, kb = item / nblk, nb = item % nblk, k0 = 64 * kb, n0 = 32 * nb;
#pragma unroll
    for (int i = 0; i < 32; ++i) { const int kk = 2 * i + (lane >> 5); float v = W[(size_t)(k0 + kk) * ldw + n0 + (lane & 31)]; if (scale) v *= scale[k0 + kk]; scr[kk * 33 + (lane & 31)] = v; }
    LDS_WAIT(); asm volatile("" ::: "memory");
    const int c = lane & 7;
#pragma unroll
    for (int j = 0; j < 4; ++j) { const int n = (lane >> 3) + 8 * j; const LAS float* s = scr + (8 * c) * 33 + n;
        u32x4 o; o.x = pk2(s[0 * 33], s[1 * 33]); o.y = pk2(s[2 * 33], s[3 * 33]); o.z = pk2(s[4 * 33], s[5 * 33]); o.w = pk2(s[6 * 33], s[7 * 33]);
        *(u32x4*)(WT + (size_t)(n0 + n) * ldt + k0 + 8 * c) = o; }
    LDS_WAIT(); asm volatile("" ::: "memory");
}
DI void prep_mixer_weights(Frame& F, int l) {
    LAS float* scr = (LAS float*)(F.lds + F.wave * 16384);
    const int gw = F.bid * 8 + F.wave, NGW = F.G * 8;
    const float* w_in = INP(F, 2) + (size_t)l * 1024 * 6912; const float* g1 = INP(F, 1) + l * 1024;
    bf16* WIN = (bf16*)(WSP(F) + WS_WIN); bf16* WG = (bf16*)(WSP(F) + WS_WG); bf16* WBR = (bf16*)(WSP(F) + WS_WBR); bf16* WOUT = (bf16*)(WSP(F) + WS_WOUT);
    constexpr int I1 = 16 * (1536 / 32), I2 = 16 * (2304 / 32), I3 = 16 * 1, I4 = 16 * (3072 / 32), I5 = 8 * (1024 / 32), I6 = 16 * (1024 / 32);
    const int n3 = l > 0 ? I3 : 0;
    const int total = I1 + I2 + n3 + I4 + 3 * I5 + I6;
    for (int it = gw; it < total; it += NGW) {
        int r = it;
        if (r < I1) { transpose_item(w_in, 6912, 1536, WIN, 1024, g1, scr, r, F.lane); continue; } r -= I1;
        if (r < I2) { transpose_item(w_in + 4608, 6912, 2304, WIN + (size_t)1536 * 1024, 1024, g1, scr, r, F.lane); continue; } r -= I2;
        if (r < n3) { transpose_item(INP(F, 3) + (size_t)(l - 1) * 1024 * 32, 32, 32, WIN + (size_t)3840 * 1024, 1024, g1, scr, r, F.lane); continue; } r -= n3;
        if (r < I4) { transpose_item(w_in + 1536, 6912, 3072, WG, 1024, g1, scr, r, F.lane); continue; } r -= I4;
        if (r < 3 * I5) { const int i = r / I5; transpose_item(INP(F, 20) + (size_t)(l * 3 + i) * 512 * 1024, 1024, 1024, WBR + (size_t)i * 1024 * 512, 512, i == 2 ? INP(F, 19) + l * 512 : nullptr, scr, r % I5, F.lane); continue; } r -= 3 * I5;
        transpose_item(INP(F, 21) + (size_t)l * 1024 * 1024, 1024, 1024, WOUT, 1024, nullptr, scr, r, F.lane);
    }
    if (l > 0) {
        u32x4* z = (u32x4*)(WIN + (size_t)3872 * 1024); const int n16 = 224 * 1024 * 2 / 16;
        for (int i = F.bid * 512 + F.tid; i < n16; i += F.G * 512) z[i] = (u32x4){0u, 0u, 0u, 0u};
    }
    { bf16* WPT = (bf16*)(WSP(F) + WS_WPT);
      for (int it = gw; it < 32; it += NGW) transpose_item(INP(F, 18) + (size_t)(l * 4 + (it >> 3)) * 128 * 128, 128, 128, WPT + (size_t)(it >> 3) * 128 * 128, 128, nullptr, scr, it & 7, F.lane); }
    { bf16* WLT = (bf16*)(WSP(F) + WS_WLT);
      constexpr int L1 = 1 * 16, L2 = 1 * 16, L3 = 2 * 16;
      for (int it = gw; it < L1 + L2 + L3; it += NGW) {
          if (it < L1) transpose_item(INP(F, 7) + (size_t)l * 64 * 512, 512, 512, WLT, 288, nullptr, scr, it, F.lane);
          else if (it < L1 + L2) transpose_item(INP(F, 9) + (size_t)l * 64 * 512, 512, 512, WLT + 64, 288, nullptr, scr, it - L1, F.lane);
          else transpose_item(INP(F, 10) + (size_t)l * 128 * 512, 512, 512, WLT + 128, 288, nullptr, scr, it - L1 - L2, F.lane); }
      const float* wv = INP(F, 17) + (size_t)(l > 0 ? l - 1 : 0) * 32 * 512;
      for (int i = F.bid * 512 + F.tid; i < 32 * 512; i += F.G * 512) { const int k = i >> 9, ch = i & 511; WLT[(size_t)ch * 288 + 256 + k] = (bf16)f2bf(l > 0 ? wv[k * 512 + ch] : 0.f); } }
    { bf16* RWH = (bf16*)(WSP(F) + WS_RWG); bf16* RWL = RWH + 48 * 1024; const float* g2 = INP(F, 22) + l * 1024; const float* rgw = INP(F, 23) + (size_t)l * 1024 * 4; const float* rew = INP(F, 25) + (size_t)l * 1024 * 32;
      for (int i = F.bid * 512 + F.tid; i < 48 * 1024; i += F.G * 512) { const int r = i >> 10, k = i & 1023;
          const float w = r < 16 ? rgw[k * 4 + (r & 3)] : r < 32 ? rew[k * 32 + 8 * ((r - 16) >> 2) + ((r - 16) & 3)] : rew[k * 32 + 8 * ((r - 32) >> 2) + 4 + ((r - 32) & 3)];
          const float v = g2[k] * w; const unsigned hb = f2bf(v); const float hf = __uint_as_float(hb << 16); RWH[i] = (bf16)hb; RWL[i] = (bf16)f2bf(v - hf); } }
}
DI void prep_expert_weights(Frame& F, int l) {
    LAS float* scr = (LAS float*)(F.lds + F.wave * 16384);
    const int gw = F.bid * 8 + F.wave, NGW = F.G * 8;
    const float* g2 = INP(F, 22) + l * 1024;
    bf16* W13 = (bf16*)(WSP(F) + WS_W13); bf16* W2 = (bf16*)(WSP(F) + WS_W2);
    constexpr int J13 = 64, N13 = NEXP * 2 * 4 * J13, J2 = 8 * 32, N2 = NEXP * J2;
    for (int it = gw; it < N13 + N2; it += NGW) {
        if (it < N13) { const int job = it / J13, item = it % J13, e = job >> 3, which = (job >> 2) & 1, grp = job & 3;
            const float* src = (which ? INP(F, 28) : INP(F, 27)) + ((size_t)(l * NEXP + e) * 1024) * 512 + grp * 128;
            transpose_item(src, 512, 128, W13 + ((size_t)e * 1024 + grp * 256 + which * 128) * 1024, 1024, g2, scr, item, F.lane);
        } else { const int r = it - N13, e = r / J2, item = r % J2;
            transpose_item(INP(F, 29) + (size_t)(l * NEXP + e) * 512 * 1024, 1024, 1024, W2 + (size_t)e * 1024 * 512, 512, nullptr, scr, item, F.lane); }
    }
}
DI void rms_rows_to_bf16(Frame& F, const float* x, bf16* xb) {
    const int gw = F.bid * 8 + F.wave, NGW = F.G * 8;
    for (int t = gw; t < T; t += NGW) {
        const f32x4* xr = (const f32x4*)(x + (size_t)t * DM) + F.lane; f32x4 v[4]; float s = 0.f;
#pragma unroll
        for (int j = 0; j < 4; ++j) { v[j] = xr[64 * j]; s += (v[j].x * v[j].x + v[j].y * v[j].y) + (v[j].z * v[j].z + v[j].w * v[j].w); }
        const float rs = rsqrtf(wave_sum(s) * (1.f / DM) + 1e-6f);
        u32x2* o = (u32x2*)(xb + (size_t)t * DM) + F.lane;
#pragma unroll
        for (int j = 0; j < 4; ++j) o[64 * j] = (u32x2){pk2(v[j].x * rs, v[j].y * rs), pk2(v[j].z * rs, v[j].w * rs)};
    }
}

DI void kmean_phase(Frame& F) {
    const bf16* K = (const bf16*)(WSP(F) + WS_K); float* kmean = (float*)(WSP(F) + WS_KMEAN);
    LAS float* red = (LAS float*)F.lds;
    for (int it = F.bid; it < BATCH * 8 * 64; it += F.G) {
        const int b = it >> 9, h = (it >> 6) & 7, n = it & 63, d = F.lane, part = F.wave;
        const bf16* kp = K + ((size_t)b * SEQ + n * 256 + part * 32) * 512 + h * 64 + d; float s = 0.f;
#pragma unroll
        for (int i = 0; i < 32; ++i) s += bf2f(kp[(size_t)i * 512]);
        red[part * 64 + d] = s;
        __syncthreads();
        if (F.tid < 64) { float a = 0.f;
#pragma unroll
            for (int p = 0; p < 8; ++p) a += red[p * 64 + F.tid];
            kmean[(size_t)it * 64 + F.tid] = a * (1.f / 256.f); }
        __syncthreads();
    }
}
DI void vt_phase(Frame& F) {
    const bf16* V = (const bf16*)(WSP(F) + WS_V); bf16* VT = (bf16*)(WSP(F) + WS_VT);
    LAS bf16* tl = (LAS bf16*)(F.lds + 4096 + F.wave * 9216);
    const int gw = F.bid * 8 + F.wave, NGW = F.G * 8, lane = F.lane;
    for (int it = gw; it < BATCH * 8 * (SEQ / 64); it += NGW) {
        const int bh = it / (SEQ / 64), tt = it % (SEQ / 64), b = bh >> 3, h = bh & 7, t0 = tt * 64;
#pragma unroll
        for (int i = 0; i < 8; ++i) { const int r = i * 8 + (lane >> 3), c = lane & 7;
            const u32x4 w = *(const u32x4*)(V + ((size_t)b * SEQ + t0 + r) * 512 + h * 64 + c * 8); *(LAS u32x4*)(tl + r * 72 + c * 8) = w; }
        LDS_WAIT(); asm volatile("" ::: "memory");
#pragma unroll
        for (int i = 0; i < 8; ++i) { const int d = i * 8 + (lane >> 3), c = lane & 7; unsigned short e[8];
#pragma unroll
            for (int k = 0; k < 8; ++k) e[k] = tl[(8 * c + k) * 72 + d];
            u32x4 w; w.x = e[0] | ((unsigned)e[1] << 16); w.y = e[2] | ((unsigned)e[3] << 16); w.z = e[4] | ((unsigned)e[5] << 16); w.w = e[6] | ((unsigned)e[7] << 16);
            *(u32x4*)(VT + ((size_t)bh * 64 + d) * SEQ + t0 + c * 8) = w; }
        LDS_WAIT(); asm volatile("" ::: "memory");
    }
}
DI int list_off(int n) { return n * SEQ - 128 * n * (n + 1); }
DI void sel_phase(Frame& F, int l) {
    const bf16* Q = (const bf16*)(WSP(F) + WS_Q); const float* kmean = (const float*)(WSP(F) + WS_KMEAN);
    unsigned short* list = (unsigned short*)(WSP(F) + WS_LIST); unsigned* lcnt = (unsigned*)(WSP(F) + WS_CTL) + CW_LCNT + 1024 * l;
    LAS float* km = (LAS float*)F.lds;
    for (int it = F.bid; it < BATCH * 8 * (SEQ / 512); it += F.G) {
        const int bh = it / (SEQ / 512), g = it % (SEQ / 512), b = bh >> 3, h = bh & 7;
        __syncthreads();
        for (int i = F.tid; i < 1024; i += 512) ((LAS f32x4*)km)[i] = ((const f32x4*)(kmean + (size_t)bh * 4096))[i];
        __syncthreads();
        const int tl = g * 512 + F.tid, own = __builtin_amdgcn_readfirstlane(tl >> 8);
        float q[64];
        { const u32x4* qp = (const u32x4*)(Q + ((size_t)b * SEQ + tl) * 512 + h * 64);
#pragma unroll
          for (int c = 0; c < 8; ++c) { const u32x4 w = qp[c]; q[8 * c] = blo(w.x); q[8 * c + 1] = bhi(w.x); q[8 * c + 2] = blo(w.y); q[8 * c + 3] = bhi(w.y); q[8 * c + 4] = blo(w.z); q[8 * c + 5] = bhi(w.z); q[8 * c + 6] = blo(w.w); q[8 * c + 7] = bhi(w.w); } }
        float v0 = -INFINITY, v1 = -INFINITY, v2 = -INFINITY; int i0 = -1, i1 = -1, i2 = -1;
        for (int n = 0; n < own; ++n) { const LAS f32x4* kp = (const LAS f32x4*)(km + n * 64); float s0 = 0.f, s1 = 0.f;
#pragma unroll
            for (int i = 0; i < 16; i += 2) { const f32x4 a = kp[i], c = kp[i + 1];
                s0 += q[4 * i] * a.x + q[4 * i + 1] * a.y + q[4 * i + 2] * a.z + q[4 * i + 3] * a.w; s1 += q[4 * i + 4] * c.x + q[4 * i + 5] * c.y + q[4 * i + 6] * c.z + q[4 * i + 7] * c.w; }
            const float gte = s0 + s1; const bool c0 = gte > v0, c1 = gte > v1, c2 = gte > v2;
            v2 = c1 ? v1 : (c2 ? gte : v2); i2 = c1 ? i1 : (c2 ? n : i2);
            v1 = c0 ? v0 : (c1 ? gte : v1); i1 = c0 ? i0 : (c1 ? n : i1);
            v0 = c0 ? gte : v0; i0 = c0 ? n : i0; }
        LAS unsigned* lc = (LAS unsigned*)(F.lds + MISC_OFF + 8192); LAS unsigned* lbase = lc + 64;
        if (F.tid < 64) lc[F.tid] = 0u;
        __syncthreads();
        unsigned r0 = 0u, r1 = 0u, r2 = 0u;
        if (i0 >= 0) r0 = atomicAdd((unsigned*)(lc + i0), 1u);
        if (i1 >= 0) r1 = atomicAdd((unsigned*)(lc + i1), 1u);
        if (i2 >= 0) r2 = atomicAdd((unsigned*)(lc + i2), 1u);
        __syncthreads();
        if (F.tid < 64) { const unsigned c = lc[F.tid]; lbase[F.tid] = c ? atomicAdd(lcnt + bh * 64 + F.tid, c) : 0u; }
        __syncthreads();
        unsigned short* lb = list + (size_t)bh * LSTRIDE;
        if (i0 >= 0) lb[list_off(i0) + lbase[i0] + r0] = (unsigned short)(tl | (0 << 14));
        if (i1 >= 0) lb[list_off(i1) + lbase[i1] + r1] = (unsigned short)(tl | (1 << 14));
        if (i2 >= 0) lb[list_off(i2) + lbase[i2] + r2] = (unsigned short)(tl | (2 << 14));
    }
    __syncthreads();
}
DI void att_phase(Frame& F, int l) {
    const bf16* Q = (const bf16*)(WSP(F) + WS_Q); const bf16* K = (const bf16*)(WSP(F) + WS_K); const bf16* VT = (const bf16*)(WSP(F) + WS_VT);
    const unsigned short* list = (const unsigned short*)(WSP(F) + WS_LIST); const unsigned* lcnt = (const unsigned*)(WSP(F) + WS_CTL) + CW_LCNT + 1024 * l;
    bf16* PO = (bf16*)(WSP(F) + WS_PARTO); float* PML = (float*)(WSP(F) + WS_PARTML);
    LAS unsigned char* Kl = F.lds;
    LAS unsigned char* Vl = F.lds + 36864;
    LAS int* pre = (LAS int*)(F.lds + MISC_OFF + 8192);
    LAS int* cl = (LAS int*)(F.lds + MISC_OFF + 12288); LAS int* ws8 = (LAS int*)(F.lds + MISC_OFF + 4352);
    const int lane = F.lane, wave = F.wave, qi = lane & 15, quad = lane >> 4;
    __syncthreads();
    { const int c0 = (int)__hip_atomic_load(lcnt + 2 * F.tid, __ATOMIC_RELAXED, __HIP_MEMORY_SCOPE_AGENT), c1 = (int)__hip_atomic_load(lcnt + 2 * F.tid + 1, __ATOMIC_RELAXED, __HIP_MEMORY_SCOPE_AGENT);
      cl[2 * F.tid] = c0; cl[2 * F.tid + 1] = c1; const int t0 = (c0 + 127) >> 7, t1 = (c1 + 127) >> 7; int inc = t0 + t1;
#pragma unroll
      for (int o = 1; o < 64; o <<= 1) { const int u = __shfl_up(inc, o); if (lane >= o) inc += u; }
      if (lane == 63) ws8[wave] = inc;
      __syncthreads();
      int off = 0;
#pragma unroll
      for (int w = 0; w < 8; ++w) { const int x = ws8[w]; if (w < wave) off += x; }
      const int ex = off + inc - (t0 + t1); pre[2 * F.tid] = ex; pre[2 * F.tid + 1] = ex + t0;
      __syncthreads();
      if (F.tid == 511) ws8[8] = off + inc; }
    __syncthreads();
    const int NL = __builtin_amdgcn_readfirstlane(ws8[8]), total = NL + BATCH * 8 * 64 * 2, per = (total + F.G - 1) / F.G;
    const int it0 = F.bid * per, it1 = (it0 + per < total) ? it0 + per : total;
    int cur = 0, loaded = -1;
    if (it0 < NL) { int lo = 0, hi = 1023;
        while (lo < hi) { const int mid = (lo + hi + 1) >> 1; if (pre[mid] <= it0) lo = mid; else hi = mid - 1; }
        cur = lo; }
    struct QA { int i, tile, own_item; bool valid; unsigned short ent; };
    struct QB { int i, own_item, tl, j; bool valid; bf16x8_t qf[2]; };
#define DEC_A(itx, R) do { int i_, tile_, own_; \
        if ((itx) < NL) { while (cur < 1023 && pre[cur + 1] <= (itx)) ++cur; i_ = cur; tile_ = (itx) - pre[cur]; own_ = 0; } \
        else { const int o_ = (itx) - NL; i_ = o_ >> 1; tile_ = o_ & 1; own_ = 1; } \
        i_ = __builtin_amdgcn_readfirstlane(i_); tile_ = __builtin_amdgcn_readfirstlane(tile_); \
        R.i = i_; R.tile = tile_; R.own_item = own_; R.ent = 0; R.valid = true; \
        if (!own_) { const int e_ = tile_ * 128 + wave * 16 + qi; R.valid = e_ < cl[i_]; if (R.valid) R.ent = list[(size_t)(i_ >> 6) * LSTRIDE + list_off(i_ & 63) + e_]; } } while (0)
#define DEC_B(A, R) do { const int bh_ = A.i >> 6, n_ = A.i & 63; R.i = A.i; R.own_item = A.own_item; R.valid = A.valid; \
        if (A.own_item) { R.tl = n_ * 256 + A.tile * 128 + wave * 16 + qi; R.j = 3; } else { R.tl = A.ent & 0x3fff; R.j = A.ent >> 14; } \
        { const size_t t_ = (size_t)(bh_ >> 3) * SEQ + R.tl; \
          R.qf[0] = *(const bf16x8_t*)(Q + t_ * 512 + (bh_ & 7) * 64 + quad * 8); R.qf[1] = *(const bf16x8_t*)(Q + t_ * 512 + (bh_ & 7) * 64 + 32 + quad * 8); } } while (0)
    QA na; na.i = 0; na.tile = 0; na.own_item = 1; na.valid = false; na.ent = 0;
    QB nx; nx.i = -1; nx.own_item = 0; nx.tl = 0; nx.j = 0; nx.valid = false; nx.qf[0] = (bf16x8_t){0, 0, 0, 0, 0, 0, 0, 0}; nx.qf[1] = nx.qf[0];
    if (it0 < it1) { DEC_A(it0, na); DEC_B(na, nx); if (it0 + 1 < it1) DEC_A(it0 + 1, na); }
    for (int it = it0; it < it1; ++it) {
        const int i = nx.i, own_item = nx.own_item, tl = nx.tl, j = nx.j; const bool valid = nx.valid; bf16x8_t qf[2] = {nx.qf[0], nx.qf[1]};
        const int bh = i >> 6, n = i & 63, b = bh >> 3, h = bh & 7;
        if (i != loaded) {
            __syncthreads();
#pragma unroll
            for (int r = 0; r < 4; ++r) { const int c = F.tid + r * 512, row = c >> 3, ch = c & 7;
                const u32x4 w = *(const u32x4*)(K + ((size_t)b * SEQ + n * 256 + row) * 512 + h * 64 + ch * 8); *(LAS u32x4*)(Kl + row * 144 + ch * 16) = w; }
#pragma unroll
            for (int r = 0; r < 4; ++r) { const int c = F.tid + r * 512, row = c >> 5, ch = c & 31;
                const u32x4 w = *(const u32x4*)(VT + ((size_t)bh * 64 + row) * SEQ + n * 256 + ch * 8); *(LAS u32x4*)(Vl + row * 528 + ch * 16) = w; }
            __syncthreads();
            loaded = i;
        }
        if (it + 1 < it1) { DEC_B(na, nx); if (it + 2 < it1) DEC_A(it + 2, na); }
        const size_t t = (size_t)b * SEQ + tl;
        const float slope2 = __builtin_amdgcn_exp2f(-(float)(h + 1)) * LOG2E;
        f32x4 sc[16];
#pragma unroll
        for (int kt = 0; kt < 16; ++kt) { f32x4 a = {0.f, 0.f, 0.f, 0.f};
#pragma unroll
            for (int ks = 0; ks < 2; ++ks) { const bf16x8_t kf = *(const LAS bf16x8_t*)(Kl + (kt * 16 + qi) * 144 + ks * 64 + quad * 16); a = __builtin_amdgcn_mfma_f32_16x16x32_bf16(kf, qf[ks], a, 0, 0, 0); }
            sc[kt] = a; if ((kt & 3) == 3) asm volatile("" ::: "memory"); }
        const int tloc = tl - n * 256;
        float mx = -INFINITY; const float sbase = slope2 * (float)(quad * 4); const int tq4 = tloc - quad * 4;
#pragma unroll
        for (int kt = 0; kt < 16; ++kt)
#pragma unroll
            for (int e = 0; e < 4; ++e) { float s = fmaf(slope2, (float)(kt * 16 + e), sc[kt][e] + sbase); if (own_item && (kt * 16 + e) > tq4) s = -INFINITY; sc[kt][e] = s; mx = fmaxf(mx, s); }
        mx = fmaxf(mx, __shfl_xor(mx, 16)); mx = fmaxf(mx, __shfl_xor(mx, 32));
        float ls = 0.f;
#pragma unroll
        for (int kt = 0; kt < 16; ++kt)
#pragma unroll
            for (int e = 0; e < 4; ++e) { const float p = __builtin_amdgcn_exp2f(sc[kt][e] - mx); sc[kt][e] = p; ls += p; }
        ls += __shfl_xor(ls, 16); ls += __shfl_xor(ls, 32);
        f32x4 o[4];
#pragma unroll
        for (int dt = 0; dt < 4; ++dt) o[dt] = (f32x4){0.f, 0.f, 0.f, 0.f};
#pragma unroll
        for (int k2 = 0; k2 < 8; ++k2) {
            u32x4 pw; pw.x = pg8::cvt_pk_bf16(sc[2 * k2][0], sc[2 * k2][1]); pw.y = pg8::cvt_pk_bf16(sc[2 * k2][2], sc[2 * k2][3]);
            pw.z = pg8::cvt_pk_bf16(sc[2 * k2 + 1][0], sc[2 * k2 + 1][1]); pw.w = pg8::cvt_pk_bf16(sc[2 * k2 + 1][2], sc[2 * k2 + 1][3]);
            const bf16x8_t pf = __builtin_bit_cast(bf16x8_t, pw);
#pragma unroll
            for (int dt = 0; dt < 4; ++dt) { const LAS unsigned char* vp = Vl + (dt * 16 + qi) * 528 + (k2 * 32 + quad * 4) * 2;
                const u32x2 lo = *(const LAS u32x2*)vp, hi = *(const LAS u32x2*)(vp + 32);
                const u32x4 vw = {lo.x, lo.y, hi.x, hi.y};
                o[dt] = __builtin_amdgcn_mfma_f32_16x16x32_bf16(__builtin_bit_cast(bf16x8_t, vw), pf, o[dt], 0, 0, 0); }
            if (k2 & 1) asm volatile("" ::: "memory"); }
        if (valid) { const float inv = 1.0f / ls; const size_t pidx = (t * 8 + h) * 4 + j; bf16* op = PO + pidx * 64 + quad * 4;
#pragma unroll
            for (int dt = 0; dt < 4; ++dt) *(u32x2*)(op + dt * 16) = (u32x2){pg8::cvt_pk_bf16(o[dt][0] * inv, o[dt][1] * inv), pg8::cvt_pk_bf16(o[dt][2] * inv, o[dt][3] * inv)};
            if (quad == 0) ((float2*)PML)[pidx] = make_float2(mx - slope2 * (float)tloc, ls); }
    }
#undef DEC_A
#undef DEC_B
    __syncthreads();
}
DI void comb_phase(Frame& F) {
    const bf16* PO = (const bf16*)(WSP(F) + WS_PARTO); const float* PML = (const float*)(WSP(F) + WS_PARTML); bf16* Y = (bf16*)(WSP(F) + WS_YATTN);
    const int gw = F.bid * 8 + F.wave, NGW = F.G * 8, lane = F.lane, h = lane >> 3, dc = lane & 7;
    for (int t = gw; t < T; t += NGW) {
        const int own = (t % SEQ) >> 8, nsel = own < 3 ? own : 3; const size_t pb = ((size_t)t * 8 + h) * 4;
        float m[4], lw[4]; float M = -INFINITY;
#pragma unroll
        for (int j = 0; j < 4; ++j) { const bool ok = (j == 3) || (j < nsel); const float2 ml = ok ? ((const float2*)PML)[pb + j] : make_float2(-INFINITY, 0.f); m[j] = ml.x; lw[j] = ml.y; M = fmaxf(M, ml.x); }
        float acc[8] = {0.f, 0.f, 0.f, 0.f, 0.f, 0.f, 0.f, 0.f}; float wsum = 0.f;
#pragma unroll
        for (int j = 0; j < 4; ++j) { const bool ok = (j == 3) || (j < nsel); if (!ok) continue;
            const float w = __builtin_amdgcn_exp2f(m[j] - M) * lw[j]; wsum += w; const u32x4 ow = *(const u32x4*)(PO + (pb + j) * 64 + dc * 8);
            acc[0] += w * blo(ow.x); acc[1] += w * bhi(ow.x); acc[2] += w * blo(ow.y); acc[3] += w * bhi(ow.y); acc[4] += w * blo(ow.z); acc[5] += w * bhi(ow.z); acc[6] += w * blo(ow.w); acc[7] += w * bhi(ow.w); }
        const float inv = 1.0f / wsum;
        *(u32x4*)(Y + (size_t)t * 512 + h * 64 + dc * 8) = (u32x4){pk2(acc[0] * inv, acc[1] * inv), pk2(acc[2] * inv, acc[3] * inv), pk2(acc[4] * inv, acc[5] * inv), pk2(acc[6] * inv, acc[7] * inv)};
    }
}
DI void pool_phase(Frame& F, int l) {
    const bf16* Z = (const bf16*)(WSP(F) + WS_POOLZ); bf16* Y = (bf16*)(WSP(F) + WS_YPOOL); const bf16* WPT = (const bf16*)(WSP(F) + WS_WPT);
    LAS unsigned char* Pl = F.lds;
    const int lane = F.lane, li = lane & 15, quad = lane >> 4, g = F.wave >> 1, dt0 = (F.wave & 1) * 4;
    bf16x8_t wf[4][4];
#pragma unroll
    for (int dt = 0; dt < 4; ++dt)
#pragma unroll
        for (int ks = 0; ks < 4; ++ks) wf[dt][ks] = *(const bf16x8_t*)(WPT + ((size_t)g * 128 + 16 * (dt0 + dt) + li) * 128 + 32 * ks + 8 * quad);
    for (int tile = F.bid; tile < T / 64; tile += F.G) {
        __syncthreads();
#pragma unroll 1
        for (int i = F.tid; i < 64 * 64; i += 512) { const int tt = i >> 6, ch = i & 63, gg = ch >> 4, win = 2 << gg, t = tile * 64 + tt, tl = t % SEQ; const int cnt = (tl + 1 < win) ? tl + 1 : win;
            u32x4 w[16];
#pragma unroll
            for (int j = 0; j < 16; ++j) { w[j] = (u32x4){0u, 0u, 0u, 0u}; if (j < cnt) w[j] = *(const u32x4*)(Z + (size_t)(t - j) * 512 + ch * 8); }
            float s[8] = {0.f, 0.f, 0.f, 0.f, 0.f, 0.f, 0.f, 0.f};
#pragma unroll
            for (int j = 0; j < 16; ++j) { s[0] += blo(w[j].x); s[1] += bhi(w[j].x); s[2] += blo(w[j].y); s[3] += bhi(w[j].y); s[4] += blo(w[j].z); s[5] += bhi(w[j].z); s[6] += blo(w[j].w); s[7] += bhi(w[j].w); }
            const float inv = 1.0f / (float)cnt;
            *(LAS u32x4*)(Pl + tt * 1040 + ch * 16) = (u32x4){pk2(s[0] * inv - blo(w[0].x), s[1] * inv - bhi(w[0].x)), pk2(s[2] * inv - blo(w[0].y), s[3] * inv - bhi(w[0].y)),
                                                                 pk2(s[4] * inv - blo(w[0].z), s[5] * inv - bhi(w[0].z)), pk2(s[6] * inv - blo(w[0].w), s[7] * inv - bhi(w[0].w))}; }
        __syncthreads();
#pragma unroll
        for (int tt = 0; tt < 4; ++tt) {
            bf16x8_t pf[4];
#pragma unroll
            for (int ks = 0; ks < 4; ++ks) pf[ks] = *(const LAS bf16x8_t*)(Pl + (16 * tt + li) * 1040 + (g * 128 + 32 * ks + 8 * quad) * 2);
#pragma unroll
            for (int dt = 0; dt < 4; ++dt) { f32x4 acc = {0.f, 0.f, 0.f, 0.f};
#pragma unroll
                for (int ks = 0; ks < 4; ++ks) acc = __builtin_amdgcn_mfma_f32_16x16x32_bf16(wf[dt][ks], pf[ks], acc, 0, 0, 0);
                *(u32x2*)(Y + (size_t)(tile * 64 + 16 * tt + li) * 512 + g * 128 + 16 * (dt0 + dt) + 4 * quad) = (u32x2){pk2(acc[0], acc[1]), pk2(acc[2], acc[3])}; } }
    }
    __syncthreads();
}
DI void rwkv_prep_phase(Frame& F, int l) {
    const bf16* RZ = (const bf16*)(WSP(F) + WS_RWKVZ); bf16* VF = (bf16*)(WSP(F) + WS_VFIRST);
    bf16* AR = (bf16*)(WSP(F) + WS_AR); const size_t AS = (size_t)T * 512;
    float* bonus = (float*)(WSP(F) + WS_BONUS); float* kinv = (float*)(WSP(F) + WS_KINV); const bf16* WLT = (const bf16*)(WSP(F) + WS_WLT);
    LAS unsigned char* Al = F.lds;
    const int h = F.wave;
    const float* mu = INP(F, 4) + l * 1792; const float* vmu = INP(F, 5) + (l > 0 ? (l - 1) * 32 : 0);
    const float* w0p = INP(F, 6) + l * 512 + h * 64; const float* a0p = INP(F, 8) + l * 512 + h * 64; const float* kkp = INP(F, 11) + l * 512 + h * 64;
    const float* kap = INP(F, 12) + l * 512 + h * 64; const float* rkp = INP(F, 13) + l * 512 + h * 64; const float* v0p = INP(F, 16) + (l > 0 ? l - 1 : 0) * 512 + h * 64;
    for (int item = F.bid; item < T / 64; item += F.G) {
        int tid = F.tid; asm volatile("" : "+v"(tid));
        const int lane = tid & 63, li = lane & 15, quad = lane >> 4;
        const int t0 = item * 64, tl0 = t0 % SEQ;
        __syncthreads();
        { const int tok = tid >> 3, c0 = tid & 7; const size_t t = (size_t)(t0 + tok); const bool first = (tl0 + tok == 0);
          u32x4 zc[5], zp[5]; f32x4 m0[5], m1[5];
#pragma unroll
          for (int r = 0; r < 5; ++r) { const int c = c0 + 8 * r; zc[r] = (u32x4){0u, 0u, 0u, 0u}; zp[r] = zc[r]; m0[r] = (f32x4){0.f, 0.f, 0.f, 0.f}; m1[r] = m0[r];
              if (c < 32 || (l > 0 && c < 36)) { const int col = 1536 + 8 * c; zc[r] = *(const u32x4*)(RZ + t * RZP + col); if (!first) zp[r] = *(const u32x4*)(RZ + (t - 1) * RZP + col);
                  const float* mp = col < 1792 ? mu + col : vmu + (col - 1792); m0[r] = *(const f32x4*)mp; m1[r] = *(const f32x4*)(mp + 4); } }
#pragma unroll
          for (int r = 0; r < 5; ++r) { const int c = c0 + 8 * r; if (c < 36) {
              const float cv[8] = {blo(zc[r].x), bhi(zc[r].x), blo(zc[r].y), bhi(zc[r].y), blo(zc[r].z), bhi(zc[r].z), blo(zc[r].w), bhi(zc[r].w)}, pv[8] = {blo(zp[r].x), bhi(zp[r].x), blo(zp[r].y), bhi(zp[r].y), blo(zp[r].z), bhi(zp[r].z), blo(zp[r].w), bhi(zp[r].w)};
              const float mm[8] = {m0[r].x, m0[r].y, m0[r].z, m0[r].w, m1[r].x, m1[r].y, m1[r].z, m1[r].w}; float f[8];
#pragma unroll
              for (int e = 0; e < 8; ++e) { const float zs = cv[e] + (pv[e] - cv[e]) * mm[e]; f[e] = r == 0 ? tanhf(zs) : (r == 2 || r == 3) ? sigmoidf_(zs) : zs; }
              *(LAS u32x4*)(Al + tok * 592 + c * 16) = (u32x4){pk2(f[0], f[1]), pk2(f[2], f[3]), pk2(f[4], f[5]), pk2(f[6], f[7])}; } } }
        __syncthreads();
        float ssq[4] = {0.f, 0.f, 0.f, 0.f}, bsm[4] = {0.f, 0.f, 0.f, 0.f};
#pragma unroll 1
        for (int ct = 0; ct < 4; ++ct) {
            const int cb = 16 * ct + 4 * quad;
            bf16x8_t wf[9];
#pragma unroll
            for (int ks = 0; ks < 9; ++ks) wf[ks] = *(const bf16x8_t*)(WLT + (size_t)(h * 64 + 16 * ct + li) * 288 + 32 * ks + 8 * quad);
            const f32x4 mr = *(const f32x4*)(mu + h * 64 + cb), mk = *(const f32x4*)(mu + 512 + h * 64 + cb), mv = *(const f32x4*)(mu + 1024 + h * 64 + cb);
            const f32x4 w0 = *(const f32x4*)(w0p + cb), a0 = *(const f32x4*)(a0p + cb), kkc = *(const f32x4*)(kkp + cb), kac = *(const f32x4*)(kap + cb), rkc = *(const f32x4*)(rkp + cb);
            f32x4 v0 = {0.f, 0.f, 0.f, 0.f}; if (l > 0) v0 = *(const f32x4*)(v0p + cb);
            u32x2 zr[4][2], zk[4][2], zv[4][2], vfw[4];
#pragma unroll
            for (int rt = 0; rt < 4; ++rt) { const int tok = 16 * rt + li; const size_t zi = (size_t)(t0 + tok) * RZP + h * 64 + cb; const bool first = (tl0 + tok == 0);
                zr[rt][0] = *(const u32x2*)(RZ + zi); zk[rt][0] = *(const u32x2*)(RZ + zi + 512); zv[rt][0] = *(const u32x2*)(RZ + zi + 1024);
                zr[rt][1] = (u32x2){0u, 0u}; zk[rt][1] = zr[rt][1]; zv[rt][1] = zr[rt][1]; vfw[rt] = zr[rt][1];
                if (!first) { zr[rt][1] = *(const u32x2*)(RZ + zi - RZP); zk[rt][1] = *(const u32x2*)(RZ + zi - RZP + 512); zv[rt][1] = *(const u32x2*)(RZ + zi - RZP + 1024); }
                if (l > 0) vfw[rt] = *(const u32x2*)(VF + (size_t)(t0 + tok) * 512 + h * 64 + cb); }
#pragma unroll
            for (int rt = 0; rt < 4; ++rt) { const int tok = 16 * rt + li; const size_t idx = (size_t)(t0 + tok) * 512 + h * 64 + cb;
                f32x4 aw = {0.f, 0.f, 0.f, 0.f}, aa = aw, ag = aw, av = aw;
#pragma unroll
                for (int ks = 0; ks < 9; ++ks) { if (ks == 8 && l == 0) break;
                    const bf16x8_t bfr = *(const LAS bf16x8_t*)(Al + tok * 592 + ks * 64 + quad * 16);
                    if (ks < 2) aw = __builtin_amdgcn_mfma_f32_16x16x32_bf16(wf[ks], bfr, aw, 0, 0, 0);
                    else if (ks < 4) aa = __builtin_amdgcn_mfma_f32_16x16x32_bf16(wf[ks], bfr, aa, 0, 0, 0);
                    else if (ks < 8) ag = __builtin_amdgcn_mfma_f32_16x16x32_bf16(wf[ks], bfr, ag, 0, 0, 0);
                    else av = __builtin_amdgcn_mfma_f32_16x16x32_bf16(wf[ks], bfr, av, 0, 0, 0); }
                const float crf[4] = {blo(zr[rt][0].x), bhi(zr[rt][0].x), blo(zr[rt][0].y), bhi(zr[rt][0].y)}, prf[4] = {blo(zr[rt][1].x), bhi(zr[rt][1].x), blo(zr[rt][1].y), bhi(zr[rt][1].y)};
                const float ckf[4] = {blo(zk[rt][0].x), bhi(zk[rt][0].x), blo(zk[rt][0].y), bhi(zk[rt][0].y)}, pkf[4] = {blo(zk[rt][1].x), bhi(zk[rt][1].x), blo(zk[rt][1].y), bhi(zk[rt][1].y)};
                const float cvf[4] = {blo(zv[rt][0].x), bhi(zv[rt][0].x), blo(zv[rt][0].y), bhi(zv[rt][0].y)}, pvf[4] = {blo(zv[rt][1].x), bhi(zv[rt][1].x), blo(zv[rt][1].y), bhi(zv[rt][1].y)};
                const float vff[4] = {blo(vfw[rt].x), bhi(vfw[rt].x), blo(vfw[rt].y), bhi(vfw[rt].y)};
                float ro[4], lwo[4], kpo[4], vo[4], kro[4], bbo[4];
#pragma unroll
                for (int e = 0; e < 4; ++e) { const float r = crf[e] + (prf[e] - crf[e]) * mr[e], k = ckf[e] + (pkf[e] - ckf[e]) * mk[e]; float v = cvf[e] + (pvf[e] - cvf[e]) * mv[e];
                    const float xw = -(w0[e] + aw[e]); const float sp = xw > 20.f ? xw : log1pf(__expf(xw)); lwo[e] = -__expf(-sp - 0.5f);
                    const float asig = sigmoidf_(a0[e] + aa[e]);
                    if (l > 0) v = v + (vff[e] - v) * sigmoidf_(v0[e] + av[e]);
                    vo[e] = v; ro[e] = r; const float kr = k * kkc[e]; kro[e] = kr; bbo[e] = kr * asig; ssq[rt] += kr * kr;
                    const float kpe = k * (1.0f + (asig - 1.0f) * kac[e]); kpo[e] = kpe; bsm[rt] += r * kpe * rkc[e]; }
                if (l == 0) *(u32x2*)(VF + idx) = (u32x2){pk2(vo[0], vo[1]), pk2(vo[2], vo[3])};
                *(u32x2*)(AR + idx) = (u32x2){pk2(ro[0], ro[1]), pk2(ro[2], ro[3])};
                *(u32x2*)(AR + AS + idx) = (u32x2){pk2(lwo[0], lwo[1]), pk2(lwo[2], lwo[3])};
                *(u32x2*)(AR + 2 * AS + idx) = (u32x2){pk2(kpo[0], kpo[1]), pk2(kpo[2], kpo[3])};
                *(u32x2*)(AR + 3 * AS + idx) = (u32x2){pk2(vo[0], vo[1]), pk2(vo[2], vo[3])};
                *(u32x2*)(AR + 4 * AS + idx) = (u32x2){pk2(kro[0], kro[1]), pk2(kro[2], kro[3])};
                *(u32x2*)(AR + 5 * AS + idx) = (u32x2){pk2(bbo[0], bbo[1]), pk2(bbo[2], bbo[3])};
                *(u32x2*)(AR + 6 * AS + idx) = (u32x2){pk2(ag[0], ag[1]), pk2(ag[2], ag[3])}; asm volatile("" ::: "memory"); }
        }
#pragma unroll
        for (int rt = 0; rt < 4; ++rt) { float ss = ssq[rt], bs = bsm[rt]; ss += __shfl_xor(ss, 16); ss += __shfl_xor(ss, 32); bs += __shfl_xor(bs, 16); bs += __shfl_xor(bs, 32);
            if (quad == 0) { const size_t t = (size_t)(t0 + 16 * rt + li); bonus[t * 8 + h] = bs; kinv[t * 8 + h] = 1.0f / fmaxf(sqrtf(ss), 1e-12f); } }
    }
    __syncthreads();
}
typedef short bf16x4_t __attribute__((ext_vector_type(4)));
DI void rwkv_chunk_phase(Frame& F) {
    const bf16* AR = (const bf16*)(WSP(F) + WS_AR); const size_t AS = (size_t)T * 512;
    bf16* PCT = (bf16*)(WSP(F) + WS_PCT); bf16* LC = (bf16*)(WSP(F) + WS_LC); bf16* RM = (bf16*)(WSP(F) + WS_RM); bf16* Y0 = (bf16*)(WSP(F) + WS_Y0);
    constexpr int ST = 144;
    LAS unsigned char* L = F.lds;
    LAS unsigned char* AT = L; LAS unsigned char* BT = L + 9216; LAS unsigned char* KT = L + 18432; LAS unsigned char* RT = L + 27648;
    LAS unsigned char* BTT = L + 36864; LAS unsigned char* KTT = L + 46080; LAS unsigned char* VTl = L + 55296; LAS unsigned char* NB = L + 64512; LAS unsigned char* MB = L + 73728;
    LAS unsigned char* WMT = L + 82944; LAS unsigned char* UMT = L + 92160;
    LAS float* LGF = (LAS float*)(L + 101376); LAS float* ND = (LAS float*)(L + 117760); LAS unsigned char* DB = L + 122112; LAS float* GC = (LAS float*)(L + 125184); LAS float* PART = (LAS float*)(L + 125440);
    const int wave = F.wave;
#define MF32(a, b, c) __builtin_amdgcn_mfma_f32_16x16x32_bf16((a), (b), (c), 0, 0, 0)
#define MF16(a, b, c) __builtin_amdgcn_mfma_f32_16x16x16bf16_1k((a), (b), (c), 0, 0, 0)
#define RD8(p) (*(const LAS bf16x8_t*)(p))
#define RD4(p) (*(const LAS bf16x4_t*)(p))
    for (int it = F.bid; it < BATCH * 8 * (SEQ / 64); it += F.G) {
        int tid = F.tid; asm volatile("" : "+v"(tid));
        const int lane = tid & 63, li = lane & 15, quad = lane >> 4;
        const int bh = it >> 8, ck = it & 255, b = bh >> 3, h = bh & 7;
        __syncthreads();
        const int et = tid >> 3, ec = (tid & 7) * 8;
        const float kiv = ((const float*)(WSP(F) + WS_KINV))[((size_t)b * SEQ + ck * 64 + et) * 8 + h];
        const bf16* ap = AR + ((size_t)b * SEQ + ck * 64 + et) * 512 + h * 64 + ec;
        const u32x4 wr = *(const u32x4*)ap, wl = *(const u32x4*)(ap + AS), wk = *(const u32x4*)(ap + 2 * AS), wv = *(const u32x4*)(ap + 3 * AS), wkk = *(const u32x4*)(ap + 4 * AS), wbb = *(const u32x4*)(ap + 5 * AS);
        const float lwv[8] = {blo(wl.x), bhi(wl.x), blo(wl.y), bhi(wl.y), blo(wl.z), bhi(wl.z), blo(wl.w), bhi(wl.w)};
        *(LAS f32x4*)(LGF + et * 64 + ec) = (f32x4){lwv[0], lwv[1], lwv[2], lwv[3]}; *(LAS f32x4*)(LGF + et * 64 + ec + 4) = (f32x4){lwv[4], lwv[5], lwv[6], lwv[7]};
        __syncthreads();
        { const int c = tid & 63, p = tid >> 6; float x[8]; float run = 0.f;
#pragma unroll
          for (int i = 0; i < 8; ++i) x[i] = LGF[(8 * p + i) * 64 + c];
#pragma unroll
          for (int i = 0; i < 8; ++i) { run += x[i]; LGF[(8 * p + i) * 64 + c] = run; }
          PART[p * 64 + c] = run; }
        __syncthreads();
        { float lg[8];
          { f32x4 o0 = {0.f, 0.f, 0.f, 0.f}, o1 = o0, tot0 = o0, tot1 = o0;
#pragma unroll
            for (int p = 0; p < 8; ++p) { const f32x4 a0 = *(const LAS f32x4*)(PART + p * 64 + ec), a1 = *(const LAS f32x4*)(PART + p * 64 + ec + 4); if (p < (et >> 3)) { o0 += a0; o1 += a1; } tot0 += a0; tot1 += a1; }
            const f32x4 l0 = *(const LAS f32x4*)(LGF + et * 64 + ec) + o0, l1 = *(const LAS f32x4*)(LGF + et * 64 + ec + 4) + o1;
            lg[0] = l0.x; lg[1] = l0.y; lg[2] = l0.z; lg[3] = l0.w; lg[4] = l1.x; lg[5] = l1.y; lg[6] = l1.z; lg[7] = l1.w;
            if (et == 63) { *(LAS f32x4*)(GC + ec) = (f32x4){__expf(tot0.x), __expf(tot0.y), __expf(tot0.z), __expf(tot0.w)}; *(LAS f32x4*)(GC + ec + 4) = (f32x4){__expf(tot1.x), __expf(tot1.y), __expf(tot1.z), __expf(tot1.w)}; } }
          const float rv[8] = {blo(wr.x), bhi(wr.x), blo(wr.y), bhi(wr.y), blo(wr.z), bhi(wr.z), blo(wr.w), bhi(wr.w)}, kv[8] = {blo(wk.x), bhi(wk.x), blo(wk.y), bhi(wk.y), blo(wk.z), bhi(wk.z), blo(wk.w), bhi(wk.w)};
          const float kkv[8] = {blo(wkk.x), bhi(wkk.x), blo(wkk.y), bhi(wkk.y), blo(wkk.z), bhi(wkk.z), blo(wkk.w), bhi(wkk.w)}, bbv[8] = {blo(wbb.x), bhi(wbb.x), blo(wbb.y), bhi(wbb.y), blo(wbb.z), bhi(wbb.z), blo(wbb.w), bhi(wbb.w)};
          unsigned short ab[8], bb_[8], kb_[8], rb[8];
#pragma unroll
          for (int e = 0; e < 8; ++e) { const float ep = __expf(lg[e]), en = __expf(-lg[e]), epv = __expf(lg[e] - lwv[e]);
              ab[e] = (unsigned short)f2bf(-kkv[e] * kiv * epv); bb_[e] = (unsigned short)f2bf(bbv[e] * kiv * en); kb_[e] = (unsigned short)f2bf(kv[e] * en); rb[e] = (unsigned short)f2bf(rv[e] * ep); }
#define PK8(x) (u32x4){(unsigned)x[0] | ((unsigned)x[1] << 16), (unsigned)x[2] | ((unsigned)x[3] << 16), (unsigned)x[4] | ((unsigned)x[5] << 16), (unsigned)x[6] | ((unsigned)x[7] << 16)}
          *(LAS u32x4*)(AT + et * ST + ec * 2) = PK8(ab); *(LAS u32x4*)(BT + et * ST + ec * 2) = PK8(bb_); *(LAS u32x4*)(KT + et * ST + ec * 2) = PK8(kb_); *(LAS u32x4*)(RT + et * ST + ec * 2) = PK8(rb);
#undef PK8
          const unsigned short vb[8] = {(unsigned short)(wv.x & 0xffff), (unsigned short)(wv.x >> 16), (unsigned short)(wv.y & 0xffff), (unsigned short)(wv.y >> 16), (unsigned short)(wv.z & 0xffff), (unsigned short)(wv.z >> 16), (unsigned short)(wv.w & 0xffff), (unsigned short)(wv.w >> 16)};
#pragma unroll
          for (int e = 0; e < 8; ++e) { *(LAS unsigned short*)(BTT + (ec + e) * ST + et * 2) = bb_[e]; *(LAS unsigned short*)(KTT + (ec + e) * ST + et * 2) = kb_[e]; *(LAS unsigned short*)(VTl + (ec + e) * ST + et * 2) = vb[e]; } }
        __syncthreads();
        bf16x8_t ppk[2], qpk[2];
        if (wave < 4) { const int tt = wave; const bf16x8_t r0 = RD8(RT + (16 * tt + li) * ST + quad * 16), r1 = RD8(RT + (16 * tt + li) * ST + 64 + quad * 16);
            u32x2 pw[4], qw[4];
#pragma unroll
            for (int jt = 0; jt < 4; ++jt) { f32x4 pa = {0.f, 0.f, 0.f, 0.f}, qa = pa;
                pa = MF32(RD8(BT + (16 * jt + li) * ST + quad * 16), r0, pa); pa = MF32(RD8(BT + (16 * jt + li) * ST + 64 + quad * 16), r1, pa);
                qa = MF32(RD8(KT + (16 * jt + li) * ST + quad * 16), r0, qa); qa = MF32(RD8(KT + (16 * jt + li) * ST + 64 + quad * 16), r1, qa);
#pragma unroll
                for (int e = 0; e < 4; ++e) { const bool keep = (16 * jt + 4 * quad + e) <= (16 * tt + li); pa[e] = keep ? pa[e] : 0.f; qa[e] = keep ? qa[e] : 0.f; }
                pw[jt] = (u32x2){pg8::cvt_pk_bf16(pa[0], pa[1]), pg8::cvt_pk_bf16(pa[2], pa[3])}; qw[jt] = (u32x2){pg8::cvt_pk_bf16(qa[0], qa[1]), pg8::cvt_pk_bf16(qa[2], qa[3])}; }
            ppk[0] = __builtin_bit_cast(bf16x8_t, (u32x4){pw[0].x, pw[0].y, pw[1].x, pw[1].y}); ppk[1] = __builtin_bit_cast(bf16x8_t, (u32x4){pw[2].x, pw[2].y, pw[3].x, pw[3].y});
            qpk[0] = __builtin_bit_cast(bf16x8_t, (u32x4){qw[0].x, qw[0].y, qw[1].x, qw[1].y}); qpk[1] = __builtin_bit_cast(bf16x8_t, (u32x4){qw[2].x, qw[2].y, qw[3].x, qw[3].y});
        } else { const int rw = wave - 4; const bf16x8_t a0 = RD8(AT + (16 * rw + li) * ST + quad * 16), a1 = RD8(AT + (16 * rw + li) * ST + 64 + quad * 16);
            ppk[0] = (bf16x8_t){0, 0, 0, 0, 0, 0, 0, 0}; ppk[1] = ppk[0]; qpk[0] = ppk[0]; qpk[1] = ppk[0];
#pragma unroll
            for (int jt = 0; jt < 4; ++jt) { f32x4 na = {0.f, 0.f, 0.f, 0.f}, ma = na;
                if (jt <= rw) { na = MF32(a0, RD8(BT + (16 * jt + li) * ST + quad * 16), na); na = MF32(a1, RD8(BT + (16 * jt + li) * ST + 64 + quad * 16), na);
                                ma = MF32(a0, RD8(KT + (16 * jt + li) * ST + quad * 16), ma); ma = MF32(a1, RD8(KT + (16 * jt + li) * ST + 64 + quad * 16), ma); }
#pragma unroll
                for (int e = 0; e < 4; ++e) { const int tr = 16 * rw + 4 * quad + e, jc = 16 * jt + li; const bool keep = jc < tr; const float nv = keep ? na[e] : 0.f, mv = keep ? ma[e] : 0.f;
                    *(LAS unsigned short*)(NB + tr * ST + jc * 2) = (unsigned short)f2bf(nv); *(LAS unsigned short*)(MB + tr * ST + jc * 2) = (unsigned short)f2bf(mv);
                    if (jt == rw) ND[rw * 272 + (4 * quad + e) * 17 + li] = nv; } }
            LDS_WAIT(); asm volatile("" ::: "memory");
            if (lane < 16) { float x[16];
#pragma unroll
                for (int t = 0; t < 16; ++t) { float s = (t == lane) ? 1.f : 0.f;
#pragma unroll
                    for (int q = 0; q < t; ++q) s += ND[rw * 272 + t * 17 + q] * x[q];
                    x[t] = s; *(LAS unsigned short*)(DB + rw * 768 + t * 48 + lane * 2) = (unsigned short)f2bf(s); } }
        }
        __syncthreads();
        { const int cw = wave & 3; f32x4 rhs[4];
          if (wave < 4) {
#pragma unroll
              for (int i = 0; i < 4; ++i)
#pragma unroll
                  for (int e = 0; e < 4; ++e) rhs[i][e] = bf2f(*(const LAS unsigned short*)(AT + (16 * i + 4 * quad + e) * ST + (16 * cw + li) * 2));
          } else { const bf16x8_t v0 = RD8(VTl + (16 * cw + li) * ST + quad * 16), v1 = RD8(VTl + (16 * cw + li) * ST + 64 + quad * 16);
#pragma unroll
              for (int i = 0; i < 4; ++i) { f32x4 a = {0.f, 0.f, 0.f, 0.f}; a = MF32(RD8(MB + (16 * i + li) * ST + quad * 16), v0, a); a = MF32(RD8(MB + (16 * i + li) * ST + 64 + quad * 16), v1, a); rhs[i] = a; } }
          LAS unsigned char* XT = (wave < 4) ? WMT : UMT; bf16x4_t xb[4];
#pragma unroll
          for (int i = 0; i < 4; ++i) { f32x4 acc = rhs[i];
#pragma unroll
              for (int kb = 0; kb < 4; ++kb) if (kb < i) acc = MF16(RD4(NB + (16 * i + li) * ST + (16 * kb + 4 * quad) * 2), xb[kb], acc);
              const u32x2 aw = {pg8::cvt_pk_bf16(acc[0], acc[1]), pg8::cvt_pk_bf16(acc[2], acc[3])};
              f32x4 x = {0.f, 0.f, 0.f, 0.f}; x = MF16(RD4(DB + i * 768 + li * 48 + quad * 8), __builtin_bit_cast(bf16x4_t, aw), x);
              const u32x2 xw = {pg8::cvt_pk_bf16(x[0], x[1]), pg8::cvt_pk_bf16(x[2], x[3])}; xb[i] = __builtin_bit_cast(bf16x4_t, xw);
              *(LAS u32x2*)(XT + (16 * cw + li) * ST + (16 * i + 4 * quad) * 2) = xw; } }
        __syncthreads();
        if (wave < 4) { const int tt = wave; const int tg = 16 * tt + li;
            bf16* rmo = RM + (size_t)it * 4096 + tg * 64; bf16* y0o = Y0 + (size_t)it * 4096 + tg * 64;
#pragma unroll
            for (int ct = 0; ct < 4; ++ct) { const u32x2 rw2 = *(const LAS u32x2*)(RT + tg * ST + (16 * ct + 4 * quad) * 2); f32x4 acc = {blo(rw2.x), bhi(rw2.x), blo(rw2.y), bhi(rw2.y)};
#pragma unroll
                for (int s2 = 0; s2 < 2; ++s2) { const LAS unsigned char* wp = WMT + (16 * ct + li) * ST + (32 * s2 + 4 * quad) * 2; const u32x2 lo = *(const LAS u32x2*)wp, hi = *(const LAS u32x2*)(wp + 32);
                    acc = MF32(__builtin_bit_cast(bf16x8_t, (u32x4){lo.x, lo.y, hi.x, hi.y}), ppk[s2], acc); }
                *(u32x2*)(rmo + 16 * ct + 4 * quad) = (u32x2){pg8::cvt_pk_bf16(acc[0], acc[1]), pg8::cvt_pk_bf16(acc[2], acc[3])}; }
#pragma unroll
            for (int vt = 0; vt < 4; ++vt) { f32x4 acc = {0.f, 0.f, 0.f, 0.f};
#pragma unroll
                for (int s2 = 0; s2 < 2; ++s2) { const LAS unsigned char* up = UMT + (16 * vt + li) * ST + (32 * s2 + 4 * quad) * 2; const u32x2 ulo = *(const LAS u32x2*)up, uhi = *(const LAS u32x2*)(up + 32);
                    acc = MF32(__builtin_bit_cast(bf16x8_t, (u32x4){ulo.x, ulo.y, uhi.x, uhi.y}), ppk[s2], acc);
                    const LAS unsigned char* vp = VTl + (16 * vt + li) * ST + (32 * s2 + 4 * quad) * 2; const u32x2 vlo = *(const LAS u32x2*)vp, vhi = *(const LAS u32x2*)(vp + 32);
                    acc = MF32(__builtin_bit_cast(bf16x8_t, (u32x4){vlo.x, vlo.y, vhi.x, vhi.y}), qpk[s2], acc); }
                *(u32x2*)(y0o + 16 * vt + 4 * quad) = (u32x2){pg8::cvt_pk_bf16(acc[0], acc[1]), pg8::cvt_pk_bf16(acc[2], acc[3])}; }
        } else { const int xt = wave - 4;
            const bf16x8_t bt0 = RD8(BTT + (16 * xt + li) * ST + quad * 16), bt1 = RD8(BTT + (16 * xt + li) * ST + 64 + quad * 16);
            const float gc2 = GC[16 * xt + li]; bf16* pco = PCT + (size_t)it * 4096 + (16 * xt + li) * 64;
#pragma unroll
            for (int c1 = 0; c1 < 4; ++c1) { f32x4 acc = {0.f, 0.f, 0.f, 0.f};
                acc = MF32(RD8(WMT + (16 * c1 + li) * ST + quad * 16), bt0, acc); acc = MF32(RD8(WMT + (16 * c1 + li) * ST + 64 + quad * 16), bt1, acc);
                float o[4];
#pragma unroll
                for (int e = 0; e < 4; ++e) o[e] = gc2 * (acc[e] + (((16 * c1 + 4 * quad + e) == (16 * xt + li)) ? 1.f : 0.f));
                *(u32x2*)(pco + 16 * c1 + 4 * quad) = (u32x2){pg8::cvt_pk_bf16(o[0], o[1]), pg8::cvt_pk_bf16(o[2], o[3])}; }
            const bf16x8_t um0 = RD8(UMT + (16 * xt + li) * ST + quad * 16), um1 = RD8(UMT + (16 * xt + li) * ST + 64 + quad * 16), vt0 = RD8(VTl + (16 * xt + li) * ST + quad * 16), vt1 = RD8(VTl + (16 * xt + li) * ST + 64 + quad * 16);
            bf16* lco = LC + (size_t)it * 4096 + (16 * xt + li) * 64;
#pragma unroll
            for (int ct = 0; ct < 4; ++ct) { f32x4 acc = {0.f, 0.f, 0.f, 0.f};
                acc = MF32(RD8(BTT + (16 * ct + li) * ST + quad * 16), um0, acc); acc = MF32(RD8(BTT + (16 * ct + li) * ST + 64 + quad * 16), um1, acc);
                acc = MF32(RD8(KTT + (16 * ct + li) * ST + quad * 16), vt0, acc); acc = MF32(RD8(KTT + (16 * ct + li) * ST + 64 + quad * 16), vt1, acc);
                const f32x4 g4 = *(const LAS f32x4*)(GC + 16 * ct + 4 * quad);
                *(u32x2*)(lco + 16 * ct + 4 * quad) = (u32x2){pg8::cvt_pk_bf16(acc[0] * g4.x, acc[1] * g4.y), pg8::cvt_pk_bf16(acc[2] * g4.z, acc[3] * g4.w)}; }
        }
    }
#undef MF32
#undef MF16
#undef RD8
#undef RD4
    __syncthreads();
}
template <int MODE> DI void state_scan16(Frame& F) {
    constexpr int SLOT = 18432, NSL = 6;
    const bf16* PT = (const bf16*)(WSP(F) + (MODE == 1 ? WS_PGT : WS_PCT)); const bf16* LL = (const bf16*)(WSP(F) + (MODE == 1 ? WS_LG : WS_LC));
    LAS unsigned char* ring = F.lds;
    const int nitems = (MODE == 1) ? BATCH * 8 : BATCH * 8 * 16;
#define RBAR() do { asm volatile("s_waitcnt lgkmcnt(0)" ::: "memory"); __builtin_amdgcn_s_barrier(); asm volatile("" ::: "memory"); } while (0)
    for (int it = F.bid; it < nitems; it += F.G) {
        int tid = F.tid; asm volatile("" : "+v"(tid));
        const int lane = tid & 63, wave = __builtin_amdgcn_readfirstlane(tid >> 6), vl = lane & 15, quad = lane >> 4;
        const size_t opbase = (MODE == 1) ? (size_t)it * 16 * 4096 : (size_t)((it >> 4) * 256 + (it & 15) * 16) * 4096;
        const bf16* pt = PT + opbase; const bf16* ll = LL + opbase;
        __syncthreads();
        const unsigned loffp = (unsigned)((tid >> 3) * 144 + (tid & 7) * 16), loffl = 9216u + loffp;
        u32x4 rg[4][2];
#define SLOAD(q, x) do { rg[q][0] = *((const u32x4*)(pt + (size_t)(x) * 4096) + tid); rg[q][1] = *((const u32x4*)(ll + (size_t)(x) * 4096) + tid); } while (0)
#define SWRITE(q, x) do { LAS unsigned char* d_ = ring + ((x) % NSL) * SLOT; *(LAS u32x4*)(d_ + loffp) = rg[q][0]; *(LAS u32x4*)(d_ + loffl) = rg[q][1]; } while (0)
        SLOAD(0, 0); SLOAD(1, 1); SLOAD(2, 2); SLOAD(3, 3);
        SWRITE(0, 0); SWRITE(1, 1);
        SLOAD(0, 4); SLOAD(1, 5);
        const bool pwave = (MODE == 0) && (wave < 4); const bool active = (MODE == 0) || (wave < 4); const int vb = wave & 3;
        f32x4 st[4];
#pragma unroll
        for (int kt = 0; kt < 4; ++kt) { st[kt] = (f32x4){0.f, 0.f, 0.f, 0.f};
            if (pwave) {
#pragma unroll
                for (int j = 0; j < 4; ++j) st[kt][j] = ((16 * kt + 4 * quad + j) == (16 * vb + vl)) ? 1.f : 0.f; }
            if (MODE == 2 && active) { const u32x2 w = *(const u32x2*)((const bf16*)(WSP(F) + WS_SG) + (size_t)it * 4096 + (16 * vb + vl) * 64 + 16 * kt + 4 * quad); st[kt] = (f32x4){blo(w.x), bhi(w.x), blo(w.y), bhi(w.y)}; } }
        const unsigned aoff = (unsigned)(vl * 144 + quad * 8), loffc = (unsigned)(9216 + (16 * vb + vl) * 144 + quad * 8);
        RBAR();
#pragma unroll
        for (int c = 0; c < 16; ++c) {
            if (c + 2 < 16) { SWRITE((c + 2) & 3, c + 2); if (c + 6 < 16) SLOAD((c + 2) & 3, c + 6); }
            if (active) {
                const LAS unsigned char* sl = ring + (c % NSL) * SLOT;
                bf16x8_t bfr[2];
                { u32x2 pk[4];
#pragma unroll
                  for (int kt = 0; kt < 4; ++kt) { pk[kt] = (u32x2){pg8::cvt_pk_bf16(st[kt][0], st[kt][1]), pg8::cvt_pk_bf16(st[kt][2], st[kt][3])};
                      if (MODE == 1) *(u32x2*)((bf16*)(WSP(F) + WS_SG) + ((size_t)it * 16 + c) * 4096 + (16 * vb + vl) * 64 + 16 * kt + 4 * quad) = pk[kt];
                      if (MODE == 2) *(u32x2*)((bf16*)(WSP(F) + WS_S0) + (opbase + (size_t)c * 4096) + (16 * vb + vl) * 64 + 16 * kt + 4 * quad) = pk[kt]; }
                  bfr[0] = __builtin_bit_cast(bf16x8_t, (u32x4){pk[0].x, pk[0].y, pk[1].x, pk[1].y}); bfr[1] = __builtin_bit_cast(bf16x8_t, (u32x4){pk[2].x, pk[2].y, pk[3].x, pk[3].y}); }
#pragma unroll
                for (int kt = 0; kt < 4; ++kt) { f32x4 acc = {0.f, 0.f, 0.f, 0.f};
                    if (!pwave) { const u32x2 lf = *(const LAS u32x2*)(sl + loffc + kt * 32); acc = (f32x4){blo(lf.x), bhi(lf.x), blo(lf.y), bhi(lf.y)}; }
#pragma unroll
                    for (int s2 = 0; s2 < 2; ++s2) { const u32x2 a0 = *(const LAS u32x2*)(sl + aoff + kt * 16 * 144 + s2 * 64), a1 = *(const LAS u32x2*)(sl + aoff + kt * 16 * 144 + s2 * 64 + 32);
                        acc = __builtin_amdgcn_mfma_f32_16x16x32_bf16(__builtin_bit_cast(bf16x8_t, (u32x4){a0.x, a0.y, a1.x, a1.y}), bfr[s2], acc, 0, 0, 0); }
                    st[kt] = acc; }
            }
            RBAR();
        }
        if (MODE == 0) {
            bf16* pg = (bf16*)(WSP(F) + WS_PGT) + (size_t)it * 4096; bf16* lg = (bf16*)(WSP(F) + WS_LG) + (size_t)it * 4096;
#pragma unroll
            for (int kt = 0; kt < 4; ++kt) {
                if (pwave) {
#pragma unroll
                    for (int j = 0; j < 4; ++j) pg[(16 * kt + 4 * quad + j) * 64 + 16 * vb + vl] = (bf16)f2bf(st[kt][j]);
                } else *(u32x2*)(lg + (16 * vb + vl) * 64 + 16 * kt + 4 * quad) = (u32x2){pg8::cvt_pk_bf16(st[kt][0], st[kt][1]), pg8::cvt_pk_bf16(st[kt][2], st[kt][3])}; }
        }
#undef SLOAD
#undef SWRITE
    }
#undef RBAR
    __syncthreads();
}
DI void rwkv_out_phase(Frame& F, int l) {
    bf16* AR = (bf16*)(WSP(F) + WS_AR); const size_t AS = (size_t)T * 512; const float* bonus = (const float*)(WSP(F) + WS_BONUS);
    const bf16* RM = (const bf16*)(WSP(F) + WS_RM); const bf16* Y0 = (const bf16*)(WSP(F) + WS_Y0); const bf16* S0 = (const bf16*)(WSP(F) + WS_S0);
    const int gw = F.bid * 8 + F.wave, NGW = F.G * 8, lane = F.lane, li = lane & 15, quad = lane >> 4;
    for (int it = gw; it < BATCH * 8 * (SEQ / 64); it += NGW) {
        const int bh = it >> 8, ck = it & 255, b = bh >> 3, h = bh & 7;
        const bf16* s0 = S0 + (size_t)it * 4096; const bf16* rm = RM + (size_t)it * 4096; const bf16* y0 = Y0 + (size_t)it * 4096;
        bf16x8_t sa[4][2];
#pragma unroll
        for (int vt = 0; vt < 4; ++vt)
#pragma unroll
            for (int s2 = 0; s2 < 2; ++s2) sa[vt][s2] = *(const bf16x8_t*)(s0 + (16 * vt + li) * 64 + 32 * s2 + 8 * quad);
        float lg[4][4], lb[4][4];
#pragma unroll
        for (int vt = 0; vt < 4; ++vt) { const f32x4 g4 = *(const f32x4*)(INP(F, 14) + l * 512 + h * 64 + 16 * vt + 4 * quad), b4 = *(const f32x4*)(INP(F, 15) + l * 512 + h * 64 + 16 * vt + 4 * quad);
            lg[vt][0] = g4.x; lg[vt][1] = g4.y; lg[vt][2] = g4.z; lg[vt][3] = g4.w; lb[vt][0] = b4.x; lb[vt][1] = b4.y; lb[vt][2] = b4.z; lb[vt][3] = b4.w; }
#pragma unroll 1
        for (int tt = 0; tt < 4; ++tt) {
            const int tch = 16 * tt + li; const size_t t = (size_t)b * SEQ + ck * 64 + tch;
            bf16x8_t rb[2];
#pragma unroll
            for (int s2 = 0; s2 < 2; ++s2) rb[s2] = *(const bf16x8_t*)(rm + tch * 64 + 32 * s2 + 8 * quad);
            f32x4 acc[4];
#pragma unroll
            for (int vt = 0; vt < 4; ++vt) { const u32x2 yw = *(const u32x2*)(y0 + tch * 64 + 16 * vt + 4 * quad); acc[vt] = (f32x4){blo(yw.x), bhi(yw.x), blo(yw.y), bhi(yw.y)};
                acc[vt] = __builtin_amdgcn_mfma_f32_16x16x32_bf16(sa[vt][0], rb[0], acc[vt], 0, 0, 0); acc[vt] = __builtin_amdgcn_mfma_f32_16x16x32_bf16(sa[vt][1], rb[1], acc[vt], 0, 0, 0); }
            float sm = 0.f;
#pragma unroll
            for (int vt = 0; vt < 4; ++vt) sm += (acc[vt][0] + acc[vt][1]) + (acc[vt][2] + acc[vt][3]);
            sm += __shfl_xor(sm, 16); sm += __shfl_xor(sm, 32);
            const float mean = sm * (1.f / 64.f); float sq = 0.f;
#pragma unroll
            for (int vt = 0; vt < 4; ++vt)
#pragma unroll
                for (int e = 0; e < 4; ++e) { const float d = acc[vt][e] - mean; acc[vt][e] = d; sq += d * d; }
            sq += __shfl_xor(sq, 16); sq += __shfl_xor(sq, 32);
            const float rstd = rsqrtf(sq * (1.f / 64.f) + 64e-5f), bon = bonus[t * 8 + h];
            const size_t idx = t * 512 + h * 64 + 4 * quad;
#pragma unroll
            for (int vt = 0; vt < 4; ++vt) { const u32x2 vw = *(const u32x2*)(AR + 3 * AS + idx + 16 * vt), gw2 = *(const u32x2*)(AR + 6 * AS + idx + 16 * vt);
                const float vv[4] = {blo(vw.x), bhi(vw.x), blo(vw.y), bhi(vw.y)}, gg[4] = {blo(gw2.x), bhi(gw2.x), blo(gw2.y), bhi(gw2.y)}; float o[4];
#pragma unroll
                for (int e = 0; e < 4; ++e) o[e] = (acc[vt][e] * rstd * lg[vt][e] + lb[vt][e] + bon * vv[e]) * gg[e];
                *(u32x2*)(AR + idx + 16 * vt) = (u32x2){pk2(o[0], o[1]), pk2(o[2], o[3])}; }
        }
    }
}
DI void route_phase(Frame& F, int l) {
    const float* x = OUTP(F); bf16* h2 = (bf16*)(WSP(F) + WS_XB); const bf16* RWH = (const bf16*)(WSP(F) + WS_RWG); const bf16* RWL = RWH + 48 * 1024;
    int* route = (int*)(WSP(F) + WS_ROUTE); float* rwt = (float*)(WSP(F) + WS_RWT); unsigned* cnt = (unsigned*)(WSP(F) + WS_CTL) + CW_CNT + 32 * l;
    const float* rgb = INP(F, 24) + l * 4; const float* reb = INP(F, 26) + l * 32;
    LAS unsigned* lc = (LAS unsigned*)(F.lds + MISC_OFF + 8192); unsigned* wgbase = (unsigned*)(WSP(F) + WS_WGBASE);
    for (int wit = F.bid; wit < T / 128; wit += F.G) {
        int lane = F.lane; asm volatile("" : "+v"(lane));
        __syncthreads();
        if (F.tid < 32) lc[F.tid] = 0u;
        __syncthreads();
        const int it = wit * 8 + F.wave;
        const int li = lane & 15, quad = lane >> 4; const size_t t = (size_t)it * 16 + li;
        const float* xr = x + t * DM + 8 * quad;
        f32x4 acc[3];
#pragma unroll
        for (int jt = 0; jt < 3; ++jt) acc[jt] = (f32x4){0.f, 0.f, 0.f, 0.f};
        float ss = 0.f;
#pragma unroll 2
        for (int ks = 0; ks < 32; ++ks) {
            const f32x4 x0 = *(const f32x4*)(xr + 32 * ks), x1 = *(const f32x4*)(xr + 32 * ks + 4);
            ss += (x0.x * x0.x + x0.y * x0.y) + (x0.z * x0.z + x0.w * x0.w) + (x1.x * x1.x + x1.y * x1.y) + (x1.z * x1.z + x1.w * x1.w);
            const float xf[8] = {x0.x, x0.y, x0.z, x0.w, x1.x, x1.y, x1.z, x1.w}; unsigned hb[8]; float lo[8];
#pragma unroll
            for (int e = 0; e < 8; ++e) { hb[e] = f2bf(xf[e]); lo[e] = xf[e] - __uint_as_float(hb[e] << 16); }
            const bf16x8_t bh = __builtin_bit_cast(bf16x8_t, (u32x4){hb[0] | (hb[1] << 16), hb[2] | (hb[3] << 16), hb[4] | (hb[5] << 16), hb[6] | (hb[7] << 16)});
            const bf16x8_t bl = __builtin_bit_cast(bf16x8_t, (u32x4){pk2(lo[0], lo[1]), pk2(lo[2], lo[3]), pk2(lo[4], lo[5]), pk2(lo[6], lo[7])});
#pragma unroll
            for (int jt = 0; jt < 3; ++jt) { const size_t wo = (size_t)(16 * jt + li) * 1024 + 32 * ks + 8 * quad;
                const bf16x8_t wh = *(const bf16x8_t*)(RWH + wo), wl = *(const bf16x8_t*)(RWL + wo);
                acc[jt] = __builtin_amdgcn_mfma_f32_16x16x32_bf16(wh, bh, acc[jt], 0, 0, 0);
                acc[jt] = __builtin_amdgcn_mfma_f32_16x16x32_bf16(wl, bh, acc[jt], 0, 0, 0);
                acc[jt] = __builtin_amdgcn_mfma_f32_16x16x32_bf16(wh, bl, acc[jt], 0, 0, 0); }
        }
        ss += __shfl_xor(ss, 16); ss += __shfl_xor(ss, 32);
        const float rs = rsqrtf(ss * (1.f / DM) + 1e-6f);
#pragma unroll 4
        for (int ks = 0; ks < 32; ++ks) { const f32x4 x0 = *(const f32x4*)(xr + 32 * ks), x1 = *(const f32x4*)(xr + 32 * ks + 4);
            *(u32x4*)(h2 + t * DM + 32 * ks + 8 * quad) = (u32x4){pk2(x0.x * rs, x0.y * rs), pk2(x0.z * rs, x0.w * rs), pk2(x1.x * rs, x1.y * rs), pk2(x1.z * rs, x1.w * rs)}; }
        float gl[4]; int grp = 0;
#pragma unroll
        for (int j = 0; j < 4; ++j) gl[j] = acc[0][j] * rs + rgb[j];
        float gm = gl[0];
#pragma unroll
        for (int j = 1; j < 4; ++j) if (gl[j] > gm) { gm = gl[j]; grp = j; }
        if (quad == grp) {
            float gs = 0.f;
#pragma unroll
            for (int j = 0; j < 4; ++j) gs += __expf(gl[j] - gm);
            const float gprob = 1.0f / gs;
            float eg[8];
#pragma unroll
            for (int i = 0; i < 4; ++i) { eg[i] = acc[1][i] * rs + reb[8 * quad + i]; eg[4 + i] = acc[2][i] * rs + reb[8 * quad + 4 + i]; }
            int i0 = 0; float m0 = eg[0];
#pragma unroll
            for (int i = 1; i < 8; ++i) if (eg[i] > m0) { m0 = eg[i]; i0 = i; }
            int i1 = -1; float m1 = -INFINITY;
#pragma unroll
            for (int i = 0; i < 8; ++i) if (i != i0 && eg[i] > m1) { m1 = eg[i]; i1 = i; }
            const float e10 = __expf(m1 - m0), wa = gprob / (1.0f + e10), wb = gprob * e10 / (1.0f + e10);
            const int e0 = grp * 8 + i0, e1 = grp * 8 + i1;
            const unsigned r0 = atomicAdd((unsigned*)(lc + e0), 1u), r1 = atomicAdd((unsigned*)(lc + e1), 1u);
            ((int4*)route)[t] = make_int4(e0, (int)r0, e1, (int)r1); ((float2*)rwt)[t] = make_float2(wa, wb);
        }
        __syncthreads();
        if (F.tid < 32) { const unsigned c = lc[F.tid]; wgbase[wit * 32 + F.tid] = c ? atomicAdd(cnt + F.tid, c) : 0u; }
    }
    __syncthreads();
}
DI int moe_tables(Frame& F, int l) {
    LAS int* ps = (LAS int*)(F.lds + MISC_OFF); LAS unsigned char* te = (LAS unsigned char*)(F.lds + MISC_OFF + 256);
    const unsigned* cnt = (const unsigned*)(WSP(F) + WS_CTL) + CW_CNT + 32 * l;
    __syncthreads();
    if (F.tid == 0) { int acc = 0;
_Pragma("unroll 1")
        for (int e = 0; e < NEXP; ++e) { ps[e] = acc; const int c = (int)__hip_atomic_load(cnt + e, __ATOMIC_RELAXED, __HIP_MEMORY_SCOPE_AGENT); const int nt = (c + 255) >> 8;
_Pragma("unroll 1")
            for (int i = 0; i < nt; ++i) te[(acc >> 8) + i] = (unsigned char)e; acc += nt << 8; } ps[NEXP] = acc; }
    __syncthreads();
    return __builtin_amdgcn_readfirstlane(ps[NEXP] >> 8);
}
DI void permute_phase(Frame& F, int l) {
    moe_tables(F, l);
    const LAS int* ps = (const LAS int*)(F.lds + MISC_OFF);
    const bf16* h2 = (const bf16*)(WSP(F) + WS_XB); bf16* xp = (bf16*)(WSP(F) + WS_XPERM); const int* route = (const int*)(WSP(F) + WS_ROUTE); int* dest = (int*)(WSP(F) + WS_DEST);
    const int gw = F.bid * 8 + F.wave, NGW = F.G * 8, lane = F.lane;
    for (int t = gw; t < T; t += NGW) {
        const int4 r = ((const int4*)route)[t]; const unsigned* wb_ = (const unsigned*)(WSP(F) + WS_WGBASE) + (t >> 7) * 32; const int d0 = ps[r.x] + (int)wb_[r.x] + r.y, d1 = ps[r.z] + (int)wb_[r.z] + r.w;
        const u32x4* src = (const u32x4*)(h2 + (size_t)t * DM) + lane; u32x4* o0 = (u32x4*)(xp + (size_t)d0 * DM) + lane; u32x4* o1 = (u32x4*)(xp + (size_t)d1 * DM) + lane;
        const u32x4 a = src[0], b = src[64]; o0[0] = a; o0[64] = b; o1[0] = a; o1[64] = b;
        if (lane == 0) ((int2*)dest)[t] = make_int2(d0, d1);
    }
}
DI void combine_phase(Frame& F, int l) {
    float* x = OUTP(F); const bf16* Y = (const bf16*)(WSP(F) + WS_YMOE); const int* dest = (const int*)(WSP(F) + WS_DEST); const float* rwt = (const float*)(WSP(F) + WS_RWT);
    bf16* xb = (bf16*)(WSP(F) + WS_XB); const float* fg = INP(F, 30);
    const int gw = F.bid * 8 + F.wave, NGW = F.G * 8, lane = F.lane; const bool last = (l == DEPTH - 1);
    for (int t = gw; t < T; t += NGW) {
        const int2 d = ((const int2*)dest)[t]; const float2 w = ((const float2*)rwt)[t];
        f32x4* xr = (f32x4*)(x + (size_t)t * DM) + lane; const u32x2* y0 = (const u32x2*)(Y + (size_t)d.x * DM) + lane; const u32x2* y1 = (const u32x2*)(Y + (size_t)d.y * DM) + lane;
        f32x4 v[4]; float s = 0.f;
#pragma unroll
        for (int j = 0; j < 4; ++j) { v[j] = xr[64 * j]; const u32x2 a = y0[64 * j], b = y1[64 * j];
            v[j].x += w.x * blo(a.x) + w.y * blo(b.x); v[j].y += w.x * bhi(a.x) + w.y * bhi(b.x); v[j].z += w.x * blo(a.y) + w.y * blo(b.y); v[j].w += w.x * bhi(a.y) + w.y * bhi(b.y);
            s += (v[j].x * v[j].x + v[j].y * v[j].y) + (v[j].z * v[j].z + v[j].w * v[j].w); }
        const float rs = rsqrtf(wave_sum(s) * (1.f / DM) + 1e-6f);
        if (last) {
#pragma unroll
            for (int j = 0; j < 4; ++j) { const f32x4 g = ((const f32x4*)fg)[lane + 64 * j]; xr[64 * j] = v[j] * rs * g; }
        } else {
            u32x2* o = (u32x2*)(xb + (size_t)t * DM) + lane;
#pragma unroll
            for (int j = 0; j < 4; ++j) { xr[64 * j] = v[j]; o[64 * j] = (u32x2){pk2(v[j].x * rs, v[j].y * rs), pk2(v[j].z * rs, v[j].w * rs)}; }
        }
    }
}

DI void dump_bf16(Frame& F, const bf16* src, int pitch, int ncols, int c0) {
    float* out = OUTP(F);
    for (size_t i = (size_t)F.bid * 512 + F.tid; i < (size_t)T * ncols; i += (size_t)F.G * 512) { const size_t t = i / ncols; const int c = (int)(i % ncols); out[t * DM + c0 + c] = bf2f(src[t * pitch + c]); }
}
__global__ void __launch_bounds__(512, 2) mk_fwd(Args args) {
    extern __shared__ __attribute__((aligned(16))) unsigned char lds_raw[];
    cg::grid_group grid = cg::this_grid();
    Frame F; F.lds = (LAS unsigned char*)lds_raw; F.tid = threadIdx.x; F.lane = F.tid & 63; F.wave = __builtin_amdgcn_readfirstlane(F.tid >> 6); F.G = gridDim.x; F.bid = (int)__builtin_amdgcn_workgroup_id_x();
    F.kp = (kargp_t)__builtin_amdgcn_kernarg_segment_ptr();
    for (int u = F.tid; u < 64; u += 512) ((LAS unsigned*)(F.lds + MISC_OFF + 4096))[u] = 0u;
    __syncthreads();
    (void)xcd_barrier_post((unsigned*)(WSP(F) + WS_CTL) + CW_BAR, (volatile LAS unsigned*)(F.lds + MISC_OFF + 4096));
    grid.sync();
#define GRID_BAR() do { XcdBarrier bb_; bb_.bar = (unsigned*)(WSP(F) + WS_CTL) + CW_BAR; bb_.x = xb_xcc_id(); bb_.st = (volatile LAS unsigned*)(F.lds + MISC_OFF + 4096); xcd_barrier(bb_); fence_frame(F); } while (0)
#define ws WSP(F)
#if defined(DBG_TMASK)
#define PT0() const unsigned long long pt0_ = __builtin_amdgcn_s_memrealtime()
#define PT1(k) do { if ((DBG_TMASK >> (k)) & 1) { const unsigned long long n_ = __builtin_amdgcn_s_memrealtime(); const unsigned long long e_ = n_ + (unsigned long long)DBG_AMP * (n_ - pt0_); while (__builtin_amdgcn_s_memrealtime() < e_) __builtin_amdgcn_s_sleep(16); } } while (0)
#else
#define PT0() do {} while (0)
#define PT1(k) do {} while (0)
#endif
    { PT0(); prep_mixer_weights(F, 0);
    rms_rows_to_bf16(F, INP(F, 0), (bf16*)(ws + WS_XB));
    GRID_BAR(); PT1(0); }
#if defined(DBG_STOP) && DBG_STOP == 10
    { PT0(); { pg8::Gemm g{(const bf16*)(ws + WS_XB), (const bf16*)(ws + WS_WG), T, 3072, DM}; pg8::StaticOrder S; S.init(T, 3072, F.G, (int)F.bid);
      pg8::EpiGate E{(unsigned char*)(ws + WS_GATES), 3072};
      pg8::gemm_phase<pg8::EpiGate, pg8::StaticOrder, true, true>(F.lds, g, S, E); }
    GRID_BAR(); PT1(10); }
    dump_bf16(F, (const bf16*)(ws + WS_GATES) + 1024, 3072, 1024, 0); return;
#endif
#pragma unroll 1
    for (int l = 0; l < DEPTH; ++l) {
        { PT0(); { pg8::Gemm g{(const bf16*)(ws + WS_XB), (const bf16*)(ws + WS_WIN), T, l == 0 ? 3840 : 4096, DM}; pg8::StaticOrder S; S.init(T, g.N, F.G, (int)F.bid);
          pg8::EpiZ E{(bf16*)(ws + WS_Q), (bf16*)(ws + WS_K), (bf16*)(ws + WS_V), (bf16*)(ws + WS_POOLZ), (bf16*)(ws + WS_RWKVZ), C2};
          pg8::gemm_phase<pg8::EpiZ, pg8::StaticOrder, true, true>(F.lds, g, S, E); }
        GRID_BAR(); PT1(1); }
        { PT0(); kmean_phase(F);
        vt_phase(F);
        pool_phase(F, l);
        GRID_BAR(); PT1(2); }
        { PT0(); sel_phase(F, l);
        GRID_BAR(); PT1(3); }
        { PT0(); att_phase(F, l);
        GRID_BAR(); PT1(4); }
        { PT0(); comb_phase(F);
        GRID_BAR(); PT1(5); }
#if defined(DBG_STOP) && DBG_STOP == 3
        dump_bf16(F, (const bf16*)(ws + WS_YATTN), 512, 512, 0); dump_bf16(F, (const bf16*)(ws + WS_YPOOL), 512, 512, 512); return;
#endif
        { PT0(); rwkv_prep_phase(F, l);
        GRID_BAR(); PT1(6); }
        { PT0(); rwkv_chunk_phase(F);
        GRID_BAR(); PT1(7); }
        { PT0(); state_scan16<0>(F);
        GRID_BAR();
        state_scan16<1>(F);
        GRID_BAR();
        state_scan16<2>(F);
        GRID_BAR(); PT1(8); }
        { PT0(); rwkv_out_phase(F, l);
        GRID_BAR(); PT1(9); }
        { pg8::Gemm g{(const bf16*)(ws + WS_XB), (const bf16*)(ws + WS_WG), T, 3072, DM}; pg8::StaticOrder S; S.init(T, 3072, F.G, (int)F.bid);
          pg8::EpiGate E{(unsigned char*)(ws + WS_GATES), 3072};
          pg8::gemm_phase<pg8::EpiGate, pg8::StaticOrder, true, true>(F.lds, g, S, E); }
        GRID_BAR();
#if defined(DBG_SCRUB)
        { const f32x4* xs = (const f32x4*)INP(F, 0) + (size_t)F.bid * 32768; f32x4 a = {0.f, 0.f, 0.f, 0.f};
          for (int i = F.tid; i < 32768; i += 512) a += xs[i];
          if (a.x + a.y + a.z + a.w == 12345.678f) ((float*)(ws + WS_BONUS))[F.tid] = a.x; }
        GRID_BAR();
#endif
        { PT0(); { pg8::StaticOrder S; S.init(T, DM, F.G, (int)F.bid);
          { pg8::Gemm g{(const bf16*)(ws + WS_YATTN), (const bf16*)(ws + WS_WBR), T, DM, 512};
            pg8::EpiMerge<true> E{(bf16*)(ws + WS_XB), DM, (const unsigned char*)(ws + WS_GATES), 3072, 0};
            pg8::gemm_phase<pg8::EpiMerge<true>, pg8::StaticOrder, true, true>(F.lds, g, S, E); }
          { pg8::Gemm g{(const bf16*)(ws + WS_AR), (const bf16*)(ws + WS_WBR) + (size_t)1024 * 512, T, DM, 512};
            pg8::EpiMerge<false> E{(bf16*)(ws + WS_XB), DM, (const unsigned char*)(ws + WS_GATES), 3072, 1024};
            pg8::gemm_phase<pg8::EpiMerge<false>, pg8::StaticOrder, true, true>(F.lds, g, S, E); }
          { pg8::Gemm g{(const bf16*)(ws + WS_YPOOL), (const bf16*)(ws + WS_WBR) + (size_t)2 * 1024 * 512, T, DM, 512};
            pg8::EpiMerge<false> E{(bf16*)(ws + WS_XB), DM, (const unsigned char*)(ws + WS_GATES), 3072, 2048};
            pg8::gemm_phase<pg8::EpiMerge<false>, pg8::StaticOrder, true, true>(F.lds, g, S, E); } }
        GRID_BAR(); PT1(11); }
#if defined(DBG_STOP) && DBG_STOP == 7
        dump_bf16(F, (const bf16*)(ws + WS_XB), 1024, 1024, 0); return;
#endif
#if defined(DBG_STOP) && DBG_STOP == 6
        dump_bf16(F, (const bf16*)(ws + WS_GATES) + 1024, 3072, 1024, 0); return;
#endif
        { PT0(); { pg8::Gemm g{(const bf16*)(ws + WS_XB), (const bf16*)(ws + WS_WOUT), T, DM, DM}; pg8::StaticOrder S; S.init(T, DM, F.G, (int)F.bid);
          pg8::EpiResF32 E{l == 0 ? INP(F, 0) : OUTP(F), OUTP(F), DM};
          pg8::gemm_phase<pg8::EpiResF32, pg8::StaticOrder, true, true>(F.lds, g, S, E); }
        GRID_BAR(); PT1(12); }
#if defined(DBG_STOP) && DBG_STOP == 1
        return;
#endif
        { PT0(); route_phase(F, l);
#if defined(DBG_TMASK)
        GRID_BAR(); PT1(13); } { PT0();
#endif
        prep_expert_weights(F, l);
        GRID_BAR(); PT1(18); }
        { PT0(); permute_phase(F, l);
        GRID_BAR(); PT1(14); }
        { const int ntile = moe_tables(F, l);
          const LAS unsigned char* te = (const LAS unsigned char*)(F.lds + MISC_OFF + 256);
          { PT0(); { pg8::Gemm g{(const bf16*)(ws + WS_XPERM), (const bf16*)(ws + WS_W13), RMAX, NEXP * 1024, DM}; pg8::MoeOrder S{te, ntile * 4, F.G, (int)F.bid};
            pg8::EpiSwiGLU E{(bf16*)(ws + WS_HACT)};
            pg8::gemm_phase<pg8::EpiSwiGLU, pg8::MoeOrder, true, true>(F.lds, g, S, E); }
          GRID_BAR(); PT1(15); }
          { PT0(); { pg8::Gemm g{(const bf16*)(ws + WS_HACT), (const bf16*)(ws + WS_W2), RMAX, NEXP * 1024, 512}; pg8::MoeOrder S{te, ntile * 4, F.G, (int)F.bid};
            pg8::EpiY E{(bf16*)(ws + WS_YMOE)};
            pg8::gemm_phase<pg8::EpiY, pg8::MoeOrder, true, true>(F.lds, g, S, E); }
        GRID_BAR(); PT1(16); } }
        { PT0(); combine_phase(F, l);
        if (l + 1 < DEPTH) prep_mixer_weights(F, l + 1);
        GRID_BAR(); PT1(17); }
#if defined(DBG_STOP) && DBG_STOP == 2
        return;
#endif
    }
#undef ws
}

extern "C" void kernel_launch(void* const* d_in, const int* in_sizes, int n_in, void* d_out, int out_size, void* d_ws, size_t ws_size, hipStream_t stream) {
    static int grid = 0;
    if (grid == 0) {
        if (n_in != 31 || out_size != T * DM || ws_size < WS_END) { fprintf(stderr, "kernel_launch: unexpected shapes (n_in %d out %d ws %zu, need %zu)\n", n_in, out_size, ws_size, (size_t)WS_END); grid = -1; return; }
        int dev = 0, cus = 0, per_cu = 0;
        (void)hipGetDevice(&dev); (void)hipDeviceGetAttribute(&cus, hipDeviceAttributeMultiprocessorCount, dev);
        (void)hipFuncSetAttribute((const void*)mk_fwd, hipFuncAttributeMaxDynamicSharedMemorySize, LDS_BYTES);
        (void)hipOccupancyMaxActiveBlocksPerMultiprocessor(&per_cu, (const void*)mk_fwd, 512, LDS_BYTES);
        (void)hipGetLastError();
        fprintf(stderr, "kernel_launch: cus %d per_cu %d ws %zu\n", cus, per_cu, ws_size);
        grid = cus;
    }
    if (grid < 0) return;
    (void)hipMemsetAsync((char*)d_ws + WS_CTL, 0, CTL_BYTES, stream);
    Args a{};
    for (int i = 0; i < 31; ++i) a.in[i] = (const float*)d_in[i];
    a.out = (float*)d_out; a.ws = (unsigned char*)d_ws;
    void* kargs[] = {&a};
    hipError_t e = hipLaunchCooperativeKernel((const void*)mk_fwd, dim3(grid), dim3(512), kargs, LDS_BYTES, stream);
    if (e != hipSuccess) fprintf(stderr, "cooperative launch failed: %s (grid %d)\n", hipGetErrorString(e), grid);
}
```

```cpp
#include <hip/hip_runtime.h>
#include <hip/hip_cooperative_groups.h>
#include <cstdio>
#include <cstdint>
#include <cmath>
namespace pg8 {
#define PG8_LAS __attribute__((address_space(3)))
typedef unsigned short bf16_t;
typedef short bf16x8 __attribute__((ext_vector_type(8)));
typedef float f32x4 __attribute__((ext_vector_type(4)));
typedef unsigned u32x4 __attribute__((ext_vector_type(4)));
constexpr int BM = 256, BK = 64, HALF = 128, HTB = HALF * BK * 2  , STAGE_BYTES = 8 * HTB, NXCD = 8, WGM = 8;

__host__ __device__ __forceinline__ int lds_byte(int r, int c) { const int st = (r >> 4) * 2 + (c >> 5), rr = r & 15, cc = c & 31, ob = rr * 64 + cc * 2; return st * 1024 + (ob ^ (((ob >> 9) & 1) << 5)); }
__host__ __device__ __forceinline__ void stage_rc(int b, int& R, int& C) { const int st = b / 1024, sb = b % 1024, swz = sb ^ (((sb >> 9) & 1) << 5); R = (st >> 1) * 16 + swz / 64; C = (st & 1) * 32 + (swz % 64) / 2; }
__host__ __device__ __forceinline__ int perm32(int rho) { const int n = rho >> 4, i = rho & 15; return 8 * (i >> 2) + 4 * n + (i & 3); }

struct Unit { int pm, pn; };
struct Gemm { const bf16_t* A; const bf16_t* Bt; int M, N, K; };

struct StaticOrder {
    int nM, nN, nwg, G, c;
    __host__ __device__ void init(int M, int N, int G_, int c_) { nM = M / BM; nN = N / BM; nwg = nM * nN; G = G_; c = c_; }
    __host__ __device__ bool next(int i, Unit& u) const {
        const long L = (long)i * G + c; if (L >= nwg) return false;
        int wgid = (int)L; { const int q = nwg / NXCD, r = nwg % NXCD, xcd = wgid % NXCD, off = wgid / NXCD; wgid = (xcd < r ? xcd * (q + 1) : r * (q + 1) + (xcd - r) * q) + off; }
        const int nig = WGM * nN, gid = wgid / nig, fm = gid * WGM, gsz = (nM - fm) < WGM ? (nM - fm) : WGM;
        u.pm = fm + ((wgid % nig) % gsz); u.pn = (wgid % nig) / gsz; return true;
    }
    __device__ __forceinline__ void a_ready(const Unit&) const {}
    __device__ __forceinline__ void done(const Unit&) const {}
};

typedef float f32x2c_t __attribute__((ext_vector_type(2))); typedef __bf16 bf16x2c_t __attribute__((ext_vector_type(2)));
__device__ __forceinline__ unsigned cvt_pk_bf16(float lo, float hi) { const f32x2c_t v = {lo, hi}; const bf16x2c_t b = __builtin_convertvector(v, bf16x2c_t); return __builtin_bit_cast(unsigned, b); }
typedef float f32x2 __attribute__((ext_vector_type(2)));
__device__ __forceinline__ float fast_sigmoid(float x) { return __builtin_amdgcn_rcpf(1.0f + __builtin_amdgcn_exp2f(-1.4426950408889634f * x)); }
struct EpiZ {
    static constexpr bool PERM = true, AFTER_DRAIN = false;
    bf16_t *q, *k, *vt, *poolz, *rwkvz; float qscale; int seq;
    __device__ __forceinline__ void operator()(const f32x4 (&acc)[2][2][4][2], const Unit& u, int wr, int wc, int fr, int fq) const {
        const int pn = u.pn;
        if (pn == 4 || pn == 5) {
            const int row0 = u.pm * BM + wr * 64 + fr, c0 = (pn - 4) * 256 + wc * 32 + 8 * fq;
#pragma unroll
            for (int ai = 0; ai < 2; ++ai)
#pragma unroll
                for (int m = 0; m < 4; ++m) { const int row = row0 + ai * HALF + m * 16, b = row / seq, tl = row - b * seq;
#pragma unroll
                    for (int bj = 0; bj < 2; ++bj) { const int c = c0 + bj * HALF, h = c >> 6, d = c & 63; bf16_t* vp = vt + ((size_t)(b * 8 + h) * 64 + d) * seq + tl;
                        const unsigned w0 = cvt_pk_bf16(acc[ai][bj][m][0][0], acc[ai][bj][m][0][1]), w1 = cvt_pk_bf16(acc[ai][bj][m][0][2], acc[ai][bj][m][0][3]);
                        const unsigned w2 = cvt_pk_bf16(acc[ai][bj][m][1][0], acc[ai][bj][m][1][1]), w3 = cvt_pk_bf16(acc[ai][bj][m][1][2], acc[ai][bj][m][1][3]);
                        vp[0] = (bf16_t)(w0 & 0xffffu); vp[(size_t)seq] = (bf16_t)(w0 >> 16); vp[(size_t)2 * seq] = (bf16_t)(w1 & 0xffffu); vp[(size_t)3 * seq] = (bf16_t)(w1 >> 16);
                        vp[(size_t)4 * seq] = (bf16_t)(w2 & 0xffffu); vp[(size_t)5 * seq] = (bf16_t)(w2 >> 16); vp[(size_t)6 * seq] = (bf16_t)(w3 & 0xffffu); vp[(size_t)7 * seq] = (bf16_t)(w3 >> 16); } }
            return;
        }
        bf16_t* base; int ldc, colt, climit; float sc = 1.f;
        if (pn < 2) { base = q; ldc = 512; colt = pn * 256; climit = 512; sc = qscale; }
        else if (pn < 4) { base = k; ldc = 512; colt = (pn - 2) * 256; climit = 512; }
        else if (pn < 8) { base = poolz; ldc = 512; colt = (pn - 6) * 256; climit = 512; }
        else { base = rwkvz; ldc = 1824; colt = (pn - 8) * 256; climit = 1824; }
        const int row0 = u.pm * BM + wr * 64 + fr, col0 = colt + wc * 32 + 8 * fq;
#pragma unroll
        for (int ai = 0; ai < 2; ++ai)
#pragma unroll
            for (int m = 0; m < 4; ++m) { bf16_t* rowp = base + (size_t)(row0 + ai * HALF + m * 16) * ldc + col0;
#pragma unroll
                for (int bj = 0; bj < 2; ++bj) { if (col0 + bj * HALF < climit) { const f32x4 v0 = acc[ai][bj][m][0] * sc, v1 = acc[ai][bj][m][1] * sc;
                    u32x4 w; w.x = cvt_pk_bf16(v0[0], v0[1]); w.y = cvt_pk_bf16(v0[2], v0[3]); w.z = cvt_pk_bf16(v1[0], v1[1]); w.w = cvt_pk_bf16(v1[2], v1[3]);
                    *(u32x4*)(rowp + bj * HALF) = w; } } }
    }
};
typedef unsigned u32x2e __attribute__((ext_vector_type(2)));
struct EpiGate {
    static constexpr bool PERM = true, AFTER_DRAIN = false;
    unsigned char* O; int ldc;
    __device__ __forceinline__ void operator()(const f32x4 (&acc)[2][2][4][2], const Unit& u, int wr, int wc, int fr, int fq) const {
        const int row0 = u.pm * BM + wr * 64 + fr, col0 = u.pn * BM + wc * 32 + 8 * fq;
#pragma unroll
        for (int ai = 0; ai < 2; ++ai)
#pragma unroll
            for (int m = 0; m < 4; ++m) { unsigned char* rowp = O + (size_t)(row0 + ai * HALF + m * 16) * ldc + col0;
#pragma unroll
                for (int bj = 0; bj < 2; ++bj) { const f32x4 v0 = acc[ai][bj][m][0], v1 = acc[ai][bj][m][1]; unsigned q[8];
#pragma unroll
                    for (int e = 0; e < 4; ++e) { q[e] = (unsigned)(fast_sigmoid(v0[e]) * 255.0f + 0.5f); q[4 + e] = (unsigned)(fast_sigmoid(v1[e]) * 255.0f + 0.5f); }
                    *(u32x2e*)(rowp + bj * HALF) = (u32x2e){q[0] | (q[1] << 8) | (q[2] << 16) | (q[3] << 24), q[4] | (q[5] << 8) | (q[6] << 16) | (q[7] << 24)}; } }
    }
};
__device__ __forceinline__ float bflo(unsigned w) { return __uint_as_float(w << 16); }
__device__ __forceinline__ float bfhi(unsigned w) { return __uint_as_float(w & 0xffff0000u); }
template <bool FIRST> struct EpiMerge {
    static constexpr bool PERM = true, AFTER_DRAIN = false;
    bf16_t* O; int ldc; const unsigned char* gate; int ldg, goff;
    __device__ __forceinline__ void operator()(const f32x4 (&acc)[2][2][4][2], const Unit& u, int wr, int wc, int fr, int fq) const {
        const int row0 = u.pm * BM + wr * 64 + fr, col0 = u.pn * BM + wc * 32 + 8 * fq;
#pragma unroll
        for (int ai = 0; ai < 2; ++ai)
#pragma unroll
            for (int m = 0; m < 4; ++m) { const size_t r = (size_t)(row0 + ai * HALF + m * 16); bf16_t* rowp = O + r * ldc + col0; const unsigned char* gp = gate + r * ldg + goff + col0;
#pragma unroll
                for (int bj = 0; bj < 2; ++bj) { const f32x4 v0 = acc[ai][bj][m][0], v1 = acc[ai][bj][m][1];
                    const u32x2e g = *(const u32x2e*)(gp + bj * HALF); const float s = 1.0f / 255.0f;
                    float o[8] = {v0[0] * (float)(g.x & 255u) * s, v0[1] * (float)((g.x >> 8) & 255u) * s, v0[2] * (float)((g.x >> 16) & 255u) * s, v0[3] * (float)(g.x >> 24) * s,
                                  v1[0] * (float)(g.y & 255u) * s, v1[1] * (float)((g.y >> 8) & 255u) * s, v1[2] * (float)((g.y >> 16) & 255u) * s, v1[3] * (float)(g.y >> 24) * s};
                    if (!FIRST) { const u32x4 p = *(const u32x4*)(rowp + bj * HALF);
                        o[0] += bflo(p.x); o[1] += bfhi(p.x); o[2] += bflo(p.y); o[3] += bfhi(p.y); o[4] += bflo(p.z); o[5] += bfhi(p.z); o[6] += bflo(p.w); o[7] += bfhi(p.w); }
                    u32x4 w; w.x = cvt_pk_bf16(o[0], o[1]); w.y = cvt_pk_bf16(o[2], o[3]); w.z = cvt_pk_bf16(o[4], o[5]); w.w = cvt_pk_bf16(o[6], o[7]);
                    *(u32x4*)(rowp + bj * HALF) = w; } }
    }
};
struct EpiResF32 {
    static constexpr bool PERM = false, AFTER_DRAIN = false;
    const float* base; float* out; int ldc;
    __device__ __forceinline__ void operator()(const f32x4 (&acc)[2][2][4][2], const Unit& u, int wr, int wc, int fr, int fq) const {
        const int row0 = u.pm * BM + wr * 64 + fr, col0 = u.pn * BM + wc * 32 + 4 * fq;
#pragma unroll
        for (int ai = 0; ai < 2; ++ai)
#pragma unroll
            for (int m = 0; m < 4; ++m) { const size_t off = (size_t)(row0 + ai * HALF + m * 16) * ldc + col0;
#pragma unroll
                for (int bj = 0; bj < 2; ++bj)
#pragma unroll
                    for (int n = 0; n < 2; ++n) { const f32x4 bs = *(const f32x4*)(base + off + bj * HALF + n * 16); *(f32x4*)(out + off + bj * HALF + n * 16) = bs + acc[ai][bj][m][n]; } }
    }
};
struct EpiSwiGLU {
    static constexpr bool PERM = true, AFTER_DRAIN = false;
    bf16_t* O;
    __device__ __forceinline__ void operator()(const f32x4 (&acc)[2][2][4][2], const Unit& u, int wr, int wc, int fr, int fq) const {
        const int row0 = u.pm * BM + wr * 64 + fr, col0 = (u.pn & 3) * 128 + wc * 32 + 8 * fq;
#pragma unroll
        for (int ai = 0; ai < 2; ++ai)
#pragma unroll
            for (int m = 0; m < 4; ++m) { bf16_t* rowp = O + (size_t)(row0 + ai * HALF + m * 16) * 512 + col0;
                float o[8];
#pragma unroll
                for (int n = 0; n < 2; ++n)
#pragma unroll
                    for (int e = 0; e < 4; ++e) { const float a1 = acc[ai][0][m][n][e], a3 = acc[ai][1][m][n][e]; o[n * 4 + e] = a1 * fast_sigmoid(a1) * a3; }
                u32x4 w; w.x = cvt_pk_bf16(o[0], o[1]); w.y = cvt_pk_bf16(o[2], o[3]); w.z = cvt_pk_bf16(o[4], o[5]); w.w = cvt_pk_bf16(o[6], o[7]);
                *(u32x4*)rowp = w; }
    }
};
struct EpiY {
    static constexpr bool PERM = true, AFTER_DRAIN = false;
    bf16_t* O;
    __device__ __forceinline__ void operator()(const f32x4 (&acc)[2][2][4][2], const Unit& u, int wr, int wc, int fr, int fq) const {
        const int row0 = u.pm * BM + wr * 64 + fr, col0 = (u.pn & 3) * BM + wc * 32 + 8 * fq;
#pragma unroll
        for (int ai = 0; ai < 2; ++ai)
#pragma unroll
            for (int m = 0; m < 4; ++m) { bf16_t* rowp = O + (size_t)(row0 + ai * HALF + m * 16) * 1024 + col0;
#pragma unroll
                for (int bj = 0; bj < 2; ++bj) { const f32x4 v0 = acc[ai][bj][m][0], v1 = acc[ai][bj][m][1];
                    u32x4 w; w.x = cvt_pk_bf16(v0[0], v0[1]); w.y = cvt_pk_bf16(v0[2], v0[3]); w.z = cvt_pk_bf16(v1[0], v1[1]); w.w = cvt_pk_bf16(v1[2], v1[3]);
                    *(u32x4*)(rowp + bj * HALF) = w; } }
    }
};
struct MoeOrder {
    const PG8_LAS unsigned char* tile_e; int nunits, G, c;
    __device__ __forceinline__ bool next(int i, Unit& u) const {
        const int L = i * G + c; if (L >= nunits) return false;
        const int pm = L >> 2; u.pm = pm; u.pn = __builtin_amdgcn_readfirstlane((int)tile_e[pm]) * 4 + (L & 3); return true;
    }
    __device__ __forceinline__ void a_ready(const Unit&) const {}
    __device__ __forceinline__ void done(const Unit&) const {}
};
template <class Epi, class Sched, bool ALIGN_EPI = false, bool SP2 = false>
__device__ __forceinline__ void gemm_phase(PG8_LAS unsigned char* lds, const Gemm g, const Sched& S, const Epi& E) {
    int tid = threadIdx.x; asm volatile("" : "+v"(tid));
    const int wid = __builtin_amdgcn_readfirstlane(tid >> 6), lane = tid & 63, wr = wid >> 2, wc = wid & 3, fr = lane & 15, fq = lane >> 4;
    const int K = g.K, nt = K / BK;
    unsigned voffA[2], voffB[2];
#pragma unroll
    for (int i = 0; i < 2; ++i) { int R, C; stage_rc(tid * 16 + i * 8192, R, C); const int Rb = Epi::PERM ? ((R & ~31) + perm32(R & 31)) : R;
        voffA[i] = (unsigned)(R * K + C) * 2u; voffB[i] = (unsigned)(Rb * K + C) * 2u; }
    const size_t kstep = (size_t)(BK * 2);
    const size_t hstep = (size_t)HALF * K * 2;
    const size_t tstep = 2 * hstep;
    const unsigned ldsw = (unsigned)wid * 1024u;
    const int aoff = lds_byte(wr * 64 + fr, fq * 8), boff = lds_byte(wc * 32 + fr, fq * 8);
#define PG8_SA(b, h) (((b) * 2 + (h)) * HTB)
#define PG8_SB(b, h) ((4 + (b) * 2 + (h)) * HTB)
#define PG8_STAGE(bufoff, gbase, voff) do { _Pragma("unroll") for (int _i = 0; _i < 2; ++_i) \
        __builtin_amdgcn_global_load_lds((const unsigned*)((const char*)(gbase) + (voff)[_i]), (PG8_LAS unsigned*)(lds + (bufoff) + ldsw + _i * 8192), 16, 0, 0); } while (0)
#define PG8_LDA(dst, b, h) do { _Pragma("unroll") for (int m = 0; m < 4; ++m) _Pragma("unroll") for (int k = 0; k < 2; ++k) dst[m][k] = *(const PG8_LAS bf16x8*)(lds + PG8_SA(b, h) + aoff + m * 2048 + k * 1024); } while (0)
#define PG8_LDB(dst, b, h) do { _Pragma("unroll") for (int n = 0; n < 2; ++n) _Pragma("unroll") for (int k = 0; k < 2; ++k) dst[n][k] = *(const PG8_LAS bf16x8*)(lds + PG8_SB(b, h) + boff + n * 2048 + k * 1024); } while (0)
#define PG8_MMA(ai, bj, At, Bt) do { __builtin_amdgcn_s_setprio(1); _Pragma("unroll") for (int m = 0; m < 4; ++m) _Pragma("unroll") for (int n = 0; n < 2; ++n) _Pragma("unroll") for (int k = 0; k < 2; ++k) \
        acc[ai][bj][m][n] = __builtin_amdgcn_mfma_f32_16x16x32_bf16(Bt[n][k], At[m][k], acc[ai][bj][m][n], 0, 0, 0); __builtin_amdgcn_s_setprio(0); } while (0)
#define PG8_WAIT_V(n) asm volatile("s_waitcnt vmcnt(" #n ")" ::: "memory")
#define PG8_WAIT_L(n) asm volatile("s_waitcnt lgkmcnt(" #n ")" ::: "memory")
#define PG8_BAR __builtin_amdgcn_s_barrier()
#define PG8_SCHED __builtin_amdgcn_sched_barrier(0)
    Unit cur, nxt; int ui = 0;
    if (!S.next(0, cur)) return;
    f32x4 acc[2][2][4][2];
#pragma unroll
    for (int a = 0; a < 2; ++a)
#pragma unroll
        for (int b = 0; b < 2; ++b)
#pragma unroll
            for (int m = 0; m < 4; ++m)
#pragma unroll
                for (int n = 0; n < 2; ++n) acc[a][b][m][n] = (f32x4){0.f, 0.f, 0.f, 0.f};
    bf16x8 At[4][2], B0[2][2], B1[2][2];
    const char* cA = (const char*)g.A + (size_t)cur.pm * tstep; const char* cB = (const char*)g.Bt + (size_t)cur.pn * tstep;
    S.a_ready(cur);
    if constexpr (SP2) {
        PG8_STAGE(PG8_SB(0, 0), cB, voffB); PG8_STAGE(PG8_SB(0, 1), cB + hstep, voffB); PG8_STAGE(PG8_SA(0, 0), cA, voffA); PG8_STAGE(PG8_SA(0, 1), cA + hstep, voffA);
        if (wr == 1) PG8_BAR;
        PG8_WAIT_V(2); PG8_BAR;
        PG8_STAGE(PG8_SB(1, 0), cB + kstep, voffB); PG8_STAGE(PG8_SA(1, 0), cA + kstep, voffA); PG8_STAGE(PG8_SB(1, 1), cB + hstep + kstep, voffB);
        PG8_WAIT_V(6); PG8_BAR;
    } else {
        PG8_STAGE(PG8_SB(0, 0), cB, voffB); PG8_STAGE(PG8_SA(0, 0), cA, voffA); PG8_STAGE(PG8_SB(0, 1), cB + hstep, voffB); PG8_STAGE(PG8_SA(0, 1), cA + hstep, voffA);
        if (wr == 1) PG8_BAR;
        PG8_WAIT_V(4); PG8_BAR;
        PG8_STAGE(PG8_SB(1, 0), cB + kstep, voffB); PG8_STAGE(PG8_SA(1, 0), cA + kstep, voffA); PG8_STAGE(PG8_SB(1, 1), cB + hstep + kstep, voffB);
        PG8_WAIT_V(6); PG8_BAR;
    }
    for (;;) {
        const bool has_next = S.next(ui + 1, nxt);
        const char* nA = has_next ? (const char*)g.A + (size_t)nxt.pm * tstep : cA; const char* nB = has_next ? (const char*)g.Bt + (size_t)nxt.pn * tstep : cB;
        for (int t = 0; t < nt; t += 2) {
            const bool last = (t == nt - 2);
            const char* a1 = cA + (size_t)(t + 1) * kstep;
            const char* a2 = last ? nA : cA + (size_t)(t + 2) * kstep; const char* b2 = last ? nB : cB + (size_t)(t + 2) * kstep;
            const char* a3 = a2 + kstep; const char* b3 = b2 + kstep;
            if (last && has_next) S.a_ready(nxt);
            if constexpr (SP2) {
            PG8_LDB(B0, 0, 0); PG8_LDB(B1, 0, 1); PG8_SCHED; PG8_LDA(At, 0, 0); PG8_STAGE(PG8_SA(1, 1), a1 + hstep, voffA);
            PG8_WAIT_V(8); PG8_WAIT_L(0); PG8_BAR; PG8_MMA(0, 0, At, B0); PG8_MMA(0, 1, At, B1); PG8_BAR; PG8_SCHED;
            PG8_LDA(At, 0, 1); PG8_STAGE(PG8_SB(0, 0), b2, voffB); PG8_STAGE(PG8_SB(0, 1), b2 + hstep, voffB); PG8_STAGE(PG8_SA(0, 0), a2, voffA);
            PG8_WAIT_V(8); PG8_WAIT_L(0); PG8_BAR; PG8_MMA(1, 0, At, B0); PG8_MMA(1, 1, At, B1); PG8_BAR; PG8_SCHED;
            PG8_LDB(B0, 1, 0); PG8_LDB(B1, 1, 1); PG8_SCHED; PG8_LDA(At, 1, 0); PG8_STAGE(PG8_SA(0, 1), a2 + hstep, voffA);
            PG8_WAIT_V(8); PG8_WAIT_L(0); PG8_BAR; PG8_MMA(0, 0, At, B0); PG8_MMA(0, 1, At, B1); PG8_BAR; PG8_SCHED;
            PG8_LDA(At, 1, 1); PG8_STAGE(PG8_SB(1, 0), b3, voffB); PG8_STAGE(PG8_SB(1, 1), b3 + hstep, voffB); PG8_STAGE(PG8_SA(1, 0), a3, voffA);
            PG8_WAIT_V(8); PG8_WAIT_L(0); PG8_BAR; PG8_MMA(1, 0, At, B0); PG8_MMA(1, 1, At, B1); PG8_BAR; PG8_SCHED;
            } else {
            PG8_LDB(B0, 0, 0); PG8_SCHED; PG8_LDA(At, 0, 0); PG8_STAGE(PG8_SA(1, 1), a1 + hstep, voffA);
            PG8_WAIT_L(8); PG8_BAR; PG8_WAIT_L(0); PG8_MMA(0, 0, At, B0); PG8_BAR; PG8_SCHED;
            PG8_LDB(B1, 0, 1); PG8_STAGE(PG8_SB(0, 0), b2, voffB);
            PG8_BAR; PG8_WAIT_L(0); PG8_MMA(0, 1, At, B1); PG8_BAR;
            PG8_LDA(At, 0, 1); PG8_STAGE(PG8_SA(0, 0), a2, voffA);
            PG8_BAR; PG8_WAIT_L(0); PG8_MMA(1, 0, At, B0); PG8_BAR; PG8_SCHED;
            PG8_STAGE(PG8_SB(0, 1), b2 + hstep, voffB);
            PG8_WAIT_V(6); PG8_BAR; PG8_MMA(1, 1, At, B1); PG8_BAR;
            PG8_LDB(B0, 1, 0); PG8_SCHED; PG8_LDA(At, 1, 0); PG8_STAGE(PG8_SA(0, 1), a2 + hstep, voffA);
            PG8_WAIT_L(8); PG8_BAR; PG8_WAIT_L(0); PG8_MMA(0, 0, At, B0); PG8_BAR; PG8_SCHED;
            PG8_LDB(B1, 1, 1); PG8_STAGE(PG8_SB(1, 0), b3, voffB);
            PG8_BAR; PG8_WAIT_L(0); PG8_MMA(0, 1, At, B1); PG8_BAR;
            PG8_LDA(At, 1, 1); PG8_STAGE(PG8_SA(1, 0), a3, voffA);
            PG8_BAR; PG8_WAIT_L(0); PG8_MMA(1, 0, At, B0); PG8_BAR; PG8_SCHED;
            PG8_STAGE(PG8_SB(1, 1), b3 + hstep, voffB);
            PG8_WAIT_V(6); PG8_BAR; PG8_MMA(1, 1, At, B1); PG8_BAR;
            }
        }
        if constexpr (ALIGN_EPI) { if (wr == 0) PG8_BAR; }
        if constexpr (!Epi::AFTER_DRAIN) { E(acc, cur, wr, wc, fr, fq); S.done(cur); }
        if (!has_next) break;
#pragma unroll
        for (int a = 0; a < 2; ++a)
#pragma unroll
            for (int b = 0; b < 2; ++b)
#pragma unroll
                for (int m = 0; m < 4; ++m)
#pragma unroll
                    for (int n = 0; n < 2; ++n) acc[a][b][m][n] = (f32x4){0.f, 0.f, 0.f, 0.f};
        cur = nxt; cA = nA; cB = nB; ++ui;
        if constexpr (ALIGN_EPI) { if (wr == 1) PG8_BAR; }
    }
    PG8_WAIT_V(0);
    if constexpr (!ALIGN_EPI) { if (wr == 0) PG8_BAR; }
    PG8_BAR;
    if constexpr (Epi::AFTER_DRAIN) { E.fused(acc, cur, wr, wc, fr, fq, lds, wid, lane); S.done(cur); }
#undef PG8_SA
#undef PG8_SB
#undef PG8_STAGE
#undef PG8_LDA
#undef PG8_LDB
#undef PG8_MMA
#undef PG8_WAIT_V
#undef PG8_WAIT_L
#undef PG8_BAR
#undef PG8_SCHED
}
}
namespace cg = cooperative_groups;
#define DI __device__ __forceinline__
#define LAS __attribute__((address_space(3)))
typedef unsigned short bf16;
typedef float f32x4 __attribute__((ext_vector_type(4)));
typedef unsigned u32x4 __attribute__((ext_vector_type(4)));
typedef unsigned u32x2 __attribute__((ext_vector_type(2)));
typedef short bf16x8_t __attribute__((ext_vector_type(8)));

constexpr int BATCH = 2, SEQ = 16384, DM = 1024, T = BATCH * SEQ, DEPTH = 2;
constexpr int NEXP = 32, RZP = 1824;
constexpr int RMAX = 73728;
constexpr float C2 = 0.125f * 1.4426950408889634f;
constexpr float LOG2E = 1.4426950408889634f;
constexpr size_t MiB = 1u << 20;
constexpr size_t WS_CTL = 0, CTL_BYTES = 1 * MiB;
constexpr size_t WS_WIN = 1 * MiB, WS_WG = 9 * MiB, WS_WBR = 15 * MiB, WS_WOUT = 18 * MiB;
constexpr size_t WS_KMEAN = 20 * MiB, WS_RWG = 20 * MiB + 512 * 1024, WS_ROUTE = 21 * MiB, WS_RWT = 22 * MiB, WS_DEST = 22 * MiB + 512 * 1024, WS_BONUS = 23 * MiB, WS_WLT = 24 * MiB, WS_WPT = 24 * MiB + 512 * 1024, WS_WGBASE = 24 * MiB + 768 * 1024, WS_KINV = 25 * MiB, WS_PGT = 26 * MiB, WS_LG = 28 * MiB, WS_SG = 30 * MiB;
constexpr size_t WS_XB = 32 * MiB, WS_VFIRST = 96 * MiB, WS_YPOOL = 128 * MiB, WS_YATTN = 160 * MiB;
constexpr size_t WS_BIG = 192 * MiB;
constexpr size_t WS_Q = WS_BIG, WS_K = WS_BIG + 32 * MiB, WS_V = WS_BIG + 64 * MiB, WS_POOLZ = WS_BIG + 232 * MiB, WS_RWKVZ = WS_BIG + 264 * MiB;
constexpr size_t WS_AR = WS_BIG;
constexpr size_t WS_GATES = WS_BIG + 32 * MiB;
constexpr size_t WS_XPERM = WS_BIG, WS_HACT = WS_BIG + 144 * MiB, WS_W13 = WS_BIG + 216 * MiB, WS_W2 = WS_BIG + 280 * MiB, WS_YMOE = WS_BIG;
constexpr size_t WS_VT = WS_YATTN;
constexpr size_t WS_PARTO = WS_BIG + 96 * MiB, WS_PARTML = WS_BIG + 224 * MiB;
constexpr size_t WS_LIST = WS_BIG + 378 * MiB;
constexpr size_t WS_PCT = WS_BIG + 32 * MiB, WS_LC = WS_BIG + 64 * MiB, WS_RM = WS_BIG + 128 * MiB, WS_Y0 = WS_BIG + 160 * MiB, WS_S0 = WS_BIG + 352 * MiB;
constexpr int LSTRIDE = 516096;
constexpr size_t WS_END = WS_BIG + 394 * MiB;
static_assert(WS_LIST + (size_t)16 * LSTRIDE * 2 <= WS_END, "ws map");
static_assert(WS_RWKVZ + (size_t)T * RZP * 2 <= WS_END, "ws map");
static_assert(WS_W2 + (size_t)32 * 1024 * 512 * 2 <= WS_END, "ws map");
constexpr int CW_CNT = 64, CW_LCNT = 1024, CW_BAR = 4096;
constexpr int LDS_BYTES = 147456, MISC_OFF = 131072;

DI float bf2f(unsigned short u) { return __uint_as_float((unsigned)u << 16); }
DI unsigned f2bf(float f) { return pg8::cvt_pk_bf16(f, 0.f) & 0xffffu; }
DI unsigned pk2(float lo, float hi) { return pg8::cvt_pk_bf16(lo, hi); }
DI float blo(unsigned w) { return __uint_as_float(w << 16); }
DI float bhi(unsigned w) { return __uint_as_float(w & 0xffff0000u); }
DI float wave_sum(float v) {
#pragma unroll
    for (int o = 1; o < 64; o <<= 1) v += __shfl_xor(v, o);
    return v;
}
DI float wave_max(float v) {
#pragma unroll
    for (int o = 1; o < 64; o <<= 1) v = fmaxf(v, __shfl_xor(v, o));
    return v;
}
DI float fexp_(float x) { return __builtin_amdgcn_exp2f(x * 1.4426950408889634f); }
DI float frcp_(float x) { return __builtin_amdgcn_rcpf(x); }
DI float sigmoidf_(float x) { return frcp_(1.0f + fexp_(-x)); }
DI float ftanh_(float x) { return 1.0f - 2.0f * frcp_(1.0f + fexp_(2.0f * x)); }
DI float fsoftplus_(float x) { return x > 20.f ? x : __builtin_amdgcn_logf(1.0f + fexp_(x)) * 0.6931471805599453f; }
#define LDS_WAIT() asm volatile("s_waitcnt lgkmcnt(0)" ::: "memory")

#define XB_TMO      128
#define XB_XCNT(j)  (256  + 64 * (j))
#define XB_XSUB(j)  (1280 + 64 * (j))
#define XB_XGEN(j)  (2304 + 64 * (j))
#define XB_TOP      3328
#define XB_TOPGEN   3392
#define XCD_BAR_WORDS 3456
#define XB_SPIN_CAP (1u << 27)

__device__ __forceinline__ unsigned xb_ld(unsigned* p)              { return __hip_atomic_load(p, __ATOMIC_RELAXED, __HIP_MEMORY_SCOPE_AGENT); }
__device__ __forceinline__ unsigned xb_add(unsigned* p, unsigned v) { return __hip_atomic_fetch_add(p, v, __ATOMIC_RELAXED, __HIP_MEMORY_SCOPE_AGENT); }
__device__ __forceinline__ unsigned xb_xcc_id() { return (unsigned)__builtin_amdgcn_s_getreg((3 << 11) | 20) & 0xFu; }
#define XB_SPIN(cond, bar) do { unsigned _sp = 0; while (cond) { __builtin_amdgcn_s_sleep(1); \
    if ((++_sp & 255u) == 0u) { if (xb_ld(&(bar)[XB_TMO])) break; if (_sp > XB_SPIN_CAP) { atomicAdd(&(bar)[XB_TMO], 1u); break; } } } } while (0)

struct XcdBarrier {
    unsigned* bar; unsigned x;
    volatile LAS unsigned* st;
};

__device__ __forceinline__ XcdBarrier xcd_barrier_post(unsigned* bar, volatile LAS unsigned* st) {
    XcdBarrier b; b.bar = bar; b.x = xb_xcc_id(); b.st = st;
    if (threadIdx.x == 0) (void)xb_add(&bar[XB_XCNT(b.x)], 1u);
    return b;
}
__device__ __forceinline__ void xcd_barrier_complete(unsigned* bar, unsigned x, unsigned& nloc, unsigned& nx) {
    const unsigned G = gridDim.x * gridDim.y * gridDim.z;
    unsigned sum, cnt, mine, sp = 0u;
    for (;;) {
        sum = 0u; cnt = 0u; mine = 0u;
#pragma unroll
        for (unsigned j = 0; j < 16; ++j) { const unsigned c = xb_ld(&bar[XB_XCNT(j)]); sum += c; cnt += (c > 0u) ? 1u : 0u; mine = (j == x) ? c : mine; }
        if (sum == G) break;
        __builtin_amdgcn_s_sleep(1);
        if ((++sp & 255u) == 0u) { if (xb_ld(&bar[XB_TMO])) break; if (sp > XB_SPIN_CAP) { atomicAdd(&bar[XB_TMO], 1u); break; } }
    }
    nloc = mine > 0u ? mine : 1u; nx = cnt > 0u ? cnt : 1u;
}

__device__ __forceinline__ void xcd_barrier(const XcdBarrier& b) {
    asm volatile("s_waitcnt vmcnt(0)" ::: "memory");
    __syncthreads();
    if (threadIdx.x == 0) {
        unsigned* bar = b.bar;
        __builtin_amdgcn_s_waitcnt(0);
        unsigned nloc = b.st[0], nx = b.st[1];
        if (nloc == 0u) { xcd_barrier_complete(bar, b.x, nloc, nx); b.st[0] = nloc; b.st[1] = nx; }
        const unsigned old = xb_add(&bar[XB_XSUB(b.x)], 1u);
        const unsigned gen = old / nloc;
        if (old + 1u == (gen + 1u) * nloc) {
            __builtin_amdgcn_fence(__ATOMIC_RELEASE, "agent");
            asm volatile("s_waitcnt vmcnt(0)" ::: "memory");
            const unsigned og = xb_add(&bar[XB_TOP], 1u);
            const unsigned tg = og / nx;
            if (og + 1u == (tg + 1u) * nx) xb_add(&bar[XB_TOPGEN], 1u);
            else XB_SPIN(xb_ld(&bar[XB_TOPGEN]) == tg, bar);
            __builtin_amdgcn_fence(__ATOMIC_ACQUIRE, "agent");
            xb_add(&bar[XB_XGEN(b.x)], 1u);
            asm volatile("s_waitcnt vmcnt(0)" ::: "memory");
        } else {
            XB_SPIN(xb_ld(&bar[XB_XGEN(b.x)]) == gen, bar);
            __builtin_amdgcn_fence(__ATOMIC_ACQUIRE, "agent");
            asm volatile("s_waitcnt vmcnt(0)" ::: "memory");
        }
    }
    __syncthreads();
}

struct Args { const float* in[31]; float* out; unsigned char* ws; };

typedef const __attribute__((address_space(4))) unsigned long long* kargp_t;
struct Frame {
    LAS unsigned char* lds; int tid, lane, wave, G, bid;
    kargp_t kp;
};
#define GASQ __attribute__((address_space(1)))
DI const float* INP(const Frame& F, int i) { return (const float*)(const GASQ float*)F.kp[i]; }
DI float* OUTP(const Frame& F) { return (float*)(GASQ float*)F.kp[31]; }
DI unsigned char* WSP(const Frame& F) { return (unsigned char*)(GASQ unsigned char*)F.kp[32]; }
DI void fence_frame(Frame& F) {
    asm volatile("" : "+s"(F.kp) :: "memory"); asm volatile("" : "+s"(F.G)); asm volatile("" : "+s"(F.bid));
    F.tid = threadIdx.x; asm volatile("" : "+v"(F.tid)); F.lane = F.tid & 63; F.wave = __builtin_amdgcn_readfirstlane(F.tid >> 6); }

DI void transpose_item(const float* W, int ldw, int ncols, bf16* WT, int ldt, const float* scale, LAS float* scr, int item, int lane) {
    const int nblk = ncols / 32, kb = item / nblk, nb = item % nblk, k0 = 64 * kb, n0 = 32 * nb;
    { const int rs = lane >> 3, c4 = (lane & 7) * 4; f32x4 v[8]; float sc[8];
#pragma unroll
      for (int i = 0; i < 8; ++i) { v[i] = *(const f32x4*)(W + (size_t)(k0 + 8 * i + rs) * ldw + n0 + c4); sc[i] = scale ? scale[k0 + 8 * i + rs] : 1.0f; }
#pragma unroll
      for (int i = 0; i < 8; ++i) { LAS float* d = scr + (8 * i + rs) * 33 + c4; d[0] = v[i].x * sc[i]; d[1] = v[i].y * sc[i]; d[2] = v[i].z * sc[i]; d[3] = v[i].w * sc[i]; } }
    LDS_WAIT(); asm volatile("" ::: "memory");
    const int c = lane & 7;
#pragma unroll
    for (int j = 0; j < 4; ++j) { const int n = (lane >> 3) + 8 * j; const LAS float* s = scr + (8 * c) * 33 + n;
        u32x4 o; o.x = pk2(s[0 * 33], s[1 * 33]); o.y = pk2(s[2 * 33], s[3 * 33]); o.z = pk2(s[4 * 33], s[5 * 33]); o.w = pk2(s[6 * 33], s[7 * 33]);
        *(u32x4*)(WT + (size_t)(n0 + n) * ldt + k0 + 8 * c) = o; }
    LDS_WAIT(); asm volatile("" ::: "memory");
}
DI void prep_mixer_weights(Frame& F, int l) {
    LAS float* scr = (LAS float*)(F.lds + F.wave * 16384);
    const int gw = F.bid * 8 + F.wave, NGW = F.G * 8;
    const float* w_in = INP(F, 2) + (size_t)l * 1024 * 6912; const float* g1 = INP(F, 1) + l * 1024;
    bf16* WIN = (bf16*)(WSP(F) + WS_WIN); bf16* WG = (bf16*)(WSP(F) + WS_WG); bf16* WBR = (bf16*)(WSP(F) + WS_WBR); bf16* WOUT = (bf16*)(WSP(F) + WS_WOUT);
    constexpr int I1 = 16 * (1536 / 32), I2 = 16 * (2304 / 32), I3 = 16 * 1, I4 = 16 * (3072 / 32), I5 = 8 * (1024 / 32), I6 = 16 * (1024 / 32);
    const int n3 = l > 0 ? I3 : 0;
    const int total = I1 + I2 + n3 + I4 + 3 * I5 + I6;
    for (int it = gw; it < total; it += NGW) {
        int r = it;
        if (r < I1) { transpose_item(w_in, 6912, 1536, WIN, 1024, g1, scr, r, F.lane); continue; } r -= I1;
        if (r < I2) { transpose_item(w_in + 4608, 6912, 2304, WIN + (size_t)1536 * 1024, 1024, g1, scr, r, F.lane); continue; } r -= I2;
        if (r < n3) { transpose_item(INP(F, 3) + (size_t)(l - 1) * 1024 * 32, 32, 32, WIN + (size_t)3840 * 1024, 1024, g1, scr, r, F.lane); continue; } r -= n3;
        if (r < I4) { transpose_item(w_in + 1536, 6912, 3072, WG, 1024, g1, scr, r, F.lane); continue; } r -= I4;
        if (r < 3 * I5) { const int i = r / I5; transpose_item(INP(F, 20) + (size_t)(l * 3 + i) * 512 * 1024, 1024, 1024, WBR + (size_t)i * 1024 * 512, 512, i == 2 ? INP(F, 19) + l * 512 : nullptr, scr, r % I5, F.lane); continue; } r -= 3 * I5;
        transpose_item(INP(F, 21) + (size_t)l * 1024 * 1024, 1024, 1024, WOUT, 1024, nullptr, scr, r, F.lane);
    }
    if (l > 0) {
        u32x4* z = (u32x4*)(WIN + (size_t)3872 * 1024); const int n16 = 224 * 1024 * 2 / 16;
        for (int i = F.bid * 512 + F.tid; i < n16; i += F.G * 512) z[i] = (u32x4){0u, 0u, 0u, 0u};
    }
    { bf16* WPT = (bf16*)(WSP(F) + WS_WPT);
      for (int it = gw; it < 32; it += NGW) transpose_item(INP(F, 18) + (size_t)(l * 4 + (it >> 3)) * 128 * 128, 128, 128, WPT + (size_t)(it >> 3) * 128 * 128, 128, nullptr, scr, it & 7, F.lane); }
    { bf16* WLT = (bf16*)(WSP(F) + WS_WLT);
      constexpr int L1 = 1 * 16, L2 = 1 * 16, L3 = 2 * 16;
      for (int it = gw; it < L1 + L2 + L3; it += NGW) {
          if (it < L1) transpose_item(INP(F, 7) + (size_t)l * 64 * 512, 512, 512, WLT, 288, nullptr, scr, it, F.lane);
          else if (it < L1 + L2) transpose_item(INP(F, 9) + (size_t)l * 64 * 512, 512, 512, WLT + 64, 288, nullptr, scr, it - L1, F.lane);
          else transpose_item(INP(F, 10) + (size_t)l * 128 * 512, 512, 512, WLT + 128, 288, nullptr, scr, it - L1 - L2, F.lane); }
      const float* wv = INP(F, 17) + (size_t)(l > 0 ? l - 1 : 0) * 32 * 512;
      for (int i = F.bid * 512 + F.tid; i < 32 * 512; i += F.G * 512) { const int k = i >> 9, ch = i & 511; WLT[(size_t)ch * 288 + 256 + k] = (bf16)f2bf(l > 0 ? wv[k * 512 + ch] : 0.f); } }
    { bf16* RWH = (bf16*)(WSP(F) + WS_RWG); bf16* RWL = RWH + 48 * 1024; const float* g2 = INP(F, 22) + l * 1024; const float* rgw = INP(F, 23) + (size_t)l * 1024 * 4; const float* rew = INP(F, 25) + (size_t)l * 1024 * 32;
      for (int i = F.bid * 512 + F.tid; i < 48 * 1024; i += F.G * 512) { const int r = i >> 10, k = i & 1023;
          const float w = r < 16 ? rgw[k * 4 + (r & 3)] : r < 32 ? rew[k * 32 + 8 * ((r - 16) >> 2) + ((r - 16) & 3)] : rew[k * 32 + 8 * ((r - 32) >> 2) + 4 + ((r - 32) & 3)];
          const float v = g2[k] * w; const unsigned hb = f2bf(v); const float hf = __uint_as_float(hb << 16); RWH[i] = (bf16)hb; RWL[i] = (bf16)f2bf(v - hf); } }
}
DI void prep_expert_weights(Frame& F, int l) {
    LAS float* scr = (LAS float*)(F.lds + F.wave * 16384);
    const int gw = F.bid * 8 + F.wave, NGW = F.G * 8;
    const float* g2 = INP(F, 22) + l * 1024;
    bf16* W13 = (bf16*)(WSP(F) + WS_W13); bf16* W2 = (bf16*)(WSP(F) + WS_W2);
    constexpr int J13 = 64, N13 = NEXP * 2 * 4 * J13, J2 = 8 * 32, N2 = NEXP * J2;
    for (int it = gw; it < N13 + N2; it += NGW) {
        if (it < N13) { const int job = it / J13, item = it % J13, e = job >> 3, which = (job >> 2) & 1, grp = job & 3;
            const float* src = (which ? INP(F, 28) : INP(F, 27)) + ((size_t)(l * NEXP + e) * 1024) * 512 + grp * 128;
            transpose_item(src, 512, 128, W13 + ((size_t)e * 1024 + grp * 256 + which * 128) * 1024, 1024, g2, scr, item, F.lane);
        } else { const int r = it - N13, e = r / J2, item = r % J2;
            transpose_item(INP(F, 29) + (size_t)(l * NEXP + e) * 512 * 1024, 1024, 1024, W2 + (size_t)e * 1024 * 512, 512, nullptr, scr, item, F.lane); }
    }
}
DI void rms_rows_to_bf16(Frame& F, const float* x, bf16* xb) {
    const int gw = F.bid * 8 + F.wave, NGW = F.G * 8;
    for (int t = gw; t < T; t += NGW) {
        const f32x4* xr = (const f32x4*)(x + (size_t)t * DM) + F.lane; f32x4 v[4]; float s = 0.f;
#pragma unroll
        for (int j = 0; j < 4; ++j) { v[j] = xr[64 * j]; s += (v[j].x * v[j].x + v[j].y * v[j].y) + (v[j].z * v[j].z + v[j].w * v[j].w); }
        const float rs = rsqrtf(wave_sum(s) * (1.f / DM) + 1e-6f);
        u32x2* o = (u32x2*)(xb + (size_t)t * DM) + F.lane;
#pragma unroll
        for (int j = 0; j < 4; ++j) o[64 * j] = (u32x2){pk2(v[j].x * rs, v[j].y * rs), pk2(v[j].z * rs, v[j].w * rs)};
    }
}

DI void kmean_phase(Frame& F) {
    const bf16* K = (const bf16*)(WSP(F) + WS_K); float* kmean = (float*)(WSP(F) + WS_KMEAN);
    LAS float* red = (LAS float*)F.lds;
    for (int it = F.bid; it < BATCH * 8 * 64; it += F.G) {
        const int b = it >> 9, h = (it >> 6) & 7, n = it & 63, c8 = F.tid & 7, rg = F.tid >> 3;
        const bf16* kp = K + ((size_t)b * SEQ + n * 256 + rg * 4) * 512 + h * 64 + c8 * 8; float s[8] = {0.f, 0.f, 0.f, 0.f, 0.f, 0.f, 0.f, 0.f};
        u32x4 w[4];
#pragma unroll
        for (int i = 0; i < 4; ++i) w[i] = *(const u32x4*)(kp + (size_t)i * 512);
#pragma unroll
        for (int i = 0; i < 4; ++i) { s[0] += blo(w[i].x); s[1] += bhi(w[i].x); s[2] += blo(w[i].y); s[3] += bhi(w[i].y); s[4] += blo(w[i].z); s[5] += bhi(w[i].z); s[6] += blo(w[i].w); s[7] += bhi(w[i].w); }
        *(LAS f32x4*)(red + rg * 68 + c8 * 8) = (f32x4){s[0], s[1], s[2], s[3]}; *(LAS f32x4*)(red + rg * 68 + c8 * 8 + 4) = (f32x4){s[4], s[5], s[6], s[7]};
        __syncthreads();
        if (F.tid < 64) { float a = 0.f;
#pragma unroll 16
            for (int p = 0; p < 64; ++p) a += red[p * 68 + F.tid];
            kmean[(size_t)it * 64 + F.tid] = a * (1.f / 256.f); }
        __syncthreads();
    }
}
DI void vt_phase(Frame& F) {
    const bf16* V = (const bf16*)(WSP(F) + WS_V); bf16* VT = (bf16*)(WSP(F) + WS_VT);
    LAS bf16* tl = (LAS bf16*)(F.lds + 20480 + F.wave * 9216);
    const int gw = F.bid * 8 + F.wave, NGW = F.G * 8, lane = F.lane;
    for (int it = gw; it < BATCH * 8 * (SEQ / 64); it += NGW) {
        const int bh = it / (SEQ / 64), tt = it % (SEQ / 64), b = bh >> 3, h = bh & 7, t0 = tt * 64;
#pragma unroll
        for (int i = 0; i < 8; ++i) { const int r = i * 8 + (lane >> 3), c = lane & 7;
            const u32x4 w = *(const u32x4*)(V + ((size_t)b * SEQ + t0 + r) * 512 + h * 64 + c * 8); *(LAS u32x4*)(tl + r * 72 + c * 8) = w; }
        LDS_WAIT(); asm volatile("" ::: "memory");
#pragma unroll
        for (int i = 0; i < 8; ++i) { const int d = i * 8 + (lane >> 3), c = lane & 7; unsigned short e[8];
#pragma unroll
            for (int k = 0; k < 8; ++k) e[k] = tl[(8 * c + k) * 72 + d];
            u32x4 w; w.x = e[0] | ((unsigned)e[1] << 16); w.y = e[2] | ((unsigned)e[3] << 16); w.z = e[4] | ((unsigned)e[5] << 16); w.w = e[6] | ((unsigned)e[7] << 16);
            *(u32x4*)(VT + ((size_t)bh * 64 + d) * SEQ + t0 + c * 8) = w; }
        LDS_WAIT(); asm volatile("" ::: "memory");
    }
}
DI int list_off(int n) { return n * SEQ - 128 * n * (n + 1); }
DI void sel_phase(Frame& F, int l) {
    const bf16* Q = (const bf16*)(WSP(F) + WS_Q); const float* kmean = (const float*)(WSP(F) + WS_KMEAN);
    unsigned short* list = (unsigned short*)(WSP(F) + WS_LIST); unsigned* lcnt = (unsigned*)(WSP(F) + WS_CTL) + CW_LCNT + 1024 * l;
    LAS float* km = (LAS float*)F.lds;
    for (int it = F.bid; it < BATCH * 8 * (SEQ / 512); it += F.G) {
        const int pr = it % 256, bh = pr >> 4, g = (it < 256) ? (pr & 15) : 31 - (pr & 15), b = bh >> 3, h = bh & 7;
        __syncthreads();
        for (int i = F.tid; i < 1024; i += 512) ((LAS f32x4*)km)[i] = ((const f32x4*)(kmean + (size_t)bh * 4096))[i];
        __syncthreads();
        const int tl = g * 512 + F.tid, own = __builtin_amdgcn_readfirstlane(tl >> 8);
        float q[64];
        { const u32x4* qp = (const u32x4*)(Q + ((size_t)b * SEQ + tl) * 512 + h * 64);
#pragma unroll
          for (int c = 0; c < 8; ++c) { const u32x4 w = qp[c]; q[8 * c] = blo(w.x); q[8 * c + 1] = bhi(w.x); q[8 * c + 2] = blo(w.y); q[8 * c + 3] = bhi(w.y); q[8 * c + 4] = blo(w.z); q[8 * c + 5] = bhi(w.z); q[8 * c + 6] = blo(w.w); q[8 * c + 7] = bhi(w.w); } }
        float v0 = -INFINITY, v1 = -INFINITY, v2 = -INFINITY; int i0 = -1, i1 = -1, i2 = -1;
        for (int n = 0; n < own; ++n) { const LAS f32x4* kp = (const LAS f32x4*)(km + n * 64); float s0 = 0.f, s1 = 0.f;
#pragma unroll
            for (int i = 0; i < 16; i += 2) { const f32x4 a = kp[i], c = kp[i + 1];
                s0 += q[4 * i] * a.x + q[4 * i + 1] * a.y + q[4 * i + 2] * a.z + q[4 * i + 3] * a.w; s1 += q[4 * i + 4] * c.x + q[4 * i + 5] * c.y + q[4 * i + 6] * c.z + q[4 * i + 7] * c.w; }
            const float gte = s0 + s1; const bool c0 = gte > v0, c1 = gte > v1, c2 = gte > v2;
            v2 = c1 ? v1 : (c2 ? gte : v2); i2 = c1 ? i1 : (c2 ? n : i2);
            v1 = c0 ? v0 : (c1 ? gte : v1); i1 = c0 ? i0 : (c1 ? n : i1);
            v0 = c0 ? gte : v0; i0 = c0 ? n : i0; }
        LAS unsigned* lc = (LAS unsigned*)(F.lds + MISC_OFF + 8192); LAS unsigned* lbase = lc + 64;
        if (F.tid < 64) lc[F.tid] = 0u;
        __syncthreads();
        unsigned r0 = 0u, r1 = 0u, r2 = 0u;
        if (i0 >= 0) r0 = atomicAdd((unsigned*)(lc + i0), 1u);
        if (i1 >= 0) r1 = atomicAdd((unsigned*)(lc + i1), 1u);
        if (i2 >= 0) r2 = atomicAdd((unsigned*)(lc + i2), 1u);
        __syncthreads();
        if (F.tid < 64) { const unsigned c = lc[F.tid]; lbase[F.tid] = c ? atomicAdd(lcnt + bh * 64 + F.tid, c) : 0u; }
        __syncthreads();
        unsigned short* lb = list + (size_t)bh * LSTRIDE;
        if (i0 >= 0) lb[list_off(i0) + lbase[i0] + r0] = (unsigned short)(tl | (0 << 14));
        if (i1 >= 0) lb[list_off(i1) + lbase[i1] + r1] = (unsigned short)(tl | (1 << 14));
        if (i2 >= 0) lb[list_off(i2) + lbase[i2] + r2] = (unsigned short)(tl | (2 << 14));
    }
    __syncthreads();
}
DI void att_phase(Frame& F, int l) {
    const bf16* Q = (const bf16*)(WSP(F) + WS_Q); const bf16* K = (const bf16*)(WSP(F) + WS_K); const bf16* VT = (const bf16*)(WSP(F) + WS_VT);
    const unsigned short* list = (const unsigned short*)(WSP(F) + WS_LIST); const unsigned* lcnt = (const unsigned*)(WSP(F) + WS_CTL) + CW_LCNT + 1024 * l;
    bf16* PO = (bf16*)(WSP(F) + WS_PARTO); float* PML = (float*)(WSP(F) + WS_PARTML);
    LAS unsigned char* Kl = F.lds;
    LAS unsigned char* Vl = F.lds + 36864;
    LAS int* pre = (LAS int*)(F.lds + MISC_OFF + 8192);
    LAS int* cl = (LAS int*)(F.lds + MISC_OFF + 12288); LAS int* ws8 = (LAS int*)(F.lds + MISC_OFF + 4352);
    const int lane = F.lane, wave = F.wave, qi = lane & 15, quad = lane >> 4;
    __syncthreads();
    { const int c0 = (int)__hip_atomic_load(lcnt + 2 * F.tid, __ATOMIC_RELAXED, __HIP_MEMORY_SCOPE_AGENT), c1 = (int)__hip_atomic_load(lcnt + 2 * F.tid + 1, __ATOMIC_RELAXED, __HIP_MEMORY_SCOPE_AGENT);
      cl[2 * F.tid] = c0; cl[2 * F.tid + 1] = c1; const int t0 = (c0 + 127) >> 7, t1 = (c1 + 127) >> 7; int inc = t0 + t1;
#pragma unroll
      for (int o = 1; o < 64; o <<= 1) { const int u = __shfl_up(inc, o); if (lane >= o) inc += u; }
      if (lane == 63) ws8[wave] = inc;
      __syncthreads();
      int off = 0;
#pragma unroll
      for (int w = 0; w < 8; ++w) { const int x = ws8[w]; if (w < wave) off += x; }
      const int ex = off + inc - (t0 + t1); pre[2 * F.tid] = ex; pre[2 * F.tid + 1] = ex + t0;
      __syncthreads();
      if (F.tid == 511) ws8[8] = off + inc; }
    __syncthreads();
    const int NL = __builtin_amdgcn_readfirstlane(ws8[8]), total = NL + BATCH * 8 * 64 * 2, per = (total + F.G - 1) / F.G;
    const int it0 = F.bid * per, it1 = (it0 + per < total) ? it0 + per : total;
    int cur = 0, loaded = -1;
    if (it0 < NL) { int lo = 0, hi = 1023;
        while (lo < hi) { const int mid = (lo + hi + 1) >> 1; if (pre[mid] <= it0) lo = mid; else hi = mid - 1; }
        cur = lo; }
    struct QA { int i, tile, own_item; bool valid; unsigned short ent; };
    struct QB { int i, own_item, tl, j; bool valid; bf16x8_t qf[2]; };
#define DEC_A(itx, R) do { int i_, tile_, own_; \
        if ((itx) < NL) { while (cur < 1023 && pre[cur + 1] <= (itx)) ++cur; i_ = cur; tile_ = (itx) - pre[cur]; own_ = 0; } \
        else { const int o_ = (itx) - NL; i_ = o_ >> 1; tile_ = o_ & 1; own_ = 1; } \
        i_ = __builtin_amdgcn_readfirstlane(i_); tile_ = __builtin_amdgcn_readfirstlane(tile_); \
        R.i = i_; R.tile = tile_; R.own_item = own_; R.ent = 0; R.valid = true; \
        if (!own_) { const int e_ = tile_ * 128 + wave * 16 + qi; R.valid = e_ < cl[i_]; if (R.valid) R.ent = list[(size_t)(i_ >> 6) * LSTRIDE + list_off(i_ & 63) + e_]; } } while (0)
#define DEC_B(A, R) do { const int bh_ = A.i >> 6, n_ = A.i & 63; R.i = A.i; R.own_item = A.own_item; R.valid = A.valid; \
        if (A.own_item) { R.tl = n_ * 256 + A.tile * 128 + wave * 16 + qi; R.j = 3; } else { R.tl = A.ent & 0x3fff; R.j = A.ent >> 14; } \
        { const size_t t_ = (size_t)(bh_ >> 3) * SEQ + R.tl; \
          R.qf[0] = *(const bf16x8_t*)(Q + t_ * 512 + (bh_ & 7) * 64 + quad * 8); R.qf[1] = *(const bf16x8_t*)(Q + t_ * 512 + (bh_ & 7) * 64 + 32 + quad * 8); } } while (0)
    QA na; na.i = 0; na.tile = 0; na.own_item = 1; na.valid = false; na.ent = 0;
    QB nx; nx.i = -1; nx.own_item = 0; nx.tl = 0; nx.j = 0; nx.valid = false; nx.qf[0] = (bf16x8_t){0, 0, 0, 0, 0, 0, 0, 0}; nx.qf[1] = nx.qf[0];
    if (it0 < it1) { DEC_A(it0, na); DEC_B(na, nx); if (it0 + 1 < it1) DEC_A(it0 + 1, na); }
    for (int it = it0; it < it1; ++it) {
        const int i = nx.i, own_item = nx.own_item, tl = nx.tl, j = nx.j; const bool valid = nx.valid; bf16x8_t qf[2] = {nx.qf[0], nx.qf[1]};
        const int bh = i >> 6, n = i & 63, b = bh >> 3, h = bh & 7;
        if (i != loaded) {
            __syncthreads();
#pragma unroll
            for (int r = 0; r < 4; ++r) { const int c = F.tid + r * 512, row = c >> 3, ch = c & 7;
                const u32x4 w = *(const u32x4*)(K + ((size_t)b * SEQ + n * 256 + row) * 512 + h * 64 + ch * 8); *(LAS u32x4*)(Kl + row * 144 + ch * 16) = w; }
#pragma unroll
            for (int r = 0; r < 4; ++r) { const int c = F.tid + r * 512, row = c >> 5, ch = c & 31;
                const u32x4 w = *(const u32x4*)(VT + ((size_t)bh * 64 + row) * SEQ + n * 256 + ch * 8); *(LAS u32x4*)(Vl + row * 528 + ch * 16) = w; }
            __syncthreads();
            loaded = i;
        }
        if (it + 1 < it1) { DEC_B(na, nx); if (it + 2 < it1) DEC_A(it + 2, na); }
        const size_t t = (size_t)b * SEQ + tl;
        const float slope2 = __builtin_amdgcn_exp2f(-(float)(h + 1)) * LOG2E;
        const bool half_only = own_item && (__builtin_amdgcn_readfirstlane(tl - n * 256) < 128);
        f32x4 sc[16];
#pragma unroll
        for (int kt = 0; kt < 16; ++kt) { f32x4 a = {0.f, 0.f, 0.f, 0.f};
            if (kt >= 8 && half_only) { sc[kt] = (f32x4){-INFINITY, -INFINITY, -INFINITY, -INFINITY}; continue; }
#pragma unroll
            for (int ks = 0; ks < 2; ++ks) { const bf16x8_t kf = *(const LAS bf16x8_t*)(Kl + (kt * 16 + qi) * 144 + ks * 64 + quad * 16); a = __builtin_amdgcn_mfma_f32_16x16x32_bf16(kf, qf[ks], a, 0, 0, 0); }
            sc[kt] = a; if ((kt & 3) == 3) asm volatile("" ::: "memory"); }
        const int tloc = tl - n * 256;
        float mx = -INFINITY; const float sbase = slope2 * (float)(quad * 4); const int tq4 = tloc - quad * 4;
#pragma unroll
        for (int kt = 0; kt < 16; ++kt)
#pragma unroll
            for (int e = 0; e < 4; ++e) { float s = fmaf(slope2, (float)(kt * 16 + e), sc[kt][e] + sbase); if (own_item && (kt * 16 + e) > tq4) s = -INFINITY; sc[kt][e] = s; mx = fmaxf(mx, s); }
        mx = fmaxf(mx, __shfl_xor(mx, 16)); mx = fmaxf(mx, __shfl_xor(mx, 32));
        float ls = 0.f;
#pragma unroll
        for (int kt = 0; kt < 16; ++kt)
#pragma unroll
            for (int e = 0; e < 4; ++e) { const float p = __builtin_amdgcn_exp2f(sc[kt][e] - mx); sc[kt][e] = p; ls += p; }
        ls += __shfl_xor(ls, 16); ls += __shfl_xor(ls, 32);
        f32x4 o[4];
#pragma unroll
        for (int dt = 0; dt < 4; ++dt) o[dt] = (f32x4){0.f, 0.f, 0.f, 0.f};
#pragma unroll
        for (int k2 = 0; k2 < 8; ++k2) {
            if (k2 >= 4 && half_only) break;
            u32x4 pw; pw.x = pg8::cvt_pk_bf16(sc[2 * k2][0], sc[2 * k2][1]); pw.y = pg8::cvt_pk_bf16(sc[2 * k2][2], sc[2 * k2][3]);
            pw.z = pg8::cvt_pk_bf16(sc[2 * k2 + 1][0], sc[2 * k2 + 1][1]); pw.w = pg8::cvt_pk_bf16(sc[2 * k2 + 1][2], sc[2 * k2 + 1][3]);
            const bf16x8_t pf = __builtin_bit_cast(bf16x8_t, pw);
#pragma unroll
            for (int dt = 0; dt < 4; ++dt) { const LAS unsigned char* vp = Vl + (dt * 16 + qi) * 528 + (k2 * 32 + quad * 4) * 2;
                const u32x2 lo = *(const LAS u32x2*)vp, hi = *(const LAS u32x2*)(vp + 32);
                const u32x4 vw = {lo.x, lo.y, hi.x, hi.y};
                o[dt] = __builtin_amdgcn_mfma_f32_16x16x32_bf16(__builtin_bit_cast(bf16x8_t, vw), pf, o[dt], 0, 0, 0); }
            if (k2 & 1) asm volatile("" ::: "memory"); }
        if (valid) { const float inv = frcp_(ls); const size_t pidx = (t * 8 + h) * 4 + j; bf16* op = PO + pidx * 64 + quad * 4;
#pragma unroll
            for (int dt = 0; dt < 4; ++dt) *(u32x2*)(op + dt * 16) = (u32x2){pg8::cvt_pk_bf16(o[dt][0] * inv, o[dt][1] * inv), pg8::cvt_pk_bf16(o[dt][2] * inv, o[dt][3] * inv)};
            if (quad == 0) ((float2*)PML)[pidx] = make_float2(mx - slope2 * (float)tloc, ls); }
    }
#undef DEC_A
#undef DEC_B
    __syncthreads();
}
DI void comb_phase(Frame& F) {
    const bf16* PO = (const bf16*)(WSP(F) + WS_PARTO); const float* PML = (const float*)(WSP(F) + WS_PARTML); bf16* Y = (bf16*)(WSP(F) + WS_YATTN);
    const int gw = F.bid * 8 + F.wave, NGW = F.G * 8, lane = F.lane, h = lane >> 3, dc = lane & 7;
    for (int t = gw; t < T; t += NGW) {
        const int own = (t % SEQ) >> 8, nsel = own < 3 ? own : 3; const size_t pb = ((size_t)t * 8 + h) * 4;
        float m[4], lw[4]; float M = -INFINITY;
#pragma unroll
        for (int j = 0; j < 4; ++j) { const bool ok = (j == 3) || (j < nsel); const float2 ml = ok ? ((const float2*)PML)[pb + j] : make_float2(-INFINITY, 0.f); m[j] = ml.x; lw[j] = ml.y; M = fmaxf(M, ml.x); }
        float acc[8] = {0.f, 0.f, 0.f, 0.f, 0.f, 0.f, 0.f, 0.f}; float wsum = 0.f;
#pragma unroll
        for (int j = 0; j < 4; ++j) { const bool ok = (j == 3) || (j < nsel); if (!ok) continue;
            const float w = __builtin_amdgcn_exp2f(m[j] - M) * lw[j]; wsum += w; const u32x4 ow = *(const u32x4*)(PO + (pb + j) * 64 + dc * 8);
            acc[0] += w * blo(ow.x); acc[1] += w * bhi(ow.x); acc[2] += w * blo(ow.y); acc[3] += w * bhi(ow.y); acc[4] += w * blo(ow.z); acc[5] += w * bhi(ow.z); acc[6] += w * blo(ow.w); acc[7] += w * bhi(ow.w); }
        const float inv = frcp_(wsum);
        *(u32x4*)(Y + (size_t)t * 512 + h * 64 + dc * 8) = (u32x4){pk2(acc[0] * inv, acc[1] * inv), pk2(acc[2] * inv, acc[3] * inv), pk2(acc[4] * inv, acc[5] * inv), pk2(acc[6] * inv, acc[7] * inv)};
    }
}
DI void pool_phase(Frame& F, int l) {
    const bf16* Z = (const bf16*)(WSP(F) + WS_POOLZ); bf16* Y = (bf16*)(WSP(F) + WS_YPOOL); const bf16* WPT = (const bf16*)(WSP(F) + WS_WPT);
    LAS unsigned char* Pl = F.lds;
    const int lane = F.lane, li = lane & 15, quad = lane >> 4, g = F.wave >> 1, dt0 = (F.wave & 1) * 4;
    bf16x8_t wf[4][4];
#pragma unroll
    for (int dt = 0; dt < 4; ++dt)
#pragma unroll
        for (int ks = 0; ks < 4; ++ks) wf[dt][ks] = *(const bf16x8_t*)(WPT + ((size_t)g * 128 + 16 * (dt0 + dt) + li) * 128 + 32 * ks + 8 * quad);
    for (int tile = F.bid; tile < T / 64; tile += F.G) {
        __syncthreads();
#pragma unroll 1
        for (int i = F.tid; i < 64 * 64; i += 512) { const int tt = i >> 6, ch = i & 63, gg = ch >> 4, win = 2 << gg, t = tile * 64 + tt, tl = t % SEQ; const int cnt = (tl + 1 < win) ? tl + 1 : win;
            u32x4 w[16];
#pragma unroll
            for (int j = 0; j < 16; ++j) { w[j] = (u32x4){0u, 0u, 0u, 0u}; if (j < cnt) w[j] = *(const u32x4*)(Z + (size_t)(t - j) * 512 + ch * 8); }
            float s[8] = {0.f, 0.f, 0.f, 0.f, 0.f, 0.f, 0.f, 0.f};
#pragma unroll
            for (int j = 0; j < 16; ++j) { s[0] += blo(w[j].x); s[1] += bhi(w[j].x); s[2] += blo(w[j].y); s[3] += bhi(w[j].y); s[4] += blo(w[j].z); s[5] += bhi(w[j].z); s[6] += blo(w[j].w); s[7] += bhi(w[j].w); }
            const float inv = 1.0f / (float)cnt;
            *(LAS u32x4*)(Pl + tt * 1040 + ch * 16) = (u32x4){pk2(s[0] * inv - blo(w[0].x), s[1] * inv - bhi(w[0].x)), pk2(s[2] * inv - blo(w[0].y), s[3] * inv - bhi(w[0].y)),
                                                                 pk2(s[4] * inv - blo(w[0].z), s[5] * inv - bhi(w[0].z)), pk2(s[6] * inv - blo(w[0].w), s[7] * inv - bhi(w[0].w))}; }
        __syncthreads();
#pragma unroll
        for (int tt = 0; tt < 4; ++tt) {
            bf16x8_t pf[4];
#pragma unroll
            for (int ks = 0; ks < 4; ++ks) pf[ks] = *(const LAS bf16x8_t*)(Pl + (16 * tt + li) * 1040 + (g * 128 + 32 * ks + 8 * quad) * 2);
#pragma unroll
            for (int dt = 0; dt < 4; ++dt) { f32x4 acc = {0.f, 0.f, 0.f, 0.f};
#pragma unroll
                for (int ks = 0; ks < 4; ++ks) acc = __builtin_amdgcn_mfma_f32_16x16x32_bf16(wf[dt][ks], pf[ks], acc, 0, 0, 0);
                *(u32x2*)(Y + (size_t)(tile * 64 + 16 * tt + li) * 512 + g * 128 + 16 * (dt0 + dt) + 4 * quad) = (u32x2){pk2(acc[0], acc[1]), pk2(acc[2], acc[3])}; } }
    }
    __syncthreads();
}
DI void rwkv_prep_phase(Frame& F, int l) {
    const bf16* RZ = (const bf16*)(WSP(F) + WS_RWKVZ); bf16* VF = (bf16*)(WSP(F) + WS_VFIRST);
    bf16* AR = (bf16*)(WSP(F) + WS_AR); const size_t AS = (size_t)T * 512;
    float* bonus = (float*)(WSP(F) + WS_BONUS); float* kinv = (float*)(WSP(F) + WS_KINV); const bf16* WLT = (const bf16*)(WSP(F) + WS_WLT);
    LAS unsigned char* Al = F.lds;
    const int h = F.wave;
    const float* mu = INP(F, 4) + l * 1792; const float* vmu = INP(F, 5) + (l > 0 ? (l - 1) * 32 : 0);
    const float* w0p = INP(F, 6) + l * 512 + h * 64; const float* a0p = INP(F, 8) + l * 512 + h * 64; const float* kkp = INP(F, 11) + l * 512 + h * 64;
    const float* kap = INP(F, 12) + l * 512 + h * 64; const float* rkp = INP(F, 13) + l * 512 + h * 64; const float* v0p = INP(F, 16) + (l > 0 ? l - 1 : 0) * 512 + h * 64;
    for (int item = F.bid; item < T / 64; item += F.G) {
        int tid = F.tid; asm volatile("" : "+v"(tid));
        const int lane = tid & 63, li = lane & 15, quad = lane >> 4;
        const int t0 = item * 64, tl0 = t0 % SEQ;
        __syncthreads();
        { const int tok = tid >> 3, c0 = tid & 7; const size_t t = (size_t)(t0 + tok); const bool first = (tl0 + tok == 0);
          u32x4 zc[5], zp[5]; f32x4 m0[5], m1[5];
#pragma unroll
          for (int r = 0; r < 5; ++r) { const int c = c0 + 8 * r; zc[r] = (u32x4){0u, 0u, 0u, 0u}; zp[r] = zc[r]; m0[r] = (f32x4){0.f, 0.f, 0.f, 0.f}; m1[r] = m0[r];
              if (c < 32 || (l > 0 && c < 36)) { const int col = 1536 + 8 * c; zc[r] = *(const u32x4*)(RZ + t * RZP + col); if (!first) zp[r] = *(const u32x4*)(RZ + (t - 1) * RZP + col);
                  const float* mp = col < 1792 ? mu + col : vmu + (col - 1792); m0[r] = *(const f32x4*)mp; m1[r] = *(const f32x4*)(mp + 4); } }
#pragma unroll
          for (int r = 0; r < 5; ++r) { const int c = c0 + 8 * r; if (c < 36) {
              const float cv[8] = {blo(zc[r].x), bhi(zc[r].x), blo(zc[r].y), bhi(zc[r].y), blo(zc[r].z), bhi(zc[r].z), blo(zc[r].w), bhi(zc[r].w)}, pv[8] = {blo(zp[r].x), bhi(zp[r].x), blo(zp[r].y), bhi(zp[r].y), blo(zp[r].z), bhi(zp[r].z), blo(zp[r].w), bhi(zp[r].w)};
              const float mm[8] = {m0[r].x, m0[r].y, m0[r].z, m0[r].w, m1[r].x, m1[r].y, m1[r].z, m1[r].w}; float f[8];
#pragma unroll
              for (int e = 0; e < 8; ++e) { const float zs = cv[e] + (pv[e] - cv[e]) * mm[e]; f[e] = r == 0 ? tanhf(zs) : (r == 2 || r == 3) ? sigmoidf_(zs) : zs; }
              *(LAS u32x4*)(Al + tok * 592 + c * 16) = (u32x4){pk2(f[0], f[1]), pk2(f[2], f[3]), pk2(f[4], f[5]), pk2(f[6], f[7])}; } } }
        __syncthreads();
        float ssq[4] = {0.f, 0.f, 0.f, 0.f}, bsm[4] = {0.f, 0.f, 0.f, 0.f};
#pragma unroll 1
        for (int ct = 0; ct < 4; ++ct) {
            const int cb = 16 * ct + 4 * quad;
            bf16x8_t wf[9];
#pragma unroll
            for (int ks = 0; ks < 9; ++ks) wf[ks] = *(const bf16x8_t*)(WLT + (size_t)(h * 64 + 16 * ct + li) * 288 + 32 * ks + 8 * quad);
            const f32x4 mr = *(const f32x4*)(mu + h * 64 + cb), mk = *(const f32x4*)(mu + 512 + h * 64 + cb), mv = *(const f32x4*)(mu + 1024 + h * 64 + cb);
            const f32x4 w0 = *(const f32x4*)(w0p + cb), a0 = *(const f32x4*)(a0p + cb), kkc = *(const f32x4*)(kkp + cb), kac = *(const f32x4*)(kap + cb), rkc = *(const f32x4*)(rkp + cb);
            f32x4 v0 = {0.f, 0.f, 0.f, 0.f}; if (l > 0) v0 = *(const f32x4*)(v0p + cb);
            u32x2 zr[4][2], zk[4][2], zv[4][2], vfw[4];
#pragma unroll
            for (int rt = 0; rt < 4; ++rt) { const int tok = 16 * rt + li; const size_t zi = (size_t)(t0 + tok) * RZP + h * 64 + cb; const bool first = (tl0 + tok == 0);
                zr[rt][0] = *(const u32x2*)(RZ + zi); zk[rt][0] = *(const u32x2*)(RZ + zi + 512); zv[rt][0] = *(const u32x2*)(RZ + zi + 1024);
                zr[rt][1] = (u32x2){0u, 0u}; zk[rt][1] = zr[rt][1]; zv[rt][1] = zr[rt][1]; vfw[rt] = zr[rt][1];
                if (!first) { zr[rt][1] = *(const u32x2*)(RZ + zi - RZP); zk[rt][1] = *(const u32x2*)(RZ + zi - RZP + 512); zv[rt][1] = *(const u32x2*)(RZ + zi - RZP + 1024); }
                if (l > 0) vfw[rt] = *(const u32x2*)(VF + (size_t)(t0 + tok) * 512 + h * 64 + cb); }
#pragma unroll
            for (int rt = 0; rt < 4; ++rt) { const int tok = 16 * rt + li; const size_t idx = (size_t)(t0 + tok) * 512 + h * 64 + cb;
                f32x4 aw = {0.f, 0.f, 0.f, 0.f}, aa = aw, ag = aw, av = aw;
#pragma unroll
                for (int ks = 0; ks < 9; ++ks) { if (ks == 8 && l == 0) break;
                    const bf16x8_t bfr = *(const LAS bf16x8_t*)(Al + tok * 592 + ks * 64 + quad * 16);
                    if (ks < 2) aw = __builtin_amdgcn_mfma_f32_16x16x32_bf16(wf[ks], bfr, aw, 0, 0, 0);
                    else if (ks < 4) aa = __builtin_amdgcn_mfma_f32_16x16x32_bf16(wf[ks], bfr, aa, 0, 0, 0);
                    else if (ks < 8) ag = __builtin_amdgcn_mfma_f32_16x16x32_bf16(wf[ks], bfr, ag, 0, 0, 0);
                    else av = __builtin_amdgcn_mfma_f32_16x16x32_bf16(wf[ks], bfr, av, 0, 0, 0); }
                const float crf[4] = {blo(zr[rt][0].x), bhi(zr[rt][0].x), blo(zr[rt][0].y), bhi(zr[rt][0].y)}, prf[4] = {blo(zr[rt][1].x), bhi(zr[rt][1].x), blo(zr[rt][1].y), bhi(zr[rt][1].y)};
                const float ckf[4] = {blo(zk[rt][0].x), bhi(zk[rt][0].x), blo(zk[rt][0].y), bhi(zk[rt][0].y)}, pkf[4] = {blo(zk[rt][1].x), bhi(zk[rt][1].x), blo(zk[rt][1].y), bhi(zk[rt][1].y)};
                const float cvf[4] = {blo(zv[rt][0].x), bhi(zv[rt][0].x), blo(zv[rt][0].y), bhi(zv[rt][0].y)}, pvf[4] = {blo(zv[rt][1].x), bhi(zv[rt][1].x), blo(zv[rt][1].y), bhi(zv[rt][1].y)};
                const float vff[4] = {blo(vfw[rt].x), bhi(vfw[rt].x), blo(vfw[rt].y), bhi(vfw[rt].y)};
                float ro[4], lwo[4], kpo[4], vo[4], kro[4], bbo[4];
#pragma unroll
                for (int e = 0; e < 4; ++e) { const float r = crf[e] + (prf[e] - crf[e]) * mr[e], k = ckf[e] + (pkf[e] - ckf[e]) * mk[e]; float v = cvf[e] + (pvf[e] - cvf[e]) * mv[e];
                    const float xw = -(w0[e] + aw[e]); const float sp = xw > 20.f ? xw : log1pf(__expf(xw)); lwo[e] = -__expf(-sp - 0.5f);
                    const float asig = sigmoidf_(a0[e] + aa[e]);
                    if (l > 0) v = v + (vff[e] - v) * sigmoidf_(v0[e] + av[e]);
                    vo[e] = v; ro[e] = r; const float kr = k * kkc[e]; kro[e] = kr; bbo[e] = kr * asig; ssq[rt] += kr * kr;
                    const float kpe = k * (1.0f + (asig - 1.0f) * kac[e]); kpo[e] = kpe; bsm[rt] += r * kpe * rkc[e]; }
                if (l == 0) *(u32x2*)(VF + idx) = (u32x2){pk2(vo[0], vo[1]), pk2(vo[2], vo[3])};
                *(u32x2*)(AR + idx) = (u32x2){pk2(ro[0], ro[1]), pk2(ro[2], ro[3])};
                *(u32x2*)(AR + AS + idx) = (u32x2){pk2(lwo[0], lwo[1]), pk2(lwo[2], lwo[3])};
                *(u32x2*)(AR + 2 * AS + idx) = (u32x2){pk2(kpo[0], kpo[1]), pk2(kpo[2], kpo[3])};
                *(u32x2*)(AR + 3 * AS + idx) = (u32x2){pk2(vo[0], vo[1]), pk2(vo[2], vo[3])};
                *(u32x2*)(AR + 4 * AS + idx) = (u32x2){pk2(kro[0], kro[1]), pk2(kro[2], kro[3])};
                *(u32x2*)(AR + 5 * AS + idx) = (u32x2){pk2(bbo[0], bbo[1]), pk2(bbo[2], bbo[3])};
                *(u32x2*)(AR + 6 * AS + idx) = (u32x2){pk2(ag[0], ag[1]), pk2(ag[2], ag[3])}; asm volatile("" ::: "memory"); }
        }
#pragma unroll
        for (int rt = 0; rt < 4; ++rt) { float ss = ssq[rt], bs = bsm[rt]; ss += __shfl_xor(ss, 16); ss += __shfl_xor(ss, 32); bs += __shfl_xor(bs, 16); bs += __shfl_xor(bs, 32);
            if (quad == 0) { const size_t t = (size_t)(t0 + 16 * rt + li); bonus[t * 8 + h] = bs; kinv[t * 8 + h] = 1.0f / fmaxf(sqrtf(ss), 1e-12f); } }
    }
    __syncthreads();
}
typedef short bf16x4_t __attribute__((ext_vector_type(4)));
DI void rwkv_chunk_phase(Frame& F, int l) {
    const bf16* RZ = (const bf16*)(WSP(F) + WS_RWKVZ); bf16* VF = (bf16*)(WSP(F) + WS_VFIRST);
    bf16* AR = (bf16*)(WSP(F) + WS_AR); const size_t AS = (size_t)T * 512; float* bonus = (float*)(WSP(F) + WS_BONUS); const bf16* WLT = (const bf16*)(WSP(F) + WS_WLT);
    bf16* PCT = (bf16*)(WSP(F) + WS_PCT); bf16* LC = (bf16*)(WSP(F) + WS_LC); bf16* RM = (bf16*)(WSP(F) + WS_RM); bf16* Y0 = (bf16*)(WSP(F) + WS_Y0);
    const float* mu = INP(F, 4) + l * 1792; const float* vmu = INP(F, 5) + (l > 0 ? (l - 1) * 32 : 0);
    constexpr int ST = 144;
    LAS unsigned char* L = F.lds;
    LAS unsigned char* AT = L; LAS unsigned char* BT = L + 9216; LAS unsigned char* KT = L + 18432; LAS unsigned char* RT = L + 27648;
    LAS unsigned char* BTT = L + 36864; LAS unsigned char* KTT = L + 46080; LAS unsigned char* VTl = L + 55296; LAS unsigned char* NB = L + 64512; LAS unsigned char* MB = L + 73728;
    LAS unsigned char* WMT = L + 82944; LAS unsigned char* UMT = L + 92160;
    LAS unsigned char* Al = L + 64512;
    LAS unsigned char* SR = L + 64512; LAS unsigned char* SKP = L + 72704; LAS unsigned char* SKR = L + 80896; LAS unsigned char* SBB = L + 89088;
    LAS float* LGF = (LAS float*)(L + 101376); LAS float* ND = (LAS float*)(L + 117760); LAS unsigned char* DB = L + 122112; LAS float* GC = (LAS float*)(L + 125184); LAS float* PART = (LAS float*)(L + 125440);
    LAS float* SSP = (LAS float*)(L + 127488); LAS float* BSP = SSP + 256;
    const int wave = F.wave;
#define MF32(a, b, c) __builtin_amdgcn_mfma_f32_16x16x32_bf16((a), (b), (c), 0, 0, 0)
#define MF16(a, b, c) __builtin_amdgcn_mfma_f32_16x16x16bf16_1k((a), (b), (c), 0, 0, 0)
#define RD8(p) (*(const LAS bf16x8_t*)(p))
#define RD4(p) (*(const LAS bf16x4_t*)(p))
    u32x4 zcn[5], zpn[5];
#define F1LOAD(itx) do { const int bh_ = (itx) >> 8, ck_ = (itx) & 255; const size_t t_ = (size_t)(bh_ >> 3) * SEQ + ck_ * 64 + (F.tid >> 3); const bool first_ = (ck_ * 64 + (F.tid >> 3) == 0); \
        _Pragma("unroll") for (int r_ = 0; r_ < 5; ++r_) { const int c_ = (F.tid & 7) + 8 * r_; zcn[r_] = (u32x4){0u, 0u, 0u, 0u}; zpn[r_] = zcn[r_]; \
            if (c_ < 32 || (l > 0 && c_ < 36)) { const int col_ = 1536 + 8 * c_; zcn[r_] = *(const u32x4*)(RZ + t_ * RZP + col_); if (!first_) zpn[r_] = *(const u32x4*)(RZ + (t_ - 1) * RZP + col_); } } } while (0)
    if (F.bid < BATCH * 8 * (SEQ / 64)) F1LOAD(F.bid);
    for (int it = F.bid; it < BATCH * 8 * (SEQ / 64); it += F.G) {
        int tid = F.tid; asm volatile("" : "+v"(tid));
        const int lane = tid & 63, li = lane & 15, quad = lane >> 4;
        const int bh = it >> 8, ck = it & 255, b = bh >> 3, h = bh & 7;
        const size_t tbase = (size_t)b * SEQ + ck * 64; const int tl0 = ck * 64;
        __syncthreads();
        { const int tok = tid >> 3, c0 = tid & 7;
          u32x4 zc[5], zp[5]; f32x4 m0[5], m1[5];
#pragma unroll
          for (int r = 0; r < 5; ++r) { const int c = c0 + 8 * r; zc[r] = zcn[r]; zp[r] = zpn[r]; m0[r] = (f32x4){0.f, 0.f, 0.f, 0.f}; m1[r] = m0[r];
              if (c < 32 || (l > 0 && c < 36)) { const int col = 1536 + 8 * c; const float* mp = col < 1792 ? mu + col : vmu + (col - 1792); m0[r] = *(const f32x4*)mp; m1[r] = *(const f32x4*)(mp + 4); } }
#pragma unroll
          for (int r = 0; r < 5; ++r) { const int c = c0 + 8 * r; if (c < 36) {
              const float cv[8] = {blo(zc[r].x), bhi(zc[r].x), blo(zc[r].y), bhi(zc[r].y), blo(zc[r].z), bhi(zc[r].z), blo(zc[r].w), bhi(zc[r].w)}, pv[8] = {blo(zp[r].x), bhi(zp[r].x), blo(zp[r].y), bhi(zp[r].y), blo(zp[r].z), bhi(zp[r].z), blo(zp[r].w), bhi(zp[r].w)};
              const float mm[8] = {m0[r].x, m0[r].y, m0[r].z, m0[r].w, m1[r].x, m1[r].y, m1[r].z, m1[r].w}; float f[8];
#pragma unroll
              for (int e = 0; e < 8; ++e) { const float zs = cv[e] + (pv[e] - cv[e]) * mm[e]; f[e] = r == 0 ? ftanh_(zs) : (r == 2 || r == 3) ? sigmoidf_(zs) : zs; }
              *(LAS u32x4*)(Al + tok * 576 + c * 16) = (u32x4){pk2(f[0], f[1]), pk2(f[2], f[3]), pk2(f[4], f[5]), pk2(f[6], f[7])}; } } }
        __syncthreads();
        { const int ct = wave & 3, hw = wave >> 2, cb = 16 * ct + 4 * quad;
          bf16x8_t wf[9];
#pragma unroll
          for (int ks = 0; ks < 9; ++ks) wf[ks] = *(const bf16x8_t*)(WLT + (size_t)(h * 64 + 16 * ct + li) * 288 + 32 * ks + 8 * quad);
          const f32x4 mr = *(const f32x4*)(mu + h * 64 + cb), mk = *(const f32x4*)(mu + 512 + h * 64 + cb), mv = *(const f32x4*)(mu + 1024 + h * 64 + cb);
          const f32x4 w0 = *(const f32x4*)(INP(F, 6) + l * 512 + h * 64 + cb), a0 = *(const f32x4*)(INP(F, 8) + l * 512 + h * 64 + cb), kkc = *(const f32x4*)(INP(F, 11) + l * 512 + h * 64 + cb);
          const f32x4 kac = *(const f32x4*)(INP(F, 12) + l * 512 + h * 64 + cb), rkc = *(const f32x4*)(INP(F, 13) + l * 512 + h * 64 + cb);
          f32x4 v0 = {0.f, 0.f, 0.f, 0.f}; if (l > 0) v0 = *(const f32x4*)(INP(F, 16) + (l - 1) * 512 + h * 64 + cb);
          u32x2 zr[2][2], zk[2][2], zv[2][2], vfw[2]; f32x4 aw[2], aa[2], ag[2], av[2];
#pragma unroll
          for (int rr = 0; rr < 2; ++rr) { const int tok = 16 * (2 * hw + rr) + li; const size_t zi = (tbase + tok) * RZP + h * 64 + cb; const bool first = (tl0 + tok == 0);
              zr[rr][0] = *(const u32x2*)(RZ + zi); zk[rr][0] = *(const u32x2*)(RZ + zi + 512); zv[rr][0] = *(const u32x2*)(RZ + zi + 1024);
              zr[rr][1] = (u32x2){0u, 0u}; zk[rr][1] = zr[rr][1]; zv[rr][1] = zr[rr][1]; vfw[rr] = zr[rr][1];
              if (!first) { zr[rr][1] = *(const u32x2*)(RZ + zi - RZP); zk[rr][1] = *(const u32x2*)(RZ + zi - RZP + 512); zv[rr][1] = *(const u32x2*)(RZ + zi - RZP + 1024); }
              if (l > 0) vfw[rr] = *(const u32x2*)(VF + (tbase + tok) * 512 + h * 64 + cb); }
#pragma unroll
          for (int rr = 0; rr < 2; ++rr) { const int tok = 16 * (2 * hw + rr) + li; aw[rr] = (f32x4){0.f, 0.f, 0.f, 0.f}; aa[rr] = aw[rr]; ag[rr] = aw[rr]; av[rr] = aw[rr];
#pragma unroll
              for (int ks = 0; ks < 9; ++ks) { if (ks == 8 && l == 0) break;
                  const bf16x8_t bfr = RD8(Al + tok * 576 + ks * 64 + quad * 16);
                  if (ks < 2) aw[rr] = MF32(wf[ks], bfr, aw[rr]); else if (ks < 4) aa[rr] = MF32(wf[ks], bfr, aa[rr]); else if (ks < 8) ag[rr] = MF32(wf[ks], bfr, ag[rr]); else av[rr] = MF32(wf[ks], bfr, av[rr]); } }
          __syncthreads();
          if (it + F.G < BATCH * 8 * (SEQ / 64)) F1LOAD(it + F.G);
#pragma unroll
          for (int rr = 0; rr < 2; ++rr) { const int tok = 16 * (2 * hw + rr) + li; const size_t idx = (tbase + tok) * 512 + h * 64 + cb;
              const float crf[4] = {blo(zr[rr][0].x), bhi(zr[rr][0].x), blo(zr[rr][0].y), bhi(zr[rr][0].y)}, prf[4] = {blo(zr[rr][1].x), bhi(zr[rr][1].x), blo(zr[rr][1].y), bhi(zr[rr][1].y)};
              const float ckf[4] = {blo(zk[rr][0].x), bhi(zk[rr][0].x), blo(zk[rr][0].y), bhi(zk[rr][0].y)}, pkf[4] = {blo(zk[rr][1].x), bhi(zk[rr][1].x), blo(zk[rr][1].y), bhi(zk[rr][1].y)};
              const float cvf[4] = {blo(zv[rr][0].x), bhi(zv[rr][0].x), blo(zv[rr][0].y), bhi(zv[rr][0].y)}, pvf[4] = {blo(zv[rr][1].x), bhi(zv[rr][1].x), blo(zv[rr][1].y), bhi(zv[rr][1].y)};
              const float vff[4] = {blo(vfw[rr].x), bhi(vfw[rr].x), blo(vfw[rr].y), bhi(vfw[rr].y)};
              float ro[4], lwo[4], kpo[4], vo[4], kro[4], bbo[4]; float ss = 0.f, bs = 0.f;
#pragma unroll
              for (int e = 0; e < 4; ++e) { const float r = crf[e] + (prf[e] - crf[e]) * mr[e], k = ckf[e] + (pkf[e] - ckf[e]) * mk[e]; float v = cvf[e] + (pvf[e] - cvf[e]) * mv[e];
                  const float xw = -(w0[e] + aw[rr][e]); const float sp = fsoftplus_(xw); lwo[e] = -fexp_(-sp - 0.5f);
                  const float asig = sigmoidf_(a0[e] + aa[rr][e]);
                  if (l > 0) v = v + (vff[e] - v) * sigmoidf_(v0[e] + av[rr][e]);
                  vo[e] = v; ro[e] = r; const float kr = k * kkc[e]; kro[e] = kr; bbo[e] = kr * asig; ss += kr * kr;
                  const float kpe = k * (1.0f + (asig - 1.0f) * kac[e]); kpo[e] = kpe; bs += r * kpe * rkc[e]; }
              const u32x2 vpk = {pk2(vo[0], vo[1]), pk2(vo[2], vo[3])};
              if (l == 0) *(u32x2*)(VF + idx) = vpk;
              *(u32x2*)(AR + 3 * AS + idx) = vpk; *(u32x2*)(AR + 6 * AS + idx) = (u32x2){pk2(ag[rr][0], ag[rr][1]), pk2(ag[rr][2], ag[rr][3])};
              *(LAS f32x4*)(LGF + tok * 64 + cb) = (f32x4){__uint_as_float(f2bf(lwo[0]) << 16), __uint_as_float(f2bf(lwo[1]) << 16), __uint_as_float(f2bf(lwo[2]) << 16), __uint_as_float(f2bf(lwo[3]) << 16)};
              *(LAS u32x2*)(SR + tok * 128 + cb * 2) = (u32x2){pk2(ro[0], ro[1]), pk2(ro[2], ro[3])}; *(LAS u32x2*)(SKP + tok * 128 + cb * 2) = (u32x2){pk2(kpo[0], kpo[1]), pk2(kpo[2], kpo[3])};
              *(LAS u32x2*)(SKR + tok * 128 + cb * 2) = (u32x2){pk2(kro[0], kro[1]), pk2(kro[2], kro[3])}; *(LAS u32x2*)(SBB + tok * 128 + cb * 2) = (u32x2){pk2(bbo[0], bbo[1]), pk2(bbo[2], bbo[3])};
#pragma unroll
              for (int e = 0; e < 4; ++e) *(LAS unsigned short*)(VTl + (cb + e) * ST + tok * 2) = (unsigned short)f2bf(vo[e]);
              ss += __shfl_xor(ss, 16); ss += __shfl_xor(ss, 32); bs += __shfl_xor(bs, 16); bs += __shfl_xor(bs, 32);
              if (quad == 0) { SSP[ct * 64 + tok] = ss; BSP[ct * 64 + tok] = bs; } } }
        __syncthreads();
        const int et = tid >> 3, ec = (tid & 7) * 8;
        { const int c = tid & 63, p = tid >> 6; float x[8]; float run = 0.f;
#pragma unroll
          for (int i = 0; i < 8; ++i) x[i] = LGF[(8 * p + i) * 64 + c];
#pragma unroll
          for (int i = 0; i < 8; ++i) { run += x[i]; LGF[(8 * p + i) * 64 + c] = run; }
          PART[p * 64 + c] = run; }
        __syncthreads();
        { float lg[8], lgp[8];
          { f32x4 o0 = {0.f, 0.f, 0.f, 0.f}, o1 = o0, q0 = o0, q1 = o0, tot0 = o0, tot1 = o0;
#pragma unroll
            for (int p = 0; p < 8; ++p) { const f32x4 a0 = *(const LAS f32x4*)(PART + p * 64 + ec), a1 = *(const LAS f32x4*)(PART + p * 64 + ec + 4); if (p < (et >> 3)) { o0 += a0; o1 += a1; } if (p < ((et - 1) >> 3)) { q0 += a0; q1 += a1; } tot0 += a0; tot1 += a1; }
            const f32x4 l0 = *(const LAS f32x4*)(LGF + et * 64 + ec) + o0, l1 = *(const LAS f32x4*)(LGF + et * 64 + ec + 4) + o1;
            f32x4 p0 = {0.f, 0.f, 0.f, 0.f}, p1 = p0; if (et > 0) { p0 = *(const LAS f32x4*)(LGF + (et - 1) * 64 + ec) + q0; p1 = *(const LAS f32x4*)(LGF + (et - 1) * 64 + ec + 4) + q1; }
            lg[0] = l0.x; lg[1] = l0.y; lg[2] = l0.z; lg[3] = l0.w; lg[4] = l1.x; lg[5] = l1.y; lg[6] = l1.z; lg[7] = l1.w;
            lgp[0] = p0.x; lgp[1] = p0.y; lgp[2] = p0.z; lgp[3] = p0.w; lgp[4] = p1.x; lgp[5] = p1.y; lgp[6] = p1.z; lgp[7] = p1.w;
            if (et == 63) { *(LAS f32x4*)(GC + ec) = (f32x4){fexp_(tot0.x), fexp_(tot0.y), fexp_(tot0.z), fexp_(tot0.w)}; *(LAS f32x4*)(GC + ec + 4) = (f32x4){fexp_(tot1.x), fexp_(tot1.y), fexp_(tot1.z), fexp_(tot1.w)}; } }
          const float ssum = (SSP[et] + SSP[64 + et]) + (SSP[128 + et] + SSP[192 + et]); const float kiv = __builtin_amdgcn_rsqf(fmaxf(ssum, 1e-24f));
          if (ec == 0) bonus[(tbase + et) * 8 + h] = (BSP[et] + BSP[64 + et]) + (BSP[128 + et] + BSP[192 + et]);
          const u32x4 wr = *(const LAS u32x4*)(SR + et * 128 + ec * 2), wk = *(const LAS u32x4*)(SKP + et * 128 + ec * 2), wkk = *(const LAS u32x4*)(SKR + et * 128 + ec * 2), wbb = *(const LAS u32x4*)(SBB + et * 128 + ec * 2);
          const float rv[8] = {blo(wr.x), bhi(wr.x), blo(wr.y), bhi(wr.y), blo(wr.z), bhi(wr.z), blo(wr.w), bhi(wr.w)}, kv[8] = {blo(wk.x), bhi(wk.x), blo(wk.y), bhi(wk.y), blo(wk.z), bhi(wk.z), blo(wk.w), bhi(wk.w)};
          const float kkv[8] = {blo(wkk.x), bhi(wkk.x), blo(wkk.y), bhi(wkk.y), blo(wkk.z), bhi(wkk.z), blo(wkk.w), bhi(wkk.w)}, bbv[8] = {blo(wbb.x), bhi(wbb.x), blo(wbb.y), bhi(wbb.y), blo(wbb.z), bhi(wbb.z), blo(wbb.w), bhi(wbb.w)};
          unsigned short ab[8], bb_[8], kb_[8], rb[8];
#pragma unroll
          for (int e = 0; e < 8; ++e) { const float ep = fexp_(lg[e]), en = fexp_(-lg[e]), epv = fexp_(lgp[e]);
              ab[e] = (unsigned short)f2bf(-kkv[e] * kiv * epv); bb_[e] = (unsigned short)f2bf(bbv[e] * kiv * en); kb_[e] = (unsigned short)f2bf(kv[e] * en); rb[e] = (unsigned short)f2bf(rv[e] * ep); }
#define PK8(x) (u32x4){(unsigned)x[0] | ((unsigned)x[1] << 16), (unsigned)x[2] | ((unsigned)x[3] << 16), (unsigned)x[4] | ((unsigned)x[5] << 16), (unsigned)x[6] | ((unsigned)x[7] << 16)}
          *(LAS u32x4*)(AT + et * ST + ec * 2) = PK8(ab); *(LAS u32x4*)(BT + et * ST + ec * 2) = PK8(bb_); *(LAS u32x4*)(KT + et * ST + ec * 2) = PK8(kb_); *(LAS u32x4*)(RT + et * ST + ec * 2) = PK8(rb);
#undef PK8
#pragma unroll
          for (int e = 0; e < 8; ++e) { *(LAS unsigned short*)(BTT + (ec + e) * ST + et * 2) = bb_[e]; *(LAS unsigned short*)(KTT + (ec + e) * ST + et * 2) = kb_[e]; } }
        __syncthreads();
        bf16x8_t ppk[2], qpk[2];
        if (wave < 4) { const int tt = wave; const bf16x8_t r0 = RD8(RT + (16 * tt + li) * ST + quad * 16), r1 = RD8(RT + (16 * tt + li) * ST + 64 + quad * 16);
            u32x2 pw[4], qw[4];
#pragma unroll
            for (int jt = 0; jt < 4; ++jt) { f32x4 pa = {0.f, 0.f, 0.f, 0.f}, qa = pa;
                pa = MF32(RD8(BT + (16 * jt + li) * ST + quad * 16), r0, pa); pa = MF32(RD8(BT + (16 * jt + li) * ST + 64 + quad * 16), r1, pa);
                qa = MF32(RD8(KT + (16 * jt + li) * ST + quad * 16), r0, qa); qa = MF32(RD8(KT + (16 * jt + li) * ST + 64 + quad * 16), r1, qa);
#pragma unroll
                for (int e = 0; e < 4; ++e) { const bool keep = (16 * jt + 4 * quad + e) <= (16 * tt + li); pa[e] = keep ? pa[e] : 0.f; qa[e] = keep ? qa[e] : 0.f; }
                pw[jt] = (u32x2){pg8::cvt_pk_bf16(pa[0], pa[1]), pg8::cvt_pk_bf16(pa[2], pa[3])}; qw[jt] = (u32x2){pg8::cvt_pk_bf16(qa[0], qa[1]), pg8::cvt_pk_bf16(qa[2], qa[3])}; }
            ppk[0] = __builtin_bit_cast(bf16x8_t, (u32x4){pw[0].x, pw[0].y, pw[1].x, pw[1].y}); ppk[1] = __builtin_bit_cast(bf16x8_t, (u32x4){pw[2].x, pw[2].y, pw[3].x, pw[3].y});
            qpk[0] = __builtin_bit_cast(bf16x8_t, (u32x4){qw[0].x, qw[0].y, qw[1].x, qw[1].y}); qpk[1] = __builtin_bit_cast(bf16x8_t, (u32x4){qw[2].x, qw[2].y, qw[3].x, qw[3].y});
        } else { const int rw = wave - 4; const bf16x8_t a0 = RD8(AT + (16 * rw + li) * ST + quad * 16), a1 = RD8(AT + (16 * rw + li) * ST + 64 + quad * 16);
            ppk[0] = (bf16x8_t){0, 0, 0, 0, 0, 0, 0, 0}; ppk[1] = ppk[0]; qpk[0] = ppk[0]; qpk[1] = ppk[0];
#pragma unroll
            for (int jt = 0; jt < 4; ++jt) { f32x4 na = {0.f, 0.f, 0.f, 0.f}, ma = na;
                if (jt <= rw) { na = MF32(a0, RD8(BT + (16 * jt + li) * ST + quad * 16), na); na = MF32(a1, RD8(BT + (16 * jt + li) * ST + 64 + quad * 16), na);
                                ma = MF32(a0, RD8(KT + (16 * jt + li) * ST + quad * 16), ma); ma = MF32(a1, RD8(KT + (16 * jt + li) * ST + 64 + quad * 16), ma); }
#pragma unroll
                for (int e = 0; e < 4; ++e) { const int tr = 16 * rw + 4 * quad + e, jc = 16 * jt + li; const bool keep = jc < tr; const float nv = keep ? na[e] : 0.f, mv = keep ? ma[e] : 0.f;
                    *(LAS unsigned short*)(NB + tr * ST + jc * 2) = (unsigned short)f2bf(nv); *(LAS unsigned short*)(MB + tr * ST + jc * 2) = (unsigned short)f2bf(mv);
                    if (jt == rw) ND[rw * 272 + (4 * quad + e) * 17 + li] = nv; } }
            LDS_WAIT(); asm volatile("" ::: "memory");
            if (lane < 16) { float x[16];
#pragma unroll
                for (int t = 0; t < 16; ++t) { float s = (t == lane) ? 1.f : 0.f;
#pragma unroll
                    for (int q = 0; q < t; ++q) s += ND[rw * 272 + t * 17 + q] * x[q];
                    x[t] = s; *(LAS unsigned short*)(DB + rw * 768 + t * 48 + lane * 2) = (unsigned short)f2bf(s); } }
        }
        __syncthreads();
        { const int cw = wave & 3; f32x4 rhs[4];
          if (wave < 4) {
#pragma unroll
              for (int i = 0; i < 4; ++i)
#pragma unroll
                  for (int e = 0; e < 4; ++e) rhs[i][e] = bf2f(*(const LAS unsigned short*)(AT + (16 * i + 4 * quad + e) * ST + (16 * cw + li) * 2));
          } else { const bf16x8_t v0 = RD8(VTl + (16 * cw + li) * ST + quad * 16), v1 = RD8(VTl + (16 * cw + li) * ST + 64 + quad * 16);
#pragma unroll
              for (int i = 0; i < 4; ++i) { f32x4 a = {0.f, 0.f, 0.f, 0.f}; a = MF32(RD8(MB + (16 * i + li) * ST + quad * 16), v0, a); a = MF32(RD8(MB + (16 * i + li) * ST + 64 + quad * 16), v1, a); rhs[i] = a; } }
          LAS unsigned char* XT = (wave < 4) ? WMT : UMT; bf16x4_t xb[4];
#pragma unroll
          for (int i = 0; i < 4; ++i) { f32x4 acc = rhs[i];
#pragma unroll
              for (int kb = 0; kb < 4; ++kb) if (kb < i) acc = MF16(RD4(NB + (16 * i + li) * ST + (16 * kb + 4 * quad) * 2), xb[kb], acc);
              const u32x2 aw = {pg8::cvt_pk_bf16(acc[0], acc[1]), pg8::cvt_pk_bf16(acc[2], acc[3])};
              f32x4 x = {0.f, 0.f, 0.f, 0.f}; x = MF16(RD4(DB + i * 768 + li * 48 + quad * 8), __builtin_bit_cast(bf16x4_t, aw), x);
              const u32x2 xw = {pg8::cvt_pk_bf16(x[0], x[1]), pg8::cvt_pk_bf16(x[2], x[3])}; xb[i] = __builtin_bit_cast(bf16x4_t, xw);
              *(LAS u32x2*)(XT + (16 * cw + li) * ST + (16 * i + 4 * quad) * 2) = xw; } }
        __syncthreads();
        if (wave < 4) { const int tt = wave; const int tg = 16 * tt + li;
            bf16* rmo = RM + (size_t)it * 4096 + tg * 64; bf16* y0o = Y0 + (size_t)it * 4096 + tg * 64;
#pragma unroll
            for (int ct = 0; ct < 4; ++ct) { const u32x2 rw2 = *(const LAS u32x2*)(RT + tg * ST + (16 * ct + 4 * quad) * 2); f32x4 acc = {blo(rw2.x), bhi(rw2.x), blo(rw2.y), bhi(rw2.y)};
#pragma unroll
                for (int s2 = 0; s2 < 2; ++s2) { const LAS unsigned char* wp = WMT + (16 * ct + li) * ST + (32 * s2 + 4 * quad) * 2; const u32x2 lo = *(const LAS u32x2*)wp, hi = *(const LAS u32x2*)(wp + 32);
                    acc = MF32(__builtin_bit_cast(bf16x8_t, (u32x4){lo.x, lo.y, hi.x, hi.y}), ppk[s2], acc); }
                *(u32x2*)(rmo + 16 * ct + 4 * quad) = (u32x2){pg8::cvt_pk_bf16(acc[0], acc[1]), pg8::cvt_pk_bf16(acc[2], acc[3])}; }
#pragma unroll
            for (int vt = 0; vt < 4; ++vt) { f32x4 acc = {0.f, 0.f, 0.f, 0.f};
#pragma unroll
                for (int s2 = 0; s2 < 2; ++s2) { const LAS unsigned char* up = UMT + (16 * vt + li) * ST + (32 * s2 + 4 * quad) * 2; const u32x2 ulo = *(const LAS u32x2*)up, uhi = *(const LAS u32x2*)(up + 32);
                    acc = MF32(__builtin_bit_cast(bf16x8_t, (u32x4){ulo.x, ulo.y, uhi.x, uhi.y}), ppk[s2], acc);
                    const LAS unsigned char* vp = VTl + (16 * vt + li) * ST + (32 * s2 + 4 * quad) * 2; const u32x2 vlo = *(const LAS u32x2*)vp, vhi = *(const LAS u32x2*)(vp + 32);
                    acc = MF32(__builtin_bit_cast(bf16x8_t, (u32x4){vlo.x, vlo.y, vhi.x, vhi.y}), qpk[s2], acc); }
                *(u32x2*)(y0o + 16 * vt + 4 * quad) = (u32x2){pg8::cvt_pk_bf16(acc[0], acc[1]), pg8::cvt_pk_bf16(acc[2], acc[3])}; }
        } else { const int xt = wave - 4;
            const bf16x8_t bt0 = RD8(BTT + (16 * xt + li) * ST + quad * 16), bt1 = RD8(BTT + (16 * xt + li) * ST + 64 + quad * 16);
            const float gc2 = GC[16 * xt + li]; bf16* pco = PCT + (size_t)it * 4096 + (16 * xt + li) * 64;
#pragma unroll
            for (int c1 = 0; c1 < 4; ++c1) { f32x4 acc = {0.f, 0.f, 0.f, 0.f};
                acc = MF32(RD8(WMT + (16 * c1 + li) * ST + quad * 16), bt0, acc); acc = MF32(RD8(WMT + (16 * c1 + li) * ST + 64 + quad * 16), bt1, acc);
                float o[4];
#pragma unroll
                for (int e = 0; e < 4; ++e) o[e] = gc2 * (acc[e] + (((16 * c1 + 4 * quad + e) == (16 * xt + li)) ? 1.f : 0.f));
                *(u32x2*)(pco + 16 * c1 + 4 * quad) = (u32x2){pg8::cvt_pk_bf16(o[0], o[1]), pg8::cvt_pk_bf16(o[2], o[3])}; }
            const bf16x8_t um0 = RD8(UMT + (16 * xt + li) * ST + quad * 16), um1 = RD8(UMT + (16 * xt + li) * ST + 64 + quad * 16), vt0 = RD8(VTl + (16 * xt + li) * ST + quad * 16), vt1 = RD8(VTl + (16 * xt + li) * ST + 64 + quad * 16);
            bf16* lco = LC + (size_t)it * 4096 + (16 * xt + li) * 64;
#pragma unroll
            for (int ct = 0; ct < 4; ++ct) { f32x4 acc = {0.f, 0.f, 0.f, 0.f};
                acc = MF32(RD8(BTT + (16 * ct + li) * ST + quad * 16), um0, acc); acc = MF32(RD8(BTT + (16 * ct + li) * ST + 64 + quad * 16), um1, acc);
                acc = MF32(RD8(KTT + (16 * ct + li) * ST + quad * 16), vt0, acc); acc = MF32(RD8(KTT + (16 * ct + li) * ST + 64 + quad * 16), vt1, acc);
                const f32x4 g4 = *(const LAS f32x4*)(GC + 16 * ct + 4 * quad);
                *(u32x2*)(lco + 16 * ct + 4 * quad) = (u32x2){pg8::cvt_pk_bf16(acc[0] * g4.x, acc[1] * g4.y), pg8::cvt_pk_bf16(acc[2] * g4.z, acc[3] * g4.w)}; }
        }
    }
#undef F1LOAD
#undef MF32
#undef MF16
#undef RD8
#undef RD4
    __syncthreads();
}
template <int MODE> DI void state_scan16(Frame& F) {
    constexpr int SLOT = 18432, NSL = 6;
    const bf16* PT = (const bf16*)(WSP(F) + (MODE == 1 ? WS_PGT : WS_PCT)); const bf16* LL = (const bf16*)(WSP(F) + (MODE == 1 ? WS_LG : WS_LC));
    LAS unsigned char* ring = F.lds;
    const int nitems = (MODE == 1) ? BATCH * 8 : BATCH * 8 * 16;
#define RBAR() do { asm volatile("s_waitcnt lgkmcnt(0)" ::: "memory"); __builtin_amdgcn_s_barrier(); asm volatile("" ::: "memory"); } while (0)
    for (int it = F.bid; it < nitems; it += F.G) {
        int tid = F.tid; asm volatile("" : "+v"(tid));
        const int lane = tid & 63, wave = __builtin_amdgcn_readfirstlane(tid >> 6), vl = lane & 15, quad = lane >> 4;
        const size_t opbase = (MODE == 1) ? (size_t)it * 16 * 4096 : (size_t)((it >> 4) * 256 + (it & 15) * 16) * 4096;
        const bf16* pt = PT + opbase; const bf16* ll = LL + opbase;
        __syncthreads();
        const unsigned loffp = (unsigned)((tid >> 3) * 144 + (tid & 7) * 16), loffl = 9216u + loffp;
        u32x4 rg[4][2];
#define SLOAD(q, x) do { rg[q][0] = *((const u32x4*)(pt + (size_t)(x) * 4096) + tid); rg[q][1] = *((const u32x4*)(ll + (size_t)(x) * 4096) + tid); } while (0)
#define SWRITE(q, x) do { LAS unsigned char* d_ = ring + ((x) % NSL) * SLOT; *(LAS u32x4*)(d_ + loffp) = rg[q][0]; *(LAS u32x4*)(d_ + loffl) = rg[q][1]; } while (0)
        SLOAD(0, 0); SLOAD(1, 1); SLOAD(2, 2); SLOAD(3, 3);
        SWRITE(0, 0); SWRITE(1, 1);
        SLOAD(0, 4); SLOAD(1, 5);
        const bool pwave = (MODE == 0) && (wave < 4); const bool active = (MODE == 0) || (wave < 4); const int vb = wave & 3;
        f32x4 st[4];
#pragma unroll
        for (int kt = 0; kt < 4; ++kt) { st[kt] = (f32x4){0.f, 0.f, 0.f, 0.f};
            if (pwave) {
#pragma unroll
                for (int j = 0; j < 4; ++j) st[kt][j] = ((16 * kt + 4 * quad + j) == (16 * vb + vl)) ? 1.f : 0.f; }
            if (MODE == 2 && active) { const u32x2 w = *(const u32x2*)((const bf16*)(WSP(F) + WS_SG) + (size_t)it * 4096 + (16 * vb + vl) * 64 + 16 * kt + 4 * quad); st[kt] = (f32x4){blo(w.x), bhi(w.x), blo(w.y), bhi(w.y)}; } }
        const unsigned aoff = (unsigned)(vl * 144 + quad * 8), loffc = (unsigned)(9216 + (16 * vb + vl) * 144 + quad * 8);
        RBAR();
#pragma unroll
        for (int c = 0; c < 16; ++c) {
            if (c + 2 < 16) { SWRITE((c + 2) & 3, c + 2); if (c + 6 < 16) SLOAD((c + 2) & 3, c + 6); }
            if (active) {
                const LAS unsigned char* sl = ring + (c % NSL) * SLOT;
                bf16x8_t bfr[2];
                { u32x2 pk[4];
#pragma unroll
                  for (int kt = 0; kt < 4; ++kt) { pk[kt] = (u32x2){pg8::cvt_pk_bf16(st[kt][0], st[kt][1]), pg8::cvt_pk_bf16(st[kt][2], st[kt][3])};
                      if (MODE == 1) *(u32x2*)((bf16*)(WSP(F) + WS_SG) + ((size_t)it * 16 + c) * 4096 + (16 * vb + vl) * 64 + 16 * kt + 4 * quad) = pk[kt];
                      if (MODE == 2) *(u32x2*)((bf16*)(WSP(F) + WS_S0) + (opbase + (size_t)c * 4096) + (16 * vb + vl) * 64 + 16 * kt + 4 * quad) = pk[kt]; }
                  bfr[0] = __builtin_bit_cast(bf16x8_t, (u32x4){pk[0].x, pk[0].y, pk[1].x, pk[1].y}); bfr[1] = __builtin_bit_cast(bf16x8_t, (u32x4){pk[2].x, pk[2].y, pk[3].x, pk[3].y}); }
#pragma unroll
                for (int kt = 0; kt < 4; ++kt) { f32x4 acc = {0.f, 0.f, 0.f, 0.f};
                    if (!pwave) { const u32x2 lf = *(const LAS u32x2*)(sl + loffc + kt * 32); acc = (f32x4){blo(lf.x), bhi(lf.x), blo(lf.y), bhi(lf.y)}; }
#pragma unroll
                    for (int s2 = 0; s2 < 2; ++s2) { const u32x2 a0 = *(const LAS u32x2*)(sl + aoff + kt * 16 * 144 + s2 * 64), a1 = *(const LAS u32x2*)(sl + aoff + kt * 16 * 144 + s2 * 64 + 32);
                        acc = __builtin_amdgcn_mfma_f32_16x16x32_bf16(__builtin_bit_cast(bf16x8_t, (u32x4){a0.x, a0.y, a1.x, a1.y}), bfr[s2], acc, 0, 0, 0); }
                    st[kt] = acc; }
            }
            RBAR();
        }
        if (MODE == 0) {
            bf16* pg = (bf16*)(WSP(F) + WS_PGT) + (size_t)it * 4096; bf16* lg = (bf16*)(WSP(F) + WS_LG) + (size_t)it * 4096;
#pragma unroll
            for (int kt = 0; kt < 4; ++kt) {
                if (pwave) {
#pragma unroll
                    for (int j = 0; j < 4; ++j) pg[(16 * kt + 4 * quad + j) * 64 + 16 * vb + vl] = (bf16)f2bf(st[kt][j]);
                } else *(u32x2*)(lg + (16 * vb + vl) * 64 + 16 * kt + 4 * quad) = (u32x2){pg8::cvt_pk_bf16(st[kt][0], st[kt][1]), pg8::cvt_pk_bf16(st[kt][2], st[kt][3])}; }
        }
#undef SLOAD
#undef SWRITE
    }
#undef RBAR
    __syncthreads();
}
DI void rwkv_out_phase(Frame& F, int l) {
    bf16* AR = (bf16*)(WSP(F) + WS_AR); const size_t AS = (size_t)T * 512; const float* bonus = (const float*)(WSP(F) + WS_BONUS);
    const bf16* RM = (const bf16*)(WSP(F) + WS_RM); const bf16* Y0 = (const bf16*)(WSP(F) + WS_Y0); const bf16* S0 = (const bf16*)(WSP(F) + WS_S0);
    const int gw = F.bid * 8 + F.wave, NGW = F.G * 8, lane = F.lane, li = lane & 15, quad = lane >> 4;
    for (int it = gw; it < BATCH * 8 * (SEQ / 64); it += NGW) {
        const int bh = it >> 8, ck = it & 255, b = bh >> 3, h = bh & 7;
        const bf16* s0 = S0 + (size_t)it * 4096; const bf16* rm = RM + (size_t)it * 4096; const bf16* y0 = Y0 + (size_t)it * 4096;
        bf16x8_t sa[4][2];
#pragma unroll
        for (int vt = 0; vt < 4; ++vt)
#pragma unroll
            for (int s2 = 0; s2 < 2; ++s2) sa[vt][s2] = *(const bf16x8_t*)(s0 + (16 * vt + li) * 64 + 32 * s2 + 8 * quad);
        float lg[4][4], lb[4][4];
#pragma unroll
        for (int vt = 0; vt < 4; ++vt) { const f32x4 g4 = *(const f32x4*)(INP(F, 14) + l * 512 + h * 64 + 16 * vt + 4 * quad), b4 = *(const f32x4*)(INP(F, 15) + l * 512 + h * 64 + 16 * vt + 4 * quad);
            lg[vt][0] = g4.x; lg[vt][1] = g4.y; lg[vt][2] = g4.z; lg[vt][3] = g4.w; lb[vt][0] = b4.x; lb[vt][1] = b4.y; lb[vt][2] = b4.z; lb[vt][3] = b4.w; }
#pragma unroll 1
        for (int tt = 0; tt < 4; ++tt) {
            const int tch = 16 * tt + li; const size_t t = (size_t)b * SEQ + ck * 64 + tch;
            bf16x8_t rb[2];
#pragma unroll
            for (int s2 = 0; s2 < 2; ++s2) rb[s2] = *(const bf16x8_t*)(rm + tch * 64 + 32 * s2 + 8 * quad);
            f32x4 acc[4];
#pragma unroll
            for (int vt = 0; vt < 4; ++vt) { const u32x2 yw = *(const u32x2*)(y0 + tch * 64 + 16 * vt + 4 * quad); acc[vt] = (f32x4){blo(yw.x), bhi(yw.x), blo(yw.y), bhi(yw.y)};
                acc[vt] = __builtin_amdgcn_mfma_f32_16x16x32_bf16(sa[vt][0], rb[0], acc[vt], 0, 0, 0); acc[vt] = __builtin_amdgcn_mfma_f32_16x16x32_bf16(sa[vt][1], rb[1], acc[vt], 0, 0, 0); }
            float sm = 0.f;
#pragma unroll
            for (int vt = 0; vt < 4; ++vt) sm += (acc[vt][0] + acc[vt][1]) + (acc[vt][2] + acc[vt][3]);
            sm += __shfl_xor(sm, 16); sm += __shfl_xor(sm, 32);
            const float mean = sm * (1.f / 64.f); float sq = 0.f;
#pragma unroll
            for (int vt = 0; vt < 4; ++vt)
#pragma unroll
                for (int e = 0; e < 4; ++e) { const float d = acc[vt][e] - mean; acc[vt][e] = d; sq += d * d; }
            sq += __shfl_xor(sq, 16); sq += __shfl_xor(sq, 32);
            const float rstd = rsqrtf(sq * (1.f / 64.f) + 64e-5f), bon = bonus[t * 8 + h];
            const size_t idx = t * 512 + h * 64 + 4 * quad;
#pragma unroll
            for (int vt = 0; vt < 4; ++vt) { const u32x2 vw = *(const u32x2*)(AR + 3 * AS + idx + 16 * vt), gw2 = *(const u32x2*)(AR + 6 * AS + idx + 16 * vt);
                const float vv[4] = {blo(vw.x), bhi(vw.x), blo(vw.y), bhi(vw.y)}, gg[4] = {blo(gw2.x), bhi(gw2.x), blo(gw2.y), bhi(gw2.y)}; float o[4];
#pragma unroll
                for (int e = 0; e < 4; ++e) o[e] = (acc[vt][e] * rstd * lg[vt][e] + lb[vt][e] + bon * vv[e]) * gg[e];
                *(u32x2*)(AR + idx + 16 * vt) = (u32x2){pk2(o[0], o[1]), pk2(o[2], o[3])}; }
        }
    }
}
DI void route_phase(Frame& F, int l) {
    const float* x = OUTP(F); bf16* h2 = (bf16*)(WSP(F) + WS_XB); const bf16* RWH = (const bf16*)(WSP(F) + WS_RWG); const bf16* RWL = RWH + 48 * 1024;
    int* route = (int*)(WSP(F) + WS_ROUTE); float* rwt = (float*)(WSP(F) + WS_RWT); unsigned* cnt = (unsigned*)(WSP(F) + WS_CTL) + CW_CNT + 32 * l;
    const float* rgb = INP(F, 24) + l * 4; const float* reb = INP(F, 26) + l * 32;
    LAS unsigned* lc = (LAS unsigned*)(F.lds + MISC_OFF + 8192); unsigned* wgbase = (unsigned*)(WSP(F) + WS_WGBASE);
    for (int wit = F.bid; wit < T / 128; wit += F.G) {
        int lane = F.lane; asm volatile("" : "+v"(lane));
        __syncthreads();
        if (F.tid < 32) lc[F.tid] = 0u;
        __syncthreads();
        const int it = wit * 8 + F.wave;
        const int li = lane & 15, quad = lane >> 4; const size_t t = (size_t)it * 16 + li;
        const float* xr = x + t * DM + 8 * quad;
        f32x4 acc[3];
#pragma unroll
        for (int jt = 0; jt < 3; ++jt) acc[jt] = (f32x4){0.f, 0.f, 0.f, 0.f};
        float ss = 0.f;
        LAS unsigned char* wbuf = F.lds;
        u32x4 wst[3]; f32x4 xc[8], xn[8];
#define WLOAD(kc) do { _Pragma("unroll") for (int i = 0; i < 3; ++i) { const int p_ = F.tid + 512 * i, hl_ = p_ / 768, q_ = p_ % 768, r_ = q_ >> 4, c_ = q_ & 15; \
            wst[i] = *(const u32x4*)((hl_ ? RWL : RWH) + (size_t)r_ * 1024 + (kc) * 128 + c_ * 8); } } while (0)
#define WSTORE(bf) do { _Pragma("unroll") for (int i = 0; i < 3; ++i) { const int p_ = F.tid + 512 * i, hl_ = p_ / 768, q_ = p_ % 768, r_ = q_ >> 4, c_ = q_ & 15; \
            *(LAS u32x4*)(wbuf + (bf) * 26112 + hl_ * 13056 + r_ * 272 + c_ * 16) = wst[i]; } } while (0)
#define XLOAD(dst, kc) do { _Pragma("unroll") for (int k_ = 0; k_ < 4; ++k_) { dst[2 * k_] = *(const f32x4*)(xr + (kc) * 128 + 32 * k_); dst[2 * k_ + 1] = *(const f32x4*)(xr + (kc) * 128 + 32 * k_ + 4); } } while (0)
        WLOAD(0); XLOAD(xc, 0);
        WSTORE(0);
        __syncthreads();
#pragma unroll
        for (int kc = 0; kc < 8; ++kc) {
            if (kc < 7) { WLOAD(kc + 1); XLOAD(xn, kc + 1); }
            const LAS unsigned char* wb = wbuf + (kc & 1) * 26112;
#pragma unroll
            for (int k4 = 0; k4 < 4; ++k4) {
                const f32x4 x0 = xc[2 * k4], x1 = xc[2 * k4 + 1];
                ss += (x0.x * x0.x + x0.y * x0.y) + (x0.z * x0.z + x0.w * x0.w) + (x1.x * x1.x + x1.y * x1.y) + (x1.z * x1.z + x1.w * x1.w);
                const unsigned h0 = pk2(x0.x, x0.y), h1 = pk2(x0.z, x0.w), h2_ = pk2(x1.x, x1.y), h3 = pk2(x1.z, x1.w);
                const bf16x8_t bh = __builtin_bit_cast(bf16x8_t, (u32x4){h0, h1, h2_, h3});
                const bf16x8_t bl = __builtin_bit_cast(bf16x8_t, (u32x4){pk2(x0.x - blo(h0), x0.y - bhi(h0)), pk2(x0.z - blo(h1), x0.w - bhi(h1)), pk2(x1.x - blo(h2_), x1.y - bhi(h2_)), pk2(x1.z - blo(h3), x1.w - bhi(h3))});
#pragma unroll
                for (int jt = 0; jt < 3; ++jt) { const LAS unsigned char* wp = wb + (16 * jt + li) * 272 + k4 * 64 + quad * 16;
                    const bf16x8_t wh = *(const LAS bf16x8_t*)wp, wl = *(const LAS bf16x8_t*)(wp + 13056);
                    acc[jt] = __builtin_amdgcn_mfma_f32_16x16x32_bf16(wh, bh, acc[jt], 0, 0, 0);
                    acc[jt] = __builtin_amdgcn_mfma_f32_16x16x32_bf16(wl, bh, acc[jt], 0, 0, 0);
                    acc[jt] = __builtin_amdgcn_mfma_f32_16x16x32_bf16(wh, bl, acc[jt], 0, 0, 0); }
            }
            if (kc < 7) { WSTORE((kc + 1) & 1);
#pragma unroll
                for (int i = 0; i < 8; ++i) xc[i] = xn[i]; }
            __syncthreads();
        }
#undef WLOAD
#undef WSTORE
#undef XLOAD
        ss += __shfl_xor(ss, 16); ss += __shfl_xor(ss, 32);
        const float rs = rsqrtf(ss * (1.f / DM) + 1e-6f);
#pragma unroll 4
        for (int ks = 0; ks < 32; ++ks) { const f32x4 x0 = *(const f32x4*)(xr + 32 * ks), x1 = *(const f32x4*)(xr + 32 * ks + 4);
            *(u32x4*)(h2 + t * DM + 32 * ks + 8 * quad) = (u32x4){pk2(x0.x * rs, x0.y * rs), pk2(x0.z * rs, x0.w * rs), pk2(x1.x * rs, x1.y * rs), pk2(x1.z * rs, x1.w * rs)}; }
        float gl[4]; int grp = 0;
#pragma unroll
        for (int j = 0; j < 4; ++j) gl[j] = acc[0][j] * rs + rgb[j];
        float gm = gl[0];
#pragma unroll
        for (int j = 1; j < 4; ++j) if (gl[j] > gm) { gm = gl[j]; grp = j; }
        if (quad == grp) {
            float gs = 0.f;
#pragma unroll
            for (int j = 0; j < 4; ++j) gs += __expf(gl[j] - gm);
            const float gprob = frcp_(gs);
            float eg[8];
#pragma unroll
            for (int i = 0; i < 4; ++i) { eg[i] = acc[1][i] * rs + reb[8 * quad + i]; eg[4 + i] = acc[2][i] * rs + reb[8 * quad + 4 + i]; }
            int i0 = 0; float m0 = eg[0];
#pragma unroll
            for (int i = 1; i < 8; ++i) if (eg[i] > m0) { m0 = eg[i]; i0 = i; }
            int i1 = -1; float m1 = -INFINITY;
#pragma unroll
            for (int i = 0; i < 8; ++i) if (i != i0 && eg[i] > m1) { m1 = eg[i]; i1 = i; }
            const float e10 = fexp_(m1 - m0), r10 = frcp_(1.0f + e10), wa = gprob * r10, wb = gprob * e10 * r10;
            const int e0 = grp * 8 + i0, e1 = grp * 8 + i1;
            const unsigned r0 = atomicAdd((unsigned*)(lc + e0), 1u), r1 = atomicAdd((unsigned*)(lc + e1), 1u);
            ((int4*)route)[t] = make_int4(e0, (int)r0, e1, (int)r1); ((float2*)rwt)[t] = make_float2(wa, wb);
        }
        __syncthreads();
        if (F.tid < 32) { const unsigned c = lc[F.tid]; wgbase[wit * 32 + F.tid] = c ? atomicAdd(cnt + F.tid, c) : 0u; }
    }
    __syncthreads();
}
DI int moe_tables(Frame& F, int l) {
    LAS int* ps = (LAS int*)(F.lds + MISC_OFF); LAS unsigned char* te = (LAS unsigned char*)(F.lds + MISC_OFF + 256);
    const unsigned* cnt = (const unsigned*)(WSP(F) + WS_CTL) + CW_CNT + 32 * l;
    __syncthreads();
    if (F.tid == 0) { int acc = 0;
_Pragma("unroll 1")
        for (int e = 0; e < NEXP; ++e) { ps[e] = acc; const int c = (int)__hip_atomic_load(cnt + e, __ATOMIC_RELAXED, __HIP_MEMORY_SCOPE_AGENT); const int nt = (c + 255) >> 8;
_Pragma("unroll 1")
            for (int i = 0; i < nt; ++i) te[(acc >> 8) + i] = (unsigned char)e; acc += nt << 8; } ps[NEXP] = acc; }
    __syncthreads();
    return __builtin_amdgcn_readfirstlane(ps[NEXP] >> 8);
}
DI void permute_phase(Frame& F, int l) {
    moe_tables(F, l);
    const LAS int* ps = (const LAS int*)(F.lds + MISC_OFF);
    const bf16* h2 = (const bf16*)(WSP(F) + WS_XB); bf16* xp = (bf16*)(WSP(F) + WS_XPERM); const int* route = (const int*)(WSP(F) + WS_ROUTE); int* dest = (int*)(WSP(F) + WS_DEST);
    const int gw = F.bid * 8 + F.wave, NGW = F.G * 8, lane = F.lane;
    for (int t = gw; t < T; t += NGW) {
        const int4 r = ((const int4*)route)[t]; const unsigned* wb_ = (const unsigned*)(WSP(F) + WS_WGBASE) + (t >> 7) * 32; const int d0 = ps[r.x] + (int)wb_[r.x] + r.y, d1 = ps[r.z] + (int)wb_[r.z] + r.w;
        const u32x4* src = (const u32x4*)(h2 + (size_t)t * DM) + lane; u32x4* o0 = (u32x4*)(xp + (size_t)d0 * DM) + lane; u32x4* o1 = (u32x4*)(xp + (size_t)d1 * DM) + lane;
        const u32x4 a = src[0], b = src[64]; o0[0] = a; o0[64] = b; o1[0] = a; o1[64] = b;
        if (lane == 0) ((int2*)dest)[t] = make_int2(d0, d1);
    }
}
DI void combine_phase(Frame& F, int l) {
    float* x = OUTP(F); const bf16* Y = (const bf16*)(WSP(F) + WS_YMOE); const int* dest = (const int*)(WSP(F) + WS_DEST); const float* rwt = (const float*)(WSP(F) + WS_RWT);
    bf16* xb = (bf16*)(WSP(F) + WS_XB); const float* fg = INP(F, 30);
    const int gw = F.bid * 8 + F.wave, NGW = F.G * 8, lane = F.lane; const bool last = (l == DEPTH - 1);
    for (int t = gw; t < T; t += NGW) {
        const int2 d = ((const int2*)dest)[t]; const float2 w = ((const float2*)rwt)[t];
        f32x4* xr = (f32x4*)(x + (size_t)t * DM) + lane; const u32x2* y0 = (const u32x2*)(Y + (size_t)d.x * DM) + lane; const u32x2* y1 = (const u32x2*)(Y + (size_t)d.y * DM) + lane;
        f32x4 v[4]; float s = 0.f;
#pragma unroll
        for (int j = 0; j < 4; ++j) { v[j] = xr[64 * j]; const u32x2 a = y0[64 * j], b = y1[64 * j];
            v[j].x += w.x * blo(a.x) + w.y * blo(b.x); v[j].y += w.x * bhi(a.x) + w.y * bhi(b.x); v[j].z += w.x * blo(a.y) + w.y * blo(b.y); v[j].w += w.x * bhi(a.y) + w.y * bhi(b.y);
            s += (v[j].x * v[j].x + v[j].y * v[j].y) + (v[j].z * v[j].z + v[j].w * v[j].w); }
        const float rs = rsqrtf(wave_sum(s) * (1.f / DM) + 1e-6f);
        if (last) {
#pragma unroll
            for (int j = 0; j < 4; ++j) { const f32x4 g = ((const f32x4*)fg)[lane + 64 * j]; xr[64 * j] = v[j] * rs * g; }
        } else {
            u32x2* o = (u32x2*)(xb + (size_t)t * DM) + lane;
#pragma unroll
            for (int j = 0; j < 4; ++j) { xr[64 * j] = v[j]; o[64 * j] = (u32x2){pk2(v[j].x * rs, v[j].y * rs), pk2(v[j].z * rs, v[j].w * rs)}; }
        }
    }
}

DI void dump_bf16(Frame& F, const bf16* src, int pitch, int ncols, int c0) {
    float* out = OUTP(F);
    for (size_t i = (size_t)F.bid * 512 + F.tid; i < (size_t)T * ncols; i += (size_t)F.G * 512) { const size_t t = i / ncols; const int c = (int)(i % ncols); out[t * DM + c0 + c] = bf2f(src[t * pitch + c]); }
}
__global__ void __launch_bounds__(512, 2) mk_fwd(Args args) {
    extern __shared__ __attribute__((aligned(16))) unsigned char lds_raw[];
    cg::grid_group grid = cg::this_grid();
    Frame F; F.lds = (LAS unsigned char*)lds_raw; F.tid = threadIdx.x; F.lane = F.tid & 63; F.wave = __builtin_amdgcn_readfirstlane(F.tid >> 6); F.G = gridDim.x; F.bid = (int)__builtin_amdgcn_workgroup_id_x();
    F.kp = (kargp_t)__builtin_amdgcn_kernarg_segment_ptr();
    for (int u = F.tid; u < 64; u += 512) ((LAS unsigned*)(F.lds + MISC_OFF + 4096))[u] = 0u;
    __syncthreads();
    (void)xcd_barrier_post((unsigned*)(WSP(F) + WS_CTL) + CW_BAR, (volatile LAS unsigned*)(F.lds + MISC_OFF + 4096));
    grid.sync();
#define GRID_BAR() do { XcdBarrier bb_; bb_.bar = (unsigned*)(WSP(F) + WS_CTL) + CW_BAR; bb_.x = xb_xcc_id(); bb_.st = (volatile LAS unsigned*)(F.lds + MISC_OFF + 4096); xcd_barrier(bb_); fence_frame(F); } while (0)
#define ws WSP(F)
#if defined(DBG_TMASK)
#define PT0() const unsigned long long pt0_ = __builtin_amdgcn_s_memrealtime()
#define PT1(k) do { if ((DBG_TMASK >> (k)) & 1) { const unsigned long long n_ = __builtin_amdgcn_s_memrealtime(); const unsigned long long e_ = n_ + (unsigned long long)DBG_AMP * (n_ - pt0_); while (__builtin_amdgcn_s_memrealtime() < e_) __builtin_amdgcn_s_sleep(16); } } while (0)
#else
#define PT0() do {} while (0)
#define PT1(k) do {} while (0)
#endif
    { PT0(); prep_mixer_weights(F, 0);
    rms_rows_to_bf16(F, INP(F, 0), (bf16*)(ws + WS_XB));
    GRID_BAR(); PT1(0); }
#if defined(DBG_STOP) && DBG_STOP == 10
    { PT0(); { pg8::Gemm g{(const bf16*)(ws + WS_XB), (const bf16*)(ws + WS_WG), T, 3072, DM}; pg8::StaticOrder S; S.init(T, 3072, F.G, (int)F.bid);
      pg8::EpiGate E{(unsigned char*)(ws + WS_GATES), 3072};
      pg8::gemm_phase<pg8::EpiGate, pg8::StaticOrder, true, true>(F.lds, g, S, E); }
    GRID_BAR(); PT1(10); }
    dump_bf16(F, (const bf16*)(ws + WS_GATES) + 1024, 3072, 1024, 0); return;
#endif
#pragma unroll 1
    for (int l = 0; l < DEPTH; ++l) {
        { PT0(); { pg8::Gemm g{(const bf16*)(ws + WS_XB), (const bf16*)(ws + WS_WIN), T, l == 0 ? 3840 : 4096, DM}; pg8::StaticOrder S; S.init(T, g.N, F.G, (int)F.bid);
          pg8::EpiZ E{(bf16*)(ws + WS_Q), (bf16*)(ws + WS_K), (bf16*)(ws + WS_VT), (bf16*)(ws + WS_POOLZ), (bf16*)(ws + WS_RWKVZ), C2, SEQ};
          pg8::gemm_phase<pg8::EpiZ, pg8::StaticOrder, true, true>(F.lds, g, S, E); }
        GRID_BAR(); PT1(1); }
        { PT0(); kmean_phase(F);
        pool_phase(F, l);
        GRID_BAR(); PT1(2); }
        { PT0(); sel_phase(F, l);
        GRID_BAR(); PT1(3); }
        { PT0(); att_phase(F, l);
        GRID_BAR(); PT1(4); }
        { PT0(); comb_phase(F);
        GRID_BAR(); PT1(5); }
#if defined(DBG_STOP) && DBG_STOP == 3
        dump_bf16(F, (const bf16*)(ws + WS_YATTN), 512, 512, 0); dump_bf16(F, (const bf16*)(ws + WS_YPOOL), 512, 512, 512); return;
#endif

        { PT0(); rwkv_chunk_phase(F, l);
        GRID_BAR(); PT1(7); }
        { PT0(); state_scan16<0>(F);
        GRID_BAR();
        state_scan16<1>(F);
        GRID_BAR();
        state_scan16<2>(F);
        GRID_BAR(); PT1(8); }
        { PT0(); rwkv_out_phase(F, l);
        GRID_BAR(); PT1(9); }
        { pg8::Gemm g{(const bf16*)(ws + WS_XB), (const bf16*)(ws + WS_WG), T, 3072, DM}; pg8::StaticOrder S; S.init(T, 3072, F.G, (int)F.bid);
          pg8::EpiGate E{(unsigned char*)(ws + WS_GATES), 3072};
          pg8::gemm_phase<pg8::EpiGate, pg8::StaticOrder, true, true>(F.lds, g, S, E); }
        GRID_BAR();
#if defined(DBG_SCRUB)
        { const f32x4* xs = (const f32x4*)INP(F, 0) + (size_t)F.bid * 32768; f32x4 a = {0.f, 0.f, 0.f, 0.f};
          for (int i = F.tid; i < 32768; i += 512) a += xs[i];
          if (a.x + a.y + a.z + a.w == 12345.678f) ((float*)(ws + WS_BONUS))[F.tid] = a.x; }
        GRID_BAR();
#endif
        { PT0(); { pg8::StaticOrder S; S.init(T, DM, F.G, (int)F.bid);
          { pg8::Gemm g{(const bf16*)(ws + WS_YATTN), (const bf16*)(ws + WS_WBR), T, DM, 512};
            pg8::EpiMerge<true> E{(bf16*)(ws + WS_XB), DM, (const unsigned char*)(ws + WS_GATES), 3072, 0};
            pg8::gemm_phase<pg8::EpiMerge<true>, pg8::StaticOrder, true, true>(F.lds, g, S, E); }
          { pg8::Gemm g{(const bf16*)(ws + WS_AR), (const bf16*)(ws + WS_WBR) + (size_t)1024 * 512, T, DM, 512};
            pg8::EpiMerge<false> E{(bf16*)(ws + WS_XB), DM, (const unsigned char*)(ws + WS_GATES), 3072, 1024};
            pg8::gemm_phase<pg8::EpiMerge<false>, pg8::StaticOrder, true, true>(F.lds, g, S, E); }
          { pg8::Gemm g{(const bf16*)(ws + WS_YPOOL), (const bf16*)(ws + WS_WBR) + (size_t)2 * 1024 * 512, T, DM, 512};
            pg8::EpiMerge<false> E{(bf16*)(ws + WS_XB), DM, (const unsigned char*)(ws + WS_GATES), 3072, 2048};
            pg8::gemm_phase<pg8::EpiMerge<false>, pg8::StaticOrder, true, true>(F.lds, g, S, E); } }
        GRID_BAR(); PT1(11); }
#if defined(DBG_STOP) && DBG_STOP == 7
        dump_bf16(F, (const bf16*)(ws + WS_XB), 1024, 1024, 0); return;
#endif
#if defined(DBG_STOP) && DBG_STOP == 6
        dump_bf16(F, (const bf16*)(ws + WS_GATES) + 1024, 3072, 1024, 0); return;
#endif
        { PT0(); { pg8::Gemm g{(const bf16*)(ws + WS_XB), (const bf16*)(ws + WS_WOUT), T, DM, DM}; pg8::StaticOrder S; S.init(T, DM, F.G, (int)F.bid);
          pg8::EpiResF32 E{l == 0 ? INP(F, 0) : OUTP(F), OUTP(F), DM};
          pg8::gemm_phase<pg8::EpiResF32, pg8::StaticOrder, true, true>(F.lds, g, S, E); }
        GRID_BAR(); PT1(12); }
#if defined(DBG_STOP) && DBG_STOP == 1
        return;
#endif
        { PT0(); route_phase(F, l);
#if defined(DBG_TMASK)
        GRID_BAR(); PT1(13); } { PT0();
#endif
        prep_expert_weights(F, l);
        GRID_BAR(); PT1(18); }
        { PT0(); permute_phase(F, l);
        GRID_BAR(); PT1(14); }
        { const int ntile = moe_tables(F, l);
          const LAS unsigned char* te = (const LAS unsigned char*)(F.lds + MISC_OFF + 256);
          { PT0(); { pg8::Gemm g{(const bf16*)(ws + WS_XPERM), (const bf16*)(ws + WS_W13), RMAX, NEXP * 1024, DM}; pg8::MoeOrder S{te, ntile * 4, F.G, (int)F.bid};
            pg8::EpiSwiGLU E{(bf16*)(ws + WS_HACT)};
            pg8::gemm_phase<pg8::EpiSwiGLU, pg8::MoeOrder, true, true>(F.lds, g, S, E); }
          GRID_BAR(); PT1(15); }
          { PT0(); { pg8::Gemm g{(const bf16*)(ws + WS_HACT), (const bf16*)(ws + WS_W2), RMAX, NEXP * 1024, 512}; pg8::MoeOrder S{te, ntile * 4, F.G, (int)F.bid};
            pg8::EpiY E{(bf16*)(ws + WS_YMOE)};
            pg8::gemm_phase<pg8::EpiY, pg8::MoeOrder, true, true>(F.lds, g, S, E); }
        GRID_BAR(); PT1(16); } }
        { PT0(); combine_phase(F, l);
        if (l + 1 < DEPTH) prep_mixer_weights(F, l + 1);
        GRID_BAR(); PT1(17); }
#if defined(DBG_STOP) && DBG_STOP == 2
        return;
#endif
    }
#undef ws
}

extern "C" void kernel_launch(void* const* d_in, const int* in_sizes, int n_in, void* d_out, int out_size, void* d_ws, size_t ws_size, hipStream_t stream) {
    static int grid = 0;
    if (grid == 0) {
        if (n_in != 31 || out_size != T * DM || ws_size < WS_END) { fprintf(stderr, "kernel_launch: unexpected shapes (n_in %d out %d ws %zu, need %zu)\n", n_in, out_size, ws_size, (size_t)WS_END); grid = -1; return; }
        int dev = 0, cus = 0, per_cu = 0;
        (void)hipGetDevice(&dev); (void)hipDeviceGetAttribute(&cus, hipDeviceAttributeMultiprocessorCount, dev);
        (void)hipFuncSetAttribute((const void*)mk_fwd, hipFuncAttributeMaxDynamicSharedMemorySize, LDS_BYTES);
        (void)hipOccupancyMaxActiveBlocksPerMultiprocessor(&per_cu, (const void*)mk_fwd, 512, LDS_BYTES);
        (void)hipGetLastError();
        fprintf(stderr, "kernel_launch: cus %d per_cu %d ws %zu\n", cus, per_cu, ws_size);
        grid = cus;
    }
    if (grid < 0) return;
    (void)hipMemsetAsync((char*)d_ws + WS_CTL, 0, CTL_BYTES, stream);
    Args a{};
    for (int i = 0; i < 31; ++i) a.in[i] = (const float*)d_in[i];
    a.out = (float*)d_out; a.ws = (unsigned char*)d_ws;
    void* kargs[] = {&a};
    hipError_t e = hipLaunchCooperativeKernel((const void*)mk_fwd, dim3(grid), dim3(512), kargs, LDS_BYTES, stream);
    if (e != hipSuccess) fprintf(stderr, "cooperative launch failed: %s (grid %d)\n", hipGetErrorString(e), grid);
}
```

```cpp
#include <hip/hip_runtime.h>
#include <hip/hip_cooperative_groups.h>
#include <cstdio>
#include <cstdint>
#include <cmath>
namespace pg8 {
#define PG8_LAS __attribute__((address_space(3)))
typedef unsigned short bf16_t;
typedef short bf16x8 __attribute__((ext_vector_type(8)));
typedef float f32x4 __attribute__((ext_vector_type(4)));
typedef unsigned u32x4 __attribute__((ext_vector_type(4)));
constexpr int BM = 256, BK = 64, HALF = 128, HTB = HALF * BK * 2  , STAGE_BYTES = 8 * HTB, NXCD = 8, WGM = 8;

__host__ __device__ __forceinline__ int lds_byte(int r, int c) { const int st = (r >> 4) * 2 + (c >> 5), rr = r & 15, cc = c & 31, ob = rr * 64 + cc * 2; return st * 1024 + (ob ^ (((ob >> 9) & 1) << 5)); }
__host__ __device__ __forceinline__ void stage_rc(int b, int& R, int& C) { const int st = b / 1024, sb = b % 1024, swz = sb ^ (((sb >> 9) & 1) << 5); R = (st >> 1) * 16 + swz / 64; C = (st & 1) * 32 + (swz % 64) / 2; }
__host__ __device__ __forceinline__ int perm32(int rho) { const int n = rho >> 4, i = rho & 15; return 8 * (i >> 2) + 4 * n + (i & 3); }

struct Unit { int pm, pn; };
struct Gemm { const bf16_t* A; const bf16_t* Bt; int M, N, K; };

struct StaticOrder {
    int nM, nN, nwg, G, c;
    __host__ __device__ void init(int M, int N, int G_, int c_) { nM = M / BM; nN = N / BM; nwg = nM * nN; G = G_; c = c_; }
    __host__ __device__ bool next(int i, Unit& u) const {
        const long L = (long)i * G + c; if (L >= nwg) return false;
        int wgid = (int)L; { const int q = nwg / NXCD, r = nwg % NXCD, xcd = wgid % NXCD, off = wgid / NXCD; wgid = (xcd < r ? xcd * (q + 1) : r * (q + 1) + (xcd - r) * q) + off; }
        const int nig = WGM * nN, gid = wgid / nig, fm = gid * WGM, gsz = (nM - fm) < WGM ? (nM - fm) : WGM;
        u.pm = fm + ((wgid % nig) % gsz); u.pn = (wgid % nig) / gsz; return true;
    }
    __device__ __forceinline__ void a_ready(const Unit&) const {}
    __device__ __forceinline__ void done(const Unit&) const {}
};

typedef float f32x2c_t __attribute__((ext_vector_type(2))); typedef __bf16 bf16x2c_t __attribute__((ext_vector_type(2)));
__device__ __forceinline__ unsigned cvt_pk_bf16(float lo, float hi) { const f32x2c_t v = {lo, hi}; const bf16x2c_t b = __builtin_convertvector(v, bf16x2c_t); return __builtin_bit_cast(unsigned, b); }
typedef float f32x2 __attribute__((ext_vector_type(2)));
__device__ __forceinline__ float fast_sigmoid(float x) { return __builtin_amdgcn_rcpf(1.0f + __builtin_amdgcn_exp2f(-1.4426950408889634f * x)); }
struct EpiZ {
    static constexpr bool PERM = true, AFTER_DRAIN = false;
    bf16_t *q, *k, *vt, *poolz, *rwkvz; float qscale; int seq;
    __device__ __forceinline__ void operator()(const f32x4 (&acc)[2][2][4][2], const Unit& u, int wr, int wc, int fr, int fq) const {
        const int pn = u.pn;
        if (pn == 4 || pn == 5) {
            const int row0 = u.pm * BM + wr * 64 + fr, c0 = (pn - 4) * 256 + wc * 32 + 8 * fq;
#pragma unroll
            for (int ai = 0; ai < 2; ++ai)
#pragma unroll
                for (int m = 0; m < 4; ++m) { const int row = row0 + ai * HALF + m * 16, b = row / seq, tl = row - b * seq;
#pragma unroll
                    for (int bj = 0; bj < 2; ++bj) { const int c = c0 + bj * HALF, h = c >> 6, d = c & 63; bf16_t* vp = vt + ((size_t)(b * 8 + h) * 64 + d) * seq + tl;
                        const unsigned w0 = cvt_pk_bf16(acc[ai][bj][m][0][0], acc[ai][bj][m][0][1]), w1 = cvt_pk_bf16(acc[ai][bj][m][0][2], acc[ai][bj][m][0][3]);
                        const unsigned w2 = cvt_pk_bf16(acc[ai][bj][m][1][0], acc[ai][bj][m][1][1]), w3 = cvt_pk_bf16(acc[ai][bj][m][1][2], acc[ai][bj][m][1][3]);
                        vp[0] = (bf16_t)(w0 & 0xffffu); vp[(size_t)seq] = (bf16_t)(w0 >> 16); vp[(size_t)2 * seq] = (bf16_t)(w1 & 0xffffu); vp[(size_t)3 * seq] = (bf16_t)(w1 >> 16);
                        vp[(size_t)4 * seq] = (bf16_t)(w2 & 0xffffu); vp[(size_t)5 * seq] = (bf16_t)(w2 >> 16); vp[(size_t)6 * seq] = (bf16_t)(w3 & 0xffffu); vp[(size_t)7 * seq] = (bf16_t)(w3 >> 16); } }
            return;
        }
        bf16_t* base; int ldc, colt, climit; float sc = 1.f;
        if (pn < 2) { base = q; ldc = 512; colt = pn * 256; climit = 512; sc = qscale; }
        else if (pn < 4) { base = k; ldc = 512; colt = (pn - 2) * 256; climit = 512; }
        else if (pn < 8) { base = poolz; ldc = 512; colt = (pn - 6) * 256; climit = 512; }
        else { base = rwkvz; ldc = 1824; colt = (pn - 8) * 256; climit = 1824; }
        const int row0 = u.pm * BM + wr * 64 + fr, col0 = colt + wc * 32 + 8 * fq;
#pragma unroll
        for (int ai = 0; ai < 2; ++ai)
#pragma unroll
            for (int m = 0; m < 4; ++m) { bf16_t* rowp = base + (size_t)(row0 + ai * HALF + m * 16) * ldc + col0;
#pragma unroll
                for (int bj = 0; bj < 2; ++bj) { if (col0 + bj * HALF < climit) { const f32x4 v0 = acc[ai][bj][m][0] * sc, v1 = acc[ai][bj][m][1] * sc;
                    u32x4 w; w.x = cvt_pk_bf16(v0[0], v0[1]); w.y = cvt_pk_bf16(v0[2], v0[3]); w.z = cvt_pk_bf16(v1[0], v1[1]); w.w = cvt_pk_bf16(v1[2], v1[3]);
                    *(u32x4*)(rowp + bj * HALF) = w; } } }
    }
};
typedef unsigned u32x2e __attribute__((ext_vector_type(2)));
struct EpiGate {
    static constexpr bool PERM = true, AFTER_DRAIN = false;
    unsigned char* O; int ldc;
    __device__ __forceinline__ void operator()(const f32x4 (&acc)[2][2][4][2], const Unit& u, int wr, int wc, int fr, int fq) const {
        const int row0 = u.pm * BM + wr * 64 + fr, col0 = u.pn * BM + wc * 32 + 8 * fq;
#pragma unroll
        for (int ai = 0; ai < 2; ++ai)
#pragma unroll
            for (int m = 0; m < 4; ++m) { unsigned char* rowp = O + (size_t)(row0 + ai * HALF + m * 16) * ldc + col0;
#pragma unroll
                for (int bj = 0; bj < 2; ++bj) { const f32x4 v0 = acc[ai][bj][m][0], v1 = acc[ai][bj][m][1]; unsigned q[8];
#pragma unroll
                    for (int e = 0; e < 4; ++e) { q[e] = (unsigned)(fast_sigmoid(v0[e]) * 255.0f + 0.5f); q[4 + e] = (unsigned)(fast_sigmoid(v1[e]) * 255.0f + 0.5f); }
                    *(u32x2e*)(rowp + bj * HALF) = (u32x2e){q[0] | (q[1] << 8) | (q[2] << 16) | (q[3] << 24), q[4] | (q[5] << 8) | (q[6] << 16) | (q[7] << 24)}; } }
    }
};
__device__ __forceinline__ float bflo(unsigned w) { return __uint_as_float(w << 16); }
__device__ __forceinline__ float bfhi(unsigned w) { return __uint_as_float(w & 0xffff0000u); }
template <bool FIRST> struct EpiMerge {
    static constexpr bool PERM = true, AFTER_DRAIN = false;
    bf16_t* O; int ldc; const unsigned char* gate; int ldg, goff;
    __device__ __forceinline__ void operator()(const f32x4 (&acc)[2][2][4][2], const Unit& u, int wr, int wc, int fr, int fq) const {
        const int row0 = u.pm * BM + wr * 64 + fr, col0 = u.pn * BM + wc * 32 + 8 * fq;
#pragma unroll
        for (int ai = 0; ai < 2; ++ai)
#pragma unroll
            for (int m = 0; m < 4; ++m) { const size_t r = (size_t)(row0 + ai * HALF + m * 16); bf16_t* rowp = O + r * ldc + col0; const unsigned char* gp = gate + r * ldg + goff + col0;
#pragma unroll
                for (int bj = 0; bj < 2; ++bj) { const f32x4 v0 = acc[ai][bj][m][0], v1 = acc[ai][bj][m][1];
                    const u32x2e g = *(const u32x2e*)(gp + bj * HALF); const float s = 1.0f / 255.0f;
                    float o[8] = {v0[0] * (float)(g.x & 255u) * s, v0[1] * (float)((g.x >> 8) & 255u) * s, v0[2] * (float)((g.x >> 16) & 255u) * s, v0[3] * (float)(g.x >> 24) * s,
                                  v1[0] * (float)(g.y & 255u) * s, v1[1] * (float)((g.y >> 8) & 255u) * s, v1[2] * (float)((g.y >> 16) & 255u) * s, v1[3] * (float)(g.y >> 24) * s};
                    if (!FIRST) { const u32x4 p = *(const u32x4*)(rowp + bj * HALF);
                        o[0] += bflo(p.x); o[1] += bfhi(p.x); o[2] += bflo(p.y); o[3] += bfhi(p.y); o[4] += bflo(p.z); o[5] += bfhi(p.z); o[6] += bflo(p.w); o[7] += bfhi(p.w); }
                    u32x4 w; w.x = cvt_pk_bf16(o[0], o[1]); w.y = cvt_pk_bf16(o[2], o[3]); w.z = cvt_pk_bf16(o[4], o[5]); w.w = cvt_pk_bf16(o[6], o[7]);
                    *(u32x4*)(rowp + bj * HALF) = w; } }
    }
};
struct EpiResF32 {
    static constexpr bool PERM = false, AFTER_DRAIN = false;
    const float* base; float* out; int ldc;
    __device__ __forceinline__ void operator()(const f32x4 (&acc)[2][2][4][2], const Unit& u, int wr, int wc, int fr, int fq) const {
        const int row0 = u.pm * BM + wr * 64 + fr, col0 = u.pn * BM + wc * 32 + 4 * fq;
#pragma unroll
        for (int ai = 0; ai < 2; ++ai)
#pragma unroll
            for (int m = 0; m < 4; ++m) { const size_t off = (size_t)(row0 + ai * HALF + m * 16) * ldc + col0;
#pragma unroll
                for (int bj = 0; bj < 2; ++bj)
#pragma unroll
                    for (int n = 0; n < 2; ++n) { const f32x4 bs = *(const f32x4*)(base + off + bj * HALF + n * 16); *(f32x4*)(out + off + bj * HALF + n * 16) = bs + acc[ai][bj][m][n]; } }
    }
};
struct EpiSwiGLU {
    static constexpr bool PERM = true, AFTER_DRAIN = false;
    bf16_t* O;
    __device__ __forceinline__ void operator()(const f32x4 (&acc)[2][2][4][2], const Unit& u, int wr, int wc, int fr, int fq) const {
        const int row0 = u.pm * BM + wr * 64 + fr, col0 = (u.pn & 3) * 128 + wc * 32 + 8 * fq;
#pragma unroll
        for (int ai = 0; ai < 2; ++ai)
#pragma unroll
            for (int m = 0; m < 4; ++m) { bf16_t* rowp = O + (size_t)(row0 + ai * HALF + m * 16) * 512 + col0;
                float o[8];
#pragma unroll
                for (int n = 0; n < 2; ++n)
#pragma unroll
                    for (int e = 0; e < 4; ++e) { const float a1 = acc[ai][0][m][n][e], a3 = acc[ai][1][m][n][e]; o[n * 4 + e] = a1 * fast_sigmoid(a1) * a3; }
                u32x4 w; w.x = cvt_pk_bf16(o[0], o[1]); w.y = cvt_pk_bf16(o[2], o[3]); w.z = cvt_pk_bf16(o[4], o[5]); w.w = cvt_pk_bf16(o[6], o[7]);
                *(u32x4*)rowp = w; }
    }
};
struct EpiY {
    static constexpr bool PERM = true, AFTER_DRAIN = false;
    bf16_t* O;
    __device__ __forceinline__ void operator()(const f32x4 (&acc)[2][2][4][2], const Unit& u, int wr, int wc, int fr, int fq) const {
        const int row0 = u.pm * BM + wr * 64 + fr, col0 = (u.pn & 3) * BM + wc * 32 + 8 * fq;
#pragma unroll
        for (int ai = 0; ai < 2; ++ai)
#pragma unroll
            for (int m = 0; m < 4; ++m) { bf16_t* rowp = O + (size_t)(row0 + ai * HALF + m * 16) * 1024 + col0;
#pragma unroll
                for (int bj = 0; bj < 2; ++bj) { const f32x4 v0 = acc[ai][bj][m][0], v1 = acc[ai][bj][m][1];
                    u32x4 w; w.x = cvt_pk_bf16(v0[0], v0[1]); w.y = cvt_pk_bf16(v0[2], v0[3]); w.z = cvt_pk_bf16(v1[0], v1[1]); w.w = cvt_pk_bf16(v1[2], v1[3]);
                    *(u32x4*)(rowp + bj * HALF) = w; } }
    }
};
struct MoeOrder {
    const PG8_LAS unsigned char* tile_e; int nunits, G, c;
    __device__ __forceinline__ bool next(int i, Unit& u) const {
        const int L = i * G + c; if (L >= nunits) return false;
        const int pm = L >> 2; u.pm = pm; u.pn = __builtin_amdgcn_readfirstlane((int)tile_e[pm]) * 4 + (L & 3); return true;
    }
    __device__ __forceinline__ void a_ready(const Unit&) const {}
    __device__ __forceinline__ void done(const Unit&) const {}
};
template <class Epi, class Sched, bool ALIGN_EPI = false, bool SP2 = false>
__device__ __forceinline__ void gemm_phase(PG8_LAS unsigned char* lds, const Gemm g, const Sched& S, const Epi& E) {
    int tid = threadIdx.x; asm volatile("" : "+v"(tid));
    const int wid = __builtin_amdgcn_readfirstlane(tid >> 6), lane = tid & 63, wr = wid >> 2, wc = wid & 3, fr = lane & 15, fq = lane >> 4;
    const int K = g.K, nt = K / BK;
    unsigned voffA[2], voffB[2];
#pragma unroll
    for (int i = 0; i < 2; ++i) { int R, C; stage_rc(tid * 16 + i * 8192, R, C); const int Rb = Epi::PERM ? ((R & ~31) + perm32(R & 31)) : R;
        voffA[i] = (unsigned)(R * K + C) * 2u; voffB[i] = (unsigned)(Rb * K + C) * 2u; }
    const size_t kstep = (size_t)(BK * 2);
    const size_t hstep = (size_t)HALF * K * 2;
    const size_t tstep = 2 * hstep;
    const unsigned ldsw = (unsigned)wid * 1024u;
    const int aoff = lds_byte(wr * 64 + fr, fq * 8), boff = lds_byte(wc * 32 + fr, fq * 8);
#define PG8_SA(b, h) (((b) * 2 + (h)) * HTB)
#define PG8_SB(b, h) ((4 + (b) * 2 + (h)) * HTB)
#define PG8_STAGE(bufoff, gbase, voff) do { _Pragma("unroll") for (int _i = 0; _i < 2; ++_i) \
        __builtin_amdgcn_global_load_lds((const unsigned*)((const char*)(gbase) + (voff)[_i]), (PG8_LAS unsigned*)(lds + (bufoff) + ldsw + _i * 8192), 16, 0, 0); } while (0)
#define PG8_LDA(dst, b, h) do { _Pragma("unroll") for (int m = 0; m < 4; ++m) _Pragma("unroll") for (int k = 0; k < 2; ++k) dst[m][k] = *(const PG8_LAS bf16x8*)(lds + PG8_SA(b, h) + aoff + m * 2048 + k * 1024); } while (0)
#define PG8_LDB(dst, b, h) do { _Pragma("unroll") for (int n = 0; n < 2; ++n) _Pragma("unroll") for (int k = 0; k < 2; ++k) dst[n][k] = *(const PG8_LAS bf16x8*)(lds + PG8_SB(b, h) + boff + n * 2048 + k * 1024); } while (0)
#define PG8_MMA(ai, bj, At, Bt) do { __builtin_amdgcn_s_setprio(1); _Pragma("unroll") for (int m = 0; m < 4; ++m) _Pragma("unroll") for (int n = 0; n < 2; ++n) _Pragma("unroll") for (int k = 0; k < 2; ++k) \
        acc[ai][bj][m][n] = __builtin_amdgcn_mfma_f32_16x16x32_bf16(Bt[n][k], At[m][k], acc[ai][bj][m][n], 0, 0, 0); __builtin_amdgcn_s_setprio(0); } while (0)
#define PG8_WAIT_V(n) asm volatile("s_waitcnt vmcnt(" #n ")" ::: "memory")
#define PG8_WAIT_L(n) asm volatile("s_waitcnt lgkmcnt(" #n ")" ::: "memory")
#define PG8_BAR __builtin_amdgcn_s_barrier()
#define PG8_SCHED __builtin_amdgcn_sched_barrier(0)
    Unit cur, nxt; int ui = 0;
    if (!S.next(0, cur)) return;
    f32x4 acc[2][2][4][2];
#pragma unroll
    for (int a = 0; a < 2; ++a)
#pragma unroll
        for (int b = 0; b < 2; ++b)
#pragma unroll
            for (int m = 0; m < 4; ++m)
#pragma unroll
                for (int n = 0; n < 2; ++n) acc[a][b][m][n] = (f32x4){0.f, 0.f, 0.f, 0.f};
    bf16x8 At[4][2], B0[2][2], B1[2][2];
    const char* cA = (const char*)g.A + (size_t)cur.pm * tstep; const char* cB = (const char*)g.Bt + (size_t)cur.pn * tstep;
    S.a_ready(cur);
    if constexpr (SP2) {
        PG8_STAGE(PG8_SB(0, 0), cB, voffB); PG8_STAGE(PG8_SB(0, 1), cB + hstep, voffB); PG8_STAGE(PG8_SA(0, 0), cA, voffA); PG8_STAGE(PG8_SA(0, 1), cA + hstep, voffA);
        if (wr == 1) PG8_BAR;
        PG8_WAIT_V(2); PG8_BAR;
        PG8_STAGE(PG8_SB(1, 0), cB + kstep, voffB); PG8_STAGE(PG8_SA(1, 0), cA + kstep, voffA); PG8_STAGE(PG8_SB(1, 1), cB + hstep + kstep, voffB);
        PG8_WAIT_V(6); PG8_BAR;
    } else {
        PG8_STAGE(PG8_SB(0, 0), cB, voffB); PG8_STAGE(PG8_SA(0, 0), cA, voffA); PG8_STAGE(PG8_SB(0, 1), cB + hstep, voffB); PG8_STAGE(PG8_SA(0, 1), cA + hstep, voffA);
        if (wr == 1) PG8_BAR;
        PG8_WAIT_V(4); PG8_BAR;
        PG8_STAGE(PG8_SB(1, 0), cB + kstep, voffB); PG8_STAGE(PG8_SA(1, 0), cA + kstep, voffA); PG8_STAGE(PG8_SB(1, 1), cB + hstep + kstep, voffB);
        PG8_WAIT_V(6); PG8_BAR;
    }
    for (;;) {
        const bool has_next = S.next(ui + 1, nxt);
        const char* nA = has_next ? (const char*)g.A + (size_t)nxt.pm * tstep : cA; const char* nB = has_next ? (const char*)g.Bt + (size_t)nxt.pn * tstep : cB;
        for (int t = 0; t < nt; t += 2) {
            const bool last = (t == nt - 2);
            const char* a1 = cA + (size_t)(t + 1) * kstep;
            const char* a2 = last ? nA : cA + (size_t)(t + 2) * kstep; const char* b2 = last ? nB : cB + (size_t)(t + 2) * kstep;
            const char* a3 = a2 + kstep; const char* b3 = b2 + kstep;
            if (last && has_next) S.a_ready(nxt);
            if constexpr (SP2) {
            PG8_LDB(B0, 0, 0); PG8_LDB(B1, 0, 1); PG8_SCHED; PG8_LDA(At, 0, 0); PG8_STAGE(PG8_SA(1, 1), a1 + hstep, voffA);
            PG8_WAIT_V(8); PG8_WAIT_L(0); PG8_BAR; PG8_MMA(0, 0, At, B0); PG8_MMA(0, 1, At, B1); PG8_BAR; PG8_SCHED;
            PG8_LDA(At, 0, 1); PG8_STAGE(PG8_SB(0, 0), b2, voffB); PG8_STAGE(PG8_SB(0, 1), b2 + hstep, voffB); PG8_STAGE(PG8_SA(0, 0), a2, voffA);
            PG8_WAIT_V(8); PG8_WAIT_L(0); PG8_BAR; PG8_MMA(1, 0, At, B0); PG8_MMA(1, 1, At, B1); PG8_BAR; PG8_SCHED;
            PG8_LDB(B0, 1, 0); PG8_LDB(B1, 1, 1); PG8_SCHED; PG8_LDA(At, 1, 0); PG8_STAGE(PG8_SA(0, 1), a2 + hstep, voffA);
            PG8_WAIT_V(8); PG8_WAIT_L(0); PG8_BAR; PG8_MMA(0, 0, At, B0); PG8_MMA(0, 1, At, B1); PG8_BAR; PG8_SCHED;
            PG8_LDA(At, 1, 1); PG8_STAGE(PG8_SB(1, 0), b3, voffB); PG8_STAGE(PG8_SB(1, 1), b3 + hstep, voffB); PG8_STAGE(PG8_SA(1, 0), a3, voffA);
            PG8_WAIT_V(8); PG8_WAIT_L(0); PG8_BAR; PG8_MMA(1, 0, At, B0); PG8_MMA(1, 1, At, B1); PG8_BAR; PG8_SCHED;
            } else {
            PG8_LDB(B0, 0, 0); PG8_SCHED; PG8_LDA(At, 0, 0); PG8_STAGE(PG8_SA(1, 1), a1 + hstep, voffA);
            PG8_WAIT_L(8); PG8_BAR; PG8_WAIT_L(0); PG8_MMA(0, 0, At, B0); PG8_BAR; PG8_SCHED;
            PG8_LDB(B1, 0, 1); PG8_STAGE(PG8_SB(0, 0), b2, voffB);
            PG8_BAR; PG8_WAIT_L(0); PG8_MMA(0, 1, At, B1); PG8_BAR;
            PG8_LDA(At, 0, 1); PG8_STAGE(PG8_SA(0, 0), a2, voffA);
            PG8_BAR; PG8_WAIT_L(0); PG8_MMA(1, 0, At, B0); PG8_BAR; PG8_SCHED;
            PG8_STAGE(PG8_SB(0, 1), b2 + hstep, voffB);
            PG8_WAIT_V(6); PG8_BAR; PG8_MMA(1, 1, At, B1); PG8_BAR;
            PG8_LDB(B0, 1, 0); PG8_SCHED; PG8_LDA(At, 1, 0); PG8_STAGE(PG8_SA(0, 1), a2 + hstep, voffA);
            PG8_WAIT_L(8); PG8_BAR; PG8_WAIT_L(0); PG8_MMA(0, 0, At, B0); PG8_BAR; PG8_SCHED;
            PG8_LDB(B1, 1, 1); PG8_STAGE(PG8_SB(1, 0), b3, voffB);
            PG8_BAR; PG8_WAIT_L(0); PG8_MMA(0, 1, At, B1); PG8_BAR;
            PG8_LDA(At, 1, 1); PG8_STAGE(PG8_SA(1, 0), a3, voffA);
            PG8_BAR; PG8_WAIT_L(0); PG8_MMA(1, 0, At, B0); PG8_BAR; PG8_SCHED;
            PG8_STAGE(PG8_SB(1, 1), b3 + hstep, voffB);
            PG8_WAIT_V(6); PG8_BAR; PG8_MMA(1, 1, At, B1); PG8_BAR;
            }
        }
        if constexpr (ALIGN_EPI) { if (wr == 0) PG8_BAR; }
        if constexpr (!Epi::AFTER_DRAIN) { E(acc, cur, wr, wc, fr, fq); S.done(cur); }
        if (!has_next) break;
#pragma unroll
        for (int a = 0; a < 2; ++a)
#pragma unroll
            for (int b = 0; b < 2; ++b)
#pragma unroll
                for (int m = 0; m < 4; ++m)
#pragma unroll
                    for (int n = 0; n < 2; ++n) acc[a][b][m][n] = (f32x4){0.f, 0.f, 0.f, 0.f};
        cur = nxt; cA = nA; cB = nB; ++ui;
        if constexpr (ALIGN_EPI) { if (wr == 1) PG8_BAR; }
    }
    PG8_WAIT_V(0);
    if constexpr (!ALIGN_EPI) { if (wr == 0) PG8_BAR; }
    PG8_BAR;
    if constexpr (Epi::AFTER_DRAIN) { E.fused(acc, cur, wr, wc, fr, fq, lds, wid, lane); S.done(cur); }
#undef PG8_SA
#undef PG8_SB
#undef PG8_STAGE
#undef PG8_LDA
#undef PG8_LDB
#undef PG8_MMA
#undef PG8_WAIT_V
#undef PG8_WAIT_L
#undef PG8_BAR
#undef PG8_SCHED
}
}
namespace cg = cooperative_groups;
#define DI __device__ __forceinline__
#define LAS __attribute__((address_space(3)))
typedef unsigned short bf16;
typedef float f32x4 __attribute__((ext_vector_type(4)));
typedef unsigned u32x4 __attribute__((ext_vector_type(4)));
typedef unsigned u32x2 __attribute__((ext_vector_type(2)));
typedef short bf16x8_t __attribute__((ext_vector_type(8)));

constexpr int BATCH = 2, SEQ = 16384, DM = 1024, T = BATCH * SEQ, DEPTH = 2;
constexpr int NEXP = 32, RZP = 1824;
constexpr int RMAX = 73728;
constexpr float C2 = 0.125f * 1.4426950408889634f;
constexpr float LOG2E = 1.4426950408889634f;
constexpr size_t MiB = 1u << 20;
constexpr size_t WS_CTL = 0, CTL_BYTES = 1 * MiB;
constexpr size_t WS_WIN = 1 * MiB, WS_WG = 9 * MiB, WS_WBR = 15 * MiB, WS_WOUT = 18 * MiB;
constexpr size_t WS_KMEAN = 20 * MiB, WS_RWG = 20 * MiB + 512 * 1024, WS_ROUTE = 21 * MiB, WS_RWT = 22 * MiB, WS_DEST = 22 * MiB + 512 * 1024, WS_BONUS = 23 * MiB, WS_WLT = 24 * MiB, WS_WPT = 24 * MiB + 512 * 1024, WS_WGBASE = 24 * MiB + 768 * 1024, WS_KINV = 25 * MiB, WS_PGT = 26 * MiB, WS_LG = 28 * MiB, WS_SG = 30 * MiB;
constexpr size_t WS_XB = 32 * MiB, WS_VFIRST = 96 * MiB, WS_YPOOL = 128 * MiB, WS_YATTN = 160 * MiB;
constexpr size_t WS_BIG = 192 * MiB;
constexpr size_t WS_Q = WS_BIG, WS_K = WS_BIG + 32 * MiB, WS_V = WS_BIG + 64 * MiB, WS_POOLZ = WS_BIG + 232 * MiB, WS_RWKVZ = WS_BIG + 264 * MiB;
constexpr size_t WS_AR = WS_BIG;
constexpr size_t WS_GATES = WS_BIG + 32 * MiB;
constexpr size_t WS_XPERM = WS_BIG, WS_HACT = WS_BIG + 144 * MiB, WS_W13 = WS_BIG + 216 * MiB, WS_W2 = WS_BIG + 280 * MiB, WS_YMOE = WS_BIG;
constexpr size_t WS_VT = WS_YATTN;
constexpr size_t WS_PARTO = WS_BIG + 96 * MiB, WS_PARTML = WS_BIG + 224 * MiB;
constexpr size_t WS_LIST = WS_BIG + 378 * MiB;
constexpr size_t WS_PCT = WS_BIG + 32 * MiB, WS_LC = WS_BIG + 64 * MiB, WS_RM = WS_BIG + 128 * MiB, WS_Y0 = WS_BIG + 160 * MiB, WS_S0 = WS_BIG + 352 * MiB;
constexpr int LSTRIDE = 516096;
constexpr size_t WS_END = WS_BIG + 394 * MiB;
static_assert(WS_LIST + (size_t)16 * LSTRIDE * 2 <= WS_END, "ws map");
static_assert(WS_RWKVZ + (size_t)T * RZP * 2 <= WS_END, "ws map");
static_assert(WS_W2 + (size_t)32 * 1024 * 512 * 2 <= WS_END, "ws map");
constexpr int CW_CNT = 64, CW_LCNT = 1024, CW_BAR = 4096;
constexpr int LDS_BYTES = 147456, MISC_OFF = 131072;

DI float bf2f(unsigned short u) { return __uint_as_float((unsigned)u << 16); }
DI unsigned f2bf(float f) { return pg8::cvt_pk_bf16(f, 0.f) & 0xffffu; }
DI unsigned pk2(float lo, float hi) { return pg8::cvt_pk_bf16(lo, hi); }
DI float blo(unsigned w) { return __uint_as_float(w << 16); }
DI float bhi(unsigned w) { return __uint_as_float(w & 0xffff0000u); }
DI float wave_sum(float v) {
#pragma unroll
    for (int o = 1; o < 64; o <<= 1) v += __shfl_xor(v, o);
    return v;
}
DI float wave_max(float v) {
#pragma unroll
    for (int o = 1; o < 64; o <<= 1) v = fmaxf(v, __shfl_xor(v, o));
    return v;
}
DI float fexp_(float x) { return __builtin_amdgcn_exp2f(x * 1.4426950408889634f); }
DI float frcp_(float x) { return __builtin_amdgcn_rcpf(x); }
DI float sigmoidf_(float x) { return frcp_(1.0f + fexp_(-x)); }
DI float ftanh_(float x) { return 1.0f - 2.0f * frcp_(1.0f + fexp_(2.0f * x)); }
DI float fsoftplus_(float x) { return x > 20.f ? x : __builtin_amdgcn_logf(1.0f + fexp_(x)) * 0.6931471805599453f; }
#define LDS_WAIT() asm volatile("s_waitcnt lgkmcnt(0)" ::: "memory")

#define XB_TMO      128
#define XB_XCNT(j)  (256  + 64 * (j))
#define XB_XSUB(j)  (1280 + 64 * (j))
#define XB_XGEN(j)  (2304 + 64 * (j))
#define XB_TOP      3328
#define XB_TOPGEN   3392
#define XCD_BAR_WORDS 3456
#define XB_SPIN_CAP (1u << 27)

__device__ __forceinline__ unsigned xb_ld(unsigned* p)              { return __hip_atomic_load(p, __ATOMIC_RELAXED, __HIP_MEMORY_SCOPE_AGENT); }
__device__ __forceinline__ unsigned xb_add(unsigned* p, unsigned v) { return __hip_atomic_fetch_add(p, v, __ATOMIC_RELAXED, __HIP_MEMORY_SCOPE_AGENT); }
__device__ __forceinline__ unsigned xb_xcc_id() { return (unsigned)__builtin_amdgcn_s_getreg((3 << 11) | 20) & 0xFu; }
#define XB_SPIN(cond, bar) do { unsigned _sp = 0; while (cond) { __builtin_amdgcn_s_sleep(1); \
    if ((++_sp & 255u) == 0u) { if (xb_ld(&(bar)[XB_TMO])) break; if (_sp > XB_SPIN_CAP) { atomicAdd(&(bar)[XB_TMO], 1u); break; } } } } while (0)

struct XcdBarrier {
    unsigned* bar; unsigned x;
    volatile LAS unsigned* st;
};

__device__ __forceinline__ XcdBarrier xcd_barrier_post(unsigned* bar, volatile LAS unsigned* st) {
    XcdBarrier b; b.bar = bar; b.x = xb_xcc_id(); b.st = st;
    if (threadIdx.x == 0) (void)xb_add(&bar[XB_XCNT(b.x)], 1u);
    return b;
}
__device__ __forceinline__ void xcd_barrier_complete(unsigned* bar, unsigned x, unsigned& nloc, unsigned& nx) {
    const unsigned G = gridDim.x * gridDim.y * gridDim.z;
    unsigned sum, cnt, mine, sp = 0u;
    for (;;) {
        sum = 0u; cnt = 0u; mine = 0u;
#pragma unroll
        for (unsigned j = 0; j < 16; ++j) { const unsigned c = xb_ld(&bar[XB_XCNT(j)]); sum += c; cnt += (c > 0u) ? 1u : 0u; mine = (j == x) ? c : mine; }
        if (sum == G) break;
        __builtin_amdgcn_s_sleep(1);
        if ((++sp & 255u) == 0u) { if (xb_ld(&bar[XB_TMO])) break; if (sp > XB_SPIN_CAP) { atomicAdd(&bar[XB_TMO], 1u); break; } }
    }
    nloc = mine > 0u ? mine : 1u; nx = cnt > 0u ? cnt : 1u;
}

__device__ __forceinline__ void xcd_barrier(const XcdBarrier& b) {
    asm volatile("s_waitcnt vmcnt(0)" ::: "memory");
    __syncthreads();
    if (threadIdx.x == 0) {
        unsigned* bar = b.bar;
        __builtin_amdgcn_s_waitcnt(0);
        unsigned nloc = b.st[0], nx = b.st[1];
        if (nloc == 0u) { xcd_barrier_complete(bar, b.x, nloc, nx); b.st[0] = nloc; b.st[1] = nx; }
        const unsigned old = xb_add(&bar[XB_XSUB(b.x)], 1u);
        const unsigned gen = old / nloc;
        if (old + 1u == (gen + 1u) * nloc) {
            __builtin_amdgcn_fence(__ATOMIC_RELEASE, "agent");
            asm volatile("s_waitcnt vmcnt(0)" ::: "memory");
            const unsigned og = xb_add(&bar[XB_TOP], 1u);
            const unsigned tg = og / nx;
            if (og + 1u == (tg + 1u) * nx) xb_add(&bar[XB_TOPGEN], 1u);
            else XB_SPIN(xb_ld(&bar[XB_TOPGEN]) == tg, bar);
            __builtin_amdgcn_fence(__ATOMIC_ACQUIRE, "agent");
            xb_add(&bar[XB_XGEN(b.x)], 1u);
            asm volatile("s_waitcnt vmcnt(0)" ::: "memory");
        } else {
            XB_SPIN(xb_ld(&bar[XB_XGEN(b.x)]) == gen, bar);
            __builtin_amdgcn_fence(__ATOMIC_ACQUIRE, "agent");
            asm volatile("s_waitcnt vmcnt(0)" ::: "memory");
        }
    }
    __syncthreads();
}

struct Args { const float* in[31]; float* out; unsigned char* ws; };

typedef const __attribute__((address_space(4))) unsigned long long* kargp_t;
struct Frame {
    LAS unsigned char* lds; int tid, lane, wave, G, bid;
    kargp_t kp;
};
#define GASQ __attribute__((address_space(1)))
DI const float* INP(const Frame& F, int i) { return (const float*)(const GASQ float*)F.kp[i]; }
DI float* OUTP(const Frame& F) { return (float*)(GASQ float*)F.kp[31]; }
DI unsigned char* WSP(const Frame& F) { return (unsigned char*)(GASQ unsigned char*)F.kp[32]; }
DI void fence_frame(Frame& F) {
    asm volatile("" : "+s"(F.kp) :: "memory"); asm volatile("" : "+s"(F.G)); asm volatile("" : "+s"(F.bid));
    F.tid = threadIdx.x; asm volatile("" : "+v"(F.tid)); F.lane = F.tid & 63; F.wave = __builtin_amdgcn_readfirstlane(F.tid >> 6); }

DI void transpose_item(const float* W, int ldw, int ncols, bf16* WT, int ldt, const float* scale, LAS float* scr, int item, int lane) {
    const int nblk = ncols / 32, kb = item / nblk, nb = item % nblk, k0 = 64 * kb, n0 = 32 * nb;
    { const int rs = lane >> 3, c4 = (lane & 7) * 4; f32x4 v[8]; float sc[8];
#pragma unroll
      for (int i = 0; i < 8; ++i) { v[i] = *(const f32x4*)(W + (size_t)(k0 + 8 * i + rs) * ldw + n0 + c4); sc[i] = scale ? scale[k0 + 8 * i + rs] : 1.0f; }
#pragma unroll
      for (int i = 0; i < 8; ++i) { LAS float* d = scr + (8 * i + rs) * 33 + c4; d[0] = v[i].x * sc[i]; d[1] = v[i].y * sc[i]; d[2] = v[i].z * sc[i]; d[3] = v[i].w * sc[i]; } }
    LDS_WAIT(); asm volatile("" ::: "memory");
    const int c = lane & 7;
#pragma unroll
    for (int j = 0; j < 4; ++j) { const int n = (lane >> 3) + 8 * j; const LAS float* s = scr + (8 * c) * 33 + n;
        u32x4 o; o.x = pk2(s[0 * 33], s[1 * 33]); o.y = pk2(s[2 * 33], s[3 * 33]); o.z = pk2(s[4 * 33], s[5 * 33]); o.w = pk2(s[6 * 33], s[7 * 33]);
        *(u32x4*)(WT + (size_t)(n0 + n) * ldt + k0 + 8 * c) = o; }
    LDS_WAIT(); asm volatile("" ::: "memory");
}
DI void prep_mixer_weights(Frame& F, int l) {
    LAS float* scr = (LAS float*)(F.lds + F.wave * 16384);
    const int gw = F.bid * 8 + F.wave, NGW = F.G * 8;
    const float* w_in = INP(F, 2) + (size_t)l * 1024 * 6912; const float* g1 = INP(F, 1) + l * 1024;
    bf16* WIN = (bf16*)(WSP(F) + WS_WIN); bf16* WG = (bf16*)(WSP(F) + WS_WG); bf16* WBR = (bf16*)(WSP(F) + WS_WBR); bf16* WOUT = (bf16*)(WSP(F) + WS_WOUT);
    constexpr int I1 = 16 * (1536 / 32), I2 = 16 * (2304 / 32), I3 = 16 * 1, I4 = 16 * (3072 / 32), I5 = 8 * (1024 / 32), I6 = 16 * (1024 / 32);
    const int n3 = l > 0 ? I3 : 0;
    const int total = I1 + I2 + n3 + I4 + 3 * I5 + I6;
    for (int it = gw; it < total; it += NGW) {
        int r = it;
        if (r < I1) { transpose_item(w_in, 6912, 1536, WIN, 1024, g1, scr, r, F.lane); continue; } r -= I1;
        if (r < I2) { transpose_item(w_in + 4608, 6912, 2304, WIN + (size_t)1536 * 1024, 1024, g1, scr, r, F.lane); continue; } r -= I2;
        if (r < n3) { transpose_item(INP(F, 3) + (size_t)(l - 1) * 1024 * 32, 32, 32, WIN + (size_t)3840 * 1024, 1024, g1, scr, r, F.lane); continue; } r -= n3;
        if (r < I4) { transpose_item(w_in + 1536, 6912, 3072, WG, 1024, g1, scr, r, F.lane); continue; } r -= I4;
        if (r < 3 * I5) { const int i = r / I5; transpose_item(INP(F, 20) + (size_t)(l * 3 + i) * 512 * 1024, 1024, 1024, WBR + (size_t)i * 1024 * 512, 512, i == 2 ? INP(F, 19) + l * 512 : nullptr, scr, r % I5, F.lane); continue; } r -= 3 * I5;
        transpose_item(INP(F, 21) + (size_t)l * 1024 * 1024, 1024, 1024, WOUT, 1024, nullptr, scr, r, F.lane);
    }
    if (l > 0) {
        u32x4* z = (u32x4*)(WIN + (size_t)3872 * 1024); const int n16 = 224 * 1024 * 2 / 16;
        for (int i = F.bid * 512 + F.tid; i < n16; i += F.G * 512) z[i] = (u32x4){0u, 0u, 0u, 0u};
    }
    { bf16* WPT = (bf16*)(WSP(F) + WS_WPT);
      for (int it = gw; it < 32; it += NGW) transpose_item(INP(F, 18) + (size_t)(l * 4 + (it >> 3)) * 128 * 128, 128, 128, WPT + (size_t)(it >> 3) * 128 * 128, 128, nullptr, scr, it & 7, F.lane); }
    { bf16* WLT = (bf16*)(WSP(F) + WS_WLT);
      constexpr int L1 = 1 * 16, L2 = 1 * 16, L3 = 2 * 16;
      for (int it = gw; it < L1 + L2 + L3; it += NGW) {
          if (it < L1) transpose_item(INP(F, 7) + (size_t)l * 64 * 512, 512, 512, WLT, 288, nullptr, scr, it, F.lane);
          else if (it < L1 + L2) transpose_item(INP(F, 9) + (size_t)l * 64 * 512, 512, 512, WLT + 64, 288, nullptr, scr, it - L1, F.lane);
          else transpose_item(INP(F, 10) + (size_t)l * 128 * 512, 512, 512, WLT + 128, 288, nullptr, scr, it - L1 - L2, F.lane); }
      const float* wv = INP(F, 17) + (size_t)(l > 0 ? l - 1 : 0) * 32 * 512;
      for (int i = F.bid * 512 + F.tid; i < 32 * 512; i += F.G * 512) { const int k = i >> 9, ch = i & 511; WLT[(size_t)ch * 288 + 256 + k] = (bf16)f2bf(l > 0 ? wv[k * 512 + ch] : 0.f); } }
    { bf16* RWH = (bf16*)(WSP(F) + WS_RWG); bf16* RWL = RWH + 48 * 1024; const float* g2 = INP(F, 22) + l * 1024; const float* rgw = INP(F, 23) + (size_t)l * 1024 * 4; const float* rew = INP(F, 25) + (size_t)l * 1024 * 32;
      for (int i = F.bid * 512 + F.tid; i < 48 * 1024; i += F.G * 512) { const int r = i >> 10, k = i & 1023;
          const float w = r < 16 ? rgw[k * 4 + (r & 3)] : r < 32 ? rew[k * 32 + 8 * ((r - 16) >> 2) + ((r - 16) & 3)] : rew[k * 32 + 8 * ((r - 32) >> 2) + 4 + ((r - 32) & 3)];
          const float v = g2[k] * w; const unsigned hb = f2bf(v); const float hf = __uint_as_float(hb << 16); RWH[i] = (bf16)hb; RWL[i] = (bf16)f2bf(v - hf); } }
}
DI void prep_expert_weights(Frame& F, int l) {
    LAS float* scr = (LAS float*)(F.lds + F.wave * 16384);
    const int gw = F.bid * 8 + F.wave, NGW = F.G * 8;
    const float* g2 = INP(F, 22) + l * 1024;
    bf16* W13 = (bf16*)(WSP(F) + WS_W13); bf16* W2 = (bf16*)(WSP(F) + WS_W2);
    constexpr int J13 = 64, N13 = NEXP * 2 * 4 * J13, J2 = 8 * 32, N2 = NEXP * J2;
    for (int it = gw; it < N13 + N2; it += NGW) {
        if (it < N13) { const int job = it / J13, item = it % J13, e = job >> 3, which = (job >> 2) & 1, grp = job & 3;
            const float* src = (which ? INP(F, 28) : INP(F, 27)) + ((size_t)(l * NEXP + e) * 1024) * 512 + grp * 128;
            transpose_item(src, 512, 128, W13 + ((size_t)e * 1024 + grp * 256 + which * 128) * 1024, 1024, g2, scr, item, F.lane);
        } else { const int r = it - N13, e = r / J2, item = r % J2;
            transpose_item(INP(F, 29) + (size_t)(l * NEXP + e) * 512 * 1024, 1024, 1024, W2 + (size_t)e * 1024 * 512, 512, nullptr, scr, item, F.lane); }
    }
}
DI void rms_rows_to_bf16(Frame& F, const float* x, bf16* xb) {
    const int gw = F.bid * 8 + F.wave, NGW = F.G * 8;
    for (int t = gw; t < T; t += NGW) {
        const f32x4* xr = (const f32x4*)(x + (size_t)t * DM) + F.lane; f32x4 v[4]; float s = 0.f;
#pragma unroll
        for (int j = 0; j < 4; ++j) { v[j] = xr[64 * j]; s += (v[j].x * v[j].x + v[j].y * v[j].y) + (v[j].z * v[j].z + v[j].w * v[j].w); }
        const float rs = rsqrtf(wave_sum(s) * (1.f / DM) + 1e-6f);
        u32x2* o = (u32x2*)(xb + (size_t)t * DM) + F.lane;
#pragma unroll
        for (int j = 0; j < 4; ++j) o[64 * j] = (u32x2){pk2(v[j].x * rs, v[j].y * rs), pk2(v[j].z * rs, v[j].w * rs)};
    }
}

DI void kmean_phase(Frame& F) {
    const bf16* K = (const bf16*)(WSP(F) + WS_K); float* kmean = (float*)(WSP(F) + WS_KMEAN);
    LAS float* red = (LAS float*)F.lds;
    for (int it = F.bid; it < BATCH * 8 * 64; it += F.G) {
        const int b = it >> 9, h = (it >> 6) & 7, n = it & 63, c8 = F.tid & 7, rg = F.tid >> 3;
        const bf16* kp = K + ((size_t)b * SEQ + n * 256 + rg * 4) * 512 + h * 64 + c8 * 8; float s[8] = {0.f, 0.f, 0.f, 0.f, 0.f, 0.f, 0.f, 0.f};
        u32x4 w[4];
#pragma unroll
        for (int i = 0; i < 4; ++i) w[i] = *(const u32x4*)(kp + (size_t)i * 512);
#pragma unroll
        for (int i = 0; i < 4; ++i) { s[0] += blo(w[i].x); s[1] += bhi(w[i].x); s[2] += blo(w[i].y); s[3] += bhi(w[i].y); s[4] += blo(w[i].z); s[5] += bhi(w[i].z); s[6] += blo(w[i].w); s[7] += bhi(w[i].w); }
        *(LAS f32x4*)(red + rg * 68 + c8 * 8) = (f32x4){s[0], s[1], s[2], s[3]}; *(LAS f32x4*)(red + rg * 68 + c8 * 8 + 4) = (f32x4){s[4], s[5], s[6], s[7]};
        __syncthreads();
        if (F.tid < 64) { float a = 0.f;
#pragma unroll 16
            for (int p = 0; p < 64; ++p) a += red[p * 68 + F.tid];
            kmean[(size_t)it * 64 + F.tid] = a * (1.f / 256.f); }
        __syncthreads();
    }
}
DI void vt_phase(Frame& F) {
    const bf16* V = (const bf16*)(WSP(F) + WS_V); bf16* VT = (bf16*)(WSP(F) + WS_VT);
    LAS bf16* tl = (LAS bf16*)(F.lds + 20480 + F.wave * 9216);
    const int gw = F.bid * 8 + F.wave, NGW = F.G * 8, lane = F.lane;
    for (int it = gw; it < BATCH * 8 * (SEQ / 64); it += NGW) {
        const int bh = it / (SEQ / 64), tt = it % (SEQ / 64), b = bh >> 3, h = bh & 7, t0 = tt * 64;
#pragma unroll
        for (int i = 0; i < 8; ++i) { const int r = i * 8 + (lane >> 3), c = lane & 7;
            const u32x4 w = *(const u32x4*)(V + ((size_t)b * SEQ + t0 + r) * 512 + h * 64 + c * 8); *(LAS u32x4*)(tl + r * 72 + c * 8) = w; }
        LDS_WAIT(); asm volatile("" ::: "memory");
#pragma unroll
        for (int i = 0; i < 8; ++i) { const int d = i * 8 + (lane >> 3), c = lane & 7; unsigned short e[8];
#pragma unroll
            for (int k = 0; k < 8; ++k) e[k] = tl[(8 * c + k) * 72 + d];
            u32x4 w; w.x = e[0] | ((unsigned)e[1] << 16); w.y = e[2] | ((unsigned)e[3] << 16); w.z = e[4] | ((unsigned)e[5] << 16); w.w = e[6] | ((unsigned)e[7] << 16);
            *(u32x4*)(VT + ((size_t)bh * 64 + d) * SEQ + t0 + c * 8) = w; }
        LDS_WAIT(); asm volatile("" ::: "memory");
    }
}
DI int list_off(int n) { return n * SEQ - 128 * n * (n + 1); }
DI void sel_phase(Frame& F, int l) {
    const bf16* Q = (const bf16*)(WSP(F) + WS_Q); const float* kmean = (const float*)(WSP(F) + WS_KMEAN);
    unsigned short* list = (unsigned short*)(WSP(F) + WS_LIST); unsigned* lcnt = (unsigned*)(WSP(F) + WS_CTL) + CW_LCNT + 1024 * l;
    LAS float* km = (LAS float*)F.lds;
    for (int it = F.bid; it < BATCH * 8 * (SEQ / 512); it += F.G) {
        const int pr = it % 256, bh = pr >> 4, g = (it < 256) ? (pr & 15) : 31 - (pr & 15), b = bh >> 3, h = bh & 7;
        __syncthreads();
        for (int i = F.tid; i < 1024; i += 512) ((LAS f32x4*)km)[i] = ((const f32x4*)(kmean + (size_t)bh * 4096))[i];
        __syncthreads();
        const int tl = g * 512 + F.tid, own = __builtin_amdgcn_readfirstlane(tl >> 8);
        float q[64];
        { const u32x4* qp = (const u32x4*)(Q + ((size_t)b * SEQ + tl) * 512 + h * 64);
#pragma unroll
          for (int c = 0; c < 8; ++c) { const u32x4 w = qp[c]; q[8 * c] = blo(w.x); q[8 * c + 1] = bhi(w.x); q[8 * c + 2] = blo(w.y); q[8 * c + 3] = bhi(w.y); q[8 * c + 4] = blo(w.z); q[8 * c + 5] = bhi(w.z); q[8 * c + 6] = blo(w.w); q[8 * c + 7] = bhi(w.w); } }
        float v0 = -INFINITY, v1 = -INFINITY, v2 = -INFINITY; int i0 = -1, i1 = -1, i2 = -1;
        for (int n = 0; n < own; ++n) { const LAS f32x4* kp = (const LAS f32x4*)(km + n * 64); float s0 = 0.f, s1 = 0.f;
#pragma unroll
            for (int i = 0; i < 16; i += 2) { const f32x4 a = kp[i], c = kp[i + 1];
                s0 += q[4 * i] * a.x + q[4 * i + 1] * a.y + q[4 * i + 2] * a.z + q[4 * i + 3] * a.w; s1 += q[4 * i + 4] * c.x + q[4 * i + 5] * c.y + q[4 * i + 6] * c.z + q[4 * i + 7] * c.w; }
            const float gte = s0 + s1; const bool c0 = gte > v0, c1 = gte > v1, c2 = gte > v2;
            v2 = c1 ? v1 : (c2 ? gte : v2); i2 = c1 ? i1 : (c2 ? n : i2);
            v1 = c0 ? v0 : (c1 ? gte : v1); i1 = c0 ? i0 : (c1 ? n : i1);
            v0 = c0 ? gte : v0; i0 = c0 ? n : i0; }
        LAS unsigned* lc = (LAS unsigned*)(F.lds + MISC_OFF + 8192); LAS unsigned* lbase = lc + 64;
        if (F.tid < 64) lc[F.tid] = 0u;
        __syncthreads();
        unsigned r0 = 0u, r1 = 0u, r2 = 0u;
        if (i0 >= 0) r0 = atomicAdd((unsigned*)(lc + i0), 1u);
        if (i1 >= 0) r1 = atomicAdd((unsigned*)(lc + i1), 1u);
        if (i2 >= 0) r2 = atomicAdd((unsigned*)(lc + i2), 1u);
        __syncthreads();
        if (F.tid < 64) { const unsigned c = lc[F.tid]; lbase[F.tid] = c ? atomicAdd(lcnt + bh * 64 + F.tid, c) : 0u; }
        __syncthreads();
        unsigned short* lb = list + (size_t)bh * LSTRIDE;
        if (i0 >= 0) lb[list_off(i0) + lbase[i0] + r0] = (unsigned short)(tl | (0 << 14));
        if (i1 >= 0) lb[list_off(i1) + lbase[i1] + r1] = (unsigned short)(tl | (1 << 14));
        if (i2 >= 0) lb[list_off(i2) + lbase[i2] + r2] = (unsigned short)(tl | (2 << 14));
    }
    __syncthreads();
}
DI void att_phase(Frame& F, int l) {
    const bf16* Q = (const bf16*)(WSP(F) + WS_Q); const bf16* K = (const bf16*)(WSP(F) + WS_K); const bf16* VT = (const bf16*)(WSP(F) + WS_VT);
    const unsigned short* list = (const unsigned short*)(WSP(F) + WS_LIST); const unsigned* lcnt = (const unsigned*)(WSP(F) + WS_CTL) + CW_LCNT + 1024 * l;
    bf16* PO = (bf16*)(WSP(F) + WS_PARTO); float* PML = (float*)(WSP(F) + WS_PARTML);
    LAS unsigned char* Kl = F.lds;
    LAS unsigned char* Vl = F.lds + 36864;
    LAS int* pre = (LAS int*)(F.lds + MISC_OFF + 8192);
    LAS int* cl = (LAS int*)(F.lds + MISC_OFF + 12288); LAS int* ws8 = (LAS int*)(F.lds + MISC_OFF + 4352);
    const int lane = F.lane, wave = F.wave, qi = lane & 15, quad = lane >> 4;
    __syncthreads();
    { const int c0 = (int)__hip_atomic_load(lcnt + 2 * F.tid, __ATOMIC_RELAXED, __HIP_MEMORY_SCOPE_AGENT), c1 = (int)__hip_atomic_load(lcnt + 2 * F.tid + 1, __ATOMIC_RELAXED, __HIP_MEMORY_SCOPE_AGENT);
      cl[2 * F.tid] = c0; cl[2 * F.tid + 1] = c1; const int t0 = (c0 + 127) >> 7, t1 = (c1 + 127) >> 7; int inc = t0 + t1;
#pragma unroll
      for (int o = 1; o < 64; o <<= 1) { const int u = __shfl_up(inc, o); if (lane >= o) inc += u; }
      if (lane == 63) ws8[wave] = inc;
      __syncthreads();
      int off = 0;
#pragma unroll
      for (int w = 0; w < 8; ++w) { const int x = ws8[w]; if (w < wave) off += x; }
      const int ex = off + inc - (t0 + t1); pre[2 * F.tid] = ex; pre[2 * F.tid + 1] = ex + t0;
      __syncthreads();
      if (F.tid == 511) ws8[8] = off + inc; }
    __syncthreads();
    const int NL = __builtin_amdgcn_readfirstlane(ws8[8]), total = NL + BATCH * 8 * 64 * 2, per = (total + F.G - 1) / F.G;
    const int it0 = F.bid * per, it1 = (it0 + per < total) ? it0 + per : total;
    int cur = 0, loaded = -1;
    if (it0 < NL) { int lo = 0, hi = 1023;
        while (lo < hi) { const int mid = (lo + hi + 1) >> 1; if (pre[mid] <= it0) lo = mid; else hi = mid - 1; }
        cur = lo; }
    struct QA { int i, tile, own_item; bool valid; unsigned short ent; };
    struct QB { int i, own_item, tl, j; bool valid; bf16x8_t qf[2]; };
#define DEC_A(itx, R) do { int i_, tile_, own_; \
        if ((itx) < NL) { while (cur < 1023 && pre[cur + 1] <= (itx)) ++cur; i_ = cur; tile_ = (itx) - pre[cur]; own_ = 0; } \
        else { const int o_ = (itx) - NL; i_ = o_ >> 1; tile_ = o_ & 1; own_ = 1; } \
        i_ = __builtin_amdgcn_readfirstlane(i_); tile_ = __builtin_amdgcn_readfirstlane(tile_); \
        R.i = i_; R.tile = tile_; R.own_item = own_; R.ent = 0; R.valid = true; \
        if (!own_) { const int e_ = tile_ * 128 + wave * 16 + qi; R.valid = e_ < cl[i_]; if (R.valid) R.ent = list[(size_t)(i_ >> 6) * LSTRIDE + list_off(i_ & 63) + e_]; } } while (0)
#define DEC_B(A, R) do { const int bh_ = A.i >> 6, n_ = A.i & 63; R.i = A.i; R.own_item = A.own_item; R.valid = A.valid; \
        if (A.own_item) { R.tl = n_ * 256 + A.tile * 128 + wave * 16 + qi; R.j = 3; } else { R.tl = A.ent & 0x3fff; R.j = A.ent >> 14; } \
        { const size_t t_ = (size_t)(bh_ >> 3) * SEQ + R.tl; \
          R.qf[0] = *(const bf16x8_t*)(Q + t_ * 512 + (bh_ & 7) * 64 + quad * 8); R.qf[1] = *(const bf16x8_t*)(Q + t_ * 512 + (bh_ & 7) * 64 + 32 + quad * 8); } } while (0)
    QA na; na.i = 0; na.tile = 0; na.own_item = 1; na.valid = false; na.ent = 0;
    QB nx; nx.i = -1; nx.own_item = 0; nx.tl = 0; nx.j = 0; nx.valid = false; nx.qf[0] = (bf16x8_t){0, 0, 0, 0, 0, 0, 0, 0}; nx.qf[1] = nx.qf[0];
    if (it0 < it1) { DEC_A(it0, na); DEC_B(na, nx); if (it0 + 1 < it1) DEC_A(it0 + 1, na); }
    for (int it = it0; it < it1; ++it) {
        const int i = nx.i, own_item = nx.own_item, tl = nx.tl, j = nx.j; const bool valid = nx.valid; bf16x8_t qf[2] = {nx.qf[0], nx.qf[1]};
        const int bh = i >> 6, n = i & 63, b = bh >> 3, h = bh & 7;
        if (i != loaded) {
            __syncthreads();
#pragma unroll
            for (int r = 0; r < 4; ++r) { const int c = F.tid + r * 512, row = c >> 3, ch = c & 7;
                const u32x4 w = *(const u32x4*)(K + ((size_t)b * SEQ + n * 256 + row) * 512 + h * 64 + ch * 8); *(LAS u32x4*)(Kl + row * 144 + ch * 16) = w; }
#pragma unroll
            for (int r = 0; r < 4; ++r) { const int c = F.tid + r * 512, row = c >> 5, ch = c & 31;
                const u32x4 w = *(const u32x4*)(VT + ((size_t)bh * 64 + row) * SEQ + n * 256 + ch * 8); *(LAS u32x4*)(Vl + row * 528 + ch * 16) = w; }
            __syncthreads();
            loaded = i;
        }
        if (it + 1 < it1) { DEC_B(na, nx); if (it + 2 < it1) DEC_A(it + 2, na); }
        const size_t t = (size_t)b * SEQ + tl;
        const float slope2 = __builtin_amdgcn_exp2f(-(float)(h + 1)) * LOG2E;
        const bool half_only = own_item && (__builtin_amdgcn_readfirstlane(tl - n * 256) < 128);
        const int tloc = tl - n * 256;
        const float sbase = slope2 * (float)(quad * 4); const int tq4 = tloc - quad * 4;
        f32x4 sc[16];
#pragma unroll
        for (int kt = 0; kt < 16; ++kt) {
            if (kt >= 8 && half_only) { sc[kt] = (f32x4){-INFINITY, -INFINITY, -INFINITY, -INFINITY}; continue; }
            f32x4 a = {fmaf(slope2, (float)(kt * 16), sbase), fmaf(slope2, (float)(kt * 16 + 1), sbase), fmaf(slope2, (float)(kt * 16 + 2), sbase), fmaf(slope2, (float)(kt * 16 + 3), sbase)};
#pragma unroll
            for (int ks = 0; ks < 2; ++ks) { const bf16x8_t kf = *(const LAS bf16x8_t*)(Kl + (kt * 16 + qi) * 144 + ks * 64 + quad * 16); a = __builtin_amdgcn_mfma_f32_16x16x32_bf16(kf, qf[ks], a, 0, 0, 0); }
            sc[kt] = a; if ((kt & 3) == 3) asm volatile("" ::: "memory"); }
        if (own_item) {
#pragma unroll
            for (int kt = 0; kt < 16; ++kt)
#pragma unroll
                for (int e = 0; e < 4; ++e) if ((kt * 16 + e) > tq4) sc[kt][e] = -INFINITY; }
        float mx = -INFINITY;
#pragma unroll
        for (int kt = 0; kt < 16; ++kt)
#pragma unroll
            for (int e = 0; e < 4; ++e) mx = fmaxf(mx, sc[kt][e]);
        mx = fmaxf(mx, __shfl_xor(mx, 16)); mx = fmaxf(mx, __shfl_xor(mx, 32));
        float ls = 0.f;
#pragma unroll
        for (int kt = 0; kt < 16; ++kt)
#pragma unroll
            for (int e = 0; e < 4; ++e) { const float p = __builtin_amdgcn_exp2f(sc[kt][e] - mx); sc[kt][e] = p; ls += p; }
        ls += __shfl_xor(ls, 16); ls += __shfl_xor(ls, 32);
        f32x4 o[4];
#pragma unroll
        for (int dt = 0; dt < 4; ++dt) o[dt] = (f32x4){0.f, 0.f, 0.f, 0.f};
#pragma unroll
        for (int k2 = 0; k2 < 8; ++k2) {
            if (k2 >= 4 && half_only) break;
            u32x4 pw; pw.x = pg8::cvt_pk_bf16(sc[2 * k2][0], sc[2 * k2][1]); pw.y = pg8::cvt_pk_bf16(sc[2 * k2][2], sc[2 * k2][3]);
            pw.z = pg8::cvt_pk_bf16(sc[2 * k2 + 1][0], sc[2 * k2 + 1][1]); pw.w = pg8::cvt_pk_bf16(sc[2 * k2 + 1][2], sc[2 * k2 + 1][3]);
            const bf16x8_t pf = __builtin_bit_cast(bf16x8_t, pw);
#pragma unroll
            for (int dt = 0; dt < 4; ++dt) { const LAS unsigned char* vp = Vl + (dt * 16 + qi) * 528 + (k2 * 32 + quad * 4) * 2;
                const u32x2 lo = *(const LAS u32x2*)vp, hi = *(const LAS u32x2*)(vp + 32);
                const u32x4 vw = {lo.x, lo.y, hi.x, hi.y};
                o[dt] = __builtin_amdgcn_mfma_f32_16x16x32_bf16(__builtin_bit_cast(bf16x8_t, vw), pf, o[dt], 0, 0, 0); }
            if (k2 & 1) asm volatile("" ::: "memory"); }
        if (valid) { const float inv = frcp_(ls); const size_t pidx = (t * 8 + h) * 4 + j; bf16* op = PO + pidx * 64 + quad * 4;
#pragma unroll
            for (int dt = 0; dt < 4; ++dt) *(u32x2*)(op + dt * 16) = (u32x2){pg8::cvt_pk_bf16(o[dt][0] * inv, o[dt][1] * inv), pg8::cvt_pk_bf16(o[dt][2] * inv, o[dt][3] * inv)};
            if (quad == 0) ((float2*)PML)[pidx] = make_float2(mx - slope2 * (float)tloc, ls); }
    }
#undef DEC_A
#undef DEC_B
    __syncthreads();
}
DI void comb_phase(Frame& F) {
    const bf16* PO = (const bf16*)(WSP(F) + WS_PARTO); const float* PML = (const float*)(WSP(F) + WS_PARTML); bf16* Y = (bf16*)(WSP(F) + WS_YATTN);
    const int gw = F.bid * 8 + F.wave, NGW = F.G * 8, lane = F.lane, h = lane >> 3, dc = lane & 7;
    for (int t = gw; t < T; t += NGW) {
        const int own = (t % SEQ) >> 8, nsel = own < 3 ? own : 3; const size_t pb = ((size_t)t * 8 + h) * 4;
        float m[4], lw[4]; float M = -INFINITY;
#pragma unroll
        for (int j = 0; j < 4; ++j) { const bool ok = (j == 3) || (j < nsel); const float2 ml = ok ? ((const float2*)PML)[pb + j] : make_float2(-INFINITY, 0.f); m[j] = ml.x; lw[j] = ml.y; M = fmaxf(M, ml.x); }
        float acc[8] = {0.f, 0.f, 0.f, 0.f, 0.f, 0.f, 0.f, 0.f}; float wsum = 0.f;
#pragma unroll
        for (int j = 0; j < 4; ++j) { const bool ok = (j == 3) || (j < nsel); if (!ok) continue;
            const float w = __builtin_amdgcn_exp2f(m[j] - M) * lw[j]; wsum += w; const u32x4 ow = *(const u32x4*)(PO + (pb + j) * 64 + dc * 8);
            acc[0] += w * blo(ow.x); acc[1] += w * bhi(ow.x); acc[2] += w * blo(ow.y); acc[3] += w * bhi(ow.y); acc[4] += w * blo(ow.z); acc[5] += w * bhi(ow.z); acc[6] += w * blo(ow.w); acc[7] += w * bhi(ow.w); }
        const float inv = frcp_(wsum);
        *(u32x4*)(Y + (size_t)t * 512 + h * 64 + dc * 8) = (u32x4){pk2(acc[0] * inv, acc[1] * inv), pk2(acc[2] * inv, acc[3] * inv), pk2(acc[4] * inv, acc[5] * inv), pk2(acc[6] * inv, acc[7] * inv)};
    }
}
DI void pool_phase(Frame& F, int l) {
    const bf16* Z = (const bf16*)(WSP(F) + WS_POOLZ); bf16* Y = (bf16*)(WSP(F) + WS_YPOOL); const bf16* WPT = (const bf16*)(WSP(F) + WS_WPT);
    LAS unsigned char* Pl = F.lds;
    const int lane = F.lane, li = lane & 15, quad = lane >> 4, g = F.wave >> 1, dt0 = (F.wave & 1) * 4;
    bf16x8_t wf[4][4];
#pragma unroll
    for (int dt = 0; dt < 4; ++dt)
#pragma unroll
        for (int ks = 0; ks < 4; ++ks) wf[dt][ks] = *(const bf16x8_t*)(WPT + ((size_t)g * 128 + 16 * (dt0 + dt) + li) * 128 + 32 * ks + 8 * quad);
    for (int tile = F.bid; tile < T / 64; tile += F.G) {
        __syncthreads();
#pragma unroll 1
        for (int i = F.tid; i < 64 * 64; i += 512) { const int tt = i >> 6, ch = i & 63, gg = ch >> 4, win = 2 << gg, t = tile * 64 + tt, tl = t % SEQ; const int cnt = (tl + 1 < win) ? tl + 1 : win;
            u32x4 w[16];
#pragma unroll
            for (int j = 0; j < 16; ++j) { w[j] = (u32x4){0u, 0u, 0u, 0u}; if (j < cnt) w[j] = *(const u32x4*)(Z + (size_t)(t - j) * 512 + ch * 8); }
            float s[8] = {0.f, 0.f, 0.f, 0.f, 0.f, 0.f, 0.f, 0.f};
#pragma unroll
            for (int j = 0; j < 16; ++j) { s[0] += blo(w[j].x); s[1] += bhi(w[j].x); s[2] += blo(w[j].y); s[3] += bhi(w[j].y); s[4] += blo(w[j].z); s[5] += bhi(w[j].z); s[6] += blo(w[j].w); s[7] += bhi(w[j].w); }
            const float inv = 1.0f / (float)cnt;
            *(LAS u32x4*)(Pl + tt * 1040 + ch * 16) = (u32x4){pk2(s[0] * inv - blo(w[0].x), s[1] * inv - bhi(w[0].x)), pk2(s[2] * inv - blo(w[0].y), s[3] * inv - bhi(w[0].y)),
                                                                 pk2(s[4] * inv - blo(w[0].z), s[5] * inv - bhi(w[0].z)), pk2(s[6] * inv - blo(w[0].w), s[7] * inv - bhi(w[0].w))}; }
        __syncthreads();
#pragma unroll
        for (int tt = 0; tt < 4; ++tt) {
            bf16x8_t pf[4];
#pragma unroll
            for (int ks = 0; ks < 4; ++ks) pf[ks] = *(const LAS bf16x8_t*)(Pl + (16 * tt + li) * 1040 + (g * 128 + 32 * ks + 8 * quad) * 2);
#pragma unroll
            for (int dt = 0; dt < 4; ++dt) { f32x4 acc = {0.f, 0.f, 0.f, 0.f};
#pragma unroll
                for (int ks = 0; ks < 4; ++ks) acc = __builtin_amdgcn_mfma_f32_16x16x32_bf16(wf[dt][ks], pf[ks], acc, 0, 0, 0);
                *(u32x2*)(Y + (size_t)(tile * 64 + 16 * tt + li) * 512 + g * 128 + 16 * (dt0 + dt) + 4 * quad) = (u32x2){pk2(acc[0], acc[1]), pk2(acc[2], acc[3])}; } }
    }
    __syncthreads();
}
DI void rwkv_prep_phase(Frame& F, int l) {
    const bf16* RZ = (const bf16*)(WSP(F) + WS_RWKVZ); bf16* VF = (bf16*)(WSP(F) + WS_VFIRST);
    bf16* AR = (bf16*)(WSP(F) + WS_AR); const size_t AS = (size_t)T * 512;
    float* bonus = (float*)(WSP(F) + WS_BONUS); float* kinv = (float*)(WSP(F) + WS_KINV); const bf16* WLT = (const bf16*)(WSP(F) + WS_WLT);
    LAS unsigned char* Al = F.lds;
    const int h = F.wave;
    const float* mu = INP(F, 4) + l * 1792; const float* vmu = INP(F, 5) + (l > 0 ? (l - 1) * 32 : 0);
    const float* w0p = INP(F, 6) + l * 512 + h * 64; const float* a0p = INP(F, 8) + l * 512 + h * 64; const float* kkp = INP(F, 11) + l * 512 + h * 64;
    const float* kap = INP(F, 12) + l * 512 + h * 64; const float* rkp = INP(F, 13) + l * 512 + h * 64; const float* v0p = INP(F, 16) + (l > 0 ? l - 1 : 0) * 512 + h * 64;
    for (int item = F.bid; item < T / 64; item += F.G) {
        int tid = F.tid; asm volatile("" : "+v"(tid));
        const int lane = tid & 63, li = lane & 15, quad = lane >> 4;
        const int t0 = item * 64, tl0 = t0 % SEQ;
        __syncthreads();
        { const int tok = tid >> 3, c0 = tid & 7; const size_t t = (size_t)(t0 + tok); const bool first = (tl0 + tok == 0);
          u32x4 zc[5], zp[5]; f32x4 m0[5], m1[5];
#pragma unroll
          for (int r = 0; r < 5; ++r) { const int c = c0 + 8 * r; zc[r] = (u32x4){0u, 0u, 0u, 0u}; zp[r] = zc[r]; m0[r] = (f32x4){0.f, 0.f, 0.f, 0.f}; m1[r] = m0[r];
              if (c < 32 || (l > 0 && c < 36)) { const int col = 1536 + 8 * c; zc[r] = *(const u32x4*)(RZ + t * RZP + col); if (!first) zp[r] = *(const u32x4*)(RZ + (t - 1) * RZP + col);
                  const float* mp = col < 1792 ? mu + col : vmu + (col - 1792); m0[r] = *(const f32x4*)mp; m1[r] = *(const f32x4*)(mp + 4); } }
#pragma unroll
          for (int r = 0; r < 5; ++r) { const int c = c0 + 8 * r; if (c < 36) {
              const float cv[8] = {blo(zc[r].x), bhi(zc[r].x), blo(zc[r].y), bhi(zc[r].y), blo(zc[r].z), bhi(zc[r].z), blo(zc[r].w), bhi(zc[r].w)}, pv[8] = {blo(zp[r].x), bhi(zp[r].x), blo(zp[r].y), bhi(zp[r].y), blo(zp[r].z), bhi(zp[r].z), blo(zp[r].w), bhi(zp[r].w)};
              const float mm[8] = {m0[r].x, m0[r].y, m0[r].z, m0[r].w, m1[r].x, m1[r].y, m1[r].z, m1[r].w}; float f[8];
#pragma unroll
              for (int e = 0; e < 8; ++e) { const float zs = cv[e] + (pv[e] - cv[e]) * mm[e]; f[e] = r == 0 ? tanhf(zs) : (r == 2 || r == 3) ? sigmoidf_(zs) : zs; }
              *(LAS u32x4*)(Al + tok * 592 + c * 16) = (u32x4){pk2(f[0], f[1]), pk2(f[2], f[3]), pk2(f[4], f[5]), pk2(f[6], f[7])}; } } }
        __syncthreads();
        float ssq[4] = {0.f, 0.f, 0.f, 0.f}, bsm[4] = {0.f, 0.f, 0.f, 0.f};
#pragma unroll 1
        for (int ct = 0; ct < 4; ++ct) {
            const int cb = 16 * ct + 4 * quad;
            bf16x8_t wf[9];
#pragma unroll
            for (int ks = 0; ks < 9; ++ks) wf[ks] = *(const bf16x8_t*)(WLT + (size_t)(h * 64 + 16 * ct + li) * 288 + 32 * ks + 8 * quad);
            const f32x4 mr = *(const f32x4*)(mu + h * 64 + cb), mk = *(const f32x4*)(mu + 512 + h * 64 + cb), mv = *(const f32x4*)(mu + 1024 + h * 64 + cb);
            const f32x4 w0 = *(const f32x4*)(w0p + cb), a0 = *(const f32x4*)(a0p + cb), kkc = *(const f32x4*)(kkp + cb), kac = *(const f32x4*)(kap + cb), rkc = *(const f32x4*)(rkp + cb);
            f32x4 v0 = {0.f, 0.f, 0.f, 0.f}; if (l > 0) v0 = *(const f32x4*)(v0p + cb);
            u32x2 zr[4][2], zk[4][2], zv[4][2], vfw[4];
#pragma unroll
            for (int rt = 0; rt < 4; ++rt) { const int tok = 16 * rt + li; const size_t zi = (size_t)(t0 + tok) * RZP + h * 64 + cb; const bool first = (tl0 + tok == 0);
                zr[rt][0] = *(const u32x2*)(RZ + zi); zk[rt][0] = *(const u32x2*)(RZ + zi + 512); zv[rt][0] = *(const u32x2*)(RZ + zi + 1024);
                zr[rt][1] = (u32x2){0u, 0u}; zk[rt][1] = zr[rt][1]; zv[rt][1] = zr[rt][1]; vfw[rt] = zr[rt][1];
                if (!first) { zr[rt][1] = *(const u32x2*)(RZ + zi - RZP); zk[rt][1] = *(const u32x2*)(RZ + zi - RZP + 512); zv[rt][1] = *(const u32x2*)(RZ + zi - RZP + 1024); }
                if (l > 0) vfw[rt] = *(const u32x2*)(VF + (size_t)(t0 + tok) * 512 + h * 64 + cb); }
#pragma unroll
            for (int rt = 0; rt < 4; ++rt) { const int tok = 16 * rt + li; const size_t idx = (size_t)(t0 + tok) * 512 + h * 64 + cb;
                f32x4 aw = {0.f, 0.f, 0.f, 0.f}, aa = aw, ag = aw, av = aw;
#pragma unroll
                for (int ks = 0; ks < 9; ++ks) { if (ks == 8 && l == 0) break;
                    const bf16x8_t bfr = *(const LAS bf16x8_t*)(Al + tok * 592 + ks * 64 + quad * 16);
                    if (ks < 2) aw = __builtin_amdgcn_mfma_f32_16x16x32_bf16(wf[ks], bfr, aw, 0, 0, 0);
                    else if (ks < 4) aa = __builtin_amdgcn_mfma_f32_16x16x32_bf16(wf[ks], bfr, aa, 0, 0, 0);
                    else if (ks < 8) ag = __builtin_amdgcn_mfma_f32_16x16x32_bf16(wf[ks], bfr, ag, 0, 0, 0);
                    else av = __builtin_amdgcn_mfma_f32_16x16x32_bf16(wf[ks], bfr, av, 0, 0, 0); }
                const float crf[4] = {blo(zr[rt][0].x), bhi(zr[rt][0].x), blo(zr[rt][0].y), bhi(zr[rt][0].y)}, prf[4] = {blo(zr[rt][1].x), bhi(zr[rt][1].x), blo(zr[rt][1].y), bhi(zr[rt][1].y)};
                const float ckf[4] = {blo(zk[rt][0].x), bhi(zk[rt][0].x), blo(zk[rt][0].y), bhi(zk[rt][0].y)}, pkf[4] = {blo(zk[rt][1].x), bhi(zk[rt][1].x), blo(zk[rt][1].y), bhi(zk[rt][1].y)};
                const float cvf[4] = {blo(zv[rt][0].x), bhi(zv[rt][0].x), blo(zv[rt][0].y), bhi(zv[rt][0].y)}, pvf[4] = {blo(zv[rt][1].x), bhi(zv[rt][1].x), blo(zv[rt][1].y), bhi(zv[rt][1].y)};
                const float vff[4] = {blo(vfw[rt].x), bhi(vfw[rt].x), blo(vfw[rt].y), bhi(vfw[rt].y)};
                float ro[4], lwo[4], kpo[4], vo[4], kro[4], bbo[4];
#pragma unroll
                for (int e = 0; e < 4; ++e) { const float r = crf[e] + (prf[e] - crf[e]) * mr[e], k = ckf[e] + (pkf[e] - ckf[e]) * mk[e]; float v = cvf[e] + (pvf[e] - cvf[e]) * mv[e];
                    const float xw = -(w0[e] + aw[e]); const float sp = xw > 20.f ? xw : log1pf(__expf(xw)); lwo[e] = -__expf(-sp - 0.5f);
                    const float asig = sigmoidf_(a0[e] + aa[e]);
                    if (l > 0) v = v + (vff[e] - v) * sigmoidf_(v0[e] + av[e]);
                    vo[e] = v; ro[e] = r; const float kr = k * kkc[e]; kro[e] = kr; bbo[e] = kr * asig; ssq[rt] += kr * kr;
                    const float kpe = k * (1.0f + (asig - 1.0f) * kac[e]); kpo[e] = kpe; bsm[rt] += r * kpe * rkc[e]; }
                if (l == 0) *(u32x2*)(VF + idx) = (u32x2){pk2(vo[0], vo[1]), pk2(vo[2], vo[3])};
                *(u32x2*)(AR + idx) = (u32x2){pk2(ro[0], ro[1]), pk2(ro[2], ro[3])};
                *(u32x2*)(AR + AS + idx) = (u32x2){pk2(lwo[0], lwo[1]), pk2(lwo[2], lwo[3])};
                *(u32x2*)(AR + 2 * AS + idx) = (u32x2){pk2(kpo[0], kpo[1]), pk2(kpo[2], kpo[3])};
                *(u32x2*)(AR + 3 * AS + idx) = (u32x2){pk2(vo[0], vo[1]), pk2(vo[2], vo[3])};
                *(u32x2*)(AR + 4 * AS + idx) = (u32x2){pk2(kro[0], kro[1]), pk2(kro[2], kro[3])};
                *(u32x2*)(AR + 5 * AS + idx) = (u32x2){pk2(bbo[0], bbo[1]), pk2(bbo[2], bbo[3])};
                *(u32x2*)(AR + 6 * AS + idx) = (u32x2){pk2(ag[0], ag[1]), pk2(ag[2], ag[3])}; asm volatile("" ::: "memory"); }
        }
#pragma unroll
        for (int rt = 0; rt < 4; ++rt) { float ss = ssq[rt], bs = bsm[rt]; ss += __shfl_xor(ss, 16); ss += __shfl_xor(ss, 32); bs += __shfl_xor(bs, 16); bs += __shfl_xor(bs, 32);
            if (quad == 0) { const size_t t = (size_t)(t0 + 16 * rt + li); bonus[t * 8 + h] = bs; kinv[t * 8 + h] = 1.0f / fmaxf(sqrtf(ss), 1e-12f); } }
    }
    __syncthreads();
}
typedef short bf16x4_t __attribute__((ext_vector_type(4)));
DI void rwkv_chunk_phase(Frame& F, int l) {
    const bf16* RZ = (const bf16*)(WSP(F) + WS_RWKVZ); bf16* VF = (bf16*)(WSP(F) + WS_VFIRST);
    bf16* AR = (bf16*)(WSP(F) + WS_AR); const size_t AS = (size_t)T * 512; float* bonus = (float*)(WSP(F) + WS_BONUS); const bf16* WLT = (const bf16*)(WSP(F) + WS_WLT);
    bf16* PCT = (bf16*)(WSP(F) + WS_PCT); bf16* LC = (bf16*)(WSP(F) + WS_LC); bf16* RM = (bf16*)(WSP(F) + WS_RM); bf16* Y0 = (bf16*)(WSP(F) + WS_Y0);
    const float* mu = INP(F, 4) + l * 1792; const float* vmu = INP(F, 5) + (l > 0 ? (l - 1) * 32 : 0);
    constexpr int ST = 144;
    LAS unsigned char* L = F.lds;
    LAS unsigned char* AT = L; LAS unsigned char* BT = L + 9216; LAS unsigned char* KT = L + 18432; LAS unsigned char* RT = L + 27648;
    LAS unsigned char* BTT = L + 36864; LAS unsigned char* KTT = L + 46080; LAS unsigned char* VTl = L + 55296; LAS unsigned char* NB = L + 64512; LAS unsigned char* MB = L + 73728;
    LAS unsigned char* WMT = L + 82944; LAS unsigned char* UMT = L + 92160;
    LAS unsigned char* Al = L + 64512;
    LAS unsigned char* SR = L + 64512; LAS unsigned char* SKP = L + 72704; LAS unsigned char* SKR = L + 80896; LAS unsigned char* SBB = L + 89088;
    LAS float* LGF = (LAS float*)(L + 101376); LAS float* ND = (LAS float*)(L + 117760); LAS unsigned char* DB = L + 122112; LAS float* GC = (LAS float*)(L + 125184); LAS float* PART = (LAS float*)(L + 125440);
    LAS float* SSP = (LAS float*)(L + 127488); LAS float* BSP = SSP + 256;
    const int wave = F.wave;
#define MF32(a, b, c) __builtin_amdgcn_mfma_f32_16x16x32_bf16((a), (b), (c), 0, 0, 0)
#define MF16(a, b, c) __builtin_amdgcn_mfma_f32_16x16x16bf16_1k((a), (b), (c), 0, 0, 0)
#define RD8(p) (*(const LAS bf16x8_t*)(p))
#define RD4(p) (*(const LAS bf16x4_t*)(p))
    u32x4 zcn[5], zpn[5], areg[5];
#define F1LOAD(ckx) do { const int b_ = (ckx) >> 8, ck_ = (ckx) & 255; const size_t t_ = (size_t)b_ * SEQ + ck_ * 64 + (F.tid >> 3); const bool first_ = (ck_ * 64 + (F.tid >> 3) == 0); \
        _Pragma("unroll") for (int r_ = 0; r_ < 5; ++r_) { const int c_ = (F.tid & 7) + 8 * r_; zcn[r_] = (u32x4){0u, 0u, 0u, 0u}; zpn[r_] = zcn[r_]; \
            if (c_ < 32 || (l > 0 && c_ < 36)) { const int col_ = 1536 + 8 * c_; zcn[r_] = *(const u32x4*)(RZ + t_ * RZP + col_); if (!first_) zpn[r_] = *(const u32x4*)(RZ + (t_ - 1) * RZP + col_); } } } while (0)
    if (F.bid < BATCH * (SEQ / 64)) F1LOAD(F.bid);
    for (int cki = F.bid; cki < BATCH * (SEQ / 64); cki += F.G) {
      {
          const int c0 = F.tid & 7; f32x4 m0[5], m1[5];
#pragma unroll
          for (int r = 0; r < 5; ++r) { const int c = c0 + 8 * r; m0[r] = (f32x4){0.f, 0.f, 0.f, 0.f}; m1[r] = m0[r];
              if (c < 32 || (l > 0 && c < 36)) { const int col = 1536 + 8 * c; const float* mp = col < 1792 ? mu + col : vmu + (col - 1792); m0[r] = *(const f32x4*)mp; m1[r] = *(const f32x4*)(mp + 4); } }
#pragma unroll
          for (int r = 0; r < 5; ++r) {
              const float cv[8] = {blo(zcn[r].x), bhi(zcn[r].x), blo(zcn[r].y), bhi(zcn[r].y), blo(zcn[r].z), bhi(zcn[r].z), blo(zcn[r].w), bhi(zcn[r].w)}, pv[8] = {blo(zpn[r].x), bhi(zpn[r].x), blo(zpn[r].y), bhi(zpn[r].y), blo(zpn[r].z), bhi(zpn[r].z), blo(zpn[r].w), bhi(zpn[r].w)};
              const float mm[8] = {m0[r].x, m0[r].y, m0[r].z, m0[r].w, m1[r].x, m1[r].y, m1[r].z, m1[r].w}; float f[8];
#pragma unroll
              for (int e = 0; e < 8; ++e) { const float zs = cv[e] + (pv[e] - cv[e]) * mm[e]; f[e] = r == 0 ? ftanh_(zs) : (r == 2 || r == 3) ? sigmoidf_(zs) : zs; }
              areg[r] = (u32x4){pk2(f[0], f[1]), pk2(f[2], f[3]), pk2(f[4], f[5]), pk2(f[6], f[7])}; } }
#pragma unroll 1
      for (int h = 0; h < 8; ++h) {
        int tid = F.tid; asm volatile("" : "+v"(tid));
        const int lane = tid & 63, li = lane & 15, quad = lane >> 4;
        const int b = cki >> 8, ck = cki & 255, bh = b * 8 + h, it = bh * 256 + ck;
        const size_t tbase = (size_t)b * SEQ + ck * 64; const int tl0 = ck * 64;
        __syncthreads();
        { const int tok = tid >> 3, c0 = tid & 7;
#pragma unroll
          for (int r = 0; r < 5; ++r) { const int c = c0 + 8 * r; if (c < 36) *(LAS u32x4*)(Al + tok * 576 + c * 16) = areg[r]; } }
        __syncthreads();
        { const int ct = wave & 3, hw = wave >> 2, cb = 16 * ct + 4 * quad;
          bf16x8_t wf[9];
#pragma unroll
          for (int ks = 0; ks < 9; ++ks) wf[ks] = *(const bf16x8_t*)(WLT + (size_t)(h * 64 + 16 * ct + li) * 288 + 32 * ks + 8 * quad);
          const f32x4 mr = *(const f32x4*)(mu + h * 64 + cb), mk = *(const f32x4*)(mu + 512 + h * 64 + cb), mv = *(const f32x4*)(mu + 1024 + h * 64 + cb);
          const f32x4 w0 = *(const f32x4*)(INP(F, 6) + l * 512 + h * 64 + cb), a0 = *(const f32x4*)(INP(F, 8) + l * 512 + h * 64 + cb), kkc = *(const f32x4*)(INP(F, 11) + l * 512 + h * 64 + cb);
          const f32x4 kac = *(const f32x4*)(INP(F, 12) + l * 512 + h * 64 + cb), rkc = *(const f32x4*)(INP(F, 13) + l * 512 + h * 64 + cb);
          f32x4 v0 = {0.f, 0.f, 0.f, 0.f}; if (l > 0) v0 = *(const f32x4*)(INP(F, 16) + (l - 1) * 512 + h * 64 + cb);
          u32x2 zr[2][2], zk[2][2], zv[2][2], vfw[2]; f32x4 aw[2], aa[2], ag[2], av[2];
#pragma unroll
          for (int rr = 0; rr < 2; ++rr) { const int tok = 16 * (2 * hw + rr) + li; const size_t zi = (tbase + tok) * RZP + h * 64 + cb; const bool first = (tl0 + tok == 0);
              zr[rr][0] = *(const u32x2*)(RZ + zi); zk[rr][0] = *(const u32x2*)(RZ + zi + 512); zv[rr][0] = *(const u32x2*)(RZ + zi + 1024);
              zr[rr][1] = (u32x2){0u, 0u}; zk[rr][1] = zr[rr][1]; zv[rr][1] = zr[rr][1]; vfw[rr] = zr[rr][1];
              if (!first) { zr[rr][1] = *(const u32x2*)(RZ + zi - RZP); zk[rr][1] = *(const u32x2*)(RZ + zi - RZP + 512); zv[rr][1] = *(const u32x2*)(RZ + zi - RZP + 1024); }
              if (l > 0) vfw[rr] = *(const u32x2*)(VF + (tbase + tok) * 512 + h * 64 + cb); }
#pragma unroll
          for (int rr = 0; rr < 2; ++rr) { const int tok = 16 * (2 * hw + rr) + li; aw[rr] = (f32x4){0.f, 0.f, 0.f, 0.f}; aa[rr] = aw[rr]; ag[rr] = aw[rr]; av[rr] = aw[rr];
#pragma unroll
              for (int ks = 0; ks < 9; ++ks) { if (ks == 8 && l == 0) break;
                  const bf16x8_t bfr = RD8(Al + tok * 576 + ks * 64 + quad * 16);
                  if (ks < 2) aw[rr] = MF32(wf[ks], bfr, aw[rr]); else if (ks < 4) aa[rr] = MF32(wf[ks], bfr, aa[rr]); else if (ks < 8) ag[rr] = MF32(wf[ks], bfr, ag[rr]); else av[rr] = MF32(wf[ks], bfr, av[rr]); } }
          __syncthreads();
          if (h == 7 && cki + F.G < BATCH * (SEQ / 64)) F1LOAD(cki + F.G);
#pragma unroll
          for (int rr = 0; rr < 2; ++rr) { const int tok = 16 * (2 * hw + rr) + li; const size_t idx = (tbase + tok) * 512 + h * 64 + cb;
              const float crf[4] = {blo(zr[rr][0].x), bhi(zr[rr][0].x), blo(zr[rr][0].y), bhi(zr[rr][0].y)}, prf[4] = {blo(zr[rr][1].x), bhi(zr[rr][1].x), blo(zr[rr][1].y), bhi(zr[rr][1].y)};
              const float ckf[4] = {blo(zk[rr][0].x), bhi(zk[rr][0].x), blo(zk[rr][0].y), bhi(zk[rr][0].y)}, pkf[4] = {blo(zk[rr][1].x), bhi(zk[rr][1].x), blo(zk[rr][1].y), bhi(zk[rr][1].y)};
              const float cvf[4] = {blo(zv[rr][0].x), bhi(zv[rr][0].x), blo(zv[rr][0].y), bhi(zv[rr][0].y)}, pvf[4] = {blo(zv[rr][1].x), bhi(zv[rr][1].x), blo(zv[rr][1].y), bhi(zv[rr][1].y)};
              const float vff[4] = {blo(vfw[rr].x), bhi(vfw[rr].x), blo(vfw[rr].y), bhi(vfw[rr].y)};
              float ro[4], lwo[4], kpo[4], vo[4], kro[4], bbo[4]; float ss = 0.f, bs = 0.f;
#pragma unroll
              for (int e = 0; e < 4; ++e) { const float r = crf[e] + (prf[e] - crf[e]) * mr[e], k = ckf[e] + (pkf[e] - ckf[e]) * mk[e]; float v = cvf[e] + (pvf[e] - cvf[e]) * mv[e];
                  const float xw = -(w0[e] + aw[rr][e]); const float sp = fsoftplus_(xw); lwo[e] = -fexp_(-sp - 0.5f);
                  const float asig = sigmoidf_(a0[e] + aa[rr][e]);
                  if (l > 0) v = v + (vff[e] - v) * sigmoidf_(v0[e] + av[rr][e]);
                  vo[e] = v; ro[e] = r; const float kr = k * kkc[e]; kro[e] = kr; bbo[e] = kr * asig; ss += kr * kr;
                  const float kpe = k * (1.0f + (asig - 1.0f) * kac[e]); kpo[e] = kpe; bs += r * kpe * rkc[e]; }
              const u32x2 vpk = {pk2(vo[0], vo[1]), pk2(vo[2], vo[3])};
              if (l == 0) *(u32x2*)(VF + idx) = vpk;
              *(u32x2*)(AR + 3 * AS + idx) = vpk; *(u32x2*)(AR + 6 * AS + idx) = (u32x2){pk2(ag[rr][0], ag[rr][1]), pk2(ag[rr][2], ag[rr][3])};
              *(LAS f32x4*)(LGF + tok * 64 + cb) = (f32x4){__uint_as_float(f2bf(lwo[0]) << 16), __uint_as_float(f2bf(lwo[1]) << 16), __uint_as_float(f2bf(lwo[2]) << 16), __uint_as_float(f2bf(lwo[3]) << 16)};
              *(LAS u32x2*)(SR + tok * 128 + cb * 2) = (u32x2){pk2(ro[0], ro[1]), pk2(ro[2], ro[3])}; *(LAS u32x2*)(SKP + tok * 128 + cb * 2) = (u32x2){pk2(kpo[0], kpo[1]), pk2(kpo[2], kpo[3])};
              *(LAS u32x2*)(SKR + tok * 128 + cb * 2) = (u32x2){pk2(kro[0], kro[1]), pk2(kro[2], kro[3])}; *(LAS u32x2*)(SBB + tok * 128 + cb * 2) = (u32x2){pk2(bbo[0], bbo[1]), pk2(bbo[2], bbo[3])};
#pragma unroll
              for (int e = 0; e < 4; ++e) *(LAS unsigned short*)(VTl + (cb + e) * ST + tok * 2) = (unsigned short)f2bf(vo[e]);
              ss += __shfl_xor(ss, 16); ss += __shfl_xor(ss, 32); bs += __shfl_xor(bs, 16); bs += __shfl_xor(bs, 32);
              if (quad == 0) { SSP[ct * 64 + tok] = ss; BSP[ct * 64 + tok] = bs; } } }
        __syncthreads();
        const int et = tid >> 3, ec = (tid & 7) * 8;
        { const int c = tid & 63, p = tid >> 6; float x[8]; float run = 0.f;
#pragma unroll
          for (int i = 0; i < 8; ++i) x[i] = LGF[(8 * p + i) * 64 + c];
#pragma unroll
          for (int i = 0; i < 8; ++i) { run += x[i]; LGF[(8 * p + i) * 64 + c] = run; }
          PART[p * 64 + c] = run; }
        __syncthreads();
        { float lg[8], lgp[8];
          { f32x4 o0 = {0.f, 0.f, 0.f, 0.f}, o1 = o0, q0 = o0, q1 = o0, tot0 = o0, tot1 = o0;
#pragma unroll
            for (int p = 0; p < 8; ++p) { const f32x4 a0 = *(const LAS f32x4*)(PART + p * 64 + ec), a1 = *(const LAS f32x4*)(PART + p * 64 + ec + 4); if (p < (et >> 3)) { o0 += a0; o1 += a1; } if (p < ((et - 1) >> 3)) { q0 += a0; q1 += a1; } tot0 += a0; tot1 += a1; }
            const f32x4 l0 = *(const LAS f32x4*)(LGF + et * 64 + ec) + o0, l1 = *(const LAS f32x4*)(LGF + et * 64 + ec + 4) + o1;
            f32x4 p0 = {0.f, 0.f, 0.f, 0.f}, p1 = p0; if (et > 0) { p0 = *(const LAS f32x4*)(LGF + (et - 1) * 64 + ec) + q0; p1 = *(const LAS f32x4*)(LGF + (et - 1) * 64 + ec + 4) + q1; }
            lg[0] = l0.x; lg[1] = l0.y; lg[2] = l0.z; lg[3] = l0.w; lg[4] = l1.x; lg[5] = l1.y; lg[6] = l1.z; lg[7] = l1.w;
            lgp[0] = p0.x; lgp[1] = p0.y; lgp[2] = p0.z; lgp[3] = p0.w; lgp[4] = p1.x; lgp[5] = p1.y; lgp[6] = p1.z; lgp[7] = p1.w;
            if (et == 63) { *(LAS f32x4*)(GC + ec) = (f32x4){fexp_(tot0.x), fexp_(tot0.y), fexp_(tot0.z), fexp_(tot0.w)}; *(LAS f32x4*)(GC + ec + 4) = (f32x4){fexp_(tot1.x), fexp_(tot1.y), fexp_(tot1.z), fexp_(tot1.w)}; } }
          const float ssum = (SSP[et] + SSP[64 + et]) + (SSP[128 + et] + SSP[192 + et]); const float kiv = __builtin_amdgcn_rsqf(fmaxf(ssum, 1e-24f));
          if (ec == 0) bonus[(tbase + et) * 8 + h] = (BSP[et] + BSP[64 + et]) + (BSP[128 + et] + BSP[192 + et]);
          const u32x4 wr = *(const LAS u32x4*)(SR + et * 128 + ec * 2), wk = *(const LAS u32x4*)(SKP + et * 128 + ec * 2), wkk = *(const LAS u32x4*)(SKR + et * 128 + ec * 2), wbb = *(const LAS u32x4*)(SBB + et * 128 + ec * 2);
          const float rv[8] = {blo(wr.x), bhi(wr.x), blo(wr.y), bhi(wr.y), blo(wr.z), bhi(wr.z), blo(wr.w), bhi(wr.w)}, kv[8] = {blo(wk.x), bhi(wk.x), blo(wk.y), bhi(wk.y), blo(wk.z), bhi(wk.z), blo(wk.w), bhi(wk.w)};
          const float kkv[8] = {blo(wkk.x), bhi(wkk.x), blo(wkk.y), bhi(wkk.y), blo(wkk.z), bhi(wkk.z), blo(wkk.w), bhi(wkk.w)}, bbv[8] = {blo(wbb.x), bhi(wbb.x), blo(wbb.y), bhi(wbb.y), blo(wbb.z), bhi(wbb.z), blo(wbb.w), bhi(wbb.w)};
          unsigned short ab[8], bb_[8], kb_[8], rb[8];
#pragma unroll
          for (int e = 0; e < 8; ++e) { const float ep = fexp_(lg[e]), en = fexp_(-lg[e]), epv = fexp_(lgp[e]);
              ab[e] = (unsigned short)f2bf(-kkv[e] * kiv * epv); bb_[e] = (unsigned short)f2bf(bbv[e] * kiv * en); kb_[e] = (unsigned short)f2bf(kv[e] * en); rb[e] = (unsigned short)f2bf(rv[e] * ep); }
#define PK8(x) (u32x4){(unsigned)x[0] | ((unsigned)x[1] << 16), (unsigned)x[2] | ((unsigned)x[3] << 16), (unsigned)x[4] | ((unsigned)x[5] << 16), (unsigned)x[6] | ((unsigned)x[7] << 16)}
          *(LAS u32x4*)(AT + et * ST + ec * 2) = PK8(ab); *(LAS u32x4*)(BT + et * ST + ec * 2) = PK8(bb_); *(LAS u32x4*)(KT + et * ST + ec * 2) = PK8(kb_); *(LAS u32x4*)(RT + et * ST + ec * 2) = PK8(rb);
#undef PK8
#pragma unroll
          for (int e = 0; e < 8; ++e) { *(LAS unsigned short*)(BTT + (ec + e) * ST + et * 2) = bb_[e]; *(LAS unsigned short*)(KTT + (ec + e) * ST + et * 2) = kb_[e]; } }
        __syncthreads();
        bf16x8_t ppk[2], qpk[2];
        if (wave < 4) { const int tt = wave; const bf16x8_t r0 = RD8(RT + (16 * tt + li) * ST + quad * 16), r1 = RD8(RT + (16 * tt + li) * ST + 64 + quad * 16);
            u32x2 pw[4], qw[4];
#pragma unroll
            for (int jt = 0; jt < 4; ++jt) { f32x4 pa = {0.f, 0.f, 0.f, 0.f}, qa = pa;
                pa = MF32(RD8(BT + (16 * jt + li) * ST + quad * 16), r0, pa); pa = MF32(RD8(BT + (16 * jt + li) * ST + 64 + quad * 16), r1, pa);
                qa = MF32(RD8(KT + (16 * jt + li) * ST + quad * 16), r0, qa); qa = MF32(RD8(KT + (16 * jt + li) * ST + 64 + quad * 16), r1, qa);
#pragma unroll
                for (int e = 0; e < 4; ++e) { const bool keep = (16 * jt + 4 * quad + e) <= (16 * tt + li); pa[e] = keep ? pa[e] : 0.f; qa[e] = keep ? qa[e] : 0.f; }
                pw[jt] = (u32x2){pg8::cvt_pk_bf16(pa[0], pa[1]), pg8::cvt_pk_bf16(pa[2], pa[3])}; qw[jt] = (u32x2){pg8::cvt_pk_bf16(qa[0], qa[1]), pg8::cvt_pk_bf16(qa[2], qa[3])}; }
            ppk[0] = __builtin_bit_cast(bf16x8_t, (u32x4){pw[0].x, pw[0].y, pw[1].x, pw[1].y}); ppk[1] = __builtin_bit_cast(bf16x8_t, (u32x4){pw[2].x, pw[2].y, pw[3].x, pw[3].y});
            qpk[0] = __builtin_bit_cast(bf16x8_t, (u32x4){qw[0].x, qw[0].y, qw[1].x, qw[1].y}); qpk[1] = __builtin_bit_cast(bf16x8_t, (u32x4){qw[2].x, qw[2].y, qw[3].x, qw[3].y});
        } else { const int rw = wave - 4; const bf16x8_t a0 = RD8(AT + (16 * rw + li) * ST + quad * 16), a1 = RD8(AT + (16 * rw + li) * ST + 64 + quad * 16);
            ppk[0] = (bf16x8_t){0, 0, 0, 0, 0, 0, 0, 0}; ppk[1] = ppk[0]; qpk[0] = ppk[0]; qpk[1] = ppk[0];
#pragma unroll
            for (int jt = 0; jt < 4; ++jt) { f32x4 na = {0.f, 0.f, 0.f, 0.f}, ma = na;
                if (jt <= rw) { na = MF32(a0, RD8(BT + (16 * jt + li) * ST + quad * 16), na); na = MF32(a1, RD8(BT + (16 * jt + li) * ST + 64 + quad * 16), na);
                                ma = MF32(a0, RD8(KT + (16 * jt + li) * ST + quad * 16), ma); ma = MF32(a1, RD8(KT + (16 * jt + li) * ST + 64 + quad * 16), ma); }
#pragma unroll
                for (int e = 0; e < 4; ++e) { const int tr = 16 * rw + 4 * quad + e, jc = 16 * jt + li; const bool keep = jc < tr; const float nv = keep ? na[e] : 0.f, mv = keep ? ma[e] : 0.f;
                    *(LAS unsigned short*)(NB + tr * ST + jc * 2) = (unsigned short)f2bf(nv); *(LAS unsigned short*)(MB + tr * ST + jc * 2) = (unsigned short)f2bf(mv);
                    if (jt == rw) ND[rw * 272 + (4 * quad + e) * 17 + li] = nv; } }
            LDS_WAIT(); asm volatile("" ::: "memory");
            if (lane < 16) { float x[16];
#pragma unroll
                for (int t = 0; t < 16; ++t) { float s = (t == lane) ? 1.f : 0.f;
#pragma unroll
                    for (int q = 0; q < t; ++q) s += ND[rw * 272 + t * 17 + q] * x[q];
                    x[t] = s; *(LAS unsigned short*)(DB + rw * 768 + t * 48 + lane * 2) = (unsigned short)f2bf(s); } }
        }
        __syncthreads();
        { const int cw = wave & 3; f32x4 rhs[4];
          if (wave < 4) {
#pragma unroll
              for (int i = 0; i < 4; ++i)
#pragma unroll
                  for (int e = 0; e < 4; ++e) rhs[i][e] = bf2f(*(const LAS unsigned short*)(AT + (16 * i + 4 * quad + e) * ST + (16 * cw + li) * 2));
          } else { const bf16x8_t v0 = RD8(VTl + (16 * cw + li) * ST + quad * 16), v1 = RD8(VTl + (16 * cw + li) * ST + 64 + quad * 16);
#pragma unroll
              for (int i = 0; i < 4; ++i) { f32x4 a = {0.f, 0.f, 0.f, 0.f}; a = MF32(RD8(MB + (16 * i + li) * ST + quad * 16), v0, a); a = MF32(RD8(MB + (16 * i + li) * ST + 64 + quad * 16), v1, a); rhs[i] = a; } }
          LAS unsigned char* XT = (wave < 4) ? WMT : UMT; bf16x4_t xb[4];
#pragma unroll
          for (int i = 0; i < 4; ++i) { f32x4 acc = rhs[i];
#pragma unroll
              for (int kb = 0; kb < 4; ++kb) if (kb < i) acc = MF16(RD4(NB + (16 * i + li) * ST + (16 * kb + 4 * quad) * 2), xb[kb], acc);
              const u32x2 aw = {pg8::cvt_pk_bf16(acc[0], acc[1]), pg8::cvt_pk_bf16(acc[2], acc[3])};
              f32x4 x = {0.f, 0.f, 0.f, 0.f}; x = MF16(RD4(DB + i * 768 + li * 48 + quad * 8), __builtin_bit_cast(bf16x4_t, aw), x);
              const u32x2 xw = {pg8::cvt_pk_bf16(x[0], x[1]), pg8::cvt_pk_bf16(x[2], x[3])}; xb[i] = __builtin_bit_cast(bf16x4_t, xw);
              *(LAS u32x2*)(XT + (16 * cw + li) * ST + (16 * i + 4 * quad) * 2) = xw; } }
        __syncthreads();
        if (wave < 4) { const int tt = wave; const int tg = 16 * tt + li;
            bf16* rmo = RM + (size_t)it * 4096 + tg * 64; bf16* y0o = Y0 + (size_t)it * 4096 + tg * 64;
#pragma unroll
            for (int ct = 0; ct < 4; ++ct) { const u32x2 rw2 = *(const LAS u32x2*)(RT + tg * ST + (16 * ct + 4 * quad) * 2); f32x4 acc = {blo(rw2.x), bhi(rw2.x), blo(rw2.y), bhi(rw2.y)};
#pragma unroll
                for (int s2 = 0; s2 < 2; ++s2) { const LAS unsigned char* wp = WMT + (16 * ct + li) * ST + (32 * s2 + 4 * quad) * 2; const u32x2 lo = *(const LAS u32x2*)wp, hi = *(const LAS u32x2*)(wp + 32);
                    acc = MF32(__builtin_bit_cast(bf16x8_t, (u32x4){lo.x, lo.y, hi.x, hi.y}), ppk[s2], acc); }
                *(u32x2*)(rmo + 16 * ct + 4 * quad) = (u32x2){pg8::cvt_pk_bf16(acc[0], acc[1]), pg8::cvt_pk_bf16(acc[2], acc[3])}; }
#pragma unroll
            for (int vt = 0; vt < 4; ++vt) { f32x4 acc = {0.f, 0.f, 0.f, 0.f};
#pragma unroll
                for (int s2 = 0; s2 < 2; ++s2) { const LAS unsigned char* up = UMT + (16 * vt + li) * ST + (32 * s2 + 4 * quad) * 2; const u32x2 ulo = *(const LAS u32x2*)up, uhi = *(const LAS u32x2*)(up + 32);
                    acc = MF32(__builtin_bit_cast(bf16x8_t, (u32x4){ulo.x, ulo.y, uhi.x, uhi.y}), ppk[s2], acc);
                    const LAS unsigned char* vp = VTl + (16 * vt + li) * ST + (32 * s2 + 4 * quad) * 2; const u32x2 vlo = *(const LAS u32x2*)vp, vhi = *(const LAS u32x2*)(vp + 32);
                    acc = MF32(__builtin_bit_cast(bf16x8_t, (u32x4){vlo.x, vlo.y, vhi.x, vhi.y}), qpk[s2], acc); }
                *(u32x2*)(y0o + 16 * vt + 4 * quad) = (u32x2){pg8::cvt_pk_bf16(acc[0], acc[1]), pg8::cvt_pk_bf16(acc[2], acc[3])}; }
        } else { const int xt = wave - 4;
            const bf16x8_t bt0 = RD8(BTT + (16 * xt + li) * ST + quad * 16), bt1 = RD8(BTT + (16 * xt + li) * ST + 64 + quad * 16);
            const float gc2 = GC[16 * xt + li]; bf16* pco = PCT + (size_t)it * 4096 + (16 * xt + li) * 64;
#pragma unroll
            for (int c1 = 0; c1 < 4; ++c1) { f32x4 acc = {0.f, 0.f, 0.f, 0.f};
                acc = MF32(RD8(WMT + (16 * c1 + li) * ST + quad * 16), bt0, acc); acc = MF32(RD8(WMT + (16 * c1 + li) * ST + 64 + quad * 16), bt1, acc);
                float o[4];
#pragma unroll
                for (int e = 0; e < 4; ++e) o[e] = gc2 * (acc[e] + (((16 * c1 + 4 * quad + e) == (16 * xt + li)) ? 1.f : 0.f));
                *(u32x2*)(pco + 16 * c1 + 4 * quad) = (u32x2){pg8::cvt_pk_bf16(o[0], o[1]), pg8::cvt_pk_bf16(o[2], o[3])}; }
            const bf16x8_t um0 = RD8(UMT + (16 * xt + li) * ST + quad * 16), um1 = RD8(UMT + (16 * xt + li) * ST + 64 + quad * 16), vt0 = RD8(VTl + (16 * xt + li) * ST + quad * 16), vt1 = RD8(VTl + (16 * xt + li) * ST + 64 + quad * 16);
            bf16* lco = LC + (size_t)it * 4096 + (16 * xt + li) * 64;
#pragma unroll
            for (int ct = 0; ct < 4; ++ct) { f32x4 acc = {0.f, 0.f, 0.f, 0.f};
                acc = MF32(RD8(BTT + (16 * ct + li) * ST + quad * 16), um0, acc); acc = MF32(RD8(BTT + (16 * ct + li) * ST + 64 + quad * 16), um1, acc);
                acc = MF32(RD8(KTT + (16 * ct + li) * ST + quad * 16), vt0, acc); acc = MF32(RD8(KTT + (16 * ct + li) * ST + 64 + quad * 16), vt1, acc);
                const f32x4 g4 = *(const LAS f32x4*)(GC + 16 * ct + 4 * quad);
                *(u32x2*)(lco + 16 * ct + 4 * quad) = (u32x2){pg8::cvt_pk_bf16(acc[0] * g4.x, acc[1] * g4.y), pg8::cvt_pk_bf16(acc[2] * g4.z, acc[3] * g4.w)}; }
        }
      }
    }
#undef F1LOAD
#undef MF32
#undef MF16
#undef RD8
#undef RD4
    __syncthreads();
}
template <int MODE> DI void state_scan16(Frame& F) {
    constexpr int SLOT = 18432, NSL = 6;
    const bf16* PT = (const bf16*)(WSP(F) + (MODE == 1 ? WS_PGT : WS_PCT)); const bf16* LL = (const bf16*)(WSP(F) + (MODE == 1 ? WS_LG : WS_LC));
    LAS unsigned char* ring = F.lds;
    const int nitems = (MODE == 1) ? BATCH * 8 : BATCH * 8 * 16;
#define RBAR() do { asm volatile("s_waitcnt lgkmcnt(0)" ::: "memory"); __builtin_amdgcn_s_barrier(); asm volatile("" ::: "memory"); } while (0)
    for (int it = F.bid; it < nitems; it += F.G) {
        int tid = F.tid; asm volatile("" : "+v"(tid));
        const int lane = tid & 63, wave = __builtin_amdgcn_readfirstlane(tid >> 6), vl = lane & 15, quad = lane >> 4;
        const size_t opbase = (MODE == 1) ? (size_t)it * 16 * 4096 : (size_t)((it >> 4) * 256 + (it & 15) * 16) * 4096;
        const bf16* pt = PT + opbase; const bf16* ll = LL + opbase;
        __syncthreads();
        const unsigned loffp = (unsigned)((tid >> 3) * 144 + (tid & 7) * 16), loffl = 9216u + loffp;
        u32x4 rg[4][2];
#define SLOAD(q, x) do { rg[q][0] = *((const u32x4*)(pt + (size_t)(x) * 4096) + tid); rg[q][1] = *((const u32x4*)(ll + (size_t)(x) * 4096) + tid); } while (0)
#define SWRITE(q, x) do { LAS unsigned char* d_ = ring + ((x) % NSL) * SLOT; *(LAS u32x4*)(d_ + loffp) = rg[q][0]; *(LAS u32x4*)(d_ + loffl) = rg[q][1]; } while (0)
        SLOAD(0, 0); SLOAD(1, 1); SLOAD(2, 2); SLOAD(3, 3);
        SWRITE(0, 0); SWRITE(1, 1);
        SLOAD(0, 4); SLOAD(1, 5);
        const bool pwave = (MODE == 0) && (wave < 4); const bool active = (MODE == 0) || (wave < 4); const int vb = wave & 3;
        f32x4 st[4];
#pragma unroll
        for (int kt = 0; kt < 4; ++kt) { st[kt] = (f32x4){0.f, 0.f, 0.f, 0.f};
            if (pwave) {
#pragma unroll
                for (int j = 0; j < 4; ++j) st[kt][j] = ((16 * kt + 4 * quad + j) == (16 * vb + vl)) ? 1.f : 0.f; }
            if (MODE == 2 && active) { const u32x2 w = *(const u32x2*)((const bf16*)(WSP(F) + WS_SG) + (size_t)it * 4096 + (16 * vb + vl) * 64 + 16 * kt + 4 * quad); st[kt] = (f32x4){blo(w.x), bhi(w.x), blo(w.y), bhi(w.y)}; } }
        const unsigned aoff = (unsigned)(vl * 144 + quad * 8), loffc = (unsigned)(9216 + (16 * vb + vl) * 144 + quad * 8);
        RBAR();
#pragma unroll
        for (int c = 0; c < 16; ++c) {
            if (c + 2 < 16) { SWRITE((c + 2) & 3, c + 2); if (c + 6 < 16) SLOAD((c + 2) & 3, c + 6); }
            if (active) {
                const LAS unsigned char* sl = ring + (c % NSL) * SLOT;
                bf16x8_t bfr[2];
                { u32x2 pk[4];
#pragma unroll
                  for (int kt = 0; kt < 4; ++kt) { pk[kt] = (u32x2){pg8::cvt_pk_bf16(st[kt][0], st[kt][1]), pg8::cvt_pk_bf16(st[kt][2], st[kt][3])};
                      if (MODE == 1) *(u32x2*)((bf16*)(WSP(F) + WS_SG) + ((size_t)it * 16 + c) * 4096 + (16 * vb + vl) * 64 + 16 * kt + 4 * quad) = pk[kt];
                      if (MODE == 2) *(u32x2*)((bf16*)(WSP(F) + WS_S0) + (opbase + (size_t)c * 4096) + (16 * vb + vl) * 64 + 16 * kt + 4 * quad) = pk[kt]; }
                  bfr[0] = __builtin_bit_cast(bf16x8_t, (u32x4){pk[0].x, pk[0].y, pk[1].x, pk[1].y}); bfr[1] = __builtin_bit_cast(bf16x8_t, (u32x4){pk[2].x, pk[2].y, pk[3].x, pk[3].y}); }
#pragma unroll
                for (int kt = 0; kt < 4; ++kt) { f32x4 acc = {0.f, 0.f, 0.f, 0.f};
                    if (!pwave) { const u32x2 lf = *(const LAS u32x2*)(sl + loffc + kt * 32); acc = (f32x4){blo(lf.x), bhi(lf.x), blo(lf.y), bhi(lf.y)}; }
#pragma unroll
                    for (int s2 = 0; s2 < 2; ++s2) { const u32x2 a0 = *(const LAS u32x2*)(sl + aoff + kt * 16 * 144 + s2 * 64), a1 = *(const LAS u32x2*)(sl + aoff + kt * 16 * 144 + s2 * 64 + 32);
                        acc = __builtin_amdgcn_mfma_f32_16x16x32_bf16(__builtin_bit_cast(bf16x8_t, (u32x4){a0.x, a0.y, a1.x, a1.y}), bfr[s2], acc, 0, 0, 0); }
                    st[kt] = acc; }
            }
            RBAR();
        }
        if (MODE == 0) {
            bf16* pg = (bf16*)(WSP(F) + WS_PGT) + (size_t)it * 4096; bf16* lg = (bf16*)(WSP(F) + WS_LG) + (size_t)it * 4096;
#pragma unroll
            for (int kt = 0; kt < 4; ++kt) {
                if (pwave) {
#pragma unroll
                    for (int j = 0; j < 4; ++j) pg[(16 * kt + 4 * quad + j) * 64 + 16 * vb + vl] = (bf16)f2bf(st[kt][j]);
                } else *(u32x2*)(lg + (16 * vb + vl) * 64 + 16 * kt + 4 * quad) = (u32x2){pg8::cvt_pk_bf16(st[kt][0], st[kt][1]), pg8::cvt_pk_bf16(st[kt][2], st[kt][3])}; }
        }
#undef SLOAD
#undef SWRITE
    }
#undef RBAR
    __syncthreads();
}
DI void rwkv_out_phase(Frame& F, int l) {
    bf16* AR = (bf16*)(WSP(F) + WS_AR); const size_t AS = (size_t)T * 512; const float* bonus = (const float*)(WSP(F) + WS_BONUS);
    const bf16* RM = (const bf16*)(WSP(F) + WS_RM); const bf16* Y0 = (const bf16*)(WSP(F) + WS_Y0); const bf16* S0 = (const bf16*)(WSP(F) + WS_S0);
    const int gw = F.bid * 8 + F.wave, NGW = F.G * 8, lane = F.lane, li = lane & 15, quad = lane >> 4;
    for (int it = gw; it < BATCH * 8 * (SEQ / 64); it += NGW) {
        const int bh = it >> 8, ck = it & 255, b = bh >> 3, h = bh & 7;
        const bf16* s0 = S0 + (size_t)it * 4096; const bf16* rm = RM + (size_t)it * 4096; const bf16* y0 = Y0 + (size_t)it * 4096;
        bf16x8_t sa[4][2];
#pragma unroll
        for (int vt = 0; vt < 4; ++vt)
#pragma unroll
            for (int s2 = 0; s2 < 2; ++s2) sa[vt][s2] = *(const bf16x8_t*)(s0 + (16 * vt + li) * 64 + 32 * s2 + 8 * quad);
        float lg[4][4], lb[4][4];
#pragma unroll
        for (int vt = 0; vt < 4; ++vt) { const f32x4 g4 = *(const f32x4*)(INP(F, 14) + l * 512 + h * 64 + 16 * vt + 4 * quad), b4 = *(const f32x4*)(INP(F, 15) + l * 512 + h * 64 + 16 * vt + 4 * quad);
            lg[vt][0] = g4.x; lg[vt][1] = g4.y; lg[vt][2] = g4.z; lg[vt][3] = g4.w; lb[vt][0] = b4.x; lb[vt][1] = b4.y; lb[vt][2] = b4.z; lb[vt][3] = b4.w; }
#pragma unroll 1
        for (int tt = 0; tt < 4; ++tt) {
            const int tch = 16 * tt + li; const size_t t = (size_t)b * SEQ + ck * 64 + tch;
            bf16x8_t rb[2];
#pragma unroll
            for (int s2 = 0; s2 < 2; ++s2) rb[s2] = *(const bf16x8_t*)(rm + tch * 64 + 32 * s2 + 8 * quad);
            f32x4 acc[4];
#pragma unroll
            for (int vt = 0; vt < 4; ++vt) { const u32x2 yw = *(const u32x2*)(y0 + tch * 64 + 16 * vt + 4 * quad); acc[vt] = (f32x4){blo(yw.x), bhi(yw.x), blo(yw.y), bhi(yw.y)};
                acc[vt] = __builtin_amdgcn_mfma_f32_16x16x32_bf16(sa[vt][0], rb[0], acc[vt], 0, 0, 0); acc[vt] = __builtin_amdgcn_mfma_f32_16x16x32_bf16(sa[vt][1], rb[1], acc[vt], 0, 0, 0); }
            float sm = 0.f;
#pragma unroll
            for (int vt = 0; vt < 4; ++vt) sm += (acc[vt][0] + acc[vt][1]) + (acc[vt][2] + acc[vt][3]);
            sm += __shfl_xor(sm, 16); sm += __shfl_xor(sm, 32);
            const float mean = sm * (1.f / 64.f); float sq = 0.f;
#pragma unroll
            for (int vt = 0; vt < 4; ++vt)
#pragma unroll
                for (int e = 0; e < 4; ++e) { const float d = acc[vt][e] - mean; acc[vt][e] = d; sq += d * d; }
            sq += __shfl_xor(sq, 16); sq += __shfl_xor(sq, 32);
            const float rstd = rsqrtf(sq * (1.f / 64.f) + 64e-5f), bon = bonus[t * 8 + h];
            const size_t idx = t * 512 + h * 64 + 4 * quad;
#pragma unroll
            for (int vt = 0; vt < 4; ++vt) { const u32x2 vw = *(const u32x2*)(AR + 3 * AS + idx + 16 * vt), gw2 = *(const u32x2*)(AR + 6 * AS + idx + 16 * vt);
                const float vv[4] = {blo(vw.x), bhi(vw.x), blo(vw.y), bhi(vw.y)}, gg[4] = {blo(gw2.x), bhi(gw2.x), blo(gw2.y), bhi(gw2.y)}; float o[4];
#pragma unroll
                for (int e = 0; e < 4; ++e) o[e] = (acc[vt][e] * rstd * lg[vt][e] + lb[vt][e] + bon * vv[e]) * gg[e];
                *(u32x2*)(AR + idx + 16 * vt) = (u32x2){pk2(o[0], o[1]), pk2(o[2], o[3])}; }
        }
    }
}
DI void route_phase(Frame& F, int l) {
    const float* x = OUTP(F); bf16* h2 = (bf16*)(WSP(F) + WS_XB); const bf16* RWH = (const bf16*)(WSP(F) + WS_RWG); const bf16* RWL = RWH + 48 * 1024;
    int* route = (int*)(WSP(F) + WS_ROUTE); float* rwt = (float*)(WSP(F) + WS_RWT); unsigned* cnt = (unsigned*)(WSP(F) + WS_CTL) + CW_CNT + 32 * l;
    const float* rgb = INP(F, 24) + l * 4; const float* reb = INP(F, 26) + l * 32;
    LAS unsigned* lc = (LAS unsigned*)(F.lds + MISC_OFF + 8192); unsigned* wgbase = (unsigned*)(WSP(F) + WS_WGBASE);
    for (int wit = F.bid; wit < T / 128; wit += F.G) {
        int lane = F.lane; asm volatile("" : "+v"(lane));
        __syncthreads();
        if (F.tid < 32) lc[F.tid] = 0u;
        __syncthreads();
        const int it = wit * 8 + F.wave;
        const int li = lane & 15, quad = lane >> 4; const size_t t = (size_t)it * 16 + li;
        const float* xr = x + t * DM + 8 * quad;
        f32x4 acc[3];
#pragma unroll
        for (int jt = 0; jt < 3; ++jt) acc[jt] = (f32x4){0.f, 0.f, 0.f, 0.f};
        float ss = 0.f;
        LAS unsigned char* wbuf = F.lds;
        u32x4 wst[3]; f32x4 xc[8], xn[8];
#define WLOAD(kc) do { _Pragma("unroll") for (int i = 0; i < 3; ++i) { const int p_ = F.tid + 512 * i, hl_ = p_ / 768, q_ = p_ % 768, r_ = q_ >> 4, c_ = q_ & 15; \
            wst[i] = *(const u32x4*)((hl_ ? RWL : RWH) + (size_t)r_ * 1024 + (kc) * 128 + c_ * 8); } } while (0)
#define WSTORE(bf) do { _Pragma("unroll") for (int i = 0; i < 3; ++i) { const int p_ = F.tid + 512 * i, hl_ = p_ / 768, q_ = p_ % 768, r_ = q_ >> 4, c_ = q_ & 15; \
            *(LAS u32x4*)(wbuf + (bf) * 26112 + hl_ * 13056 + r_ * 272 + c_ * 16) = wst[i]; } } while (0)
#define XLOAD(dst, kc) do { _Pragma("unroll") for (int k_ = 0; k_ < 4; ++k_) { dst[2 * k_] = *(const f32x4*)(xr + (kc) * 128 + 32 * k_); dst[2 * k_ + 1] = *(const f32x4*)(xr + (kc) * 128 + 32 * k_ + 4); } } while (0)
        WLOAD(0); XLOAD(xc, 0);
        WSTORE(0);
        __syncthreads();
#pragma unroll
        for (int kc = 0; kc < 8; ++kc) {
            if (kc < 7) { WLOAD(kc + 1); XLOAD(xn, kc + 1); }
            const LAS unsigned char* wb = wbuf + (kc & 1) * 26112;
#pragma unroll
            for (int k4 = 0; k4 < 4; ++k4) {
                const f32x4 x0 = xc[2 * k4], x1 = xc[2 * k4 + 1];
                ss += (x0.x * x0.x + x0.y * x0.y) + (x0.z * x0.z + x0.w * x0.w) + (x1.x * x1.x + x1.y * x1.y) + (x1.z * x1.z + x1.w * x1.w);
                const unsigned h0 = pk2(x0.x, x0.y), h1 = pk2(x0.z, x0.w), h2_ = pk2(x1.x, x1.y), h3 = pk2(x1.z, x1.w);
                const bf16x8_t bh = __builtin_bit_cast(bf16x8_t, (u32x4){h0, h1, h2_, h3});
                const bf16x8_t bl = __builtin_bit_cast(bf16x8_t, (u32x4){pk2(x0.x - blo(h0), x0.y - bhi(h0)), pk2(x0.z - blo(h1), x0.w - bhi(h1)), pk2(x1.x - blo(h2_), x1.y - bhi(h2_)), pk2(x1.z - blo(h3), x1.w - bhi(h3))});
#pragma unroll
                for (int jt = 0; jt < 3; ++jt) { const LAS unsigned char* wp = wb + (16 * jt + li) * 272 + k4 * 64 + quad * 16;
                    const bf16x8_t wh = *(const LAS bf16x8_t*)wp, wl = *(const LAS bf16x8_t*)(wp + 13056);
                    acc[jt] = __builtin_amdgcn_mfma_f32_16x16x32_bf16(wh, bh, acc[jt], 0, 0, 0);
                    acc[jt] = __builtin_amdgcn_mfma_f32_16x16x32_bf16(wl, bh, acc[jt], 0, 0, 0);
                    acc[jt] = __builtin_amdgcn_mfma_f32_16x16x32_bf16(wh, bl, acc[jt], 0, 0, 0); }
            }
            if (kc < 7) { WSTORE((kc + 1) & 1);
#pragma unroll
                for (int i = 0; i < 8; ++i) xc[i] = xn[i]; }
            __syncthreads();
        }
#undef WLOAD
#undef WSTORE
#undef XLOAD
        ss += __shfl_xor(ss, 16); ss += __shfl_xor(ss, 32);
        const float rs = rsqrtf(ss * (1.f / DM) + 1e-6f);
#pragma unroll 4
        for (int ks = 0; ks < 32; ++ks) { const f32x4 x0 = *(const f32x4*)(xr + 32 * ks), x1 = *(const f32x4*)(xr + 32 * ks + 4);
            *(u32x4*)(h2 + t * DM + 32 * ks + 8 * quad) = (u32x4){pk2(x0.x * rs, x0.y * rs), pk2(x0.z * rs, x0.w * rs), pk2(x1.x * rs, x1.y * rs), pk2(x1.z * rs, x1.w * rs)}; }
        float gl[4]; int grp = 0;
#pragma unroll
        for (int j = 0; j < 4; ++j) gl[j] = acc[0][j] * rs + rgb[j];
        float gm = gl[0];
#pragma unroll
        for (int j = 1; j < 4; ++j) if (gl[j] > gm) { gm = gl[j]; grp = j; }
        if (quad == grp) {
            float gs = 0.f;
#pragma unroll
            for (int j = 0; j < 4; ++j) gs += __expf(gl[j] - gm);
            const float gprob = frcp_(gs);
            float eg[8];
#pragma unroll
            for (int i = 0; i < 4; ++i) { eg[i] = acc[1][i] * rs + reb[8 * quad + i]; eg[4 + i] = acc[2][i] * rs + reb[8 * quad + 4 + i]; }
            int i0 = 0; float m0 = eg[0];
#pragma unroll
            for (int i = 1; i < 8; ++i) if (eg[i] > m0) { m0 = eg[i]; i0 = i; }
            int i1 = -1; float m1 = -INFINITY;
#pragma unroll
            for (int i = 0; i < 8; ++i) if (i != i0 && eg[i] > m1) { m1 = eg[i]; i1 = i; }
            const float e10 = fexp_(m1 - m0), r10 = frcp_(1.0f + e10), wa = gprob * r10, wb = gprob * e10 * r10;
            const int e0 = grp * 8 + i0, e1 = grp * 8 + i1;
            const unsigned r0 = atomicAdd((unsigned*)(lc + e0), 1u), r1 = atomicAdd((unsigned*)(lc + e1), 1u);
            ((int4*)route)[t] = make_int4(e0, (int)r0, e1, (int)r1); ((float2*)rwt)[t] = make_float2(wa, wb);
        }
        __syncthreads();
        if (F.tid < 32) { const unsigned c = lc[F.tid]; wgbase[wit * 32 + F.tid] = c ? atomicAdd(cnt + F.tid, c) : 0u; }
    }
    __syncthreads();
}
DI int moe_tables(Frame& F, int l) {
    LAS int* ps = (LAS int*)(F.lds + MISC_OFF); LAS unsigned char* te = (LAS unsigned char*)(F.lds + MISC_OFF + 256);
    const unsigned* cnt = (const unsigned*)(WSP(F) + WS_CTL) + CW_CNT + 32 * l;
    __syncthreads();
    if (F.tid == 0) { int acc = 0;
_Pragma("unroll 1")
        for (int e = 0; e < NEXP; ++e) { ps[e] = acc; const int c = (int)__hip_atomic_load(cnt + e, __ATOMIC_RELAXED, __HIP_MEMORY_SCOPE_AGENT); const int nt = (c + 255) >> 8;
_Pragma("unroll 1")
            for (int i = 0; i < nt; ++i) te[(acc >> 8) + i] = (unsigned char)e; acc += nt << 8; } ps[NEXP] = acc; }
    __syncthreads();
    return __builtin_amdgcn_readfirstlane(ps[NEXP] >> 8);
}
DI void permute_phase(Frame& F, int l) {
    moe_tables(F, l);
    const LAS int* ps = (const LAS int*)(F.lds + MISC_OFF);
    const bf16* h2 = (const bf16*)(WSP(F) + WS_XB); bf16* xp = (bf16*)(WSP(F) + WS_XPERM); const int* route = (const int*)(WSP(F) + WS_ROUTE); int* dest = (int*)(WSP(F) + WS_DEST);
    const int gw = F.bid * 8 + F.wave, NGW = F.G * 8, lane = F.lane;
    for (int t = gw; t < T; t += NGW) {
        const int4 r = ((const int4*)route)[t]; const unsigned* wb_ = (const unsigned*)(WSP(F) + WS_WGBASE) + (t >> 7) * 32; const int d0 = ps[r.x] + (int)wb_[r.x] + r.y, d1 = ps[r.z] + (int)wb_[r.z] + r.w;
        const u32x4* src = (const u32x4*)(h2 + (size_t)t * DM) + lane; u32x4* o0 = (u32x4*)(xp + (size_t)d0 * DM) + lane; u32x4* o1 = (u32x4*)(xp + (size_t)d1 * DM) + lane;
        const u32x4 a = src[0], b = src[64]; o0[0] = a; o0[64] = b; o1[0] = a; o1[64] = b;
        if (lane == 0) ((int2*)dest)[t] = make_int2(d0, d1);
    }
}
DI void combine_phase(Frame& F, int l) {
    float* x = OUTP(F); const bf16* Y = (const bf16*)(WSP(F) + WS_YMOE); const int* dest = (const int*)(WSP(F) + WS_DEST); const float* rwt = (const float*)(WSP(F) + WS_RWT);
    bf16* xb = (bf16*)(WSP(F) + WS_XB); const float* fg = INP(F, 30);
    const int gw = F.bid * 8 + F.wave, NGW = F.G * 8, lane = F.lane; const bool last = (l == DEPTH - 1);
    for (int t = gw; t < T; t += NGW) {
        const int2 d = ((const int2*)dest)[t]; const float2 w = ((const float2*)rwt)[t];
        f32x4* xr = (f32x4*)(x + (size_t)t * DM) + lane; const u32x2* y0 = (const u32x2*)(Y + (size_t)d.x * DM) + lane; const u32x2* y1 = (const u32x2*)(Y + (size_t)d.y * DM) + lane;
        f32x4 v[4]; float s = 0.f;
#pragma unroll
        for (int j = 0; j < 4; ++j) { v[j] = xr[64 * j]; const u32x2 a = y0[64 * j], b = y1[64 * j];
            v[j].x += w.x * blo(a.x) + w.y * blo(b.x); v[j].y += w.x * bhi(a.x) + w.y * bhi(b.x); v[j].z += w.x * blo(a.y) + w.y * blo(b.y); v[j].w += w.x * bhi(a.y) + w.y * bhi(b.y);
            s += (v[j].x * v[j].x + v[j].y * v[j].y) + (v[j].z * v[j].z + v[j].w * v[j].w); }
        const float rs = rsqrtf(wave_sum(s) * (1.f / DM) + 1e-6f);
        if (last) {
#pragma unroll
            for (int j = 0; j < 4; ++j) { const f32x4 g = ((const f32x4*)fg)[lane + 64 * j]; xr[64 * j] = v[j] * rs * g; }
        } else {
            u32x2* o = (u32x2*)(xb + (size_t)t * DM) + lane;
#pragma unroll
            for (int j = 0; j < 4; ++j) { xr[64 * j] = v[j]; o[64 * j] = (u32x2){pk2(v[j].x * rs, v[j].y * rs), pk2(v[j].z * rs, v[j].w * rs)}; }
        }
    }
}

DI void dump_bf16(Frame& F, const bf16* src, int pitch, int ncols, int c0) {
    float* out = OUTP(F);
    for (size_t i = (size_t)F.bid * 512 + F.tid; i < (size_t)T * ncols; i += (size_t)F.G * 512) { const size_t t = i / ncols; const int c = (int)(i % ncols); out[t * DM + c0 + c] = bf2f(src[t * pitch + c]); }
}
__global__ void __launch_bounds__(512, 2) mk_fwd(Args args) {
    extern __shared__ __attribute__((aligned(16))) unsigned char lds_raw[];
    cg::grid_group grid = cg::this_grid();
    Frame F; F.lds = (LAS unsigned char*)lds_raw; F.tid = threadIdx.x; F.lane = F.tid & 63; F.wave = __builtin_amdgcn_readfirstlane(F.tid >> 6); F.G = gridDim.x; F.bid = (int)__builtin_amdgcn_workgroup_id_x();
    F.kp = (kargp_t)__builtin_amdgcn_kernarg_segment_ptr();
    for (int u = F.tid; u < 64; u += 512) ((LAS unsigned*)(F.lds + MISC_OFF + 4096))[u] = 0u;
    __syncthreads();
    (void)xcd_barrier_post((unsigned*)(WSP(F) + WS_CTL) + CW_BAR, (volatile LAS unsigned*)(F.lds + MISC_OFF + 4096));
    grid.sync();
#define GRID_BAR() do { XcdBarrier bb_; bb_.bar = (unsigned*)(WSP(F) + WS_CTL) + CW_BAR; bb_.x = xb_xcc_id(); bb_.st = (volatile LAS unsigned*)(F.lds + MISC_OFF + 4096); xcd_barrier(bb_); fence_frame(F); } while (0)
#define ws WSP(F)
#if defined(DBG_TMASK)
#define PT0() const unsigned long long pt0_ = __builtin_amdgcn_s_memrealtime()
#define PT1(k) do { if ((DBG_TMASK >> (k)) & 1) { const unsigned long long n_ = __builtin_amdgcn_s_memrealtime(); const unsigned long long e_ = n_ + (unsigned long long)DBG_AMP * (n_ - pt0_); while (__builtin_amdgcn_s_memrealtime() < e_) __builtin_amdgcn_s_sleep(16); } } while (0)
#else
#define PT0() do {} while (0)
#define PT1(k) do {} while (0)
#endif
    { PT0(); prep_mixer_weights(F, 0);
    rms_rows_to_bf16(F, INP(F, 0), (bf16*)(ws + WS_XB));
    GRID_BAR(); PT1(0); }
#if defined(DBG_STOP) && DBG_STOP == 10
    { PT0(); { pg8::Gemm g{(const bf16*)(ws + WS_XB), (const bf16*)(ws + WS_WG), T, 3072, DM}; pg8::StaticOrder S; S.init(T, 3072, F.G, (int)F.bid);
      pg8::EpiGate E{(unsigned char*)(ws + WS_GATES), 3072};
      pg8::gemm_phase<pg8::EpiGate, pg8::StaticOrder, true, true>(F.lds, g, S, E); }
    GRID_BAR(); PT1(10); }
    dump_bf16(F, (const bf16*)(ws + WS_GATES) + 1024, 3072, 1024, 0); return;
#endif
#pragma unroll 1
    for (int l = 0; l < DEPTH; ++l) {
        { PT0(); { pg8::Gemm g{(const bf16*)(ws + WS_XB), (const bf16*)(ws + WS_WIN), T, l == 0 ? 3840 : 4096, DM}; pg8::StaticOrder S; S.init(T, g.N, F.G, (int)F.bid);
          pg8::EpiZ E{(bf16*)(ws + WS_Q), (bf16*)(ws + WS_K), (bf16*)(ws + WS_VT), (bf16*)(ws + WS_POOLZ), (bf16*)(ws + WS_RWKVZ), C2, SEQ};
          pg8::gemm_phase<pg8::EpiZ, pg8::StaticOrder, true, true>(F.lds, g, S, E); }
        GRID_BAR(); PT1(1); }
        { PT0(); kmean_phase(F);
        pool_phase(F, l);
        GRID_BAR(); PT1(2); }
        { PT0(); sel_phase(F, l);
        GRID_BAR(); PT1(3); }
        { PT0(); att_phase(F, l);
        GRID_BAR(); PT1(4); }
        { PT0(); comb_phase(F);
        GRID_BAR(); PT1(5); }
#if defined(DBG_STOP) && DBG_STOP == 3
        dump_bf16(F, (const bf16*)(ws + WS_YATTN), 512, 512, 0); dump_bf16(F, (const bf16*)(ws + WS_YPOOL), 512, 512, 512); return;
#endif

        { PT0(); rwkv_chunk_phase(F, l);
        GRID_BAR(); PT1(7); }
        { PT0(); state_scan16<0>(F);
        GRID_BAR();
        state_scan16<1>(F);
        GRID_BAR();
        state_scan16<2>(F);
        GRID_BAR(); PT1(8); }
        { PT0(); rwkv_out_phase(F, l);
        GRID_BAR(); PT1(9); }
        { pg8::Gemm g{(const bf16*)(ws + WS_XB), (const bf16*)(ws + WS_WG), T, 3072, DM}; pg8::StaticOrder S; S.init(T, 3072, F.G, (int)F.bid);
          pg8::EpiGate E{(unsigned char*)(ws + WS_GATES), 3072};
          pg8::gemm_phase<pg8::EpiGate, pg8::StaticOrder, true, true>(F.lds, g, S, E); }
        GRID_BAR();
#if defined(DBG_SCRUB)
        { const f32x4* xs = (const f32x4*)INP(F, 0) + (size_t)F.bid * 32768; f32x4 a = {0.f, 0.f, 0.f, 0.f};
          for (int i = F.tid; i < 32768; i += 512) a += xs[i];
          if (a.x + a.y + a.z + a.w == 12345.678f) ((float*)(ws + WS_BONUS))[F.tid] = a.x; }
        GRID_BAR();
#endif
        { PT0(); { pg8::StaticOrder S; S.init(T, DM, F.G, (int)F.bid);
          { pg8::Gemm g{(const bf16*)(ws + WS_YATTN), (const bf16*)(ws + WS_WBR), T, DM, 512};
            pg8::EpiMerge<true> E{(bf16*)(ws + WS_XB), DM, (const unsigned char*)(ws + WS_GATES), 3072, 0};
            pg8::gemm_phase<pg8::EpiMerge<true>, pg8::StaticOrder, true, true>(F.lds, g, S, E); }
          { pg8::Gemm g{(const bf16*)(ws + WS_AR), (const bf16*)(ws + WS_WBR) + (size_t)1024 * 512, T, DM, 512};
            pg8::EpiMerge<false> E{(bf16*)(ws + WS_XB), DM, (const unsigned char*)(ws + WS_GATES), 3072, 1024};
            pg8::gemm_phase<pg8::EpiMerge<false>, pg8::StaticOrder, true, true>(F.lds, g, S, E); }
          { pg8::Gemm g{(const bf16*)(ws + WS_YPOOL), (const bf16*)(ws + WS_WBR) + (size_t)2 * 1024 * 512, T, DM, 512};
            pg8::EpiMerge<false> E{(bf16*)(ws + WS_XB), DM, (const unsigned char*)(ws + WS_GATES), 3072, 2048};
            pg8::gemm_phase<pg8::EpiMerge<false>, pg8::StaticOrder, true, true>(F.lds, g, S, E); } }
        GRID_BAR(); PT1(11); }
#if defined(DBG_STOP) && DBG_STOP == 7
        dump_bf16(F, (const bf16*)(ws + WS_XB), 1024, 1024, 0); return;
#endif
#if defined(DBG_STOP) && DBG_STOP == 6
        dump_bf16(F, (const bf16*)(ws + WS_GATES) + 1024, 3072, 1024, 0); return;
#endif
        { PT0(); { pg8::Gemm g{(const bf16*)(ws + WS_XB), (const bf16*)(ws + WS_WOUT), T, DM, DM}; pg8::StaticOrder S; S.init(T, DM, F.G, (int)F.bid);
          pg8::EpiResF32 E{l == 0 ? INP(F, 0) : OUTP(F), OUTP(F), DM};
          pg8::gemm_phase<pg8::EpiResF32, pg8::StaticOrder, true, true>(F.lds, g, S, E); }
        GRID_BAR(); PT1(12); }
#if defined(DBG_STOP) && DBG_STOP == 1
        return;
#endif
        { PT0(); route_phase(F, l);
#if defined(DBG_TMASK)
        GRID_BAR(); PT1(13); } { PT0();
#endif
        prep_expert_weights(F, l);
        GRID_BAR(); PT1(18); }
        { PT0(); permute_phase(F, l);
        GRID_BAR(); PT1(14); }
        { const int ntile = moe_tables(F, l);
          const LAS unsigned char* te = (const LAS unsigned char*)(F.lds + MISC_OFF + 256);
          { PT0(); { pg8::Gemm g{(const bf16*)(ws + WS_XPERM), (const bf16*)(ws + WS_W13), RMAX, NEXP * 1024, DM}; pg8::MoeOrder S{te, ntile * 4, F.G, (int)F.bid};
            pg8::EpiSwiGLU E{(bf16*)(ws + WS_HACT)};
            pg8::gemm_phase<pg8::EpiSwiGLU, pg8::MoeOrder, true, true>(F.lds, g, S, E); }
          GRID_BAR(); PT1(15); }
          { PT0(); { pg8::Gemm g{(const bf16*)(ws + WS_HACT), (const bf16*)(ws + WS_W2), RMAX, NEXP * 1024, 512}; pg8::MoeOrder S{te, ntile * 4, F.G, (int)F.bid};
            pg8::EpiY E{(bf16*)(ws + WS_YMOE)};
            pg8::gemm_phase<pg8::EpiY, pg8::MoeOrder, true, true>(F.lds, g, S, E); }
        GRID_BAR(); PT1(16); } }
        { PT0(); combine_phase(F, l);
        if (l + 1 < DEPTH) prep_mixer_weights(F, l + 1);
        GRID_BAR(); PT1(17); }
#if defined(DBG_STOP) && DBG_STOP == 2
        return;
#endif
    }
#undef ws
}

extern "C" void kernel_launch(void* const* d_in, const int* in_sizes, int n_in, void* d_out, int out_size, void* d_ws, size_t ws_size, hipStream_t stream) {
    static int grid = 0;
    if (grid == 0) {
        if (n_in != 31 || out_size != T * DM || ws_size < WS_END) { fprintf(stderr, "kernel_launch: unexpected shapes (n_in %d out %d ws %zu, need %zu)\n", n_in, out_size, ws_size, (size_t)WS_END); grid = -1; return; }
        int dev = 0, cus = 0, per_cu = 0;
        (void)hipGetDevice(&dev); (void)hipDeviceGetAttribute(&cus, hipDeviceAttributeMultiprocessorCount, dev);
        (void)hipFuncSetAttribute((const void*)mk_fwd, hipFuncAttributeMaxDynamicSharedMemorySize, LDS_BYTES);
        (void)hipOccupancyMaxActiveBlocksPerMultiprocessor(&per_cu, (const void*)mk_fwd, 512, LDS_BYTES);
        (void)hipGetLastError();
        fprintf(stderr, "kernel_launch: cus %d per_cu %d ws %zu\n", cus, per_cu, ws_size);
        grid = cus;
    }
    if (grid < 0) return;
    (void)hipMemsetAsync((char*)d_ws + WS_CTL, 0, CTL_BYTES, stream);
    Args a{};
    for (int i = 0; i < 31; ++i) a.in[i] = (const float*)d_in[i];
    a.out = (float*)d_out; a.ws = (unsigned char*)d_ws;
    void* kargs[] = {&a};
    hipError_t e = hipLaunchCooperativeKernel((const void*)mk_fwd, dim3(grid), dim3(512), kargs, LDS_BYTES, stream);
    if (e != hipSuccess) fprintf(stderr, "cooperative launch failed: %s (grid %d)\n", hipGetErrorString(e), grid);
}
```

```cpp
#include <hip/hip_runtime.h>
#include <hip/hip_cooperative_groups.h>
#include <cstdio>
#include <cstdint>
#include <cmath>
namespace pg8 {
#define PG8_LAS __attribute__((address_space(3)))
typedef unsigned short bf16_t;
typedef short bf16x8 __attribute__((ext_vector_type(8)));
typedef float f32x4 __attribute__((ext_vector_type(4)));
typedef unsigned u32x4 __attribute__((ext_vector_type(4)));
constexpr int BM = 256, BK = 64, HALF = 128, HTB = HALF * BK * 2  , STAGE_BYTES = 8 * HTB, NXCD = 8, WGM = 8;

__host__ __device__ __forceinline__ int lds_byte(int r, int c) { const int st = (r >> 4) * 2 + (c >> 5), rr = r & 15, cc = c & 31, ob = rr * 64 + cc * 2; return st * 1024 + (ob ^ (((ob >> 9) & 1) << 5)); }
__host__ __device__ __forceinline__ void stage_rc(int b, int& R, int& C) { const int st = b / 1024, sb = b % 1024, swz = sb ^ (((sb >> 9) & 1) << 5); R = (st >> 1) * 16 + swz / 64; C = (st & 1) * 32 + (swz % 64) / 2; }
__host__ __device__ __forceinline__ int perm32(int rho) { const int n = rho >> 4, i = rho & 15; return 8 * (i >> 2) + 4 * n + (i & 3); }

struct Unit { int pm, pn; };
struct Gemm { const bf16_t* A; const bf16_t* Bt; int M, N, K; };

struct StaticOrder {
    int nM, nN, nwg, G, c;
    __host__ __device__ void init(int M, int N, int G_, int c_) { nM = M / BM; nN = N / BM; nwg = nM * nN; G = G_; c = c_; }
    __host__ __device__ bool next(int i, Unit& u) const {
        const long L = (long)i * G + c; if (L >= nwg) return false;
        int wgid = (int)L; { const int q = nwg / NXCD, r = nwg % NXCD, xcd = wgid % NXCD, off = wgid / NXCD; wgid = (xcd < r ? xcd * (q + 1) : r * (q + 1) + (xcd - r) * q) + off; }
        const int nig = WGM * nN, gid = wgid / nig, fm = gid * WGM, gsz = (nM - fm) < WGM ? (nM - fm) : WGM;
        u.pm = fm + ((wgid % nig) % gsz); u.pn = (wgid % nig) / gsz; return true;
    }
    __device__ __forceinline__ void a_ready(const Unit&) const {}
    __device__ __forceinline__ void done(const Unit&) const {}
};

typedef float f32x2c_t __attribute__((ext_vector_type(2))); typedef __bf16 bf16x2c_t __attribute__((ext_vector_type(2)));
__device__ __forceinline__ unsigned cvt_pk_bf16(float lo, float hi) { const f32x2c_t v = {lo, hi}; const bf16x2c_t b = __builtin_convertvector(v, bf16x2c_t); return __builtin_bit_cast(unsigned, b); }
typedef float f32x2 __attribute__((ext_vector_type(2)));
__device__ __forceinline__ float fast_sigmoid(float x) { return __builtin_amdgcn_rcpf(1.0f + __builtin_amdgcn_exp2f(-1.4426950408889634f * x)); }
struct EpiZ {
    static constexpr bool PERM = true, AFTER_DRAIN = false;
    bf16_t *q, *k, *vt, *poolz, *rwkvz; float qscale; int seq;
    __device__ __forceinline__ void operator()(const f32x4 (&acc)[2][2][4][2], const Unit& u, int wr, int wc, int fr, int fq) const {
        const int pn = u.pn;
        if (pn == 4 || pn == 5) {
            const int row0 = u.pm * BM + wr * 64 + fr, c0 = (pn - 4) * 256 + wc * 32 + 8 * fq;
#pragma unroll
            for (int ai = 0; ai < 2; ++ai)
#pragma unroll
                for (int m = 0; m < 4; ++m) { const int row = row0 + ai * HALF + m * 16, b = row / seq, tl = row - b * seq;
#pragma unroll
                    for (int bj = 0; bj < 2; ++bj) { const int c = c0 + bj * HALF, h = c >> 6, d = c & 63; bf16_t* vp = vt + ((size_t)(b * 8 + h) * 64 + d) * seq + tl;
                        const unsigned w0 = cvt_pk_bf16(acc[ai][bj][m][0][0], acc[ai][bj][m][0][1]), w1 = cvt_pk_bf16(acc[ai][bj][m][0][2], acc[ai][bj][m][0][3]);
                        const unsigned w2 = cvt_pk_bf16(acc[ai][bj][m][1][0], acc[ai][bj][m][1][1]), w3 = cvt_pk_bf16(acc[ai][bj][m][1][2], acc[ai][bj][m][1][3]);
                        vp[0] = (bf16_t)(w0 & 0xffffu); vp[(size_t)seq] = (bf16_t)(w0 >> 16); vp[(size_t)2 * seq] = (bf16_t)(w1 & 0xffffu); vp[(size_t)3 * seq] = (bf16_t)(w1 >> 16);
                        vp[(size_t)4 * seq] = (bf16_t)(w2 & 0xffffu); vp[(size_t)5 * seq] = (bf16_t)(w2 >> 16); vp[(size_t)6 * seq] = (bf16_t)(w3 & 0xffffu); vp[(size_t)7 * seq] = (bf16_t)(w3 >> 16); } }
            return;
        }
        bf16_t* base; int ldc, colt, climit; float sc = 1.f;
        if (pn < 2) { base = q; ldc = 512; colt = pn * 256; climit = 512; sc = qscale; }
        else if (pn < 4) { base = k; ldc = 512; colt = (pn - 2) * 256; climit = 512; }
        else if (pn < 8) { base = poolz; ldc = 512; colt = (pn - 6) * 256; climit = 512; }
        else { base = rwkvz; ldc = 1824; colt = (pn - 8) * 256; climit = 1824; }
        const int row0 = u.pm * BM + wr * 64 + fr, col0 = colt + wc * 32 + 8 * fq;
#pragma unroll
        for (int ai = 0; ai < 2; ++ai)
#pragma unroll
            for (int m = 0; m < 4; ++m) { bf16_t* rowp = base + (size_t)(row0 + ai * HALF + m * 16) * ldc + col0;
#pragma unroll
                for (int bj = 0; bj < 2; ++bj) { if (col0 + bj * HALF < climit) { const f32x4 v0 = acc[ai][bj][m][0] * sc, v1 = acc[ai][bj][m][1] * sc;
                    u32x4 w; w.x = cvt_pk_bf16(v0[0], v0[1]); w.y = cvt_pk_bf16(v0[2], v0[3]); w.z = cvt_pk_bf16(v1[0], v1[1]); w.w = cvt_pk_bf16(v1[2], v1[3]);
                    *(u32x4*)(rowp + bj * HALF) = w; } } }
    }
};
typedef unsigned u32x2e __attribute__((ext_vector_type(2)));
struct EpiGate {
    static constexpr bool PERM = true, AFTER_DRAIN = false;
    unsigned char* O; int ldc;
    __device__ __forceinline__ void operator()(const f32x4 (&acc)[2][2][4][2], const Unit& u, int wr, int wc, int fr, int fq) const {
        const int row0 = u.pm * BM + wr * 64 + fr, col0 = u.pn * BM + wc * 32 + 8 * fq;
#pragma unroll
        for (int ai = 0; ai < 2; ++ai)
#pragma unroll
            for (int m = 0; m < 4; ++m) { unsigned char* rowp = O + (size_t)(row0 + ai * HALF + m * 16) * ldc + col0;
#pragma unroll
                for (int bj = 0; bj < 2; ++bj) { const f32x4 v0 = acc[ai][bj][m][0], v1 = acc[ai][bj][m][1]; unsigned q[8];
#pragma unroll
                    for (int e = 0; e < 4; ++e) { q[e] = (unsigned)(fast_sigmoid(v0[e]) * 255.0f + 0.5f); q[4 + e] = (unsigned)(fast_sigmoid(v1[e]) * 255.0f + 0.5f); }
                    *(u32x2e*)(rowp + bj * HALF) = (u32x2e){q[0] | (q[1] << 8) | (q[2] << 16) | (q[3] << 24), q[4] | (q[5] << 8) | (q[6] << 16) | (q[7] << 24)}; } }
    }
};
__device__ __forceinline__ float bflo(unsigned w) { return __uint_as_float(w << 16); }
__device__ __forceinline__ float bfhi(unsigned w) { return __uint_as_float(w & 0xffff0000u); }
template <bool FIRST> struct EpiMerge {
    static constexpr bool PERM = true, AFTER_DRAIN = false;
    bf16_t* O; int ldc; const unsigned char* gate; int ldg, goff;
    __device__ __forceinline__ void operator()(const f32x4 (&acc)[2][2][4][2], const Unit& u, int wr, int wc, int fr, int fq) const {
        const int row0 = u.pm * BM + wr * 64 + fr, col0 = u.pn * BM + wc * 32 + 8 * fq;
#pragma unroll
        for (int ai = 0; ai < 2; ++ai)
#pragma unroll
            for (int m = 0; m < 4; ++m) { const size_t r = (size_t)(row0 + ai * HALF + m * 16); bf16_t* rowp = O + r * ldc + col0; const unsigned char* gp = gate + r * ldg + goff + col0;
#pragma unroll
                for (int bj = 0; bj < 2; ++bj) { const f32x4 v0 = acc[ai][bj][m][0], v1 = acc[ai][bj][m][1];
                    const u32x2e g = *(const u32x2e*)(gp + bj * HALF); const float s = 1.0f / 255.0f;
                    float o[8] = {v0[0] * (float)(g.x & 255u) * s, v0[1] * (float)((g.x >> 8) & 255u) * s, v0[2] * (float)((g.x >> 16) & 255u) * s, v0[3] * (float)(g.x >> 24) * s,
                                  v1[0] * (float)(g.y & 255u) * s, v1[1] * (float)((g.y >> 8) & 255u) * s, v1[2] * (float)((g.y >> 16) & 255u) * s, v1[3] * (float)(g.y >> 24) * s};
                    if (!FIRST) { const u32x4 p = *(const u32x4*)(rowp + bj * HALF);
                        o[0] += bflo(p.x); o[1] += bfhi(p.x); o[2] += bflo(p.y); o[3] += bfhi(p.y); o[4] += bflo(p.z); o[5] += bfhi(p.z); o[6] += bflo(p.w); o[7] += bfhi(p.w); }
                    u32x4 w; w.x = cvt_pk_bf16(o[0], o[1]); w.y = cvt_pk_bf16(o[2], o[3]); w.z = cvt_pk_bf16(o[4], o[5]); w.w = cvt_pk_bf16(o[6], o[7]);
                    *(u32x4*)(rowp + bj * HALF) = w; } }
    }
};
struct EpiResF32 {
    static constexpr bool PERM = false, AFTER_DRAIN = false;
    const float* base; float* out; int ldc;
    __device__ __forceinline__ void operator()(const f32x4 (&acc)[2][2][4][2], const Unit& u, int wr, int wc, int fr, int fq) const {
        const int row0 = u.pm * BM + wr * 64 + fr, col0 = u.pn * BM + wc * 32 + 4 * fq;
#pragma unroll
        for (int ai = 0; ai < 2; ++ai)
#pragma unroll
            for (int m = 0; m < 4; ++m) { const size_t off = (size_t)(row0 + ai * HALF + m * 16) * ldc + col0;
#pragma unroll
                for (int bj = 0; bj < 2; ++bj)
#pragma unroll
                    for (int n = 0; n < 2; ++n) { const f32x4 bs = *(const f32x4*)(base + off + bj * HALF + n * 16); *(f32x4*)(out + off + bj * HALF + n * 16) = bs + acc[ai][bj][m][n]; } }
    }
};
struct EpiSwiGLU {
    static constexpr bool PERM = true, AFTER_DRAIN = false;
    bf16_t* O;
    __device__ __forceinline__ void operator()(const f32x4 (&acc)[2][2][4][2], const Unit& u, int wr, int wc, int fr, int fq) const {
        const int row0 = u.pm * BM + wr * 64 + fr, col0 = (u.pn & 3) * 128 + wc * 32 + 8 * fq;
#pragma unroll
        for (int ai = 0; ai < 2; ++ai)
#pragma unroll
            for (int m = 0; m < 4; ++m) { bf16_t* rowp = O + (size_t)(row0 + ai * HALF + m * 16) * 512 + col0;
                float o[8];
#pragma unroll
                for (int n = 0; n < 2; ++n)
#pragma unroll
                    for (int e = 0; e < 4; ++e) { const float a1 = acc[ai][0][m][n][e], a3 = acc[ai][1][m][n][e]; o[n * 4 + e] = a1 * fast_sigmoid(a1) * a3; }
                u32x4 w; w.x = cvt_pk_bf16(o[0], o[1]); w.y = cvt_pk_bf16(o[2], o[3]); w.z = cvt_pk_bf16(o[4], o[5]); w.w = cvt_pk_bf16(o[6], o[7]);
                *(u32x4*)rowp = w; }
    }
};
struct EpiY {
    static constexpr bool PERM = true, AFTER_DRAIN = false;
    bf16_t* O;
    __device__ __forceinline__ void operator()(const f32x4 (&acc)[2][2][4][2], const Unit& u, int wr, int wc, int fr, int fq) const {
        const int row0 = u.pm * BM + wr * 64 + fr, col0 = (u.pn & 3) * BM + wc * 32 + 8 * fq;
#pragma unroll
        for (int ai = 0; ai < 2; ++ai)
#pragma unroll
            for (int m = 0; m < 4; ++m) { bf16_t* rowp = O + (size_t)(row0 + ai * HALF + m * 16) * 1024 + col0;
#pragma unroll
                for (int bj = 0; bj < 2; ++bj) { const f32x4 v0 = acc[ai][bj][m][0], v1 = acc[ai][bj][m][1];
                    u32x4 w; w.x = cvt_pk_bf16(v0[0], v0[1]); w.y = cvt_pk_bf16(v0[2], v0[3]); w.z = cvt_pk_bf16(v1[0], v1[1]); w.w = cvt_pk_bf16(v1[2], v1[3]);
                    *(u32x4*)(rowp + bj * HALF) = w; } }
    }
};
struct MoeOrder {
    const PG8_LAS unsigned char* tile_e; int nunits, G, c;
    __device__ __forceinline__ bool next(int i, Unit& u) const {
        const int L = i * G + c; if (L >= nunits) return false;
        const int pm = L >> 2; u.pm = pm; u.pn = __builtin_amdgcn_readfirstlane((int)tile_e[pm]) * 4 + (L & 3); return true;
    }
    __device__ __forceinline__ void a_ready(const Unit&) const {}
    __device__ __forceinline__ void done(const Unit&) const {}
};
template <class Epi, class Sched, bool ALIGN_EPI = false, bool SP2 = false>
__device__ __forceinline__ void gemm_phase(PG8_LAS unsigned char* lds, const Gemm g, const Sched& S, const Epi& E) {
    int tid = threadIdx.x; asm volatile("" : "+v"(tid));
    const int wid = __builtin_amdgcn_readfirstlane(tid >> 6), lane = tid & 63, wr = wid >> 2, wc = wid & 3, fr = lane & 15, fq = lane >> 4;
    const int K = g.K, nt = K / BK;
    unsigned voffA[2], voffB[2];
#pragma unroll
    for (int i = 0; i < 2; ++i) { int R, C; stage_rc(tid * 16 + i * 8192, R, C); const int Rb = Epi::PERM ? ((R & ~31) + perm32(R & 31)) : R;
        voffA[i] = (unsigned)(R * K + C) * 2u; voffB[i] = (unsigned)(Rb * K + C) * 2u; }
    const size_t kstep = (size_t)(BK * 2);
    const size_t hstep = (size_t)HALF * K * 2;
    const size_t tstep = 2 * hstep;
    const unsigned ldsw = (unsigned)wid * 1024u;
    const int aoff = lds_byte(wr * 64 + fr, fq * 8), boff = lds_byte(wc * 32 + fr, fq * 8);
#define PG8_SA(b, h) (((b) * 2 + (h)) * HTB)
#define PG8_SB(b, h) ((4 + (b) * 2 + (h)) * HTB)
#define PG8_STAGE(bufoff, gbase, voff) do { _Pragma("unroll") for (int _i = 0; _i < 2; ++_i) \
        __builtin_amdgcn_global_load_lds((const unsigned*)((const char*)(gbase) + (voff)[_i]), (PG8_LAS unsigned*)(lds + (bufoff) + ldsw + _i * 8192), 16, 0, 0); } while (0)
#define PG8_LDA(dst, b, h) do { _Pragma("unroll") for (int m = 0; m < 4; ++m) _Pragma("unroll") for (int k = 0; k < 2; ++k) dst[m][k] = *(const PG8_LAS bf16x8*)(lds + PG8_SA(b, h) + aoff + m * 2048 + k * 1024); } while (0)
#define PG8_LDB(dst, b, h) do { _Pragma("unroll") for (int n = 0; n < 2; ++n) _Pragma("unroll") for (int k = 0; k < 2; ++k) dst[n][k] = *(const PG8_LAS bf16x8*)(lds + PG8_SB(b, h) + boff + n * 2048 + k * 1024); } while (0)
#define PG8_MMA(ai, bj, At, Bt) do { __builtin_amdgcn_s_setprio(1); _Pragma("unroll") for (int m = 0; m < 4; ++m) _Pragma("unroll") for (int n = 0; n < 2; ++n) _Pragma("unroll") for (int k = 0; k < 2; ++k) \
        acc[ai][bj][m][n] = __builtin_amdgcn_mfma_f32_16x16x32_bf16(Bt[n][k], At[m][k], acc[ai][bj][m][n], 0, 0, 0); __builtin_amdgcn_s_setprio(0); } while (0)
#define PG8_WAIT_V(n) asm volatile("s_waitcnt vmcnt(" #n ")" ::: "memory")
#define PG8_WAIT_L(n) asm volatile("s_waitcnt lgkmcnt(" #n ")" ::: "memory")
#define PG8_BAR __builtin_amdgcn_s_barrier()
#define PG8_SCHED __builtin_amdgcn_sched_barrier(0)
    Unit cur, nxt; int ui = 0;
    if (!S.next(0, cur)) return;
    f32x4 acc[2][2][4][2];
#pragma unroll
    for (int a = 0; a < 2; ++a)
#pragma unroll
        for (int b = 0; b < 2; ++b)
#pragma unroll
            for (int m = 0; m < 4; ++m)
#pragma unroll
                for (int n = 0; n < 2; ++n) acc[a][b][m][n] = (f32x4){0.f, 0.f, 0.f, 0.f};
    bf16x8 At[4][2], B0[2][2], B1[2][2];
    const char* cA = (const char*)g.A + (size_t)cur.pm * tstep; const char* cB = (const char*)g.Bt + (size_t)cur.pn * tstep;
    S.a_ready(cur);
    if constexpr (SP2) {
        PG8_STAGE(PG8_SB(0, 0), cB, voffB); PG8_STAGE(PG8_SB(0, 1), cB + hstep, voffB); PG8_STAGE(PG8_SA(0, 0), cA, voffA); PG8_STAGE(PG8_SA(0, 1), cA + hstep, voffA);
        if (wr == 1) PG8_BAR;
        PG8_WAIT_V(2); PG8_BAR;
        PG8_STAGE(PG8_SB(1, 0), cB + kstep, voffB); PG8_STAGE(PG8_SA(1, 0), cA + kstep, voffA); PG8_STAGE(PG8_SB(1, 1), cB + hstep + kstep, voffB);
        PG8_WAIT_V(6); PG8_BAR;
    } else {
        PG8_STAGE(PG8_SB(0, 0), cB, voffB); PG8_STAGE(PG8_SA(0, 0), cA, voffA); PG8_STAGE(PG8_SB(0, 1), cB + hstep, voffB); PG8_STAGE(PG8_SA(0, 1), cA + hstep, voffA);
        if (wr == 1) PG8_BAR;
        PG8_WAIT_V(4); PG8_BAR;
        PG8_STAGE(PG8_SB(1, 0), cB + kstep, voffB); PG8_STAGE(PG8_SA(1, 0), cA + kstep, voffA); PG8_STAGE(PG8_SB(1, 1), cB + hstep + kstep, voffB);
        PG8_WAIT_V(6); PG8_BAR;
    }
    for (;;) {
        const bool has_next = S.next(ui + 1, nxt);
        const char* nA = has_next ? (const char*)g.A + (size_t)nxt.pm * tstep : cA; const char* nB = has_next ? (const char*)g.Bt + (size_t)nxt.pn * tstep : cB;
        for (int t = 0; t < nt; t += 2) {
            const bool last = (t == nt - 2);
            const char* a1 = cA + (size_t)(t + 1) * kstep;
            const char* a2 = last ? nA : cA + (size_t)(t + 2) * kstep; const char* b2 = last ? nB : cB + (size_t)(t + 2) * kstep;
            const char* a3 = a2 + kstep; const char* b3 = b2 + kstep;
            if (last && has_next) S.a_ready(nxt);
            if constexpr (SP2) {
            PG8_LDB(B0, 0, 0); PG8_LDB(B1, 0, 1); PG8_SCHED; PG8_LDA(At, 0, 0); PG8_STAGE(PG8_SA(1, 1), a1 + hstep, voffA);
            PG8_WAIT_V(8); PG8_WAIT_L(0); PG8_BAR; PG8_MMA(0, 0, At, B0); PG8_MMA(0, 1, At, B1); PG8_BAR; PG8_SCHED;
            PG8_LDA(At, 0, 1); PG8_STAGE(PG8_SB(0, 0), b2, voffB); PG8_STAGE(PG8_SB(0, 1), b2 + hstep, voffB); PG8_STAGE(PG8_SA(0, 0), a2, voffA);
            PG8_WAIT_V(8); PG8_WAIT_L(0); PG8_BAR; PG8_MMA(1, 0, At, B0); PG8_MMA(1, 1, At, B1); PG8_BAR; PG8_SCHED;
            PG8_LDB(B0, 1, 0); PG8_LDB(B1, 1, 1); PG8_SCHED; PG8_LDA(At, 1, 0); PG8_STAGE(PG8_SA(0, 1), a2 + hstep, voffA);
            PG8_WAIT_V(8); PG8_WAIT_L(0); PG8_BAR; PG8_MMA(0, 0, At, B0); PG8_MMA(0, 1, At, B1); PG8_BAR; PG8_SCHED;
            PG8_LDA(At, 1, 1); PG8_STAGE(PG8_SB(1, 0), b3, voffB); PG8_STAGE(PG8_SB(1, 1), b3 + hstep, voffB); PG8_STAGE(PG8_SA(1, 0), a3, voffA);
            PG8_WAIT_V(8); PG8_WAIT_L(0); PG8_BAR; PG8_MMA(1, 0, At, B0); PG8_MMA(1, 1, At, B1); PG8_BAR; PG8_SCHED;
            } else {
            PG8_LDB(B0, 0, 0); PG8_SCHED; PG8_LDA(At, 0, 0); PG8_STAGE(PG8_SA(1, 1), a1 + hstep, voffA);
            PG8_WAIT_L(8); PG8_BAR; PG8_WAIT_L(0); PG8_MMA(0, 0, At, B0); PG8_BAR; PG8_SCHED;
            PG8_LDB(B1, 0, 1); PG8_STAGE(PG8_SB(0, 0), b2, voffB);
            PG8_BAR; PG8_WAIT_L(0); PG8_MMA(0, 1, At, B1); PG8_BAR;
            PG8_LDA(At, 0, 1); PG8_STAGE(PG8_SA(0, 0), a2, voffA);
            PG8_BAR; PG8_WAIT_L(0); PG8_MMA(1, 0, At, B0); PG8_BAR; PG8_SCHED;
            PG8_STAGE(PG8_SB(0, 1), b2 + hstep, voffB);
            PG8_WAIT_V(6); PG8_BAR; PG8_MMA(1, 1, At, B1); PG8_BAR;
            PG8_LDB(B0, 1, 0); PG8_SCHED; PG8_LDA(At, 1, 0); PG8_STAGE(PG8_SA(0, 1), a2 + hstep, voffA);
            PG8_WAIT_L(8); PG8_BAR; PG8_WAIT_L(0); PG8_MMA(0, 0, At, B0); PG8_BAR; PG8_SCHED;
            PG8_LDB(B1, 1, 1); PG8_STAGE(PG8_SB(1, 0), b3, voffB);
            PG8_BAR; PG8_WAIT_L(0); PG8_MMA(0, 1, At, B1); PG8_BAR;
            PG8_LDA(At, 1, 1); PG8_STAGE(PG8_SA(1, 0), a3, voffA);
            PG8_BAR; PG8_WAIT_L(0); PG8_MMA(1, 0, At, B0); PG8_BAR; PG8_SCHED;
            PG8_STAGE(PG8_SB(1, 1), b3 + hstep, voffB);
            PG8_WAIT_V(6); PG8_BAR; PG8_MMA(1, 1, At, B1); PG8_BAR;
            }
        }
        if constexpr (ALIGN_EPI) { if (wr == 0) PG8_BAR; }
        if constexpr (!Epi::AFTER_DRAIN) { E(acc, cur, wr, wc, fr, fq); S.done(cur); }
        if (!has_next) break;
#pragma unroll
        for (int a = 0; a < 2; ++a)
#pragma unroll
            for (int b = 0; b < 2; ++b)
#pragma unroll
                for (int m = 0; m < 4; ++m)
#pragma unroll
                    for (int n = 0; n < 2; ++n) acc[a][b][m][n] = (f32x4){0.f, 0.f, 0.f, 0.f};
        cur = nxt; cA = nA; cB = nB; ++ui;
        if constexpr (ALIGN_EPI) { if (wr == 1) PG8_BAR; }
    }
    PG8_WAIT_V(0);
    if constexpr (!ALIGN_EPI) { if (wr == 0) PG8_BAR; }
    PG8_BAR;
    if constexpr (Epi::AFTER_DRAIN) { E.fused(acc, cur, wr, wc, fr, fq, lds, wid, lane); S.done(cur); }
#undef PG8_SA
#undef PG8_SB
#undef PG8_STAGE
#undef PG8_LDA
#undef PG8_LDB
#undef PG8_MMA
#undef PG8_WAIT_V
#undef PG8_WAIT_L
#undef PG8_BAR
#undef PG8_SCHED
}
}
namespace cg = cooperative_groups;
#define DI __device__ __forceinline__
#define LAS __attribute__((address_space(3)))
typedef unsigned short bf16;
typedef float f32x4 __attribute__((ext_vector_type(4)));
typedef unsigned u32x4 __attribute__((ext_vector_type(4)));
typedef unsigned u32x2 __attribute__((ext_vector_type(2)));
typedef short bf16x8_t __attribute__((ext_vector_type(8)));

constexpr int BATCH = 2, SEQ = 16384, DM = 1024, T = BATCH * SEQ, DEPTH = 2;
constexpr int NEXP = 32, RZP = 1824;
constexpr int RMAX = 73728;
constexpr float C2 = 0.125f * 1.4426950408889634f;
constexpr float LOG2E = 1.4426950408889634f;
constexpr size_t MiB = 1u << 20;
constexpr size_t WS_CTL = 0, CTL_BYTES = 1 * MiB;
constexpr size_t WS_WIN = 1 * MiB, WS_WG = 9 * MiB, WS_WBR = 15 * MiB, WS_WOUT = 18 * MiB;
constexpr size_t WS_KMEAN = 20 * MiB, WS_RWG = 20 * MiB + 512 * 1024, WS_ROUTE = 21 * MiB, WS_RWT = 22 * MiB, WS_DEST = 22 * MiB + 512 * 1024, WS_BONUS = 23 * MiB, WS_WLT = 24 * MiB, WS_WPT = 24 * MiB + 512 * 1024, WS_WGBASE = 24 * MiB + 768 * 1024, WS_KINV = 25 * MiB, WS_PGT = 26 * MiB, WS_LG = 28 * MiB, WS_SG = 30 * MiB;
constexpr size_t WS_XB = 32 * MiB, WS_VFIRST = 96 * MiB, WS_YPOOL = 128 * MiB, WS_YATTN = 160 * MiB;
constexpr size_t WS_BIG = 192 * MiB;
constexpr size_t WS_Q = WS_BIG, WS_K = WS_BIG + 32 * MiB, WS_V = WS_BIG + 64 * MiB, WS_POOLZ = WS_BIG + 232 * MiB, WS_RWKVZ = WS_BIG + 264 * MiB;
constexpr size_t WS_AR = WS_BIG;
constexpr size_t WS_GATES = WS_BIG + 32 * MiB;
constexpr size_t WS_XPERM = WS_BIG, WS_HACT = WS_BIG + 144 * MiB, WS_W13 = WS_BIG + 216 * MiB, WS_W2 = WS_BIG + 280 * MiB, WS_YMOE = WS_BIG;
constexpr size_t WS_VT = WS_YATTN;
constexpr size_t WS_PARTO = WS_BIG + 96 * MiB, WS_PARTML = WS_BIG + 224 * MiB;
constexpr size_t WS_LIST = WS_BIG + 378 * MiB;
constexpr size_t WS_PCT = WS_BIG + 32 * MiB, WS_LC = WS_BIG + 64 * MiB, WS_RM = WS_BIG + 128 * MiB, WS_Y0 = WS_BIG + 160 * MiB, WS_S0 = WS_BIG + 352 * MiB;
constexpr int LSTRIDE = 516096;
constexpr size_t WS_END = WS_BIG + 394 * MiB;
static_assert(WS_LIST + (size_t)16 * LSTRIDE * 2 <= WS_END, "ws map");
static_assert(WS_RWKVZ + (size_t)T * RZP * 2 <= WS_END, "ws map");
static_assert(WS_W2 + (size_t)32 * 1024 * 512 * 2 <= WS_END, "ws map");
constexpr int CW_CNT = 64, CW_LCNT = 1024, CW_BAR = 4096;
constexpr int LDS_BYTES = 147456, MISC_OFF = 131072;

DI float bf2f(unsigned short u) { return __uint_as_float((unsigned)u << 16); }
DI unsigned f2bf(float f) { return pg8::cvt_pk_bf16(f, 0.f) & 0xffffu; }
DI unsigned pk2(float lo, float hi) { return pg8::cvt_pk_bf16(lo, hi); }
DI float blo(unsigned w) { return __uint_as_float(w << 16); }
DI float bhi(unsigned w) { return __uint_as_float(w & 0xffff0000u); }
DI float wave_sum(float v) {
#pragma unroll
    for (int o = 1; o < 64; o <<= 1) v += __shfl_xor(v, o);
    return v;
}
DI float wave_max(float v) {
#pragma unroll
    for (int o = 1; o < 64; o <<= 1) v = fmaxf(v, __shfl_xor(v, o));
    return v;
}
DI float fexp_(float x) { return __builtin_amdgcn_exp2f(x * 1.4426950408889634f); }
DI float frcp_(float x) { return __builtin_amdgcn_rcpf(x); }
DI float sigmoidf_(float x) { return frcp_(1.0f + fexp_(-x)); }
DI float ftanh_(float x) { return 1.0f - 2.0f * frcp_(1.0f + fexp_(2.0f * x)); }
DI float fsoftplus_(float x) { return x > 20.f ? x : __builtin_amdgcn_logf(1.0f + fexp_(x)) * 0.6931471805599453f; }
#define LDS_WAIT() asm volatile("s_waitcnt lgkmcnt(0)" ::: "memory")

#define XB_TMO      128
#define XB_XCNT(j)  (256  + 64 * (j))
#define XB_XSUB(j)  (1280 + 64 * (j))
#define XB_XGEN(j)  (2304 + 64 * (j))
#define XB_TOP      3328
#define XB_TOPGEN   3392
#define XCD_BAR_WORDS 3456
#define XB_SPIN_CAP (1u << 27)

__device__ __forceinline__ unsigned xb_ld(unsigned* p)              { return __hip_atomic_load(p, __ATOMIC_RELAXED, __HIP_MEMORY_SCOPE_AGENT); }
__device__ __forceinline__ unsigned xb_add(unsigned* p, unsigned v) { return __hip_atomic_fetch_add(p, v, __ATOMIC_RELAXED, __HIP_MEMORY_SCOPE_AGENT); }
__device__ __forceinline__ unsigned xb_xcc_id() { return (unsigned)__builtin_amdgcn_s_getreg((3 << 11) | 20) & 0xFu; }
#define XB_SPIN(cond, bar) do { unsigned _sp = 0; while (cond) { __builtin_amdgcn_s_sleep(1); \
    if ((++_sp & 255u) == 0u) { if (xb_ld(&(bar)[XB_TMO])) break; if (_sp > XB_SPIN_CAP) { atomicAdd(&(bar)[XB_TMO], 1u); break; } } } } while (0)

struct XcdBarrier {
    unsigned* bar; unsigned x;
    volatile LAS unsigned* st;
};

__device__ __forceinline__ XcdBarrier xcd_barrier_post(unsigned* bar, volatile LAS unsigned* st) {
    XcdBarrier b; b.bar = bar; b.x = xb_xcc_id(); b.st = st;
    if (threadIdx.x == 0) (void)xb_add(&bar[XB_XCNT(b.x)], 1u);
    return b;
}
__device__ __forceinline__ void xcd_barrier_complete(unsigned* bar, unsigned x, unsigned& nloc, unsigned& nx) {
    const unsigned G = gridDim.x * gridDim.y * gridDim.z;
    unsigned sum, cnt, mine, sp = 0u;
    for (;;) {
        sum = 0u; cnt = 0u; mine = 0u;
#pragma unroll
        for (unsigned j = 0; j < 16; ++j) { const unsigned c = xb_ld(&bar[XB_XCNT(j)]); sum += c; cnt += (c > 0u) ? 1u : 0u; mine = (j == x) ? c : mine; }
        if (sum == G) break;
        __builtin_amdgcn_s_sleep(1);
        if ((++sp & 255u) == 0u) { if (xb_ld(&bar[XB_TMO])) break; if (sp > XB_SPIN_CAP) { atomicAdd(&bar[XB_TMO], 1u); break; } }
    }
    nloc = mine > 0u ? mine : 1u; nx = cnt > 0u ? cnt : 1u;
}

__device__ __forceinline__ void xcd_barrier(const XcdBarrier& b) {
    asm volatile("s_waitcnt vmcnt(0)" ::: "memory");
    __syncthreads();
    if (threadIdx.x == 0) {
        unsigned* bar = b.bar;
        __builtin_amdgcn_s_waitcnt(0);
        unsigned nloc = b.st[0], nx = b.st[1];
        if (nloc == 0u) { xcd_barrier_complete(bar, b.x, nloc, nx); b.st[0] = nloc; b.st[1] = nx; }
        const unsigned old = xb_add(&bar[XB_XSUB(b.x)], 1u);
        const unsigned gen = old / nloc;
        if (old + 1u == (gen + 1u) * nloc) {
            __builtin_amdgcn_fence(__ATOMIC_RELEASE, "agent");
            asm volatile("s_waitcnt vmcnt(0)" ::: "memory");
            const unsigned og = xb_add(&bar[XB_TOP], 1u);
            const unsigned tg = og / nx;
            if (og + 1u == (tg + 1u) * nx) xb_add(&bar[XB_TOPGEN], 1u);
            else XB_SPIN(xb_ld(&bar[XB_TOPGEN]) == tg, bar);
            __builtin_amdgcn_fence(__ATOMIC_ACQUIRE, "agent");
            xb_add(&bar[XB_XGEN(b.x)], 1u);
            asm volatile("s_waitcnt vmcnt(0)" ::: "memory");
        } else {
            XB_SPIN(xb_ld(&bar[XB_XGEN(b.x)]) == gen, bar);
            __builtin_amdgcn_fence(__ATOMIC_ACQUIRE, "agent");
            asm volatile("s_waitcnt vmcnt(0)" ::: "memory");
        }
    }
    __syncthreads();
}

struct Args { const float* in[31]; float* out; unsigned char* ws; };

typedef const __attribute__((address_space(4))) unsigned long long* kargp_t;
struct Frame {
    LAS unsigned char* lds; int tid, lane, wave, G, bid;
    kargp_t kp;
};
#define GASQ __attribute__((address_space(1)))
DI const float* INP(const Frame& F, int i) { return (const float*)(const GASQ float*)F.kp[i]; }
DI float* OUTP(const Frame& F) { return (float*)(GASQ float*)F.kp[31]; }
DI unsigned char* WSP(const Frame& F) { return (unsigned char*)(GASQ unsigned char*)F.kp[32]; }
DI void fence_frame(Frame& F) {
    asm volatile("" : "+s"(F.kp) :: "memory"); asm volatile("" : "+s"(F.G)); asm volatile("" : "+s"(F.bid));
    F.tid = threadIdx.x; asm volatile("" : "+v"(F.tid)); F.lane = F.tid & 63; F.wave = __builtin_amdgcn_readfirstlane(F.tid >> 6); }

DI void transpose_item(const float* W, int ldw, int ncols, bf16* WT, int ldt, const float* scale, LAS float* scr, int item, int lane) {
    const int nblk = ncols / 32, kb = item / nblk, nb = item % nblk, k0 = 64 * kb, n0 = 32 * nb;
    { const int rs = lane >> 3, c4 = (lane & 7) * 4; f32x4 v[8]; float sc[8];
#pragma unroll
      for (int i = 0; i < 8; ++i) { v[i] = *(const f32x4*)(W + (size_t)(k0 + 8 * i + rs) * ldw + n0 + c4); sc[i] = scale ? scale[k0 + 8 * i + rs] : 1.0f; }
#pragma unroll
      for (int i = 0; i < 8; ++i) { LAS float* d = scr + (8 * i + rs) * 33 + c4; d[0] = v[i].x * sc[i]; d[1] = v[i].y * sc[i]; d[2] = v[i].z * sc[i]; d[3] = v[i].w * sc[i]; } }
    LDS_WAIT(); asm volatile("" ::: "memory");
    const int c = lane & 7;
#pragma unroll
    for (int j = 0; j < 4; ++j) { const int n = (lane >> 3) + 8 * j; const LAS float* s = scr + (8 * c) * 33 + n;
        u32x4 o; o.x = pk2(s[0 * 33], s[1 * 33]); o.y = pk2(s[2 * 33], s[3 * 33]); o.z = pk2(s[4 * 33], s[5 * 33]); o.w = pk2(s[6 * 33], s[7 * 33]);
        *(u32x4*)(WT + (size_t)(n0 + n) * ldt + k0 + 8 * c) = o; }
    LDS_WAIT(); asm volatile("" ::: "memory");
}
DI void prep_mixer_weights(Frame& F, int l) {
    LAS float* scr = (LAS float*)(F.lds + F.wave * 16384);
    const int gw = F.bid * 8 + F.wave, NGW = F.G * 8;
    const float* w_in = INP(F, 2) + (size_t)l * 1024 * 6912; const float* g1 = INP(F, 1) + l * 1024;
    bf16* WIN = (bf16*)(WSP(F) + WS_WIN); bf16* WG = (bf16*)(WSP(F) + WS_WG); bf16* WBR = (bf16*)(WSP(F) + WS_WBR); bf16* WOUT = (bf16*)(WSP(F) + WS_WOUT);
    constexpr int I1 = 16 * (1536 / 32), I2 = 16 * (2304 / 32), I3 = 16 * 1, I4 = 16 * (3072 / 32), I5 = 8 * (1024 / 32), I6 = 16 * (1024 / 32);
    const int n3 = l > 0 ? I3 : 0;
    const int total = I1 + I2 + n3 + I4 + 3 * I5 + I6;
    for (int it = gw; it < total; it += NGW) {
        int r = it;
        if (r < I1) { transpose_item(w_in, 6912, 1536, WIN, 1024, g1, scr, r, F.lane); continue; } r -= I1;
        if (r < I2) { transpose_item(w_in + 4608, 6912, 2304, WIN + (size_t)1536 * 1024, 1024, g1, scr, r, F.lane); continue; } r -= I2;
        if (r < n3) { transpose_item(INP(F, 3) + (size_t)(l - 1) * 1024 * 32, 32, 32, WIN + (size_t)3840 * 1024, 1024, g1, scr, r, F.lane); continue; } r -= n3;
        if (r < I4) { transpose_item(w_in + 1536, 6912, 3072, WG, 1024, g1, scr, r, F.lane); continue; } r -= I4;
        if (r < 3 * I5) { const int i = r / I5; transpose_item(INP(F, 20) + (size_t)(l * 3 + i) * 512 * 1024, 1024, 1024, WBR + (size_t)i * 1024 * 512, 512, i == 2 ? INP(F, 19) + l * 512 : nullptr, scr, r % I5, F.lane); continue; } r -= 3 * I5;
        transpose_item(INP(F, 21) + (size_t)l * 1024 * 1024, 1024, 1024, WOUT, 1024, nullptr, scr, r, F.lane);
    }
    if (l > 0) {
        u32x4* z = (u32x4*)(WIN + (size_t)3872 * 1024); const int n16 = 224 * 1024 * 2 / 16;
        for (int i = F.bid * 512 + F.tid; i < n16; i += F.G * 512) z[i] = (u32x4){0u, 0u, 0u, 0u};
    }
    { bf16* WPT = (bf16*)(WSP(F) + WS_WPT);
      for (int it = gw; it < 32; it += NGW) transpose_item(INP(F, 18) + (size_t)(l * 4 + (it >> 3)) * 128 * 128, 128, 128, WPT + (size_t)(it >> 3) * 128 * 128, 128, nullptr, scr, it & 7, F.lane); }
    { bf16* WLT = (bf16*)(WSP(F) + WS_WLT);
      constexpr int L1 = 1 * 16, L2 = 1 * 16, L3 = 2 * 16;
      for (int it = gw; it < L1 + L2 + L3; it += NGW) {
          if (it < L1) transpose_item(INP(F, 7) + (size_t)l * 64 * 512, 512, 512, WLT, 288, nullptr, scr, it, F.lane);
          else if (it < L1 + L2) transpose_item(INP(F, 9) + (size_t)l * 64 * 512, 512, 512, WLT + 64, 288, nullptr, scr, it - L1, F.lane);
          else transpose_item(INP(F, 10) + (size_t)l * 128 * 512, 512, 512, WLT + 128, 288, nullptr, scr, it - L1 - L2, F.lane); }
      const float* wv = INP(F, 17) + (size_t)(l > 0 ? l - 1 : 0) * 32 * 512;
      for (int i = F.bid * 512 + F.tid; i < 32 * 512; i += F.G * 512) { const int k = i >> 9, ch = i & 511; WLT[(size_t)ch * 288 + 256 + k] = (bf16)f2bf(l > 0 ? wv[k * 512 + ch] : 0.f); } }
    { bf16* RWH = (bf16*)(WSP(F) + WS_RWG); bf16* RWL = RWH + 48 * 1024; const float* g2 = INP(F, 22) + l * 1024; const float* rgw = INP(F, 23) + (size_t)l * 1024 * 4; const float* rew = INP(F, 25) + (size_t)l * 1024 * 32;
      for (int i = F.bid * 512 + F.tid; i < 48 * 1024; i += F.G * 512) { const int r = i >> 10, k = i & 1023;
          const float w = r < 16 ? rgw[k * 4 + (r & 3)] : r < 32 ? rew[k * 32 + 8 * ((r - 16) >> 2) + ((r - 16) & 3)] : rew[k * 32 + 8 * ((r - 32) >> 2) + 4 + ((r - 32) & 3)];
          const float v = g2[k] * w; const unsigned hb = f2bf(v); const float hf = __uint_as_float(hb << 16); RWH[i] = (bf16)hb; RWL[i] = (bf16)f2bf(v - hf); } }
}
DI void prep_expert_weights(Frame& F, int l) {
    LAS float* scr = (LAS float*)(F.lds + F.wave * 16384);
    const int gw = F.bid * 8 + F.wave, NGW = F.G * 8;
    const float* g2 = INP(F, 22) + l * 1024;
    bf16* W13 = (bf16*)(WSP(F) + WS_W13); bf16* W2 = (bf16*)(WSP(F) + WS_W2);
    constexpr int J13 = 64, N13 = NEXP * 2 * 4 * J13, J2 = 8 * 32, N2 = NEXP * J2;
    for (int it = gw; it < N13 + N2; it += NGW) {
        if (it < N13) { const int job = it / J13, item = it % J13, e = job >> 3, which = (job >> 2) & 1, grp = job & 3;
            const float* src = (which ? INP(F, 28) : INP(F, 27)) + ((size_t)(l * NEXP + e) * 1024) * 512 + grp * 128;
            transpose_item(src, 512, 128, W13 + ((size_t)e * 1024 + grp * 256 + which * 128) * 1024, 1024, g2, scr, item, F.lane);
        } else { const int r = it - N13, e = r / J2, item = r % J2;
            transpose_item(INP(F, 29) + (size_t)(l * NEXP + e) * 512 * 1024, 1024, 1024, W2 + (size_t)e * 1024 * 512, 512, nullptr, scr, item, F.lane); }
    }
}
DI void rms_rows_to_bf16(Frame& F, const float* x, bf16* xb) {
    const int gw = F.bid * 8 + F.wave, NGW = F.G * 8;
    for (int t = gw; t < T; t += NGW) {
        const f32x4* xr = (const f32x4*)(x + (size_t)t * DM) + F.lane; f32x4 v[4]; float s = 0.f;
#pragma unroll
        for (int j = 0; j < 4; ++j) { v[j] = xr[64 * j]; s += (v[j].x * v[j].x + v[j].y * v[j].y) + (v[j].z * v[j].z + v[j].w * v[j].w); }
        const float rs = rsqrtf(wave_sum(s) * (1.f / DM) + 1e-6f);
        u32x2* o = (u32x2*)(xb + (size_t)t * DM) + F.lane;
#pragma unroll
        for (int j = 0; j < 4; ++j) o[64 * j] = (u32x2){pk2(v[j].x * rs, v[j].y * rs), pk2(v[j].z * rs, v[j].w * rs)};
    }
}

DI void kmean_phase(Frame& F) {
    const bf16* K = (const bf16*)(WSP(F) + WS_K); float* kmean = (float*)(WSP(F) + WS_KMEAN);
    LAS float* red = (LAS float*)F.lds;
    for (int it = F.bid; it < BATCH * 8 * 64; it += F.G) {
        const int b = it >> 9, h = (it >> 6) & 7, n = it & 63, c8 = F.tid & 7, rg = F.tid >> 3;
        const bf16* kp = K + ((size_t)b * SEQ + n * 256 + rg * 4) * 512 + h * 64 + c8 * 8; float s[8] = {0.f, 0.f, 0.f, 0.f, 0.f, 0.f, 0.f, 0.f};
        u32x4 w[4];
#pragma unroll
        for (int i = 0; i < 4; ++i) w[i] = *(const u32x4*)(kp + (size_t)i * 512);
#pragma unroll
        for (int i = 0; i < 4; ++i) { s[0] += blo(w[i].x); s[1] += bhi(w[i].x); s[2] += blo(w[i].y); s[3] += bhi(w[i].y); s[4] += blo(w[i].z); s[5] += bhi(w[i].z); s[6] += blo(w[i].w); s[7] += bhi(w[i].w); }
        *(LAS f32x4*)(red + rg * 68 + c8 * 8) = (f32x4){s[0], s[1], s[2], s[3]}; *(LAS f32x4*)(red + rg * 68 + c8 * 8 + 4) = (f32x4){s[4], s[5], s[6], s[7]};
        __syncthreads();
        if (F.tid < 64) { float a = 0.f;
#pragma unroll 16
            for (int p = 0; p < 64; ++p) a += red[p * 68 + F.tid];
            kmean[(size_t)it * 64 + F.tid] = a * (1.f / 256.f); }
        __syncthreads();
    }
}
DI void vt_phase(Frame& F) {
    const bf16* V = (const bf16*)(WSP(F) + WS_V); bf16* VT = (bf16*)(WSP(F) + WS_VT);
    LAS bf16* tl = (LAS bf16*)(F.lds + 20480 + F.wave * 9216);
    const int gw = F.bid * 8 + F.wave, NGW = F.G * 8, lane = F.lane;
    for (int it = gw; it < BATCH * 8 * (SEQ / 64); it += NGW) {
        const int bh = it / (SEQ / 64), tt = it % (SEQ / 64), b = bh >> 3, h = bh & 7, t0 = tt * 64;
#pragma unroll
        for (int i = 0; i < 8; ++i) { const int r = i * 8 + (lane >> 3), c = lane & 7;
            const u32x4 w = *(const u32x4*)(V + ((size_t)b * SEQ + t0 + r) * 512 + h * 64 + c * 8); *(LAS u32x4*)(tl + r * 72 + c * 8) = w; }
        LDS_WAIT(); asm volatile("" ::: "memory");
#pragma unroll
        for (int i = 0; i < 8; ++i) { const int d = i * 8 + (lane >> 3), c = lane & 7; unsigned short e[8];
#pragma unroll
            for (int k = 0; k < 8; ++k) e[k] = tl[(8 * c + k) * 72 + d];
            u32x4 w; w.x = e[0] | ((unsigned)e[1] << 16); w.y = e[2] | ((unsigned)e[3] << 16); w.z = e[4] | ((unsigned)e[5] << 16); w.w = e[6] | ((unsigned)e[7] << 16);
            *(u32x4*)(VT + ((size_t)bh * 64 + d) * SEQ + t0 + c * 8) = w; }
        LDS_WAIT(); asm volatile("" ::: "memory");
    }
}
DI int list_off(int n) { return n * SEQ - 128 * n * (n + 1); }
DI void sel_phase(Frame& F, int l) {
    const bf16* Q = (const bf16*)(WSP(F) + WS_Q); const float* kmean = (const float*)(WSP(F) + WS_KMEAN);
    unsigned short* list = (unsigned short*)(WSP(F) + WS_LIST); unsigned* lcnt = (unsigned*)(WSP(F) + WS_CTL) + CW_LCNT + 1024 * l;
    LAS float* km = (LAS float*)F.lds;
    for (int it = F.bid; it < BATCH * 8 * (SEQ / 512); it += F.G) {
        const int pr = it % 256, bh = pr >> 4, g = (it < 256) ? (pr & 15) : 31 - (pr & 15), b = bh >> 3, h = bh & 7;
        __syncthreads();
        for (int i = F.tid; i < 1024; i += 512) ((LAS f32x4*)km)[i] = ((const f32x4*)(kmean + (size_t)bh * 4096))[i];
        __syncthreads();
        const int tl = g * 512 + F.tid, own = __builtin_amdgcn_readfirstlane(tl >> 8);
        float q[64];
        { const u32x4* qp = (const u32x4*)(Q + ((size_t)b * SEQ + tl) * 512 + h * 64);
#pragma unroll
          for (int c = 0; c < 8; ++c) { const u32x4 w = qp[c]; q[8 * c] = blo(w.x); q[8 * c + 1] = bhi(w.x); q[8 * c + 2] = blo(w.y); q[8 * c + 3] = bhi(w.y); q[8 * c + 4] = blo(w.z); q[8 * c + 5] = bhi(w.z); q[8 * c + 6] = blo(w.w); q[8 * c + 7] = bhi(w.w); } }
        float v0 = -INFINITY, v1 = -INFINITY, v2 = -INFINITY; int i0 = -1, i1 = -1, i2 = -1;
        for (int n = 0; n < own; ++n) { const LAS f32x4* kp = (const LAS f32x4*)(km + n * 64); float s0 = 0.f, s1 = 0.f;
#pragma unroll
            for (int i = 0; i < 16; i += 2) { const f32x4 a = kp[i], c = kp[i + 1];
                s0 += q[4 * i] * a.x + q[4 * i + 1] * a.y + q[4 * i + 2] * a.z + q[4 * i + 3] * a.w; s1 += q[4 * i + 4] * c.x + q[4 * i + 5] * c.y + q[4 * i + 6] * c.z + q[4 * i + 7] * c.w; }
            const float gte = s0 + s1; const bool c0 = gte > v0, c1 = gte > v1, c2 = gte > v2;
            v2 = c1 ? v1 : (c2 ? gte : v2); i2 = c1 ? i1 : (c2 ? n : i2);
            v1 = c0 ? v0 : (c1 ? gte : v1); i1 = c0 ? i0 : (c1 ? n : i1);
            v0 = c0 ? gte : v0; i0 = c0 ? n : i0; }
        LAS unsigned* lc = (LAS unsigned*)(F.lds + MISC_OFF + 8192); LAS unsigned* lbase = lc + 64;
        if (F.tid < 64) lc[F.tid] = 0u;
        __syncthreads();
        unsigned r0 = 0u, r1 = 0u, r2 = 0u;
        if (i0 >= 0) r0 = atomicAdd((unsigned*)(lc + i0), 1u);
        if (i1 >= 0) r1 = atomicAdd((unsigned*)(lc + i1), 1u);
        if (i2 >= 0) r2 = atomicAdd((unsigned*)(lc + i2), 1u);
        __syncthreads();
        if (F.tid < 64) { const unsigned c = lc[F.tid]; lbase[F.tid] = c ? atomicAdd(lcnt + bh * 64 + F.tid, c) : 0u; }
        __syncthreads();
        unsigned short* lb = list + (size_t)bh * LSTRIDE;
        if (i0 >= 0) lb[list_off(i0) + lbase[i0] + r0] = (unsigned short)(tl | (0 << 14));
        if (i1 >= 0) lb[list_off(i1) + lbase[i1] + r1] = (unsigned short)(tl | (1 << 14));
        if (i2 >= 0) lb[list_off(i2) + lbase[i2] + r2] = (unsigned short)(tl | (2 << 14));
    }
    __syncthreads();
}
DI void att_phase(Frame& F, int l) {
    const bf16* Q = (const bf16*)(WSP(F) + WS_Q); const bf16* K = (const bf16*)(WSP(F) + WS_K); const bf16* VT = (const bf16*)(WSP(F) + WS_VT);
    const unsigned short* list = (const unsigned short*)(WSP(F) + WS_LIST); const unsigned* lcnt = (const unsigned*)(WSP(F) + WS_CTL) + CW_LCNT + 1024 * l;
    bf16* PO = (bf16*)(WSP(F) + WS_PARTO); float* PML = (float*)(WSP(F) + WS_PARTML);
    LAS unsigned char* Kl = F.lds;
    LAS unsigned char* Vl = F.lds + 36864;
    LAS int* pre = (LAS int*)(F.lds + MISC_OFF + 8192);
    LAS int* cl = (LAS int*)(F.lds + MISC_OFF + 12288); LAS int* ws8 = (LAS int*)(F.lds + MISC_OFF + 4352);
    const int lane = F.lane, wave = F.wave, qi = lane & 15, quad = lane >> 4;
    __syncthreads();
    { const int c0 = (int)__hip_atomic_load(lcnt + 2 * F.tid, __ATOMIC_RELAXED, __HIP_MEMORY_SCOPE_AGENT), c1 = (int)__hip_atomic_load(lcnt + 2 * F.tid + 1, __ATOMIC_RELAXED, __HIP_MEMORY_SCOPE_AGENT);
      cl[2 * F.tid] = c0; cl[2 * F.tid + 1] = c1; const int t0 = (c0 + 127) >> 7, t1 = (c1 + 127) >> 7; int inc = t0 + t1;
#pragma unroll
      for (int o = 1; o < 64; o <<= 1) { const int u = __shfl_up(inc, o); if (lane >= o) inc += u; }
      if (lane == 63) ws8[wave] = inc;
      __syncthreads();
      int off = 0;
#pragma unroll
      for (int w = 0; w < 8; ++w) { const int x = ws8[w]; if (w < wave) off += x; }
      const int ex = off + inc - (t0 + t1); pre[2 * F.tid] = ex; pre[2 * F.tid + 1] = ex + t0;
      __syncthreads();
      if (F.tid == 511) ws8[8] = off + inc; }
    __syncthreads();
    const int NL = __builtin_amdgcn_readfirstlane(ws8[8]), total = NL + BATCH * 8 * 64 * 2, per = (total + F.G - 1) / F.G;
    const int it0 = F.bid * per, it1 = (it0 + per < total) ? it0 + per : total;
    int cur = 0, loaded = -1;
    if (it0 < NL) { int lo = 0, hi = 1023;
        while (lo < hi) { const int mid = (lo + hi + 1) >> 1; if (pre[mid] <= it0) lo = mid; else hi = mid - 1; }
        cur = lo; }
    struct QA { int i, tile, own_item; bool valid; unsigned short ent; };
    struct QB { int i, own_item, tl, j; bool valid; bf16x8_t qf[2]; };
#define DEC_A(itx, R) do { int i_, tile_, own_; \
        if ((itx) < NL) { while (cur < 1023 && pre[cur + 1] <= (itx)) ++cur; i_ = cur; tile_ = (itx) - pre[cur]; own_ = 0; } \
        else { const int o_ = (itx) - NL; i_ = o_ >> 1; tile_ = o_ & 1; own_ = 1; } \
        i_ = __builtin_amdgcn_readfirstlane(i_); tile_ = __builtin_amdgcn_readfirstlane(tile_); \
        R.i = i_; R.tile = tile_; R.own_item = own_; R.ent = 0; R.valid = true; \
        if (!own_) { const int e_ = tile_ * 128 + wave * 16 + qi; R.valid = e_ < cl[i_]; if (R.valid) R.ent = list[(size_t)(i_ >> 6) * LSTRIDE + list_off(i_ & 63) + e_]; } } while (0)
#define DEC_B(A, R) do { const int bh_ = A.i >> 6, n_ = A.i & 63; R.i = A.i; R.own_item = A.own_item; R.valid = A.valid; \
        if (A.own_item) { R.tl = n_ * 256 + A.tile * 128 + wave * 16 + qi; R.j = 3; } else { R.tl = A.ent & 0x3fff; R.j = A.ent >> 14; } \
        { const size_t t_ = (size_t)(bh_ >> 3) * SEQ + R.tl; \
          R.qf[0] = *(const bf16x8_t*)(Q + t_ * 512 + (bh_ & 7) * 64 + quad * 8); R.qf[1] = *(const bf16x8_t*)(Q + t_ * 512 + (bh_ & 7) * 64 + 32 + quad * 8); } } while (0)
    QA na; na.i = 0; na.tile = 0; na.own_item = 1; na.valid = false; na.ent = 0;
    QB nx; nx.i = -1; nx.own_item = 0; nx.tl = 0; nx.j = 0; nx.valid = false; nx.qf[0] = (bf16x8_t){0, 0, 0, 0, 0, 0, 0, 0}; nx.qf[1] = nx.qf[0];
    if (it0 < it1) { DEC_A(it0, na); DEC_B(na, nx); if (it0 + 1 < it1) DEC_A(it0 + 1, na); }
    for (int it = it0; it < it1; ++it) {
        const int i = nx.i, own_item = nx.own_item, tl = nx.tl, j = nx.j; const bool valid = nx.valid; bf16x8_t qf[2] = {nx.qf[0], nx.qf[1]};
        const int bh = i >> 6, n = i & 63, b = bh >> 3, h = bh & 7;
        if (i != loaded) {
            __syncthreads();
#pragma unroll
            for (int r = 0; r < 4; ++r) { const int c = F.tid + r * 512, row = c >> 3, ch = c & 7;
                const u32x4 w = *(const u32x4*)(K + ((size_t)b * SEQ + n * 256 + row) * 512 + h * 64 + ch * 8); *(LAS u32x4*)(Kl + row * 144 + ch * 16) = w; }
#pragma unroll
            for (int r = 0; r < 4; ++r) { const int c = F.tid + r * 512, row = c >> 5, ch = c & 31;
                const u32x4 w = *(const u32x4*)(VT + ((size_t)bh * 64 + row) * SEQ + n * 256 + ch * 8); *(LAS u32x4*)(Vl + row * 528 + ch * 16) = w; }
            __syncthreads();
            loaded = i;
        }
        if (it + 1 < it1) { DEC_B(na, nx); if (it + 2 < it1) DEC_A(it + 2, na); }
        const size_t t = (size_t)b * SEQ + tl;
        const float slope2 = __builtin_amdgcn_exp2f(-(float)(h + 1)) * LOG2E;
        const bool half_only = own_item && (__builtin_amdgcn_readfirstlane(tl - n * 256) < 128);
        const int tloc = tl - n * 256;
        const float sbase = slope2 * (float)(quad * 4); const int tq4 = tloc - quad * 4;
        f32x4 sc[16];
#pragma unroll
        for (int kt = 0; kt < 16; ++kt) {
            if (kt >= 8 && half_only) { sc[kt] = (f32x4){-INFINITY, -INFINITY, -INFINITY, -INFINITY}; continue; }
            f32x4 a = {fmaf(slope2, (float)(kt * 16), sbase), fmaf(slope2, (float)(kt * 16 + 1), sbase), fmaf(slope2, (float)(kt * 16 + 2), sbase), fmaf(slope2, (float)(kt * 16 + 3), sbase)};
#pragma unroll
            for (int ks = 0; ks < 2; ++ks) { const bf16x8_t kf = *(const LAS bf16x8_t*)(Kl + (kt * 16 + qi) * 144 + ks * 64 + quad * 16); a = __builtin_amdgcn_mfma_f32_16x16x32_bf16(kf, qf[ks], a, 0, 0, 0); }
            sc[kt] = a; if ((kt & 3) == 3) asm volatile("" ::: "memory"); }
        if (own_item) {
#pragma unroll
            for (int kt = 0; kt < 16; ++kt)
#pragma unroll
                for (int e = 0; e < 4; ++e) if ((kt * 16 + e) > tq4) sc[kt][e] = -INFINITY; }
        float mx = -INFINITY;
#pragma unroll
        for (int kt = 0; kt < 16; ++kt)
#pragma unroll
            for (int e = 0; e < 4; ++e) mx = fmaxf(mx, sc[kt][e]);
        mx = fmaxf(mx, __shfl_xor(mx, 16)); mx = fmaxf(mx, __shfl_xor(mx, 32));
        float ls = 0.f;
#pragma unroll
        for (int kt = 0; kt < 16; ++kt)
#pragma unroll
            for (int e = 0; e < 4; ++e) { const float p = __builtin_amdgcn_exp2f(sc[kt][e] - mx); sc[kt][e] = p; ls += p; }
        ls += __shfl_xor(ls, 16); ls += __shfl_xor(ls, 32);
        f32x4 o[4];
#pragma unroll
        for (int dt = 0; dt < 4; ++dt) o[dt] = (f32x4){0.f, 0.f, 0.f, 0.f};
#pragma unroll
        for (int k2 = 0; k2 < 8; ++k2) {
            if (k2 >= 4 && half_only) break;
            u32x4 pw; pw.x = pg8::cvt_pk_bf16(sc[2 * k2][0], sc[2 * k2][1]); pw.y = pg8::cvt_pk_bf16(sc[2 * k2][2], sc[2 * k2][3]);
            pw.z = pg8::cvt_pk_bf16(sc[2 * k2 + 1][0], sc[2 * k2 + 1][1]); pw.w = pg8::cvt_pk_bf16(sc[2 * k2 + 1][2], sc[2 * k2 + 1][3]);
            const bf16x8_t pf = __builtin_bit_cast(bf16x8_t, pw);
#pragma unroll
            for (int dt = 0; dt < 4; ++dt) { const LAS unsigned char* vp = Vl + (dt * 16 + qi) * 528 + (k2 * 32 + quad * 4) * 2;
                const u32x2 lo = *(const LAS u32x2*)vp, hi = *(const LAS u32x2*)(vp + 32);
                const u32x4 vw = {lo.x, lo.y, hi.x, hi.y};
                o[dt] = __builtin_amdgcn_mfma_f32_16x16x32_bf16(__builtin_bit_cast(bf16x8_t, vw), pf, o[dt], 0, 0, 0); }
            if (k2 & 1) asm volatile("" ::: "memory"); }
        if (valid) { const float inv = frcp_(ls); const size_t pidx = (t * 8 + h) * 4 + j; bf16* op = PO + pidx * 64 + quad * 4;
#pragma unroll
            for (int dt = 0; dt < 4; ++dt) *(u32x2*)(op + dt * 16) = (u32x2){pg8::cvt_pk_bf16(o[dt][0] * inv, o[dt][1] * inv), pg8::cvt_pk_bf16(o[dt][2] * inv, o[dt][3] * inv)};
            if (quad == 0) ((float2*)PML)[pidx] = make_float2(mx - slope2 * (float)tloc, ls); }
    }
#undef DEC_A
#undef DEC_B
    __syncthreads();
}
DI void comb_phase(Frame& F) {
    const bf16* PO = (const bf16*)(WSP(F) + WS_PARTO); const float* PML = (const float*)(WSP(F) + WS_PARTML); bf16* Y = (bf16*)(WSP(F) + WS_YATTN);
    const int gw = F.bid * 8 + F.wave, NGW = F.G * 8, lane = F.lane, h = lane >> 3, dc = lane & 7;
    for (int t = gw; t < T; t += NGW) {
        const int own = (t % SEQ) >> 8, nsel = own < 3 ? own : 3; const size_t pb = ((size_t)t * 8 + h) * 4;
        float m[4], lw[4]; float M = -INFINITY;
#pragma unroll
        for (int j = 0; j < 4; ++j) { const bool ok = (j == 3) || (j < nsel); const float2 ml = ok ? ((const float2*)PML)[pb + j] : make_float2(-INFINITY, 0.f); m[j] = ml.x; lw[j] = ml.y; M = fmaxf(M, ml.x); }
        float acc[8] = {0.f, 0.f, 0.f, 0.f, 0.f, 0.f, 0.f, 0.f}; float wsum = 0.f;
#pragma unroll
        for (int j = 0; j < 4; ++j) { const bool ok = (j == 3) || (j < nsel); if (!ok) continue;
            const float w = __builtin_amdgcn_exp2f(m[j] - M) * lw[j]; wsum += w; const u32x4 ow = *(const u32x4*)(PO + (pb + j) * 64 + dc * 8);
            acc[0] += w * blo(ow.x); acc[1] += w * bhi(ow.x); acc[2] += w * blo(ow.y); acc[3] += w * bhi(ow.y); acc[4] += w * blo(ow.z); acc[5] += w * bhi(ow.z); acc[6] += w * blo(ow.w); acc[7] += w * bhi(ow.w); }
        const float inv = frcp_(wsum);
        *(u32x4*)(Y + (size_t)t * 512 + h * 64 + dc * 8) = (u32x4){pk2(acc[0] * inv, acc[1] * inv), pk2(acc[2] * inv, acc[3] * inv), pk2(acc[4] * inv, acc[5] * inv), pk2(acc[6] * inv, acc[7] * inv)};
    }
}
DI void pool_phase(Frame& F, int l) {
    const bf16* Z = (const bf16*)(WSP(F) + WS_POOLZ); bf16* Y = (bf16*)(WSP(F) + WS_YPOOL); const bf16* WPT = (const bf16*)(WSP(F) + WS_WPT);
    LAS unsigned char* Pl = F.lds;
    const int lane = F.lane, li = lane & 15, quad = lane >> 4, g = F.wave >> 1, dt0 = (F.wave & 1) * 4;
    bf16x8_t wf[4][4];
#pragma unroll
    for (int dt = 0; dt < 4; ++dt)
#pragma unroll
        for (int ks = 0; ks < 4; ++ks) wf[dt][ks] = *(const bf16x8_t*)(WPT + ((size_t)g * 128 + 16 * (dt0 + dt) + li) * 128 + 32 * ks + 8 * quad);
    for (int tile = F.bid; tile < T / 64; tile += F.G) {
        __syncthreads();
#pragma unroll 1
        for (int i = F.tid; i < 64 * 64; i += 512) { const int tt = i >> 6, ch = i & 63, gg = ch >> 4, win = 2 << gg, t = tile * 64 + tt, tl = t % SEQ; const int cnt = (tl + 1 < win) ? tl + 1 : win;
            u32x4 w[16];
#pragma unroll
            for (int j = 0; j < 16; ++j) { w[j] = (u32x4){0u, 0u, 0u, 0u}; if (j < cnt) w[j] = *(const u32x4*)(Z + (size_t)(t - j) * 512 + ch * 8); }
            float s[8] = {0.f, 0.f, 0.f, 0.f, 0.f, 0.f, 0.f, 0.f};
#pragma unroll
            for (int j = 0; j < 16; ++j) { s[0] += blo(w[j].x); s[1] += bhi(w[j].x); s[2] += blo(w[j].y); s[3] += bhi(w[j].y); s[4] += blo(w[j].z); s[5] += bhi(w[j].z); s[6] += blo(w[j].w); s[7] += bhi(w[j].w); }
            const float inv = 1.0f / (float)cnt;
            *(LAS u32x4*)(Pl + tt * 1040 + ch * 16) = (u32x4){pk2(s[0] * inv - blo(w[0].x), s[1] * inv - bhi(w[0].x)), pk2(s[2] * inv - blo(w[0].y), s[3] * inv - bhi(w[0].y)),
                                                                 pk2(s[4] * inv - blo(w[0].z), s[5] * inv - bhi(w[0].z)), pk2(s[6] * inv - blo(w[0].w), s[7] * inv - bhi(w[0].w))}; }
        __syncthreads();
#pragma unroll
        for (int tt = 0; tt < 4; ++tt) {
            bf16x8_t pf[4];
#pragma unroll
            for (int ks = 0; ks < 4; ++ks) pf[ks] = *(const LAS bf16x8_t*)(Pl + (16 * tt + li) * 1040 + (g * 128 + 32 * ks + 8 * quad) * 2);
#pragma unroll
            for (int dt = 0; dt < 4; ++dt) { f32x4 acc = {0.f, 0.f, 0.f, 0.f};
#pragma unroll
                for (int ks = 0; ks < 4; ++ks) acc = __builtin_amdgcn_mfma_f32_16x16x32_bf16(wf[dt][ks], pf[ks], acc, 0, 0, 0);
                *(u32x2*)(Y + (size_t)(tile * 64 + 16 * tt + li) * 512 + g * 128 + 16 * (dt0 + dt) + 4 * quad) = (u32x2){pk2(acc[0], acc[1]), pk2(acc[2], acc[3])}; } }
    }
    __syncthreads();
}
DI void rwkv_prep_phase(Frame& F, int l) {
    const bf16* RZ = (const bf16*)(WSP(F) + WS_RWKVZ); bf16* VF = (bf16*)(WSP(F) + WS_VFIRST);
    bf16* AR = (bf16*)(WSP(F) + WS_AR); const size_t AS = (size_t)T * 512;
    float* bonus = (float*)(WSP(F) + WS_BONUS); float* kinv = (float*)(WSP(F) + WS_KINV); const bf16* WLT = (const bf16*)(WSP(F) + WS_WLT);
    LAS unsigned char* Al = F.lds;
    const int h = F.wave;
    const float* mu = INP(F, 4) + l * 1792; const float* vmu = INP(F, 5) + (l > 0 ? (l - 1) * 32 : 0);
    const float* w0p = INP(F, 6) + l * 512 + h * 64; const float* a0p = INP(F, 8) + l * 512 + h * 64; const float* kkp = INP(F, 11) + l * 512 + h * 64;
    const float* kap = INP(F, 12) + l * 512 + h * 64; const float* rkp = INP(F, 13) + l * 512 + h * 64; const float* v0p = INP(F, 16) + (l > 0 ? l - 1 : 0) * 512 + h * 64;
    for (int item = F.bid; item < T / 64; item += F.G) {
        int tid = F.tid; asm volatile("" : "+v"(tid));
        const int lane = tid & 63, li = lane & 15, quad = lane >> 4;
        const int t0 = item * 64, tl0 = t0 % SEQ;
        __syncthreads();
        { const int tok = tid >> 3, c0 = tid & 7; const size_t t = (size_t)(t0 + tok); const bool first = (tl0 + tok == 0);
          u32x4 zc[5], zp[5]; f32x4 m0[5], m1[5];
#pragma unroll
          for (int r = 0; r < 5; ++r) { const int c = c0 + 8 * r; zc[r] = (u32x4){0u, 0u, 0u, 0u}; zp[r] = zc[r]; m0[r] = (f32x4){0.f, 0.f, 0.f, 0.f}; m1[r] = m0[r];
              if (c < 32 || (l > 0 && c < 36)) { const int col = 1536 + 8 * c; zc[r] = *(const u32x4*)(RZ + t * RZP + col); if (!first) zp[r] = *(const u32x4*)(RZ + (t - 1) * RZP + col);
                  const float* mp = col < 1792 ? mu + col : vmu + (col - 1792); m0[r] = *(const f32x4*)mp; m1[r] = *(const f32x4*)(mp + 4); } }
#pragma unroll
          for (int r = 0; r < 5; ++r) { const int c = c0 + 8 * r; if (c < 36) {
              const float cv[8] = {blo(zc[r].x), bhi(zc[r].x), blo(zc[r].y), bhi(zc[r].y), blo(zc[r].z), bhi(zc[r].z), blo(zc[r].w), bhi(zc[r].w)}, pv[8] = {blo(zp[r].x), bhi(zp[r].x), blo(zp[r].y), bhi(zp[r].y), blo(zp[r].z), bhi(zp[r].z), blo(zp[r].w), bhi(zp[r].w)};
              const float mm[8] = {m0[r].x, m0[r].y, m0[r].z, m0[r].w, m1[r].x, m1[r].y, m1[r].z, m1[r].w}; float f[8];
#pragma unroll
              for (int e = 0; e < 8; ++e) { const float zs = cv[e] + (pv[e] - cv[e]) * mm[e]; f[e] = r == 0 ? tanhf(zs) : (r == 2 || r == 3) ? sigmoidf_(zs) : zs; }
              *(LAS u32x4*)(Al + tok * 592 + c * 16) = (u32x4){pk2(f[0], f[1]), pk2(f[2], f[3]), pk2(f[4], f[5]), pk2(f[6], f[7])}; } } }
        __syncthreads();
        float ssq[4] = {0.f, 0.f, 0.f, 0.f}, bsm[4] = {0.f, 0.f, 0.f, 0.f};
#pragma unroll 1
        for (int ct = 0; ct < 4; ++ct) {
            const int cb = 16 * ct + 4 * quad;
            bf16x8_t wf[9];
#pragma unroll
            for (int ks = 0; ks < 9; ++ks) wf[ks] = *(const bf16x8_t*)(WLT + (size_t)(h * 64 + 16 * ct + li) * 288 + 32 * ks + 8 * quad);
            const f32x4 mr = *(const f32x4*)(mu + h * 64 + cb), mk = *(const f32x4*)(mu + 512 + h * 64 + cb), mv = *(const f32x4*)(mu + 1024 + h * 64 + cb);
            const f32x4 w0 = *(const f32x4*)(w0p + cb), a0 = *(const f32x4*)(a0p + cb), kkc = *(const f32x4*)(kkp + cb), kac = *(const f32x4*)(kap + cb), rkc = *(const f32x4*)(rkp + cb);
            f32x4 v0 = {0.f, 0.f, 0.f, 0.f}; if (l > 0) v0 = *(const f32x4*)(v0p + cb);
            u32x2 zr[4][2], zk[4][2], zv[4][2], vfw[4];
#pragma unroll
            for (int rt = 0; rt < 4; ++rt) { const int tok = 16 * rt + li; const size_t zi = (size_t)(t0 + tok) * RZP + h * 64 + cb; const bool first = (tl0 + tok == 0);
                zr[rt][0] = *(const u32x2*)(RZ + zi); zk[rt][0] = *(const u32x2*)(RZ + zi + 512); zv[rt][0] = *(const u32x2*)(RZ + zi + 1024);
                zr[rt][1] = (u32x2){0u, 0u}; zk[rt][1] = zr[rt][1]; zv[rt][1] = zr[rt][1]; vfw[rt] = zr[rt][1];
                if (!first) { zr[rt][1] = *(const u32x2*)(RZ + zi - RZP); zk[rt][1] = *(const u32x2*)(RZ + zi - RZP + 512); zv[rt][1] = *(const u32x2*)(RZ + zi - RZP + 1024); }
                if (l > 0) vfw[rt] = *(const u32x2*)(VF + (size_t)(t0 + tok) * 512 + h * 64 + cb); }
#pragma unroll
            for (int rt = 0; rt < 4; ++rt) { const int tok = 16 * rt + li; const size_t idx = (size_t)(t0 + tok) * 512 + h * 64 + cb;
                f32x4 aw = {0.f, 0.f, 0.f, 0.f}, aa = aw, ag = aw, av = aw;
#pragma unroll
                for (int ks = 0; ks < 9; ++ks) { if (ks == 8 && l == 0) break;
                    const bf16x8_t bfr = *(const LAS bf16x8_t*)(Al + tok * 592 + ks * 64 + quad * 16);
                    if (ks < 2) aw = __builtin_amdgcn_mfma_f32_16x16x32_bf16(wf[ks], bfr, aw, 0, 0, 0);
                    else if (ks < 4) aa = __builtin_amdgcn_mfma_f32_16x16x32_bf16(wf[ks], bfr, aa, 0, 0, 0);
                    else if (ks < 8) ag = __builtin_amdgcn_mfma_f32_16x16x32_bf16(wf[ks], bfr, ag, 0, 0, 0);
                    else av = __builtin_amdgcn_mfma_f32_16x16x32_bf16(wf[ks], bfr, av, 0, 0, 0); }
                const float crf[4] = {blo(zr[rt][0].x), bhi(zr[rt][0].x), blo(zr[rt][0].y), bhi(zr[rt][0].y)}, prf[4] = {blo(zr[rt][1].x), bhi(zr[rt][1].x), blo(zr[rt][1].y), bhi(zr[rt][1].y)};
                const float ckf[4] = {blo(zk[rt][0].x), bhi(zk[rt][0].x), blo(zk[rt][0].y), bhi(zk[rt][0].y)}, pkf[4] = {blo(zk[rt][1].x), bhi(zk[rt][1].x), blo(zk[rt][1].y), bhi(zk[rt][1].y)};
                const float cvf[4] = {blo(zv[rt][0].x), bhi(zv[rt][0].x), blo(zv[rt][0].y), bhi(zv[rt][0].y)}, pvf[4] = {blo(zv[rt][1].x), bhi(zv[rt][1].x), blo(zv[rt][1].y), bhi(zv[rt][1].y)};
                const float vff[4] = {blo(vfw[rt].x), bhi(vfw[rt].x), blo(vfw[rt].y), bhi(vfw[rt].y)};
                float ro[4], lwo[4], kpo[4], vo[4], kro[4], bbo[4];
#pragma unroll
                for (int e = 0; e < 4; ++e) { const float r = crf[e] + (prf[e] - crf[e]) * mr[e], k = ckf[e] + (pkf[e] - ckf[e]) * mk[e]; float v = cvf[e] + (pvf[e] - cvf[e]) * mv[e];
                    const float xw = -(w0[e] + aw[e]); const float sp = xw > 20.f ? xw : log1pf(__expf(xw)); lwo[e] = -__expf(-sp - 0.5f);
                    const float asig = sigmoidf_(a0[e] + aa[e]);
                    if (l > 0) v = v + (vff[e] - v) * sigmoidf_(v0[e] + av[e]);
                    vo[e] = v; ro[e] = r; const float kr = k * kkc[e]; kro[e] = kr; bbo[e] = kr * asig; ssq[rt] += kr * kr;
                    const float kpe = k * (1.0f + (asig - 1.0f) * kac[e]); kpo[e] = kpe; bsm[rt] += r * kpe * rkc[e]; }
                if (l == 0) *(u32x2*)(VF + idx) = (u32x2){pk2(vo[0], vo[1]), pk2(vo[2], vo[3])};
                *(u32x2*)(AR + idx) = (u32x2){pk2(ro[0], ro[1]), pk2(ro[2], ro[3])};
                *(u32x2*)(AR + AS + idx) = (u32x2){pk2(lwo[0], lwo[1]), pk2(lwo[2], lwo[3])};
                *(u32x2*)(AR + 2 * AS + idx) = (u32x2){pk2(kpo[0], kpo[1]), pk2(kpo[2], kpo[3])};
                *(u32x2*)(AR + 3 * AS + idx) = (u32x2){pk2(vo[0], vo[1]), pk2(vo[2], vo[3])};
                *(u32x2*)(AR + 4 * AS + idx) = (u32x2){pk2(kro[0], kro[1]), pk2(kro[2], kro[3])};
                *(u32x2*)(AR + 5 * AS + idx) = (u32x2){pk2(bbo[0], bbo[1]), pk2(bbo[2], bbo[3])};
                *(u32x2*)(AR + 6 * AS + idx) = (u32x2){pk2(ag[0], ag[1]), pk2(ag[2], ag[3])}; asm volatile("" ::: "memory"); }
        }
#pragma unroll
        for (int rt = 0; rt < 4; ++rt) { float ss = ssq[rt], bs = bsm[rt]; ss += __shfl_xor(ss, 16); ss += __shfl_xor(ss, 32); bs += __shfl_xor(bs, 16); bs += __shfl_xor(bs, 32);
            if (quad == 0) { const size_t t = (size_t)(t0 + 16 * rt + li); bonus[t * 8 + h] = bs; kinv[t * 8 + h] = 1.0f / fmaxf(sqrtf(ss), 1e-12f); } }
    }
    __syncthreads();
}
typedef short bf16x4_t __attribute__((ext_vector_type(4)));
DI void rwkv_chunk_phase(Frame& F, int l) {
    const bf16* RZ = (const bf16*)(WSP(F) + WS_RWKVZ); bf16* VF = (bf16*)(WSP(F) + WS_VFIRST);
    bf16* AR = (bf16*)(WSP(F) + WS_AR); const size_t AS = (size_t)T * 512; float* bonus = (float*)(WSP(F) + WS_BONUS); const bf16* WLT = (const bf16*)(WSP(F) + WS_WLT);
    bf16* PCT = (bf16*)(WSP(F) + WS_PCT); bf16* LC = (bf16*)(WSP(F) + WS_LC); bf16* RM = (bf16*)(WSP(F) + WS_RM); bf16* Y0 = (bf16*)(WSP(F) + WS_Y0);
    const float* mu = INP(F, 4) + l * 1792; const float* vmu = INP(F, 5) + (l > 0 ? (l - 1) * 32 : 0);
    constexpr int ST = 144;
    LAS unsigned char* L = F.lds;
    LAS unsigned char* AT = L; LAS unsigned char* BT = L + 9216; LAS unsigned char* KT = L + 18432; LAS unsigned char* RT = L + 27648;
    LAS unsigned char* BTT = L + 36864; LAS unsigned char* KTT = L + 46080; LAS unsigned char* VTl = L + 55296; LAS unsigned char* NB = L + 64512; LAS unsigned char* MB = L + 73728;
    LAS unsigned char* WMT = L + 82944; LAS unsigned char* UMT = L + 92160;
    LAS unsigned char* Al = L + 64512;
    LAS unsigned char* SR = L + 64512; LAS unsigned char* SKP = L + 72704; LAS unsigned char* SKR = L + 80896; LAS unsigned char* SBB = L + 89088;
    LAS float* LGF = (LAS float*)(L + 101376); LAS float* ND = (LAS float*)(L + 117760); LAS unsigned char* DB = L + 122112; LAS float* GC = (LAS float*)(L + 125184); LAS float* PART = (LAS float*)(L + 125440);
    LAS float* SSP = (LAS float*)(L + 127488); LAS float* BSP = SSP + 256;
    const int wave = F.wave;
#define MF32(a, b, c) __builtin_amdgcn_mfma_f32_16x16x32_bf16((a), (b), (c), 0, 0, 0)
#define MF16(a, b, c) __builtin_amdgcn_mfma_f32_16x16x16bf16_1k((a), (b), (c), 0, 0, 0)
#define RD8(p) (*(const LAS bf16x8_t*)(p))
#define RD4(p) (*(const LAS bf16x4_t*)(p))
    u32x4 zcn[5], zpn[5], areg[5];
#define F1LOAD(ckx) do { const int b_ = (ckx) >> 8, ck_ = (ckx) & 255; const size_t t_ = (size_t)b_ * SEQ + ck_ * 64 + (F.tid >> 3); const bool first_ = (ck_ * 64 + (F.tid >> 3) == 0); \
        _Pragma("unroll") for (int r_ = 0; r_ < 5; ++r_) { const int c_ = (F.tid & 7) + 8 * r_; zcn[r_] = (u32x4){0u, 0u, 0u, 0u}; zpn[r_] = zcn[r_]; \
            if (c_ < 32 || (l > 0 && c_ < 36)) { const int col_ = 1536 + 8 * c_; zcn[r_] = *(const u32x4*)(RZ + t_ * RZP + col_); if (!first_) zpn[r_] = *(const u32x4*)(RZ + (t_ - 1) * RZP + col_); } } } while (0)
    if (F.bid < BATCH * (SEQ / 64)) F1LOAD(F.bid);
    for (int cki = F.bid; cki < BATCH * (SEQ / 64); cki += F.G) {
      {
          const int c0 = F.tid & 7; f32x4 m0[5], m1[5];
#pragma unroll
          for (int r = 0; r < 5; ++r) { const int c = c0 + 8 * r; m0[r] = (f32x4){0.f, 0.f, 0.f, 0.f}; m1[r] = m0[r];
              if (c < 32 || (l > 0 && c < 36)) { const int col = 1536 + 8 * c; const float* mp = col < 1792 ? mu + col : vmu + (col - 1792); m0[r] = *(const f32x4*)mp; m1[r] = *(const f32x4*)(mp + 4); } }
#pragma unroll
          for (int r = 0; r < 5; ++r) {
              const float cv[8] = {blo(zcn[r].x), bhi(zcn[r].x), blo(zcn[r].y), bhi(zcn[r].y), blo(zcn[r].z), bhi(zcn[r].z), blo(zcn[r].w), bhi(zcn[r].w)}, pv[8] = {blo(zpn[r].x), bhi(zpn[r].x), blo(zpn[r].y), bhi(zpn[r].y), blo(zpn[r].z), bhi(zpn[r].z), blo(zpn[r].w), bhi(zpn[r].w)};
              const float mm[8] = {m0[r].x, m0[r].y, m0[r].z, m0[r].w, m1[r].x, m1[r].y, m1[r].z, m1[r].w}; float f[8];
#pragma unroll
              for (int e = 0; e < 8; ++e) { const float zs = cv[e] + (pv[e] - cv[e]) * mm[e]; f[e] = r == 0 ? ftanh_(zs) : (r == 2 || r == 3) ? sigmoidf_(zs) : zs; }
              areg[r] = (u32x4){pk2(f[0], f[1]), pk2(f[2], f[3]), pk2(f[4], f[5]), pk2(f[6], f[7])}; } }
#pragma unroll 1
      for (int h = 0; h < 8; ++h) {
        int tid = F.tid; asm volatile("" : "+v"(tid));
        const int lane = tid & 63, li = lane & 15, quad = lane >> 4;
        const int b = cki >> 8, ck = cki & 255, bh = b * 8 + h, it = bh * 256 + ck;
        const size_t tbase = (size_t)b * SEQ + ck * 64; const int tl0 = ck * 64;
        __syncthreads();
        { const int tok = tid >> 3, c0 = tid & 7;
#pragma unroll
          for (int r = 0; r < 5; ++r) { const int c = c0 + 8 * r; if (c < 36) *(LAS u32x4*)(Al + tok * 576 + c * 16) = areg[r]; } }
        __syncthreads();
        { const int ct = wave & 3, hw = wave >> 2, cb = 16 * ct + 4 * quad;
          bf16x8_t wf[9];
#pragma unroll
          for (int ks = 0; ks < 9; ++ks) wf[ks] = *(const bf16x8_t*)(WLT + (size_t)(h * 64 + 16 * ct + li) * 288 + 32 * ks + 8 * quad);
          const f32x4 mr = *(const f32x4*)(mu + h * 64 + cb), mk = *(const f32x4*)(mu + 512 + h * 64 + cb), mv = *(const f32x4*)(mu + 1024 + h * 64 + cb);
          const f32x4 w0 = *(const f32x4*)(INP(F, 6) + l * 512 + h * 64 + cb), a0 = *(const f32x4*)(INP(F, 8) + l * 512 + h * 64 + cb), kkc = *(const f32x4*)(INP(F, 11) + l * 512 + h * 64 + cb);
          const f32x4 kac = *(const f32x4*)(INP(F, 12) + l * 512 + h * 64 + cb), rkc = *(const f32x4*)(INP(F, 13) + l * 512 + h * 64 + cb);
          f32x4 v0 = {0.f, 0.f, 0.f, 0.f}; if (l > 0) v0 = *(const f32x4*)(INP(F, 16) + (l - 1) * 512 + h * 64 + cb);
          u32x2 zr[2][2], zk[2][2], zv[2][2], vfw[2]; f32x4 aw[2], aa[2], ag[2], av[2];
#pragma unroll
          for (int rr = 0; rr < 2; ++rr) { const int tok = 16 * (2 * hw + rr) + li; const size_t zi = (tbase + tok) * RZP + h * 64 + cb; const bool first = (tl0 + tok == 0);
              zr[rr][0] = *(const u32x2*)(RZ + zi); zk[rr][0] = *(const u32x2*)(RZ + zi + 512); zv[rr][0] = *(const u32x2*)(RZ + zi + 1024);
              zr[rr][1] = (u32x2){0u, 0u}; zk[rr][1] = zr[rr][1]; zv[rr][1] = zr[rr][1]; vfw[rr] = zr[rr][1];
              if (!first) { zr[rr][1] = *(const u32x2*)(RZ + zi - RZP); zk[rr][1] = *(const u32x2*)(RZ + zi - RZP + 512); zv[rr][1] = *(const u32x2*)(RZ + zi - RZP + 1024); }
              if (l > 0) vfw[rr] = *(const u32x2*)(VF + (tbase + tok) * 512 + h * 64 + cb); }
#pragma unroll
          for (int rr = 0; rr < 2; ++rr) { const int tok = 16 * (2 * hw + rr) + li; aw[rr] = (f32x4){0.f, 0.f, 0.f, 0.f}; aa[rr] = aw[rr]; ag[rr] = aw[rr]; av[rr] = aw[rr];
#pragma unroll
              for (int ks = 0; ks < 9; ++ks) { if (ks == 8 && l == 0) break;
                  const bf16x8_t bfr = RD8(Al + tok * 576 + ks * 64 + quad * 16);
                  if (ks < 2) aw[rr] = MF32(wf[ks], bfr, aw[rr]); else if (ks < 4) aa[rr] = MF32(wf[ks], bfr, aa[rr]); else if (ks < 8) ag[rr] = MF32(wf[ks], bfr, ag[rr]); else av[rr] = MF32(wf[ks], bfr, av[rr]); } }
          __syncthreads();
          if (h == 7 && cki + F.G < BATCH * (SEQ / 64)) F1LOAD(cki + F.G);
#pragma unroll
          for (int rr = 0; rr < 2; ++rr) { const int tok = 16 * (2 * hw + rr) + li; const size_t idx = (tbase + tok) * 512 + h * 64 + cb;
              const float crf[4] = {blo(zr[rr][0].x), bhi(zr[rr][0].x), blo(zr[rr][0].y), bhi(zr[rr][0].y)}, prf[4] = {blo(zr[rr][1].x), bhi(zr[rr][1].x), blo(zr[rr][1].y), bhi(zr[rr][1].y)};
              const float ckf[4] = {blo(zk[rr][0].x), bhi(zk[rr][0].x), blo(zk[rr][0].y), bhi(zk[rr][0].y)}, pkf[4] = {blo(zk[rr][1].x), bhi(zk[rr][1].x), blo(zk[rr][1].y), bhi(zk[rr][1].y)};
              const float cvf[4] = {blo(zv[rr][0].x), bhi(zv[rr][0].x), blo(zv[rr][0].y), bhi(zv[rr][0].y)}, pvf[4] = {blo(zv[rr][1].x), bhi(zv[rr][1].x), blo(zv[rr][1].y), bhi(zv[rr][1].y)};
              const float vff[4] = {blo(vfw[rr].x), bhi(vfw[rr].x), blo(vfw[rr].y), bhi(vfw[rr].y)};
              float ro[4], lwo[4], kpo[4], vo[4], kro[4], bbo[4]; float ss = 0.f, bs = 0.f;
#pragma unroll
              for (int e = 0; e < 4; ++e) { const float r = crf[e] + (prf[e] - crf[e]) * mr[e], k = ckf[e] + (pkf[e] - ckf[e]) * mk[e]; float v = cvf[e] + (pvf[e] - cvf[e]) * mv[e];
                  const float xw = -(w0[e] + aw[rr][e]); const float sp = fsoftplus_(xw); lwo[e] = -fexp_(-sp - 0.5f);
                  const float asig = sigmoidf_(a0[e] + aa[rr][e]);
                  if (l > 0) v = v + (vff[e] - v) * sigmoidf_(v0[e] + av[rr][e]);
                  vo[e] = v; ro[e] = r; const float kr = k * kkc[e]; kro[e] = kr; bbo[e] = kr * asig; ss += kr * kr;
                  const float kpe = k * (1.0f + (asig - 1.0f) * kac[e]); kpo[e] = kpe; bs += r * kpe * rkc[e]; }
              const u32x2 vpk = {pk2(vo[0], vo[1]), pk2(vo[2], vo[3])};
              if (l == 0) *(u32x2*)(VF + idx) = vpk;
              *(u32x2*)(AR + 3 * AS + idx) = vpk; *(u32x2*)(AR + 6 * AS + idx) = (u32x2){pk2(ag[rr][0], ag[rr][1]), pk2(ag[rr][2], ag[rr][3])};
              *(LAS f32x4*)(LGF + tok * 64 + cb) = (f32x4){__uint_as_float(f2bf(lwo[0]) << 16), __uint_as_float(f2bf(lwo[1]) << 16), __uint_as_float(f2bf(lwo[2]) << 16), __uint_as_float(f2bf(lwo[3]) << 16)};
              *(LAS u32x2*)(SR + tok * 128 + cb * 2) = (u32x2){pk2(ro[0], ro[1]), pk2(ro[2], ro[3])}; *(LAS u32x2*)(SKP + tok * 128 + cb * 2) = (u32x2){pk2(kpo[0], kpo[1]), pk2(kpo[2], kpo[3])};
              *(LAS u32x2*)(SKR + tok * 128 + cb * 2) = (u32x2){pk2(kro[0], kro[1]), pk2(kro[2], kro[3])}; *(LAS u32x2*)(SBB + tok * 128 + cb * 2) = (u32x2){pk2(bbo[0], bbo[1]), pk2(bbo[2], bbo[3])};
#pragma unroll
              for (int e = 0; e < 4; ++e) *(LAS unsigned short*)(VTl + (cb + e) * ST + tok * 2) = (unsigned short)f2bf(vo[e]);
              ss += __shfl_xor(ss, 16); ss += __shfl_xor(ss, 32); bs += __shfl_xor(bs, 16); bs += __shfl_xor(bs, 32);
              if (quad == 0) { SSP[ct * 64 + tok] = ss; BSP[ct * 64 + tok] = bs; } } }
        __syncthreads();
        const int et = tid >> 3, ec = (tid & 7) * 8;
        { const int c = tid & 63, p = tid >> 6; float x[8]; float run = 0.f;
#pragma unroll
          for (int i = 0; i < 8; ++i) x[i] = LGF[(8 * p + i) * 64 + c];
#pragma unroll
          for (int i = 0; i < 8; ++i) { run += x[i]; LGF[(8 * p + i) * 64 + c] = run; }
          PART[p * 64 + c] = run; }
        __syncthreads();
        { float lg[8], lgp[8];
          { f32x4 o0 = {0.f, 0.f, 0.f, 0.f}, o1 = o0, q0 = o0, q1 = o0, tot0 = o0, tot1 = o0;
#pragma unroll
            for (int p = 0; p < 8; ++p) { const f32x4 a0 = *(const LAS f32x4*)(PART + p * 64 + ec), a1 = *(const LAS f32x4*)(PART + p * 64 + ec + 4); if (p < (et >> 3)) { o0 += a0; o1 += a1; } if (p < ((et - 1) >> 3)) { q0 += a0; q1 += a1; } tot0 += a0; tot1 += a1; }
            const f32x4 l0 = *(const LAS f32x4*)(LGF + et * 64 + ec) + o0, l1 = *(const LAS f32x4*)(LGF + et * 64 + ec + 4) + o1;
            f32x4 p0 = {0.f, 0.f, 0.f, 0.f}, p1 = p0; if (et > 0) { p0 = *(const LAS f32x4*)(LGF + (et - 1) * 64 + ec) + q0; p1 = *(const LAS f32x4*)(LGF + (et - 1) * 64 + ec + 4) + q1; }
            lg[0] = l0.x; lg[1] = l0.y; lg[2] = l0.z; lg[3] = l0.w; lg[4] = l1.x; lg[5] = l1.y; lg[6] = l1.z; lg[7] = l1.w;
            lgp[0] = p0.x; lgp[1] = p0.y; lgp[2] = p0.z; lgp[3] = p0.w; lgp[4] = p1.x; lgp[5] = p1.y; lgp[6] = p1.z; lgp[7] = p1.w;
            if (et == 63) { *(LAS f32x4*)(GC + ec) = (f32x4){fexp_(tot0.x), fexp_(tot0.y), fexp_(tot0.z), fexp_(tot0.w)}; *(LAS f32x4*)(GC + ec + 4) = (f32x4){fexp_(tot1.x), fexp_(tot1.y), fexp_(tot1.z), fexp_(tot1.w)}; } }
          const float ssum = (SSP[et] + SSP[64 + et]) + (SSP[128 + et] + SSP[192 + et]); const float kiv = __builtin_amdgcn_rsqf(fmaxf(ssum, 1e-24f));
          if (ec == 0) bonus[(tbase + et) * 8 + h] = (BSP[et] + BSP[64 + et]) + (BSP[128 + et] + BSP[192 + et]);
          const u32x4 wr = *(const LAS u32x4*)(SR + et * 128 + ec * 2), wk = *(const LAS u32x4*)(SKP + et * 128 + ec * 2), wkk = *(const LAS u32x4*)(SKR + et * 128 + ec * 2), wbb = *(const LAS u32x4*)(SBB + et * 128 + ec * 2);
          const float rv[8] = {blo(wr.x), bhi(wr.x), blo(wr.y), bhi(wr.y), blo(wr.z), bhi(wr.z), blo(wr.w), bhi(wr.w)}, kv[8] = {blo(wk.x), bhi(wk.x), blo(wk.y), bhi(wk.y), blo(wk.z), bhi(wk.z), blo(wk.w), bhi(wk.w)};
          const float kkv[8] = {blo(wkk.x), bhi(wkk.x), blo(wkk.y), bhi(wkk.y), blo(wkk.z), bhi(wkk.z), blo(wkk.w), bhi(wkk.w)}, bbv[8] = {blo(wbb.x), bhi(wbb.x), blo(wbb.y), bhi(wbb.y), blo(wbb.z), bhi(wbb.z), blo(wbb.w), bhi(wbb.w)};
          unsigned short ab[8], bb_[8], kb_[8], rb[8];
#pragma unroll
          for (int e = 0; e < 8; ++e) { const float ep = fexp_(lg[e]), en = fexp_(-lg[e]), epv = fexp_(lgp[e]);
              ab[e] = (unsigned short)f2bf(-kkv[e] * kiv * epv); bb_[e] = (unsigned short)f2bf(bbv[e] * kiv * en); kb_[e] = (unsigned short)f2bf(kv[e] * en); rb[e] = (unsigned short)f2bf(rv[e] * ep); }
#define PK8(x) (u32x4){(unsigned)x[0] | ((unsigned)x[1] << 16), (unsigned)x[2] | ((unsigned)x[3] << 16), (unsigned)x[4] | ((unsigned)x[5] << 16), (unsigned)x[6] | ((unsigned)x[7] << 16)}
          *(LAS u32x4*)(AT + et * ST + ec * 2) = PK8(ab); *(LAS u32x4*)(BT + et * ST + ec * 2) = PK8(bb_); *(LAS u32x4*)(KT + et * ST + ec * 2) = PK8(kb_); *(LAS u32x4*)(RT + et * ST + ec * 2) = PK8(rb);
#undef PK8
#pragma unroll
          for (int e = 0; e < 8; ++e) { *(LAS unsigned short*)(BTT + (ec + e) * ST + et * 2) = bb_[e]; *(LAS unsigned short*)(KTT + (ec + e) * ST + et * 2) = kb_[e]; } }
        __syncthreads();
        bf16x8_t ppk[2], qpk[2];
        if (wave < 4) { const int tt = wave; const bf16x8_t r0 = RD8(RT + (16 * tt + li) * ST + quad * 16), r1 = RD8(RT + (16 * tt + li) * ST + 64 + quad * 16);
            u32x2 pw[4], qw[4];
#pragma unroll
            for (int jt = 0; jt < 4; ++jt) { f32x4 pa = {0.f, 0.f, 0.f, 0.f}, qa = pa;
                pa = MF32(RD8(BT + (16 * jt + li) * ST + quad * 16), r0, pa); pa = MF32(RD8(BT + (16 * jt + li) * ST + 64 + quad * 16), r1, pa);
                qa = MF32(RD8(KT + (16 * jt + li) * ST + quad * 16), r0, qa); qa = MF32(RD8(KT + (16 * jt + li) * ST + 64 + quad * 16), r1, qa);
#pragma unroll
                for (int e = 0; e < 4; ++e) { const bool keep = (16 * jt + 4 * quad + e) <= (16 * tt + li); pa[e] = keep ? pa[e] : 0.f; qa[e] = keep ? qa[e] : 0.f; }
                pw[jt] = (u32x2){pg8::cvt_pk_bf16(pa[0], pa[1]), pg8::cvt_pk_bf16(pa[2], pa[3])}; qw[jt] = (u32x2){pg8::cvt_pk_bf16(qa[0], qa[1]), pg8::cvt_pk_bf16(qa[2], qa[3])}; }
            ppk[0] = __builtin_bit_cast(bf16x8_t, (u32x4){pw[0].x, pw[0].y, pw[1].x, pw[1].y}); ppk[1] = __builtin_bit_cast(bf16x8_t, (u32x4){pw[2].x, pw[2].y, pw[3].x, pw[3].y});
            qpk[0] = __builtin_bit_cast(bf16x8_t, (u32x4){qw[0].x, qw[0].y, qw[1].x, qw[1].y}); qpk[1] = __builtin_bit_cast(bf16x8_t, (u32x4){qw[2].x, qw[2].y, qw[3].x, qw[3].y});
            { f32x4 na = {0.f, 0.f, 0.f, 0.f};
              na = MF32(RD8(AT + (16 * tt + li) * ST + quad * 16), RD8(BT + (16 * tt + li) * ST + quad * 16), na); na = MF32(RD8(AT + (16 * tt + li) * ST + 64 + quad * 16), RD8(BT + (16 * tt + li) * ST + 64 + quad * 16), na);
#pragma unroll
              for (int e = 0; e < 4; ++e) ND[tt * 272 + (4 * quad + e) * 17 + li] = (li < 4 * quad + e) ? na[e] : 0.f;
              LDS_WAIT(); asm volatile("" ::: "memory");
              if (lane < 16) { float x[16];
#pragma unroll
                  for (int t = 0; t < 16; ++t) { float sacc = (t == lane) ? 1.f : 0.f;
#pragma unroll
                      for (int q = 0; q < t; ++q) sacc += ND[tt * 272 + t * 17 + q] * x[q];
                      x[t] = sacc; *(LAS unsigned short*)(DB + tt * 768 + t * 48 + lane * 2) = (unsigned short)f2bf(sacc); } } }
        } else { const int rw = wave - 4; const bf16x8_t a0 = RD8(AT + (16 * rw + li) * ST + quad * 16), a1 = RD8(AT + (16 * rw + li) * ST + 64 + quad * 16);
            ppk[0] = (bf16x8_t){0, 0, 0, 0, 0, 0, 0, 0}; ppk[1] = ppk[0]; qpk[0] = ppk[0]; qpk[1] = ppk[0];
#pragma unroll
            for (int jt = 0; jt < 4; ++jt) { f32x4 na = {0.f, 0.f, 0.f, 0.f}, ma = na;
                if (jt <= rw) { na = MF32(a0, RD8(BT + (16 * jt + li) * ST + quad * 16), na); na = MF32(a1, RD8(BT + (16 * jt + li) * ST + 64 + quad * 16), na);
                                ma = MF32(a0, RD8(KT + (16 * jt + li) * ST + quad * 16), ma); ma = MF32(a1, RD8(KT + (16 * jt + li) * ST + 64 + quad * 16), ma); }
#pragma unroll
                for (int e = 0; e < 4; ++e) { const int tr = 16 * rw + 4 * quad + e, jc = 16 * jt + li; const bool keep = jc < tr; const float nv = keep ? na[e] : 0.f, mv = keep ? ma[e] : 0.f;
                    *(LAS unsigned short*)(NB + tr * ST + jc * 2) = (unsigned short)f2bf(nv); *(LAS unsigned short*)(MB + tr * ST + jc * 2) = (unsigned short)f2bf(mv);
                    } }
        }
        __syncthreads();
        { const int cw = wave & 3; f32x4 rhs[4];
          if (wave < 4) {
#pragma unroll
              for (int i = 0; i < 4; ++i)
#pragma unroll
                  for (int e = 0; e < 4; ++e) rhs[i][e] = bf2f(*(const LAS unsigned short*)(AT + (16 * i + 4 * quad + e) * ST + (16 * cw + li) * 2));
          } else { const bf16x8_t v0 = RD8(VTl + (16 * cw + li) * ST + quad * 16), v1 = RD8(VTl + (16 * cw + li) * ST + 64 + quad * 16);
#pragma unroll
              for (int i = 0; i < 4; ++i) { f32x4 a = {0.f, 0.f, 0.f, 0.f}; a = MF32(RD8(MB + (16 * i + li) * ST + quad * 16), v0, a); a = MF32(RD8(MB + (16 * i + li) * ST + 64 + quad * 16), v1, a); rhs[i] = a; } }
          LAS unsigned char* XT = (wave < 4) ? WMT : UMT; bf16x4_t xb[4];
#pragma unroll
          for (int i = 0; i < 4; ++i) { f32x4 acc = rhs[i];
#pragma unroll
              for (int kb = 0; kb < 4; ++kb) if (kb < i) acc = MF16(RD4(NB + (16 * i + li) * ST + (16 * kb + 4 * quad) * 2), xb[kb], acc);
              const u32x2 aw = {pg8::cvt_pk_bf16(acc[0], acc[1]), pg8::cvt_pk_bf16(acc[2], acc[3])};
              f32x4 x = {0.f, 0.f, 0.f, 0.f}; x = MF16(RD4(DB + i * 768 + li * 48 + quad * 8), __builtin_bit_cast(bf16x4_t, aw), x);
              const u32x2 xw = {pg8::cvt_pk_bf16(x[0], x[1]), pg8::cvt_pk_bf16(x[2], x[3])}; xb[i] = __builtin_bit_cast(bf16x4_t, xw);
              *(LAS u32x2*)(XT + (16 * cw + li) * ST + (16 * i + 4 * quad) * 2) = xw; } }
        __syncthreads();
        if (wave < 4) { const int tt = wave; const int tg = 16 * tt + li;
            bf16* rmo = RM + (size_t)it * 4096 + tg * 64; bf16* y0o = Y0 + (size_t)it * 4096 + tg * 64;
#pragma unroll
            for (int ct = 0; ct < 4; ++ct) { const u32x2 rw2 = *(const LAS u32x2*)(RT + tg * ST + (16 * ct + 4 * quad) * 2); f32x4 acc = {blo(rw2.x), bhi(rw2.x), blo(rw2.y), bhi(rw2.y)};
#pragma unroll
                for (int s2 = 0; s2 < 2; ++s2) { const LAS unsigned char* wp = WMT + (16 * ct + li) * ST + (32 * s2 + 4 * quad) * 2; const u32x2 lo = *(const LAS u32x2*)wp, hi = *(const LAS u32x2*)(wp + 32);
                    acc = MF32(__builtin_bit_cast(bf16x8_t, (u32x4){lo.x, lo.y, hi.x, hi.y}), ppk[s2], acc); }
                *(u32x2*)(rmo + 16 * ct + 4 * quad) = (u32x2){pg8::cvt_pk_bf16(acc[0], acc[1]), pg8::cvt_pk_bf16(acc[2], acc[3])}; }
#pragma unroll
            for (int vt = 0; vt < 4; ++vt) { f32x4 acc = {0.f, 0.f, 0.f, 0.f};
#pragma unroll
                for (int s2 = 0; s2 < 2; ++s2) { const LAS unsigned char* up = UMT + (16 * vt + li) * ST + (32 * s2 + 4 * quad) * 2; const u32x2 ulo = *(const LAS u32x2*)up, uhi = *(const LAS u32x2*)(up + 32);
                    acc = MF32(__builtin_bit_cast(bf16x8_t, (u32x4){ulo.x, ulo.y, uhi.x, uhi.y}), ppk[s2], acc);
                    const LAS unsigned char* vp = VTl + (16 * vt + li) * ST + (32 * s2 + 4 * quad) * 2; const u32x2 vlo = *(const LAS u32x2*)vp, vhi = *(const LAS u32x2*)(vp + 32);
                    acc = MF32(__builtin_bit_cast(bf16x8_t, (u32x4){vlo.x, vlo.y, vhi.x, vhi.y}), qpk[s2], acc); }
                *(u32x2*)(y0o + 16 * vt + 4 * quad) = (u32x2){pg8::cvt_pk_bf16(acc[0], acc[1]), pg8::cvt_pk_bf16(acc[2], acc[3])}; }
        } else { const int xt = wave - 4;
            const bf16x8_t bt0 = RD8(BTT + (16 * xt + li) * ST + quad * 16), bt1 = RD8(BTT + (16 * xt + li) * ST + 64 + quad * 16);
            const float gc2 = GC[16 * xt + li]; bf16* pco = PCT + (size_t)it * 4096 + (16 * xt + li) * 64;
#pragma unroll
            for (int c1 = 0; c1 < 4; ++c1) { f32x4 acc = {0.f, 0.f, 0.f, 0.f};
                acc = MF32(RD8(WMT + (16 * c1 + li) * ST + quad * 16), bt0, acc); acc = MF32(RD8(WMT + (16 * c1 + li) * ST + 64 + quad * 16), bt1, acc);
                float o[4];
#pragma unroll
                for (int e = 0; e < 4; ++e) o[e] = gc2 * (acc[e] + (((16 * c1 + 4 * quad + e) == (16 * xt + li)) ? 1.f : 0.f));
                *(u32x2*)(pco + 16 * c1 + 4 * quad) = (u32x2){pg8::cvt_pk_bf16(o[0], o[1]), pg8::cvt_pk_bf16(o[2], o[3])}; }
            const bf16x8_t um0 = RD8(UMT + (16 * xt + li) * ST + quad * 16), um1 = RD8(UMT + (16 * xt + li) * ST + 64 + quad * 16), vt0 = RD8(VTl + (16 * xt + li) * ST + quad * 16), vt1 = RD8(VTl + (16 * xt + li) * ST + 64 + quad * 16);
            bf16* lco = LC + (size_t)it * 4096 + (16 * xt + li) * 64;
#pragma unroll
            for (int ct = 0; ct < 4; ++ct) { f32x4 acc = {0.f, 0.f, 0.f, 0.f};
                acc = MF32(RD8(BTT + (16 * ct + li) * ST + quad * 16), um0, acc); acc = MF32(RD8(BTT + (16 * ct + li) * ST + 64 + quad * 16), um1, acc);
                acc = MF32(RD8(KTT + (16 * ct + li) * ST + quad * 16), vt0, acc); acc = MF32(RD8(KTT + (16 * ct + li) * ST + 64 + quad * 16), vt1, acc);
                const f32x4 g4 = *(const LAS f32x4*)(GC + 16 * ct + 4 * quad);
                *(u32x2*)(lco + 16 * ct + 4 * quad) = (u32x2){pg8::cvt_pk_bf16(acc[0] * g4.x, acc[1] * g4.y), pg8::cvt_pk_bf16(acc[2] * g4.z, acc[3] * g4.w)}; }
        }
      }
    }
#undef F1LOAD
#undef MF32
#undef MF16
#undef RD8
#undef RD4
    __syncthreads();
}
template <int MODE> DI void state_scan16(Frame& F) {
    constexpr int SLOT = 18432, NSL = 6;
    const bf16* PT = (const bf16*)(WSP(F) + (MODE == 1 ? WS_PGT : WS_PCT)); const bf16* LL = (const bf16*)(WSP(F) + (MODE == 1 ? WS_LG : WS_LC));
    LAS unsigned char* ring = F.lds;
    const int nitems = (MODE == 1) ? BATCH * 8 : BATCH * 8 * 16;
#define RBAR() do { asm volatile("s_waitcnt lgkmcnt(0)" ::: "memory"); __builtin_amdgcn_s_barrier(); asm volatile("" ::: "memory"); } while (0)
    for (int it = F.bid; it < nitems; it += F.G) {
        int tid = F.tid; asm volatile("" : "+v"(tid));
        const int lane = tid & 63, wave = __builtin_amdgcn_readfirstlane(tid >> 6), vl = lane & 15, quad = lane >> 4;
        const size_t opbase = (MODE == 1) ? (size_t)it * 16 * 4096 : (size_t)((it >> 4) * 256 + (it & 15) * 16) * 4096;
        const bf16* pt = PT + opbase; const bf16* ll = LL + opbase;
        __syncthreads();
        const unsigned loffp = (unsigned)((tid >> 3) * 144 + (tid & 7) * 16), loffl = 9216u + loffp;
        u32x4 rg[4][2];
#define SLOAD(q, x) do { rg[q][0] = *((const u32x4*)(pt + (size_t)(x) * 4096) + tid); rg[q][1] = *((const u32x4*)(ll + (size_t)(x) * 4096) + tid); } while (0)
#define SWRITE(q, x) do { LAS unsigned char* d_ = ring + ((x) % NSL) * SLOT; *(LAS u32x4*)(d_ + loffp) = rg[q][0]; *(LAS u32x4*)(d_ + loffl) = rg[q][1]; } while (0)
        SLOAD(0, 0); SLOAD(1, 1); SLOAD(2, 2); SLOAD(3, 3);
        SWRITE(0, 0); SWRITE(1, 1);
        SLOAD(0, 4); SLOAD(1, 5);
        const bool pwave = (MODE == 0) && (wave < 4); const bool active = (MODE == 0) || (wave < 4); const int vb = wave & 3;
        f32x4 st[4];
#pragma unroll
        for (int kt = 0; kt < 4; ++kt) { st[kt] = (f32x4){0.f, 0.f, 0.f, 0.f};
            if (pwave) {
#pragma unroll
                for (int j = 0; j < 4; ++j) st[kt][j] = ((16 * kt + 4 * quad + j) == (16 * vb + vl)) ? 1.f : 0.f; }
            if (MODE == 2 && active) { const u32x2 w = *(const u32x2*)((const bf16*)(WSP(F) + WS_SG) + (size_t)it * 4096 + (16 * vb + vl) * 64 + 16 * kt + 4 * quad); st[kt] = (f32x4){blo(w.x), bhi(w.x), blo(w.y), bhi(w.y)}; } }
        const unsigned aoff = (unsigned)(vl * 144 + quad * 8), loffc = (unsigned)(9216 + (16 * vb + vl) * 144 + quad * 8);
        RBAR();
#pragma unroll
        for (int c = 0; c < 16; ++c) {
            if (c + 2 < 16) { SWRITE((c + 2) & 3, c + 2); if (c + 6 < 16) SLOAD((c + 2) & 3, c + 6); }
            if (active) {
                const LAS unsigned char* sl = ring + (c % NSL) * SLOT;
                bf16x8_t bfr[2];
                { u32x2 pk[4];
#pragma unroll
                  for (int kt = 0; kt < 4; ++kt) { pk[kt] = (u32x2){pg8::cvt_pk_bf16(st[kt][0], st[kt][1]), pg8::cvt_pk_bf16(st[kt][2], st[kt][3])};
                      if (MODE == 1) *(u32x2*)((bf16*)(WSP(F) + WS_SG) + ((size_t)it * 16 + c) * 4096 + (16 * vb + vl) * 64 + 16 * kt + 4 * quad) = pk[kt];
                      if (MODE == 2) *(u32x2*)((bf16*)(WSP(F) + WS_S0) + (opbase + (size_t)c * 4096) + (16 * vb + vl) * 64 + 16 * kt + 4 * quad) = pk[kt]; }
                  bfr[0] = __builtin_bit_cast(bf16x8_t, (u32x4){pk[0].x, pk[0].y, pk[1].x, pk[1].y}); bfr[1] = __builtin_bit_cast(bf16x8_t, (u32x4){pk[2].x, pk[2].y, pk[3].x, pk[3].y}); }
#pragma unroll
                for (int kt = 0; kt < 4; ++kt) { f32x4 acc = {0.f, 0.f, 0.f, 0.f};
                    if (!pwave) { const u32x2 lf = *(const LAS u32x2*)(sl + loffc + kt * 32); acc = (f32x4){blo(lf.x), bhi(lf.x), blo(lf.y), bhi(lf.y)}; }
#pragma unroll
                    for (int s2 = 0; s2 < 2; ++s2) { const u32x2 a0 = *(const LAS u32x2*)(sl + aoff + kt * 16 * 144 + s2 * 64), a1 = *(const LAS u32x2*)(sl + aoff + kt * 16 * 144 + s2 * 64 + 32);
                        acc = __builtin_amdgcn_mfma_f32_16x16x32_bf16(__builtin_bit_cast(bf16x8_t, (u32x4){a0.x, a0.y, a1.x, a1.y}), bfr[s2], acc, 0, 0, 0); }
                    st[kt] = acc; }
            }
            RBAR();
        }
        if (MODE == 0) {
            bf16* pg = (bf16*)(WSP(F) + WS_PGT) + (size_t)it * 4096; bf16* lg = (bf16*)(WSP(F) + WS_LG) + (size_t)it * 4096;
#pragma unroll
            for (int kt = 0; kt < 4; ++kt) {
                if (pwave) {
#pragma unroll
                    for (int j = 0; j < 4; ++j) pg[(16 * kt + 4 * quad + j) * 64 + 16 * vb + vl] = (bf16)f2bf(st[kt][j]);
                } else *(u32x2*)(lg + (16 * vb + vl) * 64 + 16 * kt + 4 * quad) = (u32x2){pg8::cvt_pk_bf16(st[kt][0], st[kt][1]), pg8::cvt_pk_bf16(st[kt][2], st[kt][3])}; }
        }
#undef SLOAD
#undef SWRITE
    }
#undef RBAR
    __syncthreads();
}
DI void rwkv_out_phase(Frame& F, int l) {
    bf16* AR = (bf16*)(WSP(F) + WS_AR); const size_t AS = (size_t)T * 512; const float* bonus = (const float*)(WSP(F) + WS_BONUS);
    const bf16* RM = (const bf16*)(WSP(F) + WS_RM); const bf16* Y0 = (const bf16*)(WSP(F) + WS_Y0); const bf16* S0 = (const bf16*)(WSP(F) + WS_S0);
    const int gw = F.bid * 8 + F.wave, NGW = F.G * 8, lane = F.lane, li = lane & 15, quad = lane >> 4;
    for (int it = gw; it < BATCH * 8 * (SEQ / 64); it += NGW) {
        const int bh = it >> 8, ck = it & 255, b = bh >> 3, h = bh & 7;
        const bf16* s0 = S0 + (size_t)it * 4096; const bf16* rm = RM + (size_t)it * 4096; const bf16* y0 = Y0 + (size_t)it * 4096;
        bf16x8_t sa[4][2];
#pragma unroll
        for (int vt = 0; vt < 4; ++vt)
#pragma unroll
            for (int s2 = 0; s2 < 2; ++s2) sa[vt][s2] = *(const bf16x8_t*)(s0 + (16 * vt + li) * 64 + 32 * s2 + 8 * quad);
        float lg[4][4], lb[4][4];
#pragma unroll
        for (int vt = 0; vt < 4; ++vt) { const f32x4 g4 = *(const f32x4*)(INP(F, 14) + l * 512 + h * 64 + 16 * vt + 4 * quad), b4 = *(const f32x4*)(INP(F, 15) + l * 512 + h * 64 + 16 * vt + 4 * quad);
            lg[vt][0] = g4.x; lg[vt][1] = g4.y; lg[vt][2] = g4.z; lg[vt][3] = g4.w; lb[vt][0] = b4.x; lb[vt][1] = b4.y; lb[vt][2] = b4.z; lb[vt][3] = b4.w; }
#pragma unroll 1
        for (int tt = 0; tt < 4; ++tt) {
            const int tch = 16 * tt + li; const size_t t = (size_t)b * SEQ + ck * 64 + tch;
            bf16x8_t rb[2];
#pragma unroll
            for (int s2 = 0; s2 < 2; ++s2) rb[s2] = *(const bf16x8_t*)(rm + tch * 64 + 32 * s2 + 8 * quad);
            f32x4 acc[4];
#pragma unroll
            for (int vt = 0; vt < 4; ++vt) { const u32x2 yw = *(const u32x2*)(y0 + tch * 64 + 16 * vt + 4 * quad); acc[vt] = (f32x4){blo(yw.x), bhi(yw.x), blo(yw.y), bhi(yw.y)};
                acc[vt] = __builtin_amdgcn_mfma_f32_16x16x32_bf16(sa[vt][0], rb[0], acc[vt], 0, 0, 0); acc[vt] = __builtin_amdgcn_mfma_f32_16x16x32_bf16(sa[vt][1], rb[1], acc[vt], 0, 0, 0); }
            float sm = 0.f;
#pragma unroll
            for (int vt = 0; vt < 4; ++vt) sm += (acc[vt][0] + acc[vt][1]) + (acc[vt][2] + acc[vt][3]);
            sm += __shfl_xor(sm, 16); sm += __shfl_xor(sm, 32);
            const float mean = sm * (1.f / 64.f); float sq = 0.f;
#pragma unroll
            for (int vt = 0; vt < 4; ++vt)
#pragma unroll
                for (int e = 0; e < 4; ++e) { const float d = acc[vt][e] - mean; acc[vt][e] = d; sq += d * d; }
            sq += __shfl_xor(sq, 16); sq += __shfl_xor(sq, 32);
            const float rstd = rsqrtf(sq * (1.f / 64.f) + 64e-5f), bon = bonus[t * 8 + h];
            const size_t idx = t * 512 + h * 64 + 4 * quad;
#pragma unroll
            for (int vt = 0; vt < 4; ++vt) { const u32x2 vw = *(const u32x2*)(AR + 3 * AS + idx + 16 * vt), gw2 = *(const u32x2*)(AR + 6 * AS + idx + 16 * vt);
                const float vv[4] = {blo(vw.x), bhi(vw.x), blo(vw.y), bhi(vw.y)}, gg[4] = {blo(gw2.x), bhi(gw2.x), blo(gw2.y), bhi(gw2.y)}; float o[4];
#pragma unroll
                for (int e = 0; e < 4; ++e) o[e] = (acc[vt][e] * rstd * lg[vt][e] + lb[vt][e] + bon * vv[e]) * gg[e];
                *(u32x2*)(AR + idx + 16 * vt) = (u32x2){pk2(o[0], o[1]), pk2(o[2], o[3])}; }
        }
    }
}
DI void route_phase(Frame& F, int l) {
    const float* x = OUTP(F); bf16* h2 = (bf16*)(WSP(F) + WS_XB); const bf16* RWH = (const bf16*)(WSP(F) + WS_RWG); const bf16* RWL = RWH + 48 * 1024;
    int* route = (int*)(WSP(F) + WS_ROUTE); float* rwt = (float*)(WSP(F) + WS_RWT); unsigned* cnt = (unsigned*)(WSP(F) + WS_CTL) + CW_CNT + 32 * l;
    const float* rgb = INP(F, 24) + l * 4; const float* reb = INP(F, 26) + l * 32;
    LAS unsigned* lc = (LAS unsigned*)(F.lds + MISC_OFF + 8192); unsigned* wgbase = (unsigned*)(WSP(F) + WS_WGBASE);
    for (int wit = F.bid; wit < T / 128; wit += F.G) {
        int lane = F.lane; asm volatile("" : "+v"(lane));
        __syncthreads();
        if (F.tid < 32) lc[F.tid] = 0u;
        __syncthreads();
        const int it = wit * 8 + F.wave;
        const int li = lane & 15, quad = lane >> 4; const size_t t = (size_t)it * 16 + li;
        const float* xr = x + t * DM + 8 * quad;
        f32x4 acc[3];
#pragma unroll
        for (int jt = 0; jt < 3; ++jt) acc[jt] = (f32x4){0.f, 0.f, 0.f, 0.f};
        float ss = 0.f;
        LAS unsigned char* wbuf = F.lds;
        u32x4 wst[3]; f32x4 xc[8], xn[8];
#define WLOAD(kc) do { _Pragma("unroll") for (int i = 0; i < 3; ++i) { const int p_ = F.tid + 512 * i, hl_ = p_ / 768, q_ = p_ % 768, r_ = q_ >> 4, c_ = q_ & 15; \
            wst[i] = *(const u32x4*)((hl_ ? RWL : RWH) + (size_t)r_ * 1024 + (kc) * 128 + c_ * 8); } } while (0)
#define WSTORE(bf) do { _Pragma("unroll") for (int i = 0; i < 3; ++i) { const int p_ = F.tid + 512 * i, hl_ = p_ / 768, q_ = p_ % 768, r_ = q_ >> 4, c_ = q_ & 15; \
            *(LAS u32x4*)(wbuf + (bf) * 26112 + hl_ * 13056 + r_ * 272 + c_ * 16) = wst[i]; } } while (0)
#define XLOAD(dst, kc) do { _Pragma("unroll") for (int k_ = 0; k_ < 4; ++k_) { dst[2 * k_] = *(const f32x4*)(xr + (kc) * 128 + 32 * k_); dst[2 * k_ + 1] = *(const f32x4*)(xr + (kc) * 128 + 32 * k_ + 4); } } while (0)
        WLOAD(0); XLOAD(xc, 0);
        WSTORE(0);
        __syncthreads();
#pragma unroll
        for (int kc = 0; kc < 8; ++kc) {
            if (kc < 7) { WLOAD(kc + 1); XLOAD(xn, kc + 1); }
            const LAS unsigned char* wb = wbuf + (kc & 1) * 26112;
#pragma unroll
            for (int k4 = 0; k4 < 4; ++k4) {
                const f32x4 x0 = xc[2 * k4], x1 = xc[2 * k4 + 1];
                ss += (x0.x * x0.x + x0.y * x0.y) + (x0.z * x0.z + x0.w * x0.w) + (x1.x * x1.x + x1.y * x1.y) + (x1.z * x1.z + x1.w * x1.w);
                const unsigned h0 = pk2(x0.x, x0.y), h1 = pk2(x0.z, x0.w), h2_ = pk2(x1.x, x1.y), h3 = pk2(x1.z, x1.w);
                const bf16x8_t bh = __builtin_bit_cast(bf16x8_t, (u32x4){h0, h1, h2_, h3});
                const bf16x8_t bl = __builtin_bit_cast(bf16x8_t, (u32x4){pk2(x0.x - blo(h0), x0.y - bhi(h0)), pk2(x0.z - blo(h1), x0.w - bhi(h1)), pk2(x1.x - blo(h2_), x1.y - bhi(h2_)), pk2(x1.z - blo(h3), x1.w - bhi(h3))});
#pragma unroll
                for (int jt = 0; jt < 3; ++jt) { const LAS unsigned char* wp = wb + (16 * jt + li) * 272 + k4 * 64 + quad * 16;
                    const bf16x8_t wh = *(const LAS bf16x8_t*)wp, wl = *(const LAS bf16x8_t*)(wp + 13056);
                    acc[jt] = __builtin_amdgcn_mfma_f32_16x16x32_bf16(wh, bh, acc[jt], 0, 0, 0);
                    acc[jt] = __builtin_amdgcn_mfma_f32_16x16x32_bf16(wl, bh, acc[jt], 0, 0, 0);
                    acc[jt] = __builtin_amdgcn_mfma_f32_16x16x32_bf16(wh, bl, acc[jt], 0, 0, 0); }
            }
            if (kc < 7) { WSTORE((kc + 1) & 1);
#pragma unroll
                for (int i = 0; i < 8; ++i) xc[i] = xn[i]; }
            __syncthreads();
        }
#undef WLOAD
#undef WSTORE
#undef XLOAD
        ss += __shfl_xor(ss, 16); ss += __shfl_xor(ss, 32);
        const float rs = rsqrtf(ss * (1.f / DM) + 1e-6f);
#pragma unroll 4
        for (int ks = 0; ks < 32; ++ks) { const f32x4 x0 = *(const f32x4*)(xr + 32 * ks), x1 = *(const f32x4*)(xr + 32 * ks + 4);
            *(u32x4*)(h2 + t * DM + 32 * ks + 8 * quad) = (u32x4){pk2(x0.x * rs, x0.y * rs), pk2(x0.z * rs, x0.w * rs), pk2(x1.x * rs, x1.y * rs), pk2(x1.z * rs, x1.w * rs)}; }
        float gl[4]; int grp = 0;
#pragma unroll
        for (int j = 0; j < 4; ++j) gl[j] = acc[0][j] * rs + rgb[j];
        float gm = gl[0];
#pragma unroll
        for (int j = 1; j < 4; ++j) if (gl[j] > gm) { gm = gl[j]; grp = j; }
        if (quad == grp) {
            float gs = 0.f;
#pragma unroll
            for (int j = 0; j < 4; ++j) gs += __expf(gl[j] - gm);
            const float gprob = frcp_(gs);
            float eg[8];
#pragma unroll
            for (int i = 0; i < 4; ++i) { eg[i] = acc[1][i] * rs + reb[8 * quad + i]; eg[4 + i] = acc[2][i] * rs + reb[8 * quad + 4 + i]; }
            int i0 = 0; float m0 = eg[0];
#pragma unroll
            for (int i = 1; i < 8; ++i) if (eg[i] > m0) { m0 = eg[i]; i0 = i; }
            int i1 = -1; float m1 = -INFINITY;
#pragma unroll
            for (int i = 0; i < 8; ++i) if (i != i0 && eg[i] > m1) { m1 = eg[i]; i1 = i; }
            const float e10 = fexp_(m1 - m0), r10 = frcp_(1.0f + e10), wa = gprob * r10, wb = gprob * e10 * r10;
            const int e0 = grp * 8 + i0, e1 = grp * 8 + i1;
            const unsigned r0 = atomicAdd((unsigned*)(lc + e0), 1u), r1 = atomicAdd((unsigned*)(lc + e1), 1u);
            ((int4*)route)[t] = make_int4(e0, (int)r0, e1, (int)r1); ((float2*)rwt)[t] = make_float2(wa, wb);
        }
        __syncthreads();
        if (F.tid < 32) { const unsigned c = lc[F.tid]; wgbase[wit * 32 + F.tid] = c ? atomicAdd(cnt + F.tid, c) : 0u; }
    }
    __syncthreads();
}
DI int moe_tables(Frame& F, int l) {
    LAS int* ps = (LAS int*)(F.lds + MISC_OFF); LAS unsigned char* te = (LAS unsigned char*)(F.lds + MISC_OFF + 256);
    const unsigned* cnt = (const unsigned*)(WSP(F) + WS_CTL) + CW_CNT + 32 * l;
    __syncthreads();
    if (F.tid == 0) { int acc = 0;
_Pragma("unroll 1")
        for (int e = 0; e < NEXP; ++e) { ps[e] = acc; const int c = (int)__hip_atomic_load(cnt + e, __ATOMIC_RELAXED, __HIP_MEMORY_SCOPE_AGENT); const int nt = (c + 255) >> 8;
_Pragma("unroll 1")
            for (int i = 0; i < nt; ++i) te[(acc >> 8) + i] = (unsigned char)e; acc += nt << 8; } ps[NEXP] = acc; }
    __syncthreads();
    return __builtin_amdgcn_readfirstlane(ps[NEXP] >> 8);
}
DI void permute_phase(Frame& F, int l) {
    moe_tables(F, l);
    const LAS int* ps = (const LAS int*)(F.lds + MISC_OFF);
    const bf16* h2 = (const bf16*)(WSP(F) + WS_XB); bf16* xp = (bf16*)(WSP(F) + WS_XPERM); const int* route = (const int*)(WSP(F) + WS_ROUTE); int* dest = (int*)(WSP(F) + WS_DEST);
    const int gw = F.bid * 8 + F.wave, NGW = F.G * 8, lane = F.lane;
    for (int t = gw; t < T; t += NGW) {
        const int4 r = ((const int4*)route)[t]; const unsigned* wb_ = (const unsigned*)(WSP(F) + WS_WGBASE) + (t >> 7) * 32; const int d0 = ps[r.x] + (int)wb_[r.x] + r.y, d1 = ps[r.z] + (int)wb_[r.z] + r.w;
        const u32x4* src = (const u32x4*)(h2 + (size_t)t * DM) + lane; u32x4* o0 = (u32x4*)(xp + (size_t)d0 * DM) + lane; u32x4* o1 = (u32x4*)(xp + (size_t)d1 * DM) + lane;
        const u32x4 a = src[0], b = src[64]; o0[0] = a; o0[64] = b; o1[0] = a; o1[64] = b;
        if (lane == 0) ((int2*)dest)[t] = make_int2(d0, d1);
    }
}
DI void combine_phase(Frame& F, int l) {
    float* x = OUTP(F); const bf16* Y = (const bf16*)(WSP(F) + WS_YMOE); const int* dest = (const int*)(WSP(F) + WS_DEST); const float* rwt = (const float*)(WSP(F) + WS_RWT);
    bf16* xb = (bf16*)(WSP(F) + WS_XB); const float* fg = INP(F, 30);
    const int gw = F.bid * 8 + F.wave, NGW = F.G * 8, lane = F.lane; const bool last = (l == DEPTH - 1);
    for (int t = gw; t < T; t += NGW) {
        const int2 d = ((const int2*)dest)[t]; const float2 w = ((const float2*)rwt)[t];
        f32x4* xr = (f32x4*)(x + (size_t)t * DM) + lane; const u32x2* y0 = (const u32x2*)(Y + (size_t)d.x * DM) + lane; const u32x2* y1 = (const u32x2*)(Y + (size_t)d.y * DM) + lane;
        f32x4 v[4]; float s = 0.f;
#pragma unroll
        for (int j = 0; j < 4; ++j) { v[j] = xr[64 * j]; const u32x2 a = y0[64 * j], b = y1[64 * j];
            v[j].x += w.x * blo(a.x) + w.y * blo(b.x); v[j].y += w.x * bhi(a.x) + w.y * bhi(b.x); v[j].z += w.x * blo(a.y) + w.y * blo(b.y); v[j].w += w.x * bhi(a.y) + w.y * bhi(b.y);
            s += (v[j].x * v[j].x + v[j].y * v[j].y) + (v[j].z * v[j].z + v[j].w * v[j].w); }
        const float rs = rsqrtf(wave_sum(s) * (1.f / DM) + 1e-6f);
        if (last) {
#pragma unroll
            for (int j = 0; j < 4; ++j) { const f32x4 g = ((const f32x4*)fg)[lane + 64 * j]; xr[64 * j] = v[j] * rs * g; }
        } else {
            u32x2* o = (u32x2*)(xb + (size_t)t * DM) + lane;
#pragma unroll
            for (int j = 0; j < 4; ++j) { xr[64 * j] = v[j]; o[64 * j] = (u32x2){pk2(v[j].x * rs, v[j].y * rs), pk2(v[j].z * rs, v[j].w * rs)}; }
        }
    }
}

DI void dump_bf16(Frame& F, const bf16* src, int pitch, int ncols, int c0) {
    float* out = OUTP(F);
    for (size_t i = (size_t)F.bid * 512 + F.tid; i < (size_t)T * ncols; i += (size_t)F.G * 512) { const size_t t = i / ncols; const int c = (int)(i % ncols); out[t * DM + c0 + c] = bf2f(src[t * pitch + c]); }
}
__global__ void __launch_bounds__(512, 2) mk_fwd(Args args) {
    extern __shared__ __attribute__((aligned(16))) unsigned char lds_raw[];
    cg::grid_group grid = cg::this_grid();
    Frame F; F.lds = (LAS unsigned char*)lds_raw; F.tid = threadIdx.x; F.lane = F.tid & 63; F.wave = __builtin_amdgcn_readfirstlane(F.tid >> 6); F.G = gridDim.x; F.bid = (int)__builtin_amdgcn_workgroup_id_x();
    F.kp = (kargp_t)__builtin_amdgcn_kernarg_segment_ptr();
    for (int u = F.tid; u < 64; u += 512) ((LAS unsigned*)(F.lds + MISC_OFF + 4096))[u] = 0u;
    __syncthreads();
    (void)xcd_barrier_post((unsigned*)(WSP(F) + WS_CTL) + CW_BAR, (volatile LAS unsigned*)(F.lds + MISC_OFF + 4096));
    grid.sync();
#define GRID_BAR() do { XcdBarrier bb_; bb_.bar = (unsigned*)(WSP(F) + WS_CTL) + CW_BAR; bb_.x = xb_xcc_id(); bb_.st = (volatile LAS unsigned*)(F.lds + MISC_OFF + 4096); xcd_barrier(bb_); fence_frame(F); } while (0)
#define ws WSP(F)
#if defined(DBG_TMASK)
#define PT0() const unsigned long long pt0_ = __builtin_amdgcn_s_memrealtime()
#define PT1(k) do { if ((DBG_TMASK >> (k)) & 1) { const unsigned long long n_ = __builtin_amdgcn_s_memrealtime(); const unsigned long long e_ = n_ + (unsigned long long)DBG_AMP * (n_ - pt0_); while (__builtin_amdgcn_s_memrealtime() < e_) __builtin_amdgcn_s_sleep(16); } } while (0)
#else
#define PT0() do {} while (0)
#define PT1(k) do {} while (0)
#endif
    { PT0(); prep_mixer_weights(F, 0);
    rms_rows_to_bf16(F, INP(F, 0), (bf16*)(ws + WS_XB));
    GRID_BAR(); PT1(0); }
#if defined(DBG_STOP) && DBG_STOP == 10
    { PT0(); { pg8::Gemm g{(const bf16*)(ws + WS_XB), (const bf16*)(ws + WS_WG), T, 3072, DM}; pg8::StaticOrder S; S.init(T, 3072, F.G, (int)F.bid);
      pg8::EpiGate E{(unsigned char*)(ws + WS_GATES), 3072};
      pg8::gemm_phase<pg8::EpiGate, pg8::StaticOrder, true, true>(F.lds, g, S, E); }
    GRID_BAR(); PT1(10); }
    dump_bf16(F, (const bf16*)(ws + WS_GATES) + 1024, 3072, 1024, 0); return;
#endif
#pragma unroll 1
    for (int l = 0; l < DEPTH; ++l) {
        { PT0(); { pg8::Gemm g{(const bf16*)(ws + WS_XB), (const bf16*)(ws + WS_WIN), T, l == 0 ? 3840 : 4096, DM}; pg8::StaticOrder S; S.init(T, g.N, F.G, (int)F.bid);
          pg8::EpiZ E{(bf16*)(ws + WS_Q), (bf16*)(ws + WS_K), (bf16*)(ws + WS_VT), (bf16*)(ws + WS_POOLZ), (bf16*)(ws + WS_RWKVZ), C2, SEQ};
          pg8::gemm_phase<pg8::EpiZ, pg8::StaticOrder, true, true>(F.lds, g, S, E); }
        GRID_BAR(); PT1(1); }
        { PT0(); kmean_phase(F);
        pool_phase(F, l);
        GRID_BAR(); PT1(2); }
        { PT0(); sel_phase(F, l);
        GRID_BAR(); PT1(3); }
        { PT0(); att_phase(F, l);
        GRID_BAR(); PT1(4); }
        { PT0(); comb_phase(F);
        GRID_BAR(); PT1(5); }
#if defined(DBG_STOP) && DBG_STOP == 3
        dump_bf16(F, (const bf16*)(ws + WS_YATTN), 512, 512, 0); dump_bf16(F, (const bf16*)(ws + WS_YPOOL), 512, 512, 512); return;
#endif

        { PT0(); rwkv_chunk_phase(F, l);
        GRID_BAR(); PT1(7); }
        { PT0(); state_scan16<0>(F);
        GRID_BAR();
        state_scan16<1>(F);
        GRID_BAR();
        state_scan16<2>(F);
        GRID_BAR(); PT1(8); }
        { PT0(); rwkv_out_phase(F, l);
        GRID_BAR(); PT1(9); }
        { pg8::Gemm g{(const bf16*)(ws + WS_XB), (const bf16*)(ws + WS_WG), T, 3072, DM}; pg8::StaticOrder S; S.init(T, 3072, F.G, (int)F.bid);
          pg8::EpiGate E{(unsigned char*)(ws + WS_GATES), 3072};
          pg8::gemm_phase<pg8::EpiGate, pg8::StaticOrder, true, true>(F.lds, g, S, E); }
        GRID_BAR();
#if defined(DBG_SCRUB)
        { const f32x4* xs = (const f32x4*)INP(F, 0) + (size_t)F.bid * 32768; f32x4 a = {0.f, 0.f, 0.f, 0.f};
          for (int i = F.tid; i < 32768; i += 512) a += xs[i];
          if (a.x + a.y + a.z + a.w == 12345.678f) ((float*)(ws + WS_BONUS))[F.tid] = a.x; }
        GRID_BAR();
#endif
        { PT0(); { pg8::StaticOrder S; S.init(T, DM, F.G, (int)F.bid);
          { pg8::Gemm g{(const bf16*)(ws + WS_YATTN), (const bf16*)(ws + WS_WBR), T, DM, 512};
            pg8::EpiMerge<true> E{(bf16*)(ws + WS_XB), DM, (const unsigned char*)(ws + WS_GATES), 3072, 0};
            pg8::gemm_phase<pg8::EpiMerge<true>, pg8::StaticOrder, true, true>(F.lds, g, S, E); }
          { pg8::Gemm g{(const bf16*)(ws + WS_AR), (const bf16*)(ws + WS_WBR) + (size_t)1024 * 512, T, DM, 512};
            pg8::EpiMerge<false> E{(bf16*)(ws + WS_XB), DM, (const unsigned char*)(ws + WS_GATES), 3072, 1024};
            pg8::gemm_phase<pg8::EpiMerge<false>, pg8::StaticOrder, true, true>(F.lds, g, S, E); }
          { pg8::Gemm g{(const bf16*)(ws + WS_YPOOL), (const bf16*)(ws + WS_WBR) + (size_t)2 * 1024 * 512, T, DM, 512};
            pg8::EpiMerge<false> E{(bf16*)(ws + WS_XB), DM, (const unsigned char*)(ws + WS_GATES), 3072, 2048};
            pg8::gemm_phase<pg8::EpiMerge<false>, pg8::StaticOrder, true, true>(F.lds, g, S, E); } }
        GRID_BAR(); PT1(11); }
#if defined(DBG_STOP) && DBG_STOP == 7
        dump_bf16(F, (const bf16*)(ws + WS_XB), 1024, 1024, 0); return;
#endif
#if defined(DBG_STOP) && DBG_STOP == 6
        dump_bf16(F, (const bf16*)(ws + WS_GATES) + 1024, 3072, 1024, 0); return;
#endif
        { PT0(); { pg8::Gemm g{(const bf16*)(ws + WS_XB), (const bf16*)(ws + WS_WOUT), T, DM, DM}; pg8::StaticOrder S; S.init(T, DM, F.G, (int)F.bid);
          pg8::EpiResF32 E{l == 0 ? INP(F, 0) : OUTP(F), OUTP(F), DM};
          pg8::gemm_phase<pg8::EpiResF32, pg8::StaticOrder, true, true>(F.lds, g, S, E); }
        GRID_BAR(); PT1(12); }
#if defined(DBG_STOP) && DBG_STOP == 1
        return;
#endif
        { PT0(); route_phase(F, l);
#if defined(DBG_TMASK)
        GRID_BAR(); PT1(13); } { PT0();
#endif
        prep_expert_weights(F, l);
        GRID_BAR(); PT1(18); }
        { PT0(); permute_phase(F, l);
        GRID_BAR(); PT1(14); }
        { const int ntile = moe_tables(F, l);
          const LAS unsigned char* te = (const LAS unsigned char*)(F.lds + MISC_OFF + 256);
          { PT0(); { pg8::Gemm g{(const bf16*)(ws + WS_XPERM), (const bf16*)(ws + WS_W13), RMAX, NEXP * 1024, DM}; pg8::MoeOrder S{te, ntile * 4, F.G, (int)F.bid};
            pg8::EpiSwiGLU E{(bf16*)(ws + WS_HACT)};
            pg8::gemm_phase<pg8::EpiSwiGLU, pg8::MoeOrder, true, true>(F.lds, g, S, E); }
          GRID_BAR(); PT1(15); }
          { PT0(); { pg8::Gemm g{(const bf16*)(ws + WS_HACT), (const bf16*)(ws + WS_W2), RMAX, NEXP * 1024, 512}; pg8::MoeOrder S{te, ntile * 4, F.G, (int)F.bid};
            pg8::EpiY E{(bf16*)(ws + WS_YMOE)};
            pg8::gemm_phase<pg8::EpiY, pg8::MoeOrder, true, true>(F.lds, g, S, E); }
        GRID_BAR(); PT1(16); } }
        { PT0(); combine_phase(F, l);
        if (l + 1 < DEPTH) prep_mixer_weights(F, l + 1);
        GRID_BAR(); PT1(17); }
#if defined(DBG_STOP) && DBG_STOP == 2
        return;
#endif
    }
#undef ws
}

extern "C" void kernel_launch(void* const* d_in, const int* in_sizes, int n_in, void* d_out, int out_size, void* d_ws, size_t ws_size, hipStream_t stream) {
    static int grid = 0;
    if (grid == 0) {
        if (n_in != 31 || out_size != T * DM || ws_size < WS_END) { fprintf(stderr, "kernel_launch: unexpected shapes (n_in %d out %d ws %zu, need %zu)\n", n_in, out_size, ws_size, (size_t)WS_END); grid = -1; return; }
        int dev = 0, cus = 0, per_cu = 0;
        (void)hipGetDevice(&dev); (void)hipDeviceGetAttribute(&cus, hipDeviceAttributeMultiprocessorCount, dev);
        (void)hipFuncSetAttribute((const void*)mk_fwd, hipFuncAttributeMaxDynamicSharedMemorySize, LDS_BYTES);
        (void)hipOccupancyMaxActiveBlocksPerMultiprocessor(&per_cu, (const void*)mk_fwd, 512, LDS_BYTES);
        (void)hipGetLastError();
        fprintf(stderr, "kernel_launch: cus %d per_cu %d ws %zu\n", cus, per_cu, ws_size);
        grid = cus;
    }
    if (grid < 0) return;
    (void)hipMemsetAsync((char*)d_ws + WS_CTL, 0, CTL_BYTES, stream);
    Args a{};
    for (int i = 0; i < 31; ++i) a.in[i] = (const float*)d_in[i];
    a.out = (float*)d_out; a.ws = (unsigned char*)d_ws;
    void* kargs[] = {&a};
    hipError_t e = hipLaunchCooperativeKernel((const void*)mk_fwd, dim3(grid), dim3(512), kargs, LDS_BYTES, stream);
    if (e != hipSuccess) fprintf(stderr, "cooperative launch failed: %s (grid %d)\n", hipGetErrorString(e), grid);
}
```

```cpp
#include <hip/hip_runtime.h>
#include <hip/hip_cooperative_groups.h>
#include <cstdio>
#include <cstdint>
#include <cmath>
namespace pg8 {
#define PG8_LAS __attribute__((address_space(3)))
typedef unsigned short bf16_t;
typedef short bf16x8 __attribute__((ext_vector_type(8)));
typedef float f32x4 __attribute__((ext_vector_type(4)));
typedef unsigned u32x4 __attribute__((ext_vector_type(4)));
constexpr int BM = 256, BK = 64, HALF = 128, HTB = HALF * BK * 2  , STAGE_BYTES = 8 * HTB, NXCD = 8, WGM = 8;

__host__ __device__ __forceinline__ int lds_byte(int r, int c) { const int st = (r >> 4) * 2 + (c >> 5), rr = r & 15, cc = c & 31, ob = rr * 64 + cc * 2; return st * 1024 + (ob ^ (((ob >> 9) & 1) << 5)); }
__host__ __device__ __forceinline__ void stage_rc(int b, int& R, int& C) { const int st = b / 1024, sb = b % 1024, swz = sb ^ (((sb >> 9) & 1) << 5); R = (st >> 1) * 16 + swz / 64; C = (st & 1) * 32 + (swz % 64) / 2; }
__host__ __device__ __forceinline__ int perm32(int rho) { const int n = rho >> 4, i = rho & 15; return 8 * (i >> 2) + 4 * n + (i & 3); }

struct Unit { int pm, pn; };
struct Gemm { const bf16_t* A; const bf16_t* Bt; int M, N, K; const int* rowidx = nullptr; };

struct StaticOrder {
    int nM, nN, nwg, G, c;
    __host__ __device__ void init(int M, int N, int G_, int c_) { nM = M / BM; nN = N / BM; nwg = nM * nN; G = G_; c = c_; }
    __host__ __device__ bool next(int i, Unit& u) const {
        const long L = (long)i * G + c; if (L >= nwg) return false;
        int wgid = (int)L; { const int q = nwg / NXCD, r = nwg % NXCD, xcd = wgid % NXCD, off = wgid / NXCD; wgid = (xcd < r ? xcd * (q + 1) : r * (q + 1) + (xcd - r) * q) + off; }
        const int nig = WGM * nN, gid = wgid / nig, fm = gid * WGM, gsz = (nM - fm) < WGM ? (nM - fm) : WGM;
        u.pm = fm + ((wgid % nig) % gsz); u.pn = (wgid % nig) / gsz; return true;
    }
    __device__ __forceinline__ void a_ready(const Unit&) const {}
    __device__ __forceinline__ void done(const Unit&) const {}
};

typedef float f32x2c_t __attribute__((ext_vector_type(2))); typedef __bf16 bf16x2c_t __attribute__((ext_vector_type(2)));
__device__ __forceinline__ unsigned cvt_pk_bf16(float lo, float hi) { const f32x2c_t v = {lo, hi}; const bf16x2c_t b = __builtin_convertvector(v, bf16x2c_t); return __builtin_bit_cast(unsigned, b); }
typedef float f32x2 __attribute__((ext_vector_type(2)));
__device__ __forceinline__ float fast_sigmoid(float x) { return __builtin_amdgcn_rcpf(1.0f + __builtin_amdgcn_exp2f(-1.4426950408889634f * x)); }
struct EpiZ {
    static constexpr bool PERM = true, AFTER_DRAIN = false;
    bf16_t *q, *k, *vt, *poolz, *rwkvz; float qscale; int seq;
    __device__ __forceinline__ void operator()(const f32x4 (&acc)[2][2][4][2], const Unit& u, int wr, int wc, int fr, int fq) const {
        const int pn = u.pn;
        if (pn == 4 || pn == 5) {
            const int row0 = u.pm * BM + wr * 64 + fr, c0 = (pn - 4) * 256 + wc * 32 + 8 * fq;
#pragma unroll
            for (int ai = 0; ai < 2; ++ai)
#pragma unroll
                for (int m = 0; m < 4; ++m) { const int row = row0 + ai * HALF + m * 16, b = row / seq, tl = row - b * seq;
#pragma unroll
                    for (int bj = 0; bj < 2; ++bj) { const int c = c0 + bj * HALF, h = c >> 6, d = c & 63; bf16_t* vp = vt + ((size_t)(b * 8 + h) * 64 + d) * seq + tl;
                        const unsigned w0 = cvt_pk_bf16(acc[ai][bj][m][0][0], acc[ai][bj][m][0][1]), w1 = cvt_pk_bf16(acc[ai][bj][m][0][2], acc[ai][bj][m][0][3]);
                        const unsigned w2 = cvt_pk_bf16(acc[ai][bj][m][1][0], acc[ai][bj][m][1][1]), w3 = cvt_pk_bf16(acc[ai][bj][m][1][2], acc[ai][bj][m][1][3]);
                        vp[0] = (bf16_t)(w0 & 0xffffu); vp[(size_t)seq] = (bf16_t)(w0 >> 16); vp[(size_t)2 * seq] = (bf16_t)(w1 & 0xffffu); vp[(size_t)3 * seq] = (bf16_t)(w1 >> 16);
                        vp[(size_t)4 * seq] = (bf16_t)(w2 & 0xffffu); vp[(size_t)5 * seq] = (bf16_t)(w2 >> 16); vp[(size_t)6 * seq] = (bf16_t)(w3 & 0xffffu); vp[(size_t)7 * seq] = (bf16_t)(w3 >> 16); } }
            return;
        }
        bf16_t* base; int ldc, colt, climit; float sc = 1.f;
        if (pn < 2) { base = q; ldc = 512; colt = pn * 256; climit = 512; sc = qscale; }
        else if (pn < 4) { base = k; ldc = 512; colt = (pn - 2) * 256; climit = 512; }
        else if (pn < 8) { base = poolz; ldc = 512; colt = (pn - 6) * 256; climit = 512; }
        else { base = rwkvz; ldc = 1824; colt = (pn - 8) * 256; climit = 1824; }
        const int row0 = u.pm * BM + wr * 64 + fr, col0 = colt + wc * 32 + 8 * fq;
#pragma unroll
        for (int ai = 0; ai < 2; ++ai)
#pragma unroll
            for (int m = 0; m < 4; ++m) { bf16_t* rowp = base + (size_t)(row0 + ai * HALF + m * 16) * ldc + col0;
#pragma unroll
                for (int bj = 0; bj < 2; ++bj) { if (col0 + bj * HALF < climit) { const f32x4 v0 = acc[ai][bj][m][0] * sc, v1 = acc[ai][bj][m][1] * sc;
                    u32x4 w; w.x = cvt_pk_bf16(v0[0], v0[1]); w.y = cvt_pk_bf16(v0[2], v0[3]); w.z = cvt_pk_bf16(v1[0], v1[1]); w.w = cvt_pk_bf16(v1[2], v1[3]);
                    *(u32x4*)(rowp + bj * HALF) = w; } } }
    }
};
typedef unsigned u32x2e __attribute__((ext_vector_type(2)));
struct EpiGate {
    static constexpr bool PERM = true, AFTER_DRAIN = false;
    unsigned char* O; int ldc;
    __device__ __forceinline__ void operator()(const f32x4 (&acc)[2][2][4][2], const Unit& u, int wr, int wc, int fr, int fq) const {
        const int row0 = u.pm * BM + wr * 64 + fr, col0 = u.pn * BM + wc * 32 + 8 * fq;
#pragma unroll
        for (int ai = 0; ai < 2; ++ai)
#pragma unroll
            for (int m = 0; m < 4; ++m) { unsigned char* rowp = O + (size_t)(row0 + ai * HALF + m * 16) * ldc + col0;
#pragma unroll
                for (int bj = 0; bj < 2; ++bj) { const f32x4 v0 = acc[ai][bj][m][0], v1 = acc[ai][bj][m][1]; unsigned q[8];
#pragma unroll
                    for (int e = 0; e < 4; ++e) { q[e] = (unsigned)(fast_sigmoid(v0[e]) * 255.0f + 0.5f); q[4 + e] = (unsigned)(fast_sigmoid(v1[e]) * 255.0f + 0.5f); }
                    *(u32x2e*)(rowp + bj * HALF) = (u32x2e){q[0] | (q[1] << 8) | (q[2] << 16) | (q[3] << 24), q[4] | (q[5] << 8) | (q[6] << 16) | (q[7] << 24)}; } }
    }
};
__device__ __forceinline__ float bflo(unsigned w) { return __uint_as_float(w << 16); }
__device__ __forceinline__ float bfhi(unsigned w) { return __uint_as_float(w & 0xffff0000u); }
template <bool FIRST> struct EpiMerge {
    static constexpr bool PERM = true, AFTER_DRAIN = false;
    bf16_t* O; int ldc; const unsigned char* gate; int ldg, goff;
    __device__ __forceinline__ void operator()(const f32x4 (&acc)[2][2][4][2], const Unit& u, int wr, int wc, int fr, int fq) const {
        const int row0 = u.pm * BM + wr * 64 + fr, col0 = u.pn * BM + wc * 32 + 8 * fq;
#pragma unroll
        for (int ai = 0; ai < 2; ++ai)
#pragma unroll
            for (int m = 0; m < 4; ++m) { const size_t r = (size_t)(row0 + ai * HALF + m * 16); bf16_t* rowp = O + r * ldc + col0; const unsigned char* gp = gate + r * ldg + goff + col0;
#pragma unroll
                for (int bj = 0; bj < 2; ++bj) { const f32x4 v0 = acc[ai][bj][m][0], v1 = acc[ai][bj][m][1];
                    const u32x2e g = *(const u32x2e*)(gp + bj * HALF); const float s = 1.0f / 255.0f;
                    float o[8] = {v0[0] * (float)(g.x & 255u) * s, v0[1] * (float)((g.x >> 8) & 255u) * s, v0[2] * (float)((g.x >> 16) & 255u) * s, v0[3] * (float)(g.x >> 24) * s,
                                  v1[0] * (float)(g.y & 255u) * s, v1[1] * (float)((g.y >> 8) & 255u) * s, v1[2] * (float)((g.y >> 16) & 255u) * s, v1[3] * (float)(g.y >> 24) * s};
                    if (!FIRST) { const u32x4 p = *(const u32x4*)(rowp + bj * HALF);
                        o[0] += bflo(p.x); o[1] += bfhi(p.x); o[2] += bflo(p.y); o[3] += bfhi(p.y); o[4] += bflo(p.z); o[5] += bfhi(p.z); o[6] += bflo(p.w); o[7] += bfhi(p.w); }
                    u32x4 w; w.x = cvt_pk_bf16(o[0], o[1]); w.y = cvt_pk_bf16(o[2], o[3]); w.z = cvt_pk_bf16(o[4], o[5]); w.w = cvt_pk_bf16(o[6], o[7]);
                    *(u32x4*)(rowp + bj * HALF) = w; } }
    }
};
struct EpiResF32 {
    static constexpr bool PERM = false, AFTER_DRAIN = false;
    const float* base; float* out; int ldc;
    __device__ __forceinline__ void operator()(const f32x4 (&acc)[2][2][4][2], const Unit& u, int wr, int wc, int fr, int fq) const {
        const int row0 = u.pm * BM + wr * 64 + fr, col0 = u.pn * BM + wc * 32 + 4 * fq;
#pragma unroll
        for (int ai = 0; ai < 2; ++ai)
#pragma unroll
            for (int m = 0; m < 4; ++m) { const size_t off = (size_t)(row0 + ai * HALF + m * 16) * ldc + col0;
#pragma unroll
                for (int bj = 0; bj < 2; ++bj)
#pragma unroll
                    for (int n = 0; n < 2; ++n) { const f32x4 bs = *(const f32x4*)(base + off + bj * HALF + n * 16); *(f32x4*)(out + off + bj * HALF + n * 16) = bs + acc[ai][bj][m][n]; } }
    }
};
struct EpiSwiGLU {
    static constexpr bool PERM = true, AFTER_DRAIN = false;
    bf16_t* O;
    __device__ __forceinline__ void operator()(const f32x4 (&acc)[2][2][4][2], const Unit& u, int wr, int wc, int fr, int fq) const {
        const int row0 = u.pm * BM + wr * 64 + fr, col0 = (u.pn & 3) * 128 + wc * 32 + 8 * fq;
#pragma unroll
        for (int ai = 0; ai < 2; ++ai)
#pragma unroll
            for (int m = 0; m < 4; ++m) { bf16_t* rowp = O + (size_t)(row0 + ai * HALF + m * 16) * 512 + col0;
                float o[8];
#pragma unroll
                for (int n = 0; n < 2; ++n)
#pragma unroll
                    for (int e = 0; e < 4; ++e) { const float a1 = acc[ai][0][m][n][e], a3 = acc[ai][1][m][n][e]; o[n * 4 + e] = a1 * fast_sigmoid(a1) * a3; }
                u32x4 w; w.x = cvt_pk_bf16(o[0], o[1]); w.y = cvt_pk_bf16(o[2], o[3]); w.z = cvt_pk_bf16(o[4], o[5]); w.w = cvt_pk_bf16(o[6], o[7]);
                *(u32x4*)rowp = w; }
    }
};
struct EpiY {
    static constexpr bool PERM = true, AFTER_DRAIN = false;
    bf16_t* O;
    __device__ __forceinline__ void operator()(const f32x4 (&acc)[2][2][4][2], const Unit& u, int wr, int wc, int fr, int fq) const {
        const int row0 = u.pm * BM + wr * 64 + fr, col0 = (u.pn & 3) * BM + wc * 32 + 8 * fq;
#pragma unroll
        for (int ai = 0; ai < 2; ++ai)
#pragma unroll
            for (int m = 0; m < 4; ++m) { bf16_t* rowp = O + (size_t)(row0 + ai * HALF + m * 16) * 1024 + col0;
#pragma unroll
                for (int bj = 0; bj < 2; ++bj) { const f32x4 v0 = acc[ai][bj][m][0], v1 = acc[ai][bj][m][1];
                    u32x4 w; w.x = cvt_pk_bf16(v0[0], v0[1]); w.y = cvt_pk_bf16(v0[2], v0[3]); w.z = cvt_pk_bf16(v1[0], v1[1]); w.w = cvt_pk_bf16(v1[2], v1[3]);
                    *(u32x4*)(rowp + bj * HALF) = w; } }
    }
};
struct MoeOrder {
    const PG8_LAS unsigned char* tile_e; int nunits, G, c;
    __device__ __forceinline__ bool next(int i, Unit& u) const {
        const int L = i * G + c; if (L >= nunits) return false;
        const int pm = L >> 2; u.pm = pm; u.pn = __builtin_amdgcn_readfirstlane((int)tile_e[pm]) * 4 + (L & 3); return true;
    }
    __device__ __forceinline__ void a_ready(const Unit&) const {}
    __device__ __forceinline__ void done(const Unit&) const {}
};
template <class Epi, class Sched, bool ALIGN_EPI = false, bool SP2 = false, bool GATHER = false>
__device__ __forceinline__ void gemm_phase(PG8_LAS unsigned char* lds, const Gemm g, const Sched& S, const Epi& E) {
    int tid = threadIdx.x; asm volatile("" : "+v"(tid));
    const int wid = __builtin_amdgcn_readfirstlane(tid >> 6), lane = tid & 63, wr = wid >> 2, wc = wid & 3, fr = lane & 15, fq = lane >> 4;
    const int K = g.K, nt = K / BK;
    unsigned voffA[2], voffB[2];
#pragma unroll
    for (int i = 0; i < 2; ++i) { int R, C; stage_rc(tid * 16 + i * 8192, R, C); const int Rb = Epi::PERM ? ((R & ~31) + perm32(R & 31)) : R;
        voffA[i] = (unsigned)(R * K + C) * 2u; voffB[i] = (unsigned)(Rb * K + C) * 2u; }
    unsigned vc[2][2] = {{0u, 0u}, {0u, 0u}}, vn[2][2] = {{0u, 0u}, {0u, 0u}};
#define PG8_GVOFF(dst, pm_) do { if constexpr (GATHER) { _Pragma("unroll") for (int h_ = 0; h_ < 2; ++h_) _Pragma("unroll") for (int i_ = 0; i_ < 2; ++i_) { int R_, C_; stage_rc(tid * 16 + i_ * 8192, R_, C_); \
        const int tok_ = g.rowidx[(size_t)(pm_) * BM + h_ * HALF + R_]; dst[h_][i_] = (unsigned)((size_t)tok_ * K + C_) * 2u; } } } while (0)
    const size_t kstep = (size_t)(BK * 2);
    const size_t hstep = (size_t)HALF * K * 2;
    const size_t tstep = 2 * hstep;
    const unsigned ldsw = (unsigned)wid * 1024u;
    const int aoff = lds_byte(wr * 64 + fr, fq * 8), boff = lds_byte(wc * 32 + fr, fq * 8);
#define PG8_SA(b, h) (((b) * 2 + (h)) * HTB)
#define PG8_SB(b, h) ((4 + (b) * 2 + (h)) * HTB)
#define PG8_STAGE(bufoff, gbase, voff) do { _Pragma("unroll") for (int _i = 0; _i < 2; ++_i) \
        __builtin_amdgcn_global_load_lds((const unsigned*)((const char*)(gbase) + (voff)[_i]), (PG8_LAS unsigned*)(lds + (bufoff) + ldsw + _i * 8192), 16, 0, 0); } while (0)
#define PG8_STAGE_A(bufoff, ptr, half, nx) do { if constexpr (GATHER) { unsigned vo_[2]; vo_[0] = (nx) ? vn[half][0] : vc[half][0]; vo_[1] = (nx) ? vn[half][1] : vc[half][1]; PG8_STAGE(bufoff, ptr, vo_); } \
        else { PG8_STAGE(bufoff, (ptr) + (half) * hstep, voffA); } } while (0)
#define PG8_LDA(dst, b, h) do { _Pragma("unroll") for (int m = 0; m < 4; ++m) _Pragma("unroll") for (int k = 0; k < 2; ++k) dst[m][k] = *(const PG8_LAS bf16x8*)(lds + PG8_SA(b, h) + aoff + m * 2048 + k * 1024); } while (0)
#define PG8_LDB(dst, b, h) do { _Pragma("unroll") for (int n = 0; n < 2; ++n) _Pragma("unroll") for (int k = 0; k < 2; ++k) dst[n][k] = *(const PG8_LAS bf16x8*)(lds + PG8_SB(b, h) + boff + n * 2048 + k * 1024); } while (0)
#define PG8_MMA(ai, bj, At, Bt) do { __builtin_amdgcn_s_setprio(1); _Pragma("unroll") for (int m = 0; m < 4; ++m) _Pragma("unroll") for (int n = 0; n < 2; ++n) _Pragma("unroll") for (int k = 0; k < 2; ++k) \
        acc[ai][bj][m][n] = __builtin_amdgcn_mfma_f32_16x16x32_bf16(Bt[n][k], At[m][k], acc[ai][bj][m][n], 0, 0, 0); __builtin_amdgcn_s_setprio(0); } while (0)
#define PG8_WAIT_V(n) asm volatile("s_waitcnt vmcnt(" #n ")" ::: "memory")
#define PG8_WAIT_L(n) asm volatile("s_waitcnt lgkmcnt(" #n ")" ::: "memory")
#define PG8_BAR __builtin_amdgcn_s_barrier()
#define PG8_SCHED __builtin_amdgcn_sched_barrier(0)
    Unit cur, nxt; int ui = 0;
    if (!S.next(0, cur)) return;
    f32x4 acc[2][2][4][2];
#pragma unroll
    for (int a = 0; a < 2; ++a)
#pragma unroll
        for (int b = 0; b < 2; ++b)
#pragma unroll
            for (int m = 0; m < 4; ++m)
#pragma unroll
                for (int n = 0; n < 2; ++n) acc[a][b][m][n] = (f32x4){0.f, 0.f, 0.f, 0.f};
    bf16x8 At[4][2], B0[2][2], B1[2][2];
    const char* cA = (const char*)g.A + (GATHER ? (size_t)0 : (size_t)cur.pm * tstep); const char* cB = (const char*)g.Bt + (size_t)cur.pn * tstep;
    PG8_GVOFF(vc, cur.pm);
    S.a_ready(cur);
    if constexpr (SP2) {
        PG8_STAGE(PG8_SB(0, 0), cB, voffB); PG8_STAGE(PG8_SB(0, 1), cB + hstep, voffB); PG8_STAGE_A(PG8_SA(0, 0), cA, 0, false); PG8_STAGE_A(PG8_SA(0, 1), cA, 1, false);
        if (wr == 1) PG8_BAR;
        PG8_WAIT_V(2); PG8_BAR;
        PG8_STAGE(PG8_SB(1, 0), cB + kstep, voffB); PG8_STAGE_A(PG8_SA(1, 0), cA + kstep, 0, false); PG8_STAGE(PG8_SB(1, 1), cB + hstep + kstep, voffB);
        PG8_WAIT_V(6); PG8_BAR;
    } else {
        PG8_STAGE(PG8_SB(0, 0), cB, voffB); PG8_STAGE_A(PG8_SA(0, 0), cA, 0, false); PG8_STAGE(PG8_SB(0, 1), cB + hstep, voffB); PG8_STAGE_A(PG8_SA(0, 1), cA, 1, false);
        if (wr == 1) PG8_BAR;
        PG8_WAIT_V(4); PG8_BAR;
        PG8_STAGE(PG8_SB(1, 0), cB + kstep, voffB); PG8_STAGE_A(PG8_SA(1, 0), cA + kstep, 0, false); PG8_STAGE(PG8_SB(1, 1), cB + hstep + kstep, voffB);
        PG8_WAIT_V(6); PG8_BAR;
    }
    for (;;) {
        const bool has_next = S.next(ui + 1, nxt);
        const char* nA = (has_next && !GATHER) ? (const char*)g.A + (size_t)nxt.pm * tstep : cA; if (has_next) PG8_GVOFF(vn, nxt.pm); else { vn[0][0] = vc[0][0]; vn[0][1] = vc[0][1]; vn[1][0] = vc[1][0]; vn[1][1] = vc[1][1]; } const char* nB = has_next ? (const char*)g.Bt + (size_t)nxt.pn * tstep : cB;
        for (int t = 0; t < nt; t += 2) {
            const bool last = (t == nt - 2);
            const char* a1 = cA + (size_t)(t + 1) * kstep;
            const char* a2 = last ? nA : cA + (size_t)(t + 2) * kstep; const char* b2 = last ? nB : cB + (size_t)(t + 2) * kstep;
            const char* a3 = a2 + kstep; const char* b3 = b2 + kstep;
            if (last && has_next) S.a_ready(nxt);
            if constexpr (SP2) {
            PG8_LDB(B0, 0, 0); PG8_LDB(B1, 0, 1); PG8_SCHED; PG8_LDA(At, 0, 0); PG8_STAGE_A(PG8_SA(1, 1), a1, 1, false);
            PG8_WAIT_V(8); PG8_WAIT_L(0); PG8_BAR; PG8_MMA(0, 0, At, B0); PG8_MMA(0, 1, At, B1); PG8_BAR; PG8_SCHED;
            PG8_LDA(At, 0, 1); PG8_STAGE(PG8_SB(0, 0), b2, voffB); PG8_STAGE(PG8_SB(0, 1), b2 + hstep, voffB); PG8_STAGE_A(PG8_SA(0, 0), a2, 0, last);
            PG8_WAIT_V(8); PG8_WAIT_L(0); PG8_BAR; PG8_MMA(1, 0, At, B0); PG8_MMA(1, 1, At, B1); PG8_BAR; PG8_SCHED;
            PG8_LDB(B0, 1, 0); PG8_LDB(B1, 1, 1); PG8_SCHED; PG8_LDA(At, 1, 0); PG8_STAGE_A(PG8_SA(0, 1), a2, 1, last);
            PG8_WAIT_V(8); PG8_WAIT_L(0); PG8_BAR; PG8_MMA(0, 0, At, B0); PG8_MMA(0, 1, At, B1); PG8_BAR; PG8_SCHED;
            PG8_LDA(At, 1, 1); PG8_STAGE(PG8_SB(1, 0), b3, voffB); PG8_STAGE(PG8_SB(1, 1), b3 + hstep, voffB); PG8_STAGE_A(PG8_SA(1, 0), a3, 0, last);
            PG8_WAIT_V(8); PG8_WAIT_L(0); PG8_BAR; PG8_MMA(1, 0, At, B0); PG8_MMA(1, 1, At, B1); PG8_BAR; PG8_SCHED;
            } else {
            PG8_LDB(B0, 0, 0); PG8_SCHED; PG8_LDA(At, 0, 0); PG8_STAGE_A(PG8_SA(1, 1), a1, 1, false);
            PG8_WAIT_L(8); PG8_BAR; PG8_WAIT_L(0); PG8_MMA(0, 0, At, B0); PG8_BAR; PG8_SCHED;
            PG8_LDB(B1, 0, 1); PG8_STAGE(PG8_SB(0, 0), b2, voffB);
            PG8_BAR; PG8_WAIT_L(0); PG8_MMA(0, 1, At, B1); PG8_BAR;
            PG8_LDA(At, 0, 1); PG8_STAGE_A(PG8_SA(0, 0), a2, 0, last);
            PG8_BAR; PG8_WAIT_L(0); PG8_MMA(1, 0, At, B0); PG8_BAR; PG8_SCHED;
            PG8_STAGE(PG8_SB(0, 1), b2 + hstep, voffB);
            PG8_WAIT_V(6); PG8_BAR; PG8_MMA(1, 1, At, B1); PG8_BAR;
            PG8_LDB(B0, 1, 0); PG8_SCHED; PG8_LDA(At, 1, 0); PG8_STAGE_A(PG8_SA(0, 1), a2, 1, last);
            PG8_WAIT_L(8); PG8_BAR; PG8_WAIT_L(0); PG8_MMA(0, 0, At, B0); PG8_BAR; PG8_SCHED;
            PG8_LDB(B1, 1, 1); PG8_STAGE(PG8_SB(1, 0), b3, voffB);
            PG8_BAR; PG8_WAIT_L(0); PG8_MMA(0, 1, At, B1); PG8_BAR;
            PG8_LDA(At, 1, 1); PG8_STAGE_A(PG8_SA(1, 0), a3, 0, last);
            PG8_BAR; PG8_WAIT_L(0); PG8_MMA(1, 0, At, B0); PG8_BAR; PG8_SCHED;
            PG8_STAGE(PG8_SB(1, 1), b3 + hstep, voffB);
            PG8_WAIT_V(6); PG8_BAR; PG8_MMA(1, 1, At, B1); PG8_BAR;
            }
        }
        if constexpr (ALIGN_EPI) { if (wr == 0) PG8_BAR; }
        if constexpr (!Epi::AFTER_DRAIN) { E(acc, cur, wr, wc, fr, fq); S.done(cur); }
        if (!has_next) break;
#pragma unroll
        for (int a = 0; a < 2; ++a)
#pragma unroll
            for (int b = 0; b < 2; ++b)
#pragma unroll
                for (int m = 0; m < 4; ++m)
#pragma unroll
                    for (int n = 0; n < 2; ++n) acc[a][b][m][n] = (f32x4){0.f, 0.f, 0.f, 0.f};
        cur = nxt; cA = nA; cB = nB; ++ui; vc[0][0] = vn[0][0]; vc[0][1] = vn[0][1]; vc[1][0] = vn[1][0]; vc[1][1] = vn[1][1];
        if constexpr (ALIGN_EPI) { if (wr == 1) PG8_BAR; }
    }
    PG8_WAIT_V(0);
    if constexpr (!ALIGN_EPI) { if (wr == 0) PG8_BAR; }
    PG8_BAR;
    if constexpr (Epi::AFTER_DRAIN) { E.fused(acc, cur, wr, wc, fr, fq, lds, wid, lane); S.done(cur); }
#undef PG8_SA
#undef PG8_SB
#undef PG8_STAGE
#undef PG8_STAGE_A
#undef PG8_GVOFF
#undef PG8_LDA
#undef PG8_LDB
#undef PG8_MMA
#undef PG8_WAIT_V
#undef PG8_WAIT_L
#undef PG8_BAR
#undef PG8_SCHED
}
}
namespace cg = cooperative_groups;
#define DI __device__ __forceinline__
#define LAS __attribute__((address_space(3)))
typedef unsigned short bf16;
typedef float f32x4 __attribute__((ext_vector_type(4)));
typedef unsigned u32x4 __attribute__((ext_vector_type(4)));
typedef unsigned u32x2 __attribute__((ext_vector_type(2)));
typedef short bf16x8_t __attribute__((ext_vector_type(8)));

constexpr int BATCH = 2, SEQ = 16384, DM = 1024, T = BATCH * SEQ, DEPTH = 2;
constexpr int NEXP = 32, RZP = 1824;
constexpr int RMAX = 73728;
constexpr float C2 = 0.125f * 1.4426950408889634f;
constexpr float LOG2E = 1.4426950408889634f;
constexpr size_t MiB = 1u << 20;
constexpr size_t WS_CTL = 0, CTL_BYTES = 1 * MiB;
constexpr size_t WS_WIN = 1 * MiB, WS_WG = 9 * MiB, WS_WBR = 15 * MiB, WS_WOUT = 18 * MiB;
constexpr size_t WS_KMEAN = 20 * MiB, WS_RWG = 20 * MiB + 512 * 1024, WS_ROUTE = 21 * MiB, WS_RWT = 22 * MiB, WS_DEST = 22 * MiB + 512 * 1024, WS_BONUS = 23 * MiB, WS_WLT = 24 * MiB, WS_WPT = 24 * MiB + 512 * 1024, WS_WGBASE = 24 * MiB + 768 * 1024, WS_KINV = 25 * MiB, WS_ROWTOK = 25 * MiB, WS_PGT = 26 * MiB, WS_LG = 28 * MiB, WS_SG = 30 * MiB;
constexpr size_t WS_XB = 32 * MiB, WS_VFIRST = 96 * MiB, WS_YPOOL = 128 * MiB, WS_YATTN = 160 * MiB;
constexpr size_t WS_BIG = 192 * MiB;
constexpr size_t WS_Q = WS_BIG, WS_K = WS_BIG + 32 * MiB, WS_V = WS_BIG + 64 * MiB, WS_POOLZ = WS_BIG + 232 * MiB, WS_RWKVZ = WS_BIG + 264 * MiB;
constexpr size_t WS_AR = WS_BIG;
constexpr size_t WS_GATES = WS_BIG + 32 * MiB;
constexpr size_t WS_XPERM = WS_BIG, WS_HACT = WS_BIG + 144 * MiB, WS_W13 = WS_BIG + 216 * MiB, WS_W2 = WS_BIG + 280 * MiB, WS_YMOE = WS_BIG;
constexpr size_t WS_VT = WS_YATTN;
constexpr size_t WS_PARTO = WS_BIG + 96 * MiB, WS_PARTML = WS_BIG + 224 * MiB;
constexpr size_t WS_LIST = WS_BIG + 378 * MiB;
constexpr size_t WS_PCT = WS_BIG + 32 * MiB, WS_LC = WS_BIG + 64 * MiB, WS_RM = WS_BIG + 128 * MiB, WS_Y0 = WS_BIG + 160 * MiB, WS_S0 = WS_BIG + 352 * MiB;
constexpr int LSTRIDE = 516096;
constexpr size_t WS_END = WS_BIG + 394 * MiB;
static_assert(WS_LIST + (size_t)16 * LSTRIDE * 2 <= WS_END, "ws map");
static_assert(WS_RWKVZ + (size_t)T * RZP * 2 <= WS_END, "ws map");
static_assert(WS_W2 + (size_t)32 * 1024 * 512 * 2 <= WS_END, "ws map");
constexpr int CW_CNT = 64, CW_LCNT = 1024, CW_BAR = 4096;
constexpr int LDS_BYTES = 147456, MISC_OFF = 131072;

DI float bf2f(unsigned short u) { return __uint_as_float((unsigned)u << 16); }
DI unsigned f2bf(float f) { return pg8::cvt_pk_bf16(f, 0.f) & 0xffffu; }
DI unsigned pk2(float lo, float hi) { return pg8::cvt_pk_bf16(lo, hi); }
DI float blo(unsigned w) { return __uint_as_float(w << 16); }
DI float bhi(unsigned w) { return __uint_as_float(w & 0xffff0000u); }
DI float wave_sum(float v) {
#pragma unroll
    for (int o = 1; o < 64; o <<= 1) v += __shfl_xor(v, o);
    return v;
}
DI float wave_max(float v) {
#pragma unroll
    for (int o = 1; o < 64; o <<= 1) v = fmaxf(v, __shfl_xor(v, o));
    return v;
}
DI float fexp_(float x) { return __builtin_amdgcn_exp2f(x * 1.4426950408889634f); }
DI float frcp_(float x) { return __builtin_amdgcn_rcpf(x); }
DI float sigmoidf_(float x) { return frcp_(1.0f + fexp_(-x)); }
DI float ftanh_(float x) { return 1.0f - 2.0f * frcp_(1.0f + fexp_(2.0f * x)); }
DI float fsoftplus_(float x) { return x > 20.f ? x : __builtin_amdgcn_logf(1.0f + fexp_(x)) * 0.6931471805599453f; }
#define LDS_WAIT() asm volatile("s_waitcnt lgkmcnt(0)" ::: "memory")

#define XB_TMO      128
#define XB_XCNT(j)  (256  + 64 * (j))
#define XB_XSUB(j)  (1280 + 64 * (j))
#define XB_XGEN(j)  (2304 + 64 * (j))
#define XB_TOP      3328
#define XB_TOPGEN   3392
#define XCD_BAR_WORDS 3456
#define XB_SPIN_CAP (1u << 27)

__device__ __forceinline__ unsigned xb_ld(unsigned* p)              { return __hip_atomic_load(p, __ATOMIC_RELAXED, __HIP_MEMORY_SCOPE_AGENT); }
__device__ __forceinline__ unsigned xb_add(unsigned* p, unsigned v) { return __hip_atomic_fetch_add(p, v, __ATOMIC_RELAXED, __HIP_MEMORY_SCOPE_AGENT); }
__device__ __forceinline__ unsigned xb_xcc_id() { return (unsigned)__builtin_amdgcn_s_getreg((3 << 11) | 20) & 0xFu; }
#define XB_SPIN(cond, bar) do { unsigned _sp = 0; while (cond) { __builtin_amdgcn_s_sleep(1); \
    if ((++_sp & 255u) == 0u) { if (xb_ld(&(bar)[XB_TMO])) break; if (_sp > XB_SPIN_CAP) { atomicAdd(&(bar)[XB_TMO], 1u); break; } } } } while (0)

struct XcdBarrier {
    unsigned* bar; unsigned x;
    volatile LAS unsigned* st;
};

__device__ __forceinline__ XcdBarrier xcd_barrier_post(unsigned* bar, volatile LAS unsigned* st) {
    XcdBarrier b; b.bar = bar; b.x = xb_xcc_id(); b.st = st;
    if (threadIdx.x == 0) (void)xb_add(&bar[XB_XCNT(b.x)], 1u);
    return b;
}
__device__ __forceinline__ void xcd_barrier_complete(unsigned* bar, unsigned x, unsigned& nloc, unsigned& nx) {
    const unsigned G = gridDim.x * gridDim.y * gridDim.z;
    unsigned sum, cnt, mine, sp = 0u;
    for (;;) {
        sum = 0u; cnt = 0u; mine = 0u;
#pragma unroll
        for (unsigned j = 0; j < 16; ++j) { const unsigned c = xb_ld(&bar[XB_XCNT(j)]); sum += c; cnt += (c > 0u) ? 1u : 0u; mine = (j == x) ? c : mine; }
        if (sum == G) break;
        __builtin_amdgcn_s_sleep(1);
        if ((++sp & 255u) == 0u) { if (xb_ld(&bar[XB_TMO])) break; if (sp > XB_SPIN_CAP) { atomicAdd(&bar[XB_TMO], 1u); break; } }
    }
    nloc = mine > 0u ? mine : 1u; nx = cnt > 0u ? cnt : 1u;
}

__device__ __forceinline__ void xcd_barrier(const XcdBarrier& b) {
    asm volatile("s_waitcnt vmcnt(0)" ::: "memory");
    __syncthreads();
    if (threadIdx.x == 0) {
        unsigned* bar = b.bar;
        __builtin_amdgcn_s_waitcnt(0);
        unsigned nloc = b.st[0], nx = b.st[1];
        if (nloc == 0u) { xcd_barrier_complete(bar, b.x, nloc, nx); b.st[0] = nloc; b.st[1] = nx; }
        const unsigned old = xb_add(&bar[XB_XSUB(b.x)], 1u);
        const unsigned gen = old / nloc;
        if (old + 1u == (gen + 1u) * nloc) {
            __builtin_amdgcn_fence(__ATOMIC_RELEASE, "agent");
            asm volatile("s_waitcnt vmcnt(0)" ::: "memory");
            const unsigned og = xb_add(&bar[XB_TOP], 1u);
            const unsigned tg = og / nx;
            if (og + 1u == (tg + 1u) * nx) xb_add(&bar[XB_TOPGEN], 1u);
            else XB_SPIN(xb_ld(&bar[XB_TOPGEN]) == tg, bar);
            __builtin_amdgcn_fence(__ATOMIC_ACQUIRE, "agent");
            xb_add(&bar[XB_XGEN(b.x)], 1u);
            asm volatile("s_waitcnt vmcnt(0)" ::: "memory");
        } else {
            XB_SPIN(xb_ld(&bar[XB_XGEN(b.x)]) == gen, bar);
            __builtin_amdgcn_fence(__ATOMIC_ACQUIRE, "agent");
            asm volatile("s_waitcnt vmcnt(0)" ::: "memory");
        }
    }
    __syncthreads();
}

struct Args { const float* in[31]; float* out; unsigned char* ws; };

typedef const __attribute__((address_space(4))) unsigned long long* kargp_t;
struct Frame {
    LAS unsigned char* lds; int tid, lane, wave, G, bid;
    kargp_t kp;
};
#define GASQ __attribute__((address_space(1)))
DI const float* INP(const Frame& F, int i) { return (const float*)(const GASQ float*)F.kp[i]; }
DI float* OUTP(const Frame& F) { return (float*)(GASQ float*)F.kp[31]; }
DI unsigned char* WSP(const Frame& F) { return (unsigned char*)(GASQ unsigned char*)F.kp[32]; }
DI void fence_frame(Frame& F) {
    asm volatile("" : "+s"(F.kp) :: "memory"); asm volatile("" : "+s"(F.G)); asm volatile("" : "+s"(F.bid));
    F.tid = threadIdx.x; asm volatile("" : "+v"(F.tid)); F.lane = F.tid & 63; F.wave = __builtin_amdgcn_readfirstlane(F.tid >> 6); }

DI void transpose_item(const float* W, int ldw, int ncols, bf16* WT, int ldt, const float* scale, LAS float* scr, int item, int lane) {
    const int nblk = ncols / 32, kb = item / nblk, nb = item % nblk, k0 = 64 * kb, n0 = 32 * nb;
    { const int rs = lane >> 3, c4 = (lane & 7) * 4; f32x4 v[8]; float sc[8];
#pragma unroll
      for (int i = 0; i < 8; ++i) { v[i] = *(const f32x4*)(W + (size_t)(k0 + 8 * i + rs) * ldw + n0 + c4); sc[i] = scale ? scale[k0 + 8 * i + rs] : 1.0f; }
#pragma unroll
      for (int i = 0; i < 8; ++i) { LAS float* d = scr + (8 * i + rs) * 33 + c4; d[0] = v[i].x * sc[i]; d[1] = v[i].y * sc[i]; d[2] = v[i].z * sc[i]; d[3] = v[i].w * sc[i]; } }
    LDS_WAIT(); asm volatile("" ::: "memory");
    const int c = lane & 7;
#pragma unroll
    for (int j = 0; j < 4; ++j) { const int n = (lane >> 3) + 8 * j; const LAS float* s = scr + (8 * c) * 33 + n;
        u32x4 o; o.x = pk2(s[0 * 33], s[1 * 33]); o.y = pk2(s[2 * 33], s[3 * 33]); o.z = pk2(s[4 * 33], s[5 * 33]); o.w = pk2(s[6 * 33], s[7 * 33]);
        *(u32x4*)(WT + (size_t)(n0 + n) * ldt + k0 + 8 * c) = o; }
    LDS_WAIT(); asm volatile("" ::: "memory");
}
DI void prep_mixer_weights(Frame& F, int l) {
    LAS float* scr = (LAS float*)(F.lds + F.wave * 16384);
    const int gw = F.bid * 8 + F.wave, NGW = F.G * 8;
    const float* w_in = INP(F, 2) + (size_t)l * 1024 * 6912; const float* g1 = INP(F, 1) + l * 1024;
    bf16* WIN = (bf16*)(WSP(F) + WS_WIN); bf16* WG = (bf16*)(WSP(F) + WS_WG); bf16* WBR = (bf16*)(WSP(F) + WS_WBR); bf16* WOUT = (bf16*)(WSP(F) + WS_WOUT);
    constexpr int I1 = 16 * (1536 / 32), I2 = 16 * (2304 / 32), I3 = 16 * 1, I4 = 16 * (3072 / 32), I5 = 8 * (1024 / 32), I6 = 16 * (1024 / 32);
    const int n3 = l > 0 ? I3 : 0;
    const int total = I1 + I2 + n3 + I4 + 3 * I5 + I6;
    for (int it = gw; it < total; it += NGW) {
        int r = it;
        if (r < I1) { transpose_item(w_in, 6912, 1536, WIN, 1024, g1, scr, r, F.lane); continue; } r -= I1;
        if (r < I2) { transpose_item(w_in + 4608, 6912, 2304, WIN + (size_t)1536 * 1024, 1024, g1, scr, r, F.lane); continue; } r -= I2;
        if (r < n3) { transpose_item(INP(F, 3) + (size_t)(l - 1) * 1024 * 32, 32, 32, WIN + (size_t)3840 * 1024, 1024, g1, scr, r, F.lane); continue; } r -= n3;
        if (r < I4) { transpose_item(w_in + 1536, 6912, 3072, WG, 1024, g1, scr, r, F.lane); continue; } r -= I4;
        if (r < 3 * I5) { const int i = r / I5; transpose_item(INP(F, 20) + (size_t)(l * 3 + i) * 512 * 1024, 1024, 1024, WBR + (size_t)i * 1024 * 512, 512, i == 2 ? INP(F, 19) + l * 512 : nullptr, scr, r % I5, F.lane); continue; } r -= 3 * I5;
        transpose_item(INP(F, 21) + (size_t)l * 1024 * 1024, 1024, 1024, WOUT, 1024, nullptr, scr, r, F.lane);
    }
    if (l > 0) {
        u32x4* z = (u32x4*)(WIN + (size_t)3872 * 1024); const int n16 = 224 * 1024 * 2 / 16;
        for (int i = F.bid * 512 + F.tid; i < n16; i += F.G * 512) z[i] = (u32x4){0u, 0u, 0u, 0u};
    }
    { bf16* WPT = (bf16*)(WSP(F) + WS_WPT);
      for (int it = gw; it < 32; it += NGW) transpose_item(INP(F, 18) + (size_t)(l * 4 + (it >> 3)) * 128 * 128, 128, 128, WPT + (size_t)(it >> 3) * 128 * 128, 128, nullptr, scr, it & 7, F.lane); }
    { bf16* WLT = (bf16*)(WSP(F) + WS_WLT);
      constexpr int L1 = 1 * 16, L2 = 1 * 16, L3 = 2 * 16;
      for (int it = gw; it < L1 + L2 + L3; it += NGW) {
          if (it < L1) transpose_item(INP(F, 7) + (size_t)l * 64 * 512, 512, 512, WLT, 288, nullptr, scr, it, F.lane);
          else if (it < L1 + L2) transpose_item(INP(F, 9) + (size_t)l * 64 * 512, 512, 512, WLT + 64, 288, nullptr, scr, it - L1, F.lane);
          else transpose_item(INP(F, 10) + (size_t)l * 128 * 512, 512, 512, WLT + 128, 288, nullptr, scr, it - L1 - L2, F.lane); }
      const float* wv = INP(F, 17) + (size_t)(l > 0 ? l - 1 : 0) * 32 * 512;
      for (int i = F.bid * 512 + F.tid; i < 32 * 512; i += F.G * 512) { const int k = i >> 9, ch = i & 511; WLT[(size_t)ch * 288 + 256 + k] = (bf16)f2bf(l > 0 ? wv[k * 512 + ch] : 0.f); } }
    { bf16* RWH = (bf16*)(WSP(F) + WS_RWG); bf16* RWL = RWH + 48 * 1024; const float* g2 = INP(F, 22) + l * 1024; const float* rgw = INP(F, 23) + (size_t)l * 1024 * 4; const float* rew = INP(F, 25) + (size_t)l * 1024 * 32;
      for (int i = F.bid * 512 + F.tid; i < 48 * 1024; i += F.G * 512) { const int r = i >> 10, k = i & 1023;
          const float w = r < 16 ? rgw[k * 4 + (r & 3)] : r < 32 ? rew[k * 32 + 8 * ((r - 16) >> 2) + ((r - 16) & 3)] : rew[k * 32 + 8 * ((r - 32) >> 2) + 4 + ((r - 32) & 3)];
          const float v = g2[k] * w; const unsigned hb = f2bf(v); const float hf = __uint_as_float(hb << 16); RWH[i] = (bf16)hb; RWL[i] = (bf16)f2bf(v - hf); } }
}
DI void prep_expert_weights(Frame& F, int l) {
    LAS float* scr = (LAS float*)(F.lds + F.wave * 16384);
    const int gw = F.bid * 8 + F.wave, NGW = F.G * 8;
    const float* g2 = INP(F, 22) + l * 1024;
    bf16* W13 = (bf16*)(WSP(F) + WS_W13); bf16* W2 = (bf16*)(WSP(F) + WS_W2);
    constexpr int J13 = 64, N13 = NEXP * 2 * 4 * J13, J2 = 8 * 32, N2 = NEXP * J2;
    for (int it = gw; it < N13 + N2; it += NGW) {
        if (it < N13) { const int job = it / J13, item = it % J13, e = job >> 3, which = (job >> 2) & 1, grp = job & 3;
            const float* src = (which ? INP(F, 28) : INP(F, 27)) + ((size_t)(l * NEXP + e) * 1024) * 512 + grp * 128;
            transpose_item(src, 512, 128, W13 + ((size_t)e * 1024 + grp * 256 + which * 128) * 1024, 1024, g2, scr, item, F.lane);
        } else { const int r = it - N13, e = r / J2, item = r % J2;
            transpose_item(INP(F, 29) + (size_t)(l * NEXP + e) * 512 * 1024, 1024, 1024, W2 + (size_t)e * 1024 * 512, 512, nullptr, scr, item, F.lane); }
    }
}
DI void rms_rows_to_bf16(Frame& F, const float* x, bf16* xb) {
    const int gw = F.bid * 8 + F.wave, NGW = F.G * 8;
    for (int t = gw; t < T; t += NGW) {
        const f32x4* xr = (const f32x4*)(x + (size_t)t * DM) + F.lane; f32x4 v[4]; float s = 0.f;
#pragma unroll
        for (int j = 0; j < 4; ++j) { v[j] = xr[64 * j]; s += (v[j].x * v[j].x + v[j].y * v[j].y) + (v[j].z * v[j].z + v[j].w * v[j].w); }
        const float rs = rsqrtf(wave_sum(s) * (1.f / DM) + 1e-6f);
        u32x2* o = (u32x2*)(xb + (size_t)t * DM) + F.lane;
#pragma unroll
        for (int j = 0; j < 4; ++j) o[64 * j] = (u32x2){pk2(v[j].x * rs, v[j].y * rs), pk2(v[j].z * rs, v[j].w * rs)};
    }
}

DI void kmean_phase(Frame& F) {
    const bf16* K = (const bf16*)(WSP(F) + WS_K); float* kmean = (float*)(WSP(F) + WS_KMEAN);
    LAS float* red = (LAS float*)F.lds;
    for (int it = F.bid; it < BATCH * 8 * 64; it += F.G) {
        const int b = it >> 9, h = (it >> 6) & 7, n = it & 63, c8 = F.tid & 7, rg = F.tid >> 3;
        const bf16* kp = K + ((size_t)b * SEQ + n * 256 + rg * 4) * 512 + h * 64 + c8 * 8; float s[8] = {0.f, 0.f, 0.f, 0.f, 0.f, 0.f, 0.f, 0.f};
        u32x4 w[4];
#pragma unroll
        for (int i = 0; i < 4; ++i) w[i] = *(const u32x4*)(kp + (size_t)i * 512);
#pragma unroll
        for (int i = 0; i < 4; ++i) { s[0] += blo(w[i].x); s[1] += bhi(w[i].x); s[2] += blo(w[i].y); s[3] += bhi(w[i].y); s[4] += blo(w[i].z); s[5] += bhi(w[i].z); s[6] += blo(w[i].w); s[7] += bhi(w[i].w); }
        *(LAS f32x4*)(red + rg * 68 + c8 * 8) = (f32x4){s[0], s[1], s[2], s[3]}; *(LAS f32x4*)(red + rg * 68 + c8 * 8 + 4) = (f32x4){s[4], s[5], s[6], s[7]};
        __syncthreads();
        if (F.tid < 64) { float a = 0.f;
#pragma unroll 16
            for (int p = 0; p < 64; ++p) a += red[p * 68 + F.tid];
            kmean[(size_t)it * 64 + F.tid] = a * (1.f / 256.f); }
        __syncthreads();
    }
}
DI void vt_phase(Frame& F) {
    const bf16* V = (const bf16*)(WSP(F) + WS_V); bf16* VT = (bf16*)(WSP(F) + WS_VT);
    LAS bf16* tl = (LAS bf16*)(F.lds + 20480 + F.wave * 9216);
    const int gw = F.bid * 8 + F.wave, NGW = F.G * 8, lane = F.lane;
    for (int it = gw; it < BATCH * 8 * (SEQ / 64); it += NGW) {
        const int bh = it / (SEQ / 64), tt = it % (SEQ / 64), b = bh >> 3, h = bh & 7, t0 = tt * 64;
#pragma unroll
        for (int i = 0; i < 8; ++i) { const int r = i * 8 + (lane >> 3), c = lane & 7;
            const u32x4 w = *(const u32x4*)(V + ((size_t)b * SEQ + t0 + r) * 512 + h * 64 + c * 8); *(LAS u32x4*)(tl + r * 72 + c * 8) = w; }
        LDS_WAIT(); asm volatile("" ::: "memory");
#pragma unroll
        for (int i = 0; i < 8; ++i) { const int d = i * 8 + (lane >> 3), c = lane & 7; unsigned short e[8];
#pragma unroll
            for (int k = 0; k < 8; ++k) e[k] = tl[(8 * c + k) * 72 + d];
            u32x4 w; w.x = e[0] | ((unsigned)e[1] << 16); w.y = e[2] | ((unsigned)e[3] << 16); w.z = e[4] | ((unsigned)e[5] << 16); w.w = e[6] | ((unsigned)e[7] << 16);
            *(u32x4*)(VT + ((size_t)bh * 64 + d) * SEQ + t0 + c * 8) = w; }
        LDS_WAIT(); asm volatile("" ::: "memory");
    }
}
DI int list_off(int n) { return n * SEQ - 128 * n * (n + 1); }
DI void sel_phase(Frame& F, int l) {
    const bf16* Q = (const bf16*)(WSP(F) + WS_Q); const float* kmean = (const float*)(WSP(F) + WS_KMEAN);
    unsigned short* list = (unsigned short*)(WSP(F) + WS_LIST); unsigned* lcnt = (unsigned*)(WSP(F) + WS_CTL) + CW_LCNT + 1024 * l;
    LAS float* km = (LAS float*)F.lds;
    for (int it = F.bid; it < BATCH * 8 * (SEQ / 512); it += F.G) {
        const int pr = it % 256, bh = pr >> 4, g = (it < 256) ? (pr & 15) : 31 - (pr & 15), b = bh >> 3, h = bh & 7;
        __syncthreads();
        for (int i = F.tid; i < 1024; i += 512) ((LAS f32x4*)km)[i] = ((const f32x4*)(kmean + (size_t)bh * 4096))[i];
        __syncthreads();
        const int tl = g * 512 + F.tid, own = __builtin_amdgcn_readfirstlane(tl >> 8);
        float q[64];
        { const u32x4* qp = (const u32x4*)(Q + ((size_t)b * SEQ + tl) * 512 + h * 64);
#pragma unroll
          for (int c = 0; c < 8; ++c) { const u32x4 w = qp[c]; q[8 * c] = blo(w.x); q[8 * c + 1] = bhi(w.x); q[8 * c + 2] = blo(w.y); q[8 * c + 3] = bhi(w.y); q[8 * c + 4] = blo(w.z); q[8 * c + 5] = bhi(w.z); q[8 * c + 6] = blo(w.w); q[8 * c + 7] = bhi(w.w); } }
        float v0 = -INFINITY, v1 = -INFINITY, v2 = -INFINITY; int i0 = -1, i1 = -1, i2 = -1;
        for (int n = 0; n < own; ++n) { const LAS f32x4* kp = (const LAS f32x4*)(km + n * 64); float s0 = 0.f, s1 = 0.f;
#pragma unroll
            for (int i = 0; i < 16; i += 2) { const f32x4 a = kp[i], c = kp[i + 1];
                s0 += q[4 * i] * a.x + q[4 * i + 1] * a.y + q[4 * i + 2] * a.z + q[4 * i + 3] * a.w; s1 += q[4 * i + 4] * c.x + q[4 * i + 5] * c.y + q[4 * i + 6] * c.z + q[4 * i + 7] * c.w; }
            const float gte = s0 + s1; const bool c0 = gte > v0, c1 = gte > v1, c2 = gte > v2;
            v2 = c1 ? v1 : (c2 ? gte : v2); i2 = c1 ? i1 : (c2 ? n : i2);
            v1 = c0 ? v0 : (c1 ? gte : v1); i1 = c0 ? i0 : (c1 ? n : i1);
            v0 = c0 ? gte : v0; i0 = c0 ? n : i0; }
        LAS unsigned* lc = (LAS unsigned*)(F.lds + MISC_OFF + 8192); LAS unsigned* lbase = lc + 64;
        if (F.tid < 64) lc[F.tid] = 0u;
        __syncthreads();
        unsigned r0 = 0u, r1 = 0u, r2 = 0u;
        if (i0 >= 0) r0 = atomicAdd((unsigned*)(lc + i0), 1u);
        if (i1 >= 0) r1 = atomicAdd((unsigned*)(lc + i1), 1u);
        if (i2 >= 0) r2 = atomicAdd((unsigned*)(lc + i2), 1u);
        __syncthreads();
        if (F.tid < 64) { const unsigned c = lc[F.tid]; lbase[F.tid] = c ? atomicAdd(lcnt + bh * 64 + F.tid, c) : 0u; }
        __syncthreads();
        unsigned short* lb = list + (size_t)bh * LSTRIDE;
        if (i0 >= 0) lb[list_off(i0) + lbase[i0] + r0] = (unsigned short)(tl | (0 << 14));
        if (i1 >= 0) lb[list_off(i1) + lbase[i1] + r1] = (unsigned short)(tl | (1 << 14));
        if (i2 >= 0) lb[list_off(i2) + lbase[i2] + r2] = (unsigned short)(tl | (2 << 14));
    }
    __syncthreads();
}
DI void att_phase(Frame& F, int l) {
    const bf16* Q = (const bf16*)(WSP(F) + WS_Q); const bf16* K = (const bf16*)(WSP(F) + WS_K); const bf16* VT = (const bf16*)(WSP(F) + WS_VT);
    const unsigned short* list = (const unsigned short*)(WSP(F) + WS_LIST); const unsigned* lcnt = (const unsigned*)(WSP(F) + WS_CTL) + CW_LCNT + 1024 * l;
    bf16* PO = (bf16*)(WSP(F) + WS_PARTO); float* PML = (float*)(WSP(F) + WS_PARTML);
    LAS unsigned char* Kl = F.lds;
    LAS unsigned char* Vl = F.lds + 36864;
    LAS int* pre = (LAS int*)(F.lds + MISC_OFF + 8192);
    LAS int* cl = (LAS int*)(F.lds + MISC_OFF + 12288); LAS int* ws8 = (LAS int*)(F.lds + MISC_OFF + 4352);
    const int lane = F.lane, wave = F.wave, qi = lane & 15, quad = lane >> 4;
    __syncthreads();
    { const int c0 = (int)__hip_atomic_load(lcnt + 2 * F.tid, __ATOMIC_RELAXED, __HIP_MEMORY_SCOPE_AGENT), c1 = (int)__hip_atomic_load(lcnt + 2 * F.tid + 1, __ATOMIC_RELAXED, __HIP_MEMORY_SCOPE_AGENT);
      cl[2 * F.tid] = c0; cl[2 * F.tid + 1] = c1; const int t0 = (c0 + 127) >> 7, t1 = (c1 + 127) >> 7; int inc = t0 + t1;
#pragma unroll
      for (int o = 1; o < 64; o <<= 1) { const int u = __shfl_up(inc, o); if (lane >= o) inc += u; }
      if (lane == 63) ws8[wave] = inc;
      __syncthreads();
      int off = 0;
#pragma unroll
      for (int w = 0; w < 8; ++w) { const int x = ws8[w]; if (w < wave) off += x; }
      const int ex = off + inc - (t0 + t1); pre[2 * F.tid] = ex; pre[2 * F.tid + 1] = ex + t0;
      __syncthreads();
      if (F.tid == 511) ws8[8] = off + inc; }
    __syncthreads();
    const int NL = __builtin_amdgcn_readfirstlane(ws8[8]), total = NL + BATCH * 8 * 64 * 2, per = (total + F.G - 1) / F.G;
    const int it0 = F.bid * per, it1 = (it0 + per < total) ? it0 + per : total;
    int cur = 0, loaded = -1;
    if (it0 < NL) { int lo = 0, hi = 1023;
        while (lo < hi) { const int mid = (lo + hi + 1) >> 1; if (pre[mid] <= it0) lo = mid; else hi = mid - 1; }
        cur = lo; }
    struct QA { int i, tile, own_item; bool valid; unsigned short ent; };
    struct QB { int i, own_item, tl, j; bool valid; bf16x8_t qf[2]; };
#define DEC_A(itx, R) do { int i_, tile_, own_; \
        if ((itx) < NL) { while (cur < 1023 && pre[cur + 1] <= (itx)) ++cur; i_ = cur; tile_ = (itx) - pre[cur]; own_ = 0; } \
        else { const int o_ = (itx) - NL; i_ = o_ >> 1; tile_ = o_ & 1; own_ = 1; } \
        i_ = __builtin_amdgcn_readfirstlane(i_); tile_ = __builtin_amdgcn_readfirstlane(tile_); \
        R.i = i_; R.tile = tile_; R.own_item = own_; R.ent = 0; R.valid = true; \
        if (!own_) { const int e_ = tile_ * 128 + wave * 16 + qi; R.valid = e_ < cl[i_]; if (R.valid) R.ent = list[(size_t)(i_ >> 6) * LSTRIDE + list_off(i_ & 63) + e_]; } } while (0)
#define DEC_B(A, R) do { const int bh_ = A.i >> 6, n_ = A.i & 63; R.i = A.i; R.own_item = A.own_item; R.valid = A.valid; \
        if (A.own_item) { R.tl = n_ * 256 + A.tile * 128 + wave * 16 + qi; R.j = 3; } else { R.tl = A.ent & 0x3fff; R.j = A.ent >> 14; } \
        { const size_t t_ = (size_t)(bh_ >> 3) * SEQ + R.tl; \
          R.qf[0] = *(const bf16x8_t*)(Q + t_ * 512 + (bh_ & 7) * 64 + quad * 8); R.qf[1] = *(const bf16x8_t*)(Q + t_ * 512 + (bh_ & 7) * 64 + 32 + quad * 8); } } while (0)
    QA na; na.i = 0; na.tile = 0; na.own_item = 1; na.valid = false; na.ent = 0;
    QB nx; nx.i = -1; nx.own_item = 0; nx.tl = 0; nx.j = 0; nx.valid = false; nx.qf[0] = (bf16x8_t){0, 0, 0, 0, 0, 0, 0, 0}; nx.qf[1] = nx.qf[0];
    if (it0 < it1) { DEC_A(it0, na); DEC_B(na, nx); if (it0 + 1 < it1) DEC_A(it0 + 1, na); }
    for (int it = it0; it < it1; ++it) {
        const int i = nx.i, own_item = nx.own_item, tl = nx.tl, j = nx.j; const bool valid = nx.valid; bf16x8_t qf[2] = {nx.qf[0], nx.qf[1]};
        const int bh = i >> 6, n = i & 63, b = bh >> 3, h = bh & 7;
        if (i != loaded) {
            __syncthreads();
#pragma unroll
            for (int r = 0; r < 4; ++r) { const int c = F.tid + r * 512, row = c >> 3, ch = c & 7;
                const u32x4 w = *(const u32x4*)(K + ((size_t)b * SEQ + n * 256 + row) * 512 + h * 64 + ch * 8); *(LAS u32x4*)(Kl + row * 144 + ch * 16) = w; }
#pragma unroll
            for (int r = 0; r < 4; ++r) { const int c = F.tid + r * 512, row = c >> 5, ch = c & 31;
                const u32x4 w = *(const u32x4*)(VT + ((size_t)bh * 64 + row) * SEQ + n * 256 + ch * 8); *(LAS u32x4*)(Vl + row * 528 + ch * 16) = w; }
            __syncthreads();
            loaded = i;
        }
        if (it + 1 < it1) { DEC_B(na, nx); if (it + 2 < it1) DEC_A(it + 2, na); }
        const size_t t = (size_t)b * SEQ + tl;
        const float slope2 = __builtin_amdgcn_exp2f(-(float)(h + 1)) * LOG2E;
        const bool half_only = own_item && (__builtin_amdgcn_readfirstlane(tl - n * 256) < 128);
        const int tloc = tl - n * 256;
        const float sbase = slope2 * (float)(quad * 4); const int tq4 = tloc - quad * 4;
        f32x4 sc[16];
#pragma unroll
        for (int kt = 0; kt < 16; ++kt) {
            if (kt >= 8 && half_only) { sc[kt] = (f32x4){-INFINITY, -INFINITY, -INFINITY, -INFINITY}; continue; }
            f32x4 a = {fmaf(slope2, (float)(kt * 16), sbase), fmaf(slope2, (float)(kt * 16 + 1), sbase), fmaf(slope2, (float)(kt * 16 + 2), sbase), fmaf(slope2, (float)(kt * 16 + 3), sbase)};
#pragma unroll
            for (int ks = 0; ks < 2; ++ks) { const bf16x8_t kf = *(const LAS bf16x8_t*)(Kl + (kt * 16 + qi) * 144 + ks * 64 + quad * 16); a = __builtin_amdgcn_mfma_f32_16x16x32_bf16(kf, qf[ks], a, 0, 0, 0); }
            sc[kt] = a; if ((kt & 3) == 3) asm volatile("" ::: "memory"); }
        if (own_item) {
#pragma unroll
            for (int kt = 0; kt < 16; ++kt)
#pragma unroll
                for (int e = 0; e < 4; ++e) if ((kt * 16 + e) > tq4) sc[kt][e] = -INFINITY; }
        float mx = -INFINITY;
#pragma unroll
        for (int kt = 0; kt < 16; ++kt)
#pragma unroll
            for (int e = 0; e < 4; ++e) mx = fmaxf(mx, sc[kt][e]);
        mx = fmaxf(mx, __shfl_xor(mx, 16)); mx = fmaxf(mx, __shfl_xor(mx, 32));
        float ls = 0.f;
#pragma unroll
        for (int kt = 0; kt < 16; ++kt)
#pragma unroll
            for (int e = 0; e < 4; ++e) { const float p = __builtin_amdgcn_exp2f(sc[kt][e] - mx); sc[kt][e] = p; ls += p; }
        ls += __shfl_xor(ls, 16); ls += __shfl_xor(ls, 32);
        f32x4 o[4];
#pragma unroll
        for (int dt = 0; dt < 4; ++dt) o[dt] = (f32x4){0.f, 0.f, 0.f, 0.f};
#pragma unroll
        for (int k2 = 0; k2 < 8; ++k2) {
            if (k2 >= 4 && half_only) break;
            u32x4 pw; pw.x = pg8::cvt_pk_bf16(sc[2 * k2][0], sc[2 * k2][1]); pw.y = pg8::cvt_pk_bf16(sc[2 * k2][2], sc[2 * k2][3]);
            pw.z = pg8::cvt_pk_bf16(sc[2 * k2 + 1][0], sc[2 * k2 + 1][1]); pw.w = pg8::cvt_pk_bf16(sc[2 * k2 + 1][2], sc[2 * k2 + 1][3]);
            const bf16x8_t pf = __builtin_bit_cast(bf16x8_t, pw);
#pragma unroll
            for (int dt = 0; dt < 4; ++dt) { const LAS unsigned char* vp = Vl + (dt * 16 + qi) * 528 + (k2 * 32 + quad * 4) * 2;
                const u32x2 lo = *(const LAS u32x2*)vp, hi = *(const LAS u32x2*)(vp + 32);
                const u32x4 vw = {lo.x, lo.y, hi.x, hi.y};
                o[dt] = __builtin_amdgcn_mfma_f32_16x16x32_bf16(__builtin_bit_cast(bf16x8_t, vw), pf, o[dt], 0, 0, 0); }
            if (k2 & 1) asm volatile("" ::: "memory"); }
        if (valid) { const float inv = frcp_(ls); const size_t pidx = (t * 8 + h) * 4 + j; bf16* op = PO + pidx * 64 + quad * 4;
#pragma unroll
            for (int dt = 0; dt < 4; ++dt) *(u32x2*)(op + dt * 16) = (u32x2){pg8::cvt_pk_bf16(o[dt][0] * inv, o[dt][1] * inv), pg8::cvt_pk_bf16(o[dt][2] * inv, o[dt][3] * inv)};
            if (quad == 0) ((float2*)PML)[pidx] = make_float2(mx - slope2 * (float)tloc, ls); }
    }
#undef DEC_A
#undef DEC_B
    __syncthreads();
}
DI void comb_phase(Frame& F) {
    const bf16* PO = (const bf16*)(WSP(F) + WS_PARTO); const float* PML = (const float*)(WSP(F) + WS_PARTML); bf16* Y = (bf16*)(WSP(F) + WS_YATTN);
    const int gw = F.bid * 8 + F.wave, NGW = F.G * 8, lane = F.lane, h = lane >> 3, dc = lane & 7;
    for (int t = gw; t < T; t += NGW) {
        const int own = (t % SEQ) >> 8, nsel = own < 3 ? own : 3; const size_t pb = ((size_t)t * 8 + h) * 4;
        float m[4], lw[4]; float M = -INFINITY;
#pragma unroll
        for (int j = 0; j < 4; ++j) { const bool ok = (j == 3) || (j < nsel); const float2 ml = ok ? ((const float2*)PML)[pb + j] : make_float2(-INFINITY, 0.f); m[j] = ml.x; lw[j] = ml.y; M = fmaxf(M, ml.x); }
        float acc[8] = {0.f, 0.f, 0.f, 0.f, 0.f, 0.f, 0.f, 0.f}; float wsum = 0.f;
#pragma unroll
        for (int j = 0; j < 4; ++j) { const bool ok = (j == 3) || (j < nsel); if (!ok) continue;
            const float w = __builtin_amdgcn_exp2f(m[j] - M) * lw[j]; wsum += w; const u32x4 ow = *(const u32x4*)(PO + (pb + j) * 64 + dc * 8);
            acc[0] += w * blo(ow.x); acc[1] += w * bhi(ow.x); acc[2] += w * blo(ow.y); acc[3] += w * bhi(ow.y); acc[4] += w * blo(ow.z); acc[5] += w * bhi(ow.z); acc[6] += w * blo(ow.w); acc[7] += w * bhi(ow.w); }
        const float inv = frcp_(wsum);
        *(u32x4*)(Y + (size_t)t * 512 + h * 64 + dc * 8) = (u32x4){pk2(acc[0] * inv, acc[1] * inv), pk2(acc[2] * inv, acc[3] * inv), pk2(acc[4] * inv, acc[5] * inv), pk2(acc[6] * inv, acc[7] * inv)};
    }
}
DI void pool_phase(Frame& F, int l) {
    const bf16* Z = (const bf16*)(WSP(F) + WS_POOLZ); bf16* Y = (bf16*)(WSP(F) + WS_YPOOL); const bf16* WPT = (const bf16*)(WSP(F) + WS_WPT);
    LAS unsigned char* Pl = F.lds;
    const int lane = F.lane, li = lane & 15, quad = lane >> 4, g = F.wave >> 1, dt0 = (F.wave & 1) * 4;
    bf16x8_t wf[4][4];
#pragma unroll
    for (int dt = 0; dt < 4; ++dt)
#pragma unroll
        for (int ks = 0; ks < 4; ++ks) wf[dt][ks] = *(const bf16x8_t*)(WPT + ((size_t)g * 128 + 16 * (dt0 + dt) + li) * 128 + 32 * ks + 8 * quad);
    for (int tile = F.bid; tile < T / 64; tile += F.G) {
        __syncthreads();
#pragma unroll 1
        for (int i = F.tid; i < 64 * 64; i += 512) { const int tt = i >> 6, ch = i & 63, gg = ch >> 4, win = 2 << gg, t = tile * 64 + tt, tl = t % SEQ; const int cnt = (tl + 1 < win) ? tl + 1 : win;
            u32x4 w[16];
#pragma unroll
            for (int j = 0; j < 16; ++j) { w[j] = (u32x4){0u, 0u, 0u, 0u}; if (j < cnt) w[j] = *(const u32x4*)(Z + (size_t)(t - j) * 512 + ch * 8); }
            float s[8] = {0.f, 0.f, 0.f, 0.f, 0.f, 0.f, 0.f, 0.f};
#pragma unroll
            for (int j = 0; j < 16; ++j) { s[0] += blo(w[j].x); s[1] += bhi(w[j].x); s[2] += blo(w[j].y); s[3] += bhi(w[j].y); s[4] += blo(w[j].z); s[5] += bhi(w[j].z); s[6] += blo(w[j].w); s[7] += bhi(w[j].w); }
            const float inv = 1.0f / (float)cnt;
            *(LAS u32x4*)(Pl + tt * 1040 + ch * 16) = (u32x4){pk2(s[0] * inv - blo(w[0].x), s[1] * inv - bhi(w[0].x)), pk2(s[2] * inv - blo(w[0].y), s[3] * inv - bhi(w[0].y)),
                                                                 pk2(s[4] * inv - blo(w[0].z), s[5] * inv - bhi(w[0].z)), pk2(s[6] * inv - blo(w[0].w), s[7] * inv - bhi(w[0].w))}; }
        __syncthreads();
#pragma unroll
        for (int tt = 0; tt < 4; ++tt) {
            bf16x8_t pf[4];
#pragma unroll
            for (int ks = 0; ks < 4; ++ks) pf[ks] = *(const LAS bf16x8_t*)(Pl + (16 * tt + li) * 1040 + (g * 128 + 32 * ks + 8 * quad) * 2);
#pragma unroll
            for (int dt = 0; dt < 4; ++dt) { f32x4 acc = {0.f, 0.f, 0.f, 0.f};
#pragma unroll
                for (int ks = 0; ks < 4; ++ks) acc = __builtin_amdgcn_mfma_f32_16x16x32_bf16(wf[dt][ks], pf[ks], acc, 0, 0, 0);
                *(u32x2*)(Y + (size_t)(tile * 64 + 16 * tt + li) * 512 + g * 128 + 16 * (dt0 + dt) + 4 * quad) = (u32x2){pk2(acc[0], acc[1]), pk2(acc[2], acc[3])}; } }
    }
    __syncthreads();
}
DI void rwkv_prep_phase(Frame& F, int l) {
    const bf16* RZ = (const bf16*)(WSP(F) + WS_RWKVZ); bf16* VF = (bf16*)(WSP(F) + WS_VFIRST);
    bf16* AR = (bf16*)(WSP(F) + WS_AR); const size_t AS = (size_t)T * 512;
    float* bonus = (float*)(WSP(F) + WS_BONUS); float* kinv = (float*)(WSP(F) + WS_KINV); const bf16* WLT = (const bf16*)(WSP(F) + WS_WLT);
    LAS unsigned char* Al = F.lds;
    const int h = F.wave;
    const float* mu = INP(F, 4) + l * 1792; const float* vmu = INP(F, 5) + (l > 0 ? (l - 1) * 32 : 0);
    const float* w0p = INP(F, 6) + l * 512 + h * 64; const float* a0p = INP(F, 8) + l * 512 + h * 64; const float* kkp = INP(F, 11) + l * 512 + h * 64;
    const float* kap = INP(F, 12) + l * 512 + h * 64; const float* rkp = INP(F, 13) + l * 512 + h * 64; const float* v0p = INP(F, 16) + (l > 0 ? l - 1 : 0) * 512 + h * 64;
    for (int item = F.bid; item < T / 64; item += F.G) {
        int tid = F.tid; asm volatile("" : "+v"(tid));
        const int lane = tid & 63, li = lane & 15, quad = lane >> 4;
        const int t0 = item * 64, tl0 = t0 % SEQ;
        __syncthreads();
        { const int tok = tid >> 3, c0 = tid & 7; const size_t t = (size_t)(t0 + tok); const bool first = (tl0 + tok == 0);
          u32x4 zc[5], zp[5]; f32x4 m0[5], m1[5];
#pragma unroll
          for (int r = 0; r < 5; ++r) { const int c = c0 + 8 * r; zc[r] = (u32x4){0u, 0u, 0u, 0u}; zp[r] = zc[r]; m0[r] = (f32x4){0.f, 0.f, 0.f, 0.f}; m1[r] = m0[r];
              if (c < 32 || (l > 0 && c < 36)) { const int col = 1536 + 8 * c; zc[r] = *(const u32x4*)(RZ + t * RZP + col); if (!first) zp[r] = *(const u32x4*)(RZ + (t - 1) * RZP + col);
                  const float* mp = col < 1792 ? mu + col : vmu + (col - 1792); m0[r] = *(const f32x4*)mp; m1[r] = *(const f32x4*)(mp + 4); } }
#pragma unroll
          for (int r = 0; r < 5; ++r) { const int c = c0 + 8 * r; if (c < 36) {
              const float cv[8] = {blo(zc[r].x), bhi(zc[r].x), blo(zc[r].y), bhi(zc[r].y), blo(zc[r].z), bhi(zc[r].z), blo(zc[r].w), bhi(zc[r].w)}, pv[8] = {blo(zp[r].x), bhi(zp[r].x), blo(zp[r].y), bhi(zp[r].y), blo(zp[r].z), bhi(zp[r].z), blo(zp[r].w), bhi(zp[r].w)};
              const float mm[8] = {m0[r].x, m0[r].y, m0[r].z, m0[r].w, m1[r].x, m1[r].y, m1[r].z, m1[r].w}; float f[8];
#pragma unroll
              for (int e = 0; e < 8; ++e) { const float zs = cv[e] + (pv[e] - cv[e]) * mm[e]; f[e] = r == 0 ? tanhf(zs) : (r == 2 || r == 3) ? sigmoidf_(zs) : zs; }
              *(LAS u32x4*)(Al + tok * 592 + c * 16) = (u32x4){pk2(f[0], f[1]), pk2(f[2], f[3]), pk2(f[4], f[5]), pk2(f[6], f[7])}; } } }
        __syncthreads();
        float ssq[4] = {0.f, 0.f, 0.f, 0.f}, bsm[4] = {0.f, 0.f, 0.f, 0.f};
#pragma unroll 1
        for (int ct = 0; ct < 4; ++ct) {
            const int cb = 16 * ct + 4 * quad;
            bf16x8_t wf[9];
#pragma unroll
            for (int ks = 0; ks < 9; ++ks) wf[ks] = *(const bf16x8_t*)(WLT + (size_t)(h * 64 + 16 * ct + li) * 288 + 32 * ks + 8 * quad);
            const f32x4 mr = *(const f32x4*)(mu + h * 64 + cb), mk = *(const f32x4*)(mu + 512 + h * 64 + cb), mv = *(const f32x4*)(mu + 1024 + h * 64 + cb);
            const f32x4 w0 = *(const f32x4*)(w0p + cb), a0 = *(const f32x4*)(a0p + cb), kkc = *(const f32x4*)(kkp + cb), kac = *(const f32x4*)(kap + cb), rkc = *(const f32x4*)(rkp + cb);
            f32x4 v0 = {0.f, 0.f, 0.f, 0.f}; if (l > 0) v0 = *(const f32x4*)(v0p + cb);
            u32x2 zr[4][2], zk[4][2], zv[4][2], vfw[4];
#pragma unroll
            for (int rt = 0; rt < 4; ++rt) { const int tok = 16 * rt + li; const size_t zi = (size_t)(t0 + tok) * RZP + h * 64 + cb; const bool first = (tl0 + tok == 0);
                zr[rt][0] = *(const u32x2*)(RZ + zi); zk[rt][0] = *(const u32x2*)(RZ + zi + 512); zv[rt][0] = *(const u32x2*)(RZ + zi + 1024);
                zr[rt][1] = (u32x2){0u, 0u}; zk[rt][1] = zr[rt][1]; zv[rt][1] = zr[rt][1]; vfw[rt] = zr[rt][1];
                if (!first) { zr[rt][1] = *(const u32x2*)(RZ + zi - RZP); zk[rt][1] = *(const u32x2*)(RZ + zi - RZP + 512); zv[rt][1] = *(const u32x2*)(RZ + zi - RZP + 1024); }
                if (l > 0) vfw[rt] = *(const u32x2*)(VF + (size_t)(t0 + tok) * 512 + h * 64 + cb); }
#pragma unroll
            for (int rt = 0; rt < 4; ++rt) { const int tok = 16 * rt + li; const size_t idx = (size_t)(t0 + tok) * 512 + h * 64 + cb;
                f32x4 aw = {0.f, 0.f, 0.f, 0.f}, aa = aw, ag = aw, av = aw;
#pragma unroll
                for (int ks = 0; ks < 9; ++ks) { if (ks == 8 && l == 0) break;
                    const bf16x8_t bfr = *(const LAS bf16x8_t*)(Al + tok * 592 + ks * 64 + quad * 16);
                    if (ks < 2) aw = __builtin_amdgcn_mfma_f32_16x16x32_bf16(wf[ks], bfr, aw, 0, 0, 0);
                    else if (ks < 4) aa = __builtin_amdgcn_mfma_f32_16x16x32_bf16(wf[ks], bfr, aa, 0, 0, 0);
                    else if (ks < 8) ag = __builtin_amdgcn_mfma_f32_16x16x32_bf16(wf[ks], bfr, ag, 0, 0, 0);
                    else av = __builtin_amdgcn_mfma_f32_16x16x32_bf16(wf[ks], bfr, av, 0, 0, 0); }
                const float crf[4] = {blo(zr[rt][0].x), bhi(zr[rt][0].x), blo(zr[rt][0].y), bhi(zr[rt][0].y)}, prf[4] = {blo(zr[rt][1].x), bhi(zr[rt][1].x), blo(zr[rt][1].y), bhi(zr[rt][1].y)};
                const float ckf[4] = {blo(zk[rt][0].x), bhi(zk[rt][0].x), blo(zk[rt][0].y), bhi(zk[rt][0].y)}, pkf[4] = {blo(zk[rt][1].x), bhi(zk[rt][1].x), blo(zk[rt][1].y), bhi(zk[rt][1].y)};
                const float cvf[4] = {blo(zv[rt][0].x), bhi(zv[rt][0].x), blo(zv[rt][0].y), bhi(zv[rt][0].y)}, pvf[4] = {blo(zv[rt][1].x), bhi(zv[rt][1].x), blo(zv[rt][1].y), bhi(zv[rt][1].y)};
                const float vff[4] = {blo(vfw[rt].x), bhi(vfw[rt].x), blo(vfw[rt].y), bhi(vfw[rt].y)};
                float ro[4], lwo[4], kpo[4], vo[4], kro[4], bbo[4];
#pragma unroll
                for (int e = 0; e < 4; ++e) { const float r = crf[e] + (prf[e] - crf[e]) * mr[e], k = ckf[e] + (pkf[e] - ckf[e]) * mk[e]; float v = cvf[e] + (pvf[e] - cvf[e]) * mv[e];
                    const float xw = -(w0[e] + aw[e]); const float sp = xw > 20.f ? xw : log1pf(__expf(xw)); lwo[e] = -__expf(-sp - 0.5f);
                    const float asig = sigmoidf_(a0[e] + aa[e]);
                    if (l > 0) v = v + (vff[e] - v) * sigmoidf_(v0[e] + av[e]);
                    vo[e] = v; ro[e] = r; const float kr = k * kkc[e]; kro[e] = kr; bbo[e] = kr * asig; ssq[rt] += kr * kr;
                    const float kpe = k * (1.0f + (asig - 1.0f) * kac[e]); kpo[e] = kpe; bsm[rt] += r * kpe * rkc[e]; }
                if (l == 0) *(u32x2*)(VF + idx) = (u32x2){pk2(vo[0], vo[1]), pk2(vo[2], vo[3])};
                *(u32x2*)(AR + idx) = (u32x2){pk2(ro[0], ro[1]), pk2(ro[2], ro[3])};
                *(u32x2*)(AR + AS + idx) = (u32x2){pk2(lwo[0], lwo[1]), pk2(lwo[2], lwo[3])};
                *(u32x2*)(AR + 2 * AS + idx) = (u32x2){pk2(kpo[0], kpo[1]), pk2(kpo[2], kpo[3])};
                *(u32x2*)(AR + 3 * AS + idx) = (u32x2){pk2(vo[0], vo[1]), pk2(vo[2], vo[3])};
                *(u32x2*)(AR + 4 * AS + idx) = (u32x2){pk2(kro[0], kro[1]), pk2(kro[2], kro[3])};
                *(u32x2*)(AR + 5 * AS + idx) = (u32x2){pk2(bbo[0], bbo[1]), pk2(bbo[2], bbo[3])};
                *(u32x2*)(AR + 6 * AS + idx) = (u32x2){pk2(ag[0], ag[1]), pk2(ag[2], ag[3])}; asm volatile("" ::: "memory"); }
        }
#pragma unroll
        for (int rt = 0; rt < 4; ++rt) { float ss = ssq[rt], bs = bsm[rt]; ss += __shfl_xor(ss, 16); ss += __shfl_xor(ss, 32); bs += __shfl_xor(bs, 16); bs += __shfl_xor(bs, 32);
            if (quad == 0) { const size_t t = (size_t)(t0 + 16 * rt + li); bonus[t * 8 + h] = bs; kinv[t * 8 + h] = 1.0f / fmaxf(sqrtf(ss), 1e-12f); } }
    }
    __syncthreads();
}
typedef short bf16x4_t __attribute__((ext_vector_type(4)));
DI void rwkv_chunk_phase(Frame& F, int l) {
    const bf16* RZ = (const bf16*)(WSP(F) + WS_RWKVZ); bf16* VF = (bf16*)(WSP(F) + WS_VFIRST);
    bf16* AR = (bf16*)(WSP(F) + WS_AR); const size_t AS = (size_t)T * 512; float* bonus = (float*)(WSP(F) + WS_BONUS); const bf16* WLT = (const bf16*)(WSP(F) + WS_WLT);
    bf16* PCT = (bf16*)(WSP(F) + WS_PCT); bf16* LC = (bf16*)(WSP(F) + WS_LC); bf16* RM = (bf16*)(WSP(F) + WS_RM); bf16* Y0 = (bf16*)(WSP(F) + WS_Y0);
    const float* mu = INP(F, 4) + l * 1792; const float* vmu = INP(F, 5) + (l > 0 ? (l - 1) * 32 : 0);
    constexpr int ST = 144;
    LAS unsigned char* L = F.lds;
    LAS unsigned char* AT = L; LAS unsigned char* BT = L + 9216; LAS unsigned char* KT = L + 18432; LAS unsigned char* RT = L + 27648;
    LAS unsigned char* BTT = L + 36864; LAS unsigned char* KTT = L + 46080; LAS unsigned char* VTl = L + 55296; LAS unsigned char* NB = L + 64512; LAS unsigned char* MB = L + 73728;
    LAS unsigned char* WMT = L + 82944; LAS unsigned char* UMT = L + 92160;
    LAS unsigned char* Al = L + 64512;
    LAS unsigned char* SR = L + 64512; LAS unsigned char* SKP = L + 72704; LAS unsigned char* SKR = L + 80896; LAS unsigned char* SBB = L + 89088;
    LAS float* LGF = (LAS float*)(L + 101376); LAS float* ND = (LAS float*)(L + 117760); LAS unsigned char* DB = L + 122112; LAS float* GC = (LAS float*)(L + 125184); LAS float* PART = (LAS float*)(L + 125440);
    LAS float* SSP = (LAS float*)(L + 127488); LAS float* BSP = SSP + 256;
    const int wave = F.wave;
#define MF32(a, b, c) __builtin_amdgcn_mfma_f32_16x16x32_bf16((a), (b), (c), 0, 0, 0)
#define MF16(a, b, c) __builtin_amdgcn_mfma_f32_16x16x16bf16_1k((a), (b), (c), 0, 0, 0)
#define RD8(p) (*(const LAS bf16x8_t*)(p))
#define RD4(p) (*(const LAS bf16x4_t*)(p))
    u32x4 zcn[5], zpn[5], areg[5];
#define F1LOAD(ckx) do { const int b_ = (ckx) >> 8, ck_ = (ckx) & 255; const size_t t_ = (size_t)b_ * SEQ + ck_ * 64 + (F.tid >> 3); const bool first_ = (ck_ * 64 + (F.tid >> 3) == 0); \
        _Pragma("unroll") for (int r_ = 0; r_ < 5; ++r_) { const int c_ = (F.tid & 7) + 8 * r_; zcn[r_] = (u32x4){0u, 0u, 0u, 0u}; zpn[r_] = zcn[r_]; \
            if (c_ < 32 || (l > 0 && c_ < 36)) { const int col_ = 1536 + 8 * c_; zcn[r_] = *(const u32x4*)(RZ + t_ * RZP + col_); if (!first_) zpn[r_] = *(const u32x4*)(RZ + (t_ - 1) * RZP + col_); } } } while (0)
    if (F.bid < BATCH * (SEQ / 64)) F1LOAD(F.bid);
    for (int cki = F.bid; cki < BATCH * (SEQ / 64); cki += F.G) {
      {
          const int c0 = F.tid & 7; f32x4 m0[5], m1[5];
#pragma unroll
          for (int r = 0; r < 5; ++r) { const int c = c0 + 8 * r; m0[r] = (f32x4){0.f, 0.f, 0.f, 0.f}; m1[r] = m0[r];
              if (c < 32 || (l > 0 && c < 36)) { const int col = 1536 + 8 * c; const float* mp = col < 1792 ? mu + col : vmu + (col - 1792); m0[r] = *(const f32x4*)mp; m1[r] = *(const f32x4*)(mp + 4); } }
#pragma unroll
          for (int r = 0; r < 5; ++r) {
              const float cv[8] = {blo(zcn[r].x), bhi(zcn[r].x), blo(zcn[r].y), bhi(zcn[r].y), blo(zcn[r].z), bhi(zcn[r].z), blo(zcn[r].w), bhi(zcn[r].w)}, pv[8] = {blo(zpn[r].x), bhi(zpn[r].x), blo(zpn[r].y), bhi(zpn[r].y), blo(zpn[r].z), bhi(zpn[r].z), blo(zpn[r].w), bhi(zpn[r].w)};
              const float mm[8] = {m0[r].x, m0[r].y, m0[r].z, m0[r].w, m1[r].x, m1[r].y, m1[r].z, m1[r].w}; float f[8];
#pragma unroll
              for (int e = 0; e < 8; ++e) { const float zs = cv[e] + (pv[e] - cv[e]) * mm[e]; f[e] = r == 0 ? ftanh_(zs) : (r == 2 || r == 3) ? sigmoidf_(zs) : zs; }
              areg[r] = (u32x4){pk2(f[0], f[1]), pk2(f[2], f[3]), pk2(f[4], f[5]), pk2(f[6], f[7])}; } }
#pragma unroll 1
      for (int h = 0; h < 8; ++h) {
        int tid = F.tid; asm volatile("" : "+v"(tid));
        const int lane = tid & 63, li = lane & 15, quad = lane >> 4;
        const int b = cki >> 8, ck = cki & 255, bh = b * 8 + h, it = bh * 256 + ck;
        const size_t tbase = (size_t)b * SEQ + ck * 64; const int tl0 = ck * 64;
        __syncthreads();
        { const int tok = tid >> 3, c0 = tid & 7;
#pragma unroll
          for (int r = 0; r < 5; ++r) { const int c = c0 + 8 * r; if (c < 36) *(LAS u32x4*)(Al + tok * 576 + c * 16) = areg[r]; } }
        __syncthreads();
        { const int ct = wave & 3, hw = wave >> 2, cb = 16 * ct + 4 * quad;
          bf16x8_t wf[9];
#pragma unroll
          for (int ks = 0; ks < 9; ++ks) wf[ks] = *(const bf16x8_t*)(WLT + (size_t)(h * 64 + 16 * ct + li) * 288 + 32 * ks + 8 * quad);
          const f32x4 mr = *(const f32x4*)(mu + h * 64 + cb), mk = *(const f32x4*)(mu + 512 + h * 64 + cb), mv = *(const f32x4*)(mu + 1024 + h * 64 + cb);
          const f32x4 w0 = *(const f32x4*)(INP(F, 6) + l * 512 + h * 64 + cb), a0 = *(const f32x4*)(INP(F, 8) + l * 512 + h * 64 + cb), kkc = *(const f32x4*)(INP(F, 11) + l * 512 + h * 64 + cb);
          const f32x4 kac = *(const f32x4*)(INP(F, 12) + l * 512 + h * 64 + cb), rkc = *(const f32x4*)(INP(F, 13) + l * 512 + h * 64 + cb);
          f32x4 v0 = {0.f, 0.f, 0.f, 0.f}; if (l > 0) v0 = *(const f32x4*)(INP(F, 16) + (l - 1) * 512 + h * 64 + cb);
          u32x2 zr[2][2], zk[2][2], zv[2][2], vfw[2]; f32x4 aw[2], aa[2], ag[2], av[2];
#pragma unroll
          for (int rr = 0; rr < 2; ++rr) { const int tok = 16 * (2 * hw + rr) + li; const size_t zi = (tbase + tok) * RZP + h * 64 + cb; const bool first = (tl0 + tok == 0);
              zr[rr][0] = *(const u32x2*)(RZ + zi); zk[rr][0] = *(const u32x2*)(RZ + zi + 512); zv[rr][0] = *(const u32x2*)(RZ + zi + 1024);
              zr[rr][1] = (u32x2){0u, 0u}; zk[rr][1] = zr[rr][1]; zv[rr][1] = zr[rr][1]; vfw[rr] = zr[rr][1];
              if (!first) { zr[rr][1] = *(const u32x2*)(RZ + zi - RZP); zk[rr][1] = *(const u32x2*)(RZ + zi - RZP + 512); zv[rr][1] = *(const u32x2*)(RZ + zi - RZP + 1024); }
              if (l > 0) vfw[rr] = *(const u32x2*)(VF + (tbase + tok) * 512 + h * 64 + cb); }
#pragma unroll
          for (int rr = 0; rr < 2; ++rr) { const int tok = 16 * (2 * hw + rr) + li; aw[rr] = (f32x4){0.f, 0.f, 0.f, 0.f}; aa[rr] = aw[rr]; ag[rr] = aw[rr]; av[rr] = aw[rr];
#pragma unroll
              for (int ks = 0; ks < 9; ++ks) { if (ks == 8 && l == 0) break;
                  const bf16x8_t bfr = RD8(Al + tok * 576 + ks * 64 + quad * 16);
                  if (ks < 2) aw[rr] = MF32(wf[ks], bfr, aw[rr]); else if (ks < 4) aa[rr] = MF32(wf[ks], bfr, aa[rr]); else if (ks < 8) ag[rr] = MF32(wf[ks], bfr, ag[rr]); else av[rr] = MF32(wf[ks], bfr, av[rr]); } }
          __syncthreads();
          if (h == 7 && cki + F.G < BATCH * (SEQ / 64)) F1LOAD(cki + F.G);
#pragma unroll
          for (int rr = 0; rr < 2; ++rr) { const int tok = 16 * (2 * hw + rr) + li; const size_t idx = (tbase + tok) * 512 + h * 64 + cb;
              const float crf[4] = {blo(zr[rr][0].x), bhi(zr[rr][0].x), blo(zr[rr][0].y), bhi(zr[rr][0].y)}, prf[4] = {blo(zr[rr][1].x), bhi(zr[rr][1].x), blo(zr[rr][1].y), bhi(zr[rr][1].y)};
              const float ckf[4] = {blo(zk[rr][0].x), bhi(zk[rr][0].x), blo(zk[rr][0].y), bhi(zk[rr][0].y)}, pkf[4] = {blo(zk[rr][1].x), bhi(zk[rr][1].x), blo(zk[rr][1].y), bhi(zk[rr][1].y)};
              const float cvf[4] = {blo(zv[rr][0].x), bhi(zv[rr][0].x), blo(zv[rr][0].y), bhi(zv[rr][0].y)}, pvf[4] = {blo(zv[rr][1].x), bhi(zv[rr][1].x), blo(zv[rr][1].y), bhi(zv[rr][1].y)};
              const float vff[4] = {blo(vfw[rr].x), bhi(vfw[rr].x), blo(vfw[rr].y), bhi(vfw[rr].y)};
              float ro[4], lwo[4], kpo[4], vo[4], kro[4], bbo[4]; float ss = 0.f, bs = 0.f;
#pragma unroll
              for (int e = 0; e < 4; ++e) { const float r = crf[e] + (prf[e] - crf[e]) * mr[e], k = ckf[e] + (pkf[e] - ckf[e]) * mk[e]; float v = cvf[e] + (pvf[e] - cvf[e]) * mv[e];
                  const float xw = -(w0[e] + aw[rr][e]); const float sp = fsoftplus_(xw); lwo[e] = -fexp_(-sp - 0.5f);
                  const float asig = sigmoidf_(a0[e] + aa[rr][e]);
                  if (l > 0) v = v + (vff[e] - v) * sigmoidf_(v0[e] + av[rr][e]);
                  vo[e] = v; ro[e] = r; const float kr = k * kkc[e]; kro[e] = kr; bbo[e] = kr * asig; ss += kr * kr;
                  const float kpe = k * (1.0f + (asig - 1.0f) * kac[e]); kpo[e] = kpe; bs += r * kpe * rkc[e]; }
              const u32x2 vpk = {pk2(vo[0], vo[1]), pk2(vo[2], vo[3])};
              if (l == 0) *(u32x2*)(VF + idx) = vpk;
              *(u32x2*)(AR + 3 * AS + idx) = vpk; *(u32x2*)(AR + 6 * AS + idx) = (u32x2){pk2(ag[rr][0], ag[rr][1]), pk2(ag[rr][2], ag[rr][3])};
              *(LAS f32x4*)(LGF + tok * 64 + cb) = (f32x4){__uint_as_float(f2bf(lwo[0]) << 16), __uint_as_float(f2bf(lwo[1]) << 16), __uint_as_float(f2bf(lwo[2]) << 16), __uint_as_float(f2bf(lwo[3]) << 16)};
              *(LAS u32x2*)(SR + tok * 128 + cb * 2) = (u32x2){pk2(ro[0], ro[1]), pk2(ro[2], ro[3])}; *(LAS u32x2*)(SKP + tok * 128 + cb * 2) = (u32x2){pk2(kpo[0], kpo[1]), pk2(kpo[2], kpo[3])};
              *(LAS u32x2*)(SKR + tok * 128 + cb * 2) = (u32x2){pk2(kro[0], kro[1]), pk2(kro[2], kro[3])}; *(LAS u32x2*)(SBB + tok * 128 + cb * 2) = (u32x2){pk2(bbo[0], bbo[1]), pk2(bbo[2], bbo[3])};
#pragma unroll
              for (int e = 0; e < 4; ++e) *(LAS unsigned short*)(VTl + (cb + e) * ST + tok * 2) = (unsigned short)f2bf(vo[e]);
              ss += __shfl_xor(ss, 16); ss += __shfl_xor(ss, 32); bs += __shfl_xor(bs, 16); bs += __shfl_xor(bs, 32);
              if (quad == 0) { SSP[ct * 64 + tok] = ss; BSP[ct * 64 + tok] = bs; } } }
        __syncthreads();
        const int et = tid >> 3, ec = (tid & 7) * 8;
        { const int c = tid & 63, p = tid >> 6; float x[8]; float run = 0.f;
#pragma unroll
          for (int i = 0; i < 8; ++i) x[i] = LGF[(8 * p + i) * 64 + c];
#pragma unroll
          for (int i = 0; i < 8; ++i) { run += x[i]; LGF[(8 * p + i) * 64 + c] = run; }
          PART[p * 64 + c] = run; }
        __syncthreads();
        { float lg[8], lgp[8];
          { f32x4 o0 = {0.f, 0.f, 0.f, 0.f}, o1 = o0, q0 = o0, q1 = o0, tot0 = o0, tot1 = o0;
#pragma unroll
            for (int p = 0; p < 8; ++p) { const f32x4 a0 = *(const LAS f32x4*)(PART + p * 64 + ec), a1 = *(const LAS f32x4*)(PART + p * 64 + ec + 4); if (p < (et >> 3)) { o0 += a0; o1 += a1; } if (p < ((et - 1) >> 3)) { q0 += a0; q1 += a1; } tot0 += a0; tot1 += a1; }
            const f32x4 l0 = *(const LAS f32x4*)(LGF + et * 64 + ec) + o0, l1 = *(const LAS f32x4*)(LGF + et * 64 + ec + 4) + o1;
            f32x4 p0 = {0.f, 0.f, 0.f, 0.f}, p1 = p0; if (et > 0) { p0 = *(const LAS f32x4*)(LGF + (et - 1) * 64 + ec) + q0; p1 = *(const LAS f32x4*)(LGF + (et - 1) * 64 + ec + 4) + q1; }
            lg[0] = l0.x; lg[1] = l0.y; lg[2] = l0.z; lg[3] = l0.w; lg[4] = l1.x; lg[5] = l1.y; lg[6] = l1.z; lg[7] = l1.w;
            lgp[0] = p0.x; lgp[1] = p0.y; lgp[2] = p0.z; lgp[3] = p0.w; lgp[4] = p1.x; lgp[5] = p1.y; lgp[6] = p1.z; lgp[7] = p1.w;
            if (et == 63) { *(LAS f32x4*)(GC + ec) = (f32x4){fexp_(tot0.x), fexp_(tot0.y), fexp_(tot0.z), fexp_(tot0.w)}; *(LAS f32x4*)(GC + ec + 4) = (f32x4){fexp_(tot1.x), fexp_(tot1.y), fexp_(tot1.z), fexp_(tot1.w)}; } }
          const float ssum = (SSP[et] + SSP[64 + et]) + (SSP[128 + et] + SSP[192 + et]); const float kiv = __builtin_amdgcn_rsqf(fmaxf(ssum, 1e-24f));
          if (ec == 0) bonus[(tbase + et) * 8 + h] = (BSP[et] + BSP[64 + et]) + (BSP[128 + et] + BSP[192 + et]);
          const u32x4 wr = *(const LAS u32x4*)(SR + et * 128 + ec * 2), wk = *(const LAS u32x4*)(SKP + et * 128 + ec * 2), wkk = *(const LAS u32x4*)(SKR + et * 128 + ec * 2), wbb = *(const LAS u32x4*)(SBB + et * 128 + ec * 2);
          const float rv[8] = {blo(wr.x), bhi(wr.x), blo(wr.y), bhi(wr.y), blo(wr.z), bhi(wr.z), blo(wr.w), bhi(wr.w)}, kv[8] = {blo(wk.x), bhi(wk.x), blo(wk.y), bhi(wk.y), blo(wk.z), bhi(wk.z), blo(wk.w), bhi(wk.w)};
          const float kkv[8] = {blo(wkk.x), bhi(wkk.x), blo(wkk.y), bhi(wkk.y), blo(wkk.z), bhi(wkk.z), blo(wkk.w), bhi(wkk.w)}, bbv[8] = {blo(wbb.x), bhi(wbb.x), blo(wbb.y), bhi(wbb.y), blo(wbb.z), bhi(wbb.z), blo(wbb.w), bhi(wbb.w)};
          unsigned short ab[8], bb_[8], kb_[8], rb[8];
#pragma unroll
          for (int e = 0; e < 8; ++e) { const float ep = fexp_(lg[e]), en = fexp_(-lg[e]), epv = fexp_(lgp[e]);
              ab[e] = (unsigned short)f2bf(-kkv[e] * kiv * epv); bb_[e] = (unsigned short)f2bf(bbv[e] * kiv * en); kb_[e] = (unsigned short)f2bf(kv[e] * en); rb[e] = (unsigned short)f2bf(rv[e] * ep); }
#define PK8(x) (u32x4){(unsigned)x[0] | ((unsigned)x[1] << 16), (unsigned)x[2] | ((unsigned)x[3] << 16), (unsigned)x[4] | ((unsigned)x[5] << 16), (unsigned)x[6] | ((unsigned)x[7] << 16)}
          *(LAS u32x4*)(AT + et * ST + ec * 2) = PK8(ab); *(LAS u32x4*)(BT + et * ST + ec * 2) = PK8(bb_); *(LAS u32x4*)(KT + et * ST + ec * 2) = PK8(kb_); *(LAS u32x4*)(RT + et * ST + ec * 2) = PK8(rb);
#undef PK8
#pragma unroll
          for (int e = 0; e < 8; ++e) { *(LAS unsigned short*)(BTT + (ec + e) * ST + et * 2) = bb_[e]; *(LAS unsigned short*)(KTT + (ec + e) * ST + et * 2) = kb_[e]; } }
        __syncthreads();
        bf16x8_t ppk[2], qpk[2];
        if (wave < 4) { const int tt = wave; const bf16x8_t r0 = RD8(RT + (16 * tt + li) * ST + quad * 16), r1 = RD8(RT + (16 * tt + li) * ST + 64 + quad * 16);
            u32x2 pw[4], qw[4];
#pragma unroll
            for (int jt = 0; jt < 4; ++jt) { f32x4 pa = {0.f, 0.f, 0.f, 0.f}, qa = pa;
                pa = MF32(RD8(BT + (16 * jt + li) * ST + quad * 16), r0, pa); pa = MF32(RD8(BT + (16 * jt + li) * ST + 64 + quad * 16), r1, pa);
                qa = MF32(RD8(KT + (16 * jt + li) * ST + quad * 16), r0, qa); qa = MF32(RD8(KT + (16 * jt + li) * ST + 64 + quad * 16), r1, qa);
#pragma unroll
                for (int e = 0; e < 4; ++e) { const bool keep = (16 * jt + 4 * quad + e) <= (16 * tt + li); pa[e] = keep ? pa[e] : 0.f; qa[e] = keep ? qa[e] : 0.f; }
                pw[jt] = (u32x2){pg8::cvt_pk_bf16(pa[0], pa[1]), pg8::cvt_pk_bf16(pa[2], pa[3])}; qw[jt] = (u32x2){pg8::cvt_pk_bf16(qa[0], qa[1]), pg8::cvt_pk_bf16(qa[2], qa[3])}; }
            ppk[0] = __builtin_bit_cast(bf16x8_t, (u32x4){pw[0].x, pw[0].y, pw[1].x, pw[1].y}); ppk[1] = __builtin_bit_cast(bf16x8_t, (u32x4){pw[2].x, pw[2].y, pw[3].x, pw[3].y});
            qpk[0] = __builtin_bit_cast(bf16x8_t, (u32x4){qw[0].x, qw[0].y, qw[1].x, qw[1].y}); qpk[1] = __builtin_bit_cast(bf16x8_t, (u32x4){qw[2].x, qw[2].y, qw[3].x, qw[3].y});
            { f32x4 na = {0.f, 0.f, 0.f, 0.f};
              na = MF32(RD8(AT + (16 * tt + li) * ST + quad * 16), RD8(BT + (16 * tt + li) * ST + quad * 16), na); na = MF32(RD8(AT + (16 * tt + li) * ST + 64 + quad * 16), RD8(BT + (16 * tt + li) * ST + 64 + quad * 16), na);
#pragma unroll
              for (int e = 0; e < 4; ++e) ND[tt * 272 + (4 * quad + e) * 17 + li] = (li < 4 * quad + e) ? na[e] : 0.f;
              LDS_WAIT(); asm volatile("" ::: "memory");
              if (lane < 16) { float x[16];
#pragma unroll
                  for (int t = 0; t < 16; ++t) { float sacc = (t == lane) ? 1.f : 0.f;
#pragma unroll
                      for (int q = 0; q < t; ++q) sacc += ND[tt * 272 + t * 17 + q] * x[q];
                      x[t] = sacc; *(LAS unsigned short*)(DB + tt * 768 + t * 48 + lane * 2) = (unsigned short)f2bf(sacc); } } }
        } else { const int rw = wave - 4; const bf16x8_t a0 = RD8(AT + (16 * rw + li) * ST + quad * 16), a1 = RD8(AT + (16 * rw + li) * ST + 64 + quad * 16);
            ppk[0] = (bf16x8_t){0, 0, 0, 0, 0, 0, 0, 0}; ppk[1] = ppk[0]; qpk[0] = ppk[0]; qpk[1] = ppk[0];
#pragma unroll
            for (int jt = 0; jt < 4; ++jt) { f32x4 na = {0.f, 0.f, 0.f, 0.f}, ma = na;
                if (jt <= rw) { na = MF32(a0, RD8(BT + (16 * jt + li) * ST + quad * 16), na); na = MF32(a1, RD8(BT + (16 * jt + li) * ST + 64 + quad * 16), na);
                                ma = MF32(a0, RD8(KT + (16 * jt + li) * ST + quad * 16), ma); ma = MF32(a1, RD8(KT + (16 * jt + li) * ST + 64 + quad * 16), ma); }
#pragma unroll
                for (int e = 0; e < 4; ++e) { const int tr = 16 * rw + 4 * quad + e, jc = 16 * jt + li; const bool keep = jc < tr; const float nv = keep ? na[e] : 0.f, mv = keep ? ma[e] : 0.f;
                    *(LAS unsigned short*)(NB + tr * ST + jc * 2) = (unsigned short)f2bf(nv); *(LAS unsigned short*)(MB + tr * ST + jc * 2) = (unsigned short)f2bf(mv);
                    } }
        }
        __syncthreads();
        { const int cw = wave & 3; f32x4 rhs[4];
          if (wave < 4) {
#pragma unroll
              for (int i = 0; i < 4; ++i)
#pragma unroll
                  for (int e = 0; e < 4; ++e) rhs[i][e] = bf2f(*(const LAS unsigned short*)(AT + (16 * i + 4 * quad + e) * ST + (16 * cw + li) * 2));
          } else { const bf16x8_t v0 = RD8(VTl + (16 * cw + li) * ST + quad * 16), v1 = RD8(VTl + (16 * cw + li) * ST + 64 + quad * 16);
#pragma unroll
              for (int i = 0; i < 4; ++i) { f32x4 a = {0.f, 0.f, 0.f, 0.f}; a = MF32(RD8(MB + (16 * i + li) * ST + quad * 16), v0, a); a = MF32(RD8(MB + (16 * i + li) * ST + 64 + quad * 16), v1, a); rhs[i] = a; } }
          LAS unsigned char* XT = (wave < 4) ? WMT : UMT; bf16x4_t xb[4];
#pragma unroll
          for (int i = 0; i < 4; ++i) { f32x4 acc = rhs[i];
#pragma unroll
              for (int kb = 0; kb < 4; ++kb) if (kb < i) acc = MF16(RD4(NB + (16 * i + li) * ST + (16 * kb + 4 * quad) * 2), xb[kb], acc);
              const u32x2 aw = {pg8::cvt_pk_bf16(acc[0], acc[1]), pg8::cvt_pk_bf16(acc[2], acc[3])};
              f32x4 x = {0.f, 0.f, 0.f, 0.f}; x = MF16(RD4(DB + i * 768 + li * 48 + quad * 8), __builtin_bit_cast(bf16x4_t, aw), x);
              const u32x2 xw = {pg8::cvt_pk_bf16(x[0], x[1]), pg8::cvt_pk_bf16(x[2], x[3])}; xb[i] = __builtin_bit_cast(bf16x4_t, xw);
              *(LAS u32x2*)(XT + (16 * cw + li) * ST + (16 * i + 4 * quad) * 2) = xw; } }
        __syncthreads();
        if (wave < 4) { const int tt = wave; const int tg = 16 * tt + li;
            bf16* rmo = RM + (size_t)it * 4096 + tg * 64; bf16* y0o = Y0 + (size_t)it * 4096 + tg * 64;
#pragma unroll
            for (int ct = 0; ct < 4; ++ct) { const u32x2 rw2 = *(const LAS u32x2*)(RT + tg * ST + (16 * ct + 4 * quad) * 2); f32x4 acc = {blo(rw2.x), bhi(rw2.x), blo(rw2.y), bhi(rw2.y)};
#pragma unroll
                for (int s2 = 0; s2 < 2; ++s2) { const LAS unsigned char* wp = WMT + (16 * ct + li) * ST + (32 * s2 + 4 * quad) * 2; const u32x2 lo = *(const LAS u32x2*)wp, hi = *(const LAS u32x2*)(wp + 32);
                    acc = MF32(__builtin_bit_cast(bf16x8_t, (u32x4){lo.x, lo.y, hi.x, hi.y}), ppk[s2], acc); }
                *(u32x2*)(rmo + 16 * ct + 4 * quad) = (u32x2){pg8::cvt_pk_bf16(acc[0], acc[1]), pg8::cvt_pk_bf16(acc[2], acc[3])}; }
#pragma unroll
            for (int vt = 0; vt < 4; ++vt) { f32x4 acc = {0.f, 0.f, 0.f, 0.f};
#pragma unroll
                for (int s2 = 0; s2 < 2; ++s2) { const LAS unsigned char* up = UMT + (16 * vt + li) * ST + (32 * s2 + 4 * quad) * 2; const u32x2 ulo = *(const LAS u32x2*)up, uhi = *(const LAS u32x2*)(up + 32);
                    acc = MF32(__builtin_bit_cast(bf16x8_t, (u32x4){ulo.x, ulo.y, uhi.x, uhi.y}), ppk[s2], acc);
                    const LAS unsigned char* vp = VTl + (16 * vt + li) * ST + (32 * s2 + 4 * quad) * 2; const u32x2 vlo = *(const LAS u32x2*)vp, vhi = *(const LAS u32x2*)(vp + 32);
                    acc = MF32(__builtin_bit_cast(bf16x8_t, (u32x4){vlo.x, vlo.y, vhi.x, vhi.y}), qpk[s2], acc); }
                *(u32x2*)(y0o + 16 * vt + 4 * quad) = (u32x2){pg8::cvt_pk_bf16(acc[0], acc[1]), pg8::cvt_pk_bf16(acc[2], acc[3])}; }
        } else { const int xt = wave - 4;
            const bf16x8_t bt0 = RD8(BTT + (16 * xt + li) * ST + quad * 16), bt1 = RD8(BTT + (16 * xt + li) * ST + 64 + quad * 16);
            const float gc2 = GC[16 * xt + li]; bf16* pco = PCT + (size_t)it * 4096 + (16 * xt + li) * 64;
#pragma unroll
            for (int c1 = 0; c1 < 4; ++c1) { f32x4 acc = {0.f, 0.f, 0.f, 0.f};
                acc = MF32(RD8(WMT + (16 * c1 + li) * ST + quad * 16), bt0, acc); acc = MF32(RD8(WMT + (16 * c1 + li) * ST + 64 + quad * 16), bt1, acc);
                float o[4];
#pragma unroll
                for (int e = 0; e < 4; ++e) o[e] = gc2 * (acc[e] + (((16 * c1 + 4 * quad + e) == (16 * xt + li)) ? 1.f : 0.f));
                *(u32x2*)(pco + 16 * c1 + 4 * quad) = (u32x2){pg8::cvt_pk_bf16(o[0], o[1]), pg8::cvt_pk_bf16(o[2], o[3])}; }
            const bf16x8_t um0 = RD8(UMT + (16 * xt + li) * ST + quad * 16), um1 = RD8(UMT + (16 * xt + li) * ST + 64 + quad * 16), vt0 = RD8(VTl + (16 * xt + li) * ST + quad * 16), vt1 = RD8(VTl + (16 * xt + li) * ST + 64 + quad * 16);
            bf16* lco = LC + (size_t)it * 4096 + (16 * xt + li) * 64;
#pragma unroll
            for (int ct = 0; ct < 4; ++ct) { f32x4 acc = {0.f, 0.f, 0.f, 0.f};
                acc = MF32(RD8(BTT + (16 * ct + li) * ST + quad * 16), um0, acc); acc = MF32(RD8(BTT + (16 * ct + li) * ST + 64 + quad * 16), um1, acc);
                acc = MF32(RD8(KTT + (16 * ct + li) * ST + quad * 16), vt0, acc); acc = MF32(RD8(KTT + (16 * ct + li) * ST + 64 + quad * 16), vt1, acc);
                const f32x4 g4 = *(const LAS f32x4*)(GC + 16 * ct + 4 * quad);
                *(u32x2*)(lco + 16 * ct + 4 * quad) = (u32x2){pg8::cvt_pk_bf16(acc[0] * g4.x, acc[1] * g4.y), pg8::cvt_pk_bf16(acc[2] * g4.z, acc[3] * g4.w)}; }
        }
      }
    }
#undef F1LOAD
#undef MF32
#undef MF16
#undef RD8
#undef RD4
    __syncthreads();
}
template <int MODE> DI void state_scan16(Frame& F) {
    constexpr int SLOT = 18432, NSL = 6;
    const bf16* PT = (const bf16*)(WSP(F) + (MODE == 1 ? WS_PGT : WS_PCT)); const bf16* LL = (const bf16*)(WSP(F) + (MODE == 1 ? WS_LG : WS_LC));
    LAS unsigned char* ring = F.lds;
    const int nitems = (MODE == 1) ? BATCH * 8 : BATCH * 8 * 16;
#define RBAR() do { asm volatile("s_waitcnt lgkmcnt(0)" ::: "memory"); __builtin_amdgcn_s_barrier(); asm volatile("" ::: "memory"); } while (0)
    for (int it = F.bid; it < nitems; it += F.G) {
        int tid = F.tid; asm volatile("" : "+v"(tid));
        const int lane = tid & 63, wave = __builtin_amdgcn_readfirstlane(tid >> 6), vl = lane & 15, quad = lane >> 4;
        const size_t opbase = (MODE == 1) ? (size_t)it * 16 * 4096 : (size_t)((it >> 4) * 256 + (it & 15) * 16) * 4096;
        const bf16* pt = PT + opbase; const bf16* ll = LL + opbase;
        __syncthreads();
        const unsigned loffp = (unsigned)((tid >> 3) * 144 + (tid & 7) * 16), loffl = 9216u + loffp;
        u32x4 rg[4][2];
#define SLOAD(q, x) do { rg[q][0] = *((const u32x4*)(pt + (size_t)(x) * 4096) + tid); rg[q][1] = *((const u32x4*)(ll + (size_t)(x) * 4096) + tid); } while (0)
#define SWRITE(q, x) do { LAS unsigned char* d_ = ring + ((x) % NSL) * SLOT; *(LAS u32x4*)(d_ + loffp) = rg[q][0]; *(LAS u32x4*)(d_ + loffl) = rg[q][1]; } while (0)
        SLOAD(0, 0); SLOAD(1, 1); SLOAD(2, 2); SLOAD(3, 3);
        SWRITE(0, 0); SWRITE(1, 1);
        SLOAD(0, 4); SLOAD(1, 5);
        const bool pwave = (MODE == 0) && (wave < 4); const bool active = (MODE == 0) || (wave < 4); const int vb = wave & 3;
        f32x4 st[4];
#pragma unroll
        for (int kt = 0; kt < 4; ++kt) { st[kt] = (f32x4){0.f, 0.f, 0.f, 0.f};
            if (pwave) {
#pragma unroll
                for (int j = 0; j < 4; ++j) st[kt][j] = ((16 * kt + 4 * quad + j) == (16 * vb + vl)) ? 1.f : 0.f; }
            if (MODE == 2 && active) { const u32x2 w = *(const u32x2*)((const bf16*)(WSP(F) + WS_SG) + (size_t)it * 4096 + (16 * vb + vl) * 64 + 16 * kt + 4 * quad); st[kt] = (f32x4){blo(w.x), bhi(w.x), blo(w.y), bhi(w.y)}; } }
        const unsigned aoff = (unsigned)(vl * 144 + quad * 8), loffc = (unsigned)(9216 + (16 * vb + vl) * 144 + quad * 8);
        RBAR();
#pragma unroll
        for (int c = 0; c < 16; ++c) {
            if (c + 2 < 16) { SWRITE((c + 2) & 3, c + 2); if (c + 6 < 16) SLOAD((c + 2) & 3, c + 6); }
            if (active) {
                const LAS unsigned char* sl = ring + (c % NSL) * SLOT;
                bf16x8_t bfr[2];
                { u32x2 pk[4];
#pragma unroll
                  for (int kt = 0; kt < 4; ++kt) { pk[kt] = (u32x2){pg8::cvt_pk_bf16(st[kt][0], st[kt][1]), pg8::cvt_pk_bf16(st[kt][2], st[kt][3])};
                      if (MODE == 1) *(u32x2*)((bf16*)(WSP(F) + WS_SG) + ((size_t)it * 16 + c) * 4096 + (16 * vb + vl) * 64 + 16 * kt + 4 * quad) = pk[kt];
                      if (MODE == 2) *(u32x2*)((bf16*)(WSP(F) + WS_S0) + (opbase + (size_t)c * 4096) + (16 * vb + vl) * 64 + 16 * kt + 4 * quad) = pk[kt]; }
                  bfr[0] = __builtin_bit_cast(bf16x8_t, (u32x4){pk[0].x, pk[0].y, pk[1].x, pk[1].y}); bfr[1] = __builtin_bit_cast(bf16x8_t, (u32x4){pk[2].x, pk[2].y, pk[3].x, pk[3].y}); }
#pragma unroll
                for (int kt = 0; kt < 4; ++kt) { f32x4 acc = {0.f, 0.f, 0.f, 0.f};
                    if (!pwave) { const u32x2 lf = *(const LAS u32x2*)(sl + loffc + kt * 32); acc = (f32x4){blo(lf.x), bhi(lf.x), blo(lf.y), bhi(lf.y)}; }
#pragma unroll
                    for (int s2 = 0; s2 < 2; ++s2) { const u32x2 a0 = *(const LAS u32x2*)(sl + aoff + kt * 16 * 144 + s2 * 64), a1 = *(const LAS u32x2*)(sl + aoff + kt * 16 * 144 + s2 * 64 + 32);
                        acc = __builtin_amdgcn_mfma_f32_16x16x32_bf16(__builtin_bit_cast(bf16x8_t, (u32x4){a0.x, a0.y, a1.x, a1.y}), bfr[s2], acc, 0, 0, 0); }
                    st[kt] = acc; }
            }
            RBAR();
        }
        if (MODE == 0) {
            bf16* pg = (bf16*)(WSP(F) + WS_PGT) + (size_t)it * 4096; bf16* lg = (bf16*)(WSP(F) + WS_LG) + (size_t)it * 4096;
#pragma unroll
            for (int kt = 0; kt < 4; ++kt) {
                if (pwave) {
#pragma unroll
                    for (int j = 0; j < 4; ++j) pg[(16 * kt + 4 * quad + j) * 64 + 16 * vb + vl] = (bf16)f2bf(st[kt][j]);
                } else *(u32x2*)(lg + (16 * vb + vl) * 64 + 16 * kt + 4 * quad) = (u32x2){pg8::cvt_pk_bf16(st[kt][0], st[kt][1]), pg8::cvt_pk_bf16(st[kt][2], st[kt][3])}; }
        }
#undef SLOAD
#undef SWRITE
    }
#undef RBAR
    __syncthreads();
}
DI void rwkv_out_phase(Frame& F, int l) {
    bf16* AR = (bf16*)(WSP(F) + WS_AR); const size_t AS = (size_t)T * 512; const float* bonus = (const float*)(WSP(F) + WS_BONUS);
    const bf16* RM = (const bf16*)(WSP(F) + WS_RM); const bf16* Y0 = (const bf16*)(WSP(F) + WS_Y0); const bf16* S0 = (const bf16*)(WSP(F) + WS_S0);
    const int gw = F.bid * 8 + F.wave, NGW = F.G * 8, lane = F.lane, li = lane & 15, quad = lane >> 4;
    for (int it = gw; it < BATCH * 8 * (SEQ / 64); it += NGW) {
        const int bh = it >> 8, ck = it & 255, b = bh >> 3, h = bh & 7;
        const bf16* s0 = S0 + (size_t)it * 4096; const bf16* rm = RM + (size_t)it * 4096; const bf16* y0 = Y0 + (size_t)it * 4096;
        bf16x8_t sa[4][2];
#pragma unroll
        for (int vt = 0; vt < 4; ++vt)
#pragma unroll
            for (int s2 = 0; s2 < 2; ++s2) sa[vt][s2] = *(const bf16x8_t*)(s0 + (16 * vt + li) * 64 + 32 * s2 + 8 * quad);
        float lg[4][4], lb[4][4];
#pragma unroll
        for (int vt = 0; vt < 4; ++vt) { const f32x4 g4 = *(const f32x4*)(INP(F, 14) + l * 512 + h * 64 + 16 * vt + 4 * quad), b4 = *(const f32x4*)(INP(F, 15) + l * 512 + h * 64 + 16 * vt + 4 * quad);
            lg[vt][0] = g4.x; lg[vt][1] = g4.y; lg[vt][2] = g4.z; lg[vt][3] = g4.w; lb[vt][0] = b4.x; lb[vt][1] = b4.y; lb[vt][2] = b4.z; lb[vt][3] = b4.w; }
#pragma unroll 1
        for (int tt = 0; tt < 4; ++tt) {
            const int tch = 16 * tt + li; const size_t t = (size_t)b * SEQ + ck * 64 + tch;
            bf16x8_t rb[2];
#pragma unroll
            for (int s2 = 0; s2 < 2; ++s2) rb[s2] = *(const bf16x8_t*)(rm + tch * 64 + 32 * s2 + 8 * quad);
            f32x4 acc[4];
#pragma unroll
            for (int vt = 0; vt < 4; ++vt) { const u32x2 yw = *(const u32x2*)(y0 + tch * 64 + 16 * vt + 4 * quad); acc[vt] = (f32x4){blo(yw.x), bhi(yw.x), blo(yw.y), bhi(yw.y)};
                acc[vt] = __builtin_amdgcn_mfma_f32_16x16x32_bf16(sa[vt][0], rb[0], acc[vt], 0, 0, 0); acc[vt] = __builtin_amdgcn_mfma_f32_16x16x32_bf16(sa[vt][1], rb[1], acc[vt], 0, 0, 0); }
            float sm = 0.f;
#pragma unroll
            for (int vt = 0; vt < 4; ++vt) sm += (acc[vt][0] + acc[vt][1]) + (acc[vt][2] + acc[vt][3]);
            sm += __shfl_xor(sm, 16); sm += __shfl_xor(sm, 32);
            const float mean = sm * (1.f / 64.f); float sq = 0.f;
#pragma unroll
            for (int vt = 0; vt < 4; ++vt)
#pragma unroll
                for (int e = 0; e < 4; ++e) { const float d = acc[vt][e] - mean; acc[vt][e] = d; sq += d * d; }
            sq += __shfl_xor(sq, 16); sq += __shfl_xor(sq, 32);
            const float rstd = rsqrtf(sq * (1.f / 64.f) + 64e-5f), bon = bonus[t * 8 + h];
            const size_t idx = t * 512 + h * 64 + 4 * quad;
#pragma unroll
            for (int vt = 0; vt < 4; ++vt) { const u32x2 vw = *(const u32x2*)(AR + 3 * AS + idx + 16 * vt), gw2 = *(const u32x2*)(AR + 6 * AS + idx + 16 * vt);
                const float vv[4] = {blo(vw.x), bhi(vw.x), blo(vw.y), bhi(vw.y)}, gg[4] = {blo(gw2.x), bhi(gw2.x), blo(gw2.y), bhi(gw2.y)}; float o[4];
#pragma unroll
                for (int e = 0; e < 4; ++e) o[e] = (acc[vt][e] * rstd * lg[vt][e] + lb[vt][e] + bon * vv[e]) * gg[e];
                *(u32x2*)(AR + idx + 16 * vt) = (u32x2){pk2(o[0], o[1]), pk2(o[2], o[3])}; }
        }
    }
}
DI void route_phase(Frame& F, int l) {
    const float* x = OUTP(F); bf16* h2 = (bf16*)(WSP(F) + WS_XB); const bf16* RWH = (const bf16*)(WSP(F) + WS_RWG); const bf16* RWL = RWH + 48 * 1024;
    int* route = (int*)(WSP(F) + WS_ROUTE); float* rwt = (float*)(WSP(F) + WS_RWT); unsigned* cnt = (unsigned*)(WSP(F) + WS_CTL) + CW_CNT + 32 * l;
    const float* rgb = INP(F, 24) + l * 4; const float* reb = INP(F, 26) + l * 32;
    LAS unsigned* lc = (LAS unsigned*)(F.lds + MISC_OFF + 8192); unsigned* wgbase = (unsigned*)(WSP(F) + WS_WGBASE);
    for (int wit = F.bid; wit < T / 128; wit += F.G) {
        int lane = F.lane; asm volatile("" : "+v"(lane));
        __syncthreads();
        if (F.tid < 32) lc[F.tid] = 0u;
        __syncthreads();
        const int it = wit * 8 + F.wave;
        const int li = lane & 15, quad = lane >> 4; const size_t t = (size_t)it * 16 + li;
        const float* xr = x + t * DM + 8 * quad;
        f32x4 acc[3];
#pragma unroll
        for (int jt = 0; jt < 3; ++jt) acc[jt] = (f32x4){0.f, 0.f, 0.f, 0.f};
        float ss = 0.f;
        LAS unsigned char* wbuf = F.lds;
        u32x4 wst[3]; f32x4 xc[8], xn[8];
#define WLOAD(kc) do { _Pragma("unroll") for (int i = 0; i < 3; ++i) { const int p_ = F.tid + 512 * i, hl_ = p_ / 768, q_ = p_ % 768, r_ = q_ >> 4, c_ = q_ & 15; \
            wst[i] = *(const u32x4*)((hl_ ? RWL : RWH) + (size_t)r_ * 1024 + (kc) * 128 + c_ * 8); } } while (0)
#define WSTORE(bf) do { _Pragma("unroll") for (int i = 0; i < 3; ++i) { const int p_ = F.tid + 512 * i, hl_ = p_ / 768, q_ = p_ % 768, r_ = q_ >> 4, c_ = q_ & 15; \
            *(LAS u32x4*)(wbuf + (bf) * 26112 + hl_ * 13056 + r_ * 272 + c_ * 16) = wst[i]; } } while (0)
#define XLOAD(dst, kc) do { _Pragma("unroll") for (int k_ = 0; k_ < 4; ++k_) { dst[2 * k_] = *(const f32x4*)(xr + (kc) * 128 + 32 * k_); dst[2 * k_ + 1] = *(const f32x4*)(xr + (kc) * 128 + 32 * k_ + 4); } } while (0)
        WLOAD(0); XLOAD(xc, 0);
        WSTORE(0);
        __syncthreads();
#pragma unroll
        for (int kc = 0; kc < 8; ++kc) {
            if (kc < 7) { WLOAD(kc + 1); XLOAD(xn, kc + 1); }
            const LAS unsigned char* wb = wbuf + (kc & 1) * 26112;
#pragma unroll
            for (int k4 = 0; k4 < 4; ++k4) {
                const f32x4 x0 = xc[2 * k4], x1 = xc[2 * k4 + 1];
                ss += (x0.x * x0.x + x0.y * x0.y) + (x0.z * x0.z + x0.w * x0.w) + (x1.x * x1.x + x1.y * x1.y) + (x1.z * x1.z + x1.w * x1.w);
                const unsigned h0 = pk2(x0.x, x0.y), h1 = pk2(x0.z, x0.w), h2_ = pk2(x1.x, x1.y), h3 = pk2(x1.z, x1.w);
                const bf16x8_t bh = __builtin_bit_cast(bf16x8_t, (u32x4){h0, h1, h2_, h3});
                const bf16x8_t bl = __builtin_bit_cast(bf16x8_t, (u32x4){pk2(x0.x - blo(h0), x0.y - bhi(h0)), pk2(x0.z - blo(h1), x0.w - bhi(h1)), pk2(x1.x - blo(h2_), x1.y - bhi(h2_)), pk2(x1.z - blo(h3), x1.w - bhi(h3))});
#pragma unroll
                for (int jt = 0; jt < 3; ++jt) { const LAS unsigned char* wp = wb + (16 * jt + li) * 272 + k4 * 64 + quad * 16;
                    const bf16x8_t wh = *(const LAS bf16x8_t*)wp, wl = *(const LAS bf16x8_t*)(wp + 13056);
                    acc[jt] = __builtin_amdgcn_mfma_f32_16x16x32_bf16(wh, bh, acc[jt], 0, 0, 0);
                    acc[jt] = __builtin_amdgcn_mfma_f32_16x16x32_bf16(wl, bh, acc[jt], 0, 0, 0);
                    acc[jt] = __builtin_amdgcn_mfma_f32_16x16x32_bf16(wh, bl, acc[jt], 0, 0, 0); }
            }
            if (kc < 7) { WSTORE((kc + 1) & 1);
#pragma unroll
                for (int i = 0; i < 8; ++i) xc[i] = xn[i]; }
            __syncthreads();
        }
#undef WLOAD
#undef WSTORE
#undef XLOAD
        ss += __shfl_xor(ss, 16); ss += __shfl_xor(ss, 32);
        const float rs = rsqrtf(ss * (1.f / DM) + 1e-6f);
#pragma unroll 4
        for (int ks = 0; ks < 32; ++ks) { const f32x4 x0 = *(const f32x4*)(xr + 32 * ks), x1 = *(const f32x4*)(xr + 32 * ks + 4);
            *(u32x4*)(h2 + t * DM + 32 * ks + 8 * quad) = (u32x4){pk2(x0.x * rs, x0.y * rs), pk2(x0.z * rs, x0.w * rs), pk2(x1.x * rs, x1.y * rs), pk2(x1.z * rs, x1.w * rs)}; }
        float gl[4]; int grp = 0;
#pragma unroll
        for (int j = 0; j < 4; ++j) gl[j] = acc[0][j] * rs + rgb[j];
        float gm = gl[0];
#pragma unroll
        for (int j = 1; j < 4; ++j) if (gl[j] > gm) { gm = gl[j]; grp = j; }
        if (quad == grp) {
            float gs = 0.f;
#pragma unroll
            for (int j = 0; j < 4; ++j) gs += __expf(gl[j] - gm);
            const float gprob = frcp_(gs);
            float eg[8];
#pragma unroll
            for (int i = 0; i < 4; ++i) { eg[i] = acc[1][i] * rs + reb[8 * quad + i]; eg[4 + i] = acc[2][i] * rs + reb[8 * quad + 4 + i]; }
            int i0 = 0; float m0 = eg[0];
#pragma unroll
            for (int i = 1; i < 8; ++i) if (eg[i] > m0) { m0 = eg[i]; i0 = i; }
            int i1 = -1; float m1 = -INFINITY;
#pragma unroll
            for (int i = 0; i < 8; ++i) if (i != i0 && eg[i] > m1) { m1 = eg[i]; i1 = i; }
            const float e10 = fexp_(m1 - m0), r10 = frcp_(1.0f + e10), wa = gprob * r10, wb = gprob * e10 * r10;
            const int e0 = grp * 8 + i0, e1 = grp * 8 + i1;
            const unsigned r0 = atomicAdd((unsigned*)(lc + e0), 1u), r1 = atomicAdd((unsigned*)(lc + e1), 1u);
            ((int4*)route)[t] = make_int4(e0, (int)r0, e1, (int)r1); ((float2*)rwt)[t] = make_float2(wa, wb);
        }
        __syncthreads();
        if (F.tid < 32) { const unsigned c = lc[F.tid]; wgbase[wit * 32 + F.tid] = c ? atomicAdd(cnt + F.tid, c) : 0u; }
    }
    __syncthreads();
}
DI int moe_tables(Frame& F, int l) {
    LAS int* ps = (LAS int*)(F.lds + MISC_OFF); LAS unsigned char* te = (LAS unsigned char*)(F.lds + MISC_OFF + 256);
    const unsigned* cnt = (const unsigned*)(WSP(F) + WS_CTL) + CW_CNT + 32 * l;
    __syncthreads();
    if (F.tid == 0) { int acc = 0;
_Pragma("unroll 1")
        for (int e = 0; e < NEXP; ++e) { ps[e] = acc; const int c = (int)__hip_atomic_load(cnt + e, __ATOMIC_RELAXED, __HIP_MEMORY_SCOPE_AGENT); const int nt = (c + 255) >> 8;
_Pragma("unroll 1")
            for (int i = 0; i < nt; ++i) te[(acc >> 8) + i] = (unsigned char)e; acc += nt << 8; } ps[NEXP] = acc; }
    __syncthreads();
    return __builtin_amdgcn_readfirstlane(ps[NEXP] >> 8);
}
DI void permute_phase(Frame& F, int l) {
    moe_tables(F, l);
    const LAS int* ps = (const LAS int*)(F.lds + MISC_OFF);
    const int* route = (const int*)(WSP(F) + WS_ROUTE); int* dest = (int*)(WSP(F) + WS_DEST); int* rowtok = (int*)(WSP(F) + WS_ROWTOK);
    const unsigned* cnt = (const unsigned*)(WSP(F) + WS_CTL) + CW_CNT + 32 * l;
    for (int t = F.bid * 512 + F.tid; t < T; t += F.G * 512) {
        const int4 r = ((const int4*)route)[t]; const unsigned* wb_ = (const unsigned*)(WSP(F) + WS_WGBASE) + (t >> 7) * 32; const int d0 = ps[r.x] + (int)wb_[r.x] + r.y, d1 = ps[r.z] + (int)wb_[r.z] + r.w;
        rowtok[d0] = t; rowtok[d1] = t; ((int2*)dest)[t] = make_int2(d0, d1);
    }
    if (F.bid == 0) {
#pragma unroll 1
        for (int e = 0; e < NEXP; ++e) { const int c = (int)__hip_atomic_load(cnt + e, __ATOMIC_RELAXED, __HIP_MEMORY_SCOPE_AGENT), lo = ps[e] + c, hi = ps[e + 1]; if (lo + F.tid < hi) rowtok[lo + F.tid] = 0; }
    }
}
DI void combine_phase(Frame& F, int l) {
    float* x = OUTP(F); const bf16* Y = (const bf16*)(WSP(F) + WS_YMOE); const int* dest = (const int*)(WSP(F) + WS_DEST); const float* rwt = (const float*)(WSP(F) + WS_RWT);
    bf16* xb = (bf16*)(WSP(F) + WS_XB); const float* fg = INP(F, 30);
    const int gw = F.bid * 8 + F.wave, NGW = F.G * 8, lane = F.lane; const bool last = (l == DEPTH - 1);
    for (int t = gw; t < T; t += NGW) {
        const int2 d = ((const int2*)dest)[t]; const float2 w = ((const float2*)rwt)[t];
        f32x4* xr = (f32x4*)(x + (size_t)t * DM) + lane; const u32x2* y0 = (const u32x2*)(Y + (size_t)d.x * DM) + lane; const u32x2* y1 = (const u32x2*)(Y + (size_t)d.y * DM) + lane;
        f32x4 v[4]; float s = 0.f;
#pragma unroll
        for (int j = 0; j < 4; ++j) { v[j] = xr[64 * j]; const u32x2 a = y0[64 * j], b = y1[64 * j];
            v[j].x += w.x * blo(a.x) + w.y * blo(b.x); v[j].y += w.x * bhi(a.x) + w.y * bhi(b.x); v[j].z += w.x * blo(a.y) + w.y * blo(b.y); v[j].w += w.x * bhi(a.y) + w.y * bhi(b.y);
            s += (v[j].x * v[j].x + v[j].y * v[j].y) + (v[j].z * v[j].z + v[j].w * v[j].w); }
        const float rs = rsqrtf(wave_sum(s) * (1.f / DM) + 1e-6f);
        if (last) {
#pragma unroll
            for (int j = 0; j < 4; ++j) { const f32x4 g = ((const f32x4*)fg)[lane + 64 * j]; xr[64 * j] = v[j] * rs * g; }
        } else {
            u32x2* o = (u32x2*)(xb + (size_t)t * DM) + lane;
#pragma unroll
            for (int j = 0; j < 4; ++j) { xr[64 * j] = v[j]; o[64 * j] = (u32x2){pk2(v[j].x * rs, v[j].y * rs), pk2(v[j].z * rs, v[j].w * rs)}; }
        }
    }
}

DI void dump_bf16(Frame& F, const bf16* src, int pitch, int ncols, int c0) {
    float* out = OUTP(F);
    for (size_t i = (size_t)F.bid * 512 + F.tid; i < (size_t)T * ncols; i += (size_t)F.G * 512) { const size_t t = i / ncols; const int c = (int)(i % ncols); out[t * DM + c0 + c] = bf2f(src[t * pitch + c]); }
}
__global__ void __launch_bounds__(512, 2) mk_fwd(Args args) {
    extern __shared__ __attribute__((aligned(16))) unsigned char lds_raw[];
    cg::grid_group grid = cg::this_grid();
    Frame F; F.lds = (LAS unsigned char*)lds_raw; F.tid = threadIdx.x; F.lane = F.tid & 63; F.wave = __builtin_amdgcn_readfirstlane(F.tid >> 6); F.G = gridDim.x; F.bid = (int)__builtin_amdgcn_workgroup_id_x();
    F.kp = (kargp_t)__builtin_amdgcn_kernarg_segment_ptr();
    for (int u = F.tid; u < 64; u += 512) ((LAS unsigned*)(F.lds + MISC_OFF + 4096))[u] = 0u;
    __syncthreads();
    (void)xcd_barrier_post((unsigned*)(WSP(F) + WS_CTL) + CW_BAR, (volatile LAS unsigned*)(F.lds + MISC_OFF + 4096));
    grid.sync();
#define GRID_BAR() do { XcdBarrier bb_; bb_.bar = (unsigned*)(WSP(F) + WS_CTL) + CW_BAR; bb_.x = xb_xcc_id(); bb_.st = (volatile LAS unsigned*)(F.lds + MISC_OFF + 4096); xcd_barrier(bb_); fence_frame(F); } while (0)
#define ws WSP(F)
#if defined(DBG_TMASK)
#define PT0() const unsigned long long pt0_ = __builtin_amdgcn_s_memrealtime()
#define PT1(k) do { if ((DBG_TMASK >> (k)) & 1) { const unsigned long long n_ = __builtin_amdgcn_s_memrealtime(); const unsigned long long e_ = n_ + (unsigned long long)DBG_AMP * (n_ - pt0_); while (__builtin_amdgcn_s_memrealtime() < e_) __builtin_amdgcn_s_sleep(16); } } while (0)
#else
#define PT0() do {} while (0)
#define PT1(k) do {} while (0)
#endif
    { PT0(); prep_mixer_weights(F, 0);
    rms_rows_to_bf16(F, INP(F, 0), (bf16*)(ws + WS_XB));
    GRID_BAR(); PT1(0); }
#if defined(DBG_STOP) && DBG_STOP == 10
    { PT0(); { pg8::Gemm g{(const bf16*)(ws + WS_XB), (const bf16*)(ws + WS_WG), T, 3072, DM}; pg8::StaticOrder S; S.init(T, 3072, F.G, (int)F.bid);
      pg8::EpiGate E{(unsigned char*)(ws + WS_GATES), 3072};
      pg8::gemm_phase<pg8::EpiGate, pg8::StaticOrder, true, true>(F.lds, g, S, E); }
    GRID_BAR(); PT1(10); }
    dump_bf16(F, (const bf16*)(ws + WS_GATES) + 1024, 3072, 1024, 0); return;
#endif
#pragma unroll 1
    for (int l = 0; l < DEPTH; ++l) {
        { PT0(); { pg8::Gemm g{(const bf16*)(ws + WS_XB), (const bf16*)(ws + WS_WIN), T, l == 0 ? 3840 : 4096, DM}; pg8::StaticOrder S; S.init(T, g.N, F.G, (int)F.bid);
          pg8::EpiZ E{(bf16*)(ws + WS_Q), (bf16*)(ws + WS_K), (bf16*)(ws + WS_VT), (bf16*)(ws + WS_POOLZ), (bf16*)(ws + WS_RWKVZ), C2, SEQ};
          pg8::gemm_phase<pg8::EpiZ, pg8::StaticOrder, true, true>(F.lds, g, S, E); }
        GRID_BAR(); PT1(1); }
        { PT0(); kmean_phase(F);
        pool_phase(F, l);
        GRID_BAR(); PT1(2); }
        { PT0(); sel_phase(F, l);
        GRID_BAR(); PT1(3); }
        { PT0(); att_phase(F, l);
        GRID_BAR(); PT1(4); }
        { PT0(); comb_phase(F);
        GRID_BAR(); PT1(5); }
#if defined(DBG_STOP) && DBG_STOP == 3
        dump_bf16(F, (const bf16*)(ws + WS_YATTN), 512, 512, 0); dump_bf16(F, (const bf16*)(ws + WS_YPOOL), 512, 512, 512); return;
#endif

        { PT0(); rwkv_chunk_phase(F, l);
        GRID_BAR(); PT1(7); }
        { PT0(); state_scan16<0>(F);
        GRID_BAR();
        state_scan16<1>(F);
        GRID_BAR();
        state_scan16<2>(F);
        GRID_BAR(); PT1(8); }
        { PT0(); rwkv_out_phase(F, l);
        GRID_BAR(); PT1(9); }
        { pg8::Gemm g{(const bf16*)(ws + WS_XB), (const bf16*)(ws + WS_WG), T, 3072, DM}; pg8::StaticOrder S; S.init(T, 3072, F.G, (int)F.bid);
          pg8::EpiGate E{(unsigned char*)(ws + WS_GATES), 3072};
          pg8::gemm_phase<pg8::EpiGate, pg8::StaticOrder, true, true>(F.lds, g, S, E); }
        GRID_BAR();
#if defined(DBG_SCRUB)
        { const f32x4* xs = (const f32x4*)INP(F, 0) + (size_t)F.bid * 32768; f32x4 a = {0.f, 0.f, 0.f, 0.f};
          for (int i = F.tid; i < 32768; i += 512) a += xs[i];
          if (a.x + a.y + a.z + a.w == 12345.678f) ((float*)(ws + WS_BONUS))[F.tid] = a.x; }
        GRID_BAR();
#endif
        { PT0(); { pg8::StaticOrder S; S.init(T, DM, F.G, (int)F.bid);
          { pg8::Gemm g{(const bf16*)(ws + WS_YATTN), (const bf16*)(ws + WS_WBR), T, DM, 512};
            pg8::EpiMerge<true> E{(bf16*)(ws + WS_XB), DM, (const unsigned char*)(ws + WS_GATES), 3072, 0};
            pg8::gemm_phase<pg8::EpiMerge<true>, pg8::StaticOrder, true, true>(F.lds, g, S, E); }
          { pg8::Gemm g{(const bf16*)(ws + WS_AR), (const bf16*)(ws + WS_WBR) + (size_t)1024 * 512, T, DM, 512};
            pg8::EpiMerge<false> E{(bf16*)(ws + WS_XB), DM, (const unsigned char*)(ws + WS_GATES), 3072, 1024};
            pg8::gemm_phase<pg8::EpiMerge<false>, pg8::StaticOrder, true, true>(F.lds, g, S, E); }
          { pg8::Gemm g{(const bf16*)(ws + WS_YPOOL), (const bf16*)(ws + WS_WBR) + (size_t)2 * 1024 * 512, T, DM, 512};
            pg8::EpiMerge<false> E{(bf16*)(ws + WS_XB), DM, (const unsigned char*)(ws + WS_GATES), 3072, 2048};
            pg8::gemm_phase<pg8::EpiMerge<false>, pg8::StaticOrder, true, true>(F.lds, g, S, E); } }
        GRID_BAR(); PT1(11); }
#if defined(DBG_STOP) && DBG_STOP == 7
        dump_bf16(F, (const bf16*)(ws + WS_XB), 1024, 1024, 0); return;
#endif
#if defined(DBG_STOP) && DBG_STOP == 6
        dump_bf16(F, (const bf16*)(ws + WS_GATES) + 1024, 3072, 1024, 0); return;
#endif
        { PT0(); { pg8::Gemm g{(const bf16*)(ws + WS_XB), (const bf16*)(ws + WS_WOUT), T, DM, DM}; pg8::StaticOrder S; S.init(T, DM, F.G, (int)F.bid);
          pg8::EpiResF32 E{l == 0 ? INP(F, 0) : OUTP(F), OUTP(F), DM};
          pg8::gemm_phase<pg8::EpiResF32, pg8::StaticOrder, true, true>(F.lds, g, S, E); }
        GRID_BAR(); PT1(12); }
#if defined(DBG_STOP) && DBG_STOP == 1
        return;
#endif
        { PT0(); route_phase(F, l);
#if defined(DBG_TMASK)
        GRID_BAR(); PT1(13); } { PT0();
#endif
        prep_expert_weights(F, l);
        GRID_BAR(); PT1(18); }
        { PT0(); permute_phase(F, l);
        GRID_BAR(); PT1(14); }
        { const int ntile = moe_tables(F, l);
          const LAS unsigned char* te = (const LAS unsigned char*)(F.lds + MISC_OFF + 256);
          { PT0(); { pg8::Gemm g{(const bf16*)(ws + WS_XB), (const bf16*)(ws + WS_W13), RMAX, NEXP * 1024, DM, (const int*)(ws + WS_ROWTOK)}; pg8::MoeOrder S{te, ntile * 4, F.G, (int)F.bid};
            pg8::EpiSwiGLU E{(bf16*)(ws + WS_HACT)};
            pg8::gemm_phase<pg8::EpiSwiGLU, pg8::MoeOrder, true, true, true>(F.lds, g, S, E); }
          GRID_BAR(); PT1(15); }
          { PT0(); { pg8::Gemm g{(const bf16*)(ws + WS_HACT), (const bf16*)(ws + WS_W2), RMAX, NEXP * 1024, 512}; pg8::MoeOrder S{te, ntile * 4, F.G, (int)F.bid};
            pg8::EpiY E{(bf16*)(ws + WS_YMOE)};
            pg8::gemm_phase<pg8::EpiY, pg8::MoeOrder, true, true>(F.lds, g, S, E); }
        GRID_BAR(); PT1(16); } }
        { PT0(); combine_phase(F, l);
        if (l + 1 < DEPTH) prep_mixer_weights(F, l + 1);
        GRID_BAR(); PT1(17); }
#if defined(DBG_STOP) && DBG_STOP == 2
        return;
#endif
    }
#undef ws
}

extern "C" void kernel_launch(void* const* d_in, const int* in_sizes, int n_in, void* d_out, int out_size, void* d_ws, size_t ws_size, hipStream_t stream) {
    static int grid = 0;
    if (grid == 0) {
        if (n_in != 31 || out_size != T * DM || ws_size < WS_END) { fprintf(stderr, "kernel_launch: unexpected shapes (n_in %d out %d ws %zu, need %zu)\n", n_in, out_size, ws_size, (size_t)WS_END); grid = -1; return; }
        int dev = 0, cus = 0, per_cu = 0;
        (void)hipGetDevice(&dev); (void)hipDeviceGetAttribute(&cus, hipDeviceAttributeMultiprocessorCount, dev);
        (void)hipFuncSetAttribute((const void*)mk_fwd, hipFuncAttributeMaxDynamicSharedMemorySize, LDS_BYTES);
        (void)hipOccupancyMaxActiveBlocksPerMultiprocessor(&per_cu, (const void*)mk_fwd, 512, LDS_BYTES);
        (void)hipGetLastError();
        fprintf(stderr, "kernel_launch: cus %d per_cu %d ws %zu\n", cus, per_cu, ws_size);
        grid = cus;
    }
    if (grid < 0) return;
    (void)hipMemsetAsync((char*)d_ws + WS_CTL, 0, CTL_BYTES, stream);
    Args a{};
    for (int i = 0; i < 31; ++i) a.in[i] = (const float*)d_in[i];
    a.out = (float*)d_out; a.ws = (unsigned char*)d_ws;
    void* kargs[] = {&a};
    hipError_t e = hipLaunchCooperativeKernel((const void*)mk_fwd, dim3(grid), dim3(512), kargs, LDS_BYTES, stream);
    if (e != hipSuccess) fprintf(stderr, "cooperative launch failed: %s (grid %d)\n", hipGetErrorString(e), grid);
}
```

```cpp
#include <hip/hip_runtime.h>
#include <hip/hip_cooperative_groups.h>
#include <cstdio>
#include <cstdint>
#include <cmath>
namespace pg8 {
#define PG8_LAS __attribute__((address_space(3)))
typedef unsigned short bf16_t;
typedef short bf16x8 __attribute__((ext_vector_type(8)));
typedef float f32x4 __attribute__((ext_vector_type(4)));
typedef unsigned u32x4 __attribute__((ext_vector_type(4)));
constexpr int BM = 256, BK = 64, HALF = 128, HTB = HALF * BK * 2  , STAGE_BYTES = 8 * HTB, NXCD = 8, WGM = 8;

__host__ __device__ __forceinline__ int lds_byte(int r, int c) { const int st = (r >> 4) * 2 + (c >> 5), rr = r & 15, cc = c & 31, ob = rr * 64 + cc * 2; return st * 1024 + (ob ^ (((ob >> 9) & 1) << 5)); }
__host__ __device__ __forceinline__ void stage_rc(int b, int& R, int& C) { const int st = b / 1024, sb = b % 1024, swz = sb ^ (((sb >> 9) & 1) << 5); R = (st >> 1) * 16 + swz / 64; C = (st & 1) * 32 + (swz % 64) / 2; }
__host__ __device__ __forceinline__ int perm32(int rho) { const int n = rho >> 4, i = rho & 15; return 8 * (i >> 2) + 4 * n + (i & 3); }

struct Unit { int pm, pn; };
struct Gemm { const bf16_t* A; const bf16_t* Bt; int M, N, K; const int* rowidx = nullptr; };

struct StaticOrder {
    int nM, nN, nwg, G, c;
    __host__ __device__ void init(int M, int N, int G_, int c_) { nM = M / BM; nN = N / BM; nwg = nM * nN; G = G_; c = c_; }
    __host__ __device__ bool next(int i, Unit& u) const {
        const long L = (long)i * G + c; if (L >= nwg) return false;
        int wgid = (int)L; { const int q = nwg / NXCD, r = nwg % NXCD, xcd = wgid % NXCD, off = wgid / NXCD; wgid = (xcd < r ? xcd * (q + 1) : r * (q + 1) + (xcd - r) * q) + off; }
        const int nig = WGM * nN, gid = wgid / nig, fm = gid * WGM, gsz = (nM - fm) < WGM ? (nM - fm) : WGM;
        u.pm = fm + ((wgid % nig) % gsz); u.pn = (wgid % nig) / gsz; return true;
    }
    __device__ __forceinline__ void a_ready(const Unit&) const {}
    __device__ __forceinline__ void done(const Unit&) const {}
};

typedef float f32x2c_t __attribute__((ext_vector_type(2))); typedef __bf16 bf16x2c_t __attribute__((ext_vector_type(2)));
__device__ __forceinline__ unsigned cvt_pk_bf16(float lo, float hi) { const f32x2c_t v = {lo, hi}; const bf16x2c_t b = __builtin_convertvector(v, bf16x2c_t); return __builtin_bit_cast(unsigned, b); }
typedef float f32x2 __attribute__((ext_vector_type(2)));
__device__ __forceinline__ float fast_sigmoid(float x) { return __builtin_amdgcn_rcpf(1.0f + __builtin_amdgcn_exp2f(-1.4426950408889634f * x)); }
struct EpiZ {
    static constexpr bool PERM = true, AFTER_DRAIN = false;
    bf16_t *q, *k, *vt, *poolz, *rwkvz; float qscale; int seq;
    __device__ __forceinline__ void operator()(const f32x4 (&acc)[2][2][4][2], const Unit& u, int wr, int wc, int fr, int fq) const {
        const int pn = u.pn;
        if (pn == 4 || pn == 5) {
            const int row0 = u.pm * BM + wr * 64 + fr, c0 = (pn - 4) * 256 + wc * 32 + 8 * fq;
#pragma unroll
            for (int ai = 0; ai < 2; ++ai)
#pragma unroll
                for (int m = 0; m < 4; ++m) { const int row = row0 + ai * HALF + m * 16, b = row / seq, tl = row - b * seq;
#pragma unroll
                    for (int bj = 0; bj < 2; ++bj) { const int c = c0 + bj * HALF, h = c >> 6, d = c & 63; bf16_t* vp = vt + ((size_t)(b * 8 + h) * 64 + d) * seq + tl;
                        const unsigned w0 = cvt_pk_bf16(acc[ai][bj][m][0][0], acc[ai][bj][m][0][1]), w1 = cvt_pk_bf16(acc[ai][bj][m][0][2], acc[ai][bj][m][0][3]);
                        const unsigned w2 = cvt_pk_bf16(acc[ai][bj][m][1][0], acc[ai][bj][m][1][1]), w3 = cvt_pk_bf16(acc[ai][bj][m][1][2], acc[ai][bj][m][1][3]);
                        vp[0] = (bf16_t)(w0 & 0xffffu); vp[(size_t)seq] = (bf16_t)(w0 >> 16); vp[(size_t)2 * seq] = (bf16_t)(w1 & 0xffffu); vp[(size_t)3 * seq] = (bf16_t)(w1 >> 16);
                        vp[(size_t)4 * seq] = (bf16_t)(w2 & 0xffffu); vp[(size_t)5 * seq] = (bf16_t)(w2 >> 16); vp[(size_t)6 * seq] = (bf16_t)(w3 & 0xffffu); vp[(size_t)7 * seq] = (bf16_t)(w3 >> 16); } }
            return;
        }
        bf16_t* base; int ldc, colt, climit; float sc = 1.f;
        if (pn < 2) { base = q; ldc = 512; colt = pn * 256; climit = 512; sc = qscale; }
        else if (pn < 4) { base = k; ldc = 512; colt = (pn - 2) * 256; climit = 512; }
        else if (pn < 8) { base = poolz; ldc = 512; colt = (pn - 6) * 256; climit = 512; }
        else { base = rwkvz; ldc = 1824; colt = (pn - 8) * 256; climit = 1824; }
        const int row0 = u.pm * BM + wr * 64 + fr, col0 = colt + wc * 32 + 8 * fq;
#pragma unroll
        for (int ai = 0; ai < 2; ++ai)
#pragma unroll
            for (int m = 0; m < 4; ++m) { bf16_t* rowp = base + (size_t)(row0 + ai * HALF + m * 16) * ldc + col0;
#pragma unroll
                for (int bj = 0; bj < 2; ++bj) { if (col0 + bj * HALF < climit) { const f32x4 v0 = acc[ai][bj][m][0] * sc, v1 = acc[ai][bj][m][1] * sc;
                    u32x4 w; w.x = cvt_pk_bf16(v0[0], v0[1]); w.y = cvt_pk_bf16(v0[2], v0[3]); w.z = cvt_pk_bf16(v1[0], v1[1]); w.w = cvt_pk_bf16(v1[2], v1[3]);
                    *(u32x4*)(rowp + bj * HALF) = w; } } }
    }
};
typedef unsigned u32x2e __attribute__((ext_vector_type(2)));
struct EpiGate {
    static constexpr bool PERM = true, AFTER_DRAIN = false;
    unsigned char* O; int ldc;
    __device__ __forceinline__ void operator()(const f32x4 (&acc)[2][2][4][2], const Unit& u, int wr, int wc, int fr, int fq) const {
        const int row0 = u.pm * BM + wr * 64 + fr, col0 = u.pn * BM + wc * 32 + 8 * fq;
#pragma unroll
        for (int ai = 0; ai < 2; ++ai)
#pragma unroll
            for (int m = 0; m < 4; ++m) { unsigned char* rowp = O + (size_t)(row0 + ai * HALF + m * 16) * ldc + col0;
#pragma unroll
                for (int bj = 0; bj < 2; ++bj) { const f32x4 v0 = acc[ai][bj][m][0], v1 = acc[ai][bj][m][1]; unsigned q[8];
#pragma unroll
                    for (int e = 0; e < 4; ++e) { q[e] = (unsigned)(fast_sigmoid(v0[e]) * 255.0f + 0.5f); q[4 + e] = (unsigned)(fast_sigmoid(v1[e]) * 255.0f + 0.5f); }
                    *(u32x2e*)(rowp + bj * HALF) = (u32x2e){q[0] | (q[1] << 8) | (q[2] << 16) | (q[3] << 24), q[4] | (q[5] << 8) | (q[6] << 16) | (q[7] << 24)}; } }
    }
};
__device__ __forceinline__ float bflo(unsigned w) { return __uint_as_float(w << 16); }
__device__ __forceinline__ float bfhi(unsigned w) { return __uint_as_float(w & 0xffff0000u); }
template <bool FIRST> struct EpiMerge {
    static constexpr bool PERM = true, AFTER_DRAIN = false;
    bf16_t* O; int ldc; const unsigned char* gate; int ldg, goff;
    __device__ __forceinline__ void operator()(const f32x4 (&acc)[2][2][4][2], const Unit& u, int wr, int wc, int fr, int fq) const {
        const int row0 = u.pm * BM + wr * 64 + fr, col0 = u.pn * BM + wc * 32 + 8 * fq;
#pragma unroll
        for (int ai = 0; ai < 2; ++ai)
#pragma unroll
            for (int m = 0; m < 4; ++m) { const size_t r = (size_t)(row0 + ai * HALF + m * 16); bf16_t* rowp = O + r * ldc + col0; const unsigned char* gp = gate + r * ldg + goff + col0;
#pragma unroll
                for (int bj = 0; bj < 2; ++bj) { const f32x4 v0 = acc[ai][bj][m][0], v1 = acc[ai][bj][m][1];
                    const u32x2e g = *(const u32x2e*)(gp + bj * HALF); const float s = 1.0f / 255.0f;
                    float o[8] = {v0[0] * (float)(g.x & 255u) * s, v0[1] * (float)((g.x >> 8) & 255u) * s, v0[2] * (float)((g.x >> 16) & 255u) * s, v0[3] * (float)(g.x >> 24) * s,
                                  v1[0] * (float)(g.y & 255u) * s, v1[1] * (float)((g.y >> 8) & 255u) * s, v1[2] * (float)((g.y >> 16) & 255u) * s, v1[3] * (float)(g.y >> 24) * s};
                    if (!FIRST) { const u32x4 p = *(const u32x4*)(rowp + bj * HALF);
                        o[0] += bflo(p.x); o[1] += bfhi(p.x); o[2] += bflo(p.y); o[3] += bfhi(p.y); o[4] += bflo(p.z); o[5] += bfhi(p.z); o[6] += bflo(p.w); o[7] += bfhi(p.w); }
                    u32x4 w; w.x = cvt_pk_bf16(o[0], o[1]); w.y = cvt_pk_bf16(o[2], o[3]); w.z = cvt_pk_bf16(o[4], o[5]); w.w = cvt_pk_bf16(o[6], o[7]);
                    *(u32x4*)(rowp + bj * HALF) = w; } }
    }
};
struct EpiResF32 {
    static constexpr bool PERM = false, AFTER_DRAIN = false;
    const float* base; float* out; int ldc;
    __device__ __forceinline__ void operator()(const f32x4 (&acc)[2][2][4][2], const Unit& u, int wr, int wc, int fr, int fq) const {
        const int row0 = u.pm * BM + wr * 64 + fr, col0 = u.pn * BM + wc * 32 + 4 * fq;
#pragma unroll
        for (int ai = 0; ai < 2; ++ai)
#pragma unroll
            for (int m = 0; m < 4; ++m) { const size_t off = (size_t)(row0 + ai * HALF + m * 16) * ldc + col0;
#pragma unroll
                for (int bj = 0; bj < 2; ++bj)
#pragma unroll
                    for (int n = 0; n < 2; ++n) { const f32x4 bs = *(const f32x4*)(base + off + bj * HALF + n * 16); *(f32x4*)(out + off + bj * HALF + n * 16) = bs + acc[ai][bj][m][n]; } }
    }
};
struct EpiSwiGLU {
    static constexpr bool PERM = true, AFTER_DRAIN = false;
    bf16_t* O;
    __device__ __forceinline__ void operator()(const f32x4 (&acc)[2][2][4][2], const Unit& u, int wr, int wc, int fr, int fq) const {
        const int row0 = u.pm * BM + wr * 64 + fr, col0 = (u.pn & 3) * 128 + wc * 32 + 8 * fq;
#pragma unroll
        for (int ai = 0; ai < 2; ++ai)
#pragma unroll
            for (int m = 0; m < 4; ++m) { bf16_t* rowp = O + (size_t)(row0 + ai * HALF + m * 16) * 512 + col0;
                float o[8];
#pragma unroll
                for (int n = 0; n < 2; ++n)
#pragma unroll
                    for (int e = 0; e < 4; ++e) { const float a1 = acc[ai][0][m][n][e], a3 = acc[ai][1][m][n][e]; o[n * 4 + e] = a1 * fast_sigmoid(a1) * a3; }
                u32x4 w; w.x = cvt_pk_bf16(o[0], o[1]); w.y = cvt_pk_bf16(o[2], o[3]); w.z = cvt_pk_bf16(o[4], o[5]); w.w = cvt_pk_bf16(o[6], o[7]);
                *(u32x4*)rowp = w; }
    }
};
struct EpiY {
    static constexpr bool PERM = true, AFTER_DRAIN = false;
    bf16_t* O;
    __device__ __forceinline__ void operator()(const f32x4 (&acc)[2][2][4][2], const Unit& u, int wr, int wc, int fr, int fq) const {
        const int row0 = u.pm * BM + wr * 64 + fr, col0 = (u.pn & 3) * BM + wc * 32 + 8 * fq;
#pragma unroll
        for (int ai = 0; ai < 2; ++ai)
#pragma unroll
            for (int m = 0; m < 4; ++m) { bf16_t* rowp = O + (size_t)(row0 + ai * HALF + m * 16) * 1024 + col0;
#pragma unroll
                for (int bj = 0; bj < 2; ++bj) { const f32x4 v0 = acc[ai][bj][m][0], v1 = acc[ai][bj][m][1];
                    u32x4 w; w.x = cvt_pk_bf16(v0[0], v0[1]); w.y = cvt_pk_bf16(v0[2], v0[3]); w.z = cvt_pk_bf16(v1[0], v1[1]); w.w = cvt_pk_bf16(v1[2], v1[3]);
                    *(u32x4*)(rowp + bj * HALF) = w; } }
    }
};
struct MoeOrder {
    const PG8_LAS unsigned char* tile_e; int nunits, G, c;
    __device__ __forceinline__ bool next(int i, Unit& u) const {
        const int L = i * G + c; if (L >= nunits) return false;
        const int pm = L >> 2; u.pm = pm; u.pn = __builtin_amdgcn_readfirstlane((int)tile_e[pm]) * 4 + (L & 3); return true;
    }
    __device__ __forceinline__ void a_ready(const Unit&) const {}
    __device__ __forceinline__ void done(const Unit&) const {}
};
template <class Epi, class Sched, bool ALIGN_EPI = false, bool SP2 = false, bool GATHER = false>
__device__ __forceinline__ void gemm_phase(PG8_LAS unsigned char* lds, const Gemm g, const Sched& S, const Epi& E) {
    int tid = threadIdx.x; asm volatile("" : "+v"(tid));
    const int wid = __builtin_amdgcn_readfirstlane(tid >> 6), lane = tid & 63, wr = wid >> 2, wc = wid & 3, fr = lane & 15, fq = lane >> 4;
    const int K = g.K, nt = K / BK;
    unsigned voffA[2], voffB[2];
#pragma unroll
    for (int i = 0; i < 2; ++i) { int R, C; stage_rc(tid * 16 + i * 8192, R, C); const int Rb = Epi::PERM ? ((R & ~31) + perm32(R & 31)) : R;
        voffA[i] = (unsigned)(R * K + C) * 2u; voffB[i] = (unsigned)(Rb * K + C) * 2u; }
    unsigned vc[2][2] = {{0u, 0u}, {0u, 0u}}, vn[2][2] = {{0u, 0u}, {0u, 0u}};
#define PG8_GVOFF(dst, pm_) do { if constexpr (GATHER) { _Pragma("unroll") for (int h_ = 0; h_ < 2; ++h_) _Pragma("unroll") for (int i_ = 0; i_ < 2; ++i_) { int R_, C_; stage_rc(tid * 16 + i_ * 8192, R_, C_); \
        const int tok_ = g.rowidx[(size_t)(pm_) * BM + h_ * HALF + R_]; dst[h_][i_] = (unsigned)((size_t)tok_ * K + C_) * 2u; } } } while (0)
    const size_t kstep = (size_t)(BK * 2);
    const size_t hstep = (size_t)HALF * K * 2;
    const size_t tstep = 2 * hstep;
    const unsigned ldsw = (unsigned)wid * 1024u;
    const int aoff = lds_byte(wr * 64 + fr, fq * 8), boff = lds_byte(wc * 32 + fr, fq * 8);
#define PG8_SA(b, h) (((b) * 2 + (h)) * HTB)
#define PG8_SB(b, h) ((4 + (b) * 2 + (h)) * HTB)
#define PG8_STAGE(bufoff, gbase, voff) do { _Pragma("unroll") for (int _i = 0; _i < 2; ++_i) \
        __builtin_amdgcn_global_load_lds((const unsigned*)((const char*)(gbase) + (voff)[_i]), (PG8_LAS unsigned*)(lds + (bufoff) + ldsw + _i * 8192), 16, 0, 0); } while (0)
#define PG8_STAGE_A(bufoff, ptr, half, nx) do { if constexpr (GATHER) { unsigned vo_[2]; vo_[0] = (nx) ? vn[half][0] : vc[half][0]; vo_[1] = (nx) ? vn[half][1] : vc[half][1]; PG8_STAGE(bufoff, ptr, vo_); } \
        else { PG8_STAGE(bufoff, (ptr) + (half) * hstep, voffA); } } while (0)
#define PG8_LDA(dst, b, h) do { _Pragma("unroll") for (int m = 0; m < 4; ++m) _Pragma("unroll") for (int k = 0; k < 2; ++k) dst[m][k] = *(const PG8_LAS bf16x8*)(lds + PG8_SA(b, h) + aoff + m * 2048 + k * 1024); } while (0)
#define PG8_LDB(dst, b, h) do { _Pragma("unroll") for (int n = 0; n < 2; ++n) _Pragma("unroll") for (int k = 0; k < 2; ++k) dst[n][k] = *(const PG8_LAS bf16x8*)(lds + PG8_SB(b, h) + boff + n * 2048 + k * 1024); } while (0)
#define PG8_MMA(ai, bj, At, Bt) do { __builtin_amdgcn_s_setprio(1); _Pragma("unroll") for (int m = 0; m < 4; ++m) _Pragma("unroll") for (int n = 0; n < 2; ++n) _Pragma("unroll") for (int k = 0; k < 2; ++k) \
        acc[ai][bj][m][n] = __builtin_amdgcn_mfma_f32_16x16x32_bf16(Bt[n][k], At[m][k], acc[ai][bj][m][n], 0, 0, 0); __builtin_amdgcn_s_setprio(0); } while (0)
#define PG8_WAIT_V(n) asm volatile("s_waitcnt vmcnt(" #n ")" ::: "memory")
#define PG8_WAIT_L(n) asm volatile("s_waitcnt lgkmcnt(" #n ")" ::: "memory")
#define PG8_BAR __builtin_amdgcn_s_barrier()
#define PG8_SCHED __builtin_amdgcn_sched_barrier(0)
    Unit cur, nxt; int ui = 0;
    if (!S.next(0, cur)) return;
    f32x4 acc[2][2][4][2];
#pragma unroll
    for (int a = 0; a < 2; ++a)
#pragma unroll
        for (int b = 0; b < 2; ++b)
#pragma unroll
            for (int m = 0; m < 4; ++m)
#pragma unroll
                for (int n = 0; n < 2; ++n) acc[a][b][m][n] = (f32x4){0.f, 0.f, 0.f, 0.f};
    bf16x8 At[4][2], B0[2][2], B1[2][2];
    const char* cA = (const char*)g.A + (GATHER ? (size_t)0 : (size_t)cur.pm * tstep); const char* cB = (const char*)g.Bt + (size_t)cur.pn * tstep;
    PG8_GVOFF(vc, cur.pm);
    S.a_ready(cur);
    if constexpr (SP2) {
        PG8_STAGE(PG8_SB(0, 0), cB, voffB); PG8_STAGE(PG8_SB(0, 1), cB + hstep, voffB); PG8_STAGE_A(PG8_SA(0, 0), cA, 0, false); PG8_STAGE_A(PG8_SA(0, 1), cA, 1, false);
        if (wr == 1) PG8_BAR;
        PG8_WAIT_V(2); PG8_BAR;
        PG8_STAGE(PG8_SB(1, 0), cB + kstep, voffB); PG8_STAGE_A(PG8_SA(1, 0), cA + kstep, 0, false); PG8_STAGE(PG8_SB(1, 1), cB + hstep + kstep, voffB);
        PG8_WAIT_V(6); PG8_BAR;
    } else {
        PG8_STAGE(PG8_SB(0, 0), cB, voffB); PG8_STAGE_A(PG8_SA(0, 0), cA, 0, false); PG8_STAGE(PG8_SB(0, 1), cB + hstep, voffB); PG8_STAGE_A(PG8_SA(0, 1), cA, 1, false);
        if (wr == 1) PG8_BAR;
        PG8_WAIT_V(4); PG8_BAR;
        PG8_STAGE(PG8_SB(1, 0), cB + kstep, voffB); PG8_STAGE_A(PG8_SA(1, 0), cA + kstep, 0, false); PG8_STAGE(PG8_SB(1, 1), cB + hstep + kstep, voffB);
        PG8_WAIT_V(6); PG8_BAR;
    }
    for (;;) {
        const bool has_next = S.next(ui + 1, nxt);
        const char* nA = (has_next && !GATHER) ? (const char*)g.A + (size_t)nxt.pm * tstep : cA; if (has_next) PG8_GVOFF(vn, nxt.pm); else { vn[0][0] = vc[0][0]; vn[0][1] = vc[0][1]; vn[1][0] = vc[1][0]; vn[1][1] = vc[1][1]; } const char* nB = has_next ? (const char*)g.Bt + (size_t)nxt.pn * tstep : cB;
        for (int t = 0; t < nt; t += 2) {
            const bool last = (t == nt - 2);
            const char* a1 = cA + (size_t)(t + 1) * kstep;
            const char* a2 = last ? nA : cA + (size_t)(t + 2) * kstep; const char* b2 = last ? nB : cB + (size_t)(t + 2) * kstep;
            const char* a3 = a2 + kstep; const char* b3 = b2 + kstep;
            if (last && has_next) S.a_ready(nxt);
            if constexpr (SP2) {
            PG8_LDB(B0, 0, 0); PG8_LDB(B1, 0, 1); PG8_SCHED; PG8_LDA(At, 0, 0); PG8_STAGE_A(PG8_SA(1, 1), a1, 1, false);
            PG8_WAIT_V(8); PG8_WAIT_L(0); PG8_BAR; PG8_MMA(0, 0, At, B0); PG8_MMA(0, 1, At, B1); PG8_BAR; PG8_SCHED;
            PG8_LDA(At, 0, 1); PG8_STAGE(PG8_SB(0, 0), b2, voffB); PG8_STAGE(PG8_SB(0, 1), b2 + hstep, voffB); PG8_STAGE_A(PG8_SA(0, 0), a2, 0, last);
            PG8_WAIT_V(8); PG8_WAIT_L(0); PG8_BAR; PG8_MMA(1, 0, At, B0); PG8_MMA(1, 1, At, B1); PG8_BAR; PG8_SCHED;
            PG8_LDB(B0, 1, 0); PG8_LDB(B1, 1, 1); PG8_SCHED; PG8_LDA(At, 1, 0); PG8_STAGE_A(PG8_SA(0, 1), a2, 1, last);
            PG8_WAIT_V(8); PG8_WAIT_L(0); PG8_BAR; PG8_MMA(0, 0, At, B0); PG8_MMA(0, 1, At, B1); PG8_BAR; PG8_SCHED;
            PG8_LDA(At, 1, 1); PG8_STAGE(PG8_SB(1, 0), b3, voffB); PG8_STAGE(PG8_SB(1, 1), b3 + hstep, voffB); PG8_STAGE_A(PG8_SA(1, 0), a3, 0, last);
            PG8_WAIT_V(8); PG8_WAIT_L(0); PG8_BAR; PG8_MMA(1, 0, At, B0); PG8_MMA(1, 1, At, B1); PG8_BAR; PG8_SCHED;
            } else {
            PG8_LDB(B0, 0, 0); PG8_SCHED; PG8_LDA(At, 0, 0); PG8_STAGE_A(PG8_SA(1, 1), a1, 1, false);
            PG8_WAIT_L(8); PG8_BAR; PG8_WAIT_L(0); PG8_MMA(0, 0, At, B0); PG8_BAR; PG8_SCHED;
            PG8_LDB(B1, 0, 1); PG8_STAGE(PG8_SB(0, 0), b2, voffB);
            PG8_BAR; PG8_WAIT_L(0); PG8_MMA(0, 1, At, B1); PG8_BAR;
            PG8_LDA(At, 0, 1); PG8_STAGE_A(PG8_SA(0, 0), a2, 0, last);
            PG8_BAR; PG8_WAIT_L(0); PG8_MMA(1, 0, At, B0); PG8_BAR; PG8_SCHED;
            PG8_STAGE(PG8_SB(0, 1), b2 + hstep, voffB);
            PG8_WAIT_V(6); PG8_BAR; PG8_MMA(1, 1, At, B1); PG8_BAR;
            PG8_LDB(B0, 1, 0); PG8_SCHED; PG8_LDA(At, 1, 0); PG8_STAGE_A(PG8_SA(0, 1), a2, 1, last);
            PG8_WAIT_L(8); PG8_BAR; PG8_WAIT_L(0); PG8_MMA(0, 0, At, B0); PG8_BAR; PG8_SCHED;
            PG8_LDB(B1, 1, 1); PG8_STAGE(PG8_SB(1, 0), b3, voffB);
            PG8_BAR; PG8_WAIT_L(0); PG8_MMA(0, 1, At, B1); PG8_BAR;
            PG8_LDA(At, 1, 1); PG8_STAGE_A(PG8_SA(1, 0), a3, 0, last);
            PG8_BAR; PG8_WAIT_L(0); PG8_MMA(1, 0, At, B0); PG8_BAR; PG8_SCHED;
            PG8_STAGE(PG8_SB(1, 1), b3 + hstep, voffB);
            PG8_WAIT_V(6); PG8_BAR; PG8_MMA(1, 1, At, B1); PG8_BAR;
            }
        }
        if constexpr (ALIGN_EPI) { if (wr == 0) PG8_BAR; }
        if constexpr (!Epi::AFTER_DRAIN) { E(acc, cur, wr, wc, fr, fq); S.done(cur); }
        if (!has_next) break;
#pragma unroll
        for (int a = 0; a < 2; ++a)
#pragma unroll
            for (int b = 0; b < 2; ++b)
#pragma unroll
                for (int m = 0; m < 4; ++m)
#pragma unroll
                    for (int n = 0; n < 2; ++n) acc[a][b][m][n] = (f32x4){0.f, 0.f, 0.f, 0.f};
        cur = nxt; cA = nA; cB = nB; ++ui; vc[0][0] = vn[0][0]; vc[0][1] = vn[0][1]; vc[1][0] = vn[1][0]; vc[1][1] = vn[1][1];
        if constexpr (ALIGN_EPI) { if (wr == 1) PG8_BAR; }
    }
    PG8_WAIT_V(0);
    if constexpr (!ALIGN_EPI) { if (wr == 0) PG8_BAR; }
    PG8_BAR;
    if constexpr (Epi::AFTER_DRAIN) { E.fused(acc, cur, wr, wc, fr, fq, lds, wid, lane); S.done(cur); }
#undef PG8_SA
#undef PG8_SB
#undef PG8_STAGE
#undef PG8_STAGE_A
#undef PG8_GVOFF
#undef PG8_LDA
#undef PG8_LDB
#undef PG8_MMA
#undef PG8_WAIT_V
#undef PG8_WAIT_L
#undef PG8_BAR
#undef PG8_SCHED
}
}
namespace cg = cooperative_groups;
#define DI __device__ __forceinline__
#define LAS __attribute__((address_space(3)))
typedef unsigned short bf16;
typedef float f32x4 __attribute__((ext_vector_type(4)));
typedef unsigned u32x4 __attribute__((ext_vector_type(4)));
typedef unsigned u32x2 __attribute__((ext_vector_type(2)));
typedef short bf16x8_t __attribute__((ext_vector_type(8)));

constexpr int BATCH = 2, SEQ = 16384, DM = 1024, T = BATCH * SEQ, DEPTH = 2;
constexpr int NEXP = 32, RZP = 1824;
constexpr int RMAX = 73728;
constexpr float C2 = 0.125f * 1.4426950408889634f;
constexpr float LOG2E = 1.4426950408889634f;
constexpr size_t MiB = 1u << 20;
constexpr size_t WS_CTL = 0, CTL_BYTES = 1 * MiB;
constexpr size_t WS_WIN = 1 * MiB, WS_WG = 9 * MiB, WS_WBR = 15 * MiB, WS_WOUT = 18 * MiB;
constexpr size_t WS_KMEAN = 20 * MiB, WS_RWG = 20 * MiB + 512 * 1024, WS_ROUTE = 21 * MiB, WS_RWT = 22 * MiB, WS_DEST = 22 * MiB + 512 * 1024, WS_BONUS = 23 * MiB, WS_WLT = 24 * MiB, WS_WPT = 24 * MiB + 512 * 1024, WS_WGBASE = 24 * MiB + 768 * 1024, WS_KINV = 25 * MiB, WS_ROWTOK = 25 * MiB, WS_PGT = 26 * MiB, WS_LG = 28 * MiB, WS_SG = 30 * MiB;
constexpr size_t WS_XB = 32 * MiB, WS_VFIRST = 96 * MiB, WS_YPOOL = 128 * MiB, WS_YATTN = 160 * MiB;
constexpr size_t WS_BIG = 192 * MiB;
constexpr size_t WS_Q = WS_BIG, WS_K = WS_BIG + 32 * MiB, WS_V = WS_BIG + 64 * MiB, WS_POOLZ = WS_BIG + 232 * MiB, WS_RWKVZ = WS_BIG + 264 * MiB;
constexpr size_t WS_AR = WS_BIG;
constexpr size_t WS_GATES = WS_BIG + 32 * MiB;
constexpr size_t WS_XPERM = WS_BIG, WS_HACT = WS_BIG + 144 * MiB, WS_W13 = WS_BIG + 216 * MiB, WS_W2 = WS_BIG + 280 * MiB, WS_YMOE = WS_BIG;
constexpr size_t WS_VT = WS_YATTN;
constexpr size_t WS_PARTO = WS_BIG + 96 * MiB, WS_PARTML = WS_BIG + 224 * MiB;
constexpr size_t WS_LIST = WS_BIG + 378 * MiB;
constexpr size_t WS_PCT = WS_BIG + 32 * MiB, WS_LC = WS_BIG + 64 * MiB, WS_RM = WS_BIG + 128 * MiB, WS_Y0 = WS_BIG + 160 * MiB, WS_S0 = WS_BIG + 352 * MiB;
constexpr int LSTRIDE = 516096;
constexpr size_t WS_END = WS_BIG + 394 * MiB;
static_assert(WS_LIST + (size_t)16 * LSTRIDE * 2 <= WS_END, "ws map");
static_assert(WS_RWKVZ + (size_t)T * RZP * 2 <= WS_END, "ws map");
static_assert(WS_W2 + (size_t)32 * 1024 * 512 * 2 <= WS_END, "ws map");
constexpr int CW_CNT = 64, CW_LCNT = 1024, CW_BAR = 4096;
constexpr int LDS_BYTES = 147456, MISC_OFF = 131072;

DI float bf2f(unsigned short u) { return __uint_as_float((unsigned)u << 16); }
DI unsigned f2bf(float f) { return pg8::cvt_pk_bf16(f, 0.f) & 0xffffu; }
DI unsigned pk2(float lo, float hi) { return pg8::cvt_pk_bf16(lo, hi); }
DI float blo(unsigned w) { return __uint_as_float(w << 16); }
DI float bhi(unsigned w) { return __uint_as_float(w & 0xffff0000u); }
DI float wave_sum(float v) {
#pragma unroll
    for (int o = 1; o < 64; o <<= 1) v += __shfl_xor(v, o);
    return v;
}
DI float wave_max(float v) {
#pragma unroll
    for (int o = 1; o < 64; o <<= 1) v = fmaxf(v, __shfl_xor(v, o));
    return v;
}
DI float fexp_(float x) { return __builtin_amdgcn_exp2f(x * 1.4426950408889634f); }
DI float frcp_(float x) { return __builtin_amdgcn_rcpf(x); }
DI float sigmoidf_(float x) { return frcp_(1.0f + fexp_(-x)); }
DI float ftanh_(float x) { return 1.0f - 2.0f * frcp_(1.0f + fexp_(2.0f * x)); }
DI float fsoftplus_(float x) { return x > 20.f ? x : __builtin_amdgcn_logf(1.0f + fexp_(x)) * 0.6931471805599453f; }
#define LDS_WAIT() asm volatile("s_waitcnt lgkmcnt(0)" ::: "memory")

#define XB_TMO      128
#define XB_XCNT(j)  (256  + 64 * (j))
#define XB_XSUB(j)  (1280 + 64 * (j))
#define XB_XGEN(j)  (2304 + 64 * (j))
#define XB_TOP      3328
#define XB_TOPGEN   3392
#define XCD_BAR_WORDS 3456
#define XB_SPIN_CAP (1u << 27)

__device__ __forceinline__ unsigned xb_ld(unsigned* p)              { return __hip_atomic_load(p, __ATOMIC_RELAXED, __HIP_MEMORY_SCOPE_AGENT); }
__device__ __forceinline__ unsigned xb_add(unsigned* p, unsigned v) { return __hip_atomic_fetch_add(p, v, __ATOMIC_RELAXED, __HIP_MEMORY_SCOPE_AGENT); }
__device__ __forceinline__ unsigned xb_xcc_id() { return (unsigned)__builtin_amdgcn_s_getreg((3 << 11) | 20) & 0xFu; }
#define XB_SPIN(cond, bar) do { unsigned _sp = 0; while (cond) { __builtin_amdgcn_s_sleep(1); \
    if ((++_sp & 255u) == 0u) { if (xb_ld(&(bar)[XB_TMO])) break; if (_sp > XB_SPIN_CAP) { atomicAdd(&(bar)[XB_TMO], 1u); break; } } } } while (0)

struct XcdBarrier {
    unsigned* bar; unsigned x;
    volatile LAS unsigned* st;
};

__device__ __forceinline__ XcdBarrier xcd_barrier_post(unsigned* bar, volatile LAS unsigned* st) {
    XcdBarrier b; b.bar = bar; b.x = xb_xcc_id(); b.st = st;
    if (threadIdx.x == 0) (void)xb_add(&bar[XB_XCNT(b.x)], 1u);
    return b;
}
__device__ __forceinline__ void xcd_barrier_complete(unsigned* bar, unsigned x, unsigned& nloc, unsigned& nx) {
    const unsigned G = gridDim.x * gridDim.y * gridDim.z;
    unsigned sum, cnt, mine, sp = 0u;
    for (;;) {
        sum = 0u; cnt = 0u; mine = 0u;
#pragma unroll
        for (unsigned j = 0; j < 16; ++j) { const unsigned c = xb_ld(&bar[XB_XCNT(j)]); sum += c; cnt += (c > 0u) ? 1u : 0u; mine = (j == x) ? c : mine; }
        if (sum == G) break;
        __builtin_amdgcn_s_sleep(1);
        if ((++sp & 255u) == 0u) { if (xb_ld(&bar[XB_TMO])) break; if (sp > XB_SPIN_CAP) { atomicAdd(&bar[XB_TMO], 1u); break; } }
    }
    nloc = mine > 0u ? mine : 1u; nx = cnt > 0u ? cnt : 1u;
}

__device__ __forceinline__ void xcd_barrier(const XcdBarrier& b) {
    asm volatile("s_waitcnt vmcnt(0)" ::: "memory");
    __syncthreads();
    if (threadIdx.x == 0) {
        unsigned* bar = b.bar;
        __builtin_amdgcn_s_waitcnt(0);
        unsigned nloc = b.st[0], nx = b.st[1];
        if (nloc == 0u) { xcd_barrier_complete(bar, b.x, nloc, nx); b.st[0] = nloc; b.st[1] = nx; }
        const unsigned old = xb_add(&bar[XB_XSUB(b.x)], 1u);
        const unsigned gen = old / nloc;
        if (old + 1u == (gen + 1u) * nloc) {
            __builtin_amdgcn_fence(__ATOMIC_RELEASE, "agent");
            asm volatile("s_waitcnt vmcnt(0)" ::: "memory");
            const unsigned og = xb_add(&bar[XB_TOP], 1u);
            const unsigned tg = og / nx;
            if (og + 1u == (tg + 1u) * nx) xb_add(&bar[XB_TOPGEN], 1u);
            else XB_SPIN(xb_ld(&bar[XB_TOPGEN]) == tg, bar);
            __builtin_amdgcn_fence(__ATOMIC_ACQUIRE, "agent");
            xb_add(&bar[XB_XGEN(b.x)], 1u);
            asm volatile("s_waitcnt vmcnt(0)" ::: "memory");
        } else {
            XB_SPIN(xb_ld(&bar[XB_XGEN(b.x)]) == gen, bar);
            __builtin_amdgcn_fence(__ATOMIC_ACQUIRE, "agent");
            asm volatile("s_waitcnt vmcnt(0)" ::: "memory");
        }
    }
    __syncthreads();
}

struct Args { const float* in[31]; float* out; unsigned char* ws; };

typedef const __attribute__((address_space(4))) unsigned long long* kargp_t;
struct Frame {
    LAS unsigned char* lds; int tid, lane, wave, G, bid;
    kargp_t kp;
};
#define GASQ __attribute__((address_space(1)))
DI const float* INP(const Frame& F, int i) { return (const float*)(const GASQ float*)F.kp[i]; }
DI float* OUTP(const Frame& F) { return (float*)(GASQ float*)F.kp[31]; }
DI unsigned char* WSP(const Frame& F) { return (unsigned char*)(GASQ unsigned char*)F.kp[32]; }
DI void fence_frame(Frame& F) {
    asm volatile("" : "+s"(F.kp) :: "memory"); asm volatile("" : "+s"(F.G)); asm volatile("" : "+s"(F.bid));
    F.tid = threadIdx.x; asm volatile("" : "+v"(F.tid)); F.lane = F.tid & 63; F.wave = __builtin_amdgcn_readfirstlane(F.tid >> 6); }

DI void transpose_item(const float* W, int ldw, int ncols, bf16* WT, int ldt, const float* scale, LAS float* scr, int item, int lane) {
    const int nblk = ncols / 32, kb = item / nblk, nb = item % nblk, k0 = 64 * kb, n0 = 32 * nb;
    { const int rs = lane >> 3, c4 = (lane & 7) * 4; f32x4 v[8]; float sc[8];
#pragma unroll
      for (int i = 0; i < 8; ++i) { v[i] = *(const f32x4*)(W + (size_t)(k0 + 8 * i + rs) * ldw + n0 + c4); sc[i] = scale ? scale[k0 + 8 * i + rs] : 1.0f; }
#pragma unroll
      for (int i = 0; i < 8; ++i) { LAS float* d = scr + (8 * i + rs) * 33 + c4; d[0] = v[i].x * sc[i]; d[1] = v[i].y * sc[i]; d[2] = v[i].z * sc[i]; d[3] = v[i].w * sc[i]; } }
    LDS_WAIT(); asm volatile("" ::: "memory");
    const int c = lane & 7;
#pragma unroll
    for (int j = 0; j < 4; ++j) { const int n = (lane >> 3) + 8 * j; const LAS float* s = scr + (8 * c) * 33 + n;
        u32x4 o; o.x = pk2(s[0 * 33], s[1 * 33]); o.y = pk2(s[2 * 33], s[3 * 33]); o.z = pk2(s[4 * 33], s[5 * 33]); o.w = pk2(s[6 * 33], s[7 * 33]);
        *(u32x4*)(WT + (size_t)(n0 + n) * ldt + k0 + 8 * c) = o; }
    LDS_WAIT(); asm volatile("" ::: "memory");
}
DI void prep_mixer_weights(Frame& F, int l) {
    LAS float* scr = (LAS float*)(F.lds + F.wave * 16384);
    const int gw = F.bid * 8 + F.wave, NGW = F.G * 8;
    const float* w_in = INP(F, 2) + (size_t)l * 1024 * 6912; const float* g1 = INP(F, 1) + l * 1024;
    bf16* WIN = (bf16*)(WSP(F) + WS_WIN); bf16* WG = (bf16*)(WSP(F) + WS_WG); bf16* WBR = (bf16*)(WSP(F) + WS_WBR); bf16* WOUT = (bf16*)(WSP(F) + WS_WOUT);
    constexpr int I1 = 16 * (1536 / 32), I2 = 16 * (2304 / 32), I3 = 16 * 1, I4 = 16 * (3072 / 32), I5 = 8 * (1024 / 32), I6 = 16 * (1024 / 32);
    const int n3 = l > 0 ? I3 : 0;
    const int total = I1 + I2 + n3 + I4 + 3 * I5 + I6;
    for (int it = gw; it < total; it += NGW) {
        int r = it;
        if (r < I1) { transpose_item(w_in, 6912, 1536, WIN, 1024, g1, scr, r, F.lane); continue; } r -= I1;
        if (r < I2) { transpose_item(w_in + 4608, 6912, 2304, WIN + (size_t)1536 * 1024, 1024, g1, scr, r, F.lane); continue; } r -= I2;
        if (r < n3) { transpose_item(INP(F, 3) + (size_t)(l - 1) * 1024 * 32, 32, 32, WIN + (size_t)3840 * 1024, 1024, g1, scr, r, F.lane); continue; } r -= n3;
        if (r < I4) { transpose_item(w_in + 1536, 6912, 3072, WG, 1024, g1, scr, r, F.lane); continue; } r -= I4;
        if (r < 3 * I5) { const int i = r / I5; transpose_item(INP(F, 20) + (size_t)(l * 3 + i) * 512 * 1024, 1024, 1024, WBR + (size_t)i * 1024 * 512, 512, i == 2 ? INP(F, 19) + l * 512 : nullptr, scr, r % I5, F.lane); continue; } r -= 3 * I5;
        transpose_item(INP(F, 21) + (size_t)l * 1024 * 1024, 1024, 1024, WOUT, 1024, nullptr, scr, r, F.lane);
    }
    if (l > 0) {
        u32x4* z = (u32x4*)(WIN + (size_t)3872 * 1024); const int n16 = 224 * 1024 * 2 / 16;
        for (int i = F.bid * 512 + F.tid; i < n16; i += F.G * 512) z[i] = (u32x4){0u, 0u, 0u, 0u};
    }
    { bf16* WPT = (bf16*)(WSP(F) + WS_WPT);
      for (int it = gw; it < 32; it += NGW) transpose_item(INP(F, 18) + (size_t)(l * 4 + (it >> 3)) * 128 * 128, 128, 128, WPT + (size_t)(it >> 3) * 128 * 128, 128, nullptr, scr, it & 7, F.lane); }
    { bf16* WLT = (bf16*)(WSP(F) + WS_WLT);
      constexpr int L1 = 1 * 16, L2 = 1 * 16, L3 = 2 * 16;
      for (int it = gw; it < L1 + L2 + L3; it += NGW) {
          if (it < L1) transpose_item(INP(F, 7) + (size_t)l * 64 * 512, 512, 512, WLT, 288, nullptr, scr, it, F.lane);
          else if (it < L1 + L2) transpose_item(INP(F, 9) + (size_t)l * 64 * 512, 512, 512, WLT + 64, 288, nullptr, scr, it - L1, F.lane);
          else transpose_item(INP(F, 10) + (size_t)l * 128 * 512, 512, 512, WLT + 128, 288, nullptr, scr, it - L1 - L2, F.lane); }
      const float* wv = INP(F, 17) + (size_t)(l > 0 ? l - 1 : 0) * 32 * 512;
      for (int i = F.bid * 512 + F.tid; i < 32 * 512; i += F.G * 512) { const int k = i >> 9, ch = i & 511; WLT[(size_t)ch * 288 + 256 + k] = (bf16)f2bf(l > 0 ? wv[k * 512 + ch] : 0.f); } }
    { bf16* RWH = (bf16*)(WSP(F) + WS_RWG); bf16* RWL = RWH + 48 * 1024; const float* g2 = INP(F, 22) + l * 1024; const float* rgw = INP(F, 23) + (size_t)l * 1024 * 4; const float* rew = INP(F, 25) + (size_t)l * 1024 * 32;
      for (int i = F.bid * 512 + F.tid; i < 48 * 1024; i += F.G * 512) { const int r = i >> 10, k = i & 1023;
          const float w = r < 16 ? rgw[k * 4 + (r & 3)] : r < 32 ? rew[k * 32 + 8 * ((r - 16) >> 2) + ((r - 16) & 3)] : rew[k * 32 + 8 * ((r - 32) >> 2) + 4 + ((r - 32) & 3)];
          const float v = g2[k] * w; const unsigned hb = f2bf(v); const float hf = __uint_as_float(hb << 16); RWH[i] = (bf16)hb; RWL[i] = (bf16)f2bf(v - hf); } }
}
DI void prep_expert_weights(Frame& F, int l) {
    LAS float* scr = (LAS float*)(F.lds + F.wave * 16384);
    const int gw = F.bid * 8 + F.wave, NGW = F.G * 8;
    const float* g2 = INP(F, 22) + l * 1024;
    bf16* W13 = (bf16*)(WSP(F) + WS_W13); bf16* W2 = (bf16*)(WSP(F) + WS_W2);
    constexpr int J13 = 64, N13 = NEXP * 2 * 4 * J13, J2 = 8 * 32, N2 = NEXP * J2;
    for (int it = gw; it < N13 + N2; it += NGW) {
        if (it < N13) { const int job = it / J13, item = it % J13, e = job >> 3, which = (job >> 2) & 1, grp = job & 3;
            const float* src = (which ? INP(F, 28) : INP(F, 27)) + ((size_t)(l * NEXP + e) * 1024) * 512 + grp * 128;
            transpose_item(src, 512, 128, W13 + ((size_t)e * 1024 + grp * 256 + which * 128) * 1024, 1024, g2, scr, item, F.lane);
        } else { const int r = it - N13, e = r / J2, item = r % J2;
            transpose_item(INP(F, 29) + (size_t)(l * NEXP + e) * 512 * 1024, 1024, 1024, W2 + (size_t)e * 1024 * 512, 512, nullptr, scr, item, F.lane); }
    }
}
DI void rms_rows_to_bf16(Frame& F, const float* x, bf16* xb) {
    const int gw = F.bid * 8 + F.wave, NGW = F.G * 8;
    for (int t = gw; t < T; t += NGW) {
        const f32x4* xr = (const f32x4*)(x + (size_t)t * DM) + F.lane; f32x4 v[4]; float s = 0.f;
#pragma unroll
        for (int j = 0; j < 4; ++j) { v[j] = xr[64 * j]; s += (v[j].x * v[j].x + v[j].y * v[j].y) + (v[j].z * v[j].z + v[j].w * v[j].w); }
        const float rs = rsqrtf(wave_sum(s) * (1.f / DM) + 1e-6f);
        u32x2* o = (u32x2*)(xb + (size_t)t * DM) + F.lane;
#pragma unroll
        for (int j = 0; j < 4; ++j) o[64 * j] = (u32x2){pk2(v[j].x * rs, v[j].y * rs), pk2(v[j].z * rs, v[j].w * rs)};
    }
}

DI void kmean_phase(Frame& F) {
    const bf16* K = (const bf16*)(WSP(F) + WS_K); float* kmean = (float*)(WSP(F) + WS_KMEAN);
    LAS float* red = (LAS float*)F.lds;
    for (int it = F.bid; it < BATCH * 8 * 64; it += F.G) {
        const int b = it >> 9, h = (it >> 6) & 7, n = it & 63, c8 = F.tid & 7, rg = F.tid >> 3;
        const bf16* kp = K + ((size_t)b * SEQ + n * 256 + rg * 4) * 512 + h * 64 + c8 * 8; float s[8] = {0.f, 0.f, 0.f, 0.f, 0.f, 0.f, 0.f, 0.f};
        u32x4 w[4];
#pragma unroll
        for (int i = 0; i < 4; ++i) w[i] = *(const u32x4*)(kp + (size_t)i * 512);
#pragma unroll
        for (int i = 0; i < 4; ++i) { s[0] += blo(w[i].x); s[1] += bhi(w[i].x); s[2] += blo(w[i].y); s[3] += bhi(w[i].y); s[4] += blo(w[i].z); s[5] += bhi(w[i].z); s[6] += blo(w[i].w); s[7] += bhi(w[i].w); }
#pragma unroll
        for (int e = 0; e < 8; ++e) { float v = s[e]; v += __shfl_xor(v, 8); v += __shfl_xor(v, 16); v += __shfl_xor(v, 32); s[e] = v; }
        if ((F.lane >> 3) == 0) { *(LAS f32x4*)(red + F.wave * 68 + c8 * 8) = (f32x4){s[0], s[1], s[2], s[3]}; *(LAS f32x4*)(red + F.wave * 68 + c8 * 8 + 4) = (f32x4){s[4], s[5], s[6], s[7]}; }
        __syncthreads();
        if (F.tid < 64) { float a = 0.f;
#pragma unroll
            for (int p = 0; p < 8; ++p) a += red[p * 68 + F.tid];
            kmean[(size_t)it * 64 + F.tid] = a * (1.f / 256.f); }
        __syncthreads();
    }
}
DI void vt_phase(Frame& F) {
    const bf16* V = (const bf16*)(WSP(F) + WS_V); bf16* VT = (bf16*)(WSP(F) + WS_VT);
    LAS bf16* tl = (LAS bf16*)(F.lds + 20480 + F.wave * 9216);
    const int gw = F.bid * 8 + F.wave, NGW = F.G * 8, lane = F.lane;
    for (int it = gw; it < BATCH * 8 * (SEQ / 64); it += NGW) {
        const int bh = it / (SEQ / 64), tt = it % (SEQ / 64), b = bh >> 3, h = bh & 7, t0 = tt * 64;
#pragma unroll
        for (int i = 0; i < 8; ++i) { const int r = i * 8 + (lane >> 3), c = lane & 7;
            const u32x4 w = *(const u32x4*)(V + ((size_t)b * SEQ + t0 + r) * 512 + h * 64 + c * 8); *(LAS u32x4*)(tl + r * 72 + c * 8) = w; }
        LDS_WAIT(); asm volatile("" ::: "memory");
#pragma unroll
        for (int i = 0; i < 8; ++i) { const int d = i * 8 + (lane >> 3), c = lane & 7; unsigned short e[8];
#pragma unroll
            for (int k = 0; k < 8; ++k) e[k] = tl[(8 * c + k) * 72 + d];
            u32x4 w; w.x = e[0] | ((unsigned)e[1] << 16); w.y = e[2] | ((unsigned)e[3] << 16); w.z = e[4] | ((unsigned)e[5] << 16); w.w = e[6] | ((unsigned)e[7] << 16);
            *(u32x4*)(VT + ((size_t)bh * 64 + d) * SEQ + t0 + c * 8) = w; }
        LDS_WAIT(); asm volatile("" ::: "memory");
    }
}
DI int list_off(int n) { return n * SEQ - 128 * n * (n + 1); }
DI void sel_ins(float gv, int gi, float& v0, float& v1, float& v2, int& i0, int& i1, int& i2) {
    const bool c0 = gv > v0 || (gv == v0 && gi < i0), c1 = gv > v1 || (gv == v1 && gi < i1), c2 = gv > v2 || (gv == v2 && gi < i2);
    v2 = c1 ? v1 : (c2 ? gv : v2); i2 = c1 ? i1 : (c2 ? gi : i2);
    v1 = c0 ? v0 : (c1 ? gv : v1); i1 = c0 ? i0 : (c1 ? gi : i1);
    v0 = c0 ? gv : v0; i0 = c0 ? gi : i0;
}
DI void sel_phase(Frame& F, int l) {
    const bf16* Q = (const bf16*)(WSP(F) + WS_Q); const float* kmean = (const float*)(WSP(F) + WS_KMEAN);
    unsigned short* list = (unsigned short*)(WSP(F) + WS_LIST); unsigned* lcnt = (unsigned*)(WSP(F) + WS_CTL) + CW_LCNT + 1024 * l;
    LAS unsigned char* kmh = F.lds; LAS unsigned char* kml = F.lds + 9216;
    for (int it = F.bid; it < BATCH * 8 * (SEQ / 512); it += F.G) {
        const int pr = it % 256, bh = pr >> 4, g = (it < 256) ? (pr & 15) : 31 - (pr & 15), b = bh >> 3, h = bh & 7;
        __syncthreads();
        { const int n = F.tid >> 3, c8 = (F.tid & 7) * 8; const f32x4 a = *(const f32x4*)(kmean + (size_t)bh * 4096 + n * 64 + c8), c = *(const f32x4*)(kmean + (size_t)bh * 4096 + n * 64 + c8 + 4);
          const float f[8] = {a.x, a.y, a.z, a.w, c.x, c.y, c.z, c.w}; unsigned hw[4], lw[4];
#pragma unroll
          for (int e = 0; e < 4; ++e) { hw[e] = pk2(f[2 * e], f[2 * e + 1]); lw[e] = pk2(f[2 * e] - blo(hw[e]), f[2 * e + 1] - bhi(hw[e])); }
          *(LAS u32x4*)(kmh + n * 144 + c8 * 2) = (u32x4){hw[0], hw[1], hw[2], hw[3]}; *(LAS u32x4*)(kml + n * 144 + c8 * 2) = (u32x4){lw[0], lw[1], lw[2], lw[3]}; }
        __syncthreads();
        const int lane = F.lane, li = lane & 15, quad = lane >> 4;
        const int tl = g * 512 + F.tid, own = __builtin_amdgcn_readfirstlane(tl >> 8), ntl = (own + 15) >> 4;
        float v0 = -INFINITY, v1 = -INFINITY, v2 = -INFINITY; int i0 = -1, i1 = -1, i2 = -1;
#pragma unroll
        for (int qt = 0; qt < 4; ++qt) {
            const bf16* qp = Q + ((size_t)b * SEQ + g * 512 + F.wave * 64 + qt * 16 + li) * 512 + h * 64 + quad * 8;
            const bf16x8_t q0 = *(const bf16x8_t*)qp, q1 = *(const bf16x8_t*)(qp + 32);
            float a0 = -INFINITY, a1 = -INFINITY, a2 = -INFINITY; int j0 = -1, j1 = -1, j2 = -1;
#pragma unroll
            for (int nt = 0; nt < 4; ++nt) { if (nt < ntl) { f32x4 acc = {0.f, 0.f, 0.f, 0.f};
                const LAS unsigned char* hp = kmh + (16 * nt + li) * 144 + quad * 16; const LAS unsigned char* lp = kml + (16 * nt + li) * 144 + quad * 16;
                acc = __builtin_amdgcn_mfma_f32_16x16x32_bf16(*(const LAS bf16x8_t*)hp, q0, acc, 0, 0, 0); acc = __builtin_amdgcn_mfma_f32_16x16x32_bf16(*(const LAS bf16x8_t*)(hp + 64), q1, acc, 0, 0, 0);
                acc = __builtin_amdgcn_mfma_f32_16x16x32_bf16(*(const LAS bf16x8_t*)lp, q0, acc, 0, 0, 0); acc = __builtin_amdgcn_mfma_f32_16x16x32_bf16(*(const LAS bf16x8_t*)(lp + 64), q1, acc, 0, 0, 0);
#pragma unroll
                for (int e = 0; e < 4; ++e) { const int n = 16 * nt + 4 * quad + e; if (n < own) sel_ins(acc[e], n, a0, a1, a2, j0, j1, j2); } } }
#pragma unroll
            for (int o = 16; o <= 32; o <<= 1) { const float p0 = __shfl_xor(a0, o), p1 = __shfl_xor(a1, o), p2 = __shfl_xor(a2, o); const int k0 = __shfl_xor(j0, o), k1 = __shfl_xor(j1, o), k2 = __shfl_xor(j2, o);
                if (k0 >= 0) sel_ins(p0, k0, a0, a1, a2, j0, j1, j2); if (k1 >= 0) sel_ins(p1, k1, a0, a1, a2, j0, j1, j2); if (k2 >= 0) sel_ins(p2, k2, a0, a1, a2, j0, j1, j2); }
            if (quad == qt) { v0 = a0; v1 = a1; v2 = a2; i0 = j0; i1 = j1; i2 = j2; }
        }
        (void)v0; (void)v1; (void)v2;
        LAS unsigned* lc = (LAS unsigned*)(F.lds + MISC_OFF + 8192); LAS unsigned* lbase = lc + 64;
        if (F.tid < 64) lc[F.tid] = 0u;
        __syncthreads();
        unsigned r0 = 0u, r1 = 0u, r2 = 0u;
        if (i0 >= 0) r0 = atomicAdd((unsigned*)(lc + i0), 1u);
        if (i1 >= 0) r1 = atomicAdd((unsigned*)(lc + i1), 1u);
        if (i2 >= 0) r2 = atomicAdd((unsigned*)(lc + i2), 1u);
        __syncthreads();
        if (F.tid < 64) { const unsigned c = lc[F.tid]; lbase[F.tid] = c ? atomicAdd(lcnt + bh * 64 + F.tid, c) : 0u; }
        __syncthreads();
        unsigned short* lb = list + (size_t)bh * LSTRIDE;
        if (i0 >= 0) lb[list_off(i0) + lbase[i0] + r0] = (unsigned short)(tl | (0 << 14));
        if (i1 >= 0) lb[list_off(i1) + lbase[i1] + r1] = (unsigned short)(tl | (1 << 14));
        if (i2 >= 0) lb[list_off(i2) + lbase[i2] + r2] = (unsigned short)(tl | (2 << 14));
    }
    __syncthreads();
}
DI void att_phase(Frame& F, int l) {
    const bf16* Q = (const bf16*)(WSP(F) + WS_Q); const bf16* K = (const bf16*)(WSP(F) + WS_K); const bf16* VT = (const bf16*)(WSP(F) + WS_VT);
    const unsigned short* list = (const unsigned short*)(WSP(F) + WS_LIST); const unsigned* lcnt = (const unsigned*)(WSP(F) + WS_CTL) + CW_LCNT + 1024 * l;
    bf16* PO = (bf16*)(WSP(F) + WS_PARTO); float* PML = (float*)(WSP(F) + WS_PARTML);
    LAS unsigned char* Kl = F.lds;
    LAS unsigned char* Vl = F.lds + 36864;
    LAS int* pre = (LAS int*)(F.lds + MISC_OFF + 8192);
    LAS int* cl = (LAS int*)(F.lds + MISC_OFF + 12288); LAS int* ws8 = (LAS int*)(F.lds + MISC_OFF + 4352);
    const int lane = F.lane, wave = F.wave, qi = lane & 15, quad = lane >> 4;
    __syncthreads();
    { const int c0 = (int)__hip_atomic_load(lcnt + 2 * F.tid, __ATOMIC_RELAXED, __HIP_MEMORY_SCOPE_AGENT), c1 = (int)__hip_atomic_load(lcnt + 2 * F.tid + 1, __ATOMIC_RELAXED, __HIP_MEMORY_SCOPE_AGENT);
      cl[2 * F.tid] = c0; cl[2 * F.tid + 1] = c1; const int t0 = (c0 + 127) >> 7, t1 = (c1 + 127) >> 7; int inc = t0 + t1;
#pragma unroll
      for (int o = 1; o < 64; o <<= 1) { const int u = __shfl_up(inc, o); if (lane >= o) inc += u; }
      if (lane == 63) ws8[wave] = inc;
      __syncthreads();
      int off = 0;
#pragma unroll
      for (int w = 0; w < 8; ++w) { const int x = ws8[w]; if (w < wave) off += x; }
      const int ex = off + inc - (t0 + t1); pre[2 * F.tid] = ex; pre[2 * F.tid + 1] = ex + t0;
      __syncthreads();
      if (F.tid == 511) ws8[8] = off + inc; }
    __syncthreads();
    const int NL = __builtin_amdgcn_readfirstlane(ws8[8]), total = NL + BATCH * 8 * 64 * 2, per = (total + F.G - 1) / F.G;
    const int it0 = F.bid * per, it1 = (it0 + per < total) ? it0 + per : total;
    int cur = 0, loaded = -1;
    if (it0 < NL) { int lo = 0, hi = 1023;
        while (lo < hi) { const int mid = (lo + hi + 1) >> 1; if (pre[mid] <= it0) lo = mid; else hi = mid - 1; }
        cur = lo; }
    struct QA { int i, tile, own_item; bool valid; unsigned short ent; };
    struct QB { int i, own_item, tl, j; bool valid; bf16x8_t qf[2]; };
#define DEC_A(itx, R) do { int i_, tile_, own_; \
        if ((itx) < NL) { while (cur < 1023 && pre[cur + 1] <= (itx)) ++cur; i_ = cur; tile_ = (itx) - pre[cur]; own_ = 0; } \
        else { const int o_ = (itx) - NL; i_ = o_ >> 1; tile_ = o_ & 1; own_ = 1; } \
        i_ = __builtin_amdgcn_readfirstlane(i_); tile_ = __builtin_amdgcn_readfirstlane(tile_); \
        R.i = i_; R.tile = tile_; R.own_item = own_; R.ent = 0; R.valid = true; \
        if (!own_) { const int e_ = tile_ * 128 + wave * 16 + qi; R.valid = e_ < cl[i_]; if (R.valid) R.ent = list[(size_t)(i_ >> 6) * LSTRIDE + list_off(i_ & 63) + e_]; } } while (0)
#define DEC_B(A, R) do { const int bh_ = A.i >> 6, n_ = A.i & 63; R.i = A.i; R.own_item = A.own_item; R.valid = A.valid; \
        if (A.own_item) { R.tl = n_ * 256 + A.tile * 128 + wave * 16 + qi; R.j = 3; } else { R.tl = A.ent & 0x3fff; R.j = A.ent >> 14; } \
        { const size_t t_ = (size_t)(bh_ >> 3) * SEQ + R.tl; \
          R.qf[0] = *(const bf16x8_t*)(Q + t_ * 512 + (bh_ & 7) * 64 + quad * 8); R.qf[1] = *(const bf16x8_t*)(Q + t_ * 512 + (bh_ & 7) * 64 + 32 + quad * 8); } } while (0)
    QA na; na.i = 0; na.tile = 0; na.own_item = 1; na.valid = false; na.ent = 0;
    QB nx; nx.i = -1; nx.own_item = 0; nx.tl = 0; nx.j = 0; nx.valid = false; nx.qf[0] = (bf16x8_t){0, 0, 0, 0, 0, 0, 0, 0}; nx.qf[1] = nx.qf[0];
    if (it0 < it1) { DEC_A(it0, na); DEC_B(na, nx); if (it0 + 1 < it1) DEC_A(it0 + 1, na); }
    for (int it = it0; it < it1; ++it) {
        const int i = nx.i, own_item = nx.own_item, tl = nx.tl, j = nx.j; const bool valid = nx.valid; bf16x8_t qf[2] = {nx.qf[0], nx.qf[1]};
        const int bh = i >> 6, n = i & 63, b = bh >> 3, h = bh & 7;
        if (i != loaded) {
            __syncthreads();
#pragma unroll
            for (int r = 0; r < 4; ++r) { const int c = F.tid + r * 512, row = c >> 3, ch = c & 7;
                const u32x4 w = *(const u32x4*)(K + ((size_t)b * SEQ + n * 256 + row) * 512 + h * 64 + ch * 8); *(LAS u32x4*)(Kl + row * 144 + ch * 16) = w; }
#pragma unroll
            for (int r = 0; r < 4; ++r) { const int c = F.tid + r * 512, row = c >> 5, ch = c & 31;
                const u32x4 w = *(const u32x4*)(VT + ((size_t)bh * 64 + row) * SEQ + n * 256 + ch * 8); *(LAS u32x4*)(Vl + row * 528 + ch * 16) = w; }
            __syncthreads();
            loaded = i;
        }
        if (it + 1 < it1) { DEC_B(na, nx); if (it + 2 < it1) DEC_A(it + 2, na); }
        const size_t t = (size_t)b * SEQ + tl;
        const float slope2 = __builtin_amdgcn_exp2f(-(float)(h + 1)) * LOG2E;
        const bool half_only = own_item && (__builtin_amdgcn_readfirstlane(tl - n * 256) < 128);
        const int tloc = tl - n * 256;
        const float sbase = slope2 * (float)(quad * 4); const int tq4 = tloc - quad * 4;
        f32x4 sc[16];
#pragma unroll
        for (int kt = 0; kt < 16; ++kt) {
            if (kt >= 8 && half_only) { sc[kt] = (f32x4){-INFINITY, -INFINITY, -INFINITY, -INFINITY}; continue; }
            f32x4 a = {fmaf(slope2, (float)(kt * 16), sbase), fmaf(slope2, (float)(kt * 16 + 1), sbase), fmaf(slope2, (float)(kt * 16 + 2), sbase), fmaf(slope2, (float)(kt * 16 + 3), sbase)};
#pragma unroll
            for (int ks = 0; ks < 2; ++ks) { const bf16x8_t kf = *(const LAS bf16x8_t*)(Kl + (kt * 16 + qi) * 144 + ks * 64 + quad * 16); a = __builtin_amdgcn_mfma_f32_16x16x32_bf16(kf, qf[ks], a, 0, 0, 0); }
            sc[kt] = a; if ((kt & 3) == 3) asm volatile("" ::: "memory"); }
        if (own_item) {
#pragma unroll
            for (int kt = 0; kt < 16; ++kt)
#pragma unroll
                for (int e = 0; e < 4; ++e) if ((kt * 16 + e) > tq4) sc[kt][e] = -INFINITY; }
        float mx = -INFINITY;
#pragma unroll
        for (int kt = 0; kt < 16; ++kt)
#pragma unroll
            for (int e = 0; e < 4; ++e) mx = fmaxf(mx, sc[kt][e]);
        mx = fmaxf(mx, __shfl_xor(mx, 16)); mx = fmaxf(mx, __shfl_xor(mx, 32));
        float ls = 0.f;
#pragma unroll
        for (int kt = 0; kt < 16; ++kt)
#pragma unroll
            for (int e = 0; e < 4; ++e) { const float p = __builtin_amdgcn_exp2f(sc[kt][e] - mx); sc[kt][e] = p; ls += p; }
        ls += __shfl_xor(ls, 16); ls += __shfl_xor(ls, 32);
        f32x4 o[4];
#pragma unroll
        for (int dt = 0; dt < 4; ++dt) o[dt] = (f32x4){0.f, 0.f, 0.f, 0.f};
#pragma unroll
        for (int k2 = 0; k2 < 8; ++k2) {
            if (k2 >= 4 && half_only) break;
            u32x4 pw; pw.x = pg8::cvt_pk_bf16(sc[2 * k2][0], sc[2 * k2][1]); pw.y = pg8::cvt_pk_bf16(sc[2 * k2][2], sc[2 * k2][3]);
            pw.z = pg8::cvt_pk_bf16(sc[2 * k2 + 1][0], sc[2 * k2 + 1][1]); pw.w = pg8::cvt_pk_bf16(sc[2 * k2 + 1][2], sc[2 * k2 + 1][3]);
            const bf16x8_t pf = __builtin_bit_cast(bf16x8_t, pw);
#pragma unroll
            for (int dt = 0; dt < 4; ++dt) { const LAS unsigned char* vp = Vl + (dt * 16 + qi) * 528 + (k2 * 32 + quad * 4) * 2;
                const u32x2 lo = *(const LAS u32x2*)vp, hi = *(const LAS u32x2*)(vp + 32);
                const u32x4 vw = {lo.x, lo.y, hi.x, hi.y};
                o[dt] = __builtin_amdgcn_mfma_f32_16x16x32_bf16(__builtin_bit_cast(bf16x8_t, vw), pf, o[dt], 0, 0, 0); }
            if (k2 & 1) asm volatile("" ::: "memory"); }
        if (valid) { const float inv = frcp_(ls); const size_t pidx = (t * 8 + h) * 4 + j; bf16* op = PO + pidx * 64 + quad * 4;
#pragma unroll
            for (int dt = 0; dt < 4; ++dt) *(u32x2*)(op + dt * 16) = (u32x2){pg8::cvt_pk_bf16(o[dt][0] * inv, o[dt][1] * inv), pg8::cvt_pk_bf16(o[dt][2] * inv, o[dt][3] * inv)};
            if (quad == 0) ((float2*)PML)[pidx] = make_float2(mx - slope2 * (float)tloc, ls); }
    }
#undef DEC_A
#undef DEC_B
    __syncthreads();
}
DI void comb_phase(Frame& F) {
    const bf16* PO = (const bf16*)(WSP(F) + WS_PARTO); const float* PML = (const float*)(WSP(F) + WS_PARTML); bf16* Y = (bf16*)(WSP(F) + WS_YATTN);
    const int gw = F.bid * 8 + F.wave, NGW = F.G * 8, lane = F.lane, h = lane >> 3, dc = lane & 7;
    for (int t = gw; t < T; t += NGW) {
        const int own = (t % SEQ) >> 8, nsel = own < 3 ? own : 3; const size_t pb = ((size_t)t * 8 + h) * 4;
        float m[4], lw[4]; float M = -INFINITY;
#pragma unroll
        for (int j = 0; j < 4; ++j) { const bool ok = (j == 3) || (j < nsel); const float2 ml = ok ? ((const float2*)PML)[pb + j] : make_float2(-INFINITY, 0.f); m[j] = ml.x; lw[j] = ml.y; M = fmaxf(M, ml.x); }
        float acc[8] = {0.f, 0.f, 0.f, 0.f, 0.f, 0.f, 0.f, 0.f}; float wsum = 0.f;
#pragma unroll
        for (int j = 0; j < 4; ++j) { const bool ok = (j == 3) || (j < nsel); if (!ok) continue;
            const float w = __builtin_amdgcn_exp2f(m[j] - M) * lw[j]; wsum += w; const u32x4 ow = *(const u32x4*)(PO + (pb + j) * 64 + dc * 8);
            acc[0] += w * blo(ow.x); acc[1] += w * bhi(ow.x); acc[2] += w * blo(ow.y); acc[3] += w * bhi(ow.y); acc[4] += w * blo(ow.z); acc[5] += w * bhi(ow.z); acc[6] += w * blo(ow.w); acc[7] += w * bhi(ow.w); }
        const float inv = frcp_(wsum);
        *(u32x4*)(Y + (size_t)t * 512 + h * 64 + dc * 8) = (u32x4){pk2(acc[0] * inv, acc[1] * inv), pk2(acc[2] * inv, acc[3] * inv), pk2(acc[4] * inv, acc[5] * inv), pk2(acc[6] * inv, acc[7] * inv)};
    }
}
DI void pool_phase(Frame& F, int l) {
    const bf16* Z = (const bf16*)(WSP(F) + WS_POOLZ); bf16* Y = (bf16*)(WSP(F) + WS_YPOOL); const bf16* WPT = (const bf16*)(WSP(F) + WS_WPT);
    LAS unsigned char* Pl = F.lds;
    const int lane = F.lane, li = lane & 15, quad = lane >> 4, g = F.wave >> 1, dt0 = (F.wave & 1) * 4;
    bf16x8_t wf[4][4];
#pragma unroll
    for (int dt = 0; dt < 4; ++dt)
#pragma unroll
        for (int ks = 0; ks < 4; ++ks) wf[dt][ks] = *(const bf16x8_t*)(WPT + ((size_t)g * 128 + 16 * (dt0 + dt) + li) * 128 + 32 * ks + 8 * quad);
    for (int tile = F.bid; tile < T / 64; tile += F.G) {
        __syncthreads();
#pragma unroll 1
        for (int i = F.tid; i < 64 * 64; i += 512) { const int tt = i >> 6, ch = i & 63, gg = ch >> 4, win = 2 << gg, t = tile * 64 + tt, tl = t % SEQ; const int cnt = (tl + 1 < win) ? tl + 1 : win;
            u32x4 w[16];
#pragma unroll
            for (int j = 0; j < 16; ++j) { w[j] = (u32x4){0u, 0u, 0u, 0u}; if (j < cnt) w[j] = *(const u32x4*)(Z + (size_t)(t - j) * 512 + ch * 8); }
            float s[8] = {0.f, 0.f, 0.f, 0.f, 0.f, 0.f, 0.f, 0.f};
#pragma unroll
            for (int j = 0; j < 16; ++j) { s[0] += blo(w[j].x); s[1] += bhi(w[j].x); s[2] += blo(w[j].y); s[3] += bhi(w[j].y); s[4] += blo(w[j].z); s[5] += bhi(w[j].z); s[6] += blo(w[j].w); s[7] += bhi(w[j].w); }
            const float inv = 1.0f / (float)cnt;
            *(LAS u32x4*)(Pl + tt * 1040 + ch * 16) = (u32x4){pk2(s[0] * inv - blo(w[0].x), s[1] * inv - bhi(w[0].x)), pk2(s[2] * inv - blo(w[0].y), s[3] * inv - bhi(w[0].y)),
                                                                 pk2(s[4] * inv - blo(w[0].z), s[5] * inv - bhi(w[0].z)), pk2(s[6] * inv - blo(w[0].w), s[7] * inv - bhi(w[0].w))}; }
        __syncthreads();
#pragma unroll
        for (int tt = 0; tt < 4; ++tt) {
            bf16x8_t pf[4];
#pragma unroll
            for (int ks = 0; ks < 4; ++ks) pf[ks] = *(const LAS bf16x8_t*)(Pl + (16 * tt + li) * 1040 + (g * 128 + 32 * ks + 8 * quad) * 2);
#pragma unroll
            for (int dt = 0; dt < 4; ++dt) { f32x4 acc = {0.f, 0.f, 0.f, 0.f};
#pragma unroll
                for (int ks = 0; ks < 4; ++ks) acc = __builtin_amdgcn_mfma_f32_16x16x32_bf16(wf[dt][ks], pf[ks], acc, 0, 0, 0);
                *(u32x2*)(Y + (size_t)(tile * 64 + 16 * tt + li) * 512 + g * 128 + 16 * (dt0 + dt) + 4 * quad) = (u32x2){pk2(acc[0], acc[1]), pk2(acc[2], acc[3])}; } }
    }
    __syncthreads();
}
DI void rwkv_prep_phase(Frame& F, int l) {
    const bf16* RZ = (const bf16*)(WSP(F) + WS_RWKVZ); bf16* VF = (bf16*)(WSP(F) + WS_VFIRST);
    bf16* AR = (bf16*)(WSP(F) + WS_AR); const size_t AS = (size_t)T * 512;
    float* bonus = (float*)(WSP(F) + WS_BONUS); float* kinv = (float*)(WSP(F) + WS_KINV); const bf16* WLT = (const bf16*)(WSP(F) + WS_WLT);
    LAS unsigned char* Al = F.lds;
    const int h = F.wave;
    const float* mu = INP(F, 4) + l * 1792; const float* vmu = INP(F, 5) + (l > 0 ? (l - 1) * 32 : 0);
    const float* w0p = INP(F, 6) + l * 512 + h * 64; const float* a0p = INP(F, 8) + l * 512 + h * 64; const float* kkp = INP(F, 11) + l * 512 + h * 64;
    const float* kap = INP(F, 12) + l * 512 + h * 64; const float* rkp = INP(F, 13) + l * 512 + h * 64; const float* v0p = INP(F, 16) + (l > 0 ? l - 1 : 0) * 512 + h * 64;
    for (int item = F.bid; item < T / 64; item += F.G) {
        int tid = F.tid; asm volatile("" : "+v"(tid));
        const int lane = tid & 63, li = lane & 15, quad = lane >> 4;
        const int t0 = item * 64, tl0 = t0 % SEQ;
        __syncthreads();
        { const int tok = tid >> 3, c0 = tid & 7; const size_t t = (size_t)(t0 + tok); const bool first = (tl0 + tok == 0);
          u32x4 zc[5], zp[5]; f32x4 m0[5], m1[5];
#pragma unroll
          for (int r = 0; r < 5; ++r) { const int c = c0 + 8 * r; zc[r] = (u32x4){0u, 0u, 0u, 0u}; zp[r] = zc[r]; m0[r] = (f32x4){0.f, 0.f, 0.f, 0.f}; m1[r] = m0[r];
              if (c < 32 || (l > 0 && c < 36)) { const int col = 1536 + 8 * c; zc[r] = *(const u32x4*)(RZ + t * RZP + col); if (!first) zp[r] = *(const u32x4*)(RZ + (t - 1) * RZP + col);
                  const float* mp = col < 1792 ? mu + col : vmu + (col - 1792); m0[r] = *(const f32x4*)mp; m1[r] = *(const f32x4*)(mp + 4); } }
#pragma unroll
          for (int r = 0; r < 5; ++r) { const int c = c0 + 8 * r; if (c < 36) {
              const float cv[8] = {blo(zc[r].x), bhi(zc[r].x), blo(zc[r].y), bhi(zc[r].y), blo(zc[r].z), bhi(zc[r].z), blo(zc[r].w), bhi(zc[r].w)}, pv[8] = {blo(zp[r].x), bhi(zp[r].x), blo(zp[r].y), bhi(zp[r].y), blo(zp[r].z), bhi(zp[r].z), blo(zp[r].w), bhi(zp[r].w)};
              const float mm[8] = {m0[r].x, m0[r].y, m0[r].z, m0[r].w, m1[r].x, m1[r].y, m1[r].z, m1[r].w}; float f[8];
#pragma unroll
              for (int e = 0; e < 8; ++e) { const float zs = cv[e] + (pv[e] - cv[e]) * mm[e]; f[e] = r == 0 ? tanhf(zs) : (r == 2 || r == 3) ? sigmoidf_(zs) : zs; }
              *(LAS u32x4*)(Al + tok * 592 + c * 16) = (u32x4){pk2(f[0], f[1]), pk2(f[2], f[3]), pk2(f[4], f[5]), pk2(f[6], f[7])}; } } }
        __syncthreads();
        float ssq[4] = {0.f, 0.f, 0.f, 0.f}, bsm[4] = {0.f, 0.f, 0.f, 0.f};
#pragma unroll 1
        for (int ct = 0; ct < 4; ++ct) {
            const int cb = 16 * ct + 4 * quad;
            bf16x8_t wf[9];
#pragma unroll
            for (int ks = 0; ks < 9; ++ks) wf[ks] = *(const bf16x8_t*)(WLT + (size_t)(h * 64 + 16 * ct + li) * 288 + 32 * ks + 8 * quad);
            const f32x4 mr = *(const f32x4*)(mu + h * 64 + cb), mk = *(const f32x4*)(mu + 512 + h * 64 + cb), mv = *(const f32x4*)(mu + 1024 + h * 64 + cb);
            const f32x4 w0 = *(const f32x4*)(w0p + cb), a0 = *(const f32x4*)(a0p + cb), kkc = *(const f32x4*)(kkp + cb), kac = *(const f32x4*)(kap + cb), rkc = *(const f32x4*)(rkp + cb);
            f32x4 v0 = {0.f, 0.f, 0.f, 0.f}; if (l > 0) v0 = *(const f32x4*)(v0p + cb);
            u32x2 zr[4][2], zk[4][2], zv[4][2], vfw[4];
#pragma unroll
            for (int rt = 0; rt < 4; ++rt) { const int tok = 16 * rt + li; const size_t zi = (size_t)(t0 + tok) * RZP + h * 64 + cb; const bool first = (tl0 + tok == 0);
                zr[rt][0] = *(const u32x2*)(RZ + zi); zk[rt][0] = *(const u32x2*)(RZ + zi + 512); zv[rt][0] = *(const u32x2*)(RZ + zi + 1024);
                zr[rt][1] = (u32x2){0u, 0u}; zk[rt][1] = zr[rt][1]; zv[rt][1] = zr[rt][1]; vfw[rt] = zr[rt][1];
                if (!first) { zr[rt][1] = *(const u32x2*)(RZ + zi - RZP); zk[rt][1] = *(const u32x2*)(RZ + zi - RZP + 512); zv[rt][1] = *(const u32x2*)(RZ + zi - RZP + 1024); }
                if (l > 0) vfw[rt] = *(const u32x2*)(VF + (size_t)(t0 + tok) * 512 + h * 64 + cb); }
#pragma unroll
            for (int rt = 0; rt < 4; ++rt) { const int tok = 16 * rt + li; const size_t idx = (size_t)(t0 + tok) * 512 + h * 64 + cb;
                f32x4 aw = {0.f, 0.f, 0.f, 0.f}, aa = aw, ag = aw, av = aw;
#pragma unroll
                for (int ks = 0; ks < 9; ++ks) { if (ks == 8 && l == 0) break;
                    const bf16x8_t bfr = *(const LAS bf16x8_t*)(Al + tok * 592 + ks * 64 + quad * 16);
                    if (ks < 2) aw = __builtin_amdgcn_mfma_f32_16x16x32_bf16(wf[ks], bfr, aw, 0, 0, 0);
                    else if (ks < 4) aa = __builtin_amdgcn_mfma_f32_16x16x32_bf16(wf[ks], bfr, aa, 0, 0, 0);
                    else if (ks < 8) ag = __builtin_amdgcn_mfma_f32_16x16x32_bf16(wf[ks], bfr, ag, 0, 0, 0);
                    else av = __builtin_amdgcn_mfma_f32_16x16x32_bf16(wf[ks], bfr, av, 0, 0, 0); }
                const float crf[4] = {blo(zr[rt][0].x), bhi(zr[rt][0].x), blo(zr[rt][0].y), bhi(zr[rt][0].y)}, prf[4] = {blo(zr[rt][1].x), bhi(zr[rt][1].x), blo(zr[rt][1].y), bhi(zr[rt][1].y)};
                const float ckf[4] = {blo(zk[rt][0].x), bhi(zk[rt][0].x), blo(zk[rt][0].y), bhi(zk[rt][0].y)}, pkf[4] = {blo(zk[rt][1].x), bhi(zk[rt][1].x), blo(zk[rt][1].y), bhi(zk[rt][1].y)};
                const float cvf[4] = {blo(zv[rt][0].x), bhi(zv[rt][0].x), blo(zv[rt][0].y), bhi(zv[rt][0].y)}, pvf[4] = {blo(zv[rt][1].x), bhi(zv[rt][1].x), blo(zv[rt][1].y), bhi(zv[rt][1].y)};
                const float vff[4] = {blo(vfw[rt].x), bhi(vfw[rt].x), blo(vfw[rt].y), bhi(vfw[rt].y)};
                float ro[4], lwo[4], kpo[4], vo[4], kro[4], bbo[4];
#pragma unroll
                for (int e = 0; e < 4; ++e) { const float r = crf[e] + (prf[e] - crf[e]) * mr[e], k = ckf[e] + (pkf[e] - ckf[e]) * mk[e]; float v = cvf[e] + (pvf[e] - cvf[e]) * mv[e];
                    const float xw = -(w0[e] + aw[e]); const float sp = xw > 20.f ? xw : log1pf(__expf(xw)); lwo[e] = -__expf(-sp - 0.5f);
                    const float asig = sigmoidf_(a0[e] + aa[e]);
                    if (l > 0) v = v + (vff[e] - v) * sigmoidf_(v0[e] + av[e]);
                    vo[e] = v; ro[e] = r; const float kr = k * kkc[e]; kro[e] = kr; bbo[e] = kr * asig; ssq[rt] += kr * kr;
                    const float kpe = k * (1.0f + (asig - 1.0f) * kac[e]); kpo[e] = kpe; bsm[rt] += r * kpe * rkc[e]; }
                if (l == 0) *(u32x2*)(VF + idx) = (u32x2){pk2(vo[0], vo[1]), pk2(vo[2], vo[3])};
                *(u32x2*)(AR + idx) = (u32x2){pk2(ro[0], ro[1]), pk2(ro[2], ro[3])};
                *(u32x2*)(AR + AS + idx) = (u32x2){pk2(lwo[0], lwo[1]), pk2(lwo[2], lwo[3])};
                *(u32x2*)(AR + 2 * AS + idx) = (u32x2){pk2(kpo[0], kpo[1]), pk2(kpo[2], kpo[3])};
                *(u32x2*)(AR + 3 * AS + idx) = (u32x2){pk2(vo[0], vo[1]), pk2(vo[2], vo[3])};
                *(u32x2*)(AR + 4 * AS + idx) = (u32x2){pk2(kro[0], kro[1]), pk2(kro[2], kro[3])};
                *(u32x2*)(AR + 5 * AS + idx) = (u32x2){pk2(bbo[0], bbo[1]), pk2(bbo[2], bbo[3])};
                *(u32x2*)(AR + 6 * AS + idx) = (u32x2){pk2(ag[0], ag[1]), pk2(ag[2], ag[3])}; asm volatile("" ::: "memory"); }
        }
#pragma unroll
        for (int rt = 0; rt < 4; ++rt) { float ss = ssq[rt], bs = bsm[rt]; ss += __shfl_xor(ss, 16); ss += __shfl_xor(ss, 32); bs += __shfl_xor(bs, 16); bs += __shfl_xor(bs, 32);
            if (quad == 0) { const size_t t = (size_t)(t0 + 16 * rt + li); bonus[t * 8 + h] = bs; kinv[t * 8 + h] = 1.0f / fmaxf(sqrtf(ss), 1e-12f); } }
    }
    __syncthreads();
}
typedef short bf16x4_t __attribute__((ext_vector_type(4)));
DI void rwkv_chunk_phase(Frame& F, int l) {
    const bf16* RZ = (const bf16*)(WSP(F) + WS_RWKVZ); bf16* VF = (bf16*)(WSP(F) + WS_VFIRST);
    bf16* AR = (bf16*)(WSP(F) + WS_AR); const size_t AS = (size_t)T * 512; float* bonus = (float*)(WSP(F) + WS_BONUS); const bf16* WLT = (const bf16*)(WSP(F) + WS_WLT);
    bf16* PCT = (bf16*)(WSP(F) + WS_PCT); bf16* LC = (bf16*)(WSP(F) + WS_LC); bf16* RM = (bf16*)(WSP(F) + WS_RM); bf16* Y0 = (bf16*)(WSP(F) + WS_Y0);
    const float* mu = INP(F, 4) + l * 1792; const float* vmu = INP(F, 5) + (l > 0 ? (l - 1) * 32 : 0);
    constexpr int ST = 144;
    LAS unsigned char* L = F.lds;
    LAS unsigned char* AT = L; LAS unsigned char* BT = L + 9216; LAS unsigned char* KT = L + 18432; LAS unsigned char* RT = L + 27648;
    LAS unsigned char* BTT = L + 36864; LAS unsigned char* KTT = L + 46080; LAS unsigned char* VTl = L + 55296; LAS unsigned char* NB = L + 64512; LAS unsigned char* MB = L + 73728;
    LAS unsigned char* WMT = L + 82944; LAS unsigned char* UMT = L + 92160;
    LAS unsigned char* Al = L + 64512;
    LAS unsigned char* SR = L + 64512; LAS unsigned char* SKP = L + 72704; LAS unsigned char* SKR = L + 80896; LAS unsigned char* SBB = L + 89088;
    LAS float* LGF = (LAS float*)(L + 101376); LAS float* ND = (LAS float*)(L + 117760); LAS unsigned char* DB = L + 122112; LAS float* GC = (LAS float*)(L + 125184); LAS float* PART = (LAS float*)(L + 125440);
    LAS float* SSP = (LAS float*)(L + 127488); LAS float* BSP = SSP + 256;
    const int wave = F.wave;
#define MF32(a, b, c) __builtin_amdgcn_mfma_f32_16x16x32_bf16((a), (b), (c), 0, 0, 0)
#define MF16(a, b, c) __builtin_amdgcn_mfma_f32_16x16x16bf16_1k((a), (b), (c), 0, 0, 0)
#define RD8(p) (*(const LAS bf16x8_t*)(p))
#define RD4(p) (*(const LAS bf16x4_t*)(p))
    u32x4 zcn[5], zpn[5], areg[5];
#define F1LOAD(ckx) do { const int b_ = (ckx) >> 8, ck_ = (ckx) & 255; const size_t t_ = (size_t)b_ * SEQ + ck_ * 64 + (F.tid >> 3); const bool first_ = (ck_ * 64 + (F.tid >> 3) == 0); \
        _Pragma("unroll") for (int r_ = 0; r_ < 5; ++r_) { const int c_ = (F.tid & 7) + 8 * r_; zcn[r_] = (u32x4){0u, 0u, 0u, 0u}; zpn[r_] = zcn[r_]; \
            if (c_ < 32 || (l > 0 && c_ < 36)) { const int col_ = 1536 + 8 * c_; zcn[r_] = *(const u32x4*)(RZ + t_ * RZP + col_); if (!first_) zpn[r_] = *(const u32x4*)(RZ + (t_ - 1) * RZP + col_); } } } while (0)
    if (F.bid < BATCH * (SEQ / 64)) F1LOAD(F.bid);
    for (int cki = F.bid; cki < BATCH * (SEQ / 64); cki += F.G) {
      {
          const int c0 = F.tid & 7; f32x4 m0[5], m1[5];
#pragma unroll
          for (int r = 0; r < 5; ++r) { const int c = c0 + 8 * r; m0[r] = (f32x4){0.f, 0.f, 0.f, 0.f}; m1[r] = m0[r];
              if (c < 32 || (l > 0 && c < 36)) { const int col = 1536 + 8 * c; const float* mp = col < 1792 ? mu + col : vmu + (col - 1792); m0[r] = *(const f32x4*)mp; m1[r] = *(const f32x4*)(mp + 4); } }
#pragma unroll
          for (int r = 0; r < 5; ++r) {
              const float cv[8] = {blo(zcn[r].x), bhi(zcn[r].x), blo(zcn[r].y), bhi(zcn[r].y), blo(zcn[r].z), bhi(zcn[r].z), blo(zcn[r].w), bhi(zcn[r].w)}, pv[8] = {blo(zpn[r].x), bhi(zpn[r].x), blo(zpn[r].y), bhi(zpn[r].y), blo(zpn[r].z), bhi(zpn[r].z), blo(zpn[r].w), bhi(zpn[r].w)};
              const float mm[8] = {m0[r].x, m0[r].y, m0[r].z, m0[r].w, m1[r].x, m1[r].y, m1[r].z, m1[r].w}; float f[8];
#pragma unroll
              for (int e = 0; e < 8; ++e) { const float zs = cv[e] + (pv[e] - cv[e]) * mm[e]; f[e] = r == 0 ? ftanh_(zs) : (r == 2 || r == 3) ? sigmoidf_(zs) : zs; }
              areg[r] = (u32x4){pk2(f[0], f[1]), pk2(f[2], f[3]), pk2(f[4], f[5]), pk2(f[6], f[7])}; } }
#pragma unroll 1
      for (int h = 0; h < 8; ++h) {
        int tid = F.tid; asm volatile("" : "+v"(tid));
        const int lane = tid & 63, li = lane & 15, quad = lane >> 4;
        const int b = cki >> 8, ck = cki & 255, bh = b * 8 + h, it = bh * 256 + ck;
        const size_t tbase = (size_t)b * SEQ + ck * 64; const int tl0 = ck * 64;
        __syncthreads();
        { const int tok = tid >> 3, c0 = tid & 7;
#pragma unroll
          for (int r = 0; r < 5; ++r) { const int c = c0 + 8 * r; if (c < 36) *(LAS u32x4*)(Al + tok * 576 + c * 16) = areg[r]; } }
        __syncthreads();
        { const int ct = wave & 3, hw = wave >> 2, cb = 16 * ct + 4 * quad;
          bf16x8_t wf[9];
#pragma unroll
          for (int ks = 0; ks < 9; ++ks) wf[ks] = *(const bf16x8_t*)(WLT + (size_t)(h * 64 + 16 * ct + li) * 288 + 32 * ks + 8 * quad);
          const f32x4 mr = *(const f32x4*)(mu + h * 64 + cb), mk = *(const f32x4*)(mu + 512 + h * 64 + cb), mv = *(const f32x4*)(mu + 1024 + h * 64 + cb);
          const f32x4 w0 = *(const f32x4*)(INP(F, 6) + l * 512 + h * 64 + cb), a0 = *(const f32x4*)(INP(F, 8) + l * 512 + h * 64 + cb), kkc = *(const f32x4*)(INP(F, 11) + l * 512 + h * 64 + cb);
          const f32x4 kac = *(const f32x4*)(INP(F, 12) + l * 512 + h * 64 + cb), rkc = *(const f32x4*)(INP(F, 13) + l * 512 + h * 64 + cb);
          f32x4 v0 = {0.f, 0.f, 0.f, 0.f}; if (l > 0) v0 = *(const f32x4*)(INP(F, 16) + (l - 1) * 512 + h * 64 + cb);
          u32x2 zr[2][2], zk[2][2], zv[2][2], vfw[2]; f32x4 aw[2], aa[2], ag[2], av[2];
#pragma unroll
          for (int rr = 0; rr < 2; ++rr) { const int tok = 16 * (2 * hw + rr) + li; const size_t zi = (tbase + tok) * RZP + h * 64 + cb; const bool first = (tl0 + tok == 0);
              zr[rr][0] = *(const u32x2*)(RZ + zi); zk[rr][0] = *(const u32x2*)(RZ + zi + 512); zv[rr][0] = *(const u32x2*)(RZ + zi + 1024);
              zr[rr][1] = (u32x2){0u, 0u}; zk[rr][1] = zr[rr][1]; zv[rr][1] = zr[rr][1]; vfw[rr] = zr[rr][1];
              if (!first) { zr[rr][1] = *(const u32x2*)(RZ + zi - RZP); zk[rr][1] = *(const u32x2*)(RZ + zi - RZP + 512); zv[rr][1] = *(const u32x2*)(RZ + zi - RZP + 1024); }
              if (l > 0) vfw[rr] = *(const u32x2*)(VF + (tbase + tok) * 512 + h * 64 + cb); }
#pragma unroll
          for (int rr = 0; rr < 2; ++rr) { const int tok = 16 * (2 * hw + rr) + li; aw[rr] = (f32x4){0.f, 0.f, 0.f, 0.f}; aa[rr] = aw[rr]; ag[rr] = aw[rr]; av[rr] = aw[rr];
#pragma unroll
              for (int ks = 0; ks < 9; ++ks) { if (ks == 8 && l == 0) break;
                  const bf16x8_t bfr = RD8(Al + tok * 576 + ks * 64 + quad * 16);
                  if (ks < 2) aw[rr] = MF32(wf[ks], bfr, aw[rr]); else if (ks < 4) aa[rr] = MF32(wf[ks], bfr, aa[rr]); else if (ks < 8) ag[rr] = MF32(wf[ks], bfr, ag[rr]); else av[rr] = MF32(wf[ks], bfr, av[rr]); } }
          __syncthreads();
          if (h == 7 && cki + F.G < BATCH * (SEQ / 64)) F1LOAD(cki + F.G);
#pragma unroll
          for (int rr = 0; rr < 2; ++rr) { const int tok = 16 * (2 * hw + rr) + li; const size_t idx = (tbase + tok) * 512 + h * 64 + cb;
              const float crf[4] = {blo(zr[rr][0].x), bhi(zr[rr][0].x), blo(zr[rr][0].y), bhi(zr[rr][0].y)}, prf[4] = {blo(zr[rr][1].x), bhi(zr[rr][1].x), blo(zr[rr][1].y), bhi(zr[rr][1].y)};
              const float ckf[4] = {blo(zk[rr][0].x), bhi(zk[rr][0].x), blo(zk[rr][0].y), bhi(zk[rr][0].y)}, pkf[4] = {blo(zk[rr][1].x), bhi(zk[rr][1].x), blo(zk[rr][1].y), bhi(zk[rr][1].y)};
              const float cvf[4] = {blo(zv[rr][0].x), bhi(zv[rr][0].x), blo(zv[rr][0].y), bhi(zv[rr][0].y)}, pvf[4] = {blo(zv[rr][1].x), bhi(zv[rr][1].x), blo(zv[rr][1].y), bhi(zv[rr][1].y)};
              const float vff[4] = {blo(vfw[rr].x), bhi(vfw[rr].x), blo(vfw[rr].y), bhi(vfw[rr].y)};
              float ro[4], lwo[4], kpo[4], vo[4], kro[4], bbo[4]; float ss = 0.f, bs = 0.f;
#pragma unroll
              for (int e = 0; e < 4; ++e) { const float r = crf[e] + (prf[e] - crf[e]) * mr[e], k = ckf[e] + (pkf[e] - ckf[e]) * mk[e]; float v = cvf[e] + (pvf[e] - cvf[e]) * mv[e];
                  const float xw = -(w0[e] + aw[rr][e]); const float sp = fsoftplus_(xw); lwo[e] = -fexp_(-sp - 0.5f);
                  const float asig = sigmoidf_(a0[e] + aa[rr][e]);
                  if (l > 0) v = v + (vff[e] - v) * sigmoidf_(v0[e] + av[rr][e]);
                  vo[e] = v; ro[e] = r; const float kr = k * kkc[e]; kro[e] = kr; bbo[e] = kr * asig; ss += kr * kr;
                  const float kpe = k * (1.0f + (asig - 1.0f) * kac[e]); kpo[e] = kpe; bs += r * kpe * rkc[e]; }
              const u32x2 vpk = {pk2(vo[0], vo[1]), pk2(vo[2], vo[3])};
              if (l == 0) *(u32x2*)(VF + idx) = vpk;
              *(u32x2*)(AR + 3 * AS + idx) = vpk; *(u32x2*)(AR + 6 * AS + idx) = (u32x2){pk2(ag[rr][0], ag[rr][1]), pk2(ag[rr][2], ag[rr][3])};
              *(LAS f32x4*)(LGF + tok * 64 + cb) = (f32x4){__uint_as_float(f2bf(lwo[0]) << 16), __uint_as_float(f2bf(lwo[1]) << 16), __uint_as_float(f2bf(lwo[2]) << 16), __uint_as_float(f2bf(lwo[3]) << 16)};
              *(LAS u32x2*)(SR + tok * 128 + cb * 2) = (u32x2){pk2(ro[0], ro[1]), pk2(ro[2], ro[3])}; *(LAS u32x2*)(SKP + tok * 128 + cb * 2) = (u32x2){pk2(kpo[0], kpo[1]), pk2(kpo[2], kpo[3])};
              *(LAS u32x2*)(SKR + tok * 128 + cb * 2) = (u32x2){pk2(kro[0], kro[1]), pk2(kro[2], kro[3])}; *(LAS u32x2*)(SBB + tok * 128 + cb * 2) = (u32x2){pk2(bbo[0], bbo[1]), pk2(bbo[2], bbo[3])};
#pragma unroll
              for (int e = 0; e < 4; ++e) *(LAS unsigned short*)(VTl + (cb + e) * ST + tok * 2) = (unsigned short)f2bf(vo[e]);
              ss += __shfl_xor(ss, 16); ss += __shfl_xor(ss, 32); bs += __shfl_xor(bs, 16); bs += __shfl_xor(bs, 32);
              if (quad == 0) { SSP[ct * 64 + tok] = ss; BSP[ct * 64 + tok] = bs; } } }
        __syncthreads();
        const int et = tid >> 3, ec = (tid & 7) * 8;
        { const int c = tid & 63, p = tid >> 6; float x[8]; float run = 0.f;
#pragma unroll
          for (int i = 0; i < 8; ++i) x[i] = LGF[(8 * p + i) * 64 + c];
#pragma unroll
          for (int i = 0; i < 8; ++i) { run += x[i]; LGF[(8 * p + i) * 64 + c] = run; }
          PART[p * 64 + c] = run; }
        __syncthreads();
        { float lg[8], lgp[8];
          { f32x4 o0 = {0.f, 0.f, 0.f, 0.f}, o1 = o0, q0 = o0, q1 = o0, tot0 = o0, tot1 = o0;
#pragma unroll
            for (int p = 0; p < 8; ++p) { const f32x4 a0 = *(const LAS f32x4*)(PART + p * 64 + ec), a1 = *(const LAS f32x4*)(PART + p * 64 + ec + 4); if (p < (et >> 3)) { o0 += a0; o1 += a1; } if (p < ((et - 1) >> 3)) { q0 += a0; q1 += a1; } tot0 += a0; tot1 += a1; }
            const f32x4 l0 = *(const LAS f32x4*)(LGF + et * 64 + ec) + o0, l1 = *(const LAS f32x4*)(LGF + et * 64 + ec + 4) + o1;
            f32x4 p0 = {0.f, 0.f, 0.f, 0.f}, p1 = p0; if (et > 0) { p0 = *(const LAS f32x4*)(LGF + (et - 1) * 64 + ec) + q0; p1 = *(const LAS f32x4*)(LGF + (et - 1) * 64 + ec + 4) + q1; }
            lg[0] = l0.x; lg[1] = l0.y; lg[2] = l0.z; lg[3] = l0.w; lg[4] = l1.x; lg[5] = l1.y; lg[6] = l1.z; lg[7] = l1.w;
            lgp[0] = p0.x; lgp[1] = p0.y; lgp[2] = p0.z; lgp[3] = p0.w; lgp[4] = p1.x; lgp[5] = p1.y; lgp[6] = p1.z; lgp[7] = p1.w;
            if (et == 63) { *(LAS f32x4*)(GC + ec) = (f32x4){fexp_(tot0.x), fexp_(tot0.y), fexp_(tot0.z), fexp_(tot0.w)}; *(LAS f32x4*)(GC + ec + 4) = (f32x4){fexp_(tot1.x), fexp_(tot1.y), fexp_(tot1.z), fexp_(tot1.w)}; } }
          const float ssum = (SSP[et] + SSP[64 + et]) + (SSP[128 + et] + SSP[192 + et]); const float kiv = __builtin_amdgcn_rsqf(fmaxf(ssum, 1e-24f));
          if (ec == 0) bonus[(tbase + et) * 8 + h] = (BSP[et] + BSP[64 + et]) + (BSP[128 + et] + BSP[192 + et]);
          const u32x4 wr = *(const LAS u32x4*)(SR + et * 128 + ec * 2), wk = *(const LAS u32x4*)(SKP + et * 128 + ec * 2), wkk = *(const LAS u32x4*)(SKR + et * 128 + ec * 2), wbb = *(const LAS u32x4*)(SBB + et * 128 + ec * 2);
          const float rv[8] = {blo(wr.x), bhi(wr.x), blo(wr.y), bhi(wr.y), blo(wr.z), bhi(wr.z), blo(wr.w), bhi(wr.w)}, kv[8] = {blo(wk.x), bhi(wk.x), blo(wk.y), bhi(wk.y), blo(wk.z), bhi(wk.z), blo(wk.w), bhi(wk.w)};
          const float kkv[8] = {blo(wkk.x), bhi(wkk.x), blo(wkk.y), bhi(wkk.y), blo(wkk.z), bhi(wkk.z), blo(wkk.w), bhi(wkk.w)}, bbv[8] = {blo(wbb.x), bhi(wbb.x), blo(wbb.y), bhi(wbb.y), blo(wbb.z), bhi(wbb.z), blo(wbb.w), bhi(wbb.w)};
          unsigned short ab[8], bb_[8], kb_[8], rb[8];
#pragma unroll
          for (int e = 0; e < 8; ++e) { const float ep = fexp_(lg[e]), en = fexp_(-lg[e]), epv = fexp_(lgp[e]);
              ab[e] = (unsigned short)f2bf(-kkv[e] * kiv * epv); bb_[e] = (unsigned short)f2bf(bbv[e] * kiv * en); kb_[e] = (unsigned short)f2bf(kv[e] * en); rb[e] = (unsigned short)f2bf(rv[e] * ep); }
#define PK8(x) (u32x4){(unsigned)x[0] | ((unsigned)x[1] << 16), (unsigned)x[2] | ((unsigned)x[3] << 16), (unsigned)x[4] | ((unsigned)x[5] << 16), (unsigned)x[6] | ((unsigned)x[7] << 16)}
          *(LAS u32x4*)(AT + et * ST + ec * 2) = PK8(ab); *(LAS u32x4*)(BT + et * ST + ec * 2) = PK8(bb_); *(LAS u32x4*)(KT + et * ST + ec * 2) = PK8(kb_); *(LAS u32x4*)(RT + et * ST + ec * 2) = PK8(rb);
#undef PK8
#pragma unroll
          for (int e = 0; e < 8; ++e) { *(LAS unsigned short*)(BTT + (ec + e) * ST + et * 2) = bb_[e]; *(LAS unsigned short*)(KTT + (ec + e) * ST + et * 2) = kb_[e]; } }
        __syncthreads();
        bf16x8_t ppk[2], qpk[2];
        if (wave < 4) { const int tt = wave; const bf16x8_t r0 = RD8(RT + (16 * tt + li) * ST + quad * 16), r1 = RD8(RT + (16 * tt + li) * ST + 64 + quad * 16);
            u32x2 pw[4], qw[4];
#pragma unroll
            for (int jt = 0; jt < 4; ++jt) { f32x4 pa = {0.f, 0.f, 0.f, 0.f}, qa = pa;
                pa = MF32(RD8(BT + (16 * jt + li) * ST + quad * 16), r0, pa); pa = MF32(RD8(BT + (16 * jt + li) * ST + 64 + quad * 16), r1, pa);
                qa = MF32(RD8(KT + (16 * jt + li) * ST + quad * 16), r0, qa); qa = MF32(RD8(KT + (16 * jt + li) * ST + 64 + quad * 16), r1, qa);
#pragma unroll
                for (int e = 0; e < 4; ++e) { const bool keep = (16 * jt + 4 * quad + e) <= (16 * tt + li); pa[e] = keep ? pa[e] : 0.f; qa[e] = keep ? qa[e] : 0.f; }
                pw[jt] = (u32x2){pg8::cvt_pk_bf16(pa[0], pa[1]), pg8::cvt_pk_bf16(pa[2], pa[3])}; qw[jt] = (u32x2){pg8::cvt_pk_bf16(qa[0], qa[1]), pg8::cvt_pk_bf16(qa[2], qa[3])}; }
            ppk[0] = __builtin_bit_cast(bf16x8_t, (u32x4){pw[0].x, pw[0].y, pw[1].x, pw[1].y}); ppk[1] = __builtin_bit_cast(bf16x8_t, (u32x4){pw[2].x, pw[2].y, pw[3].x, pw[3].y});
            qpk[0] = __builtin_bit_cast(bf16x8_t, (u32x4){qw[0].x, qw[0].y, qw[1].x, qw[1].y}); qpk[1] = __builtin_bit_cast(bf16x8_t, (u32x4){qw[2].x, qw[2].y, qw[3].x, qw[3].y});
            { f32x4 na = {0.f, 0.f, 0.f, 0.f};
              na = MF32(RD8(AT + (16 * tt + li) * ST + quad * 16), RD8(BT + (16 * tt + li) * ST + quad * 16), na); na = MF32(RD8(AT + (16 * tt + li) * ST + 64 + quad * 16), RD8(BT + (16 * tt + li) * ST + 64 + quad * 16), na);
#pragma unroll
              for (int e = 0; e < 4; ++e) ND[tt * 272 + (4 * quad + e) * 17 + li] = (li < 4 * quad + e) ? na[e] : 0.f;
              LDS_WAIT(); asm volatile("" ::: "memory");
              if (lane < 16) { float x[16];
#pragma unroll
                  for (int t = 0; t < 16; ++t) { float sacc = (t == lane) ? 1.f : 0.f;
#pragma unroll
                      for (int q = 0; q < t; ++q) sacc += ND[tt * 272 + t * 17 + q] * x[q];
                      x[t] = sacc; *(LAS unsigned short*)(DB + tt * 768 + t * 48 + lane * 2) = (unsigned short)f2bf(sacc); } } }
        } else { const int rw = wave - 4; const bf16x8_t a0 = RD8(AT + (16 * rw + li) * ST + quad * 16), a1 = RD8(AT + (16 * rw + li) * ST + 64 + quad * 16);
            ppk[0] = (bf16x8_t){0, 0, 0, 0, 0, 0, 0, 0}; ppk[1] = ppk[0]; qpk[0] = ppk[0]; qpk[1] = ppk[0];
#pragma unroll
            for (int jt = 0; jt < 4; ++jt) { f32x4 na = {0.f, 0.f, 0.f, 0.f}, ma = na;
                if (jt <= rw) { na = MF32(a0, RD8(BT + (16 * jt + li) * ST + quad * 16), na); na = MF32(a1, RD8(BT + (16 * jt + li) * ST + 64 + quad * 16), na);
                                ma = MF32(a0, RD8(KT + (16 * jt + li) * ST + quad * 16), ma); ma = MF32(a1, RD8(KT + (16 * jt + li) * ST + 64 + quad * 16), ma); }
#pragma unroll
                for (int e = 0; e < 4; ++e) { const int tr = 16 * rw + 4 * quad + e, jc = 16 * jt + li; const bool keep = jc < tr; const float nv = keep ? na[e] : 0.f, mv = keep ? ma[e] : 0.f;
                    *(LAS unsigned short*)(NB + tr * ST + jc * 2) = (unsigned short)f2bf(nv); *(LAS unsigned short*)(MB + tr * ST + jc * 2) = (unsigned short)f2bf(mv);
                    } }
        }
        __syncthreads();
        { const int cw = wave & 3; f32x4 rhs[4];
          if (wave < 4) {
#pragma unroll
              for (int i = 0; i < 4; ++i)
#pragma unroll
                  for (int e = 0; e < 4; ++e) rhs[i][e] = bf2f(*(const LAS unsigned short*)(AT + (16 * i + 4 * quad + e) * ST + (16 * cw + li) * 2));
          } else { const bf16x8_t v0 = RD8(VTl + (16 * cw + li) * ST + quad * 16), v1 = RD8(VTl + (16 * cw + li) * ST + 64 + quad * 16);
#pragma unroll
              for (int i = 0; i < 4; ++i) { f32x4 a = {0.f, 0.f, 0.f, 0.f}; a = MF32(RD8(MB + (16 * i + li) * ST + quad * 16), v0, a); a = MF32(RD8(MB + (16 * i + li) * ST + 64 + quad * 16), v1, a); rhs[i] = a; } }
          LAS unsigned char* XT = (wave < 4) ? WMT : UMT; bf16x4_t xb[4];
#pragma unroll
          for (int i = 0; i < 4; ++i) { f32x4 acc = rhs[i];
#pragma unroll
              for (int kb = 0; kb < 4; ++kb) if (kb < i) acc = MF16(RD4(NB + (16 * i + li) * ST + (16 * kb + 4 * quad) * 2), xb[kb], acc);
              const u32x2 aw = {pg8::cvt_pk_bf16(acc[0], acc[1]), pg8::cvt_pk_bf16(acc[2], acc[3])};
              f32x4 x = {0.f, 0.f, 0.f, 0.f}; x = MF16(RD4(DB + i * 768 + li * 48 + quad * 8), __builtin_bit_cast(bf16x4_t, aw), x);
              const u32x2 xw = {pg8::cvt_pk_bf16(x[0], x[1]), pg8::cvt_pk_bf16(x[2], x[3])}; xb[i] = __builtin_bit_cast(bf16x4_t, xw);
              *(LAS u32x2*)(XT + (16 * cw + li) * ST + (16 * i + 4 * quad) * 2) = xw; } }
        __syncthreads();
        if (wave < 4) { const int tt = wave; const int tg = 16 * tt + li;
            bf16* rmo = RM + (size_t)it * 4096 + tg * 64; bf16* y0o = Y0 + (size_t)it * 4096 + tg * 64;
#pragma unroll
            for (int ct = 0; ct < 4; ++ct) { const u32x2 rw2 = *(const LAS u32x2*)(RT + tg * ST + (16 * ct + 4 * quad) * 2); f32x4 acc = {blo(rw2.x), bhi(rw2.x), blo(rw2.y), bhi(rw2.y)};
#pragma unroll
                for (int s2 = 0; s2 < 2; ++s2) { const LAS unsigned char* wp = WMT + (16 * ct + li) * ST + (32 * s2 + 4 * quad) * 2; const u32x2 lo = *(const LAS u32x2*)wp, hi = *(const LAS u32x2*)(wp + 32);
                    acc = MF32(__builtin_bit_cast(bf16x8_t, (u32x4){lo.x, lo.y, hi.x, hi.y}), ppk[s2], acc); }
                *(u32x2*)(rmo + 16 * ct + 4 * quad) = (u32x2){pg8::cvt_pk_bf16(acc[0], acc[1]), pg8::cvt_pk_bf16(acc[2], acc[3])}; }
#pragma unroll
            for (int vt = 0; vt < 4; ++vt) { f32x4 acc = {0.f, 0.f, 0.f, 0.f};
#pragma unroll
                for (int s2 = 0; s2 < 2; ++s2) { const LAS unsigned char* up = UMT + (16 * vt + li) * ST + (32 * s2 + 4 * quad) * 2; const u32x2 ulo = *(const LAS u32x2*)up, uhi = *(const LAS u32x2*)(up + 32);
                    acc = MF32(__builtin_bit_cast(bf16x8_t, (u32x4){ulo.x, ulo.y, uhi.x, uhi.y}), ppk[s2], acc);
                    const LAS unsigned char* vp = VTl + (16 * vt + li) * ST + (32 * s2 + 4 * quad) * 2; const u32x2 vlo = *(const LAS u32x2*)vp, vhi = *(const LAS u32x2*)(vp + 32);
                    acc = MF32(__builtin_bit_cast(bf16x8_t, (u32x4){vlo.x, vlo.y, vhi.x, vhi.y}), qpk[s2], acc); }
                *(u32x2*)(y0o + 16 * vt + 4 * quad) = (u32x2){pg8::cvt_pk_bf16(acc[0], acc[1]), pg8::cvt_pk_bf16(acc[2], acc[3])}; }
        } else { const int xt = wave - 4;
            const bf16x8_t bt0 = RD8(BTT + (16 * xt + li) * ST + quad * 16), bt1 = RD8(BTT + (16 * xt + li) * ST + 64 + quad * 16);
            const float gc2 = GC[16 * xt + li]; bf16* pco = PCT + (size_t)it * 4096 + (16 * xt + li) * 64;
#pragma unroll
            for (int c1 = 0; c1 < 4; ++c1) { f32x4 acc = {0.f, 0.f, 0.f, 0.f};
                acc = MF32(RD8(WMT + (16 * c1 + li) * ST + quad * 16), bt0, acc); acc = MF32(RD8(WMT + (16 * c1 + li) * ST + 64 + quad * 16), bt1, acc);
                float o[4];
#pragma unroll
                for (int e = 0; e < 4; ++e) o[e] = gc2 * (acc[e] + (((16 * c1 + 4 * quad + e) == (16 * xt + li)) ? 1.f : 0.f));
                *(u32x2*)(pco + 16 * c1 + 4 * quad) = (u32x2){pg8::cvt_pk_bf16(o[0], o[1]), pg8::cvt_pk_bf16(o[2], o[3])}; }
            const bf16x8_t um0 = RD8(UMT + (16 * xt + li) * ST + quad * 16), um1 = RD8(UMT + (16 * xt + li) * ST + 64 + quad * 16), vt0 = RD8(VTl + (16 * xt + li) * ST + quad * 16), vt1 = RD8(VTl + (16 * xt + li) * ST + 64 + quad * 16);
            bf16* lco = LC + (size_t)it * 4096 + (16 * xt + li) * 64;
#pragma unroll
            for (int ct = 0; ct < 4; ++ct) { f32x4 acc = {0.f, 0.f, 0.f, 0.f};
                acc = MF32(RD8(BTT + (16 * ct + li) * ST + quad * 16), um0, acc); acc = MF32(RD8(BTT + (16 * ct + li) * ST + 64 + quad * 16), um1, acc);
                acc = MF32(RD8(KTT + (16 * ct + li) * ST + quad * 16), vt0, acc); acc = MF32(RD8(KTT + (16 * ct + li) * ST + 64 + quad * 16), vt1, acc);
                const f32x4 g4 = *(const LAS f32x4*)(GC + 16 * ct + 4 * quad);
                *(u32x2*)(lco + 16 * ct + 4 * quad) = (u32x2){pg8::cvt_pk_bf16(acc[0] * g4.x, acc[1] * g4.y), pg8::cvt_pk_bf16(acc[2] * g4.z, acc[3] * g4.w)}; }
        }
      }
    }
#undef F1LOAD
#undef MF32
#undef MF16
#undef RD8
#undef RD4
    __syncthreads();
}
template <int MODE> DI void state_scan16(Frame& F) {
    constexpr int SLOT = 18432, NSL = 6;
    const bf16* PT = (const bf16*)(WSP(F) + (MODE == 1 ? WS_PGT : WS_PCT)); const bf16* LL = (const bf16*)(WSP(F) + (MODE == 1 ? WS_LG : WS_LC));
    LAS unsigned char* ring = F.lds;
    const int nitems = (MODE == 1) ? BATCH * 8 : BATCH * 8 * 16;
#define RBAR() do { asm volatile("s_waitcnt lgkmcnt(0)" ::: "memory"); __builtin_amdgcn_s_barrier(); asm volatile("" ::: "memory"); } while (0)
    for (int it = F.bid; it < nitems; it += F.G) {
        int tid = F.tid; asm volatile("" : "+v"(tid));
        const int lane = tid & 63, wave = __builtin_amdgcn_readfirstlane(tid >> 6), vl = lane & 15, quad = lane >> 4;
        const size_t opbase = (MODE == 1) ? (size_t)it * 16 * 4096 : (size_t)((it >> 4) * 256 + (it & 15) * 16) * 4096;
        const bf16* pt = PT + opbase; const bf16* ll = LL + opbase;
        __syncthreads();
        const unsigned loffp = (unsigned)((tid >> 3) * 144 + (tid & 7) * 16), loffl = 9216u + loffp;
        u32x4 rg[4][2];
#define SLOAD(q, x) do { rg[q][0] = *((const u32x4*)(pt + (size_t)(x) * 4096) + tid); rg[q][1] = *((const u32x4*)(ll + (size_t)(x) * 4096) + tid); } while (0)
#define SWRITE(q, x) do { LAS unsigned char* d_ = ring + ((x) % NSL) * SLOT; *(LAS u32x4*)(d_ + loffp) = rg[q][0]; *(LAS u32x4*)(d_ + loffl) = rg[q][1]; } while (0)
        SLOAD(0, 0); SLOAD(1, 1); SLOAD(2, 2); SLOAD(3, 3);
        SWRITE(0, 0); SWRITE(1, 1);
        SLOAD(0, 4); SLOAD(1, 5);
        const bool pwave = (MODE == 0) && (wave < 4); const bool active = (MODE == 0) || (wave < 4); const int vb = wave & 3;
        f32x4 st[4];
#pragma unroll
        for (int kt = 0; kt < 4; ++kt) { st[kt] = (f32x4){0.f, 0.f, 0.f, 0.f};
            if (pwave) {
#pragma unroll
                for (int j = 0; j < 4; ++j) st[kt][j] = ((16 * kt + 4 * quad + j) == (16 * vb + vl)) ? 1.f : 0.f; }
            if (MODE == 2 && active) { const u32x2 w = *(const u32x2*)((const bf16*)(WSP(F) + WS_SG) + (size_t)it * 4096 + (16 * vb + vl) * 64 + 16 * kt + 4 * quad); st[kt] = (f32x4){blo(w.x), bhi(w.x), blo(w.y), bhi(w.y)}; } }
        const unsigned aoff = (unsigned)(vl * 144 + quad * 8), loffc = (unsigned)(9216 + (16 * vb + vl) * 144 + quad * 8);
        RBAR();
#pragma unroll
        for (int c = 0; c < 16; ++c) {
            if (c + 2 < 16) { SWRITE((c + 2) & 3, c + 2); if (c + 6 < 16) SLOAD((c + 2) & 3, c + 6); }
            if (active) {
                const LAS unsigned char* sl = ring + (c % NSL) * SLOT;
                bf16x8_t bfr[2];
                { u32x2 pk[4];
#pragma unroll
                  for (int kt = 0; kt < 4; ++kt) { pk[kt] = (u32x2){pg8::cvt_pk_bf16(st[kt][0], st[kt][1]), pg8::cvt_pk_bf16(st[kt][2], st[kt][3])};
                      if (MODE == 1) *(u32x2*)((bf16*)(WSP(F) + WS_SG) + ((size_t)it * 16 + c) * 4096 + (16 * vb + vl) * 64 + 16 * kt + 4 * quad) = pk[kt];
                      if (MODE == 2) *(u32x2*)((bf16*)(WSP(F) + WS_S0) + (opbase + (size_t)c * 4096) + (16 * vb + vl) * 64 + 16 * kt + 4 * quad) = pk[kt]; }
                  bfr[0] = __builtin_bit_cast(bf16x8_t, (u32x4){pk[0].x, pk[0].y, pk[1].x, pk[1].y}); bfr[1] = __builtin_bit_cast(bf16x8_t, (u32x4){pk[2].x, pk[2].y, pk[3].x, pk[3].y}); }
#pragma unroll
                for (int kt = 0; kt < 4; ++kt) { f32x4 acc = {0.f, 0.f, 0.f, 0.f};
                    if (!pwave) { const u32x2 lf = *(const LAS u32x2*)(sl + loffc + kt * 32); acc = (f32x4){blo(lf.x), bhi(lf.x), blo(lf.y), bhi(lf.y)}; }
#pragma unroll
                    for (int s2 = 0; s2 < 2; ++s2) { const u32x2 a0 = *(const LAS u32x2*)(sl + aoff + kt * 16 * 144 + s2 * 64), a1 = *(const LAS u32x2*)(sl + aoff + kt * 16 * 144 + s2 * 64 + 32);
                        acc = __builtin_amdgcn_mfma_f32_16x16x32_bf16(__builtin_bit_cast(bf16x8_t, (u32x4){a0.x, a0.y, a1.x, a1.y}), bfr[s2], acc, 0, 0, 0); }
                    st[kt] = acc; }
            }
            RBAR();
        }
        if (MODE == 0) {
            bf16* pg = (bf16*)(WSP(F) + WS_PGT) + (size_t)it * 4096; bf16* lg = (bf16*)(WSP(F) + WS_LG) + (size_t)it * 4096;
#pragma unroll
            for (int kt = 0; kt < 4; ++kt) {
                if (pwave) {
#pragma unroll
                    for (int j = 0; j < 4; ++j) pg[(16 * kt + 4 * quad + j) * 64 + 16 * vb + vl] = (bf16)f2bf(st[kt][j]);
                } else *(u32x2*)(lg + (16 * vb + vl) * 64 + 16 * kt + 4 * quad) = (u32x2){pg8::cvt_pk_bf16(st[kt][0], st[kt][1]), pg8::cvt_pk_bf16(st[kt][2], st[kt][3])}; }
        }
#undef SLOAD
#undef SWRITE
    }
#undef RBAR
    __syncthreads();
}
DI void rwkv_out_phase(Frame& F, int l) {
    bf16* AR = (bf16*)(WSP(F) + WS_AR); const size_t AS = (size_t)T * 512; const float* bonus = (const float*)(WSP(F) + WS_BONUS);
    const bf16* RM = (const bf16*)(WSP(F) + WS_RM); const bf16* Y0 = (const bf16*)(WSP(F) + WS_Y0); const bf16* S0 = (const bf16*)(WSP(F) + WS_S0);
    const int gw = F.bid * 8 + F.wave, NGW = F.G * 8, lane = F.lane, li = lane & 15, quad = lane >> 4;
    for (int it = gw; it < BATCH * 8 * (SEQ / 64); it += NGW) {
        const int bh = it >> 8, ck = it & 255, b = bh >> 3, h = bh & 7;
        const bf16* s0 = S0 + (size_t)it * 4096; const bf16* rm = RM + (size_t)it * 4096; const bf16* y0 = Y0 + (size_t)it * 4096;
        bf16x8_t sa[4][2];
#pragma unroll
        for (int vt = 0; vt < 4; ++vt)
#pragma unroll
            for (int s2 = 0; s2 < 2; ++s2) sa[vt][s2] = *(const bf16x8_t*)(s0 + (16 * vt + li) * 64 + 32 * s2 + 8 * quad);
        float lg[4][4], lb[4][4];
#pragma unroll
        for (int vt = 0; vt < 4; ++vt) { const f32x4 g4 = *(const f32x4*)(INP(F, 14) + l * 512 + h * 64 + 16 * vt + 4 * quad), b4 = *(const f32x4*)(INP(F, 15) + l * 512 + h * 64 + 16 * vt + 4 * quad);
            lg[vt][0] = g4.x; lg[vt][1] = g4.y; lg[vt][2] = g4.z; lg[vt][3] = g4.w; lb[vt][0] = b4.x; lb[vt][1] = b4.y; lb[vt][2] = b4.z; lb[vt][3] = b4.w; }
#pragma unroll 1
        for (int tt = 0; tt < 4; ++tt) {
            const int tch = 16 * tt + li; const size_t t = (size_t)b * SEQ + ck * 64 + tch;
            bf16x8_t rb[2];
#pragma unroll
            for (int s2 = 0; s2 < 2; ++s2) rb[s2] = *(const bf16x8_t*)(rm + tch * 64 + 32 * s2 + 8 * quad);
            f32x4 acc[4];
#pragma unroll
            for (int vt = 0; vt < 4; ++vt) { const u32x2 yw = *(const u32x2*)(y0 + tch * 64 + 16 * vt + 4 * quad); acc[vt] = (f32x4){blo(yw.x), bhi(yw.x), blo(yw.y), bhi(yw.y)};
                acc[vt] = __builtin_amdgcn_mfma_f32_16x16x32_bf16(sa[vt][0], rb[0], acc[vt], 0, 0, 0); acc[vt] = __builtin_amdgcn_mfma_f32_16x16x32_bf16(sa[vt][1], rb[1], acc[vt], 0, 0, 0); }
            float sm = 0.f;
#pragma unroll
            for (int vt = 0; vt < 4; ++vt) sm += (acc[vt][0] + acc[vt][1]) + (acc[vt][2] + acc[vt][3]);
            sm += __shfl_xor(sm, 16); sm += __shfl_xor(sm, 32);
            const float mean = sm * (1.f / 64.f); float sq = 0.f;
#pragma unroll
            for (int vt = 0; vt < 4; ++vt)
#pragma unroll
                for (int e = 0; e < 4; ++e) { const float d = acc[vt][e] - mean; acc[vt][e] = d; sq += d * d; }
            sq += __shfl_xor(sq, 16); sq += __shfl_xor(sq, 32);
            const float rstd = rsqrtf(sq * (1.f / 64.f) + 64e-5f), bon = bonus[t * 8 + h];
            const size_t idx = t * 512 + h * 64 + 4 * quad;
#pragma unroll
            for (int vt = 0; vt < 4; ++vt) { const u32x2 vw = *(const u32x2*)(AR + 3 * AS + idx + 16 * vt), gw2 = *(const u32x2*)(AR + 6 * AS + idx + 16 * vt);
                const float vv[4] = {blo(vw.x), bhi(vw.x), blo(vw.y), bhi(vw.y)}, gg[4] = {blo(gw2.x), bhi(gw2.x), blo(gw2.y), bhi(gw2.y)}; float o[4];
#pragma unroll
                for (int e = 0; e < 4; ++e) o[e] = (acc[vt][e] * rstd * lg[vt][e] + lb[vt][e] + bon * vv[e]) * gg[e];
                *(u32x2*)(AR + idx + 16 * vt) = (u32x2){pk2(o[0], o[1]), pk2(o[2], o[3])}; }
        }
    }
}
DI void route_phase(Frame& F, int l) {
    const float* x = OUTP(F); bf16* h2 = (bf16*)(WSP(F) + WS_XB); const bf16* RWH = (const bf16*)(WSP(F) + WS_RWG); const bf16* RWL = RWH + 48 * 1024;
    int* route = (int*)(WSP(F) + WS_ROUTE); float* rwt = (float*)(WSP(F) + WS_RWT); unsigned* cnt = (unsigned*)(WSP(F) + WS_CTL) + CW_CNT + 32 * l;
    const float* rgb = INP(F, 24) + l * 4; const float* reb = INP(F, 26) + l * 32;
    LAS unsigned* lc = (LAS unsigned*)(F.lds + MISC_OFF + 8192); unsigned* wgbase = (unsigned*)(WSP(F) + WS_WGBASE);
    for (int wit = F.bid; wit < T / 128; wit += F.G) {
        int lane = F.lane; asm volatile("" : "+v"(lane));
        __syncthreads();
        if (F.tid < 32) lc[F.tid] = 0u;
        __syncthreads();
        const int it = wit * 8 + F.wave;
        const int li = lane & 15, quad = lane >> 4; const size_t t = (size_t)it * 16 + li;
        const float* xr = x + t * DM + 8 * quad;
        f32x4 acc[3];
#pragma unroll
        for (int jt = 0; jt < 3; ++jt) acc[jt] = (f32x4){0.f, 0.f, 0.f, 0.f};
        float ss = 0.f;
        LAS unsigned char* wbuf = F.lds;
        u32x4 wst[3]; f32x4 xc[8], xn[8];
#define WLOAD(kc) do { _Pragma("unroll") for (int i = 0; i < 3; ++i) { const int p_ = F.tid + 512 * i, hl_ = p_ / 768, q_ = p_ % 768, r_ = q_ >> 4, c_ = q_ & 15; \
            wst[i] = *(const u32x4*)((hl_ ? RWL : RWH) + (size_t)r_ * 1024 + (kc) * 128 + c_ * 8); } } while (0)
#define WSTORE(bf) do { _Pragma("unroll") for (int i = 0; i < 3; ++i) { const int p_ = F.tid + 512 * i, hl_ = p_ / 768, q_ = p_ % 768, r_ = q_ >> 4, c_ = q_ & 15; \
            *(LAS u32x4*)(wbuf + (bf) * 26112 + hl_ * 13056 + r_ * 272 + c_ * 16) = wst[i]; } } while (0)
#define XLOAD(dst, kc) do { _Pragma("unroll") for (int k_ = 0; k_ < 4; ++k_) { dst[2 * k_] = *(const f32x4*)(xr + (kc) * 128 + 32 * k_); dst[2 * k_ + 1] = *(const f32x4*)(xr + (kc) * 128 + 32 * k_ + 4); } } while (0)
        WLOAD(0); XLOAD(xc, 0);
        WSTORE(0);
        __syncthreads();
#pragma unroll
        for (int kc = 0; kc < 8; ++kc) {
            if (kc < 7) { WLOAD(kc + 1); XLOAD(xn, kc + 1); }
            const LAS unsigned char* wb = wbuf + (kc & 1) * 26112;
#pragma unroll
            for (int k4 = 0; k4 < 4; ++k4) {
                const f32x4 x0 = xc[2 * k4], x1 = xc[2 * k4 + 1];
                ss += (x0.x * x0.x + x0.y * x0.y) + (x0.z * x0.z + x0.w * x0.w) + (x1.x * x1.x + x1.y * x1.y) + (x1.z * x1.z + x1.w * x1.w);
                const unsigned h0 = pk2(x0.x, x0.y), h1 = pk2(x0.z, x0.w), h2_ = pk2(x1.x, x1.y), h3 = pk2(x1.z, x1.w);
                const bf16x8_t bh = __builtin_bit_cast(bf16x8_t, (u32x4){h0, h1, h2_, h3});
                const bf16x8_t bl = __builtin_bit_cast(bf16x8_t, (u32x4){pk2(x0.x - blo(h0), x0.y - bhi(h0)), pk2(x0.z - blo(h1), x0.w - bhi(h1)), pk2(x1.x - blo(h2_), x1.y - bhi(h2_)), pk2(x1.z - blo(h3), x1.w - bhi(h3))});
#pragma unroll
                for (int jt = 0; jt < 3; ++jt) { const LAS unsigned char* wp = wb + (16 * jt + li) * 272 + k4 * 64 + quad * 16;
                    const bf16x8_t wh = *(const LAS bf16x8_t*)wp, wl = *(const LAS bf16x8_t*)(wp + 13056);
                    acc[jt] = __builtin_amdgcn_mfma_f32_16x16x32_bf16(wh, bh, acc[jt], 0, 0, 0);
                    acc[jt] = __builtin_amdgcn_mfma_f32_16x16x32_bf16(wl, bh, acc[jt], 0, 0, 0);
                    acc[jt] = __builtin_amdgcn_mfma_f32_16x16x32_bf16(wh, bl, acc[jt], 0, 0, 0); }
            }
            if (kc < 7) { WSTORE((kc + 1) & 1);
#pragma unroll
                for (int i = 0; i < 8; ++i) xc[i] = xn[i]; }
            __syncthreads();
        }
#undef WLOAD
#undef WSTORE
#undef XLOAD
        ss += __shfl_xor(ss, 16); ss += __shfl_xor(ss, 32);
        const float rs = rsqrtf(ss * (1.f / DM) + 1e-6f);
#pragma unroll 4
        for (int ks = 0; ks < 32; ++ks) { const f32x4 x0 = *(const f32x4*)(xr + 32 * ks), x1 = *(const f32x4*)(xr + 32 * ks + 4);
            *(u32x4*)(h2 + t * DM + 32 * ks + 8 * quad) = (u32x4){pk2(x0.x * rs, x0.y * rs), pk2(x0.z * rs, x0.w * rs), pk2(x1.x * rs, x1.y * rs), pk2(x1.z * rs, x1.w * rs)}; }
        float gl[4]; int grp = 0;
#pragma unroll
        for (int j = 0; j < 4; ++j) gl[j] = acc[0][j] * rs + rgb[j];
        float gm = gl[0];
#pragma unroll
        for (int j = 1; j < 4; ++j) if (gl[j] > gm) { gm = gl[j]; grp = j; }
        if (quad == grp) {
            float gs = 0.f;
#pragma unroll
            for (int j = 0; j < 4; ++j) gs += __expf(gl[j] - gm);
            const float gprob = frcp_(gs);
            float eg[8];
#pragma unroll
            for (int i = 0; i < 4; ++i) { eg[i] = acc[1][i] * rs + reb[8 * quad + i]; eg[4 + i] = acc[2][i] * rs + reb[8 * quad + 4 + i]; }
            int i0 = 0; float m0 = eg[0];
#pragma unroll
            for (int i = 1; i < 8; ++i) if (eg[i] > m0) { m0 = eg[i]; i0 = i; }
            int i1 = -1; float m1 = -INFINITY;
#pragma unroll
            for (int i = 0; i < 8; ++i) if (i != i0 && eg[i] > m1) { m1 = eg[i]; i1 = i; }
            const float e10 = fexp_(m1 - m0), r10 = frcp_(1.0f + e10), wa = gprob * r10, wb = gprob * e10 * r10;
            const int e0 = grp * 8 + i0, e1 = grp * 8 + i1;
            const unsigned r0 = atomicAdd((unsigned*)(lc + e0), 1u), r1 = atomicAdd((unsigned*)(lc + e1), 1u);
            ((int4*)route)[t] = make_int4(e0, (int)r0, e1, (int)r1); ((float2*)rwt)[t] = make_float2(wa, wb);
        }
        __syncthreads();
        if (F.tid < 32) { const unsigned c = lc[F.tid]; wgbase[wit * 32 + F.tid] = c ? atomicAdd(cnt + F.tid, c) : 0u; }
    }
    __syncthreads();
}
DI int moe_tables(Frame& F, int l) {
    LAS int* ps = (LAS int*)(F.lds + MISC_OFF); LAS unsigned char* te = (LAS unsigned char*)(F.lds + MISC_OFF + 256);
    const unsigned* cnt = (const unsigned*)(WSP(F) + WS_CTL) + CW_CNT + 32 * l;
    __syncthreads();
    if (F.tid == 0) { int acc = 0;
_Pragma("unroll 1")
        for (int e = 0; e < NEXP; ++e) { ps[e] = acc; const int c = (int)__hip_atomic_load(cnt + e, __ATOMIC_RELAXED, __HIP_MEMORY_SCOPE_AGENT); const int nt = (c + 255) >> 8;
_Pragma("unroll 1")
            for (int i = 0; i < nt; ++i) te[(acc >> 8) + i] = (unsigned char)e; acc += nt << 8; } ps[NEXP] = acc; }
    __syncthreads();
    return __builtin_amdgcn_readfirstlane(ps[NEXP] >> 8);
}
DI void permute_phase(Frame& F, int l) {
    moe_tables(F, l);
    const LAS int* ps = (const LAS int*)(F.lds + MISC_OFF);
    const int* route = (const int*)(WSP(F) + WS_ROUTE); int* dest = (int*)(WSP(F) + WS_DEST); int* rowtok = (int*)(WSP(F) + WS_ROWTOK);
    const unsigned* cnt = (const unsigned*)(WSP(F) + WS_CTL) + CW_CNT + 32 * l;
    for (int t = F.bid * 512 + F.tid; t < T; t += F.G * 512) {
        const int4 r = ((const int4*)route)[t]; const unsigned* wb_ = (const unsigned*)(WSP(F) + WS_WGBASE) + (t >> 7) * 32; const int d0 = ps[r.x] + (int)wb_[r.x] + r.y, d1 = ps[r.z] + (int)wb_[r.z] + r.w;
        rowtok[d0] = t; rowtok[d1] = t; ((int2*)dest)[t] = make_int2(d0, d1);
    }
    if (F.bid == 0) {
#pragma unroll 1
        for (int e = 0; e < NEXP; ++e) { const int c = (int)__hip_atomic_load(cnt + e, __ATOMIC_RELAXED, __HIP_MEMORY_SCOPE_AGENT), lo = ps[e] + c, hi = ps[e + 1]; if (lo + F.tid < hi) rowtok[lo + F.tid] = 0; }
    }
}
DI void combine_phase(Frame& F, int l) {
    float* x = OUTP(F); const bf16* Y = (const bf16*)(WSP(F) + WS_YMOE); const int* dest = (const int*)(WSP(F) + WS_DEST); const float* rwt = (const float*)(WSP(F) + WS_RWT);
    bf16* xb = (bf16*)(WSP(F) + WS_XB); const float* fg = INP(F, 30);
    const int gw = F.bid * 8 + F.wave, NGW = F.G * 8, lane = F.lane; const bool last = (l == DEPTH - 1);
    for (int t = gw; t < T; t += NGW) {
        const int2 d = ((const int2*)dest)[t]; const float2 w = ((const float2*)rwt)[t];
        f32x4* xr = (f32x4*)(x + (size_t)t * DM) + lane; const u32x2* y0 = (const u32x2*)(Y + (size_t)d.x * DM) + lane; const u32x2* y1 = (const u32x2*)(Y + (size_t)d.y * DM) + lane;
        f32x4 v[4]; float s = 0.f;
#pragma unroll
        for (int j = 0; j < 4; ++j) { v[j] = xr[64 * j]; const u32x2 a = y0[64 * j], b = y1[64 * j];
            v[j].x += w.x * blo(a.x) + w.y * blo(b.x); v[j].y += w.x * bhi(a.x) + w.y * bhi(b.x); v[j].z += w.x * blo(a.y) + w.y * blo(b.y); v[j].w += w.x * bhi(a.y) + w.y * bhi(b.y);
            s += (v[j].x * v[j].x + v[j].y * v[j].y) + (v[j].z * v[j].z + v[j].w * v[j].w); }
        const float rs = rsqrtf(wave_sum(s) * (1.f / DM) + 1e-6f);
        if (last) {
#pragma unroll
            for (int j = 0; j < 4; ++j) { const f32x4 g = ((const f32x4*)fg)[lane + 64 * j]; xr[64 * j] = v[j] * rs * g; }
        } else {
            u32x2* o = (u32x2*)(xb + (size_t)t * DM) + lane;
#pragma unroll
            for (int j = 0; j < 4; ++j) { xr[64 * j] = v[j]; o[64 * j] = (u32x2){pk2(v[j].x * rs, v[j].y * rs), pk2(v[j].z * rs, v[j].w * rs)}; }
        }
    }
}

DI void dump_bf16(Frame& F, const bf16* src, int pitch, int ncols, int c0) {
    float* out = OUTP(F);
    for (size_t i = (size_t)F.bid * 512 + F.tid; i < (size_t)T * ncols; i += (size_t)F.G * 512) { const size_t t = i / ncols; const int c = (int)(i % ncols); out[t * DM + c0 + c] = bf2f(src[t * pitch + c]); }
}
__global__ void __launch_bounds__(512, 2) mk_fwd(Args args) {
    extern __shared__ __attribute__((aligned(16))) unsigned char lds_raw[];
    cg::grid_group grid = cg::this_grid();
    Frame F; F.lds = (LAS unsigned char*)lds_raw; F.tid = threadIdx.x; F.lane = F.tid & 63; F.wave = __builtin_amdgcn_readfirstlane(F.tid >> 6); F.G = gridDim.x; F.bid = (int)__builtin_amdgcn_workgroup_id_x();
    F.kp = (kargp_t)__builtin_amdgcn_kernarg_segment_ptr();
    for (int u = F.tid; u < 64; u += 512) ((LAS unsigned*)(F.lds + MISC_OFF + 4096))[u] = 0u;
    __syncthreads();
    (void)xcd_barrier_post((unsigned*)(WSP(F) + WS_CTL) + CW_BAR, (volatile LAS unsigned*)(F.lds + MISC_OFF + 4096));
    grid.sync();
#define GRID_BAR() do { XcdBarrier bb_; bb_.bar = (unsigned*)(WSP(F) + WS_CTL) + CW_BAR; bb_.x = xb_xcc_id(); bb_.st = (volatile LAS unsigned*)(F.lds + MISC_OFF + 4096); xcd_barrier(bb_); fence_frame(F); } while (0)
#define ws WSP(F)
#if defined(DBG_TMASK)
#define PT0() const unsigned long long pt0_ = __builtin_amdgcn_s_memrealtime()
#define PT1(k) do { if ((DBG_TMASK >> (k)) & 1) { const unsigned long long n_ = __builtin_amdgcn_s_memrealtime(); const unsigned long long e_ = n_ + (unsigned long long)DBG_AMP * (n_ - pt0_); while (__builtin_amdgcn_s_memrealtime() < e_) __builtin_amdgcn_s_sleep(16); } } while (0)
#else
#define PT0() do {} while (0)
#define PT1(k) do {} while (0)
#endif
    { PT0(); prep_mixer_weights(F, 0);
    rms_rows_to_bf16(F, INP(F, 0), (bf16*)(ws + WS_XB));
    GRID_BAR(); PT1(0); }
#if defined(DBG_STOP) && DBG_STOP == 10
    { PT0(); { pg8::Gemm g{(const bf16*)(ws + WS_XB), (const bf16*)(ws + WS_WG), T, 3072, DM}; pg8::StaticOrder S; S.init(T, 3072, F.G, (int)F.bid);
      pg8::EpiGate E{(unsigned char*)(ws + WS_GATES), 3072};
      pg8::gemm_phase<pg8::EpiGate, pg8::StaticOrder, true, true>(F.lds, g, S, E); }
    GRID_BAR(); PT1(10); }
    dump_bf16(F, (const bf16*)(ws + WS_GATES) + 1024, 3072, 1024, 0); return;
#endif
#pragma unroll 1
    for (int l = 0; l < DEPTH; ++l) {
        { PT0(); { pg8::Gemm g{(const bf16*)(ws + WS_XB), (const bf16*)(ws + WS_WIN), T, l == 0 ? 3840 : 4096, DM}; pg8::StaticOrder S; S.init(T, g.N, F.G, (int)F.bid);
          pg8::EpiZ E{(bf16*)(ws + WS_Q), (bf16*)(ws + WS_K), (bf16*)(ws + WS_VT), (bf16*)(ws + WS_POOLZ), (bf16*)(ws + WS_RWKVZ), C2, SEQ};
          pg8::gemm_phase<pg8::EpiZ, pg8::StaticOrder, true, true>(F.lds, g, S, E); }
        GRID_BAR(); PT1(1); }
        { PT0(); kmean_phase(F);
        pool_phase(F, l);
        GRID_BAR(); PT1(2); }
        { PT0(); sel_phase(F, l);
        GRID_BAR(); PT1(3); }
        { PT0(); att_phase(F, l);
        GRID_BAR(); PT1(4); }
        { PT0(); comb_phase(F);
        GRID_BAR(); PT1(5); }
#if defined(DBG_STOP) && DBG_STOP == 3
        dump_bf16(F, (const bf16*)(ws + WS_YATTN), 512, 512, 0); dump_bf16(F, (const bf16*)(ws + WS_YPOOL), 512, 512, 512); return;
#endif

        { PT0(); rwkv_chunk_phase(F, l);
        GRID_BAR(); PT1(7); }
        { PT0(); state_scan16<0>(F);
        GRID_BAR();
        state_scan16<1>(F);
        GRID_BAR();
        state_scan16<2>(F);
        GRID_BAR(); PT1(8); }
        { PT0(); rwkv_out_phase(F, l);
        GRID_BAR(); PT1(9); }
        { pg8::Gemm g{(const bf16*)(ws + WS_XB), (const bf16*)(ws + WS_WG), T, 3072, DM}; pg8::StaticOrder S; S.init(T, 3072, F.G, (int)F.bid);
          pg8::EpiGate E{(unsigned char*)(ws + WS_GATES), 3072};
          pg8::gemm_phase<pg8::EpiGate, pg8::StaticOrder, true, true>(F.lds, g, S, E); }
        GRID_BAR();
#if defined(DBG_SCRUB)
        { const f32x4* xs = (const f32x4*)INP(F, 0) + (size_t)F.bid * 32768; f32x4 a = {0.f, 0.f, 0.f, 0.f};
          for (int i = F.tid; i < 32768; i += 512) a += xs[i];
          if (a.x + a.y + a.z + a.w == 12345.678f) ((float*)(ws + WS_BONUS))[F.tid] = a.x; }
        GRID_BAR();
#endif
        { PT0(); { pg8::StaticOrder S; S.init(T, DM, F.G, (int)F.bid);
          { pg8::Gemm g{(const bf16*)(ws + WS_YATTN), (const bf16*)(ws + WS_WBR), T, DM, 512};
            pg8::EpiMerge<true> E{(bf16*)(ws + WS_XB), DM, (const unsigned char*)(ws + WS_GATES), 3072, 0};
            pg8::gemm_phase<pg8::EpiMerge<true>, pg8::StaticOrder, true, true>(F.lds, g, S, E); }
          { pg8::Gemm g{(const bf16*)(ws + WS_AR), (const bf16*)(ws + WS_WBR) + (size_t)1024 * 512, T, DM, 512};
            pg8::EpiMerge<false> E{(bf16*)(ws + WS_XB), DM, (const unsigned char*)(ws + WS_GATES), 3072, 1024};
            pg8::gemm_phase<pg8::EpiMerge<false>, pg8::StaticOrder, true, true>(F.lds, g, S, E); }
          { pg8::Gemm g{(const bf16*)(ws + WS_YPOOL), (const bf16*)(ws + WS_WBR) + (size_t)2 * 1024 * 512, T, DM, 512};
            pg8::EpiMerge<false> E{(bf16*)(ws + WS_XB), DM, (const unsigned char*)(ws + WS_GATES), 3072, 2048};
            pg8::gemm_phase<pg8::EpiMerge<false>, pg8::StaticOrder, true, true>(F.lds, g, S, E); } }
        GRID_BAR(); PT1(11); }
#if defined(DBG_STOP) && DBG_STOP == 7
        dump_bf16(F, (const bf16*)(ws + WS_XB), 1024, 1024, 0); return;
#endif
#if defined(DBG_STOP) && DBG_STOP == 6
        dump_bf16(F, (const bf16*)(ws + WS_GATES) + 1024, 3072, 1024, 0); return;
#endif
        { PT0(); { pg8::Gemm g{(const bf16*)(ws + WS_XB), (const bf16*)(ws + WS_WOUT), T, DM, DM}; pg8::StaticOrder S; S.init(T, DM, F.G, (int)F.bid);
          pg8::EpiResF32 E{l == 0 ? INP(F, 0) : OUTP(F), OUTP(F), DM};
          pg8::gemm_phase<pg8::EpiResF32, pg8::StaticOrder, true, true>(F.lds, g, S, E); }
        GRID_BAR(); PT1(12); }
#if defined(DBG_STOP) && DBG_STOP == 1
        return;
#endif
        { PT0(); route_phase(F, l);
#if defined(DBG_TMASK)
        GRID_BAR(); PT1(13); } { PT0();
#endif
        prep_expert_weights(F, l);
        GRID_BAR(); PT1(18); }
        { PT0(); permute_phase(F, l);
        GRID_BAR(); PT1(14); }
        { const int ntile = moe_tables(F, l);
          const LAS unsigned char* te = (const LAS unsigned char*)(F.lds + MISC_OFF + 256);
          { PT0(); { pg8::Gemm g{(const bf16*)(ws + WS_XB), (const bf16*)(ws + WS_W13), RMAX, NEXP * 1024, DM, (const int*)(ws + WS_ROWTOK)}; pg8::MoeOrder S{te, ntile * 4, F.G, (int)F.bid};
            pg8::EpiSwiGLU E{(bf16*)(ws + WS_HACT)};
            pg8::gemm_phase<pg8::EpiSwiGLU, pg8::MoeOrder, true, true, true>(F.lds, g, S, E); }
          GRID_BAR(); PT1(15); }
          { PT0(); { pg8::Gemm g{(const bf16*)(ws + WS_HACT), (const bf16*)(ws + WS_W2), RMAX, NEXP * 1024, 512}; pg8::MoeOrder S{te, ntile * 4, F.G, (int)F.bid};
            pg8::EpiY E{(bf16*)(ws + WS_YMOE)};
            pg8::gemm_phase<pg8::EpiY, pg8::MoeOrder, true, true>(F.lds, g, S, E); }
        GRID_BAR(); PT1(16); } }
        { PT0(); combine_phase(F, l);
        if (l + 1 < DEPTH) prep_mixer_weights(F, l + 1);
        GRID_BAR(); PT1(17); }
#if defined(DBG_STOP) && DBG_STOP == 2
        return;
#endif
    }
#undef ws
}

extern "C" void kernel_launch(void* const* d_in, const int* in_sizes, int n_in, void* d_out, int out_size, void* d_ws, size_t ws_size, hipStream_t stream) {
    static int grid = 0;
    if (grid == 0) {
        if (n_in != 31 || out_size != T * DM || ws_size < WS_END) { fprintf(stderr, "kernel_launch: unexpected shapes (n_in %d out %d ws %zu, need %zu)\n", n_in, out_size, ws_size, (size_t)WS_END); grid = -1; return; }
        int dev = 0, cus = 0, per_cu = 0;
        (void)hipGetDevice(&dev); (void)hipDeviceGetAttribute(&cus, hipDeviceAttributeMultiprocessorCount, dev);
        (void)hipFuncSetAttribute((const void*)mk_fwd, hipFuncAttributeMaxDynamicSharedMemorySize, LDS_BYTES);
        (void)hipOccupancyMaxActiveBlocksPerMultiprocessor(&per_cu, (const void*)mk_fwd, 512, LDS_BYTES);
        (void)hipGetLastError();
        fprintf(stderr, "kernel_launch: cus %d per_cu %d ws %zu\n", cus, per_cu, ws_size);
        grid = cus;
    }
    if (grid < 0) return;
    (void)hipMemsetAsync((char*)d_ws + WS_CTL, 0, CTL_BYTES, stream);
    Args a{};
    for (int i = 0; i < 31; ++i) a.in[i] = (const float*)d_in[i];
    a.out = (float*)d_out; a.ws = (unsigned char*)d_ws;
    void* kargs[] = {&a};
    hipError_t e = hipLaunchCooperativeKernel((const void*)mk_fwd, dim3(grid), dim3(512), kargs, LDS_BYTES, stream);
    if (e != hipSuccess) fprintf(stderr, "cooperative launch failed: %s (grid %d)\n", hipGetErrorString(e), grid);
}
```
